# Optimizing an MI355X kernel written in HIP

```python
import math
import jax, jax.numpy as jnp
from jax import lax
import numpy as np

D_MODEL = 2048
BATCH = 16
SEQ = 256
DEPTH = 2
DEC_BATCH = 8
DEC_SEQ = 2048
PAST_LEN = 512

GRID_W = 64
D_A = D_MODEL // 2
EMB_DIM = 33
N_BANDS = (EMB_DIM - 1) // 2
FILTER_FF = 64
DECAY_TARGET = 1e-2
FAST_DECAY_PCT = 0.3
SLOW_DECAY_PCT = 1.5
MAX_DECAY = math.log(DECAY_TARGET) / FAST_DECAY_PCT
MIN_DECAY = math.log(DECAY_TARGET) / SLOW_DECAY_PCT
N_HEADS = 8
QK_NOPE = 128
ROPE_DIM = 64
V_DIM = 128
Q_LORA = D_MODEL // 4
KV_LORA = D_MODEL // 8
D_B = N_HEADS * V_DIM
ROPE_THETA = 10000.0
ROPE_HALF = ROPE_DIM // 2
AXIS_PAIRS = ROPE_HALF // 2
ATTN_SCALE = (QK_NOPE + ROPE_DIM) ** -0.5
Q_BLOCK = 128
D_C = D_MODEL // 2
D_FF = 5632
EPS = 1e-6
N_IN = 3 * D_A + Q_LORA + KV_LORA + ROPE_DIM + 3 * D_C + 3 * D_MODEL
SPLIT_IDX = (3 * D_A,
             3 * D_A + Q_LORA,
             3 * D_A + Q_LORA + KV_LORA,
             3 * D_A + Q_LORA + KV_LORA + ROPE_DIM,
             3 * D_A + Q_LORA + KV_LORA + ROPE_DIM + 3 * D_C)

kernel_name = "hybrid_flow_prefix_hyena_mla_shortconv"


def rmsnorm(x, g):
    xf = x.astype(jnp.float32)
    y = xf * lax.rsqrt(jnp.mean(xf * xf, axis=-1, keepdims=True) + EPS)
    return y.astype(x.dtype) * g


def dwconv3(x, w):
    xp = jnp.pad(x, ((0, 0), (1, 1), (0, 0)))
    return xp[:, :-2] * w[0] + x * w[1] + xp[:, 2:] * w[2]


def axial_rope(L):
    rows = L // GRID_W
    row = jnp.repeat(jnp.arange(rows, dtype=jnp.float32), GRID_W)
    col = jnp.tile(jnp.arange(GRID_W, dtype=jnp.float32), rows)
    inv = ROPE_THETA ** (-jnp.arange(AXIS_PAIRS, dtype=jnp.float32) / AXIS_PAIRS)
    ang = jnp.concatenate([row[:, None] * inv, col[:, None] * inv], axis=-1)
    return jnp.cos(ang), jnp.sin(ang)


def apply_rope(x, cos, sin):
    cos = cos.astype(x.dtype)
    sin = sin.astype(x.dtype)
    x1, x2 = x[..., :ROPE_HALF], x[..., ROPE_HALF:]
    return jnp.concatenate([x1 * cos - x2 * sin, x1 * sin + x2 * cos], axis=-1)


def hyena_filter(L, lp):
    f32 = jnp.float32
    t_idx = jnp.arange(L, dtype=f32)
    t_norm = t_idx / max(L - 1, 1)
    w = 2.0 * math.pi * t_idx / L
    bands = jnp.linspace(1e-4, N_BANDS - 1, N_BANDS, dtype=f32)
    ang = w[:, None] * bands[None, :]
    z = jnp.concatenate([t_norm[:, None], jnp.cos(ang), -jnp.sin(ang)], axis=-1)
    freq = lp['hy_f_freq'].astype(f32)
    hdn = jnp.sin(freq[0] * (z @ lp['hy_f_w1'].astype(f32) + lp['hy_f_b1'].astype(f32)))
    hdn = jnp.sin(freq[1] * (hdn @ lp['hy_f_w2'].astype(f32) + lp['hy_f_b2'].astype(f32)))
    hf = hdn @ lp['hy_f_w3'].astype(f32) + lp['hy_f_b3'].astype(f32)
    deltas = jnp.abs(jnp.linspace(MIN_DECAY, MAX_DECAY, D_A, dtype=f32))
    window = jnp.exp(-t_norm[:, None] * deltas[None, :])
    hf = hf * jnp.concatenate([window, window], axis=-1)
    h_fwd, h_bwd = hf[:, :D_A], hf[:, D_A:]
    k = jnp.concatenate([h_fwd, jnp.zeros((1, D_A), f32), h_bwd[:0:-1]], axis=0)
    return k / jnp.sum(jnp.abs(k), axis=0, keepdims=True)


def long_conv(u, k):
    L = u.shape[1]
    uf = jnp.fft.rfft(u.astype(jnp.float32), n=2 * L, axis=1)
    kf = jnp.fft.rfft(k, n=2 * L, axis=0)
    y = jnp.fft.irfft(uf * kf[None], n=2 * L, axis=1)[:, :L]
    return y.astype(u.dtype)


def mla_attend(q_lat, q_pe, keys_c, keys_pe):
    B, Lq, H, C = q_lat.shape
    nb = Lq // Q_BLOCK
    qlb = q_lat.reshape(B, nb, Q_BLOCK, H, C).swapaxes(0, 1)
    qpb = q_pe.reshape(B, nb, Q_BLOCK, H, ROPE_DIM).swapaxes(0, 1)

    def block(args):
        ql, qp = args
        s = (jnp.einsum('bqhc,bkc->bhqk', ql, keys_c)
             + jnp.einsum('bqhr,bkr->bhqk', qp, keys_pe)).astype(jnp.float32) * ATTN_SCALE
        p = jax.nn.softmax(s, axis=-1).astype(keys_c.dtype)
        return jnp.einsum('bhqk,bkc->bqhc', p, keys_c)

    out = lax.map(block, (qlb, qpb))
    return out.swapaxes(0, 1).reshape(B, Lq, H, C)


def token_mix(h, lp, rope, ctx_kv):
    Bsz, L, _ = h.shape
    proj = h @ lp['w_in']
    hy_in, cq, ckv, kpe, sc_in, gates = jnp.split(proj, SPLIT_IDX, axis=-1)
    hy = dwconv3(hy_in, lp['hy_conv_w']) + lp['hy_conv_b']
    x0, x1, v = jnp.split(hy, 3, axis=-1)
    zz = x1 * v
    y_a = x0 * (long_conv(zz, hyena_filter(L, lp)) + zz * lp['hy_bias'])
    q = (rmsnorm(cq, lp['q_norm']) @ lp['w_uq']).reshape(Bsz, L, N_HEADS, QK_NOPE + ROPE_DIM)
    q_nope, q_pe = q[..., :QK_NOPE], q[..., QK_NOPE:]
    ckv_n = rmsnorm(ckv, lp['kv_norm'])
    if rope is not None:
        cos, sin = rope
        q_pe = apply_rope(q_pe, cos[:, None, :], sin[:, None, :])
        kpe_r = apply_rope(kpe, cos, sin)
    else:
        kpe_r = kpe
    if ctx_kv is not None:
        keys_c = jnp.concatenate([ckv_n, ctx_kv[0]], axis=1)
        keys_pe = jnp.concatenate([kpe_r, ctx_kv[1]], axis=1)
    else:
        keys_c, keys_pe = ckv_n, kpe_r
    w_ukv = lp['w_ukv'].reshape(KV_LORA, N_HEADS, QK_NOPE + V_DIM)
    q_lat = jnp.einsum('blhn,chn->blhc', q_nope, w_ukv[..., :QK_NOPE])
    o_lat = mla_attend(q_lat, q_pe, keys_c, keys_pe)
    y_b = jnp.einsum('blhc,chv->blhv', o_lat, w_ukv[..., QK_NOPE:]).reshape(Bsz, L, D_B)
    b_g, c_g, u = jnp.split(sc_in, 3, axis=-1)
    y_c = b_g * dwconv3(c_g * u, lp['sc_conv_w'])
    g_a, g_b, g_c = jnp.split(gates, 3, axis=-1)
    m = (jax.nn.sigmoid(g_a) * (y_a @ lp['w_br_a'])
         + jax.nn.sigmoid(g_b) * (y_b @ lp['w_br_b'])
         + jax.nn.sigmoid(g_c) * (y_c @ lp['w_br_c']))
    return m @ lp['w_o'], (ckv_n, kpe)


def conv_ffn(h, lp):
    uu = dwconv3(h @ lp['ffn_up'], lp['ffn_conv_w']) + lp['ffn_conv_b']
    g, v = jnp.split(uu, 2, axis=-1)
    return (jax.nn.silu(g) * v) @ lp['ffn_down']


def trunk_layer(x, cvec, lp, rope, ctx_kv):
    mod = jax.nn.silu(cvec) @ lp['ada_w'] + lp['ada_b']
    sh1, sc1, g1, sh2, sc2, g2 = jnp.split(mod[:, None, :], 6, axis=-1)
    h = rmsnorm(x, lp['norm_mix_pre']) * (1.0 + sc1) + sh1
    o, kv = token_mix(h, lp, rope, ctx_kv)
    x = x + g1 * rmsnorm(o, lp['norm_mix_post'])
    h = rmsnorm(x, lp['norm_ffn_pre']) * (1.0 + sc2) + sh2
    x = x + g2 * rmsnorm(conv_ffn(h, lp), lp['norm_ffn_post'])
    return x, kv


def setup_inputs(seed: int = 0) -> dict:
    key = jax.random.key(seed)
    ks = iter(jax.random.split(key, 64))

    def nrm(shape, scale):
        return jax.random.normal(next(ks), shape, jnp.float32) * scale

    def gain(shape):
        return 1.0 + nrm(shape, 0.05)

    return {
        'x_prompt': nrm((BATCH, SEQ, D_MODEL), 1.0),
        'x_sample': nrm((DEC_BATCH, DEC_SEQ, D_MODEL), 1.0),
        'c': nrm((DEC_BATCH, D_MODEL), 1.0),
        'cache_ckv': nrm((DEC_BATCH, DEPTH, PAST_LEN, KV_LORA), 1.0),
        'cache_kpe': nrm((DEC_BATCH, DEPTH, PAST_LEN, ROPE_DIM), 1.0),
        'c_ctx': nrm((D_MODEL,), 1.0),
        'ada_w': nrm((DEPTH, D_MODEL, 6 * D_MODEL), 0.5 * D_MODEL ** -0.5),
        'ada_b': nrm((DEPTH, 6 * D_MODEL), 0.01),
        'norm_mix_pre': gain((DEPTH, D_MODEL)),
        'norm_mix_post': gain((DEPTH, D_MODEL)),
        'norm_ffn_pre': gain((DEPTH, D_MODEL)),
        'norm_ffn_post': gain((DEPTH, D_MODEL)),
        'w_in': nrm((DEPTH, D_MODEL, N_IN), D_MODEL ** -0.5),
        'hy_conv_w': nrm((DEPTH, 3, 3 * D_A), 3 ** -0.5),
        'hy_conv_b': nrm((DEPTH, 3 * D_A), 0.01),
        'hy_f_w1': nrm((DEPTH, EMB_DIM, FILTER_FF), EMB_DIM ** -0.5),
        'hy_f_b1': nrm((DEPTH, FILTER_FF), 0.01),
        'hy_f_w2': nrm((DEPTH, FILTER_FF, FILTER_FF), FILTER_FF ** -0.5),
        'hy_f_b2': nrm((DEPTH, FILTER_FF), 0.01),
        'hy_f_w3': nrm((DEPTH, FILTER_FF, 2 * D_A), FILTER_FF ** -0.5),
        'hy_f_b3': nrm((DEPTH, 2 * D_A), 0.01),
        'hy_f_freq': gain((DEPTH, 2, FILTER_FF)),
        'hy_bias': nrm((DEPTH, D_A), 0.1),
        'q_norm': gain((DEPTH, Q_LORA)),
        'kv_norm': gain((DEPTH, KV_LORA)),
        'w_uq': nrm((DEPTH, Q_LORA, N_HEADS * (QK_NOPE + ROPE_DIM)), Q_LORA ** -0.5),
        'w_ukv': nrm((DEPTH, KV_LORA, N_HEADS * (QK_NOPE + V_DIM)), KV_LORA ** -0.5),
        'sc_conv_w': nrm((DEPTH, 3, D_C), 3 ** -0.5),
        'w_br_a': nrm((DEPTH, D_A, D_MODEL), D_A ** -0.5),
        'w_br_b': nrm((DEPTH, D_B, D_MODEL), D_B ** -0.5),
        'w_br_c': nrm((DEPTH, D_C, D_MODEL), D_C ** -0.5),
        'w_o': nrm((DEPTH, D_MODEL, D_MODEL), D_MODEL ** -0.5),
        'ffn_up': nrm((DEPTH, D_MODEL, 2 * D_FF), D_MODEL ** -0.5),
        'ffn_conv_w': nrm((DEPTH, 3, 2 * D_FF), 3 ** -0.5),
        'ffn_conv_b': nrm((DEPTH, 2 * D_FF), 0.01),
        'ffn_down': nrm((DEPTH, D_FF, D_MODEL), D_FF ** -0.5),
    }


def reference(x_prompt, x_sample, c, cache_ckv, cache_kpe, c_ctx, ada_w, ada_b,
              norm_mix_pre, norm_mix_post, norm_ffn_pre, norm_ffn_post, w_in,
              hy_conv_w, hy_conv_b, hy_f_w1, hy_f_b1, hy_f_w2, hy_f_b2, hy_f_w3, hy_f_b3,
              hy_f_freq, hy_bias, q_norm, kv_norm, w_uq, w_ukv, sc_conv_w,
              w_br_a, w_br_b, w_br_c, w_o, ffn_up, ffn_conv_w, ffn_conv_b, ffn_down):
    rope = axial_rope(x_sample.shape[1])
    xp, xs = x_prompt, x_sample
    ckv_list, kpe_list = [], []
    for l in range(DEPTH):
        lp = dict(ada_w=ada_w[l], ada_b=ada_b[l],
                  norm_mix_pre=norm_mix_pre[l], norm_mix_post=norm_mix_post[l],
                  norm_ffn_pre=norm_ffn_pre[l], norm_ffn_post=norm_ffn_post[l],
                  w_in=w_in[l], hy_conv_w=hy_conv_w[l], hy_conv_b=hy_conv_b[l],
                  hy_f_w1=hy_f_w1[l], hy_f_b1=hy_f_b1[l], hy_f_w2=hy_f_w2[l], hy_f_b2=hy_f_b2[l],
                  hy_f_w3=hy_f_w3[l], hy_f_b3=hy_f_b3[l], hy_f_freq=hy_f_freq[l], hy_bias=hy_bias[l],
                  q_norm=q_norm[l], kv_norm=kv_norm[l], w_uq=w_uq[l], w_ukv=w_ukv[l],
                  sc_conv_w=sc_conv_w[l], w_br_a=w_br_a[l], w_br_b=w_br_b[l], w_br_c=w_br_c[l],
                  w_o=w_o[l], ffn_up=ffn_up[l], ffn_conv_w=ffn_conv_w[l], ffn_conv_b=ffn_conv_b[l],
                  ffn_down=ffn_down[l])
        xp, (ckv_l, kpe_l) = trunk_layer(xp, c_ctx[None, :], lp, None, None)
        ckv_list.append(ckv_l)
        kpe_list.append(kpe_l)
        xs, _ = trunk_layer(xs, c, lp, rope, (cache_ckv[:, l], cache_kpe[:, l]))
    new_ckv = jnp.stack(ckv_list, axis=1)
    new_kpe = jnp.stack(kpe_list, axis=1)
    return (xp, xs, new_ckv, new_kpe)
```

```cpp
#include <hip/hip_runtime.h>
#include <hip/hip_cooperative_groups.h>
#include <cstdio>
namespace cg = cooperative_groups;

#define LAS __attribute__((address_space(3)))
typedef unsigned short bf16_t;
typedef short bf16x8 __attribute__((ext_vector_type(8)));
typedef float f32x4 __attribute__((ext_vector_type(4)));
typedef float f32x16 __attribute__((ext_vector_type(16)));
typedef unsigned u32x4 __attribute__((ext_vector_type(4)));
typedef unsigned u32x2 __attribute__((ext_vector_type(2)));

constexpr int DM = 2048, MP = 4096, MS = 16384, MT = 20480, NLAYER = 2;
constexpr int LP = 256, LS = 2048, BP = 16, BS = 8, PAST = 512, LKS = 2560;
constexpr int NIN = 13120, NGATE0 = 6976, PA_LD = 7168, GATE_LD = 6144;
constexpr int DFF = 5632, UU_LD = 11264;
constexpr int KROWS = 24576;
constexpr int NTHREADS = 512;
constexpr int LDS_BYTES = 131072;

enum { I_XP = 0, I_XS, I_C, I_CCKV, I_CKPE, I_CCTX, I_ADAW, I_ADAB, I_NMPRE, I_NMPOST, I_NFPRE, I_NFPOST, I_WIN, I_HCW, I_HCB,
       I_FW1, I_FB1, I_FW2, I_FB2, I_FW3, I_FB3, I_FFREQ, I_HBIAS, I_QN, I_KVN, I_WUQ, I_WUKV, I_SCW, I_WBRA, I_WBRB, I_WBRC,
       I_WO, I_FUP, I_FCW, I_FCB, I_FDN, N_INPUTS };

constexpr size_t E_WIN = (size_t)13312 * 2048, E_WUQ = (size_t)1536 * 512, E_WUKV = (size_t)2048 * 256, E_WBR = (size_t)2048 * 1024,
                 E_WO = (size_t)2048 * 2048, E_WUP = (size_t)11264 * 2048, E_WDN = (size_t)2048 * 5632;
constexpr size_t W_IN = 0, W_UQ = W_IN + E_WIN * 2, W_UKV = W_UQ + E_WUQ * 2, W_BRA = W_UKV + E_WUKV * 2, W_BRB = W_BRA + E_WBR * 2,
                 W_BRC = W_BRB + E_WBR * 2, W_O = W_BRC + E_WBR * 2, W_UP = W_O + E_WO * 2, W_DN = W_UP + E_WUP * 2, W_END = W_DN + E_WDN * 2;
constexpr size_t S_MOD = W_END, SZ_MOD = (size_t)NLAYER * 9 * 12288 * 4;
constexpr size_t S_KTS = S_MOD + SZ_MOD, S_KTP = S_KTS + (size_t)1024 * 4096 * 4, S_PARTS = S_KTP + (size_t)1024 * 512 * 4,
                 S_PARTP = S_PARTS + (size_t)64 * 2048 * 4, S_ROPE = S_PARTP + (size_t)8 * 2048 * 4, S_END = S_ROPE + (size_t)2 * 2048 * 32 * 4;
constexpr size_t AR = S_END;
constexpr size_t SZ_H = (size_t)MT * 2048 * 2;
constexpr size_t A_H = AR, A_UU = AR + SZ_H, A_ACT = A_UU + (size_t)MT * UU_LD * 2, AR_END = A_ACT + (size_t)MT * DFF * 2;
constexpr size_t A_PROJA = A_UU;
constexpr size_t A_Q = A_UU, A_KN = A_Q + (size_t)MT * 1536 * 2, A_VT = A_KN + (size_t)KROWS * 1024 * 2, A_YCT = A_VT + (size_t)KROWS * 1024 * 2;
constexpr size_t A_GATES = A_UU, A_M32 = A_GATES + (size_t)MT * GATE_LD * 2, A_MBF = A_H, A_F32 = A_UU;
constexpr size_t A_S = A_M32 + (size_t)MT * 2048 * 4;
constexpr size_t A_ZZT = A_S, A_X0S = A_ZZT + (size_t)MT * 1024 * 2, A_CQN = A_X0S + (size_t)MT * 1024 * 2, A_KEYSC = A_CQN + (size_t)MT * 512 * 2,
                 A_KPER = A_KEYSC + (size_t)KROWS * 256 * 2, A_YC = A_KPER + (size_t)KROWS * 64 * 2, A_YA = A_YC + (size_t)MT * 1024 * 2,
                 A_OATT = A_YA + (size_t)MT * 1024 * 2, A_SEND = A_OATT + (size_t)MT * 1024 * 2;
static_assert(A_SEND <= AR_END, "arena overflow");
static_assert(A_YCT + (size_t)MT * 1024 * 2 <= A_M32, "arena overlap");
constexpr size_t WS_NEED = AR_END;
static_assert(WS_NEED <= 967590400ull, "workspace too large");

struct Params {
    const float* in[N_INPUTS];
    float* out;
    unsigned char* ws;
};

__device__ __forceinline__ unsigned cvt_pk_bf16(float lo, float hi) { unsigned r; asm volatile("v_cvt_pk_bf16_f32 %0, %1, %2" : "=v"(r) : "v"(lo), "v"(hi)); return r; }
__device__ __forceinline__ bf16_t f2bf(float f) { return (bf16_t)(cvt_pk_bf16(f, 0.f) & 0xffffu); }
__device__ __forceinline__ float bf_lo(unsigned w) { return __uint_as_float(w << 16); }
__device__ __forceinline__ float bf_hi(unsigned w) { return __uint_as_float(w & 0xffff0000u); }
__device__ __forceinline__ void unpack8(const u32x4 v, float* f) { f[0] = bf_lo(v.x); f[1] = bf_hi(v.x); f[2] = bf_lo(v.y); f[3] = bf_hi(v.y); f[4] = bf_lo(v.z); f[5] = bf_hi(v.z); f[6] = bf_lo(v.w); f[7] = bf_hi(v.w); }
__device__ __forceinline__ u32x4 pack8(const float* f) { u32x4 r; r.x = cvt_pk_bf16(f[0], f[1]); r.y = cvt_pk_bf16(f[2], f[3]); r.z = cvt_pk_bf16(f[4], f[5]); r.w = cvt_pk_bf16(f[6], f[7]); return r; }
__device__ __forceinline__ float shx(float v, int mask, int lane) { return __int_as_float(__builtin_amdgcn_ds_bpermute((lane ^ mask) << 2, __float_as_int(v))); }
__device__ __forceinline__ float wave_sum(float v, int lane) {
#pragma unroll
    for (int o = 32; o >= 1; o >>= 1) v += shx(v, o, lane);
    return v;
}
__device__ __forceinline__ int otid(int wv) { int t; asm volatile("v_mbcnt_lo_u32_b32 %0, -1, 0\n\tv_mbcnt_hi_u32_b32 %0, -1, %0" : "=v"(t)); return wv * 64 + t; }
__device__ __forceinline__ int obid() { int t = blockIdx.x; asm volatile("" : "+s"(t)); return t; }
__device__ __forceinline__ float sigmoidf_(float x) { return 1.0f / (1.0f + __expf(-x)); }
__device__ __forceinline__ float siluf_(float x) { return x / (1.0f + __expf(-x)); }

namespace pg8 {
constexpr int BM = 256, BK = 64, HALF = 128, HTB = HALF * BK * 2, STAGE_BYTES = 8 * HTB, NXCD = 8, WGM = 8;
__host__ __device__ __forceinline__ int lds_byte(int r, int c) { const int st = (r >> 4) * 2 + (c >> 5), rr = r & 15, cc = c & 31, ob = rr * 64 + cc * 2; return st * 1024 + (ob ^ (((ob >> 9) & 1) << 5)); }
__host__ __device__ __forceinline__ void stage_rc(int b, int& R, int& C) { const int st = b / 1024, sb = b % 1024, swz = sb ^ (((sb >> 9) & 1) << 5); R = (st >> 1) * 16 + swz / 64; C = (st & 1) * 32 + (swz % 64) / 2; }
struct Unit { int pm, pn; };
struct Gemm { const bf16_t* A; const bf16_t* Bt; int M, N, K; };
struct StaticOrder {
    int nM, nN, nwg, G, c;
    __device__ void init(int M, int N, int G_, int c_) { nM = M / BM; nN = N / BM; nwg = nM * nN; G = G_; c = c_; }
    __device__ bool next(int i, Unit& u) const {
        const long L = (long)i * G + c; if (L >= nwg) return false;
        int wgid = (int)L; { const int q = nwg / NXCD, r = nwg % NXCD, xcd = wgid % NXCD, off = wgid / NXCD; wgid = (xcd < r ? xcd * (q + 1) : r * (q + 1) + (xcd - r) * q) + off; }
        const int nig = WGM * nN, gid = wgid / nig, fm = gid * WGM, gsz = (nM - fm) < WGM ? (nM - fm) : WGM;
        u.pm = fm + ((wgid % nig) % gsz); u.pn = (wgid % nig) / gsz; return true;
    }
};
template <class Epi>
__device__ __forceinline__ void gemm_phase(int wv, LAS unsigned char* lds, const Gemm g, const StaticOrder& S, const Epi& E) {
    const int tid = otid(wv), wid = __builtin_amdgcn_readfirstlane(tid >> 6), lane = tid & 63, wr = wid >> 2, wc = wid & 3, fr = lane & 15, fq = lane >> 4;
    const int K = g.K, nt = K / BK;
    unsigned voffA[2];
#pragma unroll
    for (int i = 0; i < 2; ++i) { int R, C; stage_rc(tid * 16 + i * 8192, R, C); voffA[i] = (unsigned)(R * K + C) * 2u; }
    const size_t kstep = (size_t)(BK * 2);
    const size_t hstep = (size_t)HALF * K * 2;
    const size_t tstep = 2 * hstep;
    const unsigned ldsw = (unsigned)wid * 1024u;
    const int aoff = lds_byte(wr * 64 + fr, fq * 8), boff = lds_byte(wc * 32 + fr, fq * 8);
#define PG8_SA(b, h) (((b) * 2 + (h)) * HTB)
#define PG8_SB(b, h) ((4 + (b) * 2 + (h)) * HTB)
#define PG8_STAGE(bufoff, gbase, voff) do { _Pragma("unroll") for (int _i = 0; _i < 2; ++_i) \
        __builtin_amdgcn_global_load_lds((const unsigned*)((const char*)(gbase) + (voff)[_i]), (LAS unsigned*)(lds + (bufoff) + ldsw + _i * 8192), 16, 0, 0); } while (0)
#define PG8_LDA(dst, b, h) do { _Pragma("unroll") for (int m = 0; m < 4; ++m) _Pragma("unroll") for (int k = 0; k < 2; ++k) dst[m][k] = *(const LAS bf16x8*)(lds + PG8_SA(b, h) + aoff + m * 2048 + k * 1024); } while (0)
#define PG8_LDB(dst, b, h) do { _Pragma("unroll") for (int n = 0; n < 2; ++n) _Pragma("unroll") for (int k = 0; k < 2; ++k) dst[n][k] = *(const LAS bf16x8*)(lds + PG8_SB(b, h) + boff + n * 2048 + k * 1024); } while (0)
#define PG8_MMA(ai, bj, At, Bt) do { __builtin_amdgcn_s_setprio(1); _Pragma("unroll") for (int m = 0; m < 4; ++m) _Pragma("unroll") for (int n = 0; n < 2; ++n) _Pragma("unroll") for (int k = 0; k < 2; ++k) \
        acc[ai][bj][m][n] = __builtin_amdgcn_mfma_f32_16x16x32_bf16(Bt[n][k], At[m][k], acc[ai][bj][m][n], 0, 0, 0); __builtin_amdgcn_s_setprio(0); } while (0)
#define PG8_WAIT_V(n) asm volatile("s_waitcnt vmcnt(" #n ")" ::: "memory")
#define PG8_WAIT_L(n) asm volatile("s_waitcnt lgkmcnt(" #n ")" ::: "memory")
#define PG8_BAR __builtin_amdgcn_s_barrier()
#define PG8_SCHED __builtin_amdgcn_sched_barrier(0)
    Unit cur, nxt; int ui = 0;
    if (!S.next(0, cur)) return;
    f32x4 acc[2][2][4][2];
#pragma unroll
    for (int a = 0; a < 2; ++a)
#pragma unroll
        for (int b = 0; b < 2; ++b)
#pragma unroll
            for (int m = 0; m < 4; ++m)
#pragma unroll
                for (int n = 0; n < 2; ++n) acc[a][b][m][n] = (f32x4){0.f, 0.f, 0.f, 0.f};
    bf16x8 At[4][2], B0[2][2], B1[2][2];
    const char* cA = (const char*)g.A + (size_t)cur.pm * tstep; const char* cB = (const char*)g.Bt + (size_t)cur.pn * tstep;
    PG8_STAGE(PG8_SB(0, 0), cB, voffA); PG8_STAGE(PG8_SA(0, 0), cA, voffA); PG8_STAGE(PG8_SB(0, 1), cB + hstep, voffA); PG8_STAGE(PG8_SA(0, 1), cA + hstep, voffA);
    if (wr == 1) PG8_BAR;
    PG8_WAIT_V(4); PG8_BAR;
    PG8_STAGE(PG8_SB(1, 0), cB + kstep, voffA); PG8_STAGE(PG8_SA(1, 0), cA + kstep, voffA); PG8_STAGE(PG8_SB(1, 1), cB + hstep + kstep, voffA);
    PG8_WAIT_V(6); PG8_BAR;
    for (;;) {
        const bool has_next = S.next(ui + 1, nxt);
        const char* nA = has_next ? (const char*)g.A + (size_t)nxt.pm * tstep : cA; const char* nB = has_next ? (const char*)g.Bt + (size_t)nxt.pn * tstep : cB;
        for (int t = 0; t < nt; t += 2) {
            const bool last = (t == nt - 2);
            const char* a1 = cA + (size_t)(t + 1) * kstep;
            const char* a2 = last ? nA : cA + (size_t)(t + 2) * kstep; const char* b2 = last ? nB : cB + (size_t)(t + 2) * kstep;
            const char* a3 = a2 + kstep; const char* b3 = b2 + kstep;
            PG8_LDB(B0, 0, 0); PG8_SCHED; PG8_LDA(At, 0, 0); PG8_STAGE(PG8_SA(1, 1), a1 + hstep, voffA);
            PG8_WAIT_L(8); PG8_BAR; PG8_WAIT_L(0); PG8_MMA(0, 0, At, B0); PG8_BAR; PG8_SCHED;
            PG8_LDB(B1, 0, 1); PG8_STAGE(PG8_SB(0, 0), b2, voffA);
            PG8_BAR; PG8_WAIT_L(0); PG8_MMA(0, 1, At, B1); PG8_BAR;
            PG8_LDA(At, 0, 1); PG8_STAGE(PG8_SA(0, 0), a2, voffA);
            PG8_BAR; PG8_WAIT_L(0); PG8_MMA(1, 0, At, B0); PG8_BAR; PG8_SCHED;
            PG8_STAGE(PG8_SB(0, 1), b2 + hstep, voffA);
            PG8_WAIT_V(6); PG8_BAR; PG8_MMA(1, 1, At, B1); PG8_BAR;
            PG8_LDB(B0, 1, 0); PG8_SCHED; PG8_LDA(At, 1, 0); PG8_STAGE(PG8_SA(0, 1), a2 + hstep, voffA);
            PG8_WAIT_L(8); PG8_BAR; PG8_WAIT_L(0); PG8_MMA(0, 0, At, B0); PG8_BAR; PG8_SCHED;
            PG8_LDB(B1, 1, 1); PG8_STAGE(PG8_SB(1, 0), b3, voffA);
            PG8_BAR; PG8_WAIT_L(0); PG8_MMA(0, 1, At, B1); PG8_BAR;
            PG8_LDA(At, 1, 1); PG8_STAGE(PG8_SA(1, 0), a3, voffA);
            PG8_BAR; PG8_WAIT_L(0); PG8_MMA(1, 0, At, B0); PG8_BAR; PG8_SCHED;
            PG8_STAGE(PG8_SB(1, 1), b3 + hstep, voffA);
            PG8_WAIT_V(6); PG8_BAR; PG8_MMA(1, 1, At, B1); PG8_BAR;
        }
        E(acc, cur, wr, wc, fr, fq);
        if (!has_next) break;
#pragma unroll
        for (int a = 0; a < 2; ++a)
#pragma unroll
            for (int b = 0; b < 2; ++b)
#pragma unroll
                for (int m = 0; m < 4; ++m)
#pragma unroll
                    for (int n = 0; n < 2; ++n) acc[a][b][m][n] = (f32x4){0.f, 0.f, 0.f, 0.f};
        cur = nxt; cA = nA; cB = nB; ++ui;
    }
    PG8_WAIT_V(0);
    if (wr == 0) PG8_BAR;
    PG8_BAR;
#undef PG8_SA
#undef PG8_SB
#undef PG8_STAGE
#undef PG8_LDA
#undef PG8_LDB
#undef PG8_MMA
#undef PG8_WAIT_V
#undef PG8_WAIT_L
#undef PG8_BAR
#undef PG8_SCHED
}

struct EpiBf16 {
    bf16_t* O; int ldc;
    __device__ __forceinline__ void operator()(const f32x4 (&acc)[2][2][4][2], const Unit& u, int wr, int wc, int fr, int fq) const {
        const int row0 = u.pm * BM + wr * 64 + fr, col0 = u.pn * BM + wc * 32 + 4 * fq;
#pragma unroll
        for (int ai = 0; ai < 2; ++ai)
#pragma unroll
            for (int m = 0; m < 4; ++m) { bf16_t* rowp = O + (size_t)(row0 + ai * HALF + m * 16) * ldc + col0;
#pragma unroll
                for (int bj = 0; bj < 2; ++bj)
#pragma unroll
                    for (int n = 0; n < 2; ++n) { const f32x4 v = acc[ai][bj][m][n]; u32x2 w; w.x = cvt_pk_bf16(v[0], v[1]); w.y = cvt_pk_bf16(v[2], v[3]); *(u32x2*)(rowp + bj * HALF + n * 16) = w; } }
    }
};
struct EpiF32 {
    float* C; int ldc;
    __device__ __forceinline__ void operator()(const f32x4 (&acc)[2][2][4][2], const Unit& u, int wr, int wc, int fr, int fq) const {
        const int row0 = u.pm * BM + wr * 64 + fr, col0 = u.pn * BM + wc * 32 + 4 * fq;
#pragma unroll
        for (int ai = 0; ai < 2; ++ai)
#pragma unroll
            for (int m = 0; m < 4; ++m) { float* rowp = C + (size_t)(row0 + ai * HALF + m * 16) * ldc + col0;
#pragma unroll
                for (int bj = 0; bj < 2; ++bj)
#pragma unroll
                    for (int n = 0; n < 2; ++n) *(f32x4*)(rowp + bj * HALF + n * 16) = acc[ai][bj][m][n]; }
    }
};
struct EpiVT {
    bf16_t* VTs; bf16_t* VTp;
    __device__ __forceinline__ void operator()(const f32x4 (&acc)[2][2][4][2], const Unit& u, int wr, int wc, int fr, int fq) const {
        const int KR0 = u.pn * BM;
        bf16_t* vt; int Lk;
        if (KR0 < BS * LKS) { const int b = KR0 / LKS; Lk = LKS; vt = VTs + (size_t)b * 1024 * LKS + (KR0 - b * LKS); }
        else { const int b = (KR0 - BS * LKS) >> 8; Lk = LP; vt = VTp + (size_t)b * 1024 * LP; }
        const int row0 = u.pm * BM + wr * 64 + fr, col0 = wc * 32 + 4 * fq;
#pragma unroll
        for (int ai = 0; ai < 2; ++ai)
#pragma unroll
            for (int m = 0; m < 4; ++m) { bf16_t* rowp = vt + (size_t)(row0 + ai * HALF + m * 16) * Lk + col0;
#pragma unroll
                for (int bj = 0; bj < 2; ++bj)
#pragma unroll
                    for (int n = 0; n < 2; ++n) { const f32x4 v = acc[ai][bj][m][n]; u32x2 w; w.x = cvt_pk_bf16(v[0], v[1]); w.y = cvt_pk_bf16(v[2], v[3]); *(u32x2*)(rowp + bj * HALF + n * 16) = w; } }
    }
};
template <int P> struct EpiGate {
    const bf16_t* gates; float* m32; bf16_t* mbf;
    __device__ __forceinline__ void operator()(const f32x4 (&acc)[2][2][4][2], const Unit& u, int wr, int wc, int fr, int fq) const {
        const int row0 = u.pm * BM + wr * 64 + fr, col0 = u.pn * BM + wc * 32 + 4 * fq;
#pragma unroll
        for (int ai = 0; ai < 2; ++ai)
#pragma unroll
            for (int m = 0; m < 4; ++m) {
                const size_t row = (size_t)(row0 + ai * HALF + m * 16);
#pragma unroll
                for (int bj = 0; bj < 2; ++bj)
#pragma unroll
                    for (int n = 0; n < 2; ++n) {
                        const int col = col0 + bj * HALF + n * 16;
                        const u32x2 gw = *(const u32x2*)(gates + row * GATE_LD + P * 2048 + col);
                        f32x4 v = acc[ai][bj][m][n];
                        v[0] *= sigmoidf_(bf_lo(gw.x)); v[1] *= sigmoidf_(bf_hi(gw.x)); v[2] *= sigmoidf_(bf_lo(gw.y)); v[3] *= sigmoidf_(bf_hi(gw.y));
                        float* mp = m32 + row * 2048 + col;
                        if (P == 0) { *(f32x4*)mp = v; }
                        else if (P == 1) { const f32x4 o = *(const f32x4*)mp; *(f32x4*)mp = o + v; }
                        else { const f32x4 o = *(const f32x4*)mp; v = v + o; u32x2 w; w.x = cvt_pk_bf16(v[0], v[1]); w.y = cvt_pk_bf16(v[2], v[3]); *(u32x2*)(mbf + row * 2048 + col) = w; }
                    }
            }
    }
};
}

template <class Epi>
__device__ __forceinline__ void run_gemm(int wv, LAS unsigned char* lds, const bf16_t* A, const bf16_t* Bt, int M, int N, int K, const Epi& E) {
    pg8::Gemm g; g.A = A; g.Bt = Bt; g.M = M; g.N = N; g.K = K;
    pg8::StaticOrder S; S.init(M, N, (int)gridDim.x, obid());
    pg8::gemm_phase<Epi>(wv, lds, g, S, E);
    __syncthreads();
}

__device__ __forceinline__ void convT(int wv, const float* __restrict__ src, int K, int N, bf16_t* __restrict__ dst, int gate_shift, LAS unsigned char* lds) {
    const int tn = N / 64, tk = K / 64, ntile = tn * tk, tid = otid(wv);
    LAS bf16_t* T = (LAS bf16_t*)lds;
    for (int tile = obid(); tile < ntile; tile += gridDim.x) {
        const int tkk = tile / tn, tnn = tile - tkk * tn, k0 = tkk * 64, n0 = tnn * 64;
        const int kk = tid >> 4, n4 = (tid & 15) * 4;
#pragma unroll
        for (int half = 0; half < 2; ++half) {
            const int k = kk + half * 32;
            const f32x4 v = *(const f32x4*)(src + (size_t)(k0 + k) * N + n0 + n4);
#pragma unroll
            for (int i = 0; i < 4; ++i) T[(n4 + i) * 72 + k] = f2bf(v[i]);
        }
        __syncthreads();
        const int n = tid >> 3, kc = (tid & 7) * 8;
        int nd = n0 + n; if (gate_shift == 1 && nd >= NGATE0) nd += 192; if (gate_shift == 2) { const int hd = nd >> 8, wi = nd & 255; nd = (wi < 128) ? hd * 128 + wi : 1024 + hd * 128 + (wi - 128); }
        *(u32x4*)(dst + (size_t)nd * K + k0 + kc) = *(const LAS u32x4*)(T + n * 72 + kc);
        __syncthreads();
    }
}

__device__ __forceinline__ void ada_phase(int wv, const Params& p, LAS unsigned char* lds) {
    LAS float* sl = (LAS float*)lds;
    float* mod = (float*)(p.ws + S_MOD);
    const int tid = otid(wv);
    for (int u = obid(); u < NLAYER * 6 * 16; u += gridDim.x) {
        const int l = u / 96, r = u % 96, cb = r % 6, kc = r / 6, k0 = kc * 128;
        for (int i = tid; i < 9 * 128; i += NTHREADS) { const int v = i >> 7, k = i & 127; const float x = (v == 0) ? p.in[I_CCTX][k0 + k] : p.in[I_C][(v - 1) * DM + k0 + k]; sl[i] = siluf_(x); }
        __syncthreads();
        const int col = cb * 2048 + tid * 4;
        f32x4 acc[9];
#pragma unroll
        for (int i = 0; i < 9; ++i) acc[i] = (f32x4){0.f, 0.f, 0.f, 0.f};
        const float* wp = p.in[I_ADAW] + ((size_t)l * DM + k0) * 12288 + col;
        for (int k = 0; k < 128; ++k) {
            const f32x4 w = *(const f32x4*)(wp + (size_t)k * 12288);
#pragma unroll
            for (int i = 0; i < 9; ++i) acc[i] += sl[i * 128 + k] * w;
        }
#pragma unroll
        for (int i = 0; i < 9; ++i)
#pragma unroll
            for (int j = 0; j < 4; ++j) atomicAdd(mod + (size_t)(l * 9 + i) * 12288 + col + j, acc[i][j]);
        __syncthreads();
    }
}

__device__ __forceinline__ void filter_phase(int wv, const Params& p, int l, LAS unsigned char* lds) {
    LAS float* z = (LAS float*)lds;
    LAS float* H1 = z + 32 * 33;
    LAS float* H2 = H1 + 32 * 64;
    const int tid = otid(wv);
    const float* w1 = p.in[I_FW1] + (size_t)l * 33 * 64; const float* b1 = p.in[I_FB1] + l * 64;
    const float* w2 = p.in[I_FW2] + (size_t)l * 64 * 64; const float* b2 = p.in[I_FB2] + l * 64;
    const float* w3 = p.in[I_FW3] + (size_t)l * 64 * 2048; const float* b3 = p.in[I_FB3] + l * 2048;
    const float* fq = p.in[I_FFREQ] + l * 128;
    for (int u = obid(); u < 72; u += gridDim.x) {
        const int g = (u < 64) ? 1 : 0; const int tc = g ? u : u - 64; const int L = g ? LS : LP; const int t0 = tc * 32;
        float* kT = (float*)(p.ws + (g ? S_KTS : S_KTP)); float* part = (float*)(p.ws + (g ? S_PARTS : S_PARTP));
        for (int i = tid; i < 32 * 33; i += NTHREADS) {
            const int t = i / 33, e = i - t * 33; const float tf = (float)(t0 + t);
            float v;
            if (e == 0) v = tf / (float)(L - 1);
            else { const int k = (e - 1) & 15; const float band = 1e-4f + (float)k * ((15.0f - 1e-4f) / 15.0f); const float w = (6.283185307179586f * tf) / (float)L; const float ang = w * band;
                   v = (e <= 16) ? cosf(ang) : -sinf(ang); }
            z[i] = v;
        }
        __syncthreads();
        for (int i = tid; i < 32 * 64; i += NTHREADS) {
            const int t = i >> 6, j = i & 63; float s = b1[j];
            for (int e = 0; e < 33; ++e) s += z[t * 33 + e] * w1[e * 64 + j];
            H1[i] = sinf(fq[j] * s);
        }
        __syncthreads();
        for (int i = tid; i < 32 * 64; i += NTHREADS) {
            const int t = i >> 6, j = i & 63; float s = b2[j];
            for (int e = 0; e < 64; ++e) s += H1[t * 64 + e] * w2[e * 64 + j];
            H2[i] = sinf(fq[64 + j] * s);
        }
        __syncthreads();
        const int c = tid * 4;
        const f32x4 bias = *(const f32x4*)(b3 + c);
        f32x4 delta;
#pragma unroll
        for (int j = 0; j < 4; ++j) { const int d = (c + j) & 1023; const float mn = -3.0701134573253945f, mx = -15.350567286626973f; delta[j] = fabsf(mn + (float)d * ((mx - mn) / 1023.0f)); }
        f32x4 psum = (f32x4){0.f, 0.f, 0.f, 0.f};
        for (int tb = 0; tb < 4; ++tb) {
            f32x4 acc[8];
#pragma unroll
            for (int i = 0; i < 8; ++i) acc[i] = bias;
            for (int k = 0; k < 64; ++k) {
                const f32x4 w = *(const f32x4*)(w3 + (size_t)k * 2048 + c);
#pragma unroll
                for (int i = 0; i < 8; ++i) acc[i] += H2[(tb * 8 + i) * 64 + k] * w;
            }
#pragma unroll
            for (int i = 0; i < 8; ++i) {
                const int t = t0 + tb * 8 + i; const float tn = (float)t / (float)(L - 1);
#pragma unroll
                for (int j = 0; j < 4; ++j) {
                    const float v = acc[i][j] * __expf(-tn * delta[j]);
                    const int cc = c + j;
                    if (cc < 1024) { kT[(size_t)cc * (2 * L) + t] = v; psum[j] += fabsf(v); }
                    else { const int d = cc - 1024; if (t == 0) kT[(size_t)d * (2 * L) + L] = 0.f; else { kT[(size_t)d * (2 * L) + 2 * L - t] = v; psum[j] += fabsf(v); } }
                }
            }
        }
        *(f32x4*)(part + (size_t)tc * 2048 + c) = psum;
        __syncthreads();
    }
}

__device__ __forceinline__ void row_phase(int wv, const Params& p, int l, int mode) {
    const int tid = otid(wv); const int wave = obid() * 8 + (tid >> 6), nw = gridDim.x * 8, lane = tid & 63;
    float* X = p.out;
    bf16_t* H = (bf16_t*)(p.ws + A_H);
    const float* mod = (const float*)(p.ws + S_MOD);
    for (int row = wave; row < MT; row += nw) {
        const int mi = row < MP ? 0 : 1 + ((row - MP) >> 11);
        f32x4 x[8];
        const float* xs = (mode == 0) ? (row < MP ? p.in[I_XP] + (size_t)row * DM : p.in[I_XS] + (size_t)(row - MP) * DM) : X + (size_t)row * DM;
#pragma unroll
        for (int i = 0; i < 8; ++i) x[i] = *(const f32x4*)(xs + i * 256 + lane * 4);
        if (mode != 0) {
            const float* o = (const float*)(p.ws + (mode == 1 ? A_M32 : A_F32)) + (size_t)row * DM;
            f32x4 ov[8]; float ss = 0.f;
#pragma unroll
            for (int i = 0; i < 8; ++i) { ov[i] = *(const f32x4*)(o + i * 256 + lane * 4); ss += ov[i][0] * ov[i][0] + ov[i][1] * ov[i][1] + ov[i][2] * ov[i][2] + ov[i][3] * ov[i][3]; }
            ss = wave_sum(ss, lane);
            const float rstd = rsqrtf(ss * (1.0f / DM) + 1e-6f);
            const int gi = (mode == 1) ? 2 : 5;
            const float* gm = mod + (size_t)(l * 9 + mi) * 12288 + gi * 2048; const float* gb = p.in[I_ADAB] + (size_t)l * 12288 + gi * 2048;
            const float* pw = p.in[mode == 1 ? I_NMPOST : I_NFPOST] + l * DM;
#pragma unroll
            for (int i = 0; i < 8; ++i) {
                const int c = i * 256 + lane * 4;
                const f32x4 g = *(const f32x4*)(gm + c) + *(const f32x4*)(gb + c); const f32x4 w = *(const f32x4*)(pw + c);
                x[i] += g * (ov[i] * rstd * w);
            }
        }
        if (mode != 1 || true) {
#pragma unroll
            for (int i = 0; i < 8; ++i) *(f32x4*)(X + (size_t)row * DM + i * 256 + lane * 4) = x[i];
        }
        int l2, shi, sci; const float* prew; bool wh = true;
        if (mode == 0) { l2 = l; shi = 0; sci = 1; prew = p.in[I_NMPRE] + l * DM; }
        else if (mode == 1) { l2 = l; shi = 3; sci = 4; prew = p.in[I_NFPRE] + l * DM; }
        else { l2 = l + 1; shi = 0; sci = 1; wh = (l + 1 < NLAYER); prew = p.in[I_NMPRE] + (wh ? l2 : l) * DM; }
        if (wh) {
            float ss = 0.f;
#pragma unroll
            for (int i = 0; i < 8; ++i) ss += x[i][0] * x[i][0] + x[i][1] * x[i][1] + x[i][2] * x[i][2] + x[i][3] * x[i][3];
            ss = wave_sum(ss, lane);
            const float rstd = rsqrtf(ss * (1.0f / DM) + 1e-6f);
            const float* mb = mod + (size_t)(l2 * 9 + mi) * 12288; const float* ab = p.in[I_ADAB] + (size_t)l2 * 12288;
#pragma unroll
            for (int i = 0; i < 8; ++i) {
                const int c = i * 256 + lane * 4;
                const f32x4 sh = *(const f32x4*)(mb + shi * 2048 + c) + *(const f32x4*)(ab + shi * 2048 + c);
                const f32x4 sc = *(const f32x4*)(mb + sci * 2048 + c) + *(const f32x4*)(ab + sci * 2048 + c);
                const f32x4 w = *(const f32x4*)(prew + c);
                const f32x4 hv = (x[i] * rstd * w) * (1.0f + sc) + sh;
                u32x2 o; o.x = cvt_pk_bf16(hv[0], hv[1]); o.y = cvt_pk_bf16(hv[2], hv[3]);
                *(u32x2*)(H + (size_t)row * DM + c) = o;
            }
        }
    }
}

__device__ __forceinline__ void rope_table_phase(int wv, const Params& p) {
    float* C = (float*)(p.ws + S_ROPE); float* Sn = C + 2048 * 32;
    const int tid = otid(wv);
    for (int idx = obid() * NTHREADS + tid; idx < 2048 * 32; idx += gridDim.x * NTHREADS) {
        const int t = idx >> 5, i = idx & 31, k = i & 15;
        const float inv = exp2f(-(float)k * 0.8304820237218406f);
        const float pos = (i < 16) ? (float)(t >> 6) : (float)(t & 63);
        const float ang = pos * inv; C[idx] = cosf(ang); Sn[idx] = sinf(ang);
    }
}
__device__ __forceinline__ void e2_phase(int wv, const Params& p, int l, LAS unsigned char* lds) {
    const bf16_t* PA = (const bf16_t*)(p.ws + A_PROJA);
    const int tid = otid(wv), lane = tid & 63;
    {
        bf16_t* CQN = (bf16_t*)(p.ws + A_CQN); bf16_t* KC = (bf16_t*)(p.ws + A_KEYSC); bf16_t* KP = (bf16_t*)(p.ws + A_KPER);
        float* out_ckv = p.out + (size_t)MT * DM; float* out_kpe = out_ckv + (size_t)BP * NLAYER * LP * 256;
        const int wave = obid() * 8 + (tid >> 6), nw = gridDim.x * 8;
        for (int row = wave; row < MT + BS * PAST; row += nw) {
            if (row < MT) {
                const bf16_t* pr = PA + (size_t)row * PA_LD;
                { const u32x4 v = *(const u32x4*)(pr + 3072 + lane * 8); float f[8]; unpack8(v, f); float ss = 0.f;
#pragma unroll
                  for (int j = 0; j < 8; ++j) ss += f[j] * f[j];
                  ss = wave_sum(ss, lane); const float rstd = rsqrtf(ss * (1.0f / 512.0f) + 1e-6f);
                  const float* qn = p.in[I_QN] + l * 512 + lane * 8;
#pragma unroll
                  for (int j = 0; j < 8; ++j) f[j] = f[j] * rstd * qn[j];
                  *(u32x4*)(CQN + (size_t)row * 512 + lane * 8) = pack8(f); }
                int KR, t; const bool isp = row < MP; int b;
                if (isp) { b = row >> 8; t = row & 255; KR = BS * LKS + row; } else { const int r2 = row - MP; b = r2 >> 11; t = r2 & 2047; KR = b * LKS + t; }
                { const u32x2 v = *(const u32x2*)(pr + 3584 + lane * 4); float f[4] = {bf_lo(v.x), bf_hi(v.x), bf_lo(v.y), bf_hi(v.y)};
                  float ss = f[0] * f[0] + f[1] * f[1] + f[2] * f[2] + f[3] * f[3]; ss = wave_sum(ss, lane); const float rstd = rsqrtf(ss * (1.0f / 256.0f) + 1e-6f);
                  const float* kn = p.in[I_KVN] + l * 256 + lane * 4;
#pragma unroll
                  for (int j = 0; j < 4; ++j) f[j] = f[j] * rstd * kn[j];
                  if (isp) *(f32x4*)(out_ckv + ((size_t)(b * NLAYER + l) * LP + t) * 256 + lane * 4) = (f32x4){f[0], f[1], f[2], f[3]};
                  u32x2 w; w.x = cvt_pk_bf16(f[0], f[1]); w.y = cvt_pk_bf16(f[2], f[3]); *(u32x2*)(KC + (size_t)KR * 256 + lane * 4) = w; }
                { const float v = __uint_as_float(((unsigned)pr[3840 + lane]) << 16);
                  float o = v;
                  if (isp) out_kpe[((size_t)(b * NLAYER + l) * LP + t) * 64 + lane] = v;
                  else { const float pv = shx(v, 32, lane); const float* rc = (const float*)(p.ws + S_ROPE); const float cs = rc[t * 32 + (lane & 31)], sn = rc[2048 * 32 + t * 32 + (lane & 31)]; o = (lane < 32) ? (v * cs - pv * sn) : (pv * sn + v * cs); }
                  KP[(size_t)KR * 64 + lane] = f2bf(o); }
            } else {
                const int r2 = row - MT, b = r2 >> 9, j = r2 & 511; const int KR = b * LKS + LS + j;
                const float* cc = p.in[I_CCKV] + ((size_t)(b * NLAYER + l) * PAST + j) * 256 + lane * 4;
                const f32x4 v = *(const f32x4*)cc; u32x2 w; w.x = cvt_pk_bf16(v[0], v[1]); w.y = cvt_pk_bf16(v[2], v[3]); *(u32x2*)(KC + (size_t)KR * 256 + lane * 4) = w;
                KP[(size_t)KR * 64 + lane] = f2bf(p.in[I_CKPE][((size_t)(b * NLAYER + l) * PAST + j) * 64 + lane]);
            }
        }
    }
    {
        bf16_t* YC = (bf16_t*)(p.ws + A_YC); const float* scw = p.in[I_SCW] + (size_t)l * 3 * 1024;
        for (int it = obid() * NTHREADS + tid; it < MT * 128; it += gridDim.x * NTHREADS) {
            const int row = it >> 7, d0 = (it & 127) * 8;
            const int t = row < MP ? (row & 255) : ((row - MP) & 2047); const int L = row < MP ? LP : LS;
            const bf16_t* pr = PA + (size_t)row * PA_LD;
            float acc[8];
#pragma unroll
            for (int j = 0; j < 8; ++j) acc[j] = 0.f;
#pragma unroll
            for (int o = -1; o <= 1; ++o) {
                if (t + o < 0 || t + o >= L) continue;
                float cg[8], uu[8]; unpack8(*(const u32x4*)(pr + (long)o * PA_LD + 4928 + d0), cg); unpack8(*(const u32x4*)(pr + (long)o * PA_LD + 5952 + d0), uu);
                const float* w = scw + (o + 1) * 1024 + d0;
#pragma unroll
                for (int j = 0; j < 8; ++j) acc[j] += w[j] * (cg[j] * uu[j]);
            }
            float bg[8]; unpack8(*(const u32x4*)(pr + 3904 + d0), bg);
#pragma unroll
            for (int j = 0; j < 8; ++j) acc[j] *= bg[j];
            *(u32x4*)(YC + (size_t)row * 1024 + d0) = pack8(acc);
        }
    }
    {
        bf16_t* X0S = (bf16_t*)(p.ws + A_X0S); bf16_t* ZZT = (bf16_t*)(p.ws + A_ZZT);
        const float* hw = p.in[I_HCW] + (size_t)l * 3 * 3072; const float* hb = p.in[I_HCB] + (size_t)l * 3072;
        LAS bf16_t* zt = (LAS bf16_t*)lds;
        for (int u = obid(); u < (MT / 64) * 16; u += gridDim.x) {
            const int rt = u >> 4, dt = u & 15; const int row0 = rt * 64;
            const int tl = tid >> 3, dg = tid & 7, d0 = dt * 64 + dg * 8; const int row = row0 + tl;
            const int t = row < MP ? (row & 255) : ((row - MP) & 2047); const int L = row < MP ? LP : LS;
            const bf16_t* pr = PA + (size_t)row * PA_LD;
            float h0[8], h1[8], h2[8];
#pragma unroll
            for (int j = 0; j < 8; ++j) { h0[j] = hb[d0 + j]; h1[j] = hb[1024 + d0 + j]; h2[j] = hb[2048 + d0 + j]; }
#pragma unroll
            for (int o = -1; o <= 1; ++o) {
                if (t + o < 0 || t + o >= L) continue;
                float a[8], b[8], c[8];
                unpack8(*(const u32x4*)(pr + (long)o * PA_LD + d0), a); unpack8(*(const u32x4*)(pr + (long)o * PA_LD + 1024 + d0), b); unpack8(*(const u32x4*)(pr + (long)o * PA_LD + 2048 + d0), c);
                const float* w = hw + (o + 1) * 3072;
#pragma unroll
                for (int j = 0; j < 8; ++j) { h0[j] += w[d0 + j] * a[j]; h1[j] += w[1024 + d0 + j] * b[j]; h2[j] += w[2048 + d0 + j] * c[j]; }
            }
            *(u32x4*)(X0S + (size_t)row * 1024 + d0) = pack8(h0);
#pragma unroll
            for (int j = 0; j < 8; ++j) zt[(dg * 8 + j) * 72 + tl] = f2bf(h1[j] * h2[j]);
            __syncthreads();
            {
                const int dl = tid >> 3, tch = tid & 7; const int d = dt * 64 + dl;
                size_t base; int t0;
                if (row0 < MP) { const int b = row0 >> 8; t0 = row0 & 255; base = ((size_t)b * 1024 + d) * LP; }
                else { const int r2 = row0 - MP; const int b = r2 >> 11; t0 = r2 & 2047; base = (size_t)BP * 1024 * LP + ((size_t)b * 1024 + d) * LS; }
                *(u32x4*)(ZZT + base + t0 + tch * 8) = *(const LAS u32x4*)(zt + dl * 72 + tch * 8);
            }
            __syncthreads();
        }
    }
}

__device__ __forceinline__ void conv_phase(int wv, const Params& p, int l, LAS unsigned char* lds) {
    const int tid = otid(wv), wid = tid >> 6, lane = tid & 63, r = lane & 31, hh = lane >> 5;
    const bf16_t* ZZT = (const bf16_t*)(p.ws + A_ZZT); bf16_t* YCT = (bf16_t*)(p.ws + A_YCT);
    const float* hbias = p.in[I_HBIAS] + l * 1024;
    for (int u = obid(); u < 2048; u += gridDim.x) {
        const int g = (u < 1024) ? 1 : 0, d = u & 1023;
        const int L = g ? LS : LP, B = g ? BS : BP, L2 = 2 * L, NB = L / 32, NI = 32 / B, NT = NB / NI, lgB = g ? 3 : 4;
        const float* kT = (const float*)(p.ws + (g ? S_KTS : S_KTP)) + (size_t)d * L2;
        const float* part = (const float*)(p.ws + (g ? S_PARTS : S_PARTP));
        const int NU = g ? 64 : 8;
        float tot = 0.f;
        for (int i = 0; i < NU; ++i) tot += part[i * 2048 + d] + part[i * 2048 + 1024 + d];
        const float scale = 1.0f / tot; const float bias = hbias[d];
        LAS bf16_t* cp = (LAS bf16_t*)lds;
        LAS bf16_t* zz = (LAS bf16_t*)(lds + 65536);
        for (int idx = tid; idx < 8 * L2; idx += NTHREADS) {
            const int c = idx / L2, m = idx - c * L2; const int rpos = (m + c) & (L2 - 1); const int n = (L2 - rpos) & (L2 - 1);
            float v = kT[n] * scale; if (n == 0) v += bias;
            cp[idx] = f2bf(v);
        }
        const size_t zbase = g ? (size_t)BP * 1024 * LP : 0;
        for (int ch = tid; ch < B * L / 8; ch += NTHREADS) {
            const int b = ch / (L / 8), s8 = ch - b * (L / 8);
            *(LAS u32x4*)(zz + b * L + s8 * 8) = *(const u32x4*)(ZZT + zbase + ((size_t)b * 1024 + d) * L + s8 * 8);
        }
        __syncthreads();
        const int Iloc = r >> lgB, b = r & (B - 1);
        for (int nt = wid; nt < NT; nt += 8) {
            const int I0 = nt * NI;
            f32x16 acc;
#pragma unroll
            for (int i = 0; i < 16; ++i) acc[i] = 0.f;
            for (int dl = I0 - (NB - 1); dl <= I0 + NI - 1; ++dl) {
                const int J = I0 + Iloc - dl; const bool valid = (J >= 0) && (J < NB);
#pragma unroll
                for (int ks = 0; ks < 2; ++ks) {
                    const int i0 = (16 * ks + 8 * hh - 32 * dl - r) & (L2 - 1); const int c = i0 & 7, q = i0 >> 3;
                    const bf16x8 Af = *(const LAS bf16x8*)(cp + c * L2 + q * 8);
                    bf16x8 Bf = (bf16x8){0, 0, 0, 0, 0, 0, 0, 0};
                    if (valid) Bf = *(const LAS bf16x8*)(zz + b * L + 32 * J + 16 * ks + 8 * hh);
                    acc = __builtin_amdgcn_mfma_f32_32x32x16_bf16(Af, Bf, acc, 0, 0, 0);
                }
            }
            const int I = I0 + Iloc;
            bf16_t* op = YCT + zbase + ((size_t)b * 1024 + d) * L + 32 * I + 4 * hh;
#pragma unroll
            for (int g4 = 0; g4 < 4; ++g4) { u32x2 w; w.x = cvt_pk_bf16(acc[4 * g4], acc[4 * g4 + 1]); w.y = cvt_pk_bf16(acc[4 * g4 + 2], acc[4 * g4 + 3]); *(u32x2*)(op + 8 * g4) = w; }
        }
        __syncthreads();
    }
}

__device__ __forceinline__ void e3b_phase(int wv, const Params& p, LAS unsigned char* lds) {
    const int tid = otid(wv);
    const bf16_t* X0S = (const bf16_t*)(p.ws + A_X0S); const bf16_t* YCT = (const bf16_t*)(p.ws + A_YCT); bf16_t* YA = (bf16_t*)(p.ws + A_YA);
    LAS bf16_t* yt = (LAS bf16_t*)lds;
    for (int u = obid(); u < (MT / 64) * 16; u += gridDim.x) {
        const int rt = u >> 4, dt = u & 15; const int row0 = rt * 64;
        {
            const int dl = tid >> 3, tch = tid & 7; const int d = dt * 64 + dl;
            size_t base; int t0;
            if (row0 < MP) { const int b = row0 >> 8; t0 = row0 & 255; base = ((size_t)b * 1024 + d) * LP; }
            else { const int r2 = row0 - MP; const int b = r2 >> 11; t0 = r2 & 2047; base = (size_t)BP * 1024 * LP + ((size_t)b * 1024 + d) * LS; }
            const u32x4 v = *(const u32x4*)(YCT + base + t0 + tch * 8);
            const unsigned w[4] = {v.x, v.y, v.z, v.w};
#pragma unroll
            for (int j = 0; j < 4; ++j) { yt[(tch * 8 + 2 * j) * 72 + dl] = (bf16_t)(w[j] & 0xffffu); yt[(tch * 8 + 2 * j + 1) * 72 + dl] = (bf16_t)(w[j] >> 16); }
        }
        __syncthreads();
        {
            const int tl = tid >> 3, dg = tid & 7; const int row = row0 + tl, d0 = dt * 64 + dg * 8;
            float a[8], b[8]; unpack8(*(const LAS u32x4*)(yt + tl * 72 + dg * 8), a); unpack8(*(const u32x4*)(X0S + (size_t)row * 1024 + d0), b);
#pragma unroll
            for (int j = 0; j < 8; ++j) a[j] *= b[j];
            *(u32x4*)(YA + (size_t)row * 1024 + d0) = pack8(a);
        }
        __syncthreads();
    }
}

__device__ __forceinline__ void attn_phase(int wv, const Params& p, LAS unsigned char* lds) {
    const bf16_t* Q = (const bf16_t*)(p.ws + A_Q); const bf16_t* KN = (const bf16_t*)(p.ws + A_KN); const bf16_t* KP = (const bf16_t*)(p.ws + A_KPER);
    const bf16_t* VT = (const bf16_t*)(p.ws + A_VT); bf16_t* O = (bf16_t*)(p.ws + A_OATT);
    LAS unsigned char* Ks = lds;
    LAS unsigned char* Vs = lds + 64 * 400;
    const float sc2 = 0.07216878364870322f * 1.4426950408889634f;
    for (int u = obid(); u < 512 + 128; u += gridDim.x) {
        const int tid = otid(wv), wid = tid >> 6, lane = tid & 63, r = lane & 31, hh = lane >> 5;
        int b, h, row0, Lk, KR0; size_t vtb; bool samp;
        if (u < 512) { samp = true; b = u >> 6; h = (u >> 3) & 7; const int qb = u & 7; row0 = MP + b * LS + qb * 256; Lk = LKS; KR0 = b * LKS; vtb = (size_t)(b * 8 + h) * 128 * LKS; }
        else { samp = false; const int u2 = u - 512; b = u2 >> 3; h = u2 & 7; row0 = b * LP; Lk = LP; KR0 = BS * LKS + b * LP; vtb = (size_t)BS * 8 * 128 * LKS + (size_t)(b * 8 + h) * 128 * LP; }
        const int qrow = row0 + wid * 32 + r;
        bf16x8 qf[12];
        {
            const bf16_t* qp = Q + (size_t)qrow * 1536 + h * 192 + 8 * hh;
            u32x4 qv[12];
#pragma unroll
            for (int s = 0; s < 12; ++s) qv[s] = *(const u32x4*)(qp + 16 * s);
            if (samp) {
                const int t = (qrow - MP) & 2047;
#pragma unroll
                for (int s2 = 0; s2 < 2; ++s2) {
                    float x1[8], x2[8]; unpack8(qv[8 + s2], x1); unpack8(qv[10 + s2], x2);
                    const float* rc = (const float*)(p.ws + S_ROPE) + t * 32 + 16 * s2 + 8 * hh;
                    const f32x4 c0 = *(const f32x4*)rc, c1 = *(const f32x4*)(rc + 4), s0 = *(const f32x4*)(rc + 2048 * 32), s1 = *(const f32x4*)(rc + 2048 * 32 + 4);
#pragma unroll
                    for (int j = 0; j < 8; ++j) { const float cs = (j < 4) ? c0[j & 3] : c1[j & 3], sn = (j < 4) ? s0[j & 3] : s1[j & 3]; const float a = x1[j], c = x2[j]; x1[j] = a * cs - c * sn; x2[j] = a * sn + c * cs; }
                    qv[8 + s2] = pack8(x1); qv[10 + s2] = pack8(x2);
                }
            }
#pragma unroll
            for (int s = 0; s < 12; ++s) qf[s] = __builtin_bit_cast(bf16x8, qv[s]);
        }
        f32x16 oacc[4];
#pragma unroll
        for (int ct = 0; ct < 4; ++ct)
#pragma unroll
            for (int i = 0; i < 16; ++i) oacc[ct][i] = 0.f;
        float mrun = -1e30f, lrun = 0.f;
        const int nkt = Lk / 64;
        u32x4 kst[3], vst[2];
#pragma unroll
        for (int i = 0; i < 3; ++i) { const int ck = tid + i * NTHREADS; const int key = ck / 24, part = ck - key * 24;
            kst[i] = (part < 16) ? *(const u32x4*)(KN + (size_t)(KR0 + key) * 1024 + h * 128 + part * 8) : *(const u32x4*)(KP + (size_t)(KR0 + key) * 64 + (part - 16) * 8); }
#pragma unroll
        for (int i = 0; i < 2; ++i) { const int cv = tid + i * NTHREADS; const int v = cv >> 3, kc = cv & 7; vst[i] = *(const u32x4*)(VT + vtb + (size_t)v * Lk + kc * 8); }
        for (int kt = 0; kt < nkt; ++kt) {
            __syncthreads();
#pragma unroll
            for (int i = 0; i < 3; ++i) { const int ck = tid + i * NTHREADS; const int key = ck / 24, part = ck - key * 24; *(LAS u32x4*)(Ks + key * 400 + part * 16) = kst[i]; }
#pragma unroll
            for (int i = 0; i < 2; ++i) { const int cv = tid + i * NTHREADS; const int v = cv >> 3, kc = cv & 7; *(LAS u32x4*)(Vs + v * 144 + kc * 16) = vst[i]; }
            __syncthreads();
            if (kt + 1 < nkt) {
                const int k0 = (kt + 1) * 64;
#pragma unroll
                for (int i = 0; i < 3; ++i) { const int ck = tid + i * NTHREADS; const int key = ck / 24, part = ck - key * 24;
                    kst[i] = (part < 16) ? *(const u32x4*)(KN + (size_t)(KR0 + k0 + key) * 1024 + h * 128 + part * 8) : *(const u32x4*)(KP + (size_t)(KR0 + k0 + key) * 64 + (part - 16) * 8); }
#pragma unroll
                for (int i = 0; i < 2; ++i) { const int cv = tid + i * NTHREADS; const int v = cv >> 3, kc = cv & 7; vst[i] = *(const u32x4*)(VT + vtb + (size_t)v * Lk + k0 + kc * 8); }
            }
            f32x16 sacc[2];
#pragma unroll
            for (int kk = 0; kk < 2; ++kk) {
#pragma unroll
                for (int i = 0; i < 16; ++i) sacc[kk][i] = 0.f;
#pragma unroll
                for (int s = 0; s < 12; ++s) {
                    const bf16x8 kf = *(const LAS bf16x8*)(Ks + (32 * kk + r) * 400 + (16 * s + 8 * hh) * 2);
                    sacc[kk] = __builtin_amdgcn_mfma_f32_32x32x16_bf16(kf, qf[s], sacc[kk], 0, 0, 0);
                }
            }
            float mx = sacc[0][0];
#pragma unroll
            for (int kk = 0; kk < 2; ++kk)
#pragma unroll
                for (int i = 0; i < 16; ++i) mx = fmaxf(mx, sacc[kk][i]);
            mx = fmaxf(mx, shx(mx, 32, lane));
            const float mnew = fmaxf(mrun, mx);
            const float alpha = __builtin_amdgcn_exp2f((mrun - mnew) * sc2);
            mrun = mnew;
            float ps = 0.f;
#pragma unroll
            for (int kk = 0; kk < 2; ++kk)
#pragma unroll
                for (int i = 0; i < 16; ++i) { const float pv = __builtin_amdgcn_exp2f((sacc[kk][i] - mnew) * sc2); sacc[kk][i] = pv; ps += pv; }
            lrun = lrun * alpha + ps;
#pragma unroll
            for (int ct = 0; ct < 4; ++ct)
#pragma unroll
                for (int i = 0; i < 16; ++i) oacc[ct][i] *= alpha;
#pragma unroll
            for (int ks = 0; ks < 4; ++ks) {
                const int kk = ks >> 1, s2 = ks & 1;
                u32x4 pw;
                pw.x = cvt_pk_bf16(sacc[kk][8 * s2 + 0], sacc[kk][8 * s2 + 1]); pw.y = cvt_pk_bf16(sacc[kk][8 * s2 + 2], sacc[kk][8 * s2 + 3]);
                pw.z = cvt_pk_bf16(sacc[kk][8 * s2 + 4], sacc[kk][8 * s2 + 5]); pw.w = cvt_pk_bf16(sacc[kk][8 * s2 + 6], sacc[kk][8 * s2 + 7]);
                const bf16x8 pf = __builtin_bit_cast(bf16x8, pw);
#pragma unroll
                for (int ct = 0; ct < 4; ++ct) {
                    const LAS unsigned char* vp = Vs + (32 * ct + r) * 144 + (32 * kk + 16 * s2 + 4 * hh) * 2;
                    const u32x2 lo = *(const LAS u32x2*)vp, hi = *(const LAS u32x2*)(vp + 16);
                    u32x4 vw; vw.x = lo.x; vw.y = lo.y; vw.z = hi.x; vw.w = hi.y;
                    oacc[ct] = __builtin_amdgcn_mfma_f32_32x32x16_bf16(__builtin_bit_cast(bf16x8, vw), pf, oacc[ct], 0, 0, 0);
                }
            }
        }
        lrun += shx(lrun, 32, lane);
        const float invl = 1.0f / lrun;
        const int tid2 = otid(wv); const int qrow2 = row0 + (tid2 >> 6) * 32 + (tid2 & 31);
        bf16_t* op = O + (size_t)qrow2 * 1024 + h * 128 + 4 * ((tid2 >> 5) & 1);
#pragma unroll
        for (int ct = 0; ct < 4; ++ct)
#pragma unroll
            for (int g4 = 0; g4 < 4; ++g4) {
                u32x2 w; w.x = cvt_pk_bf16(oacc[ct][4 * g4] * invl, oacc[ct][4 * g4 + 1] * invl); w.y = cvt_pk_bf16(oacc[ct][4 * g4 + 2] * invl, oacc[ct][4 * g4 + 3] * invl);
                *(u32x2*)(op + 32 * ct + 8 * g4) = w;
            }
        __syncthreads();
    }
}

__device__ __forceinline__ void e9_phase(int wv, const Params& p, int l) {
    const bf16_t* UU = (const bf16_t*)(p.ws + A_UU); bf16_t* ACT = (bf16_t*)(p.ws + A_ACT);
    const float* cw = p.in[I_FCW] + (size_t)l * 3 * UU_LD; const float* cb = p.in[I_FCB] + (size_t)l * UU_LD;
    const int tid9 = otid(wv);
    for (int it = obid() * NTHREADS + tid9; it < MT * (DFF / 8); it += gridDim.x * NTHREADS) {
        const int row = it / (DFF / 8), c0 = (it - row * (DFF / 8)) * 8;
        const int t = row < MP ? (row & 255) : ((row - MP) & 2047); const int L = row < MP ? LP : LS;
        const bf16_t* pr = UU + (size_t)row * UU_LD;
        float ga[8], va[8];
#pragma unroll
        for (int j = 0; j < 8; ++j) { ga[j] = cb[c0 + j]; va[j] = cb[DFF + c0 + j]; }
#pragma unroll
        for (int o = -1; o <= 1; ++o) {
            if (t + o < 0 || t + o >= L) continue;
            float a[8], b[8]; unpack8(*(const u32x4*)(pr + (long)o * UU_LD + c0), a); unpack8(*(const u32x4*)(pr + (long)o * UU_LD + DFF + c0), b);
            const float* w = cw + (o + 1) * UU_LD;
#pragma unroll
            for (int j = 0; j < 8; ++j) { ga[j] += w[c0 + j] * a[j]; va[j] += w[DFF + c0 + j] * b[j]; }
        }
#pragma unroll
        for (int j = 0; j < 8; ++j) ga[j] = siluf_(ga[j]) * va[j];
        *(u32x4*)(ACT + (size_t)row * DFF + c0) = pack8(ga);
    }
}

__device__ __forceinline__ void convert_layer(int wv, const Params& p, int l, LAS unsigned char* lds) {
    unsigned char* ws = p.ws;
    convT(wv, p.in[I_WIN] + (size_t)l * DM * NIN, DM, NIN, (bf16_t*)(ws + W_IN), 1, lds);
    convT(wv, p.in[I_WUQ] + (size_t)l * 512 * 1536, 512, 1536, (bf16_t*)(ws + W_UQ), 0, lds);
    convT(wv, p.in[I_WUKV] + (size_t)l * 256 * 2048, 256, 2048, (bf16_t*)(ws + W_UKV), 2, lds);
    convT(wv, p.in[I_WBRA] + (size_t)l * 1024 * 2048, 1024, 2048, (bf16_t*)(ws + W_BRA), 0, lds);
    convT(wv, p.in[I_WBRB] + (size_t)l * 1024 * 2048, 1024, 2048, (bf16_t*)(ws + W_BRB), 0, lds);
    convT(wv, p.in[I_WBRC] + (size_t)l * 1024 * 2048, 1024, 2048, (bf16_t*)(ws + W_BRC), 0, lds);
    convT(wv, p.in[I_WO] + (size_t)l * 2048 * 2048, 2048, 2048, (bf16_t*)(ws + W_O), 0, lds);
    convT(wv, p.in[I_FUP] + (size_t)l * 2048 * UU_LD, 2048, UU_LD, (bf16_t*)(ws + W_UP), 0, lds);
    convT(wv, p.in[I_FDN] + (size_t)l * DFF * 2048, DFF, 2048, (bf16_t*)(ws + W_DN), 0, lds);
}

namespace pg8 {
struct EpiGateRT {
    const bf16_t* gates; float* m32; bf16_t* mbf; int P;
    __device__ __forceinline__ void operator()(const f32x4 (&acc)[2][2][4][2], const Unit& u, int wr, int wc, int fr, int fq) const {
        const int row0 = u.pm * BM + wr * 64 + fr, col0 = u.pn * BM + wc * 32 + 4 * fq;
#pragma unroll
        for (int ai = 0; ai < 2; ++ai)
#pragma unroll
            for (int m = 0; m < 4; ++m) {
                const size_t row = (size_t)(row0 + ai * HALF + m * 16);
#pragma unroll
                for (int bj = 0; bj < 2; ++bj)
#pragma unroll
                    for (int n = 0; n < 2; ++n) {
                        const int col = col0 + bj * HALF + n * 16;
                        const u32x2 gw = *(const u32x2*)(gates + row * GATE_LD + P * 2048 + col);
                        f32x4 v = acc[ai][bj][m][n];
                        v[0] *= sigmoidf_(bf_lo(gw.x)); v[1] *= sigmoidf_(bf_hi(gw.x)); v[2] *= sigmoidf_(bf_lo(gw.y)); v[3] *= sigmoidf_(bf_hi(gw.y));
                        float* mp = m32 + row * 2048 + col;
                        if (P != 0) { const f32x4 o = *(const f32x4*)mp; v = v + o; }
                        if (P != 2) { *(f32x4*)mp = v; }
                        else { u32x2 w; w.x = cvt_pk_bf16(v[0], v[1]); w.y = cvt_pk_bf16(v[2], v[3]); *(u32x2*)(mbf + row * 2048 + col) = w; }
                    }
            }
    }
};
}

enum { K_G1A = 0, K_E2, K_I3, K_I4, K_G1B, K_G5, K_G6, K_ROW1, K_G8, K_E9, K_G10, K_ROW2, K_PRO, K_ROW0 };

__global__ void __launch_bounds__(NTHREADS) fwd_megakernel(Params p) {
    extern __shared__ __attribute__((aligned(16))) unsigned char shm[];
    LAS unsigned char* lds = (LAS unsigned char*)shm;
    cg::grid_group grid = cg::this_grid();
    const int wv = __builtin_amdgcn_readfirstlane((int)(threadIdx.x >> 6));
#pragma unroll 1
    for (int ph = 0; ph < 2 + 12 * NLAYER; ++ph) {
        int kind, l;
        if (ph == 0) { kind = K_PRO; l = 0; } else if (ph == 1) { kind = K_ROW0; l = 0; } else { l = (ph - 2) / 12; kind = (ph - 2) - l * 12; }
        unsigned char* ws = p.ws;
        asm volatile("" : "+s"(ws));
        if (kind == K_G1A || kind == K_I3 || kind == K_G1B || kind == K_G8) {
            const bf16_t* A; const bf16_t* Bt; bf16_t* O; int N, K;
            if (kind == K_G1A) { A = (const bf16_t*)(ws + A_H); Bt = (const bf16_t*)(ws + W_IN); O = (bf16_t*)(ws + A_PROJA); N = PA_LD; K = DM; }
            else if (kind == K_I3) { A = (const bf16_t*)(ws + A_CQN); Bt = (const bf16_t*)(ws + W_UQ); O = (bf16_t*)(ws + A_Q); N = 1536; K = 512; }
            else if (kind == K_G1B) { A = (const bf16_t*)(ws + A_H); Bt = (const bf16_t*)(ws + W_IN) + (size_t)PA_LD * DM; O = (bf16_t*)(ws + A_GATES); N = GATE_LD; K = DM; }
            else { A = (const bf16_t*)(ws + A_H); Bt = (const bf16_t*)(ws + W_UP); O = (bf16_t*)(ws + A_UU); N = UU_LD; K = DM; }
            int Mr = MT;
            const int nrep = (kind == K_I3) ? 2 : 1;
#pragma unroll 1
            for (int rp = 0; rp < nrep; ++rp) {
                if (rp == 1) { A = (const bf16_t*)(ws + A_KEYSC); Bt = (const bf16_t*)(ws + W_UKV); O = (bf16_t*)(ws + A_KN); N = 1024; K = 256; Mr = KROWS; }
                run_gemm(wv, lds, A, Bt, Mr, N, K, pg8::EpiBf16{O, N});
            }
        }
        if (kind == K_I3) {
            run_gemm(wv, lds, (const bf16_t*)(ws + W_UKV) + (size_t)1024 * 256, (const bf16_t*)(ws + A_KEYSC), 1024, KROWS, 256,
                     pg8::EpiVT{(bf16_t*)(ws + A_VT), (bf16_t*)(ws + A_VT) + (size_t)BS * 8 * 128 * LKS});
            conv_phase(wv, p, l, lds);
        }
        if (kind == K_I4) { attn_phase(wv, p, lds); e3b_phase(wv, p, lds); }
        if (kind == K_G5) {
#pragma unroll 1
            for (int P = 0; P < 3; ++P) {
                const bf16_t* A = (const bf16_t*)(ws + (P == 0 ? A_YA : (P == 1 ? A_OATT : A_YC)));
                const bf16_t* Bt = (const bf16_t*)(ws + (P == 0 ? W_BRA : (P == 1 ? W_BRB : W_BRC)));
                run_gemm(wv, lds, A, Bt, MT, DM, 1024, pg8::EpiGateRT{(const bf16_t*)(ws + A_GATES), (float*)(ws + A_M32), (bf16_t*)(ws + A_MBF), P});
            }
        }
        if (kind == K_G6 || kind == K_G10) {
            const bool g6 = (kind == K_G6);
            run_gemm(wv, lds, (const bf16_t*)(ws + (g6 ? A_MBF : A_ACT)), (const bf16_t*)(ws + (g6 ? W_O : W_DN)), MT, DM, g6 ? DM : DFF, pg8::EpiF32{(float*)(ws + (g6 ? A_M32 : A_F32)), DM});
        }
        if (kind == K_E2) e2_phase(wv, p, l, lds);
        if (kind == K_E9) e9_phase(wv, p, l);
        if (kind == K_ROW0 || kind == K_ROW1 || kind == K_ROW2) row_phase(wv, p, l, kind == K_ROW0 ? 0 : (kind == K_ROW1 ? 1 : 2));
        if (kind == K_PRO) { ada_phase(wv, p, lds); rope_table_phase(wv, p); }
        if (kind == K_PRO || (kind == K_ROW2 && l + 1 < NLAYER)) { const int ln = (kind == K_PRO) ? 0 : l + 1; filter_phase(wv, p, ln, lds); convert_layer(wv, p, ln, lds); }
        grid.sync();
    }
}

extern "C" void kernel_launch(void* const* d_in, const int* in_sizes, int n_in, void* d_out, int out_size, void* d_ws, size_t ws_size, hipStream_t stream) {
    static int grid_blocks = 0;
    if (grid_blocks == 0) {
        if (n_in != N_INPUTS || ws_size < WS_NEED) { fprintf(stderr, "kernel_launch: need %d inputs and %zu bytes of workspace; got %d, %zu\n", N_INPUTS, (size_t)WS_NEED, n_in, ws_size); grid_blocks = -1; return; }
        int dev = 0, cus = 0, per_cu = 0;
        hipGetDevice(&dev);
        hipDeviceGetAttribute(&cus, hipDeviceAttributeMultiprocessorCount, dev);
        if (hipFuncSetAttribute((const void*)fwd_megakernel, hipFuncAttributeMaxDynamicSharedMemorySize, LDS_BYTES) != hipSuccess) { fprintf(stderr, "kernel_launch: hipFuncSetAttribute failed\n"); grid_blocks = -1; return; }
        if (hipOccupancyMaxActiveBlocksPerMultiprocessor(&per_cu, (const void*)fwd_megakernel, NTHREADS, LDS_BYTES) != hipSuccess || per_cu < 1) { fprintf(stderr, "kernel_launch: occupancy query gave %d\n", per_cu); per_cu = 1; }
        (void)hipGetLastError();
        grid_blocks = cus * 1;
    }
    if (grid_blocks < 0) return;
    hipMemsetAsync((unsigned char*)d_ws + S_MOD, 0, SZ_MOD, stream);
    Params p{};
    for (int i = 0; i < N_INPUTS; ++i) p.in[i] = (const float*)d_in[i];
    p.out = (float*)d_out; p.ws = (unsigned char*)d_ws;
    void* args[] = {&p};
    hipError_t e = hipLaunchCooperativeKernel((const void*)fwd_megakernel, dim3(grid_blocks), dim3(NTHREADS), args, LDS_BYTES, stream);
    if (e != hipSuccess) fprintf(stderr, "cooperative launch failed: %s (grid %d)\n", hipGetErrorString(e), grid_blocks);
}
```

```cpp
#include <hip/hip_runtime.h>
#include <hip/hip_cooperative_groups.h>
#include <cstdio>
namespace cg = cooperative_groups;

#define LAS __attribute__((address_space(3)))
typedef unsigned short bf16_t;
typedef short bf16x8 __attribute__((ext_vector_type(8)));
typedef float f32x4 __attribute__((ext_vector_type(4)));
typedef float f32x16 __attribute__((ext_vector_type(16)));
typedef unsigned u32x4 __attribute__((ext_vector_type(4)));
typedef unsigned u32x2 __attribute__((ext_vector_type(2)));

constexpr int DM = 2048, MP = 4096, MS = 16384, MT = 20480, NLAYER = 2;
constexpr int LP = 256, LS = 2048, BP = 16, BS = 8, PAST = 512, LKS = 2560;
constexpr int NIN = 13120, NGATE0 = 6976, PA_LD = 7168, GATE_LD = 6144;
constexpr int DFF = 5632, UU_LD = 11264;
constexpr int KROWS = 24576;
constexpr int NTHREADS = 512;
constexpr int LDS_BYTES = 131072 + 16;

enum { I_XP = 0, I_XS, I_C, I_CCKV, I_CKPE, I_CCTX, I_ADAW, I_ADAB, I_NMPRE, I_NMPOST, I_NFPRE, I_NFPOST, I_WIN, I_HCW, I_HCB,
       I_FW1, I_FB1, I_FW2, I_FB2, I_FW3, I_FB3, I_FFREQ, I_HBIAS, I_QN, I_KVN, I_WUQ, I_WUKV, I_SCW, I_WBRA, I_WBRB, I_WBRC,
       I_WO, I_FUP, I_FCW, I_FCB, I_FDN, N_INPUTS };

constexpr size_t E_WIN = (size_t)13312 * 2048, E_WUQ = (size_t)1536 * 512, E_WUKV = (size_t)2048 * 256, E_WBR = (size_t)2048 * 1024,
                 E_WO = (size_t)2048 * 2048, E_WUP = (size_t)11264 * 2048, E_WDN = (size_t)2048 * 5632;
constexpr size_t W_IN = 0, W_UQ = W_IN + E_WIN * 2, W_UKV = W_UQ + E_WUQ * 2, W_BRA = W_UKV + E_WUKV * 2, W_BRB = W_BRA + E_WBR * 2,
                 W_BRC = W_BRB + E_WBR * 2, W_O = W_BRC + E_WBR * 2, W_UP = W_O + E_WO * 2, W_DN = W_UP + E_WUP * 2, W_END = W_DN + E_WDN * 2;
constexpr size_t S_MOD = W_END, SZ_MOD = (size_t)NLAYER * 9 * 12288 * 4;
constexpr size_t S_KTS = S_MOD + SZ_MOD, S_KTP = S_KTS + (size_t)1024 * 4096 * 4, S_PARTS = S_KTP + (size_t)1024 * 512 * 4,
                 S_PARTP = S_PARTS + (size_t)64 * 2048 * 4, S_ROPE = S_PARTP + (size_t)8 * 2048 * 4, S_BAR = S_ROPE + (size_t)2 * 2048 * 32 * 4, S_END = S_BAR + 16384;
constexpr size_t AR = S_END;
constexpr size_t SZ_H = (size_t)MT * 2048 * 2;
constexpr size_t A_H = AR, A_UU = AR + SZ_H, A_ACT = A_UU + (size_t)MT * UU_LD * 2, AR_END = A_ACT + (size_t)MT * DFF * 2;
constexpr size_t A_PROJA = A_UU;
constexpr size_t A_Q = A_UU, A_KN = A_Q + (size_t)MT * 1536 * 2, A_VT = A_KN + (size_t)KROWS * 1024 * 2, A_YCT = A_VT + (size_t)KROWS * 1024 * 2;
constexpr size_t A_GATES = A_UU, A_M32 = A_GATES + (size_t)MT * GATE_LD * 2, A_MBF = A_H, A_F32 = A_UU;
constexpr size_t A_S = A_M32 + (size_t)MT * 2048 * 4;
constexpr size_t A_ZZT = A_S, A_X0S = A_ZZT + (size_t)MT * 1024 * 2, A_CQN = A_X0S + (size_t)MT * 1024 * 2, A_KEYSC = A_CQN + (size_t)MT * 512 * 2,
                 A_KPER = A_KEYSC + (size_t)KROWS * 256 * 2, A_YC = A_KPER + (size_t)KROWS * 64 * 2, A_YA = A_YC + (size_t)MT * 1024 * 2,
                 A_OATT = A_YA + (size_t)MT * 1024 * 2, A_SEND = A_OATT + (size_t)MT * 1024 * 2;
static_assert(A_SEND <= AR_END, "arena overflow");
static_assert(A_YCT + (size_t)MT * 1024 * 2 <= A_M32, "arena overlap");
constexpr size_t WS_NEED = AR_END;
static_assert(WS_NEED <= 967590400ull, "workspace too large");

struct Params {
    const float* in[N_INPUTS];
    float* out;
    unsigned char* ws;
};

__device__ __forceinline__ unsigned cvt_pk_bf16(float lo, float hi) { unsigned r; asm volatile("v_cvt_pk_bf16_f32 %0, %1, %2" : "=v"(r) : "v"(lo), "v"(hi)); return r; }
__device__ __forceinline__ bf16_t f2bf(float f) { return (bf16_t)(cvt_pk_bf16(f, 0.f) & 0xffffu); }
__device__ __forceinline__ float bf_lo(unsigned w) { return __uint_as_float(w << 16); }
__device__ __forceinline__ float bf_hi(unsigned w) { return __uint_as_float(w & 0xffff0000u); }
__device__ __forceinline__ void unpack8(const u32x4 v, float* f) { f[0] = bf_lo(v.x); f[1] = bf_hi(v.x); f[2] = bf_lo(v.y); f[3] = bf_hi(v.y); f[4] = bf_lo(v.z); f[5] = bf_hi(v.z); f[6] = bf_lo(v.w); f[7] = bf_hi(v.w); }
__device__ __forceinline__ u32x4 pack8(const float* f) { u32x4 r; r.x = cvt_pk_bf16(f[0], f[1]); r.y = cvt_pk_bf16(f[2], f[3]); r.z = cvt_pk_bf16(f[4], f[5]); r.w = cvt_pk_bf16(f[6], f[7]); return r; }
__device__ __forceinline__ float shx(float v, int mask, int lane) { return __int_as_float(__builtin_amdgcn_ds_bpermute((lane ^ mask) << 2, __float_as_int(v))); }
__device__ __forceinline__ float wave_sum(float v, int lane) {
#pragma unroll
    for (int o = 32; o >= 1; o >>= 1) v += shx(v, o, lane);
    return v;
}
__device__ __forceinline__ int otid(int wv) { int t; asm volatile("v_mbcnt_lo_u32_b32 %0, -1, 0\n\tv_mbcnt_hi_u32_b32 %0, -1, %0" : "=v"(t)); return wv * 64 + t; }
__device__ __forceinline__ int obid() { int t = blockIdx.x; asm volatile("" : "+s"(t)); return t; }
__device__ __forceinline__ float sigmoidf_(float x) { return 1.0f / (1.0f + __expf(-x)); }
__device__ __forceinline__ float siluf_(float x) { return x / (1.0f + __expf(-x)); }

namespace pg8 {
constexpr int BM = 256, BK = 64, HALF = 128, HTB = HALF * BK * 2, STAGE_BYTES = 8 * HTB, NXCD = 8, WGM = 8;
__host__ __device__ __forceinline__ int lds_byte(int r, int c) { const int st = (r >> 4) * 2 + (c >> 5), rr = r & 15, cc = c & 31, ob = rr * 64 + cc * 2; return st * 1024 + (ob ^ (((ob >> 9) & 1) << 5)); }
__host__ __device__ __forceinline__ void stage_rc(int b, int& R, int& C) { const int st = b / 1024, sb = b % 1024, swz = sb ^ (((sb >> 9) & 1) << 5); R = (st >> 1) * 16 + swz / 64; C = (st & 1) * 32 + (swz % 64) / 2; }
struct Unit { int pm, pn; };
struct Gemm { const bf16_t* A; const bf16_t* Bt; int M, N, K; };
struct StaticOrder {
    int nM, nN, nwg, G, c;
    __device__ void init(int M, int N, int G_, int c_) { nM = M / BM; nN = N / BM; nwg = nM * nN; G = G_; c = c_; }
    __device__ bool next(int i, Unit& u) const {
        const long L = (long)i * G + c; if (L >= nwg) return false;
        int wgid = (int)L; { const int q = nwg / NXCD, r = nwg % NXCD, xcd = wgid % NXCD, off = wgid / NXCD; wgid = (xcd < r ? xcd * (q + 1) : r * (q + 1) + (xcd - r) * q) + off; }
        const int nig = WGM * nN, gid = wgid / nig, fm = gid * WGM, gsz = (nM - fm) < WGM ? (nM - fm) : WGM;
        u.pm = fm + ((wgid % nig) % gsz); u.pn = (wgid % nig) / gsz; return true;
    }
};
template <class Epi>
__device__ __forceinline__ void gemm_phase(int wv, LAS unsigned char* lds, const Gemm g, const StaticOrder& S, const Epi& E) {
    const int tid = otid(wv), wid = __builtin_amdgcn_readfirstlane(tid >> 6), lane = tid & 63, wr = wid >> 2, wc = wid & 3, fr = lane & 15, fq = lane >> 4;
    const int K = g.K, nt = K / BK;
    unsigned voffA[2];
#pragma unroll
    for (int i = 0; i < 2; ++i) { int R, C; stage_rc(tid * 16 + i * 8192, R, C); voffA[i] = (unsigned)(R * K + C) * 2u; }
    const size_t kstep = (size_t)(BK * 2);
    const size_t hstep = (size_t)HALF * K * 2;
    const size_t tstep = 2 * hstep;
    const unsigned ldsw = (unsigned)wid * 1024u;
    const int aoff = lds_byte(wr * 64 + fr, fq * 8), boff = lds_byte(wc * 32 + fr, fq * 8);
#define PG8_SA(b, h) (((b) * 2 + (h)) * HTB)
#define PG8_SB(b, h) ((4 + (b) * 2 + (h)) * HTB)
#define PG8_STAGE(bufoff, gbase, voff) do { _Pragma("unroll") for (int _i = 0; _i < 2; ++_i) \
        __builtin_amdgcn_global_load_lds((const unsigned*)((const char*)(gbase) + (voff)[_i]), (LAS unsigned*)(lds + (bufoff) + ldsw + _i * 8192), 16, 0, 0); } while (0)
#define PG8_LDA(dst, b, h) do { _Pragma("unroll") for (int m = 0; m < 4; ++m) _Pragma("unroll") for (int k = 0; k < 2; ++k) dst[m][k] = *(const LAS bf16x8*)(lds + PG8_SA(b, h) + aoff + m * 2048 + k * 1024); } while (0)
#define PG8_LDB(dst, b, h) do { _Pragma("unroll") for (int n = 0; n < 2; ++n) _Pragma("unroll") for (int k = 0; k < 2; ++k) dst[n][k] = *(const LAS bf16x8*)(lds + PG8_SB(b, h) + boff + n * 2048 + k * 1024); } while (0)
#define PG8_MMA(ai, bj, At, Bt) do { __builtin_amdgcn_s_setprio(1); _Pragma("unroll") for (int m = 0; m < 4; ++m) _Pragma("unroll") for (int n = 0; n < 2; ++n) _Pragma("unroll") for (int k = 0; k < 2; ++k) \
        acc[ai][bj][m][n] = __builtin_amdgcn_mfma_f32_16x16x32_bf16(Bt[n][k], At[m][k], acc[ai][bj][m][n], 0, 0, 0); __builtin_amdgcn_s_setprio(0); } while (0)
#define PG8_WAIT_V(n) asm volatile("s_waitcnt vmcnt(" #n ")" ::: "memory")
#define PG8_WAIT_L(n) asm volatile("s_waitcnt lgkmcnt(" #n ")" ::: "memory")
#define PG8_BAR __builtin_amdgcn_s_barrier()
#define PG8_SCHED __builtin_amdgcn_sched_barrier(0)
    Unit cur, nxt; int ui = 0;
    if (!S.next(0, cur)) return;
    f32x4 acc[2][2][4][2];
#pragma unroll
    for (int a = 0; a < 2; ++a)
#pragma unroll
        for (int b = 0; b < 2; ++b)
#pragma unroll
            for (int m = 0; m < 4; ++m)
#pragma unroll
                for (int n = 0; n < 2; ++n) acc[a][b][m][n] = (f32x4){0.f, 0.f, 0.f, 0.f};
    bf16x8 At[4][2], B0[2][2], B1[2][2];
    const char* cA = (const char*)g.A + (size_t)cur.pm * tstep; const char* cB = (const char*)g.Bt + (size_t)cur.pn * tstep;
    PG8_STAGE(PG8_SB(0, 0), cB, voffA); PG8_STAGE(PG8_SA(0, 0), cA, voffA); PG8_STAGE(PG8_SB(0, 1), cB + hstep, voffA); PG8_STAGE(PG8_SA(0, 1), cA + hstep, voffA);
    if (wr == 1) PG8_BAR;
    PG8_WAIT_V(4); PG8_BAR;
    PG8_STAGE(PG8_SB(1, 0), cB + kstep, voffA); PG8_STAGE(PG8_SA(1, 0), cA + kstep, voffA); PG8_STAGE(PG8_SB(1, 1), cB + hstep + kstep, voffA);
    PG8_WAIT_V(6); PG8_BAR;
    for (;;) {
        const bool has_next = S.next(ui + 1, nxt);
        const char* nA = has_next ? (const char*)g.A + (size_t)nxt.pm * tstep : cA; const char* nB = has_next ? (const char*)g.Bt + (size_t)nxt.pn * tstep : cB;
        for (int t = 0; t < nt; t += 2) {
            const bool last = (t == nt - 2);
            const char* a1 = cA + (size_t)(t + 1) * kstep;
            const char* a2 = last ? nA : cA + (size_t)(t + 2) * kstep; const char* b2 = last ? nB : cB + (size_t)(t + 2) * kstep;
            const char* a3 = a2 + kstep; const char* b3 = b2 + kstep;
            PG8_LDB(B0, 0, 0); PG8_SCHED; PG8_LDA(At, 0, 0); PG8_STAGE(PG8_SA(1, 1), a1 + hstep, voffA);
            PG8_WAIT_L(8); PG8_BAR; PG8_WAIT_L(0); PG8_MMA(0, 0, At, B0); PG8_BAR; PG8_SCHED;
            PG8_LDB(B1, 0, 1); PG8_STAGE(PG8_SB(0, 0), b2, voffA);
            PG8_BAR; PG8_WAIT_L(0); PG8_MMA(0, 1, At, B1); PG8_BAR;
            PG8_LDA(At, 0, 1); PG8_STAGE(PG8_SA(0, 0), a2, voffA);
            PG8_BAR; PG8_WAIT_L(0); PG8_MMA(1, 0, At, B0); PG8_BAR; PG8_SCHED;
            PG8_STAGE(PG8_SB(0, 1), b2 + hstep, voffA);
            PG8_WAIT_V(6); PG8_BAR; PG8_MMA(1, 1, At, B1); PG8_BAR;
            PG8_LDB(B0, 1, 0); PG8_SCHED; PG8_LDA(At, 1, 0); PG8_STAGE(PG8_SA(0, 1), a2 + hstep, voffA);
            PG8_WAIT_L(8); PG8_BAR; PG8_WAIT_L(0); PG8_MMA(0, 0, At, B0); PG8_BAR; PG8_SCHED;
            PG8_LDB(B1, 1, 1); PG8_STAGE(PG8_SB(1, 0), b3, voffA);
            PG8_BAR; PG8_WAIT_L(0); PG8_MMA(0, 1, At, B1); PG8_BAR;
            PG8_LDA(At, 1, 1); PG8_STAGE(PG8_SA(1, 0), a3, voffA);
            PG8_BAR; PG8_WAIT_L(0); PG8_MMA(1, 0, At, B0); PG8_BAR; PG8_SCHED;
            PG8_STAGE(PG8_SB(1, 1), b3 + hstep, voffA);
            PG8_WAIT_V(6); PG8_BAR; PG8_MMA(1, 1, At, B1); PG8_BAR;
        }
        { const int t2 = otid(wv); const int l2 = t2 & 63, w2 = __builtin_amdgcn_readfirstlane(t2 >> 6); E(acc, cur, w2 >> 2, w2 & 3, l2 & 15, l2 >> 4); }
        if (!has_next) break;
#pragma unroll
        for (int a = 0; a < 2; ++a)
#pragma unroll
            for (int b = 0; b < 2; ++b)
#pragma unroll
                for (int m = 0; m < 4; ++m)
#pragma unroll
                    for (int n = 0; n < 2; ++n) acc[a][b][m][n] = (f32x4){0.f, 0.f, 0.f, 0.f};
        cur = nxt; cA = nA; cB = nB; ++ui;
    }
    PG8_WAIT_V(0);
    if (wr == 0) PG8_BAR;
    PG8_BAR;
#undef PG8_SA
#undef PG8_SB
#undef PG8_STAGE
#undef PG8_LDA
#undef PG8_LDB
#undef PG8_MMA
#undef PG8_WAIT_V
#undef PG8_WAIT_L
#undef PG8_BAR
#undef PG8_SCHED
}

struct EpiBf16 {
    bf16_t* O; int ldc;
    __device__ __forceinline__ void operator()(const f32x4 (&acc)[2][2][4][2], const Unit& u, int wr, int wc, int fr, int fq) const {
        const int row0 = u.pm * BM + wr * 64 + fr, col0 = u.pn * BM + wc * 32 + 4 * fq;
#pragma unroll
        for (int ai = 0; ai < 2; ++ai)
#pragma unroll
            for (int m = 0; m < 4; ++m) { bf16_t* rowp = O + (size_t)(row0 + ai * HALF + m * 16) * ldc + col0;
#pragma unroll
                for (int bj = 0; bj < 2; ++bj)
#pragma unroll
                    for (int n = 0; n < 2; ++n) { const f32x4 v = acc[ai][bj][m][n]; u32x2 w; w.x = cvt_pk_bf16(v[0], v[1]); w.y = cvt_pk_bf16(v[2], v[3]); *(u32x2*)(rowp + bj * HALF + n * 16) = w; } }
    }
};
struct EpiF32 {
    float* C; int ldc;
    __device__ __forceinline__ void operator()(const f32x4 (&acc)[2][2][4][2], const Unit& u, int wr, int wc, int fr, int fq) const {
        const int row0 = u.pm * BM + wr * 64 + fr, col0 = u.pn * BM + wc * 32 + 4 * fq;
#pragma unroll
        for (int ai = 0; ai < 2; ++ai)
#pragma unroll
            for (int m = 0; m < 4; ++m) { float* rowp = C + (size_t)(row0 + ai * HALF + m * 16) * ldc + col0;
#pragma unroll
                for (int bj = 0; bj < 2; ++bj)
#pragma unroll
                    for (int n = 0; n < 2; ++n) *(f32x4*)(rowp + bj * HALF + n * 16) = acc[ai][bj][m][n]; }
    }
};
struct EpiVT {
    bf16_t* VTs; bf16_t* VTp;
    __device__ __forceinline__ void operator()(const f32x4 (&acc)[2][2][4][2], const Unit& u, int wr, int wc, int fr, int fq) const {
        const int KR0 = u.pn * BM;
        bf16_t* vt; int Lk;
        if (KR0 < BS * LKS) { const int b = KR0 / LKS; Lk = LKS; vt = VTs + (size_t)b * 1024 * LKS + (KR0 - b * LKS); }
        else { const int b = (KR0 - BS * LKS) >> 8; Lk = LP; vt = VTp + (size_t)b * 1024 * LP; }
        const int row0 = u.pm * BM + wr * 64 + fr, col0 = wc * 32 + 4 * fq;
#pragma unroll
        for (int ai = 0; ai < 2; ++ai)
#pragma unroll
            for (int m = 0; m < 4; ++m) { bf16_t* rowp = vt + (size_t)(row0 + ai * HALF + m * 16) * Lk + col0;
#pragma unroll
                for (int bj = 0; bj < 2; ++bj)
#pragma unroll
                    for (int n = 0; n < 2; ++n) { const f32x4 v = acc[ai][bj][m][n]; u32x2 w; w.x = cvt_pk_bf16(v[0], v[1]); w.y = cvt_pk_bf16(v[2], v[3]); *(u32x2*)(rowp + bj * HALF + n * 16) = w; } }
    }
};
template <int P> struct EpiGate {
    const bf16_t* gates; float* m32; bf16_t* mbf;
    __device__ __forceinline__ void operator()(const f32x4 (&acc)[2][2][4][2], const Unit& u, int wr, int wc, int fr, int fq) const {
        const int row0 = u.pm * BM + wr * 64 + fr, col0 = u.pn * BM + wc * 32 + 4 * fq;
#pragma unroll
        for (int ai = 0; ai < 2; ++ai)
#pragma unroll
            for (int m = 0; m < 4; ++m) {
                const size_t row = (size_t)(row0 + ai * HALF + m * 16);
#pragma unroll
                for (int bj = 0; bj < 2; ++bj)
#pragma unroll
                    for (int n = 0; n < 2; ++n) {
                        const int col = col0 + bj * HALF + n * 16;
                        const u32x2 gw = *(const u32x2*)(gates + row * GATE_LD + P * 2048 + col);
                        f32x4 v = acc[ai][bj][m][n];
                        v[0] *= sigmoidf_(bf_lo(gw.x)); v[1] *= sigmoidf_(bf_hi(gw.x)); v[2] *= sigmoidf_(bf_lo(gw.y)); v[3] *= sigmoidf_(bf_hi(gw.y));
                        float* mp = m32 + row * 2048 + col;
                        if (P == 0) { *(f32x4*)mp = v; }
                        else if (P == 1) { const f32x4 o = *(const f32x4*)mp; *(f32x4*)mp = o + v; }
                        else { const f32x4 o = *(const f32x4*)mp; v = v + o; u32x2 w; w.x = cvt_pk_bf16(v[0], v[1]); w.y = cvt_pk_bf16(v[2], v[3]); *(u32x2*)(mbf + row * 2048 + col) = w; }
                    }
            }
    }
};
}

template <class Epi>
__device__ __forceinline__ void run_gemm(int wv, LAS unsigned char* lds, const bf16_t* A, const bf16_t* Bt, int M, int N, int K, const Epi& E) {
    pg8::Gemm g; g.A = A; g.Bt = Bt; g.M = M; g.N = N; g.K = K;
    pg8::StaticOrder S; S.init(M, N, (int)gridDim.x, obid());
    pg8::gemm_phase<Epi>(wv, lds, g, S, E);
    __syncthreads();
}

__device__ __forceinline__ void convT(int wv, const float* __restrict__ src, int K, int N, bf16_t* __restrict__ dst, int gate_shift, LAS unsigned char* lds) {
    const int tn = N / 64, tk = K / 64, ntile = tn * tk, tid = otid(wv);
    LAS bf16_t* T = (LAS bf16_t*)lds;
    for (int tile = obid(); tile < ntile; tile += gridDim.x) {
        const int tkk = tile / tn, tnn = tile - tkk * tn, k0 = tkk * 64, n0 = tnn * 64;
        const int kk = tid >> 4, n4 = (tid & 15) * 4;
#pragma unroll
        for (int half = 0; half < 2; ++half) {
            const int k = kk + half * 32;
            const f32x4 v = *(const f32x4*)(src + (size_t)(k0 + k) * N + n0 + n4);
#pragma unroll
            for (int i = 0; i < 4; ++i) T[(n4 + i) * 72 + k] = f2bf(v[i]);
        }
        __syncthreads();
        const int n = tid >> 3, kc = (tid & 7) * 8;
        int nd = n0 + n; if (gate_shift == 1 && nd >= NGATE0) nd += 192; if (gate_shift == 2) { const int hd = nd >> 8, wi = nd & 255; nd = (wi < 128) ? hd * 128 + wi : 1024 + hd * 128 + (wi - 128); }
        *(u32x4*)(dst + (size_t)nd * K + k0 + kc) = *(const LAS u32x4*)(T + n * 72 + kc);
        __syncthreads();
    }
}

__device__ __forceinline__ void ada_phase(int wv, const Params& p, LAS unsigned char* lds) {
    LAS float* sl = (LAS float*)lds;
    float* mod = (float*)(p.ws + S_MOD);
    const int tid = otid(wv);
    for (int u = obid(); u < NLAYER * 6 * 16; u += gridDim.x) {
        const int l = u / 96, r = u % 96, cb = r % 6, kc = r / 6, k0 = kc * 128;
        for (int i = tid; i < 9 * 128; i += NTHREADS) { const int v = i >> 7, k = i & 127; const float x = (v == 0) ? p.in[I_CCTX][k0 + k] : p.in[I_C][(v - 1) * DM + k0 + k]; sl[i] = siluf_(x); }
        __syncthreads();
        const int col = cb * 2048 + tid * 4;
        f32x4 acc[9];
#pragma unroll
        for (int i = 0; i < 9; ++i) acc[i] = (f32x4){0.f, 0.f, 0.f, 0.f};
        const float* wp = p.in[I_ADAW] + ((size_t)l * DM + k0) * 12288 + col;
#pragma unroll 8
        for (int k = 0; k < 128; ++k) {
            const f32x4 w = *(const f32x4*)(wp + (size_t)k * 12288);
#pragma unroll
            for (int i = 0; i < 9; ++i) acc[i] += sl[i * 128 + k] * w;
        }
#pragma unroll
        for (int i = 0; i < 9; ++i)
#pragma unroll
            for (int j = 0; j < 4; ++j) atomicAdd(mod + (size_t)(l * 9 + i) * 12288 + col + j, acc[i][j]);
        __syncthreads();
    }
}

__device__ __forceinline__ void filter_phase(int wv, const Params& p, int l, LAS unsigned char* lds) {
    LAS float* z = (LAS float*)lds;
    LAS float* H1 = z + 32 * 33;
    LAS float* H2 = H1 + 32 * 64;
    const int tid = otid(wv);
    const float* w1 = p.in[I_FW1] + (size_t)l * 33 * 64; const float* b1 = p.in[I_FB1] + l * 64;
    const float* w2 = p.in[I_FW2] + (size_t)l * 64 * 64; const float* b2 = p.in[I_FB2] + l * 64;
    const float* w3 = p.in[I_FW3] + (size_t)l * 64 * 2048; const float* b3 = p.in[I_FB3] + l * 2048;
    const float* fq = p.in[I_FFREQ] + l * 128;
    for (int u = obid(); u < 72; u += gridDim.x) {
        const int g = (u < 64) ? 1 : 0; const int tc = g ? u : u - 64; const int L = g ? LS : LP; const int t0 = tc * 32;
        float* kT = (float*)(p.ws + (g ? S_KTS : S_KTP)); float* part = (float*)(p.ws + (g ? S_PARTS : S_PARTP));
        for (int i = tid; i < 32 * 33; i += NTHREADS) {
            const int t = i / 33, e = i - t * 33; const float tf = (float)(t0 + t);
            float v;
            if (e == 0) v = tf / (float)(L - 1);
            else { const int k = (e - 1) & 15; const float band = 1e-4f + (float)k * ((15.0f - 1e-4f) / 15.0f); const float w = (6.283185307179586f * tf) / (float)L; const float ang = w * band;
                   v = (e <= 16) ? cosf(ang) : -sinf(ang); }
            z[i] = v;
        }
        __syncthreads();
        for (int i = tid; i < 32 * 64; i += NTHREADS) {
            const int t = i >> 6, j = i & 63; float s = b1[j];
            for (int e = 0; e < 33; ++e) s += z[t * 33 + e] * w1[e * 64 + j];
            H1[i] = sinf(fq[j] * s);
        }
        __syncthreads();
        for (int i = tid; i < 32 * 64; i += NTHREADS) {
            const int t = i >> 6, j = i & 63; float s = b2[j];
            for (int e = 0; e < 64; ++e) s += H1[t * 64 + e] * w2[e * 64 + j];
            H2[i] = sinf(fq[64 + j] * s);
        }
        __syncthreads();
        const int c = tid * 4;
        const f32x4 bias = *(const f32x4*)(b3 + c);
        f32x4 delta;
#pragma unroll
        for (int j = 0; j < 4; ++j) { const int d = (c + j) & 1023; const float mn = -3.0701134573253945f, mx = -15.350567286626973f; delta[j] = fabsf(mn + (float)d * ((mx - mn) / 1023.0f)); }
        f32x4 psum = (f32x4){0.f, 0.f, 0.f, 0.f};
        for (int tb = 0; tb < 4; ++tb) {
            f32x4 acc[8];
#pragma unroll
            for (int i = 0; i < 8; ++i) acc[i] = bias;
            for (int k = 0; k < 64; ++k) {
                const f32x4 w = *(const f32x4*)(w3 + (size_t)k * 2048 + c);
#pragma unroll
                for (int i = 0; i < 8; ++i) acc[i] += H2[(tb * 8 + i) * 64 + k] * w;
            }
#pragma unroll
            for (int i = 0; i < 8; ++i) {
                const int t = t0 + tb * 8 + i; const float tn = (float)t / (float)(L - 1);
#pragma unroll
                for (int j = 0; j < 4; ++j) {
                    const float v = acc[i][j] * __expf(-tn * delta[j]);
                    const int cc = c + j;
                    if (cc < 1024) { kT[(size_t)cc * (2 * L) + t] = v; psum[j] += fabsf(v); }
                    else { const int d = cc - 1024; if (t == 0) kT[(size_t)d * (2 * L) + L] = 0.f; else { kT[(size_t)d * (2 * L) + 2 * L - t] = v; psum[j] += fabsf(v); } }
                }
            }
        }
        *(f32x4*)(part + (size_t)tc * 2048 + c) = psum;
        __syncthreads();
    }
}

__device__ __forceinline__ void row_phase(int wv, const Params& p, int l, int mode) {
    const int tid = otid(wv); const int wave = obid() * 8 + (tid >> 6), nw = gridDim.x * 8, lane = tid & 63;
    float* X = p.out;
    bf16_t* H = (bf16_t*)(p.ws + A_H);
    const float* mod = (const float*)(p.ws + S_MOD);
    for (int row = wave; row < MT; row += nw) {
        const int mi = row < MP ? 0 : 1 + ((row - MP) >> 11);
        f32x4 x[8];
        const float* xs = (mode == 0) ? (row < MP ? p.in[I_XP] + (size_t)row * DM : p.in[I_XS] + (size_t)(row - MP) * DM) : X + (size_t)row * DM;
#pragma unroll
        for (int i = 0; i < 8; ++i) x[i] = *(const f32x4*)(xs + i * 256 + lane * 4);
        if (mode != 0) {
            const float* o = (const float*)(p.ws + (mode == 1 ? A_M32 : A_F32)) + (size_t)row * DM;
            f32x4 ov[8]; float ss = 0.f;
#pragma unroll
            for (int i = 0; i < 8; ++i) { ov[i] = *(const f32x4*)(o + i * 256 + lane * 4); ss += ov[i][0] * ov[i][0] + ov[i][1] * ov[i][1] + ov[i][2] * ov[i][2] + ov[i][3] * ov[i][3]; }
            ss = wave_sum(ss, lane);
            const float rstd = rsqrtf(ss * (1.0f / DM) + 1e-6f);
            const int gi = (mode == 1) ? 2 : 5;
            const float* gm = mod + (size_t)(l * 9 + mi) * 12288 + gi * 2048; const float* gb = p.in[I_ADAB] + (size_t)l * 12288 + gi * 2048;
            const float* pw = p.in[mode == 1 ? I_NMPOST : I_NFPOST] + l * DM;
#pragma unroll
            for (int i = 0; i < 8; ++i) {
                const int c = i * 256 + lane * 4;
                const f32x4 g = *(const f32x4*)(gm + c) + *(const f32x4*)(gb + c); const f32x4 w = *(const f32x4*)(pw + c);
                x[i] += g * (ov[i] * rstd * w);
            }
        }
        if (mode != 1 || true) {
#pragma unroll
            for (int i = 0; i < 8; ++i) *(f32x4*)(X + (size_t)row * DM + i * 256 + lane * 4) = x[i];
        }
        int l2, shi, sci; const float* prew; bool wh = true;
        if (mode == 0) { l2 = l; shi = 0; sci = 1; prew = p.in[I_NMPRE] + l * DM; }
        else if (mode == 1) { l2 = l; shi = 3; sci = 4; prew = p.in[I_NFPRE] + l * DM; }
        else { l2 = l + 1; shi = 0; sci = 1; wh = (l + 1 < NLAYER); prew = p.in[I_NMPRE] + (wh ? l2 : l) * DM; }
        if (wh) {
            float ss = 0.f;
#pragma unroll
            for (int i = 0; i < 8; ++i) ss += x[i][0] * x[i][0] + x[i][1] * x[i][1] + x[i][2] * x[i][2] + x[i][3] * x[i][3];
            ss = wave_sum(ss, lane);
            const float rstd = rsqrtf(ss * (1.0f / DM) + 1e-6f);
            const float* mb = mod + (size_t)(l2 * 9 + mi) * 12288; const float* ab = p.in[I_ADAB] + (size_t)l2 * 12288;
#pragma unroll
            for (int i = 0; i < 8; ++i) {
                const int c = i * 256 + lane * 4;
                const f32x4 sh = *(const f32x4*)(mb + shi * 2048 + c) + *(const f32x4*)(ab + shi * 2048 + c);
                const f32x4 sc = *(const f32x4*)(mb + sci * 2048 + c) + *(const f32x4*)(ab + sci * 2048 + c);
                const f32x4 w = *(const f32x4*)(prew + c);
                const f32x4 hv = (x[i] * rstd * w) * (1.0f + sc) + sh;
                u32x2 o; o.x = cvt_pk_bf16(hv[0], hv[1]); o.y = cvt_pk_bf16(hv[2], hv[3]);
                *(u32x2*)(H + (size_t)row * DM + c) = o;
            }
        }
    }
}

__device__ __forceinline__ void rope_table_phase(int wv, const Params& p) {
    float* C = (float*)(p.ws + S_ROPE); float* Sn = C + 2048 * 32;
    const int tid = otid(wv);
    for (int idx = obid() * NTHREADS + tid; idx < 2048 * 32; idx += gridDim.x * NTHREADS) {
        const int t = idx >> 5, i = idx & 31, k = i & 15;
        const float inv = exp2f(-(float)k * 0.8304820237218406f);
        const float pos = (i < 16) ? (float)(t >> 6) : (float)(t & 63);
        const float ang = pos * inv; C[idx] = cosf(ang); Sn[idx] = sinf(ang);
    }
}
__device__ __forceinline__ void e2_phase(int wv, const Params& p, int l, LAS unsigned char* lds) {
    const bf16_t* PA = (const bf16_t*)(p.ws + A_PROJA);
    const int tid = otid(wv), lane = tid & 63;
    {
        bf16_t* CQN = (bf16_t*)(p.ws + A_CQN); bf16_t* KC = (bf16_t*)(p.ws + A_KEYSC); bf16_t* KP = (bf16_t*)(p.ws + A_KPER);
        float* out_ckv = p.out + (size_t)MT * DM; float* out_kpe = out_ckv + (size_t)BP * NLAYER * LP * 256;
        const int wave = obid() * 8 + (tid >> 6), nw = gridDim.x * 8;
        for (int row = wave; row < MT + BS * PAST; row += nw) {
            if (row < MT) {
                const bf16_t* pr = PA + (size_t)row * PA_LD;
                { const u32x4 v = *(const u32x4*)(pr + 3072 + lane * 8); float f[8]; unpack8(v, f); float ss = 0.f;
#pragma unroll
                  for (int j = 0; j < 8; ++j) ss += f[j] * f[j];
                  ss = wave_sum(ss, lane); const float rstd = rsqrtf(ss * (1.0f / 512.0f) + 1e-6f);
                  const float* qn = p.in[I_QN] + l * 512 + lane * 8;
#pragma unroll
                  for (int j = 0; j < 8; ++j) f[j] = f[j] * rstd * qn[j];
                  *(u32x4*)(CQN + (size_t)row * 512 + lane * 8) = pack8(f); }
                int KR, t; const bool isp = row < MP; int b;
                if (isp) { b = row >> 8; t = row & 255; KR = BS * LKS + row; } else { const int r2 = row - MP; b = r2 >> 11; t = r2 & 2047; KR = b * LKS + t; }
                { const u32x2 v = *(const u32x2*)(pr + 3584 + lane * 4); float f[4] = {bf_lo(v.x), bf_hi(v.x), bf_lo(v.y), bf_hi(v.y)};
                  float ss = f[0] * f[0] + f[1] * f[1] + f[2] * f[2] + f[3] * f[3]; ss = wave_sum(ss, lane); const float rstd = rsqrtf(ss * (1.0f / 256.0f) + 1e-6f);
                  const float* kn = p.in[I_KVN] + l * 256 + lane * 4;
#pragma unroll
                  for (int j = 0; j < 4; ++j) f[j] = f[j] * rstd * kn[j];
                  if (isp) *(f32x4*)(out_ckv + ((size_t)(b * NLAYER + l) * LP + t) * 256 + lane * 4) = (f32x4){f[0], f[1], f[2], f[3]};
                  u32x2 w; w.x = cvt_pk_bf16(f[0], f[1]); w.y = cvt_pk_bf16(f[2], f[3]); *(u32x2*)(KC + (size_t)KR * 256 + lane * 4) = w; }
                { const float v = __uint_as_float(((unsigned)pr[3840 + lane]) << 16);
                  float o = v;
                  if (isp) out_kpe[((size_t)(b * NLAYER + l) * LP + t) * 64 + lane] = v;
                  else { const float pv = shx(v, 32, lane); const float* rc = (const float*)(p.ws + S_ROPE); const float cs = rc[t * 32 + (lane & 31)], sn = rc[2048 * 32 + t * 32 + (lane & 31)]; o = (lane < 32) ? (v * cs - pv * sn) : (pv * sn + v * cs); }
                  KP[(size_t)KR * 64 + lane] = f2bf(o); }
            } else {
                const int r2 = row - MT, b = r2 >> 9, j = r2 & 511; const int KR = b * LKS + LS + j;
                const float* cc = p.in[I_CCKV] + ((size_t)(b * NLAYER + l) * PAST + j) * 256 + lane * 4;
                const f32x4 v = *(const f32x4*)cc; u32x2 w; w.x = cvt_pk_bf16(v[0], v[1]); w.y = cvt_pk_bf16(v[2], v[3]); *(u32x2*)(KC + (size_t)KR * 256 + lane * 4) = w;
                KP[(size_t)KR * 64 + lane] = f2bf(p.in[I_CKPE][((size_t)(b * NLAYER + l) * PAST + j) * 64 + lane]);
            }
        }
    }
    {
        bf16_t* YC = (bf16_t*)(p.ws + A_YC); const float* scw = p.in[I_SCW] + (size_t)l * 3 * 1024;
        for (int it = obid() * NTHREADS + tid; it < MT * 128; it += gridDim.x * NTHREADS) {
            const int row = it >> 7, d0 = (it & 127) * 8;
            const int t = row < MP ? (row & 255) : ((row - MP) & 2047); const int L = row < MP ? LP : LS;
            const bf16_t* pr = PA + (size_t)row * PA_LD;
            float acc[8];
#pragma unroll
            for (int j = 0; j < 8; ++j) acc[j] = 0.f;
#pragma unroll
            for (int o = -1; o <= 1; ++o) {
                if (t + o < 0 || t + o >= L) continue;
                float cg[8], uu[8]; unpack8(*(const u32x4*)(pr + (long)o * PA_LD + 4928 + d0), cg); unpack8(*(const u32x4*)(pr + (long)o * PA_LD + 5952 + d0), uu);
                const float* w = scw + (o + 1) * 1024 + d0;
#pragma unroll
                for (int j = 0; j < 8; ++j) acc[j] += w[j] * (cg[j] * uu[j]);
            }
            float bg[8]; unpack8(*(const u32x4*)(pr + 3904 + d0), bg);
#pragma unroll
            for (int j = 0; j < 8; ++j) acc[j] *= bg[j];
            *(u32x4*)(YC + (size_t)row * 1024 + d0) = pack8(acc);
        }
    }
    {
        bf16_t* X0S = (bf16_t*)(p.ws + A_X0S); bf16_t* ZZT = (bf16_t*)(p.ws + A_ZZT);
        const float* hw = p.in[I_HCW] + (size_t)l * 3 * 3072; const float* hb = p.in[I_HCB] + (size_t)l * 3072;
        LAS bf16_t* zt = (LAS bf16_t*)lds;
        for (int u = obid(); u < (MT / 64) * 16; u += gridDim.x) {
            const int rt = u >> 4, dt = u & 15; const int row0 = rt * 64;
            const int tl = tid >> 3, dg = tid & 7, d0 = dt * 64 + dg * 8; const int row = row0 + tl;
            const int t = row < MP ? (row & 255) : ((row - MP) & 2047); const int L = row < MP ? LP : LS;
            const bf16_t* pr = PA + (size_t)row * PA_LD;
            float h0[8], h1[8], h2[8];
#pragma unroll
            for (int j = 0; j < 8; ++j) { h0[j] = hb[d0 + j]; h1[j] = hb[1024 + d0 + j]; h2[j] = hb[2048 + d0 + j]; }
#pragma unroll
            for (int o = -1; o <= 1; ++o) {
                if (t + o < 0 || t + o >= L) continue;
                float a[8], b[8], c[8];
                unpack8(*(const u32x4*)(pr + (long)o * PA_LD + d0), a); unpack8(*(const u32x4*)(pr + (long)o * PA_LD + 1024 + d0), b); unpack8(*(const u32x4*)(pr + (long)o * PA_LD + 2048 + d0), c);
                const float* w = hw + (o + 1) * 3072;
#pragma unroll
                for (int j = 0; j < 8; ++j) { h0[j] += w[d0 + j] * a[j]; h1[j] += w[1024 + d0 + j] * b[j]; h2[j] += w[2048 + d0 + j] * c[j]; }
            }
            *(u32x4*)(X0S + (size_t)row * 1024 + d0) = pack8(h0);
#pragma unroll
            for (int j = 0; j < 8; ++j) zt[(dg * 8 + j) * 72 + tl] = f2bf(h1[j] * h2[j]);
            __syncthreads();
            {
                const int dl = tid >> 3, tch = tid & 7; const int d = dt * 64 + dl;
                size_t base; int t0;
                if (row0 < MP) { const int b = row0 >> 8; t0 = row0 & 255; base = ((size_t)b * 1024 + d) * LP; }
                else { const int r2 = row0 - MP; const int b = r2 >> 11; t0 = r2 & 2047; base = (size_t)BP * 1024 * LP + ((size_t)b * 1024 + d) * LS; }
                *(u32x4*)(ZZT + base + t0 + tch * 8) = *(const LAS u32x4*)(zt + dl * 72 + tch * 8);
            }
            __syncthreads();
        }
    }
}

__device__ __forceinline__ void conv_phase(int wv, const Params& p, int l, LAS unsigned char* lds) {
    const int tid = otid(wv), wid = tid >> 6, lane = tid & 63, r = lane & 31, hh = lane >> 5;
    const bf16_t* ZZT = (const bf16_t*)(p.ws + A_ZZT); bf16_t* YCT = (bf16_t*)(p.ws + A_YCT);
    const float* hbias = p.in[I_HBIAS] + l * 1024;
    for (int u = obid(); u < 2048; u += gridDim.x) {
        const int g = (u < 1024) ? 1 : 0, d = u & 1023;
        const int L = g ? LS : LP, B = g ? BS : BP, L2 = 2 * L, NB = L / 32, NI = 32 / B, NT = NB / NI, lgB = g ? 3 : 4;
        const float* kT = (const float*)(p.ws + (g ? S_KTS : S_KTP)) + (size_t)d * L2;
        const float* part = (const float*)(p.ws + (g ? S_PARTS : S_PARTP));
        const int NU = g ? 64 : 8;
        float tot = 0.f;
        for (int i = 0; i < NU; ++i) tot += part[i * 2048 + d] + part[i * 2048 + 1024 + d];
        const float scale = 1.0f / tot; const float bias = hbias[d];
        LAS bf16_t* cp = (LAS bf16_t*)lds;
        LAS bf16_t* zz = (LAS bf16_t*)(lds + 65536);
        for (int idx = tid; idx < 8 * L2; idx += NTHREADS) {
            const int c = idx / L2, m = idx - c * L2; const int rpos = (m + c) & (L2 - 1); const int n = (L2 - rpos) & (L2 - 1);
            float v = kT[n] * scale; if (n == 0) v += bias;
            cp[idx] = f2bf(v);
        }
        const size_t zbase = g ? (size_t)BP * 1024 * LP : 0;
        for (int ch = tid; ch < B * L / 8; ch += NTHREADS) {
            const int b = ch / (L / 8), s8 = ch - b * (L / 8);
            *(LAS u32x4*)(zz + b * L + s8 * 8) = *(const u32x4*)(ZZT + zbase + ((size_t)b * 1024 + d) * L + s8 * 8);
        }
        __syncthreads();
        const int Iloc = r >> lgB, b = r & (B - 1);
        for (int nt = wid; nt < NT; nt += 8) {
            const int I0 = nt * NI;
            f32x16 acc;
#pragma unroll
            for (int i = 0; i < 16; ++i) acc[i] = 0.f;
            for (int dl = I0 - (NB - 1); dl <= I0 + NI - 1; ++dl) {
                const int J = I0 + Iloc - dl; const bool valid = (J >= 0) && (J < NB);
#pragma unroll
                for (int ks = 0; ks < 2; ++ks) {
                    const int i0 = (16 * ks + 8 * hh - 32 * dl - r) & (L2 - 1); const int c = i0 & 7, q = i0 >> 3;
                    const bf16x8 Af = *(const LAS bf16x8*)(cp + c * L2 + q * 8);
                    bf16x8 Bf = (bf16x8){0, 0, 0, 0, 0, 0, 0, 0};
                    if (valid) Bf = *(const LAS bf16x8*)(zz + b * L + 32 * J + 16 * ks + 8 * hh);
                    acc = __builtin_amdgcn_mfma_f32_32x32x16_bf16(Af, Bf, acc, 0, 0, 0);
                }
            }
            const int I = I0 + Iloc;
            bf16_t* op = YCT + zbase + ((size_t)b * 1024 + d) * L + 32 * I + 4 * hh;
#pragma unroll
            for (int g4 = 0; g4 < 4; ++g4) { u32x2 w; w.x = cvt_pk_bf16(acc[4 * g4], acc[4 * g4 + 1]); w.y = cvt_pk_bf16(acc[4 * g4 + 2], acc[4 * g4 + 3]); *(u32x2*)(op + 8 * g4) = w; }
        }
        __syncthreads();
    }
}

__device__ __forceinline__ void e3b_phase(int wv, const Params& p, LAS unsigned char* lds) {
    const int tid = otid(wv);
    const bf16_t* X0S = (const bf16_t*)(p.ws + A_X0S); const bf16_t* YCT = (const bf16_t*)(p.ws + A_YCT); bf16_t* YA = (bf16_t*)(p.ws + A_YA);
    LAS bf16_t* yt = (LAS bf16_t*)lds;
    for (int u = obid(); u < (MT / 64) * 16; u += gridDim.x) {
        const int rt = u >> 4, dt = u & 15; const int row0 = rt * 64;
        {
            const int dl = tid >> 3, tch = tid & 7; const int d = dt * 64 + dl;
            size_t base; int t0;
            if (row0 < MP) { const int b = row0 >> 8; t0 = row0 & 255; base = ((size_t)b * 1024 + d) * LP; }
            else { const int r2 = row0 - MP; const int b = r2 >> 11; t0 = r2 & 2047; base = (size_t)BP * 1024 * LP + ((size_t)b * 1024 + d) * LS; }
            const u32x4 v = *(const u32x4*)(YCT + base + t0 + tch * 8);
            const unsigned w[4] = {v.x, v.y, v.z, v.w};
#pragma unroll
            for (int j = 0; j < 4; ++j) { yt[(tch * 8 + 2 * j) * 72 + dl] = (bf16_t)(w[j] & 0xffffu); yt[(tch * 8 + 2 * j + 1) * 72 + dl] = (bf16_t)(w[j] >> 16); }
        }
        __syncthreads();
        {
            const int tl = tid >> 3, dg = tid & 7; const int row = row0 + tl, d0 = dt * 64 + dg * 8;
            float a[8], b[8]; unpack8(*(const LAS u32x4*)(yt + tl * 72 + dg * 8), a); unpack8(*(const u32x4*)(X0S + (size_t)row * 1024 + d0), b);
#pragma unroll
            for (int j = 0; j < 8; ++j) a[j] *= b[j];
            *(u32x4*)(YA + (size_t)row * 1024 + d0) = pack8(a);
        }
        __syncthreads();
    }
}

__device__ __forceinline__ void attn_phase(int wv, const Params& p, LAS unsigned char* lds) {
    const bf16_t* Q = (const bf16_t*)(p.ws + A_Q); const bf16_t* KN = (const bf16_t*)(p.ws + A_KN); const bf16_t* KP = (const bf16_t*)(p.ws + A_KPER);
    const bf16_t* VT = (const bf16_t*)(p.ws + A_VT); bf16_t* O = (bf16_t*)(p.ws + A_OATT);
    LAS unsigned char* Ks = lds;
    LAS unsigned char* Vs = lds + 64 * 400;
    const float sc2 = 0.07216878364870322f * 1.4426950408889634f;
    for (int u = obid(); u < 512 + 128; u += gridDim.x) {
        const int tid = otid(wv), wid = tid >> 6, lane = tid & 63, r = lane & 31, hh = lane >> 5;
        int b, h, row0, Lk, KR0; size_t vtb; bool samp;
        if (u < 512) { samp = true; b = u >> 6; h = (u >> 3) & 7; const int qb = u & 7; row0 = MP + b * LS + qb * 256; Lk = LKS; KR0 = b * LKS; vtb = (size_t)(b * 8 + h) * 128 * LKS; }
        else { samp = false; const int u2 = u - 512; b = u2 >> 3; h = u2 & 7; row0 = b * LP; Lk = LP; KR0 = BS * LKS + b * LP; vtb = (size_t)BS * 8 * 128 * LKS + (size_t)(b * 8 + h) * 128 * LP; }
        const int qrow = row0 + wid * 32 + r;
        bf16x8 qf[12];
        {
            const bf16_t* qp = Q + (size_t)qrow * 1536 + h * 192 + 8 * hh;
            u32x4 qv[12];
#pragma unroll
            for (int s = 0; s < 12; ++s) qv[s] = *(const u32x4*)(qp + 16 * s);
            if (samp) {
                const int t = (qrow - MP) & 2047;
#pragma unroll
                for (int s2 = 0; s2 < 2; ++s2) {
                    float x1[8], x2[8]; unpack8(qv[8 + s2], x1); unpack8(qv[10 + s2], x2);
                    const float* rc = (const float*)(p.ws + S_ROPE) + t * 32 + 16 * s2 + 8 * hh;
                    const f32x4 c0 = *(const f32x4*)rc, c1 = *(const f32x4*)(rc + 4), s0 = *(const f32x4*)(rc + 2048 * 32), s1 = *(const f32x4*)(rc + 2048 * 32 + 4);
#pragma unroll
                    for (int j = 0; j < 8; ++j) { const float cs = (j < 4) ? c0[j & 3] : c1[j & 3], sn = (j < 4) ? s0[j & 3] : s1[j & 3]; const float a = x1[j], c = x2[j]; x1[j] = a * cs - c * sn; x2[j] = a * sn + c * cs; }
                    qv[8 + s2] = pack8(x1); qv[10 + s2] = pack8(x2);
                }
            }
#pragma unroll
            for (int s = 0; s < 12; ++s) qf[s] = __builtin_bit_cast(bf16x8, qv[s]);
        }
        f32x16 oacc[4];
#pragma unroll
        for (int ct = 0; ct < 4; ++ct)
#pragma unroll
            for (int i = 0; i < 16; ++i) oacc[ct][i] = 0.f;
        float mrun = -1e30f, lrun = 0.f;
        const int nkt = Lk / 64;
        u32x4 kst[3], vst[2];
#pragma unroll
        for (int i = 0; i < 3; ++i) { const int ck = tid + i * NTHREADS; const int key = ck / 24, part = ck - key * 24;
            kst[i] = (part < 16) ? *(const u32x4*)(KN + (size_t)(KR0 + key) * 1024 + h * 128 + part * 8) : *(const u32x4*)(KP + (size_t)(KR0 + key) * 64 + (part - 16) * 8); }
#pragma unroll
        for (int i = 0; i < 2; ++i) { const int cv = tid + i * NTHREADS; const int v = cv >> 3, kc = cv & 7; vst[i] = *(const u32x4*)(VT + vtb + (size_t)v * Lk + kc * 8); }
        for (int kt = 0; kt < nkt; ++kt) {
            __syncthreads();
#pragma unroll
            for (int i = 0; i < 3; ++i) { const int ck = tid + i * NTHREADS; const int key = ck / 24, part = ck - key * 24; *(LAS u32x4*)(Ks + key * 400 + part * 16) = kst[i]; }
#pragma unroll
            for (int i = 0; i < 2; ++i) { const int cv = tid + i * NTHREADS; const int v = cv >> 3, kc = cv & 7; *(LAS u32x4*)(Vs + v * 144 + kc * 16) = vst[i]; }
            __syncthreads();
            if (kt + 1 < nkt) {
                const int k0 = (kt + 1) * 64;
#pragma unroll
                for (int i = 0; i < 3; ++i) { const int ck = tid + i * NTHREADS; const int key = ck / 24, part = ck - key * 24;
                    kst[i] = (part < 16) ? *(const u32x4*)(KN + (size_t)(KR0 + k0 + key) * 1024 + h * 128 + part * 8) : *(const u32x4*)(KP + (size_t)(KR0 + k0 + key) * 64 + (part - 16) * 8); }
#pragma unroll
                for (int i = 0; i < 2; ++i) { const int cv = tid + i * NTHREADS; const int v = cv >> 3, kc = cv & 7; vst[i] = *(const u32x4*)(VT + vtb + (size_t)v * Lk + k0 + kc * 8); }
            }
            f32x16 sacc[2];
#pragma unroll
            for (int kk = 0; kk < 2; ++kk) {
#pragma unroll
                for (int i = 0; i < 16; ++i) sacc[kk][i] = 0.f;
#pragma unroll
                for (int s = 0; s < 12; ++s) {
                    const bf16x8 kf = *(const LAS bf16x8*)(Ks + (32 * kk + r) * 400 + (16 * s + 8 * hh) * 2);
                    sacc[kk] = __builtin_amdgcn_mfma_f32_32x32x16_bf16(kf, qf[s], sacc[kk], 0, 0, 0);
                }
            }
            float mx = sacc[0][0];
#pragma unroll
            for (int kk = 0; kk < 2; ++kk)
#pragma unroll
                for (int i = 0; i < 16; ++i) mx = fmaxf(mx, sacc[kk][i]);
            mx = fmaxf(mx, shx(mx, 32, lane));
            const float mnew = fmaxf(mrun, mx);
            const float alpha = __builtin_amdgcn_exp2f((mrun - mnew) * sc2);
            mrun = mnew;
            float ps = 0.f;
#pragma unroll
            for (int kk = 0; kk < 2; ++kk)
#pragma unroll
                for (int i = 0; i < 16; ++i) { const float pv = __builtin_amdgcn_exp2f((sacc[kk][i] - mnew) * sc2); sacc[kk][i] = pv; ps += pv; }
            lrun = lrun * alpha + ps;
#pragma unroll
            for (int ct = 0; ct < 4; ++ct)
#pragma unroll
                for (int i = 0; i < 16; ++i) oacc[ct][i] *= alpha;
#pragma unroll
            for (int ks = 0; ks < 4; ++ks) {
                const int kk = ks >> 1, s2 = ks & 1;
                u32x4 pw;
                pw.x = cvt_pk_bf16(sacc[kk][8 * s2 + 0], sacc[kk][8 * s2 + 1]); pw.y = cvt_pk_bf16(sacc[kk][8 * s2 + 2], sacc[kk][8 * s2 + 3]);
                pw.z = cvt_pk_bf16(sacc[kk][8 * s2 + 4], sacc[kk][8 * s2 + 5]); pw.w = cvt_pk_bf16(sacc[kk][8 * s2 + 6], sacc[kk][8 * s2 + 7]);
                const bf16x8 pf = __builtin_bit_cast(bf16x8, pw);
#pragma unroll
                for (int ct = 0; ct < 4; ++ct) {
                    const LAS unsigned char* vp = Vs + (32 * ct + r) * 144 + (32 * kk + 16 * s2 + 4 * hh) * 2;
                    const u32x2 lo = *(const LAS u32x2*)vp, hi = *(const LAS u32x2*)(vp + 16);
                    u32x4 vw; vw.x = lo.x; vw.y = lo.y; vw.z = hi.x; vw.w = hi.y;
                    oacc[ct] = __builtin_amdgcn_mfma_f32_32x32x16_bf16(__builtin_bit_cast(bf16x8, vw), pf, oacc[ct], 0, 0, 0);
                }
            }
        }
        lrun += shx(lrun, 32, lane);
        const float invl = 1.0f / lrun;
        const int tid2 = otid(wv); const int qrow2 = row0 + (tid2 >> 6) * 32 + (tid2 & 31);
        bf16_t* op = O + (size_t)qrow2 * 1024 + h * 128 + 4 * ((tid2 >> 5) & 1);
#pragma unroll
        for (int ct = 0; ct < 4; ++ct)
#pragma unroll
            for (int g4 = 0; g4 < 4; ++g4) {
                u32x2 w; w.x = cvt_pk_bf16(oacc[ct][4 * g4] * invl, oacc[ct][4 * g4 + 1] * invl); w.y = cvt_pk_bf16(oacc[ct][4 * g4 + 2] * invl, oacc[ct][4 * g4 + 3] * invl);
                *(u32x2*)(op + 32 * ct + 8 * g4) = w;
            }
        __syncthreads();
    }
}

__device__ __forceinline__ void e9_phase(int wv, const Params& p, int l) {
    const bf16_t* UU = (const bf16_t*)(p.ws + A_UU); bf16_t* ACT = (bf16_t*)(p.ws + A_ACT);
    const float* cw = p.in[I_FCW] + (size_t)l * 3 * UU_LD; const float* cb = p.in[I_FCB] + (size_t)l * UU_LD;
    const int tid9 = otid(wv);
    for (int it = obid() * NTHREADS + tid9; it < MT * (DFF / 8); it += gridDim.x * NTHREADS) {
        const int row = it / (DFF / 8), c0 = (it - row * (DFF / 8)) * 8;
        const int t = row < MP ? (row & 255) : ((row - MP) & 2047); const int L = row < MP ? LP : LS;
        const bf16_t* pr = UU + (size_t)row * UU_LD;
        float ga[8], va[8];
#pragma unroll
        for (int j = 0; j < 8; ++j) { ga[j] = cb[c0 + j]; va[j] = cb[DFF + c0 + j]; }
#pragma unroll
        for (int o = -1; o <= 1; ++o) {
            if (t + o < 0 || t + o >= L) continue;
            float a[8], b[8]; unpack8(*(const u32x4*)(pr + (long)o * UU_LD + c0), a); unpack8(*(const u32x4*)(pr + (long)o * UU_LD + DFF + c0), b);
            const float* w = cw + (o + 1) * UU_LD;
#pragma unroll
            for (int j = 0; j < 8; ++j) { ga[j] += w[c0 + j] * a[j]; va[j] += w[DFF + c0 + j] * b[j]; }
        }
#pragma unroll
        for (int j = 0; j < 8; ++j) ga[j] = siluf_(ga[j]) * va[j];
        *(u32x4*)(ACT + (size_t)row * DFF + c0) = pack8(ga);
    }
}

__device__ __forceinline__ void convert_layer(int wv, const Params& p, int l, LAS unsigned char* lds) {
    unsigned char* ws = p.ws;
    convT(wv, p.in[I_WIN] + (size_t)l * DM * NIN, DM, NIN, (bf16_t*)(ws + W_IN), 1, lds);
    convT(wv, p.in[I_WUQ] + (size_t)l * 512 * 1536, 512, 1536, (bf16_t*)(ws + W_UQ), 0, lds);
    convT(wv, p.in[I_WUKV] + (size_t)l * 256 * 2048, 256, 2048, (bf16_t*)(ws + W_UKV), 2, lds);
    convT(wv, p.in[I_WBRA] + (size_t)l * 1024 * 2048, 1024, 2048, (bf16_t*)(ws + W_BRA), 0, lds);
    convT(wv, p.in[I_WBRB] + (size_t)l * 1024 * 2048, 1024, 2048, (bf16_t*)(ws + W_BRB), 0, lds);
    convT(wv, p.in[I_WBRC] + (size_t)l * 1024 * 2048, 1024, 2048, (bf16_t*)(ws + W_BRC), 0, lds);
    convT(wv, p.in[I_WO] + (size_t)l * 2048 * 2048, 2048, 2048, (bf16_t*)(ws + W_O), 0, lds);
    convT(wv, p.in[I_FUP] + (size_t)l * 2048 * UU_LD, 2048, UU_LD, (bf16_t*)(ws + W_UP), 0, lds);
    convT(wv, p.in[I_FDN] + (size_t)l * DFF * 2048, DFF, 2048, (bf16_t*)(ws + W_DN), 0, lds);
}

namespace pg8 {
struct EpiGateRT {
    const bf16_t* gates; float* m32; bf16_t* mbf; int P;
    __device__ __forceinline__ void operator()(const f32x4 (&acc)[2][2][4][2], const Unit& u, int wr, int wc, int fr, int fq) const {
        const int row0 = u.pm * BM + wr * 64 + fr, col0 = u.pn * BM + wc * 32 + 4 * fq;
#pragma unroll
        for (int ai = 0; ai < 2; ++ai)
#pragma unroll
            for (int m = 0; m < 4; ++m) {
                const size_t row = (size_t)(row0 + ai * HALF + m * 16);
#pragma unroll
                for (int bj = 0; bj < 2; ++bj)
#pragma unroll
                    for (int n = 0; n < 2; ++n) {
                        const int col = col0 + bj * HALF + n * 16;
                        const u32x2 gw = *(const u32x2*)(gates + row * GATE_LD + P * 2048 + col);
                        f32x4 v = acc[ai][bj][m][n];
                        v[0] *= sigmoidf_(bf_lo(gw.x)); v[1] *= sigmoidf_(bf_hi(gw.x)); v[2] *= sigmoidf_(bf_lo(gw.y)); v[3] *= sigmoidf_(bf_hi(gw.y));
                        float* mp = m32 + row * 2048 + col;
                        if (P != 0) { const f32x4 o = *(const f32x4*)mp; v = v + o; }
                        if (P != 2) { *(f32x4*)mp = v; }
                        else { u32x2 w; w.x = cvt_pk_bf16(v[0], v[1]); w.y = cvt_pk_bf16(v[2], v[3]); *(u32x2*)(mbf + row * 2048 + col) = w; }
                    }
            }
    }
};
}


#define XB_TMO      128
#define XB_XCNT(j)  (256  + 64 * (j))
#define XB_XSUB(j)  (1280 + 64 * (j))
#define XB_XGEN(j)  (2304 + 64 * (j))
#define XB_TOP      3328
#define XB_TOPGEN   3392
#define XCD_BAR_WORDS 3456
#define XB_SPIN_CAP (1u << 20)
__device__ __forceinline__ unsigned xb_ld(unsigned* p)              { return __hip_atomic_load(p, __ATOMIC_RELAXED, __HIP_MEMORY_SCOPE_AGENT); }
__device__ __forceinline__ unsigned xb_add(unsigned* p, unsigned v) { return __hip_atomic_fetch_add(p, v, __ATOMIC_RELAXED, __HIP_MEMORY_SCOPE_AGENT); }
__device__ __forceinline__ unsigned xb_xcc_id() { return (unsigned)__builtin_amdgcn_s_getreg((3 << 11) | 20) & 0xFu; }
#define XB_SPIN(cond, bar) do { unsigned _sp = 0; while (cond) { __builtin_amdgcn_s_sleep(1); \
    if ((++_sp & 255u) == 0u) { if (xb_ld(&(bar)[XB_TMO])) break; if (_sp > XB_SPIN_CAP) { atomicAdd(&(bar)[XB_TMO], 1u); break; } } } } while (0)
__device__ __forceinline__ void xcd_barrier_complete(unsigned* bar, unsigned x, unsigned& nloc, unsigned& nx) {
    const unsigned G = gridDim.x;
    unsigned sum, cnt, mine, sp = 0u;
    for (;;) {
        sum = 0u; cnt = 0u; mine = 0u;
#pragma unroll
        for (unsigned j = 0; j < 16; ++j) { const unsigned c = xb_ld(&bar[XB_XCNT(j)]); sum += c; cnt += (c > 0u) ? 1u : 0u; mine = (j == x) ? c : mine; }
        if (sum == G) break;
        __builtin_amdgcn_s_sleep(1);
        if ((++sp & 255u) == 0u) { if (xb_ld(&bar[XB_TMO])) break; if (sp > XB_SPIN_CAP) { atomicAdd(&bar[XB_TMO], 1u); break; } }
    }
    nloc = mine > 0u ? mine : 1u; nx = cnt > 0u ? cnt : 1u;
}
__device__ __forceinline__ void xcd_barrier(int wv, unsigned* bar, volatile LAS unsigned* st) {
    asm volatile("s_waitcnt vmcnt(0)" ::: "memory");
    __syncthreads();
    if (otid(wv) == 0) {
        __builtin_amdgcn_s_waitcnt(0);
        const unsigned x = xb_xcc_id();
        unsigned nloc = st[0], nx = st[1];
        if (nloc == 0u) { xcd_barrier_complete(bar, x, nloc, nx); st[0] = nloc; st[1] = nx; }
        const unsigned old = xb_add(&bar[XB_XSUB(x)], 1u);
        const unsigned gen = old / nloc;
        if (old + 1u == (gen + 1u) * nloc) {
            __builtin_amdgcn_fence(__ATOMIC_RELEASE, "agent");
            asm volatile("s_waitcnt vmcnt(0)" ::: "memory");
            const unsigned og = xb_add(&bar[XB_TOP], 1u);
            const unsigned tg = og / nx;
            if (og + 1u == (tg + 1u) * nx) xb_add(&bar[XB_TOPGEN], 1u);
            else XB_SPIN(xb_ld(&bar[XB_TOPGEN]) == tg, bar);
            __builtin_amdgcn_fence(__ATOMIC_ACQUIRE, "agent");
            xb_add(&bar[XB_XGEN(x)], 1u);
            asm volatile("s_waitcnt vmcnt(0)" ::: "memory");
        } else {
            XB_SPIN(xb_ld(&bar[XB_XGEN(x)]) == gen, bar);
            __builtin_amdgcn_fence(__ATOMIC_ACQUIRE, "agent");
            asm volatile("s_waitcnt vmcnt(0)" ::: "memory");
        }
    }
    __syncthreads();
}

#ifndef REP_GEMM
#define REP_GEMM 1
#endif
#ifndef REP_ATTN
#define REP_ATTN 1
#endif
#ifndef REP_CONV
#define REP_CONV 1
#endif
#ifndef REP_ELT
#define REP_ELT 1
#endif
#ifndef REP_CVT
#define REP_CVT 1
#endif
enum { K_G1A = 0, K_E2, K_I3, K_I4, K_G1B, K_G5, K_G6, K_ROW1, K_G8, K_E9, K_G10, K_ROW2, K_PRO, K_ROW0 };

__global__ void __launch_bounds__(NTHREADS) fwd_megakernel(Params p) {
    extern __shared__ __attribute__((aligned(16))) unsigned char shm[];
    LAS unsigned char* lds = (LAS unsigned char*)shm;
    cg::grid_group grid = cg::this_grid();
    const int wv = __builtin_amdgcn_readfirstlane((int)(threadIdx.x >> 6));
    volatile LAS unsigned* bst = (volatile LAS unsigned*)(lds + 131072);
    unsigned* bar = (unsigned*)(p.ws + S_BAR);
    if (threadIdx.x == 0) { bst[0] = 0u; bst[1] = 0u; bst[2] = 0u; bst[3] = 0u; (void)xb_add(&bar[XB_XCNT(xb_xcc_id())], 1u); }
    __syncthreads();
#pragma unroll 1
    for (int ph = 0; ph < 2 + 12 * NLAYER; ++ph) {
        int kind, l;
        if (ph == 0) { kind = K_PRO; l = 0; } else if (ph == 1) { kind = K_ROW0; l = 0; } else { l = (ph - 2) / 12; kind = (ph - 2) - l * 12; }
        unsigned char* ws = p.ws;
        asm volatile("" : "+s"(ws));
        if (kind == K_G1A || kind == K_I3 || kind == K_G1B || kind == K_G8) {
            const bf16_t* A; const bf16_t* Bt; bf16_t* O; int N, K;
            if (kind == K_G1A) { A = (const bf16_t*)(ws + A_H); Bt = (const bf16_t*)(ws + W_IN); O = (bf16_t*)(ws + A_PROJA); N = PA_LD; K = DM; }
            else if (kind == K_I3) { A = (const bf16_t*)(ws + A_CQN); Bt = (const bf16_t*)(ws + W_UQ); O = (bf16_t*)(ws + A_Q); N = 1536; K = 512; }
            else if (kind == K_G1B) { A = (const bf16_t*)(ws + A_H); Bt = (const bf16_t*)(ws + W_IN) + (size_t)PA_LD * DM; O = (bf16_t*)(ws + A_GATES); N = GATE_LD; K = DM; }
            else { A = (const bf16_t*)(ws + A_H); Bt = (const bf16_t*)(ws + W_UP); O = (bf16_t*)(ws + A_UU); N = UU_LD; K = DM; }
            int Mr = MT;
            const int nrep = ((kind == K_I3) ? 2 : 1) * REP_GEMM;
#pragma unroll 1
            for (int rp = 0; rp < nrep; ++rp) {
                if (kind == K_I3 && rp >= REP_GEMM) { A = (const bf16_t*)(ws + A_KEYSC); Bt = (const bf16_t*)(ws + W_UKV); O = (bf16_t*)(ws + A_KN); N = 1024; K = 256; Mr = KROWS; }
                run_gemm(wv, lds, A, Bt, Mr, N, K, pg8::EpiBf16{O, N});
            }
        }
        if (kind == K_I3) {
#pragma unroll 1
            for (int rp = 0; rp < REP_GEMM; ++rp)
            run_gemm(wv, lds, (const bf16_t*)(ws + W_UKV) + (size_t)1024 * 256, (const bf16_t*)(ws + A_KEYSC), 1024, KROWS, 256,
                     pg8::EpiVT{(bf16_t*)(ws + A_VT), (bf16_t*)(ws + A_VT) + (size_t)BS * 8 * 128 * LKS});
#pragma unroll 1
            for (int rp = 0; rp < REP_CONV; ++rp) conv_phase(wv, p, l, lds);
        }
        if (kind == K_I4) {
#pragma unroll 1
            for (int rp = 0; rp < REP_ATTN; ++rp) attn_phase(wv, p, lds);
#pragma unroll 1
            for (int rp = 0; rp < REP_ELT; ++rp) e3b_phase(wv, p, lds); }
        if (kind == K_G5) {
#pragma unroll 1
            for (int P3 = 0; P3 < 3 * REP_GEMM; ++P3) { const int P = P3 % 3;
                const bf16_t* A = (const bf16_t*)(ws + (P == 0 ? A_YA : (P == 1 ? A_OATT : A_YC)));
                const bf16_t* Bt = (const bf16_t*)(ws + (P == 0 ? W_BRA : (P == 1 ? W_BRB : W_BRC)));
                run_gemm(wv, lds, A, Bt, MT, DM, 1024, pg8::EpiGateRT{(const bf16_t*)(ws + A_GATES), (float*)(ws + A_M32), (bf16_t*)(ws + A_MBF), P});
            }
        }
        if (kind == K_G6 || kind == K_G10) {
            const bool g6 = (kind == K_G6);
#pragma unroll 1
            for (int rp = 0; rp < REP_GEMM; ++rp)
            run_gemm(wv, lds, (const bf16_t*)(ws + (g6 ? A_MBF : A_ACT)), (const bf16_t*)(ws + (g6 ? W_O : W_DN)), MT, DM, g6 ? DM : DFF, pg8::EpiF32{(float*)(ws + (g6 ? A_M32 : A_F32)), DM});
        }
        if (kind == K_E2) {
#pragma unroll 1
            for (int rp = 0; rp < REP_ELT; ++rp) e2_phase(wv, p, l, lds); }
        if (kind == K_E9) {
#pragma unroll 1
            for (int rp = 0; rp < REP_ELT; ++rp) e9_phase(wv, p, l); }
        if (kind == K_ROW0 || kind == K_ROW1 || kind == K_ROW2) row_phase(wv, p, l, kind == K_ROW0 ? 0 : (kind == K_ROW1 ? 1 : 2));
        if (kind == K_PRO) { ada_phase(wv, p, lds); rope_table_phase(wv, p); }
        if (kind == K_PRO || (kind == K_ROW2 && l + 1 < NLAYER)) { const int ln = (kind == K_PRO) ? 0 : l + 1;
#pragma unroll 1
            for (int rp = 0; rp < REP_CVT; ++rp) { filter_phase(wv, p, ln, lds); convert_layer(wv, p, ln, lds); } }
        if (ph == 0) grid.sync(); else xcd_barrier(wv, bar, bst);
    }
}

extern "C" void kernel_launch(void* const* d_in, const int* in_sizes, int n_in, void* d_out, int out_size, void* d_ws, size_t ws_size, hipStream_t stream) {
    static int grid_blocks = 0;
    if (grid_blocks == 0) {
        if (n_in != N_INPUTS || ws_size < WS_NEED) { fprintf(stderr, "kernel_launch: need %d inputs and %zu bytes of workspace; got %d, %zu\n", N_INPUTS, (size_t)WS_NEED, n_in, ws_size); grid_blocks = -1; return; }
        int dev = 0, cus = 0, per_cu = 0;
        hipGetDevice(&dev);
        hipDeviceGetAttribute(&cus, hipDeviceAttributeMultiprocessorCount, dev);
        if (hipFuncSetAttribute((const void*)fwd_megakernel, hipFuncAttributeMaxDynamicSharedMemorySize, LDS_BYTES) != hipSuccess) { fprintf(stderr, "kernel_launch: hipFuncSetAttribute failed\n"); grid_blocks = -1; return; }
        if (hipOccupancyMaxActiveBlocksPerMultiprocessor(&per_cu, (const void*)fwd_megakernel, NTHREADS, LDS_BYTES) != hipSuccess || per_cu < 1) { fprintf(stderr, "kernel_launch: occupancy query gave %d\n", per_cu); per_cu = 1; }
        (void)hipGetLastError();
        grid_blocks = cus * 1;
    }
    if (grid_blocks < 0) return;
    (void)hipMemsetAsync((unsigned char*)d_ws + S_MOD, 0, SZ_MOD, stream);
    (void)hipMemsetAsync((unsigned char*)d_ws + S_BAR, 0, 16384, stream);
    Params p{};
    for (int i = 0; i < N_INPUTS; ++i) p.in[i] = (const float*)d_in[i];
    p.out = (float*)d_out; p.ws = (unsigned char*)d_ws;
    void* args[] = {&p};
    hipError_t e = hipLaunchCooperativeKernel((const void*)fwd_megakernel, dim3(grid_blocks), dim3(NTHREADS), args, LDS_BYTES, stream);
    if (e != hipSuccess) fprintf(stderr, "cooperative launch failed: %s (grid %d)\n", hipGetErrorString(e), grid_blocks);
}
```

```cpp
#include <hip/hip_runtime.h>
#include <hip/hip_cooperative_groups.h>
#include <cstdio>
namespace cg = cooperative_groups;

#define LAS __attribute__((address_space(3)))
typedef unsigned short bf16_t;
typedef short bf16x8 __attribute__((ext_vector_type(8)));
typedef float f32x4 __attribute__((ext_vector_type(4)));
typedef float f32x16 __attribute__((ext_vector_type(16)));
typedef unsigned u32x4 __attribute__((ext_vector_type(4)));
typedef unsigned u32x2 __attribute__((ext_vector_type(2)));

constexpr int DM = 2048, MP = 4096, MS = 16384, MT = 20480, NLAYER = 2;
constexpr int LP = 256, LS = 2048, BP = 16, BS = 8, PAST = 512, LKS = 2560;
constexpr int NIN = 13120, NGATE0 = 6976, PA_LD = 7168, GATE_LD = 6144;
constexpr int DFF = 5632, UU_LD = 11264;
constexpr int KROWS = 24576;
constexpr int NTHREADS = 512;
constexpr int LDS_BYTES = 131072 + 16;

enum { I_XP = 0, I_XS, I_C, I_CCKV, I_CKPE, I_CCTX, I_ADAW, I_ADAB, I_NMPRE, I_NMPOST, I_NFPRE, I_NFPOST, I_WIN, I_HCW, I_HCB,
       I_FW1, I_FB1, I_FW2, I_FB2, I_FW3, I_FB3, I_FFREQ, I_HBIAS, I_QN, I_KVN, I_WUQ, I_WUKV, I_SCW, I_WBRA, I_WBRB, I_WBRC,
       I_WO, I_FUP, I_FCW, I_FCB, I_FDN, N_INPUTS };

constexpr size_t E_WIN = (size_t)13312 * 2048, E_WUQ = (size_t)1536 * 512, E_WUKV = (size_t)2048 * 256, E_WBR = (size_t)2048 * 1024,
                 E_WO = (size_t)2048 * 2048, E_WUP = (size_t)11264 * 2048, E_WDN = (size_t)2048 * 5632;
constexpr size_t W_IN = 0, W_UQ = W_IN + E_WIN * 2, W_UKV = W_UQ + E_WUQ * 2, W_BRA = W_UKV + E_WUKV * 2, W_BRB = W_BRA + E_WBR * 2,
                 W_BRC = W_BRB + E_WBR * 2, W_O = W_BRC + E_WBR * 2, W_UP = W_O + E_WO * 2, W_DN = W_UP + E_WUP * 2, W_END = W_DN + E_WDN * 2;
constexpr size_t S_MOD = W_END, SZ_MOD = (size_t)NLAYER * 16 * 9 * 12288 * 4;
constexpr size_t S_KTS = S_MOD + SZ_MOD, S_KTP = S_KTS + (size_t)1024 * 4096 * 4, S_PARTS = S_KTP + (size_t)1024 * 512 * 4,
                 S_PARTP = S_PARTS + (size_t)64 * 2048 * 4, S_ROPE = S_PARTP + (size_t)8 * 2048 * 4, S_BAR = S_ROPE + (size_t)2 * 2048 * 32 * 4, S_COMB = S_BAR + 16384, S_END = S_COMB + (size_t)NLAYER * 3 * 9 * 3 * 2048 * 4;
constexpr size_t AR = S_END;
constexpr size_t SZ_H = (size_t)MT * 2048 * 2;
constexpr size_t A_H = AR, A_UU = AR + SZ_H, A_ACT = A_UU + (size_t)MT * UU_LD * 2, AR_END = A_ACT + (size_t)MT * DFF * 2;
constexpr size_t A_PROJA = A_UU;
constexpr size_t A_Q = A_UU, A_KN = A_Q + (size_t)MT * 1536 * 2, A_VT = A_KN + (size_t)KROWS * 1024 * 2, A_YCT = A_VT + (size_t)KROWS * 1024 * 2;
constexpr size_t A_GATES = A_UU, A_M32 = A_GATES + (size_t)MT * GATE_LD * 2, A_MBF = A_H, A_F32 = A_UU;
constexpr size_t A_S = A_M32 + (size_t)MT * 2048 * 4;
constexpr size_t A_ZZT = A_S, A_X0S = A_ZZT + (size_t)MT * 1024 * 2, A_CQN = A_X0S + (size_t)MT * 1024 * 2, A_KEYSC = A_CQN + (size_t)MT * 512 * 2,
                 A_KPER = A_KEYSC + (size_t)KROWS * 256 * 2, A_YC = A_KPER + (size_t)KROWS * 64 * 2, A_YA = A_YC + (size_t)MT * 1024 * 2,
                 A_OATT = A_YA + (size_t)MT * 1024 * 2, A_SEND = A_OATT + (size_t)MT * 1024 * 2;
static_assert(A_SEND <= AR_END, "arena overflow");
static_assert(A_YCT + (size_t)MT * 1024 * 2 <= A_M32, "arena overlap");
constexpr size_t WS_NEED = AR_END;
static_assert(WS_NEED <= 967590400ull, "workspace too large");

struct Params {
    const float* in[N_INPUTS];
    float* out;
    unsigned char* ws;
};

__device__ __forceinline__ unsigned cvt_pk_bf16(float lo, float hi) { unsigned r; asm volatile("v_cvt_pk_bf16_f32 %0, %1, %2" : "=v"(r) : "v"(lo), "v"(hi)); return r; }
__device__ __forceinline__ bf16_t f2bf(float f) { return (bf16_t)(cvt_pk_bf16(f, 0.f) & 0xffffu); }
__device__ __forceinline__ float bf_lo(unsigned w) { return __uint_as_float(w << 16); }
__device__ __forceinline__ float bf_hi(unsigned w) { return __uint_as_float(w & 0xffff0000u); }
__device__ __forceinline__ void unpack8(const u32x4 v, float* f) { f[0] = bf_lo(v.x); f[1] = bf_hi(v.x); f[2] = bf_lo(v.y); f[3] = bf_hi(v.y); f[4] = bf_lo(v.z); f[5] = bf_hi(v.z); f[6] = bf_lo(v.w); f[7] = bf_hi(v.w); }
__device__ __forceinline__ u32x4 pack8(const float* f) { u32x4 r; r.x = cvt_pk_bf16(f[0], f[1]); r.y = cvt_pk_bf16(f[2], f[3]); r.z = cvt_pk_bf16(f[4], f[5]); r.w = cvt_pk_bf16(f[6], f[7]); return r; }
__device__ __forceinline__ float shx(float v, int mask, int lane) { return __int_as_float(__builtin_amdgcn_ds_bpermute((lane ^ mask) << 2, __float_as_int(v))); }
__device__ __forceinline__ float wave_sum(float v, int lane) {
#pragma unroll
    for (int o = 32; o >= 1; o >>= 1) v += shx(v, o, lane);
    return v;
}
__device__ __forceinline__ int otid(int wv) { int t; asm volatile("v_mbcnt_lo_u32_b32 %0, -1, 0\n\tv_mbcnt_hi_u32_b32 %0, -1, %0" : "=v"(t)); return wv * 64 + t; }
__device__ __forceinline__ int obid() { int t = blockIdx.x; asm volatile("" : "+s"(t)); return t; }
__device__ __forceinline__ float sigmoidf_(float x) { return 1.0f / (1.0f + __expf(-x)); }
__device__ __forceinline__ float siluf_(float x) { return x / (1.0f + __expf(-x)); }

namespace pg8 {
constexpr int BM = 256, BK = 64, HALF = 128, HTB = HALF * BK * 2, STAGE_BYTES = 8 * HTB, NXCD = 8, WGM = 8;
__host__ __device__ __forceinline__ int lds_byte(int r, int c) { const int st = (r >> 4) * 2 + (c >> 5), rr = r & 15, cc = c & 31, ob = rr * 64 + cc * 2; return st * 1024 + (ob ^ (((ob >> 9) & 1) << 5)); }
__host__ __device__ __forceinline__ void stage_rc(int b, int& R, int& C) { const int st = b / 1024, sb = b % 1024, swz = sb ^ (((sb >> 9) & 1) << 5); R = (st >> 1) * 16 + swz / 64; C = (st & 1) * 32 + (swz % 64) / 2; }
struct Unit { int pm, pn; };
struct Gemm { const bf16_t* A; const bf16_t* Bt; int M, N, K; };
struct StaticOrder {
    int nM, nN, nwg, G, c;
    __device__ void init(int M, int N, int G_, int c_) { nM = M / BM; nN = N / BM; nwg = nM * nN; G = G_; c = c_; }
    __device__ bool next(int i, Unit& u) const {
        const long L = (long)i * G + c; if (L >= nwg) return false;
        int wgid = (int)L; { const int q = nwg / NXCD, r = nwg % NXCD, xcd = wgid % NXCD, off = wgid / NXCD; wgid = (xcd < r ? xcd * (q + 1) : r * (q + 1) + (xcd - r) * q) + off; }
        const int nig = WGM * nN, gid = wgid / nig, fm = gid * WGM, gsz = (nM - fm) < WGM ? (nM - fm) : WGM;
        u.pm = fm + ((wgid % nig) % gsz); u.pn = (wgid % nig) / gsz; return true;
    }
};
template <class Epi>
__device__ __forceinline__ void gemm_phase(int wv, LAS unsigned char* lds, const Gemm g, const StaticOrder& S, const Epi& E) {
    const int tid = otid(wv), wid = __builtin_amdgcn_readfirstlane(tid >> 6), lane = tid & 63, wr = wid >> 2, wc = wid & 3, fr = lane & 15, fq = lane >> 4;
    const int K = g.K, nt = K / BK;
    unsigned voffA[2];
#pragma unroll
    for (int i = 0; i < 2; ++i) { int R, C; stage_rc(tid * 16 + i * 8192, R, C); voffA[i] = (unsigned)(R * K + C) * 2u; }
    const size_t kstep = (size_t)(BK * 2);
    const size_t hstep = (size_t)HALF * K * 2;
    const size_t tstep = 2 * hstep;
    const unsigned ldsw = (unsigned)wid * 1024u;
    const int aoff = lds_byte(wr * 64 + fr, fq * 8), boff = lds_byte(wc * 32 + fr, fq * 8);
#define PG8_SA(b, h) (((b) * 2 + (h)) * HTB)
#define PG8_SB(b, h) ((4 + (b) * 2 + (h)) * HTB)
#define PG8_STAGE(bufoff, gbase, voff) do { _Pragma("unroll") for (int _i = 0; _i < 2; ++_i) \
        __builtin_amdgcn_global_load_lds((const unsigned*)((const char*)(gbase) + (voff)[_i]), (LAS unsigned*)(lds + (bufoff) + ldsw + _i * 8192), 16, 0, 0); } while (0)
#define PG8_LDA(dst, b, h) do { _Pragma("unroll") for (int m = 0; m < 4; ++m) _Pragma("unroll") for (int k = 0; k < 2; ++k) dst[m][k] = *(const LAS bf16x8*)(lds + PG8_SA(b, h) + aoff + m * 2048 + k * 1024); } while (0)
#define PG8_LDB(dst, b, h) do { _Pragma("unroll") for (int n = 0; n < 2; ++n) _Pragma("unroll") for (int k = 0; k < 2; ++k) dst[n][k] = *(const LAS bf16x8*)(lds + PG8_SB(b, h) + boff + n * 2048 + k * 1024); } while (0)
#define PG8_MMA(ai, bj, At, Bt) do { __builtin_amdgcn_s_setprio(1); _Pragma("unroll") for (int m = 0; m < 4; ++m) _Pragma("unroll") for (int n = 0; n < 2; ++n) _Pragma("unroll") for (int k = 0; k < 2; ++k) \
        acc[ai][bj][m][n] = __builtin_amdgcn_mfma_f32_16x16x32_bf16(Bt[n][k], At[m][k], acc[ai][bj][m][n], 0, 0, 0); __builtin_amdgcn_s_setprio(0); } while (0)
#define PG8_WAIT_V(n) asm volatile("s_waitcnt vmcnt(" #n ")" ::: "memory")
#define PG8_WAIT_L(n) asm volatile("s_waitcnt lgkmcnt(" #n ")" ::: "memory")
#define PG8_BAR __builtin_amdgcn_s_barrier()
#define PG8_SCHED __builtin_amdgcn_sched_barrier(0)
    Unit cur, nxt; int ui = 0;
    if (!S.next(0, cur)) return;
    f32x4 acc[2][2][4][2];
#pragma unroll
    for (int a = 0; a < 2; ++a)
#pragma unroll
        for (int b = 0; b < 2; ++b)
#pragma unroll
            for (int m = 0; m < 4; ++m)
#pragma unroll
                for (int n = 0; n < 2; ++n) acc[a][b][m][n] = (f32x4){0.f, 0.f, 0.f, 0.f};
    bf16x8 At[4][2], B0[2][2], B1[2][2];
    const char* cA = (const char*)g.A + (size_t)cur.pm * tstep; const char* cB = (const char*)g.Bt + (size_t)cur.pn * tstep;
    PG8_STAGE(PG8_SB(0, 0), cB, voffA); PG8_STAGE(PG8_SA(0, 0), cA, voffA); PG8_STAGE(PG8_SB(0, 1), cB + hstep, voffA); PG8_STAGE(PG8_SA(0, 1), cA + hstep, voffA);
    if (wr == 1) PG8_BAR;
    PG8_WAIT_V(4); PG8_BAR;
    PG8_STAGE(PG8_SB(1, 0), cB + kstep, voffA); PG8_STAGE(PG8_SA(1, 0), cA + kstep, voffA); PG8_STAGE(PG8_SB(1, 1), cB + hstep + kstep, voffA);
    PG8_WAIT_V(6); PG8_BAR;
    for (;;) {
        const bool has_next = S.next(ui + 1, nxt);
        const char* nA = has_next ? (const char*)g.A + (size_t)nxt.pm * tstep : cA; const char* nB = has_next ? (const char*)g.Bt + (size_t)nxt.pn * tstep : cB;
        for (int t = 0; t < nt; t += 2) {
            const bool last = (t == nt - 2);
            const char* a1 = cA + (size_t)(t + 1) * kstep;
            const char* a2 = last ? nA : cA + (size_t)(t + 2) * kstep; const char* b2 = last ? nB : cB + (size_t)(t + 2) * kstep;
            const char* a3 = a2 + kstep; const char* b3 = b2 + kstep;
            PG8_LDB(B0, 0, 0); PG8_SCHED; PG8_LDA(At, 0, 0); PG8_STAGE(PG8_SA(1, 1), a1 + hstep, voffA);
            PG8_WAIT_L(8); PG8_BAR; PG8_WAIT_L(0); PG8_MMA(0, 0, At, B0); PG8_BAR; PG8_SCHED;
            PG8_LDB(B1, 0, 1); PG8_STAGE(PG8_SB(0, 0), b2, voffA);
            PG8_BAR; PG8_WAIT_L(0); PG8_MMA(0, 1, At, B1); PG8_BAR;
            PG8_LDA(At, 0, 1); PG8_STAGE(PG8_SA(0, 0), a2, voffA);
            PG8_BAR; PG8_WAIT_L(0); PG8_MMA(1, 0, At, B0); PG8_BAR; PG8_SCHED;
            PG8_STAGE(PG8_SB(0, 1), b2 + hstep, voffA);
            PG8_WAIT_V(6); PG8_BAR; PG8_MMA(1, 1, At, B1); PG8_BAR;
            PG8_LDB(B0, 1, 0); PG8_SCHED; PG8_LDA(At, 1, 0); PG8_STAGE(PG8_SA(0, 1), a2 + hstep, voffA);
            PG8_WAIT_L(8); PG8_BAR; PG8_WAIT_L(0); PG8_MMA(0, 0, At, B0); PG8_BAR; PG8_SCHED;
            PG8_LDB(B1, 1, 1); PG8_STAGE(PG8_SB(1, 0), b3, voffA);
            PG8_BAR; PG8_WAIT_L(0); PG8_MMA(0, 1, At, B1); PG8_BAR;
            PG8_LDA(At, 1, 1); PG8_STAGE(PG8_SA(1, 0), a3, voffA);
            PG8_BAR; PG8_WAIT_L(0); PG8_MMA(1, 0, At, B0); PG8_BAR; PG8_SCHED;
            PG8_STAGE(PG8_SB(1, 1), b3 + hstep, voffA);
            PG8_WAIT_V(6); PG8_BAR; PG8_MMA(1, 1, At, B1); PG8_BAR;
        }
        { const int t2 = otid(wv); const int l2 = t2 & 63, w2 = __builtin_amdgcn_readfirstlane(t2 >> 6); E(acc, cur, w2 >> 2, w2 & 3, l2 & 15, l2 >> 4); }
        if (!has_next) break;
#pragma unroll
        for (int a = 0; a < 2; ++a)
#pragma unroll
            for (int b = 0; b < 2; ++b)
#pragma unroll
                for (int m = 0; m < 4; ++m)
#pragma unroll
                    for (int n = 0; n < 2; ++n) acc[a][b][m][n] = (f32x4){0.f, 0.f, 0.f, 0.f};
        cur = nxt; cA = nA; cB = nB; ++ui;
    }
    PG8_WAIT_V(0);
    if (wr == 0) PG8_BAR;
    PG8_BAR;
#undef PG8_SA
#undef PG8_SB
#undef PG8_STAGE
#undef PG8_LDA
#undef PG8_LDB
#undef PG8_MMA
#undef PG8_WAIT_V
#undef PG8_WAIT_L
#undef PG8_BAR
#undef PG8_SCHED
}

struct EpiBf16 {
    bf16_t* O; int ldc;
    __device__ __forceinline__ void operator()(const f32x4 (&acc)[2][2][4][2], const Unit& u, int wr, int wc, int fr, int fq) const {
        const int row0 = u.pm * BM + wr * 64 + fr, col0 = u.pn * BM + wc * 32 + 4 * fq;
#pragma unroll
        for (int ai = 0; ai < 2; ++ai)
#pragma unroll
            for (int m = 0; m < 4; ++m) { bf16_t* rowp = O + (size_t)(row0 + ai * HALF + m * 16) * ldc + col0;
#pragma unroll
                for (int bj = 0; bj < 2; ++bj)
#pragma unroll
                    for (int n = 0; n < 2; ++n) { const f32x4 v = acc[ai][bj][m][n]; u32x2 w; w.x = cvt_pk_bf16(v[0], v[1]); w.y = cvt_pk_bf16(v[2], v[3]); *(u32x2*)(rowp + bj * HALF + n * 16) = w; } }
    }
};
struct EpiF32 {
    float* C; int ldc;
    __device__ __forceinline__ void operator()(const f32x4 (&acc)[2][2][4][2], const Unit& u, int wr, int wc, int fr, int fq) const {
        const int row0 = u.pm * BM + wr * 64 + fr, col0 = u.pn * BM + wc * 32 + 4 * fq;
#pragma unroll
        for (int ai = 0; ai < 2; ++ai)
#pragma unroll
            for (int m = 0; m < 4; ++m) { float* rowp = C + (size_t)(row0 + ai * HALF + m * 16) * ldc + col0;
#pragma unroll
                for (int bj = 0; bj < 2; ++bj)
#pragma unroll
                    for (int n = 0; n < 2; ++n) *(f32x4*)(rowp + bj * HALF + n * 16) = acc[ai][bj][m][n]; }
    }
};
struct EpiVT {
    bf16_t* VTs; bf16_t* VTp;
    __device__ __forceinline__ void operator()(const f32x4 (&acc)[2][2][4][2], const Unit& u, int wr, int wc, int fr, int fq) const {
        const int KR0 = u.pn * BM;
        bf16_t* vt; int Lk;
        if (KR0 < BS * LKS) { const int b = KR0 / LKS; Lk = LKS; vt = VTs + (size_t)b * 1024 * LKS + (KR0 - b * LKS); }
        else { const int b = (KR0 - BS * LKS) >> 8; Lk = LP; vt = VTp + (size_t)b * 1024 * LP; }
        const int row0 = u.pm * BM + wr * 64 + fr, col0 = wc * 32 + 4 * fq;
#pragma unroll
        for (int ai = 0; ai < 2; ++ai)
#pragma unroll
            for (int m = 0; m < 4; ++m) { bf16_t* rowp = vt + (size_t)(row0 + ai * HALF + m * 16) * Lk + col0;
#pragma unroll
                for (int bj = 0; bj < 2; ++bj)
#pragma unroll
                    for (int n = 0; n < 2; ++n) { const f32x4 v = acc[ai][bj][m][n]; u32x2 w; w.x = cvt_pk_bf16(v[0], v[1]); w.y = cvt_pk_bf16(v[2], v[3]); *(u32x2*)(rowp + bj * HALF + n * 16) = w; } }
    }
};
template <int P> struct EpiGate {
    const bf16_t* gates; float* m32; bf16_t* mbf;
    __device__ __forceinline__ void operator()(const f32x4 (&acc)[2][2][4][2], const Unit& u, int wr, int wc, int fr, int fq) const {
        const int row0 = u.pm * BM + wr * 64 + fr, col0 = u.pn * BM + wc * 32 + 4 * fq;
#pragma unroll
        for (int ai = 0; ai < 2; ++ai)
#pragma unroll
            for (int m = 0; m < 4; ++m) {
                const size_t row = (size_t)(row0 + ai * HALF + m * 16);
#pragma unroll
                for (int bj = 0; bj < 2; ++bj)
#pragma unroll
                    for (int n = 0; n < 2; ++n) {
                        const int col = col0 + bj * HALF + n * 16;
                        const u32x2 gw = *(const u32x2*)(gates + row * GATE_LD + P * 2048 + col);
                        f32x4 v = acc[ai][bj][m][n];
                        v[0] *= sigmoidf_(bf_lo(gw.x)); v[1] *= sigmoidf_(bf_hi(gw.x)); v[2] *= sigmoidf_(bf_lo(gw.y)); v[3] *= sigmoidf_(bf_hi(gw.y));
                        float* mp = m32 + row * 2048 + col;
                        if (P == 0) { *(f32x4*)mp = v; }
                        else if (P == 1) { const f32x4 o = *(const f32x4*)mp; *(f32x4*)mp = o + v; }
                        else { const f32x4 o = *(const f32x4*)mp; v = v + o; u32x2 w; w.x = cvt_pk_bf16(v[0], v[1]); w.y = cvt_pk_bf16(v[2], v[3]); *(u32x2*)(mbf + row * 2048 + col) = w; }
                    }
            }
    }
};
}

template <class Epi>
__device__ __forceinline__ void run_gemm(int wv, LAS unsigned char* lds, const bf16_t* A, const bf16_t* Bt, int M, int N, int K, const Epi& E) {
    pg8::Gemm g; g.A = A; g.Bt = Bt; g.M = M; g.N = N; g.K = K;
    pg8::StaticOrder S; S.init(M, N, (int)gridDim.x, obid());
    pg8::gemm_phase<Epi>(wv, lds, g, S, E);
    __syncthreads();
}

__device__ __forceinline__ void convT(int wv, const float* __restrict__ src, int K, int N, bf16_t* __restrict__ dst, int gate_shift, LAS unsigned char* lds) {
    const int tn = N / 64, tk = K / 64, ntile = tn * tk, tid = otid(wv);
    LAS bf16_t* T = (LAS bf16_t*)lds;
    for (int tile = obid(); tile < ntile; tile += gridDim.x) {
        const int tkk = tile / tn, tnn = tile - tkk * tn, k0 = tkk * 64, n0 = tnn * 64;
        const int kk = tid >> 4, n4 = (tid & 15) * 4;
#pragma unroll
        for (int half = 0; half < 2; ++half) {
            const int k = kk + half * 32;
            const f32x4 v = *(const f32x4*)(src + (size_t)(k0 + k) * N + n0 + n4);
#pragma unroll
            for (int i = 0; i < 4; ++i) T[(n4 + i) * 72 + k] = f2bf(v[i]);
        }
        __syncthreads();
        const int n = tid >> 3, kc = (tid & 7) * 8;
        int nd = n0 + n; if (gate_shift == 1 && nd >= NGATE0) nd += 192; if (gate_shift == 2) { const int hd = nd >> 8, wi = nd & 255; nd = (wi < 128) ? hd * 128 + wi : 1024 + hd * 128 + (wi - 128); }
        *(u32x4*)(dst + (size_t)nd * K + k0 + kc) = *(const LAS u32x4*)(T + n * 72 + kc);
        __syncthreads();
    }
}

__device__ __forceinline__ void ada_phase(int wv, const Params& p, LAS unsigned char* lds) {
    LAS float* sl = (LAS float*)lds;
    float* mod = (float*)(p.ws + S_MOD);
    const int tid = otid(wv);
    for (int u = obid(); u < NLAYER * 6 * 16; u += gridDim.x) {
        const int l = u / 96, r = u % 96, cb = r % 6, kc = r / 6, k0 = kc * 128;
        for (int i = tid; i < 9 * 128; i += NTHREADS) { const int v = i >> 7, k = i & 127; const float x = (v == 0) ? p.in[I_CCTX][k0 + k] : p.in[I_C][(v - 1) * DM + k0 + k]; sl[i] = siluf_(x); }
        __syncthreads();
        const int col = cb * 2048 + tid * 4;
        f32x4 acc[9];
#pragma unroll
        for (int i = 0; i < 9; ++i) acc[i] = (f32x4){0.f, 0.f, 0.f, 0.f};
        const float* wp = p.in[I_ADAW] + ((size_t)l * DM + k0) * 12288 + col;
#pragma unroll 8
        for (int k = 0; k < 128; ++k) {
            const f32x4 w = *(const f32x4*)(wp + (size_t)k * 12288);
#pragma unroll
            for (int i = 0; i < 9; ++i) acc[i] += sl[i * 128 + k] * w;
        }
#pragma unroll
        for (int i = 0; i < 9; ++i) *(f32x4*)(mod + ((size_t)(l * 16 + kc) * 9 + i) * 12288 + col) = acc[i];
        __syncthreads();
    }
}

__device__ __forceinline__ void filter_phase(int wv, const Params& p, int l, LAS unsigned char* lds) {
    LAS float* z = (LAS float*)lds;
    LAS float* H1 = z + 32 * 33;
    LAS float* H2 = H1 + 32 * 64;
    const int tid = otid(wv);
    const float* w1 = p.in[I_FW1] + (size_t)l * 33 * 64; const float* b1 = p.in[I_FB1] + l * 64;
    const float* w2 = p.in[I_FW2] + (size_t)l * 64 * 64; const float* b2 = p.in[I_FB2] + l * 64;
    const float* w3 = p.in[I_FW3] + (size_t)l * 64 * 2048; const float* b3 = p.in[I_FB3] + l * 2048;
    const float* fq = p.in[I_FFREQ] + l * 128;
    for (int u = obid(); u < 72; u += gridDim.x) {
        const int g = (u < 64) ? 1 : 0; const int tc = g ? u : u - 64; const int L = g ? LS : LP; const int t0 = tc * 32;
        float* kT = (float*)(p.ws + (g ? S_KTS : S_KTP)); float* part = (float*)(p.ws + (g ? S_PARTS : S_PARTP));
        for (int i = tid; i < 32 * 33; i += NTHREADS) {
            const int t = i / 33, e = i - t * 33; const float tf = (float)(t0 + t);
            float v;
            if (e == 0) v = tf / (float)(L - 1);
            else { const int k = (e - 1) & 15; const float band = 1e-4f + (float)k * ((15.0f - 1e-4f) / 15.0f); const float w = (6.283185307179586f * tf) / (float)L; const float ang = w * band;
                   v = (e <= 16) ? cosf(ang) : -sinf(ang); }
            z[i] = v;
        }
        __syncthreads();
        for (int i = tid; i < 32 * 64; i += NTHREADS) {
            const int t = i >> 6, j = i & 63; float s = b1[j];
            for (int e = 0; e < 33; ++e) s += z[t * 33 + e] * w1[e * 64 + j];
            H1[i] = sinf(fq[j] * s);
        }
        __syncthreads();
        for (int i = tid; i < 32 * 64; i += NTHREADS) {
            const int t = i >> 6, j = i & 63; float s = b2[j];
            for (int e = 0; e < 64; ++e) s += H1[t * 64 + e] * w2[e * 64 + j];
            H2[i] = sinf(fq[64 + j] * s);
        }
        __syncthreads();
        const int c = tid * 4;
        const f32x4 bias = *(const f32x4*)(b3 + c);
        f32x4 delta;
#pragma unroll
        for (int j = 0; j < 4; ++j) { const int d = (c + j) & 1023; const float mn = -3.0701134573253945f, mx = -15.350567286626973f; delta[j] = fabsf(mn + (float)d * ((mx - mn) / 1023.0f)); }
        f32x4 psum = (f32x4){0.f, 0.f, 0.f, 0.f};
        for (int tb = 0; tb < 4; ++tb) {
            f32x4 acc[8];
#pragma unroll
            for (int i = 0; i < 8; ++i) acc[i] = bias;
            for (int k = 0; k < 64; ++k) {
                const f32x4 w = *(const f32x4*)(w3 + (size_t)k * 2048 + c);
#pragma unroll
                for (int i = 0; i < 8; ++i) acc[i] += H2[(tb * 8 + i) * 64 + k] * w;
            }
#pragma unroll
            for (int i = 0; i < 8; ++i) {
                const int t = t0 + tb * 8 + i; const float tn = (float)t / (float)(L - 1);
#pragma unroll
                for (int j = 0; j < 4; ++j) {
                    const float v = acc[i][j] * __expf(-tn * delta[j]);
                    const int cc = c + j;
                    if (cc < 1024) { kT[(size_t)cc * (2 * L) + t] = v; psum[j] += fabsf(v); }
                    else { const int d = cc - 1024; if (t == 0) kT[(size_t)d * (2 * L) + L] = 0.f; else { kT[(size_t)d * (2 * L) + 2 * L - t] = v; psum[j] += fabsf(v); } }
                }
            }
        }
        *(f32x4*)(part + (size_t)tc * 2048 + c) = psum;
        __syncthreads();
    }
}

__device__ __forceinline__ void row_sel(const Params& p, int l, int mode, int& l2, int& shi, int& sci, const float*& prew, bool& wh, int& gi, const float*& pw) {
    wh = true;
    if (mode == 0) { l2 = l; shi = 0; sci = 1; prew = p.in[I_NMPRE] + l * DM; }
    else if (mode == 1) { l2 = l; shi = 3; sci = 4; prew = p.in[I_NFPRE] + l * DM; }
    else { l2 = l + 1; shi = 0; sci = 1; wh = (l + 1 < NLAYER); if (!wh) l2 = l; prew = p.in[I_NMPRE] + l2 * DM; }
    gi = (mode == 1) ? 2 : 5;
    pw = p.in[mode == 1 ? I_NMPOST : I_NFPOST] + l * DM;
}
__device__ __forceinline__ void comb_phase(int wv, const Params& p) {
    const int tid = otid(wv);
    const float* mod = (const float*)(p.ws + S_MOD); float* comb = (float*)(p.ws + S_COMB);
    for (int idx = obid() * NTHREADS + tid; idx < NLAYER * 3 * 9 * 2048; idx += gridDim.x * NTHREADS) {
        const int c = idx & 2047, q = idx >> 11, mi = q % 9, q2 = q / 9, mode = q2 % 3, l = q2 / 3;
        int l2, shi, sci, gi; const float* prew; const float* pw; bool wh;
        row_sel(p, l, mode, l2, shi, sci, prew, wh, gi, pw);
        float g = 0.f, sc = 0.f, sh = 0.f;
        for (int kc = 0; kc < 16; ++kc) {
            g += mod[((size_t)(l * 16 + kc) * 9 + mi) * 12288 + gi * 2048 + c];
            sc += mod[((size_t)(l2 * 16 + kc) * 9 + mi) * 12288 + sci * 2048 + c];
            sh += mod[((size_t)(l2 * 16 + kc) * 9 + mi) * 12288 + shi * 2048 + c];
        }
        g += p.in[I_ADAB][(size_t)l * 12288 + gi * 2048 + c];
        sc += p.in[I_ADAB][(size_t)l2 * 12288 + sci * 2048 + c];
        sh += p.in[I_ADAB][(size_t)l2 * 12288 + shi * 2048 + c];
        float* o = comb + (size_t)q * 3 * 2048 + c;
        o[0] = g * pw[c]; o[2048] = prew[c] * (1.0f + sc); o[4096] = sh;
    }
}
__device__ __forceinline__ void row_phase(int wv, const Params& p, int l, int mode) {
    const int tid = otid(wv); const int wave = obid() * 8 + (tid >> 6), nw = gridDim.x * 8, lane = tid & 63;
    float* X = p.out;
    bf16_t* H = (bf16_t*)(p.ws + A_H);
    const bool wh = !(mode == 2 && l + 1 >= NLAYER);
    const int rows_per = (MT + nw - 1) / nw;
    for (int rr = 0; rr < rows_per; ++rr) {
        const int row = wave * rows_per + rr;
        if (row >= MT) break;
        const int mi = row < MP ? 0 : 1 + ((row - MP) >> 11);
        const float* cb = (const float*)(p.ws + S_COMB) + (size_t)((l * 3 + mode) * 9 + mi) * 3 * 2048 + lane * 4;
        f32x4 x[8];
        const float* xs = (mode == 0) ? (row < MP ? p.in[I_XP] + (size_t)row * DM : p.in[I_XS] + (size_t)(row - MP) * DM) : X + (size_t)row * DM;
#pragma unroll
        for (int i = 0; i < 8; ++i) x[i] = *(const f32x4*)(xs + i * 256 + lane * 4);
        if (mode != 0) {
            const bf16_t* o = (const bf16_t*)(p.ws + (mode == 1 ? A_M32 : A_F32)) + (size_t)row * DM;
            u32x2 ow[8]; float ss = 0.f;
#pragma unroll
            for (int i = 0; i < 8; ++i) { ow[i] = *(const u32x2*)(o + i * 256 + lane * 4); const float a = bf_lo(ow[i].x), b = bf_hi(ow[i].x), c = bf_lo(ow[i].y), d = bf_hi(ow[i].y); ss += a * a + b * b + c * c + d * d; }
            ss = wave_sum(ss, lane);
            const float rstd = rsqrtf(ss * (1.0f / DM) + 1e-6f);
#pragma unroll
            for (int i = 0; i < 8; ++i) { const f32x4 ov = (f32x4){bf_lo(ow[i].x), bf_hi(ow[i].x), bf_lo(ow[i].y), bf_hi(ow[i].y)}; x[i] += *(const f32x4*)(cb + i * 256) * (ov * rstd); }
        }
#pragma unroll
        for (int i = 0; i < 8; ++i) *(f32x4*)(X + (size_t)row * DM + i * 256 + lane * 4) = x[i];
        if (wh) {
            float ss = 0.f;
#pragma unroll
            for (int i = 0; i < 8; ++i) ss += x[i][0] * x[i][0] + x[i][1] * x[i][1] + x[i][2] * x[i][2] + x[i][3] * x[i][3];
            ss = wave_sum(ss, lane);
            const float rstd = rsqrtf(ss * (1.0f / DM) + 1e-6f);
#pragma unroll
            for (int i = 0; i < 8; ++i) {
                const f32x4 hv = (x[i] * rstd) * *(const f32x4*)(cb + 2048 + i * 256) + *(const f32x4*)(cb + 4096 + i * 256);
                u32x2 o; o.x = cvt_pk_bf16(hv[0], hv[1]); o.y = cvt_pk_bf16(hv[2], hv[3]);
                *(u32x2*)(H + (size_t)row * DM + i * 256 + lane * 4) = o;
            }
        }
    }
}

__device__ __forceinline__ void rope_table_phase(int wv, const Params& p) {
    float* C = (float*)(p.ws + S_ROPE); float* Sn = C + 2048 * 32;
    const int tid = otid(wv);
    for (int idx = obid() * NTHREADS + tid; idx < 2048 * 32; idx += gridDim.x * NTHREADS) {
        const int t = idx >> 5, i = idx & 31, k = i & 15;
        const float inv = exp2f(-(float)k * 0.8304820237218406f);
        const float pos = (i < 16) ? (float)(t >> 6) : (float)(t & 63);
        const float ang = pos * inv; C[idx] = cosf(ang); Sn[idx] = sinf(ang);
    }
}
__device__ __forceinline__ void e2_phase(int wv, const Params& p, int l, LAS unsigned char* lds) {
    const bf16_t* PA = (const bf16_t*)(p.ws + A_PROJA);
    const int tid = otid(wv), lane = tid & 63;
    {
        bf16_t* CQN = (bf16_t*)(p.ws + A_CQN); bf16_t* KC = (bf16_t*)(p.ws + A_KEYSC); bf16_t* KP = (bf16_t*)(p.ws + A_KPER);
        float* out_ckv = p.out + (size_t)MT * DM; float* out_kpe = out_ckv + (size_t)BP * NLAYER * LP * 256;
        const int wave = obid() * 8 + (tid >> 6), nw = gridDim.x * 8;
        for (int row = wave; row < MT + BS * PAST; row += nw) {
            if (row < MT) {
                const bf16_t* pr = PA + (size_t)row * PA_LD;
                { const u32x4 v = *(const u32x4*)(pr + 3072 + lane * 8); float f[8]; unpack8(v, f); float ss = 0.f;
#pragma unroll
                  for (int j = 0; j < 8; ++j) ss += f[j] * f[j];
                  ss = wave_sum(ss, lane); const float rstd = rsqrtf(ss * (1.0f / 512.0f) + 1e-6f);
                  const float* qn = p.in[I_QN] + l * 512 + lane * 8;
#pragma unroll
                  for (int j = 0; j < 8; ++j) f[j] = f[j] * rstd * qn[j];
                  *(u32x4*)(CQN + (size_t)row * 512 + lane * 8) = pack8(f); }
                int KR, t; const bool isp = row < MP; int b;
                if (isp) { b = row >> 8; t = row & 255; KR = BS * LKS + row; } else { const int r2 = row - MP; b = r2 >> 11; t = r2 & 2047; KR = b * LKS + t; }
                { const u32x2 v = *(const u32x2*)(pr + 3584 + lane * 4); float f[4] = {bf_lo(v.x), bf_hi(v.x), bf_lo(v.y), bf_hi(v.y)};
                  float ss = f[0] * f[0] + f[1] * f[1] + f[2] * f[2] + f[3] * f[3]; ss = wave_sum(ss, lane); const float rstd = rsqrtf(ss * (1.0f / 256.0f) + 1e-6f);
                  const float* kn = p.in[I_KVN] + l * 256 + lane * 4;
#pragma unroll
                  for (int j = 0; j < 4; ++j) f[j] = f[j] * rstd * kn[j];
                  if (isp) *(f32x4*)(out_ckv + ((size_t)(b * NLAYER + l) * LP + t) * 256 + lane * 4) = (f32x4){f[0], f[1], f[2], f[3]};
                  u32x2 w; w.x = cvt_pk_bf16(f[0], f[1]); w.y = cvt_pk_bf16(f[2], f[3]); *(u32x2*)(KC + (size_t)KR * 256 + lane * 4) = w; }
                { const float v = __uint_as_float(((unsigned)pr[3840 + lane]) << 16);
                  float o = v;
                  if (isp) out_kpe[((size_t)(b * NLAYER + l) * LP + t) * 64 + lane] = v;
                  else { const float pv = shx(v, 32, lane); const float* rc = (const float*)(p.ws + S_ROPE); const float cs = rc[t * 32 + (lane & 31)], sn = rc[2048 * 32 + t * 32 + (lane & 31)]; o = (lane < 32) ? (v * cs - pv * sn) : (pv * sn + v * cs); }
                  KP[(size_t)KR * 64 + lane] = f2bf(o); }
            } else {
                const int r2 = row - MT, b = r2 >> 9, j = r2 & 511; const int KR = b * LKS + LS + j;
                const float* cc = p.in[I_CCKV] + ((size_t)(b * NLAYER + l) * PAST + j) * 256 + lane * 4;
                const f32x4 v = *(const f32x4*)cc; u32x2 w; w.x = cvt_pk_bf16(v[0], v[1]); w.y = cvt_pk_bf16(v[2], v[3]); *(u32x2*)(KC + (size_t)KR * 256 + lane * 4) = w;
                KP[(size_t)KR * 64 + lane] = f2bf(p.in[I_CKPE][((size_t)(b * NLAYER + l) * PAST + j) * 64 + lane]);
            }
        }
    }
    {
        bf16_t* YC = (bf16_t*)(p.ws + A_YC); const float* scw = p.in[I_SCW] + (size_t)l * 3 * 1024;
        for (int it = obid() * NTHREADS + tid; it < (MT / 4) * 128; it += gridDim.x * NTHREADS) {
            const int ch = it >> 7, d0 = (it & 127) * 8, row0 = ch * 4;
            const int t0 = row0 < MP ? (row0 & 255) : ((row0 - MP) & 2047); const int L = row0 < MP ? LP : LS;
            float w0[8], w1[8], w2[8];
            { const f32x4 a = *(const f32x4*)(scw + d0), b = *(const f32x4*)(scw + d0 + 4), c = *(const f32x4*)(scw + 1024 + d0), d = *(const f32x4*)(scw + 1024 + d0 + 4),
                          e2 = *(const f32x4*)(scw + 2048 + d0), f = *(const f32x4*)(scw + 2048 + d0 + 4);
#pragma unroll
              for (int j = 0; j < 4; ++j) { w0[j] = a[j]; w0[4 + j] = b[j]; w1[j] = c[j]; w1[4 + j] = d[j]; w2[j] = e2[j]; w2[4 + j] = f[j]; } }
            const bf16_t* pr = PA + (size_t)row0 * PA_LD;
            float pp[8], pc[8], pn[8];
#pragma unroll
            for (int j = 0; j < 8; ++j) pp[j] = 0.f;
            if (t0 > 0) { float cg[8], uu[8]; unpack8(*(const u32x4*)(pr - PA_LD + 4928 + d0), cg); unpack8(*(const u32x4*)(pr - PA_LD + 5952 + d0), uu);
#pragma unroll
                for (int j = 0; j < 8; ++j) pp[j] = cg[j] * uu[j]; }
            { float cg[8], uu[8]; unpack8(*(const u32x4*)(pr + 4928 + d0), cg); unpack8(*(const u32x4*)(pr + 5952 + d0), uu);
#pragma unroll
              for (int j = 0; j < 8; ++j) pc[j] = cg[j] * uu[j]; }
#pragma unroll
            for (int i = 0; i < 4; ++i) {
#pragma unroll
                for (int j = 0; j < 8; ++j) pn[j] = 0.f;
                if (t0 + i + 1 < L) { float cg[8], uu[8]; unpack8(*(const u32x4*)(pr + (size_t)(i + 1) * PA_LD + 4928 + d0), cg); unpack8(*(const u32x4*)(pr + (size_t)(i + 1) * PA_LD + 5952 + d0), uu);
#pragma unroll
                    for (int j = 0; j < 8; ++j) pn[j] = cg[j] * uu[j]; }
                float bg[8], o[8]; unpack8(*(const u32x4*)(pr + (size_t)i * PA_LD + 3904 + d0), bg);
#pragma unroll
                for (int j = 0; j < 8; ++j) { o[j] = bg[j] * (w0[j] * pp[j] + w1[j] * pc[j] + w2[j] * pn[j]); pp[j] = pc[j]; pc[j] = pn[j]; }
                *(u32x4*)(YC + (size_t)(row0 + i) * 1024 + d0) = pack8(o);
            }
        }
    }
    {
        bf16_t* X0S = (bf16_t*)(p.ws + A_X0S); bf16_t* ZZT = (bf16_t*)(p.ws + A_ZZT);
        const float* hw = p.in[I_HCW] + (size_t)l * 3 * 3072; const float* hb = p.in[I_HCB] + (size_t)l * 3072;
        LAS bf16_t* zt = (LAS bf16_t*)lds;
        for (int u = obid(); u < (MT / 256) * 16; u += gridDim.x) {
            const int rt = u >> 4, dt = u & 15; const int row0 = rt * 256;
            const int dg = tid & 7, rb = tid >> 3, d0 = dt * 64 + dg * 8; const int rowb = row0 + rb * 4;
            const int L = row0 < MP ? LP : LS; const int tb = (row0 < MP ? (row0 & 255) : ((row0 - MP) & 2047)) + rb * 4;
            float wgt[3][3][8], bs[3][8];
#pragma unroll
            for (int g = 0; g < 3; ++g) {
#pragma unroll
                for (int o = 0; o < 3; ++o) { const f32x4 a = *(const f32x4*)(hw + o * 3072 + g * 1024 + d0), b = *(const f32x4*)(hw + o * 3072 + g * 1024 + d0 + 4);
#pragma unroll
                    for (int j = 0; j < 4; ++j) { wgt[g][o][j] = a[j]; wgt[g][o][4 + j] = b[j]; } }
                const f32x4 a = *(const f32x4*)(hb + g * 1024 + d0), b = *(const f32x4*)(hb + g * 1024 + d0 + 4);
#pragma unroll
                for (int j = 0; j < 4; ++j) { bs[g][j] = a[j]; bs[g][4 + j] = b[j]; }
            }
            const bf16_t* pr = PA + (size_t)rowb * PA_LD + d0;
            u32x4 wp[3], wc[3], wn[3];
#pragma unroll
            for (int g = 0; g < 3; ++g) { wp[g] = (u32x4){0u, 0u, 0u, 0u}; if (tb > 0) wp[g] = *(const u32x4*)(pr - PA_LD + g * 1024); wc[g] = *(const u32x4*)(pr + g * 1024); }
#pragma unroll
            for (int i = 0; i < 4; ++i) {
#pragma unroll
                for (int g = 0; g < 3; ++g) { wn[g] = (u32x4){0u, 0u, 0u, 0u}; if (tb + i + 1 < L) wn[g] = *(const u32x4*)(pr + (size_t)(i + 1) * PA_LD + g * 1024); }
                float hv[3][8];
#pragma unroll
                for (int g = 0; g < 3; ++g) { float a[8], b[8], c[8]; unpack8(wp[g], a); unpack8(wc[g], b); unpack8(wn[g], c);
#pragma unroll
                    for (int j = 0; j < 8; ++j) hv[g][j] = bs[g][j] + wgt[g][0][j] * a[j] + wgt[g][1][j] * b[j] + wgt[g][2][j] * c[j];
                    wp[g] = wc[g]; wc[g] = wn[g]; }
                *(u32x4*)(X0S + (size_t)(rowb + i) * 1024 + d0) = pack8(hv[0]);
#pragma unroll
                for (int j = 0; j < 8; ++j) zt[(dg * 8 + j) * 264 + rb * 4 + i] = f2bf(hv[1][j] * hv[2][j]);
            }
            __syncthreads();
#pragma unroll
            for (int i = 0; i < 4; ++i) {
                const int chunk = tid + i * NTHREADS; const int dl = chunk >> 5, tch = chunk & 31; const int d = dt * 64 + dl;
                size_t base; int t0;
                if (row0 < MP) { const int b = row0 >> 8; t0 = 0; base = ((size_t)b * 1024 + d) * LP; }
                else { const int r2 = row0 - MP; const int b = r2 >> 11; t0 = r2 & 2047; base = (size_t)BP * 1024 * LP + ((size_t)b * 1024 + d) * LS; }
                *(u32x4*)(ZZT + base + t0 + tch * 8) = *(const LAS u32x4*)(zt + dl * 264 + tch * 8);
            }
            __syncthreads();
        }
    }
}

__device__ __forceinline__ void conv_phase(int wv, const Params& p, int l, LAS unsigned char* lds) {
    const int tid = otid(wv), wid = tid >> 6, lane = tid & 63, r = lane & 31, hh = lane >> 5;
    const bf16_t* ZZT = (const bf16_t*)(p.ws + A_ZZT); bf16_t* YCT = (bf16_t*)(p.ws + A_YCT);
    const float* hbias = p.in[I_HBIAS] + l * 1024;
    for (int u = obid(); u < 2048; u += gridDim.x) {
        const int g = (u < 1024) ? 1 : 0, d = u & 1023;
        const int L = g ? LS : LP, B = g ? BS : BP, L2 = 2 * L, NB = L / 32, NI = 32 / B, NT = NB / NI, lgB = g ? 3 : 4;
        const float* kT = (const float*)(p.ws + (g ? S_KTS : S_KTP)) + (size_t)d * L2;
        const float* part = (const float*)(p.ws + (g ? S_PARTS : S_PARTP));
        const int NU = g ? 64 : 8;
        float tot = 0.f;
        for (int i = 0; i < NU; ++i) tot += part[i * 2048 + d] + part[i * 2048 + 1024 + d];
        const float scale = 1.0f / tot; const float bias = hbias[d];
        LAS bf16_t* cp = (LAS bf16_t*)lds;
        LAS bf16_t* zz = (LAS bf16_t*)(lds + 65536);
        for (int idx = tid; idx < 8 * L2; idx += NTHREADS) {
            const int c = idx / L2, m = idx - c * L2; const int rpos = (m + c) & (L2 - 1); const int n = (L2 - rpos) & (L2 - 1);
            float v = kT[n] * scale; if (n == 0) v += bias;
            cp[idx] = f2bf(v);
        }
        const size_t zbase = g ? (size_t)BP * 1024 * LP : 0;
        for (int ch = tid; ch < B * L / 8; ch += NTHREADS) {
            const int b = ch / (L / 8), s8 = ch - b * (L / 8);
            *(LAS u32x4*)(zz + b * L + s8 * 8) = *(const u32x4*)(ZZT + zbase + ((size_t)b * 1024 + d) * L + s8 * 8);
        }
        __syncthreads();
        const int Iloc = r >> lgB, b = r & (B - 1);
        for (int nt = wid; nt < NT; nt += 8) {
            const int I0 = nt * NI;
            f32x16 acc;
#pragma unroll
            for (int i = 0; i < 16; ++i) acc[i] = 0.f;
            for (int dl = I0 - (NB - 1); dl <= I0 + NI - 1; ++dl) {
                const int J = I0 + Iloc - dl; const bool valid = (J >= 0) && (J < NB);
#pragma unroll
                for (int ks = 0; ks < 2; ++ks) {
                    const int i0 = (16 * ks + 8 * hh - 32 * dl - r) & (L2 - 1); const int c = i0 & 7, q = i0 >> 3;
                    const bf16x8 Af = *(const LAS bf16x8*)(cp + c * L2 + q * 8);
                    bf16x8 Bf = (bf16x8){0, 0, 0, 0, 0, 0, 0, 0};
                    if (valid) Bf = *(const LAS bf16x8*)(zz + b * L + 32 * J + 16 * ks + 8 * hh);
                    acc = __builtin_amdgcn_mfma_f32_32x32x16_bf16(Af, Bf, acc, 0, 0, 0);
                }
            }
            const int I = I0 + Iloc;
            bf16_t* op = YCT + zbase + ((size_t)b * 1024 + d) * L + 32 * I + 4 * hh;
#pragma unroll
            for (int g4 = 0; g4 < 4; ++g4) { u32x2 w; w.x = cvt_pk_bf16(acc[4 * g4], acc[4 * g4 + 1]); w.y = cvt_pk_bf16(acc[4 * g4 + 2], acc[4 * g4 + 3]); *(u32x2*)(op + 8 * g4) = w; }
        }
        __syncthreads();
    }
}

__device__ __forceinline__ void e3b_phase(int wv, const Params& p, LAS unsigned char* lds) {
    const int tid = otid(wv);
    const bf16_t* X0S = (const bf16_t*)(p.ws + A_X0S); const bf16_t* YCT = (const bf16_t*)(p.ws + A_YCT); bf16_t* YA = (bf16_t*)(p.ws + A_YA);
    LAS bf16_t* yt = (LAS bf16_t*)lds;
    for (int u = obid(); u < (MT / 64) * 16; u += gridDim.x) {
        const int rt = u >> 4, dt = u & 15; const int row0 = rt * 64;
        {
            const int dl = tid >> 3, tch = tid & 7; const int d = dt * 64 + dl;
            size_t base; int t0;
            if (row0 < MP) { const int b = row0 >> 8; t0 = row0 & 255; base = ((size_t)b * 1024 + d) * LP; }
            else { const int r2 = row0 - MP; const int b = r2 >> 11; t0 = r2 & 2047; base = (size_t)BP * 1024 * LP + ((size_t)b * 1024 + d) * LS; }
            const u32x4 v = *(const u32x4*)(YCT + base + t0 + tch * 8);
            const unsigned w[4] = {v.x, v.y, v.z, v.w};
#pragma unroll
            for (int j = 0; j < 4; ++j) { yt[(tch * 8 + 2 * j) * 72 + dl] = (bf16_t)(w[j] & 0xffffu); yt[(tch * 8 + 2 * j + 1) * 72 + dl] = (bf16_t)(w[j] >> 16); }
        }
        __syncthreads();
        {
            const int tl = tid >> 3, dg = tid & 7; const int row = row0 + tl, d0 = dt * 64 + dg * 8;
            float a[8], b[8]; unpack8(*(const LAS u32x4*)(yt + tl * 72 + dg * 8), a); unpack8(*(const u32x4*)(X0S + (size_t)row * 1024 + d0), b);
#pragma unroll
            for (int j = 0; j < 8; ++j) a[j] *= b[j];
            *(u32x4*)(YA + (size_t)row * 1024 + d0) = pack8(a);
        }
        __syncthreads();
    }
}

__device__ __forceinline__ void attn_phase(int wv, const Params& p, LAS unsigned char* lds) {
    const bf16_t* Q = (const bf16_t*)(p.ws + A_Q); const bf16_t* KN = (const bf16_t*)(p.ws + A_KN); const bf16_t* KP = (const bf16_t*)(p.ws + A_KPER);
    const bf16_t* VT = (const bf16_t*)(p.ws + A_VT); bf16_t* O = (bf16_t*)(p.ws + A_OATT);
    LAS unsigned char* Ks = lds;
    LAS unsigned char* Vs = lds + 64 * 400;
    const float sc2 = 0.07216878364870322f * 1.4426950408889634f;
    for (int u = obid(); u < 512 + 128; u += gridDim.x) {
        const int tid = otid(wv), wid = tid >> 6, lane = tid & 63, r = lane & 31, hh = lane >> 5;
        int b, h, row0, Lk, KR0; size_t vtb; bool samp;
        if (u < 512) { samp = true; b = u >> 6; h = (u >> 3) & 7; const int qb = u & 7; row0 = MP + b * LS + qb * 256; Lk = LKS; KR0 = b * LKS; vtb = (size_t)(b * 8 + h) * 128 * LKS; }
        else { samp = false; const int u2 = u - 512; b = u2 >> 3; h = u2 & 7; row0 = b * LP; Lk = LP; KR0 = BS * LKS + b * LP; vtb = (size_t)BS * 8 * 128 * LKS + (size_t)(b * 8 + h) * 128 * LP; }
        const int qrow = row0 + wid * 32 + r;
        bf16x8 qf[12];
        {
            const bf16_t* qp = Q + (size_t)qrow * 1536 + h * 192 + 8 * hh;
            u32x4 qv[12];
#pragma unroll
            for (int s = 0; s < 12; ++s) qv[s] = *(const u32x4*)(qp + 16 * s);
            if (samp) {
                const int t = (qrow - MP) & 2047;
#pragma unroll
                for (int s2 = 0; s2 < 2; ++s2) {
                    float x1[8], x2[8]; unpack8(qv[8 + s2], x1); unpack8(qv[10 + s2], x2);
                    const float* rc = (const float*)(p.ws + S_ROPE) + t * 32 + 16 * s2 + 8 * hh;
                    const f32x4 c0 = *(const f32x4*)rc, c1 = *(const f32x4*)(rc + 4), s0 = *(const f32x4*)(rc + 2048 * 32), s1 = *(const f32x4*)(rc + 2048 * 32 + 4);
#pragma unroll
                    for (int j = 0; j < 8; ++j) { const float cs = (j < 4) ? c0[j & 3] : c1[j & 3], sn = (j < 4) ? s0[j & 3] : s1[j & 3]; const float a = x1[j], c = x2[j]; x1[j] = a * cs - c * sn; x2[j] = a * sn + c * cs; }
                    qv[8 + s2] = pack8(x1); qv[10 + s2] = pack8(x2);
                }
            }
#pragma unroll
            for (int s = 0; s < 12; ++s) qf[s] = __builtin_bit_cast(bf16x8, qv[s]);
        }
        f32x16 oacc[4];
#pragma unroll
        for (int ct = 0; ct < 4; ++ct)
#pragma unroll
            for (int i = 0; i < 16; ++i) oacc[ct][i] = 0.f;
        float mrun = -1e30f, lrun = 0.f;
        const int nkt = Lk / 64;
        u32x4 kst[3], vst[2];
#pragma unroll
        for (int i = 0; i < 3; ++i) { const int ck = tid + i * NTHREADS; const int key = ck / 24, part = ck - key * 24;
            kst[i] = (part < 16) ? *(const u32x4*)(KN + (size_t)(KR0 + key) * 1024 + h * 128 + part * 8) : *(const u32x4*)(KP + (size_t)(KR0 + key) * 64 + (part - 16) * 8); }
#pragma unroll
        for (int i = 0; i < 2; ++i) { const int cv = tid + i * NTHREADS; const int v = cv >> 3, kc = cv & 7; vst[i] = *(const u32x4*)(VT + vtb + (size_t)v * Lk + kc * 8); }
        for (int kt = 0; kt < nkt; ++kt) {
            __syncthreads();
#pragma unroll
            for (int i = 0; i < 3; ++i) { const int ck = tid + i * NTHREADS; const int key = ck / 24, part = ck - key * 24; *(LAS u32x4*)(Ks + key * 400 + part * 16) = kst[i]; }
#pragma unroll
            for (int i = 0; i < 2; ++i) { const int cv = tid + i * NTHREADS; const int v = cv >> 3, kc = cv & 7; *(LAS u32x4*)(Vs + v * 144 + kc * 16) = vst[i]; }
            __syncthreads();
            if (kt + 1 < nkt) {
                const int k0 = (kt + 1) * 64;
#pragma unroll
                for (int i = 0; i < 3; ++i) { const int ck = tid + i * NTHREADS; const int key = ck / 24, part = ck - key * 24;
                    kst[i] = (part < 16) ? *(const u32x4*)(KN + (size_t)(KR0 + k0 + key) * 1024 + h * 128 + part * 8) : *(const u32x4*)(KP + (size_t)(KR0 + k0 + key) * 64 + (part - 16) * 8); }
#pragma unroll
                for (int i = 0; i < 2; ++i) { const int cv = tid + i * NTHREADS; const int v = cv >> 3, kc = cv & 7; vst[i] = *(const u32x4*)(VT + vtb + (size_t)v * Lk + k0 + kc * 8); }
            }
            f32x16 sacc[2];
#pragma unroll
            for (int kk = 0; kk < 2; ++kk) {
#pragma unroll
                for (int i = 0; i < 16; ++i) sacc[kk][i] = 0.f;
#pragma unroll
                for (int s = 0; s < 12; ++s) {
                    const bf16x8 kf = *(const LAS bf16x8*)(Ks + (32 * kk + r) * 400 + (16 * s + 8 * hh) * 2);
                    sacc[kk] = __builtin_amdgcn_mfma_f32_32x32x16_bf16(kf, qf[s], sacc[kk], 0, 0, 0);
                }
            }
            float mx = sacc[0][0];
#pragma unroll
            for (int kk = 0; kk < 2; ++kk)
#pragma unroll
                for (int i = 0; i < 16; ++i) mx = fmaxf(mx, sacc[kk][i]);
            mx = fmaxf(mx, shx(mx, 32, lane));
            const float mnew = fmaxf(mrun, mx);
            const float alpha = __builtin_amdgcn_exp2f((mrun - mnew) * sc2);
            mrun = mnew;
            float ps = 0.f;
#pragma unroll
            for (int kk = 0; kk < 2; ++kk)
#pragma unroll
                for (int i = 0; i < 16; ++i) { const float pv = __builtin_amdgcn_exp2f((sacc[kk][i] - mnew) * sc2); sacc[kk][i] = pv; ps += pv; }
            lrun = lrun * alpha + ps;
#pragma unroll
            for (int ct = 0; ct < 4; ++ct)
#pragma unroll
                for (int i = 0; i < 16; ++i) oacc[ct][i] *= alpha;
#pragma unroll
            for (int ks = 0; ks < 4; ++ks) {
                const int kk = ks >> 1, s2 = ks & 1;
                u32x4 pw;
                pw.x = cvt_pk_bf16(sacc[kk][8 * s2 + 0], sacc[kk][8 * s2 + 1]); pw.y = cvt_pk_bf16(sacc[kk][8 * s2 + 2], sacc[kk][8 * s2 + 3]);
                pw.z = cvt_pk_bf16(sacc[kk][8 * s2 + 4], sacc[kk][8 * s2 + 5]); pw.w = cvt_pk_bf16(sacc[kk][8 * s2 + 6], sacc[kk][8 * s2 + 7]);
                const bf16x8 pf = __builtin_bit_cast(bf16x8, pw);
#pragma unroll
                for (int ct = 0; ct < 4; ++ct) {
                    const LAS unsigned char* vp = Vs + (32 * ct + r) * 144 + (32 * kk + 16 * s2 + 4 * hh) * 2;
                    const u32x2 lo = *(const LAS u32x2*)vp, hi = *(const LAS u32x2*)(vp + 16);
                    u32x4 vw; vw.x = lo.x; vw.y = lo.y; vw.z = hi.x; vw.w = hi.y;
                    oacc[ct] = __builtin_amdgcn_mfma_f32_32x32x16_bf16(__builtin_bit_cast(bf16x8, vw), pf, oacc[ct], 0, 0, 0);
                }
            }
        }
        lrun += shx(lrun, 32, lane);
        const float invl = 1.0f / lrun;
        const int tid2 = otid(wv); const int qrow2 = row0 + (tid2 >> 6) * 32 + (tid2 & 31);
        bf16_t* op = O + (size_t)qrow2 * 1024 + h * 128 + 4 * ((tid2 >> 5) & 1);
#pragma unroll
        for (int ct = 0; ct < 4; ++ct)
#pragma unroll
            for (int g4 = 0; g4 < 4; ++g4) {
                u32x2 w; w.x = cvt_pk_bf16(oacc[ct][4 * g4] * invl, oacc[ct][4 * g4 + 1] * invl); w.y = cvt_pk_bf16(oacc[ct][4 * g4 + 2] * invl, oacc[ct][4 * g4 + 3] * invl);
                *(u32x2*)(op + 32 * ct + 8 * g4) = w;
            }
        __syncthreads();
    }
}

__device__ __forceinline__ void e9_phase(int wv, const Params& p, int l) {
    const bf16_t* UU = (const bf16_t*)(p.ws + A_UU); bf16_t* ACT = (bf16_t*)(p.ws + A_ACT);
    const float* cw = p.in[I_FCW] + (size_t)l * 3 * UU_LD; const float* cb = p.in[I_FCB] + (size_t)l * UU_LD;
    const int tid9 = otid(wv);
    constexpr int RC = 16, NCG = DFF / 8;
    for (int it = obid() * NTHREADS + tid9; it < (MT / RC) * NCG; it += gridDim.x * NTHREADS) {
        const int ch = it / NCG, c0 = (it - ch * NCG) * 8, row0 = ch * RC;
        const int t0 = row0 < MP ? (row0 & 255) : ((row0 - MP) & 2047); const int L = row0 < MP ? LP : LS;
        float wg[3][8], wx[3][8], bg[8], bx[8];
#pragma unroll
        for (int o = 0; o < 3; ++o) { const f32x4 a = *(const f32x4*)(cw + o * UU_LD + c0), b = *(const f32x4*)(cw + o * UU_LD + c0 + 4), c = *(const f32x4*)(cw + o * UU_LD + DFF + c0), d = *(const f32x4*)(cw + o * UU_LD + DFF + c0 + 4);
#pragma unroll
            for (int j = 0; j < 4; ++j) { wg[o][j] = a[j]; wg[o][4 + j] = b[j]; wx[o][j] = c[j]; wx[o][4 + j] = d[j]; } }
        { const f32x4 a = *(const f32x4*)(cb + c0), b = *(const f32x4*)(cb + c0 + 4), c = *(const f32x4*)(cb + DFF + c0), d = *(const f32x4*)(cb + DFF + c0 + 4);
#pragma unroll
          for (int j = 0; j < 4; ++j) { bg[j] = a[j]; bg[4 + j] = b[j]; bx[j] = c[j]; bx[4 + j] = d[j]; } }
        const bf16_t* pr = UU + (size_t)row0 * UU_LD + c0;
        u32x4 gp = (u32x4){0u, 0u, 0u, 0u}, xp = gp, gc, xc, gn, xn;
        if (t0 > 0) { gp = *(const u32x4*)(pr - UU_LD); xp = *(const u32x4*)(pr - UU_LD + DFF); }
        gc = *(const u32x4*)pr; xc = *(const u32x4*)(pr + DFF);
#pragma unroll 4
        for (int i = 0; i < RC; ++i) {
            gn = (u32x4){0u, 0u, 0u, 0u}; xn = gn;
            if (t0 + i + 1 < L) { gn = *(const u32x4*)(pr + (size_t)(i + 1) * UU_LD); xn = *(const u32x4*)(pr + (size_t)(i + 1) * UU_LD + DFF); }
            float a[8], b[8], c[8], ga[8], va[8];
            unpack8(gp, a); unpack8(gc, b); unpack8(gn, c);
#pragma unroll
            for (int j = 0; j < 8; ++j) ga[j] = bg[j] + wg[0][j] * a[j] + wg[1][j] * b[j] + wg[2][j] * c[j];
            unpack8(xp, a); unpack8(xc, b); unpack8(xn, c);
#pragma unroll
            for (int j = 0; j < 8; ++j) va[j] = bx[j] + wx[0][j] * a[j] + wx[1][j] * b[j] + wx[2][j] * c[j];
#pragma unroll
            for (int j = 0; j < 8; ++j) ga[j] = siluf_(ga[j]) * va[j];
            *(u32x4*)(ACT + (size_t)(row0 + i) * DFF + c0) = pack8(ga);
            gp = gc; gc = gn; xp = xc; xc = xn;
        }
    }
}

__device__ __forceinline__ void convert_layer(int wv, const Params& p, int l, LAS unsigned char* lds) {
    unsigned char* ws = p.ws;
    convT(wv, p.in[I_WIN] + (size_t)l * DM * NIN, DM, NIN, (bf16_t*)(ws + W_IN), 1, lds);
    convT(wv, p.in[I_WUQ] + (size_t)l * 512 * 1536, 512, 1536, (bf16_t*)(ws + W_UQ), 0, lds);
    convT(wv, p.in[I_WUKV] + (size_t)l * 256 * 2048, 256, 2048, (bf16_t*)(ws + W_UKV), 2, lds);
    convT(wv, p.in[I_WBRA] + (size_t)l * 1024 * 2048, 1024, 2048, (bf16_t*)(ws + W_BRA), 0, lds);
    convT(wv, p.in[I_WBRB] + (size_t)l * 1024 * 2048, 1024, 2048, (bf16_t*)(ws + W_BRB), 0, lds);
    convT(wv, p.in[I_WBRC] + (size_t)l * 1024 * 2048, 1024, 2048, (bf16_t*)(ws + W_BRC), 0, lds);
    convT(wv, p.in[I_WO] + (size_t)l * 2048 * 2048, 2048, 2048, (bf16_t*)(ws + W_O), 0, lds);
    convT(wv, p.in[I_FUP] + (size_t)l * 2048 * UU_LD, 2048, UU_LD, (bf16_t*)(ws + W_UP), 0, lds);
    convT(wv, p.in[I_FDN] + (size_t)l * DFF * 2048, DFF, 2048, (bf16_t*)(ws + W_DN), 0, lds);
}

namespace pg8 {
struct EpiGateRT {
    const bf16_t* gates; float* m32; bf16_t* mbf; int P;
    __device__ __forceinline__ void operator()(const f32x4 (&acc)[2][2][4][2], const Unit& u, int wr, int wc, int fr, int fq) const {
        const int row0 = u.pm * BM + wr * 64 + fr, col0 = u.pn * BM + wc * 32 + 4 * fq;
#pragma unroll
        for (int ai = 0; ai < 2; ++ai)
#pragma unroll
            for (int m = 0; m < 4; ++m) {
                const size_t row = (size_t)(row0 + ai * HALF + m * 16);
#pragma unroll
                for (int bj = 0; bj < 2; ++bj)
#pragma unroll
                    for (int n = 0; n < 2; ++n) {
                        const int col = col0 + bj * HALF + n * 16;
                        const u32x2 gw = *(const u32x2*)(gates + row * GATE_LD + P * 2048 + col);
                        f32x4 v = acc[ai][bj][m][n];
                        v[0] *= sigmoidf_(bf_lo(gw.x)); v[1] *= sigmoidf_(bf_hi(gw.x)); v[2] *= sigmoidf_(bf_lo(gw.y)); v[3] *= sigmoidf_(bf_hi(gw.y));
                        float* mp = m32 + row * 2048 + col;
                        if (P != 0) { const f32x4 o = *(const f32x4*)mp; v = v + o; }
                        if (P != 2) { *(f32x4*)mp = v; }
                        else { u32x2 w; w.x = cvt_pk_bf16(v[0], v[1]); w.y = cvt_pk_bf16(v[2], v[3]); *(u32x2*)(mbf + row * 2048 + col) = w; }
                    }
            }
    }
};
}


#define XB_TMO      128
#define XB_XCNT(j)  (256  + 64 * (j))
#define XB_XSUB(j)  (1280 + 64 * (j))
#define XB_XGEN(j)  (2304 + 64 * (j))
#define XB_TOP      3328
#define XB_TOPGEN   3392
#define XCD_BAR_WORDS 3456
#define XB_SPIN_CAP (1u << 20)
__device__ __forceinline__ unsigned xb_ld(unsigned* p)              { return __hip_atomic_load(p, __ATOMIC_RELAXED, __HIP_MEMORY_SCOPE_AGENT); }
__device__ __forceinline__ unsigned xb_add(unsigned* p, unsigned v) { return __hip_atomic_fetch_add(p, v, __ATOMIC_RELAXED, __HIP_MEMORY_SCOPE_AGENT); }
__device__ __forceinline__ unsigned xb_xcc_id() { return (unsigned)__builtin_amdgcn_s_getreg((3 << 11) | 20) & 0xFu; }
#define XB_SPIN(cond, bar) do { unsigned _sp = 0; while (cond) { __builtin_amdgcn_s_sleep(1); \
    if ((++_sp & 255u) == 0u) { if (xb_ld(&(bar)[XB_TMO])) break; if (_sp > XB_SPIN_CAP) { atomicAdd(&(bar)[XB_TMO], 1u); break; } } } } while (0)
__device__ __forceinline__ void xcd_barrier_complete(unsigned* bar, unsigned x, unsigned& nloc, unsigned& nx) {
    const unsigned G = gridDim.x;
    unsigned sum, cnt, mine, sp = 0u;
    for (;;) {
        sum = 0u; cnt = 0u; mine = 0u;
#pragma unroll
        for (unsigned j = 0; j < 16; ++j) { const unsigned c = xb_ld(&bar[XB_XCNT(j)]); sum += c; cnt += (c > 0u) ? 1u : 0u; mine = (j == x) ? c : mine; }
        if (sum == G) break;
        __builtin_amdgcn_s_sleep(1);
        if ((++sp & 255u) == 0u) { if (xb_ld(&bar[XB_TMO])) break; if (sp > XB_SPIN_CAP) { atomicAdd(&bar[XB_TMO], 1u); break; } }
    }
    nloc = mine > 0u ? mine : 1u; nx = cnt > 0u ? cnt : 1u;
}
__device__ __forceinline__ void xcd_barrier(int wv, unsigned* bar, volatile LAS unsigned* st) {
    asm volatile("s_waitcnt vmcnt(0)" ::: "memory");
    __syncthreads();
    if (otid(wv) == 0) {
        __builtin_amdgcn_s_waitcnt(0);
        const unsigned x = xb_xcc_id();
        unsigned nloc = st[0], nx = st[1];
        if (nloc == 0u) { xcd_barrier_complete(bar, x, nloc, nx); st[0] = nloc; st[1] = nx; }
        const unsigned old = xb_add(&bar[XB_XSUB(x)], 1u);
        const unsigned gen = old / nloc;
        if (old + 1u == (gen + 1u) * nloc) {
            __builtin_amdgcn_fence(__ATOMIC_RELEASE, "agent");
            asm volatile("s_waitcnt vmcnt(0)" ::: "memory");
            const unsigned og = xb_add(&bar[XB_TOP], 1u);
            const unsigned tg = og / nx;
            if (og + 1u == (tg + 1u) * nx) xb_add(&bar[XB_TOPGEN], 1u);
            else XB_SPIN(xb_ld(&bar[XB_TOPGEN]) == tg, bar);
            __builtin_amdgcn_fence(__ATOMIC_ACQUIRE, "agent");
            xb_add(&bar[XB_XGEN(x)], 1u);
            asm volatile("s_waitcnt vmcnt(0)" ::: "memory");
        } else {
            XB_SPIN(xb_ld(&bar[XB_XGEN(x)]) == gen, bar);
            __builtin_amdgcn_fence(__ATOMIC_ACQUIRE, "agent");
            asm volatile("s_waitcnt vmcnt(0)" ::: "memory");
        }
    }
    __syncthreads();
}

#ifndef REP_GEMM
#define REP_GEMM 1
#endif
#ifndef REP_ATTN
#define REP_ATTN 1
#endif
#ifndef REP_CONV
#define REP_CONV 1
#endif
#ifndef REP_ELT
#define REP_ELT 1
#endif
#ifndef REP_CVT
#define REP_CVT 1
#endif
enum { K_G1A = 0, K_E2, K_I3, K_I4, K_G1B, K_G5, K_G6, K_ROW1, K_G8, K_E9, K_G10, K_ROW2, K_PRO, K_ROW0, K_COMB };

__global__ void __launch_bounds__(NTHREADS) fwd_megakernel(Params p) {
    extern __shared__ __attribute__((aligned(16))) unsigned char shm[];
    LAS unsigned char* lds = (LAS unsigned char*)shm;
    cg::grid_group grid = cg::this_grid();
    const int wv = __builtin_amdgcn_readfirstlane((int)(threadIdx.x >> 6));
    volatile LAS unsigned* bst = (volatile LAS unsigned*)(lds + 131072);
    unsigned* bar = (unsigned*)(p.ws + S_BAR);
    if (threadIdx.x == 0) { bst[0] = 0u; bst[1] = 0u; bst[2] = 0u; bst[3] = 0u; (void)xb_add(&bar[XB_XCNT(xb_xcc_id())], 1u); }
    __syncthreads();
#pragma unroll 1
    for (int ph = 0; ph < 3 + 12 * NLAYER; ++ph) {
        int kind, l;
        if (ph == 0) { kind = K_PRO; l = 0; } else if (ph == 1) { kind = K_COMB; l = 0; } else if (ph == 2) { kind = K_ROW0; l = 0; } else { l = (ph - 3) / 12; kind = (ph - 3) - l * 12; }
        unsigned char* ws = p.ws;
        asm volatile("" : "+s"(ws));
        if (kind == K_G1A || kind == K_I3 || kind == K_G1B || kind == K_G8) {
            const bf16_t* A; const bf16_t* Bt; bf16_t* O; int N, K;
            if (kind == K_G1A) { A = (const bf16_t*)(ws + A_H); Bt = (const bf16_t*)(ws + W_IN); O = (bf16_t*)(ws + A_PROJA); N = PA_LD; K = DM; }
            else if (kind == K_I3) { A = (const bf16_t*)(ws + A_CQN); Bt = (const bf16_t*)(ws + W_UQ); O = (bf16_t*)(ws + A_Q); N = 1536; K = 512; }
            else if (kind == K_G1B) { A = (const bf16_t*)(ws + A_H); Bt = (const bf16_t*)(ws + W_IN) + (size_t)PA_LD * DM; O = (bf16_t*)(ws + A_GATES); N = GATE_LD; K = DM; }
            else { A = (const bf16_t*)(ws + A_H); Bt = (const bf16_t*)(ws + W_UP); O = (bf16_t*)(ws + A_UU); N = UU_LD; K = DM; }
            int Mr = MT;
            const int nrep = ((kind == K_I3) ? 2 : 1) * REP_GEMM;
#pragma unroll 1
            for (int rp = 0; rp < nrep; ++rp) {
                if (kind == K_I3 && rp >= REP_GEMM) { A = (const bf16_t*)(ws + A_KEYSC); Bt = (const bf16_t*)(ws + W_UKV); O = (bf16_t*)(ws + A_KN); N = 1024; K = 256; Mr = KROWS; }
                run_gemm(wv, lds, A, Bt, Mr, N, K, pg8::EpiBf16{O, N});
            }
        }
        if (kind == K_I3) {
#pragma unroll 1
            for (int rp = 0; rp < REP_GEMM; ++rp)
            run_gemm(wv, lds, (const bf16_t*)(ws + W_UKV) + (size_t)1024 * 256, (const bf16_t*)(ws + A_KEYSC), 1024, KROWS, 256,
                     pg8::EpiVT{(bf16_t*)(ws + A_VT), (bf16_t*)(ws + A_VT) + (size_t)BS * 8 * 128 * LKS});
#pragma unroll 1
            for (int rp = 0; rp < REP_CONV; ++rp) conv_phase(wv, p, l, lds);
        }
        if (kind == K_I4) {
#pragma unroll 1
            for (int rp = 0; rp < REP_ATTN; ++rp) attn_phase(wv, p, lds);
#pragma unroll 1
            for (int rp = 0; rp < REP_ELT; ++rp) e3b_phase(wv, p, lds); }
        if (kind == K_G5) {
#pragma unroll 1
            for (int P3 = 0; P3 < 3 * REP_GEMM; ++P3) { const int P = P3 % 3;
                const bf16_t* A = (const bf16_t*)(ws + (P == 0 ? A_YA : (P == 1 ? A_OATT : A_YC)));
                const bf16_t* Bt = (const bf16_t*)(ws + (P == 0 ? W_BRA : (P == 1 ? W_BRB : W_BRC)));
                run_gemm(wv, lds, A, Bt, MT, DM, 1024, pg8::EpiGateRT{(const bf16_t*)(ws + A_GATES), (float*)(ws + A_M32), (bf16_t*)(ws + A_MBF), P});
            }
        }
        if (kind == K_G6 || kind == K_G10) {
            const bool g6 = (kind == K_G6);
#pragma unroll 1
            for (int rp = 0; rp < REP_GEMM; ++rp)
            run_gemm(wv, lds, (const bf16_t*)(ws + (g6 ? A_MBF : A_ACT)), (const bf16_t*)(ws + (g6 ? W_O : W_DN)), MT, DM, g6 ? DM : DFF, pg8::EpiBf16{(bf16_t*)(ws + (g6 ? A_M32 : A_F32)), DM});
        }
        if (kind == K_E2) {
#pragma unroll 1
            for (int rp = 0; rp < REP_ELT; ++rp) e2_phase(wv, p, l, lds); }
        if (kind == K_E9) {
#pragma unroll 1
            for (int rp = 0; rp < REP_ELT; ++rp) e9_phase(wv, p, l); }
        if (kind == K_ROW0 || kind == K_ROW1 || kind == K_ROW2) row_phase(wv, p, l, kind == K_ROW0 ? 0 : (kind == K_ROW1 ? 1 : 2));
        if (kind == K_COMB) comb_phase(wv, p);
        if (kind == K_PRO) { ada_phase(wv, p, lds); rope_table_phase(wv, p); }
        if (kind == K_PRO || (kind == K_ROW2 && l + 1 < NLAYER)) { const int ln = (kind == K_PRO) ? 0 : l + 1;
#pragma unroll 1
            for (int rp = 0; rp < REP_CVT; ++rp) { filter_phase(wv, p, ln, lds); convert_layer(wv, p, ln, lds); } }
        if (ph == 0) grid.sync(); else xcd_barrier(wv, bar, bst);
    }
}

extern "C" void kernel_launch(void* const* d_in, const int* in_sizes, int n_in, void* d_out, int out_size, void* d_ws, size_t ws_size, hipStream_t stream) {
    static int grid_blocks = 0;
    if (grid_blocks == 0) {
        if (n_in != N_INPUTS || ws_size < WS_NEED) { fprintf(stderr, "kernel_launch: need %d inputs and %zu bytes of workspace; got %d, %zu\n", N_INPUTS, (size_t)WS_NEED, n_in, ws_size); grid_blocks = -1; return; }
        int dev = 0, cus = 0, per_cu = 0;
        hipGetDevice(&dev);
        hipDeviceGetAttribute(&cus, hipDeviceAttributeMultiprocessorCount, dev);
        if (hipFuncSetAttribute((const void*)fwd_megakernel, hipFuncAttributeMaxDynamicSharedMemorySize, LDS_BYTES) != hipSuccess) { fprintf(stderr, "kernel_launch: hipFuncSetAttribute failed\n"); grid_blocks = -1; return; }
        if (hipOccupancyMaxActiveBlocksPerMultiprocessor(&per_cu, (const void*)fwd_megakernel, NTHREADS, LDS_BYTES) != hipSuccess || per_cu < 1) { fprintf(stderr, "kernel_launch: occupancy query gave %d\n", per_cu); per_cu = 1; }
        (void)hipGetLastError();
        grid_blocks = cus * 1;
    }
    if (grid_blocks < 0) return;
        (void)hipMemsetAsync((unsigned char*)d_ws + S_BAR, 0, 16384, stream);
    Params p{};
    for (int i = 0; i < N_INPUTS; ++i) p.in[i] = (const float*)d_in[i];
    p.out = (float*)d_out; p.ws = (unsigned char*)d_ws;
    void* args[] = {&p};
    hipError_t e = hipLaunchCooperativeKernel((const void*)fwd_megakernel, dim3(grid_blocks), dim3(NTHREADS), args, LDS_BYTES, stream);
    if (e != hipSuccess) fprintf(stderr, "cooperative launch failed: %s (grid %d)\n", hipGetErrorString(e), grid_blocks);
}
```

```cpp
#include <hip/hip_runtime.h>
#include <hip/hip_cooperative_groups.h>
#include <cstdio>
namespace cg = cooperative_groups;

#define LAS __attribute__((address_space(3)))
typedef unsigned short bf16_t;
typedef short bf16x8 __attribute__((ext_vector_type(8)));
typedef float f32x4 __attribute__((ext_vector_type(4)));
typedef float f32x16 __attribute__((ext_vector_type(16)));
typedef unsigned u32x4 __attribute__((ext_vector_type(4)));
typedef unsigned u32x2 __attribute__((ext_vector_type(2)));
typedef float f32x2 __attribute__((ext_vector_type(2)));

constexpr int DM = 2048, MP = 4096, MS = 16384, MT = 20480, NLAYER = 2;
constexpr int LP = 256, LS = 2048, BP = 16, BS = 8, PAST = 512, LKS = 2560;
constexpr int NIN = 13120, NGATE0 = 6976, PA_LD = 7168, GATE_LD = 6144;
constexpr int DFF = 5632, UU_LD = 11264;
constexpr int KROWS = 24576;
constexpr int NTHREADS = 512;
constexpr int LDS_BYTES = 131072 + 16;

enum { I_XP = 0, I_XS, I_C, I_CCKV, I_CKPE, I_CCTX, I_ADAW, I_ADAB, I_NMPRE, I_NMPOST, I_NFPRE, I_NFPOST, I_WIN, I_HCW, I_HCB,
       I_FW1, I_FB1, I_FW2, I_FB2, I_FW3, I_FB3, I_FFREQ, I_HBIAS, I_QN, I_KVN, I_WUQ, I_WUKV, I_SCW, I_WBRA, I_WBRB, I_WBRC,
       I_WO, I_FUP, I_FCW, I_FCB, I_FDN, N_INPUTS };

constexpr size_t E_WIN = (size_t)13312 * 2048, E_WUQ = (size_t)1536 * 512, E_WUKV = (size_t)2048 * 256, E_WBR = (size_t)2048 * 1024,
                 E_WO = (size_t)2048 * 2048, E_WUP = (size_t)11264 * 2048, E_WDN = (size_t)2048 * 5632;
constexpr size_t W_IN = 0, W_UQ = W_IN + E_WIN * 2, W_UKV = W_UQ + E_WUQ * 2, W_BRA = W_UKV + E_WUKV * 2, W_BRB = W_BRA + E_WBR * 2,
                 W_BRC = W_BRB + E_WBR * 2, W_O = W_BRC + E_WBR * 2, W_UP = W_O + E_WO * 2, W_DN = W_UP + E_WUP * 2, W_END = W_DN + E_WDN * 2;
constexpr size_t S_MOD = W_END, SZ_MOD = (size_t)NLAYER * 16 * 9 * 12288 * 4;
constexpr size_t S_KTS = S_MOD + SZ_MOD, S_KTP = S_KTS + (size_t)1024 * 4096 * 4, S_PARTS = S_KTP + (size_t)1024 * 512 * 4,
                 S_PARTP = S_PARTS + (size_t)64 * 2048 * 4, S_ROPE = S_PARTP + (size_t)8 * 2048 * 4, S_BAR = S_ROPE + (size_t)2 * 2048 * 32 * 4, S_COMB = S_BAR + 16384, S_SCALE = S_COMB + (size_t)NLAYER * 3 * 9 * 3 * 2048 * 4, S_TAIL = S_SCALE + 8192, S_END = S_TAIL + 512;
constexpr size_t AR = S_END;
constexpr size_t SZ_H = (size_t)MT * 2048 * 2;
constexpr size_t A_H = AR, A_UU = AR + SZ_H, A_ACT = A_UU + (size_t)MT * UU_LD * 2, AR_END = A_ACT + (size_t)MT * DFF * 2;
constexpr size_t A_PROJA = A_UU;
constexpr size_t A_Q = A_UU, A_KN = A_Q + (size_t)MT * 1536 * 2, A_VT = A_KN + (size_t)KROWS * 1024 * 2, A_YCT = A_VT + (size_t)KROWS * 1024 * 2;
constexpr size_t A_GATES = A_UU, A_M32 = A_GATES + (size_t)MT * GATE_LD * 2, A_MBF = A_H, A_F32 = A_UU;
constexpr size_t A_S = A_M32 + (size_t)MT * 2048 * 4;
constexpr size_t A_ZZT = A_S, A_X0S = A_ZZT + (size_t)MT * 1024 * 2, A_CQN = A_X0S + (size_t)MT * 1024 * 2, A_KEYSC = A_CQN + (size_t)MT * 512 * 2,
                 A_KPER = A_KEYSC + (size_t)KROWS * 256 * 2, A_YC = A_KPER + (size_t)KROWS * 64 * 2, A_YA = A_YC + (size_t)MT * 1024 * 2,
                 A_OATT = A_YA + (size_t)MT * 1024 * 2, A_SEND = A_OATT + (size_t)MT * 1024 * 2;
static_assert(A_SEND <= AR_END, "arena overflow");
static_assert(A_YCT + (size_t)MT * 1024 * 2 <= A_M32, "arena overlap");
constexpr size_t WS_NEED = AR_END;
static_assert(WS_NEED <= 967590400ull, "workspace too large");

struct Params {
    const float* in[N_INPUTS];
    float* out;
    unsigned char* ws;
};

__device__ __forceinline__ unsigned cvt_pk_bf16(float lo, float hi) { unsigned r; asm volatile("v_cvt_pk_bf16_f32 %0, %1, %2" : "=v"(r) : "v"(lo), "v"(hi)); return r; }
__device__ __forceinline__ bf16_t f2bf(float f) { return (bf16_t)(cvt_pk_bf16(f, 0.f) & 0xffffu); }
__device__ __forceinline__ float bf_lo(unsigned w) { return __uint_as_float(w << 16); }
__device__ __forceinline__ float bf_hi(unsigned w) { return __uint_as_float(w & 0xffff0000u); }
__device__ __forceinline__ void unpack8(const u32x4 v, float* f) { f[0] = bf_lo(v.x); f[1] = bf_hi(v.x); f[2] = bf_lo(v.y); f[3] = bf_hi(v.y); f[4] = bf_lo(v.z); f[5] = bf_hi(v.z); f[6] = bf_lo(v.w); f[7] = bf_hi(v.w); }
__device__ __forceinline__ u32x4 pack8(const float* f) { u32x4 r; r.x = cvt_pk_bf16(f[0], f[1]); r.y = cvt_pk_bf16(f[2], f[3]); r.z = cvt_pk_bf16(f[4], f[5]); r.w = cvt_pk_bf16(f[6], f[7]); return r; }
__device__ __forceinline__ float shx(float v, int mask, int lane) { return __int_as_float(__builtin_amdgcn_ds_bpermute((lane ^ mask) << 2, __float_as_int(v))); }
__device__ __forceinline__ float wave_sum(float v, int lane) {
#pragma unroll
    for (int o = 32; o >= 1; o >>= 1) v += shx(v, o, lane);
    return v;
}
__device__ __forceinline__ int otid(int wv) { int t; asm volatile("v_mbcnt_lo_u32_b32 %0, -1, 0\n\tv_mbcnt_hi_u32_b32 %0, -1, %0" : "=v"(t)); return wv * 64 + t; }
__device__ __forceinline__ int obid() { int t = blockIdx.x; asm volatile("" : "+s"(t)); return t; }
__device__ __forceinline__ float sigmoidf_(float x) { return 1.0f / (1.0f + __expf(-x)); }
__device__ __forceinline__ float siluf_(float x) { return x / (1.0f + __expf(-x)); }

namespace pg8 {
constexpr int BM = 256, BK = 64, HALF = 128, HTB = HALF * BK * 2, STAGE_BYTES = 8 * HTB, NXCD = 8, WGM = 8;
__host__ __device__ __forceinline__ int lds_byte(int r, int c) { const int st = (r >> 4) * 2 + (c >> 5), rr = r & 15, cc = c & 31, ob = rr * 64 + cc * 2; return st * 1024 + (ob ^ (((ob >> 9) & 1) << 5)); }
__host__ __device__ __forceinline__ void stage_rc(int b, int& R, int& C) { const int st = b / 1024, sb = b % 1024, swz = sb ^ (((sb >> 9) & 1) << 5); R = (st >> 1) * 16 + swz / 64; C = (st & 1) * 32 + (swz % 64) / 2; }
struct Unit { int pm, pn, kh; };
struct Gemm { const bf16_t* A; const bf16_t* Bt; int M, N, K; };
struct StaticOrder {
    int nM, nN, nwg, G, c, nfull;
    __device__ void init(int M, int N, int G_, int c_, bool split = false) { nM = M / BM; nN = N / BM; nwg = nM * nN; G = G_; c = c_;
        nfull = nwg; if (split) { const int rem = nwg % G; if (rem > 0 && 2 * rem <= G) nfull = nwg - rem; } }
    __device__ void tile_of(int wgid, Unit& u) const {
        { const int q = nwg / NXCD, r = nwg % NXCD, xcd = wgid % NXCD, off = wgid / NXCD; wgid = (xcd < r ? xcd * (q + 1) : r * (q + 1) + (xcd - r) * q) + off; }
        const int nig = WGM * nN, gid = wgid / nig, fm = gid * WGM, gsz = (nM - fm) < WGM ? (nM - fm) : WGM;
        u.pm = fm + ((wgid % nig) % gsz); u.pn = (wgid % nig) / gsz;
    }
    __device__ bool next(int i, Unit& u) const {
        const long L = (long)i * G + c;
        int tile = (int)L, kh = -1; bool ok = L < nwg;
        if (L >= nfull) { const long h = L - nfull; ok = h < 2 * (long)(nwg - nfull); tile = nfull + (int)(h >> 1); kh = (int)(h & 1); }
        if (!ok) return false;
        int pm, pn;
        { int wgid = tile; const int q = nwg / NXCD, r = nwg % NXCD, xcd = wgid % NXCD, off = wgid / NXCD; wgid = (xcd < r ? xcd * (q + 1) : r * (q + 1) + (xcd - r) * q) + off;
          const int nig = WGM * nN, gid = wgid / nig, fm = gid * WGM, gsz = (nM - fm) < WGM ? (nM - fm) : WGM;
          pm = fm + ((wgid % nig) % gsz); pn = (wgid % nig) / gsz; }
        u.pm = pm; u.pn = pn; u.kh = kh; return true;
    }
};
template <class Epi>
__device__ __forceinline__ void gemm_phase(int wv, LAS unsigned char* lds, const Gemm g, const StaticOrder& S, const Epi& E) {
    const int tid = otid(wv), wid = __builtin_amdgcn_readfirstlane(tid >> 6), lane = tid & 63, wr = wid >> 2, wc = wid & 3, fr = lane & 15, fq = lane >> 4;
    const int K = g.K, nt = K / BK;
    unsigned voffA[2];
#pragma unroll
    for (int i = 0; i < 2; ++i) { int R, C; stage_rc(tid * 16 + i * 8192, R, C); voffA[i] = (unsigned)(R * K + C) * 2u; }
    const size_t kstep = (size_t)(BK * 2);
    const size_t hstep = (size_t)HALF * K * 2;
    const size_t tstep = 2 * hstep;
    const unsigned ldsw = (unsigned)wid * 1024u;
    const int aoff = lds_byte(wr * 64 + fr, fq * 8), boff = lds_byte(wc * 32 + fr, fq * 8);
#define PG8_SA(b, h) (((b) * 2 + (h)) * HTB)
#define PG8_SB(b, h) ((4 + (b) * 2 + (h)) * HTB)
#define PG8_STAGE(bufoff, gbase, voff) do { _Pragma("unroll") for (int _i = 0; _i < 2; ++_i) \
        __builtin_amdgcn_global_load_lds((const unsigned*)((const char*)(gbase) + (voff)[_i]), (LAS unsigned*)(lds + (bufoff) + ldsw + _i * 8192), 16, 0, 0); } while (0)
#define PG8_LDA(dst, b, h) do { _Pragma("unroll") for (int m = 0; m < 4; ++m) _Pragma("unroll") for (int k = 0; k < 2; ++k) dst[m][k] = *(const LAS bf16x8*)(lds + PG8_SA(b, h) + aoff + m * 2048 + k * 1024); } while (0)
#define PG8_LDB(dst, b, h) do { _Pragma("unroll") for (int n = 0; n < 2; ++n) _Pragma("unroll") for (int k = 0; k < 2; ++k) dst[n][k] = *(const LAS bf16x8*)(lds + PG8_SB(b, h) + boff + n * 2048 + k * 1024); } while (0)
#define PG8_MMA(ai, bj, At, Bt) do { __builtin_amdgcn_s_setprio(1); _Pragma("unroll") for (int m = 0; m < 4; ++m) _Pragma("unroll") for (int n = 0; n < 2; ++n) _Pragma("unroll") for (int k = 0; k < 2; ++k) \
        acc[ai][bj][m][n] = __builtin_amdgcn_mfma_f32_16x16x32_bf16(Bt[n][k], At[m][k], acc[ai][bj][m][n], 0, 0, 0); __builtin_amdgcn_s_setprio(0); } while (0)
#define PG8_WAIT_V(n) asm volatile("s_waitcnt vmcnt(" #n ")" ::: "memory")
#define PG8_WAIT_L(n) asm volatile("s_waitcnt lgkmcnt(" #n ")" ::: "memory")
#define PG8_BAR __builtin_amdgcn_s_barrier()
#define PG8_SCHED __builtin_amdgcn_sched_barrier(0)
    Unit cur, nxt; int ui = 0;
    if (!S.next(0, cur)) return;
    f32x4 acc[2][2][4][2];
#pragma unroll
    for (int a = 0; a < 2; ++a)
#pragma unroll
        for (int b = 0; b < 2; ++b)
#pragma unroll
            for (int m = 0; m < 4; ++m)
#pragma unroll
                for (int n = 0; n < 2; ++n) acc[a][b][m][n] = (f32x4){0.f, 0.f, 0.f, 0.f};
    bf16x8 At[4][2], B0[2][2], B1[2][2];
    const size_t khoff = (size_t)(nt / 2) * kstep;
    const char* cA = (const char*)g.A + (size_t)cur.pm * tstep + (cur.kh == 1 ? khoff : 0); const char* cB = (const char*)g.Bt + (size_t)cur.pn * tstep + (cur.kh == 1 ? khoff : 0);
    PG8_STAGE(PG8_SB(0, 0), cB, voffA); PG8_STAGE(PG8_SA(0, 0), cA, voffA); PG8_STAGE(PG8_SB(0, 1), cB + hstep, voffA); PG8_STAGE(PG8_SA(0, 1), cA + hstep, voffA);
    if (wr == 1) PG8_BAR;
    PG8_WAIT_V(4); PG8_BAR;
    PG8_STAGE(PG8_SB(1, 0), cB + kstep, voffA); PG8_STAGE(PG8_SA(1, 0), cA + kstep, voffA); PG8_STAGE(PG8_SB(1, 1), cB + hstep + kstep, voffA);
    PG8_WAIT_V(6); PG8_BAR;
    for (;;) {
        const bool has_next = S.next(ui + 1, nxt);
        const char* nA = has_next ? (const char*)g.A + (size_t)nxt.pm * tstep + (nxt.kh == 1 ? khoff : 0) : cA; const char* nB = has_next ? (const char*)g.Bt + (size_t)nxt.pn * tstep + (nxt.kh == 1 ? khoff : 0) : cB;
        const int ntu = (cur.kh < 0) ? nt : (nt >> 1);
        for (int t = 0; t < ntu; t += 2) {
            const bool last = (t == ntu - 2);
            const char* a1 = cA + (size_t)(t + 1) * kstep;
            const char* a2 = last ? nA : cA + (size_t)(t + 2) * kstep; const char* b2 = last ? nB : cB + (size_t)(t + 2) * kstep;
            const char* a3 = a2 + kstep; const char* b3 = b2 + kstep;
            PG8_LDB(B0, 0, 0); PG8_SCHED; PG8_LDA(At, 0, 0); PG8_STAGE(PG8_SA(1, 1), a1 + hstep, voffA);
            PG8_WAIT_L(8); PG8_BAR; PG8_WAIT_L(0); PG8_MMA(0, 0, At, B0); PG8_BAR; PG8_SCHED;
            PG8_LDB(B1, 0, 1); PG8_STAGE(PG8_SB(0, 0), b2, voffA);
            PG8_BAR; PG8_WAIT_L(0); PG8_MMA(0, 1, At, B1); PG8_BAR;
            PG8_LDA(At, 0, 1); PG8_STAGE(PG8_SA(0, 0), a2, voffA);
            PG8_BAR; PG8_WAIT_L(0); PG8_MMA(1, 0, At, B0); PG8_BAR; PG8_SCHED;
            PG8_STAGE(PG8_SB(0, 1), b2 + hstep, voffA);
            PG8_WAIT_V(6); PG8_BAR; PG8_MMA(1, 1, At, B1); PG8_BAR;
            PG8_LDB(B0, 1, 0); PG8_SCHED; PG8_LDA(At, 1, 0); PG8_STAGE(PG8_SA(0, 1), a2 + hstep, voffA);
            PG8_WAIT_L(8); PG8_BAR; PG8_WAIT_L(0); PG8_MMA(0, 0, At, B0); PG8_BAR; PG8_SCHED;
            PG8_LDB(B1, 1, 1); PG8_STAGE(PG8_SB(1, 0), b3, voffA);
            PG8_BAR; PG8_WAIT_L(0); PG8_MMA(0, 1, At, B1); PG8_BAR;
            PG8_LDA(At, 1, 1); PG8_STAGE(PG8_SA(1, 0), a3, voffA);
            PG8_BAR; PG8_WAIT_L(0); PG8_MMA(1, 0, At, B0); PG8_BAR; PG8_SCHED;
            PG8_STAGE(PG8_SB(1, 1), b3 + hstep, voffA);
            PG8_WAIT_V(6); PG8_BAR; PG8_MMA(1, 1, At, B1); PG8_BAR;
        }
        { const int t2 = otid(wv); const int l2 = t2 & 63, w2 = __builtin_amdgcn_readfirstlane(t2 >> 6); E(acc, cur, w2 >> 2, w2 & 3, l2 & 15, l2 >> 4); }
        if (!has_next) break;
#pragma unroll
        for (int a = 0; a < 2; ++a)
#pragma unroll
            for (int b = 0; b < 2; ++b)
#pragma unroll
                for (int m = 0; m < 4; ++m)
#pragma unroll
                    for (int n = 0; n < 2; ++n) acc[a][b][m][n] = (f32x4){0.f, 0.f, 0.f, 0.f};
        cur = nxt; cA = nA; cB = nB; ++ui;
    }
    PG8_WAIT_V(0);
    if (wr == 0) PG8_BAR;
    PG8_BAR;
#undef PG8_SA
#undef PG8_SB
#undef PG8_STAGE
#undef PG8_LDA
#undef PG8_LDB
#undef PG8_MMA
#undef PG8_WAIT_V
#undef PG8_WAIT_L
#undef PG8_BAR
#undef PG8_SCHED
}

struct EpiBf16 {
    bf16_t* O; int ldc; bf16_t* O2;
    __device__ __forceinline__ void operator()(const f32x4 (&acc)[2][2][4][2], const Unit& u, int wr, int wc, int fr, int fq) const {
        const int row0 = u.pm * BM + wr * 64 + fr, col0 = u.pn * BM + wc * 32 + 4 * fq;
        bf16_t* Ob = (u.kh == 1) ? O2 : O;
#pragma unroll
        for (int ai = 0; ai < 2; ++ai)
#pragma unroll
            for (int m = 0; m < 4; ++m) { bf16_t* rowp = Ob + (size_t)(row0 + ai * HALF + m * 16) * ldc + col0;
#pragma unroll
                for (int bj = 0; bj < 2; ++bj)
#pragma unroll
                    for (int n = 0; n < 2; ++n) { const f32x4 v = acc[ai][bj][m][n]; u32x2 w; w.x = cvt_pk_bf16(v[0], v[1]); w.y = cvt_pk_bf16(v[2], v[3]); *(u32x2*)(rowp + bj * HALF + n * 16) = w; } }
    }
};
struct EpiF32 {
    float* C; int ldc;
    __device__ __forceinline__ void operator()(const f32x4 (&acc)[2][2][4][2], const Unit& u, int wr, int wc, int fr, int fq) const {
        const int row0 = u.pm * BM + wr * 64 + fr, col0 = u.pn * BM + wc * 32 + 4 * fq;
#pragma unroll
        for (int ai = 0; ai < 2; ++ai)
#pragma unroll
            for (int m = 0; m < 4; ++m) { float* rowp = C + (size_t)(row0 + ai * HALF + m * 16) * ldc + col0;
#pragma unroll
                for (int bj = 0; bj < 2; ++bj)
#pragma unroll
                    for (int n = 0; n < 2; ++n) *(f32x4*)(rowp + bj * HALF + n * 16) = acc[ai][bj][m][n]; }
    }
};
struct EpiVT {
    bf16_t* VTs; bf16_t* VTp;
    __device__ __forceinline__ void operator()(const f32x4 (&acc)[2][2][4][2], const Unit& u, int wr, int wc, int fr, int fq) const {
        const int KR0 = u.pn * BM;
        bf16_t* vt; int Lk;
        if (KR0 < BS * LKS) { const int b = KR0 / LKS; Lk = LKS; vt = VTs + (size_t)b * 1024 * LKS + (KR0 - b * LKS); }
        else { const int b = (KR0 - BS * LKS) >> 8; Lk = LP; vt = VTp + (size_t)b * 1024 * LP; }
        const int row0 = u.pm * BM + wr * 64 + fr, col0 = wc * 32 + 4 * fq;
#pragma unroll
        for (int ai = 0; ai < 2; ++ai)
#pragma unroll
            for (int m = 0; m < 4; ++m) { bf16_t* rowp = vt + (size_t)(row0 + ai * HALF + m * 16) * Lk + col0;
#pragma unroll
                for (int bj = 0; bj < 2; ++bj)
#pragma unroll
                    for (int n = 0; n < 2; ++n) { const f32x4 v = acc[ai][bj][m][n]; u32x2 w; w.x = cvt_pk_bf16(v[0], v[1]); w.y = cvt_pk_bf16(v[2], v[3]); *(u32x2*)(rowp + bj * HALF + n * 16) = w; } }
    }
};
template <int P> struct EpiGate {
    const bf16_t* gates; float* m32; bf16_t* mbf;
    __device__ __forceinline__ void operator()(const f32x4 (&acc)[2][2][4][2], const Unit& u, int wr, int wc, int fr, int fq) const {
        const int row0 = u.pm * BM + wr * 64 + fr, col0 = u.pn * BM + wc * 32 + 4 * fq;
#pragma unroll
        for (int ai = 0; ai < 2; ++ai)
#pragma unroll
            for (int m = 0; m < 4; ++m) {
                const size_t row = (size_t)(row0 + ai * HALF + m * 16);
#pragma unroll
                for (int bj = 0; bj < 2; ++bj)
#pragma unroll
                    for (int n = 0; n < 2; ++n) {
                        const int col = col0 + bj * HALF + n * 16;
                        const u32x2 gw = *(const u32x2*)(gates + row * GATE_LD + P * 2048 + col);
                        f32x4 v = acc[ai][bj][m][n];
                        v[0] *= sigmoidf_(bf_lo(gw.x)); v[1] *= sigmoidf_(bf_hi(gw.x)); v[2] *= sigmoidf_(bf_lo(gw.y)); v[3] *= sigmoidf_(bf_hi(gw.y));
                        float* mp = m32 + row * 2048 + col;
                        if (P == 0) { *(f32x4*)mp = v; }
                        else if (P == 1) { const f32x4 o = *(const f32x4*)mp; *(f32x4*)mp = o + v; }
                        else { const f32x4 o = *(const f32x4*)mp; v = v + o; u32x2 w; w.x = cvt_pk_bf16(v[0], v[1]); w.y = cvt_pk_bf16(v[2], v[3]); *(u32x2*)(mbf + row * 2048 + col) = w; }
                    }
            }
    }
};
}

template <class Epi>
__device__ __forceinline__ void run_gemm(int wv, LAS unsigned char* lds, const bf16_t* A, const bf16_t* Bt, int M, int N, int K, const Epi& E, bool split = false) {
    pg8::Gemm g; g.A = A; g.Bt = Bt; g.M = M; g.N = N; g.K = K;
    pg8::StaticOrder S; S.init(M, N, (int)gridDim.x, obid(), split);
    pg8::gemm_phase<Epi>(wv, lds, g, S, E);
    __syncthreads();
}

__device__ __forceinline__ void convT(int wv, const float* __restrict__ src, int K, int N, bf16_t* __restrict__ dst, int gate_shift, LAS unsigned char* lds) {
    const int tid = otid(wv), lane = tid & 63, kq = lane & 7, ng = lane >> 3;
    const int tn = N / 32, tk = K / 64, ntile = tn * tk, nwaves = gridDim.x * 8;
    for (int tile = obid() * 8 + (tid >> 6); tile < ntile; tile += 2 * nwaves) {
        const int tile2 = tile + nwaves; const bool has2 = tile2 < ntile;
        const int tkk = tile / tn, tnn = tile - tkk * tn, k0 = tkk * 64 + 8 * kq, n0 = tnn * 32 + 4 * ng;
        const int tkk2 = has2 ? tile2 / tn : tkk, tnn2 = has2 ? tile2 - tkk2 * tn : tnn, k02 = tkk2 * 64 + 8 * kq, n02 = tnn2 * 32 + 4 * ng;
        f32x4 v[8], v2[8];
#pragma unroll
        for (int i = 0; i < 8; ++i) v[i] = *(const f32x4*)(src + (size_t)(k0 + i) * N + n0);
#pragma unroll
        for (int i = 0; i < 8; ++i) v2[i] = *(const f32x4*)(src + (size_t)(k02 + i) * N + n02);
#pragma unroll
        for (int j = 0; j < 4; ++j) {
            int nd = n0 + j; if (gate_shift == 1 && nd >= NGATE0) nd += 192; if (gate_shift == 2) { const int hd = nd >> 8, wi = nd & 255; nd = (wi < 128) ? hd * 128 + wi : 1024 + hd * 128 + (wi - 128); }
            u32x4 w; w.x = cvt_pk_bf16(v[0][j], v[1][j]); w.y = cvt_pk_bf16(v[2][j], v[3][j]); w.z = cvt_pk_bf16(v[4][j], v[5][j]); w.w = cvt_pk_bf16(v[6][j], v[7][j]);
            *(u32x4*)(dst + (size_t)nd * K + k0) = w;
        }
        if (has2) {
#pragma unroll
            for (int j = 0; j < 4; ++j) {
                int nd = n02 + j; if (gate_shift == 1 && nd >= NGATE0) nd += 192; if (gate_shift == 2) { const int hd = nd >> 8, wi = nd & 255; nd = (wi < 128) ? hd * 128 + wi : 1024 + hd * 128 + (wi - 128); }
                u32x4 w; w.x = cvt_pk_bf16(v2[0][j], v2[1][j]); w.y = cvt_pk_bf16(v2[2][j], v2[3][j]); w.z = cvt_pk_bf16(v2[4][j], v2[5][j]); w.w = cvt_pk_bf16(v2[6][j], v2[7][j]);
                *(u32x4*)(dst + (size_t)nd * K + k02) = w;
            }
        }
    }
}

__device__ __forceinline__ void ada_phase(int wv, const Params& p, LAS unsigned char* lds) {
    LAS float* sl = (LAS float*)lds;
    float* mod = (float*)(p.ws + S_MOD);
    const int tid = otid(wv);
    for (int u = obid(); u < NLAYER * 6 * 16; u += gridDim.x) {
        const int l = u / 96, r = u % 96, cb = r % 6, kc = r / 6, k0 = kc * 128;
        for (int i = tid; i < 9 * 128; i += NTHREADS) { const int v = i >> 7, k = i & 127; const float x = (v == 0) ? p.in[I_CCTX][k0 + k] : p.in[I_C][(v - 1) * DM + k0 + k]; sl[i] = siluf_(x); }
        __syncthreads();
        const int col = cb * 2048 + tid * 4;
        f32x4 acc[9];
#pragma unroll
        for (int i = 0; i < 9; ++i) acc[i] = (f32x4){0.f, 0.f, 0.f, 0.f};
        const float* wp = p.in[I_ADAW] + ((size_t)l * DM + k0) * 12288 + col;
#pragma unroll 8
        for (int k = 0; k < 128; ++k) {
            const f32x4 w = *(const f32x4*)(wp + (size_t)k * 12288);
#pragma unroll
            for (int i = 0; i < 9; ++i) acc[i] += sl[i * 128 + k] * w;
        }
#pragma unroll
        for (int i = 0; i < 9; ++i) *(f32x4*)(mod + ((size_t)(l * 16 + kc) * 9 + i) * 12288 + col) = acc[i];
        __syncthreads();
    }
}

__device__ __forceinline__ void filter_phase(int wv, const Params& p, int l, LAS unsigned char* lds) {
    LAS float* z = (LAS float*)lds;
    LAS float* H1 = z + 32 * 33;
    LAS float* H2 = H1 + 32 * 64;
    LAS float* W1 = H2 + 32 * 64;
    LAS float* W2 = W1 + 33 * 64;
    LAS float* BF = W2 + 64 * 64;
    const int tid = otid(wv);
    const float* w3 = p.in[I_FW3] + (size_t)l * 64 * 2048; const float* b3 = p.in[I_FB3] + l * 2048;
    for (int u = obid(); u < 72; u += gridDim.x) {
        const int g = (u < 64) ? 1 : 0; const int tc = g ? u : u - 64; const int L = g ? LS : LP; const int t0 = tc * 32;
        float* kT = (float*)(p.ws + (g ? S_KTS : S_KTP)); float* part = (float*)(p.ws + (g ? S_PARTS : S_PARTP));
        for (int i = tid; i < 33 * 64; i += NTHREADS) W1[i] = p.in[I_FW1][(size_t)l * 33 * 64 + i];
        for (int i = tid; i < 64 * 64; i += NTHREADS) W2[i] = p.in[I_FW2][(size_t)l * 64 * 64 + i];
        if (tid < 64) BF[tid] = p.in[I_FB1][l * 64 + tid]; else if (tid < 128) BF[tid] = p.in[I_FB2][l * 64 + tid - 64]; else if (tid < 256) BF[tid] = p.in[I_FFREQ][l * 128 + tid - 128];
        for (int i = tid; i < 32 * 33; i += NTHREADS) {
            const int t = i / 33, e = i - t * 33; const float tf = (float)(t0 + t);
            float v;
            if (e == 0) v = tf / (float)(L - 1);
            else { const int k = (e - 1) & 15; const float band = 1e-4f + (float)k * ((15.0f - 1e-4f) / 15.0f); const float w = (6.283185307179586f * tf) / (float)L; const float ang = w * band;
                   v = (e <= 16) ? cosf(ang) : -sinf(ang); }
            z[i] = v;
        }
        __syncthreads();
#pragma unroll
        for (int q = 0; q < 4; ++q) { const int i = tid + q * NTHREADS; const int t = i >> 6, j = i & 63; float s = BF[j];
#pragma unroll
            for (int e = 0; e < 33; ++e) s += z[t * 33 + e] * W1[e * 64 + j];
            H1[i] = sinf(BF[128 + j] * s); }
        __syncthreads();
#pragma unroll
        for (int q = 0; q < 4; ++q) { const int i = tid + q * NTHREADS; const int t = i >> 6, j = i & 63; float s = BF[64 + j];
#pragma unroll 16
            for (int e = 0; e < 64; ++e) s += H1[t * 64 + e] * W2[e * 64 + j];
            H2[i] = sinf(BF[192 + j] * s); }
        __syncthreads();
        const int c = tid * 4;
        const f32x4 bias = *(const f32x4*)(b3 + c);
        f32x4 delta;
#pragma unroll
        for (int j = 0; j < 4; ++j) { const int d = (c + j) & 1023; const float mn = -3.0701134573253945f, mx = -15.350567286626973f; delta[j] = fabsf(mn + (float)d * ((mx - mn) / 1023.0f)); }
        f32x4 psum = (f32x4){0.f, 0.f, 0.f, 0.f};
        for (int tb = 0; tb < 2; ++tb) {
            f32x4 acc[16];
#pragma unroll
            for (int i = 0; i < 16; ++i) acc[i] = bias;
#pragma unroll 8
            for (int k = 0; k < 64; ++k) {
                const f32x4 w = *(const f32x4*)(w3 + (size_t)k * 2048 + c);
#pragma unroll
                for (int i = 0; i < 16; ++i) acc[i] += H2[(tb * 16 + i) * 64 + k] * w;
            }
#pragma unroll
            for (int i = 0; i < 16; ++i) {
                const int t = t0 + tb * 16 + i; const float tn = (float)t / (float)(L - 1);
#pragma unroll
                for (int j = 0; j < 4; ++j) {
                    const float v = acc[i][j] * __expf(-tn * delta[j]);
                    const int cc = c + j;
                    if (cc < 1024) { kT[(size_t)cc * (2 * L) + t] = v; psum[j] += fabsf(v); }
                    else { const int d = cc - 1024; if (t == 0) kT[(size_t)d * (2 * L) + L] = 0.f; else { kT[(size_t)d * (2 * L) + 2 * L - t] = v; psum[j] += fabsf(v); } }
                }
            }
        }
        *(f32x4*)(part + (size_t)tc * 2048 + c) = psum;
        __syncthreads();
    }
}

__device__ __forceinline__ void row_sel(const Params& p, int l, int mode, int& l2, int& shi, int& sci, const float*& prew, bool& wh, int& gi, const float*& pw) {
    wh = true;
    if (mode == 0) { l2 = l; shi = 0; sci = 1; prew = p.in[I_NMPRE] + l * DM; }
    else if (mode == 1) { l2 = l; shi = 3; sci = 4; prew = p.in[I_NFPRE] + l * DM; }
    else { l2 = l + 1; shi = 0; sci = 1; wh = (l + 1 < NLAYER); if (!wh) l2 = l; prew = p.in[I_NMPRE] + l2 * DM; }
    gi = (mode == 1) ? 2 : 5;
    pw = p.in[mode == 1 ? I_NMPOST : I_NFPOST] + l * DM;
}
__device__ __forceinline__ void comb_phase(int wv, const Params& p) {
    const int tid = otid(wv);
    const float* mod = (const float*)(p.ws + S_MOD); float* comb = (float*)(p.ws + S_COMB);
    for (int idx = obid() * NTHREADS + tid; idx < NLAYER * 3 * 9 * 2048; idx += gridDim.x * NTHREADS) {
        const int c = idx & 2047, q = idx >> 11, mi = q % 9, q2 = q / 9, mode = q2 % 3, l = q2 / 3;
        int l2, shi, sci, gi; const float* prew; const float* pw; bool wh;
        row_sel(p, l, mode, l2, shi, sci, prew, wh, gi, pw);
        float g = 0.f, sc = 0.f, sh = 0.f;
        for (int kc = 0; kc < 16; ++kc) {
            g += mod[((size_t)(l * 16 + kc) * 9 + mi) * 12288 + gi * 2048 + c];
            sc += mod[((size_t)(l2 * 16 + kc) * 9 + mi) * 12288 + sci * 2048 + c];
            sh += mod[((size_t)(l2 * 16 + kc) * 9 + mi) * 12288 + shi * 2048 + c];
        }
        g += p.in[I_ADAB][(size_t)l * 12288 + gi * 2048 + c];
        sc += p.in[I_ADAB][(size_t)l2 * 12288 + sci * 2048 + c];
        sh += p.in[I_ADAB][(size_t)l2 * 12288 + shi * 2048 + c];
        float* o = comb + (size_t)q * 3 * 2048 + c;
        o[0] = g * pw[c]; o[2048] = prew[c] * (1.0f + sc); o[4096] = sh;
    }
}
__device__ __forceinline__ void row_phase(int wv, const Params& p, int l, int mode) {
    const int tid = otid(wv); const int wave = obid() * 8 + (tid >> 6), nw = gridDim.x * 8, lane = tid & 63;
    float* X = p.out;
    bf16_t* H = (bf16_t*)(p.ws + A_H);
    const bool wh = !(mode == 2 && l + 1 >= NLAYER);
    const int rows_per = (MT + nw - 1) / nw;
    for (int rr = 0; rr < rows_per; ++rr) {
        const int row = wave * rows_per + rr;
        if (row >= MT) break;
        const int mi = row < MP ? 0 : 1 + ((row - MP) >> 11);
        const float* cb = (const float*)(p.ws + S_COMB) + (size_t)((l * 3 + mode) * 9 + mi) * 3 * 2048 + lane * 4;
        f32x4 x[8];
        const float* xs = (mode == 0) ? (row < MP ? p.in[I_XP] + (size_t)row * DM : p.in[I_XS] + (size_t)(row - MP) * DM) : X + (size_t)row * DM;
#pragma unroll
        for (int i = 0; i < 8; ++i) x[i] = *(const f32x4*)(xs + i * 256 + lane * 4);
        if (mode != 0) {
            const bf16_t* o = (const bf16_t*)(p.ws + (mode == 1 ? A_M32 : A_F32)) + (size_t)row * DM;
            const unsigned tm = ((const unsigned*)(p.ws + S_TAIL))[row >> 8];
            f32x4 ovv[8]; float ss = 0.f;
#pragma unroll
            for (int i = 0; i < 8; ++i) { const u32x2 w = *(const u32x2*)(o + i * 256 + lane * 4); ovv[i] = (f32x4){bf_lo(w.x), bf_hi(w.x), bf_lo(w.y), bf_hi(w.y)};
                if ((tm >> i) & 1u) { const u32x2 w2 = *(const u32x2*)(o + (size_t)MT * DM + i * 256 + lane * 4); ovv[i] += (f32x4){bf_lo(w2.x), bf_hi(w2.x), bf_lo(w2.y), bf_hi(w2.y)}; }
                ss += ovv[i][0] * ovv[i][0] + ovv[i][1] * ovv[i][1] + ovv[i][2] * ovv[i][2] + ovv[i][3] * ovv[i][3]; }
            ss = wave_sum(ss, lane);
            const float rstd = rsqrtf(ss * (1.0f / DM) + 1e-6f);
#pragma unroll
            for (int i = 0; i < 8; ++i) x[i] += *(const f32x4*)(cb + i * 256) * (ovv[i] * rstd);
        }
#pragma unroll
        for (int i = 0; i < 8; ++i) *(f32x4*)(X + (size_t)row * DM + i * 256 + lane * 4) = x[i];
        if (wh) {
            float ss = 0.f;
#pragma unroll
            for (int i = 0; i < 8; ++i) ss += x[i][0] * x[i][0] + x[i][1] * x[i][1] + x[i][2] * x[i][2] + x[i][3] * x[i][3];
            ss = wave_sum(ss, lane);
            const float rstd = rsqrtf(ss * (1.0f / DM) + 1e-6f);
#pragma unroll
            for (int i = 0; i < 8; ++i) {
                const f32x4 hv = (x[i] * rstd) * *(const f32x4*)(cb + 2048 + i * 256) + *(const f32x4*)(cb + 4096 + i * 256);
                u32x2 o; o.x = cvt_pk_bf16(hv[0], hv[1]); o.y = cvt_pk_bf16(hv[2], hv[3]);
                *(u32x2*)(H + (size_t)row * DM + i * 256 + lane * 4) = o;
            }
        }
    }
}

__device__ __forceinline__ void rope_table_phase(int wv, const Params& p) {
    float* C = (float*)(p.ws + S_ROPE); float* Sn = C + 2048 * 32;
    const int tid = otid(wv);
    for (int idx = obid() * NTHREADS + tid; idx < 2048 * 32; idx += gridDim.x * NTHREADS) {
        const int t = idx >> 5, i = idx & 31, k = i & 15;
        const float inv = exp2f(-(float)k * 0.8304820237218406f);
        const float pos = (i < 16) ? (float)(t >> 6) : (float)(t & 63);
        const float ang = pos * inv; C[idx] = cosf(ang); Sn[idx] = sinf(ang);
    }
}
__device__ __forceinline__ void e2_phase(int wv, const Params& p, int l, LAS unsigned char* lds) {
    const bf16_t* PA = (const bf16_t*)(p.ws + A_PROJA);
    const int tid = otid(wv), lane = tid & 63;
    {
        const int gidx = obid() * NTHREADS + tid;
        if (gidx < 2048) {
            const int g = gidx >> 10, d = gidx & 1023; const int NU = g ? 64 : 8;
            const float* part = (const float*)(p.ws + (g ? S_PARTS : S_PARTP));
            float tot = 0.f;
            for (int i = 0; i < NU; ++i) tot += part[i * 2048 + d] + part[i * 2048 + 1024 + d];
            ((float*)(p.ws + S_SCALE))[gidx] = 1.0f / tot;
        }
    }
    {
        bf16_t* CQN = (bf16_t*)(p.ws + A_CQN); bf16_t* KC = (bf16_t*)(p.ws + A_KEYSC); bf16_t* KP = (bf16_t*)(p.ws + A_KPER);
        float* out_ckv = p.out + (size_t)MT * DM; float* out_kpe = out_ckv + (size_t)BP * NLAYER * LP * 256;
        const int wave = obid() * 8 + (tid >> 6), nw = gridDim.x * 8;
        for (int row = wave; row < MT + BS * PAST; row += nw) {
            if (row < MT) {
                const bf16_t* pr = PA + (size_t)row * PA_LD;
                { const u32x4 v = *(const u32x4*)(pr + 3072 + lane * 8); float f[8]; unpack8(v, f); float ss = 0.f;
#pragma unroll
                  for (int j = 0; j < 8; ++j) ss += f[j] * f[j];
                  ss = wave_sum(ss, lane); const float rstd = rsqrtf(ss * (1.0f / 512.0f) + 1e-6f);
                  const float* qn = p.in[I_QN] + l * 512 + lane * 8;
#pragma unroll
                  for (int j = 0; j < 8; ++j) f[j] = f[j] * rstd * qn[j];
                  *(u32x4*)(CQN + (size_t)row * 512 + lane * 8) = pack8(f); }
                int KR, t; const bool isp = row < MP; int b;
                if (isp) { b = row >> 8; t = row & 255; KR = BS * LKS + row; } else { const int r2 = row - MP; b = r2 >> 11; t = r2 & 2047; KR = b * LKS + t; }
                { const u32x2 v = *(const u32x2*)(pr + 3584 + lane * 4); float f[4] = {bf_lo(v.x), bf_hi(v.x), bf_lo(v.y), bf_hi(v.y)};
                  float ss = f[0] * f[0] + f[1] * f[1] + f[2] * f[2] + f[3] * f[3]; ss = wave_sum(ss, lane); const float rstd = rsqrtf(ss * (1.0f / 256.0f) + 1e-6f);
                  const float* kn = p.in[I_KVN] + l * 256 + lane * 4;
#pragma unroll
                  for (int j = 0; j < 4; ++j) f[j] = f[j] * rstd * kn[j];
                  if (isp) *(f32x4*)(out_ckv + ((size_t)(b * NLAYER + l) * LP + t) * 256 + lane * 4) = (f32x4){f[0], f[1], f[2], f[3]};
                  u32x2 w; w.x = cvt_pk_bf16(f[0], f[1]); w.y = cvt_pk_bf16(f[2], f[3]); *(u32x2*)(KC + (size_t)KR * 256 + lane * 4) = w; }
                { const float v = __uint_as_float(((unsigned)pr[3840 + lane]) << 16);
                  float o = v;
                  if (isp) out_kpe[((size_t)(b * NLAYER + l) * LP + t) * 64 + lane] = v;
                  else { const float pv = shx(v, 32, lane); const float* rc = (const float*)(p.ws + S_ROPE); const float cs = rc[t * 32 + (lane & 31)], sn = rc[2048 * 32 + t * 32 + (lane & 31)]; o = (lane < 32) ? (v * cs - pv * sn) : (pv * sn + v * cs); }
                  KP[(size_t)KR * 64 + lane] = f2bf(o); }
            } else {
                const int r2 = row - MT, b = r2 >> 9, j = r2 & 511; const int KR = b * LKS + LS + j;
                const float* cc = p.in[I_CCKV] + ((size_t)(b * NLAYER + l) * PAST + j) * 256 + lane * 4;
                const f32x4 v = *(const f32x4*)cc; u32x2 w; w.x = cvt_pk_bf16(v[0], v[1]); w.y = cvt_pk_bf16(v[2], v[3]); *(u32x2*)(KC + (size_t)KR * 256 + lane * 4) = w;
                KP[(size_t)KR * 64 + lane] = f2bf(p.in[I_CKPE][((size_t)(b * NLAYER + l) * PAST + j) * 64 + lane]);
            }
        }
    }
    {
        bf16_t* YC = (bf16_t*)(p.ws + A_YC); const float* scw = p.in[I_SCW] + (size_t)l * 3 * 1024;
        for (int it = obid() * NTHREADS + tid; it < (MT / 4) * 128; it += gridDim.x * NTHREADS) {
            const int ch = it >> 7, d0 = (it & 127) * 8, row0 = ch * 4;
            const int t0 = row0 < MP ? (row0 & 255) : ((row0 - MP) & 2047); const int L = row0 < MP ? LP : LS;
            float w0[8], w1[8], w2[8];
            { const f32x4 a = *(const f32x4*)(scw + d0), b = *(const f32x4*)(scw + d0 + 4), c = *(const f32x4*)(scw + 1024 + d0), d = *(const f32x4*)(scw + 1024 + d0 + 4),
                          e2 = *(const f32x4*)(scw + 2048 + d0), f = *(const f32x4*)(scw + 2048 + d0 + 4);
#pragma unroll
              for (int j = 0; j < 4; ++j) { w0[j] = a[j]; w0[4 + j] = b[j]; w1[j] = c[j]; w1[4 + j] = d[j]; w2[j] = e2[j]; w2[4 + j] = f[j]; } }
            const bf16_t* pr = PA + (size_t)row0 * PA_LD;
            float pp[8], pc[8], pn[8];
#pragma unroll
            for (int j = 0; j < 8; ++j) pp[j] = 0.f;
            if (t0 > 0) { float cg[8], uu[8]; unpack8(*(const u32x4*)(pr - PA_LD + 4928 + d0), cg); unpack8(*(const u32x4*)(pr - PA_LD + 5952 + d0), uu);
#pragma unroll
                for (int j = 0; j < 8; ++j) pp[j] = cg[j] * uu[j]; }
            { float cg[8], uu[8]; unpack8(*(const u32x4*)(pr + 4928 + d0), cg); unpack8(*(const u32x4*)(pr + 5952 + d0), uu);
#pragma unroll
              for (int j = 0; j < 8; ++j) pc[j] = cg[j] * uu[j]; }
#pragma unroll
            for (int i = 0; i < 4; ++i) {
#pragma unroll
                for (int j = 0; j < 8; ++j) pn[j] = 0.f;
                if (t0 + i + 1 < L) { float cg[8], uu[8]; unpack8(*(const u32x4*)(pr + (size_t)(i + 1) * PA_LD + 4928 + d0), cg); unpack8(*(const u32x4*)(pr + (size_t)(i + 1) * PA_LD + 5952 + d0), uu);
#pragma unroll
                    for (int j = 0; j < 8; ++j) pn[j] = cg[j] * uu[j]; }
                float bg[8], o[8]; unpack8(*(const u32x4*)(pr + (size_t)i * PA_LD + 3904 + d0), bg);
#pragma unroll
                for (int j = 0; j < 8; ++j) { o[j] = bg[j] * (w0[j] * pp[j] + w1[j] * pc[j] + w2[j] * pn[j]); pp[j] = pc[j]; pc[j] = pn[j]; }
                *(u32x4*)(YC + (size_t)(row0 + i) * 1024 + d0) = pack8(o);
            }
        }
    }
    {
        bf16_t* X0S = (bf16_t*)(p.ws + A_X0S); bf16_t* ZZT = (bf16_t*)(p.ws + A_ZZT);
        const float* hw = p.in[I_HCW] + (size_t)l * 3 * 3072; const float* hb = p.in[I_HCB] + (size_t)l * 3072;
        LAS bf16_t* zt = (LAS bf16_t*)lds;
        for (int u = obid(); u < (MT / 256) * 16; u += gridDim.x) {
            const int rt = u >> 4, dt = u & 15; const int row0 = rt * 256;
            const int dg = tid & 7, rb = tid >> 3, d0 = dt * 64 + dg * 8; const int rowb = row0 + rb * 4;
            const int L = row0 < MP ? LP : LS; const int tb = (row0 < MP ? (row0 & 255) : ((row0 - MP) & 2047)) + rb * 4;
            float wgt[3][3][8], bs[3][8];
#pragma unroll
            for (int g = 0; g < 3; ++g) {
#pragma unroll
                for (int o = 0; o < 3; ++o) { const f32x4 a = *(const f32x4*)(hw + o * 3072 + g * 1024 + d0), b = *(const f32x4*)(hw + o * 3072 + g * 1024 + d0 + 4);
#pragma unroll
                    for (int j = 0; j < 4; ++j) { wgt[g][o][j] = a[j]; wgt[g][o][4 + j] = b[j]; } }
                const f32x4 a = *(const f32x4*)(hb + g * 1024 + d0), b = *(const f32x4*)(hb + g * 1024 + d0 + 4);
#pragma unroll
                for (int j = 0; j < 4; ++j) { bs[g][j] = a[j]; bs[g][4 + j] = b[j]; }
            }
            const bf16_t* pr = PA + (size_t)rowb * PA_LD + d0;
            u32x4 wp[3], wc[3], wn[3];
#pragma unroll
            for (int g = 0; g < 3; ++g) { wp[g] = (u32x4){0u, 0u, 0u, 0u}; if (tb > 0) wp[g] = *(const u32x4*)(pr - PA_LD + g * 1024); wc[g] = *(const u32x4*)(pr + g * 1024); }
#pragma unroll
            for (int i = 0; i < 4; ++i) {
#pragma unroll
                for (int g = 0; g < 3; ++g) { wn[g] = (u32x4){0u, 0u, 0u, 0u}; if (tb + i + 1 < L) wn[g] = *(const u32x4*)(pr + (size_t)(i + 1) * PA_LD + g * 1024); }
                float hv[3][8];
#pragma unroll
                for (int g = 0; g < 3; ++g) { float a[8], b[8], c[8]; unpack8(wp[g], a); unpack8(wc[g], b); unpack8(wn[g], c);
#pragma unroll
                    for (int j = 0; j < 8; ++j) hv[g][j] = bs[g][j] + wgt[g][0][j] * a[j] + wgt[g][1][j] * b[j] + wgt[g][2][j] * c[j];
                    wp[g] = wc[g]; wc[g] = wn[g]; }
                *(u32x4*)(X0S + (size_t)(rowb + i) * 1024 + d0) = pack8(hv[0]);
#pragma unroll
                for (int j = 0; j < 8; ++j) zt[(dg * 8 + j) * 264 + rb * 4 + i] = f2bf(hv[1][j] * hv[2][j]);
            }
            __syncthreads();
#pragma unroll
            for (int i = 0; i < 4; ++i) {
                const int chunk = tid + i * NTHREADS; const int dl = chunk >> 5, tch = chunk & 31; const int d = dt * 64 + dl;
                size_t base; int t0;
                if (row0 < MP) { const int b = row0 >> 8; t0 = 0; base = ((size_t)b * 1024 + d) * LP; }
                else { const int r2 = row0 - MP; const int b = r2 >> 11; t0 = r2 & 2047; base = (size_t)BP * 1024 * LP + ((size_t)b * 1024 + d) * LS; }
                *(u32x4*)(ZZT + base + t0 + tch * 8) = *(const LAS u32x4*)(zt + dl * 264 + tch * 8);
            }
            __syncthreads();
        }
    }
}

__device__ __forceinline__ void conv_phase(int wv, const Params& p, int l, LAS unsigned char* lds) {
    const int tid = otid(wv), wid = tid >> 6, lane = tid & 63, r = lane & 31, hh = lane >> 5;
    const bf16_t* ZZT = (const bf16_t*)(p.ws + A_ZZT); bf16_t* YCT = (bf16_t*)(p.ws + A_YCT);
    const float* hbias = p.in[I_HBIAS] + l * 1024;
    LAS bf16_t* cp = (LAS bf16_t*)lds;
    LAS bf16_t* zz = (LAS bf16_t*)(lds + 65536);
    LAS float* kf = (LAS float*)(lds + 98304);
    for (int u = obid(); u < 2048; u += gridDim.x) {
        const int g = (u < 1024) ? 1 : 0, d = u & 1023;
        const int L = g ? LS : LP, B = g ? BS : BP, L2 = 2 * L, NB = L / 32, NI = 32 / B, NT = NB / NI, lgB = g ? 3 : 4;
        const float* kT = (const float*)(p.ws + (g ? S_KTS : S_KTP)) + (size_t)d * L2;
        const float scale = ((const float*)(p.ws + S_SCALE))[g * 1024 + d]; const float bias = hbias[d];
        for (int i = tid; i < L2 / 4; i += NTHREADS) { f32x4 v = *(const f32x4*)(kT + i * 4); v *= scale; if (i == 0) v[0] += bias; *(LAS f32x4*)(kf + i * 4) = v; }
        const size_t zbase = g ? (size_t)BP * 1024 * LP : 0;
        for (int ch = tid; ch < B * L / 8; ch += NTHREADS) {
            const int b = ch / (L / 8), s8 = ch - b * (L / 8);
            *(LAS u32x4*)(zz + b * L + s8 * 8) = *(const u32x4*)(ZZT + zbase + ((size_t)b * 1024 + d) * L + s8 * 8);
        }
        __syncthreads();
        for (int ck = tid; ck < L2; ck += NTHREADS) {
            const int c = ck / (L2 / 8), m0 = (ck - c * (L2 / 8)) * 8;
            float f[8];
#pragma unroll
            for (int j = 0; j < 8; ++j) f[j] = kf[(L2 - (m0 + c + j)) & (L2 - 1)];
            *(LAS u32x4*)(cp + c * L2 + m0) = pack8(f);
        }
        __syncthreads();
        const int Iloc = r >> lgB, b = r & (B - 1);
        for (int nt = wid * 2; nt < NT; nt += 16) {
            const int I0 = nt * NI;
            f32x16 acc0, acc1;
#pragma unroll
            for (int i = 0; i < 16; ++i) { acc0[i] = 0.f; acc1[i] = 0.f; }
            for (int dl = I0 - (NB - 1); dl <= I0 + 2 * NI - 1; ++dl) {
                const int J0 = I0 + Iloc - dl, J1 = J0 + NI; const bool v0 = (J0 >= 0) && (J0 < NB), v1 = (J1 >= 0) && (J1 < NB);
#pragma unroll
                for (int ks = 0; ks < 2; ++ks) {
                    const int i0 = (16 * ks + 8 * hh - 32 * dl - r) & (L2 - 1); const int c = i0 & 7, q = i0 >> 3;
                    const bf16x8 Af = *(const LAS bf16x8*)(cp + c * L2 + q * 8);
                    bf16x8 B0 = (bf16x8){0, 0, 0, 0, 0, 0, 0, 0}, B1 = B0;
                    if (v0) B0 = *(const LAS bf16x8*)(zz + b * L + 32 * J0 + 16 * ks + 8 * hh);
                    if (v1) B1 = *(const LAS bf16x8*)(zz + b * L + 32 * J1 + 16 * ks + 8 * hh);
                    acc0 = __builtin_amdgcn_mfma_f32_32x32x16_bf16(Af, B0, acc0, 0, 0, 0);
                    acc1 = __builtin_amdgcn_mfma_f32_32x32x16_bf16(Af, B1, acc1, 0, 0, 0);
                }
            }
            bf16_t* op = YCT + zbase + ((size_t)b * 1024 + d) * L + 32 * (I0 + Iloc) + 4 * hh;
#pragma unroll
            for (int g4 = 0; g4 < 4; ++g4) {
                u32x2 w; w.x = cvt_pk_bf16(acc0[4 * g4], acc0[4 * g4 + 1]); w.y = cvt_pk_bf16(acc0[4 * g4 + 2], acc0[4 * g4 + 3]); *(u32x2*)(op + 8 * g4) = w;
                u32x2 w1; w1.x = cvt_pk_bf16(acc1[4 * g4], acc1[4 * g4 + 1]); w1.y = cvt_pk_bf16(acc1[4 * g4 + 2], acc1[4 * g4 + 3]); *(u32x2*)(op + 32 * NI + 8 * g4) = w1;
            }
        }
        __syncthreads();
    }
}

__device__ __forceinline__ void e3b_phase(int wv, const Params& p, LAS unsigned char* lds) {
    const int tid = otid(wv);
    const bf16_t* X0S = (const bf16_t*)(p.ws + A_X0S); const bf16_t* YCT = (const bf16_t*)(p.ws + A_YCT); bf16_t* YA = (bf16_t*)(p.ws + A_YA);
    LAS bf16_t* yt = (LAS bf16_t*)lds;
    for (int u = obid(); u < (MT / 64) * 16; u += gridDim.x) {
        const int rt = u >> 4, dt = u & 15; const int row0 = rt * 64;
        {
            const int dl = tid >> 3, tch = tid & 7; const int d = dt * 64 + dl;
            size_t base; int t0;
            if (row0 < MP) { const int b = row0 >> 8; t0 = row0 & 255; base = ((size_t)b * 1024 + d) * LP; }
            else { const int r2 = row0 - MP; const int b = r2 >> 11; t0 = r2 & 2047; base = (size_t)BP * 1024 * LP + ((size_t)b * 1024 + d) * LS; }
            const u32x4 v = *(const u32x4*)(YCT + base + t0 + tch * 8);
            const unsigned w[4] = {v.x, v.y, v.z, v.w};
#pragma unroll
            for (int j = 0; j < 4; ++j) { yt[(tch * 8 + 2 * j) * 72 + dl] = (bf16_t)(w[j] & 0xffffu); yt[(tch * 8 + 2 * j + 1) * 72 + dl] = (bf16_t)(w[j] >> 16); }
        }
        __syncthreads();
        {
            const int tl = tid >> 3, dg = tid & 7; const int row = row0 + tl, d0 = dt * 64 + dg * 8;
            float a[8], b[8]; unpack8(*(const LAS u32x4*)(yt + tl * 72 + dg * 8), a); unpack8(*(const u32x4*)(X0S + (size_t)row * 1024 + d0), b);
#pragma unroll
            for (int j = 0; j < 8; ++j) a[j] *= b[j];
            *(u32x4*)(YA + (size_t)row * 1024 + d0) = pack8(a);
        }
        __syncthreads();
    }
}

__device__ __forceinline__ void attn_phase(int wv, const Params& p, LAS unsigned char* lds) {
    const bf16_t* Q = (const bf16_t*)(p.ws + A_Q); const bf16_t* KN = (const bf16_t*)(p.ws + A_KN); const bf16_t* KP = (const bf16_t*)(p.ws + A_KPER);
    const bf16_t* VT = (const bf16_t*)(p.ws + A_VT); bf16_t* O = (bf16_t*)(p.ws + A_OATT);
    LAS unsigned char* Ks = lds;
    LAS unsigned char* Vs = lds + 64 * 400;
    const float sc2 = 0.07216878364870322f * 1.4426950408889634f;
    for (int u = obid(); u < 512 + 128; u += gridDim.x) {
        const int tid = otid(wv), wid = tid >> 6, lane = tid & 63, r = lane & 31, hh = lane >> 5;
        int b, h, row0, Lk, KR0; size_t vtb; bool samp;
        if (u < 512) { samp = true; b = u >> 6; h = (u >> 3) & 7; const int qb = u & 7; row0 = MP + b * LS + qb * 256; Lk = LKS; KR0 = b * LKS; vtb = (size_t)(b * 8 + h) * 128 * LKS; }
        else { samp = false; const int u2 = u - 512; b = u2 >> 3; h = u2 & 7; row0 = b * LP; Lk = LP; KR0 = BS * LKS + b * LP; vtb = (size_t)BS * 8 * 128 * LKS + (size_t)(b * 8 + h) * 128 * LP; }
        const int qrow = row0 + wid * 32 + r;
        bf16x8 qf[12];
        {
            const bf16_t* qp = Q + (size_t)qrow * 1536 + h * 192 + 8 * hh;
            u32x4 qv[12];
#pragma unroll
            for (int s = 0; s < 12; ++s) qv[s] = *(const u32x4*)(qp + 16 * s);
            if (samp) {
                const int t = (qrow - MP) & 2047;
#pragma unroll
                for (int s2 = 0; s2 < 2; ++s2) {
                    float x1[8], x2[8]; unpack8(qv[8 + s2], x1); unpack8(qv[10 + s2], x2);
                    const float* rc = (const float*)(p.ws + S_ROPE) + t * 32 + 16 * s2 + 8 * hh;
                    const f32x4 c0 = *(const f32x4*)rc, c1 = *(const f32x4*)(rc + 4), s0 = *(const f32x4*)(rc + 2048 * 32), s1 = *(const f32x4*)(rc + 2048 * 32 + 4);
#pragma unroll
                    for (int j = 0; j < 8; ++j) { const float cs = (j < 4) ? c0[j & 3] : c1[j & 3], sn = (j < 4) ? s0[j & 3] : s1[j & 3]; const float a = x1[j], c = x2[j]; x1[j] = a * cs - c * sn; x2[j] = a * sn + c * cs; }
                    qv[8 + s2] = pack8(x1); qv[10 + s2] = pack8(x2);
                }
            }
#pragma unroll
            for (int s = 0; s < 12; ++s) qf[s] = __builtin_bit_cast(bf16x8, qv[s]);
        }
        f32x16 oacc[4];
#pragma unroll
        for (int ct = 0; ct < 4; ++ct)
#pragma unroll
            for (int i = 0; i < 16; ++i) oacc[ct][i] = 0.f;
        float mrun = -1e30f, lrun = 0.f;
        const int nkt = Lk / 64;
        u32x4 kst[3], vst[2];
#pragma unroll
        for (int i = 0; i < 3; ++i) { const int ck = tid + i * NTHREADS; const int key = ck / 24, part = ck - key * 24;
            kst[i] = (part < 16) ? *(const u32x4*)(KN + (size_t)(KR0 + key) * 1024 + h * 128 + part * 8) : *(const u32x4*)(KP + (size_t)(KR0 + key) * 64 + (part - 16) * 8); }
#pragma unroll
        for (int i = 0; i < 2; ++i) { const int cv = tid + i * NTHREADS; const int v = cv >> 3, kc = cv & 7; vst[i] = *(const u32x4*)(VT + vtb + (size_t)v * Lk + kc * 8); }
        for (int kt = 0; kt < nkt; ++kt) {
            __syncthreads();
#pragma unroll
            for (int i = 0; i < 3; ++i) { const int ck = tid + i * NTHREADS; const int key = ck / 24, part = ck - key * 24; *(LAS u32x4*)(Ks + key * 400 + part * 16) = kst[i]; }
#pragma unroll
            for (int i = 0; i < 2; ++i) { const int cv = tid + i * NTHREADS; const int v = cv >> 3, kc = cv & 7; *(LAS u32x4*)(Vs + v * 144 + kc * 16) = vst[i]; }
            __syncthreads();
            if (kt + 1 < nkt) {
                const int k0 = (kt + 1) * 64;
#pragma unroll
                for (int i = 0; i < 3; ++i) { const int ck = tid + i * NTHREADS; const int key = ck / 24, part = ck - key * 24;
                    kst[i] = (part < 16) ? *(const u32x4*)(KN + (size_t)(KR0 + k0 + key) * 1024 + h * 128 + part * 8) : *(const u32x4*)(KP + (size_t)(KR0 + k0 + key) * 64 + (part - 16) * 8); }
#pragma unroll
                for (int i = 0; i < 2; ++i) { const int cv = tid + i * NTHREADS; const int v = cv >> 3, kc = cv & 7; vst[i] = *(const u32x4*)(VT + vtb + (size_t)v * Lk + k0 + kc * 8); }
            }
            f32x16 sacc[2];
#pragma unroll
            for (int kk = 0; kk < 2; ++kk) {
#pragma unroll
                for (int i = 0; i < 16; ++i) sacc[kk][i] = 0.f;
#pragma unroll
                for (int s = 0; s < 12; ++s) {
                    const bf16x8 kf = *(const LAS bf16x8*)(Ks + (32 * kk + r) * 400 + (16 * s + 8 * hh) * 2);
                    sacc[kk] = __builtin_amdgcn_mfma_f32_32x32x16_bf16(kf, qf[s], sacc[kk], 0, 0, 0);
                }
            }
            float mx0 = fmaxf(sacc[0][0], sacc[1][0]), mx1 = fmaxf(sacc[0][1], sacc[1][1]);
#pragma unroll
            for (int i = 2; i < 16; i += 2) { mx0 = __builtin_fmaxf(__builtin_fmaxf(mx0, sacc[0][i]), sacc[1][i]); mx1 = __builtin_fmaxf(__builtin_fmaxf(mx1, sacc[0][i + 1]), sacc[1][i + 1]); }
            float mx = fmaxf(mx0, mx1);
            mx = fmaxf(mx, shx(mx, 32, lane));
            const float mnew = fmaxf(mrun, mx);
            const bool resc = __builtin_amdgcn_ballot_w64(mnew != mrun) != 0ull;
            const float alpha = __builtin_amdgcn_exp2f((mrun - mnew) * sc2);
            mrun = mnew;
            const float nm = -mnew * sc2;
            f32x2 ps2 = (f32x2){0.f, 0.f};
#pragma unroll
            for (int kk = 0; kk < 2; ++kk)
#pragma unroll
                for (int i = 0; i < 16; i += 2) {
                    f32x2 a = (f32x2){sacc[kk][i], sacc[kk][i + 1]}; a = a * sc2 + nm;
                    a.x = __builtin_amdgcn_exp2f(a.x); a.y = __builtin_amdgcn_exp2f(a.y);
                    sacc[kk][i] = a.x; sacc[kk][i + 1] = a.y; ps2 += a;
                }
            lrun = lrun * alpha + (ps2.x + ps2.y);
            if (resc) {
#pragma unroll
                for (int ct = 0; ct < 4; ++ct)
#pragma unroll
                    for (int i = 0; i < 16; ++i) oacc[ct][i] *= alpha;
            }
#pragma unroll
            for (int ks = 0; ks < 4; ++ks) {
                const int kk = ks >> 1, s2 = ks & 1;
                u32x4 pw;
                pw.x = cvt_pk_bf16(sacc[kk][8 * s2 + 0], sacc[kk][8 * s2 + 1]); pw.y = cvt_pk_bf16(sacc[kk][8 * s2 + 2], sacc[kk][8 * s2 + 3]);
                pw.z = cvt_pk_bf16(sacc[kk][8 * s2 + 4], sacc[kk][8 * s2 + 5]); pw.w = cvt_pk_bf16(sacc[kk][8 * s2 + 6], sacc[kk][8 * s2 + 7]);
                const bf16x8 pf = __builtin_bit_cast(bf16x8, pw);
#pragma unroll
                for (int ct = 0; ct < 4; ++ct) {
                    const LAS unsigned char* vp = Vs + (32 * ct + r) * 144 + (32 * kk + 16 * s2 + 4 * hh) * 2;
                    const u32x2 lo = *(const LAS u32x2*)vp, hi = *(const LAS u32x2*)(vp + 16);
                    u32x4 vw; vw.x = lo.x; vw.y = lo.y; vw.z = hi.x; vw.w = hi.y;
                    oacc[ct] = __builtin_amdgcn_mfma_f32_32x32x16_bf16(__builtin_bit_cast(bf16x8, vw), pf, oacc[ct], 0, 0, 0);
                }
            }
        }
        lrun += shx(lrun, 32, lane);
        const float invl = 1.0f / lrun;
        const int tid2 = otid(wv); const int qrow2 = row0 + (tid2 >> 6) * 32 + (tid2 & 31);
        bf16_t* op = O + (size_t)qrow2 * 1024 + h * 128 + 4 * ((tid2 >> 5) & 1);
#pragma unroll
        for (int ct = 0; ct < 4; ++ct)
#pragma unroll
            for (int g4 = 0; g4 < 4; ++g4) {
                u32x2 w; w.x = cvt_pk_bf16(oacc[ct][4 * g4] * invl, oacc[ct][4 * g4 + 1] * invl); w.y = cvt_pk_bf16(oacc[ct][4 * g4 + 2] * invl, oacc[ct][4 * g4 + 3] * invl);
                *(u32x2*)(op + 32 * ct + 8 * g4) = w;
            }
        __syncthreads();
    }
}

__device__ __forceinline__ void e9_phase(int wv, const Params& p, int l) {
    const bf16_t* UU = (const bf16_t*)(p.ws + A_UU); bf16_t* ACT = (bf16_t*)(p.ws + A_ACT);
    const float* cw = p.in[I_FCW] + (size_t)l * 3 * UU_LD; const float* cb = p.in[I_FCB] + (size_t)l * UU_LD;
    const int tid9 = otid(wv);
    constexpr int RC = 16, NCG = DFF / 8;
    for (int it = obid() * NTHREADS + tid9; it < (MT / RC) * NCG; it += gridDim.x * NTHREADS) {
        const int ch = it / NCG, c0 = (it - ch * NCG) * 8, row0 = ch * RC;
        const int t0 = row0 < MP ? (row0 & 255) : ((row0 - MP) & 2047); const int L = row0 < MP ? LP : LS;
        float wg[3][8], wx[3][8], bg[8], bx[8];
#pragma unroll
        for (int o = 0; o < 3; ++o) { const f32x4 a = *(const f32x4*)(cw + o * UU_LD + c0), b = *(const f32x4*)(cw + o * UU_LD + c0 + 4), c = *(const f32x4*)(cw + o * UU_LD + DFF + c0), d = *(const f32x4*)(cw + o * UU_LD + DFF + c0 + 4);
#pragma unroll
            for (int j = 0; j < 4; ++j) { wg[o][j] = a[j]; wg[o][4 + j] = b[j]; wx[o][j] = c[j]; wx[o][4 + j] = d[j]; } }
        { const f32x4 a = *(const f32x4*)(cb + c0), b = *(const f32x4*)(cb + c0 + 4), c = *(const f32x4*)(cb + DFF + c0), d = *(const f32x4*)(cb + DFF + c0 + 4);
#pragma unroll
          for (int j = 0; j < 4; ++j) { bg[j] = a[j]; bg[4 + j] = b[j]; bx[j] = c[j]; bx[4 + j] = d[j]; } }
        const bf16_t* pr = UU + (size_t)row0 * UU_LD + c0;
        u32x4 gp = (u32x4){0u, 0u, 0u, 0u}, xp = gp, gc, xc, gn, xn;
        if (t0 > 0) { gp = *(const u32x4*)(pr - UU_LD); xp = *(const u32x4*)(pr - UU_LD + DFF); }
        gc = *(const u32x4*)pr; xc = *(const u32x4*)(pr + DFF);
#pragma unroll 4
        for (int i = 0; i < RC; ++i) {
            gn = (u32x4){0u, 0u, 0u, 0u}; xn = gn;
            if (t0 + i + 1 < L) { gn = *(const u32x4*)(pr + (size_t)(i + 1) * UU_LD); xn = *(const u32x4*)(pr + (size_t)(i + 1) * UU_LD + DFF); }
            float a[8], b[8], c[8], ga[8], va[8];
            unpack8(gp, a); unpack8(gc, b); unpack8(gn, c);
#pragma unroll
            for (int j = 0; j < 8; ++j) ga[j] = bg[j] + wg[0][j] * a[j] + wg[1][j] * b[j] + wg[2][j] * c[j];
            unpack8(xp, a); unpack8(xc, b); unpack8(xn, c);
#pragma unroll
            for (int j = 0; j < 8; ++j) va[j] = bx[j] + wx[0][j] * a[j] + wx[1][j] * b[j] + wx[2][j] * c[j];
#pragma unroll
            for (int j = 0; j < 8; ++j) ga[j] = siluf_(ga[j]) * va[j];
            *(u32x4*)(ACT + (size_t)(row0 + i) * DFF + c0) = pack8(ga);
            gp = gc; gc = gn; xp = xc; xc = xn;
        }
    }
}

__device__ __forceinline__ void convert_layer(int wv, const Params& p, int l, LAS unsigned char* lds) {
    unsigned char* ws = p.ws;
    convT(wv, p.in[I_WIN] + (size_t)l * DM * NIN, DM, NIN, (bf16_t*)(ws + W_IN), 1, lds);
    convT(wv, p.in[I_WUQ] + (size_t)l * 512 * 1536, 512, 1536, (bf16_t*)(ws + W_UQ), 0, lds);
    convT(wv, p.in[I_WUKV] + (size_t)l * 256 * 2048, 256, 2048, (bf16_t*)(ws + W_UKV), 2, lds);
    convT(wv, p.in[I_WBRA] + (size_t)l * 1024 * 2048, 1024, 2048, (bf16_t*)(ws + W_BRA), 0, lds);
    convT(wv, p.in[I_WBRB] + (size_t)l * 1024 * 2048, 1024, 2048, (bf16_t*)(ws + W_BRB), 0, lds);
    convT(wv, p.in[I_WBRC] + (size_t)l * 1024 * 2048, 1024, 2048, (bf16_t*)(ws + W_BRC), 0, lds);
    convT(wv, p.in[I_WO] + (size_t)l * 2048 * 2048, 2048, 2048, (bf16_t*)(ws + W_O), 0, lds);
    convT(wv, p.in[I_FUP] + (size_t)l * 2048 * UU_LD, 2048, UU_LD, (bf16_t*)(ws + W_UP), 0, lds);
    convT(wv, p.in[I_FDN] + (size_t)l * DFF * 2048, DFF, 2048, (bf16_t*)(ws + W_DN), 0, lds);
}

namespace pg8 {
struct EpiGateRT {
    const bf16_t* gates; float* m32; bf16_t* mbf; int P;
    __device__ __forceinline__ void operator()(const f32x4 (&acc)[2][2][4][2], const Unit& u, int wr, int wc, int fr, int fq) const {
        const int row0 = u.pm * BM + wr * 64 + fr, col0 = u.pn * BM + wc * 32 + 4 * fq;
#pragma unroll
        for (int ai = 0; ai < 2; ++ai)
#pragma unroll
            for (int m = 0; m < 4; ++m) {
                const size_t row = (size_t)(row0 + ai * HALF + m * 16);
#pragma unroll
                for (int bj = 0; bj < 2; ++bj)
#pragma unroll
                    for (int n = 0; n < 2; ++n) {
                        const int col = col0 + bj * HALF + n * 16;
                        const u32x2 gw = *(const u32x2*)(gates + row * GATE_LD + P * 2048 + col);
                        f32x4 v = acc[ai][bj][m][n];
                        v[0] *= sigmoidf_(bf_lo(gw.x)); v[1] *= sigmoidf_(bf_hi(gw.x)); v[2] *= sigmoidf_(bf_lo(gw.y)); v[3] *= sigmoidf_(bf_hi(gw.y));
                        float* mp = m32 + row * 2048 + col;
                        if (P != 0) { const f32x4 o = *(const f32x4*)mp; v = v + o; }
                        if (P != 2) { *(f32x4*)mp = v; }
                        else { u32x2 w; w.x = cvt_pk_bf16(v[0], v[1]); w.y = cvt_pk_bf16(v[2], v[3]); *(u32x2*)(mbf + row * 2048 + col) = w; }
                    }
            }
    }
};
}


#define XB_TMO      128
#define XB_XCNT(j)  (256  + 64 * (j))
#define XB_XSUB(j)  (1280 + 64 * (j))
#define XB_XGEN(j)  (2304 + 64 * (j))
#define XB_TOP      3328
#define XB_TOPGEN   3392
#define XCD_BAR_WORDS 3456
#define XB_SPIN_CAP (1u << 20)
__device__ __forceinline__ unsigned xb_ld(unsigned* p)              { return __hip_atomic_load(p, __ATOMIC_RELAXED, __HIP_MEMORY_SCOPE_AGENT); }
__device__ __forceinline__ unsigned xb_add(unsigned* p, unsigned v) { return __hip_atomic_fetch_add(p, v, __ATOMIC_RELAXED, __HIP_MEMORY_SCOPE_AGENT); }
__device__ __forceinline__ unsigned xb_xcc_id() { return (unsigned)__builtin_amdgcn_s_getreg((3 << 11) | 20) & 0xFu; }
#define XB_SPIN(cond, bar) do { unsigned _sp = 0; while (cond) { __builtin_amdgcn_s_sleep(1); \
    if ((++_sp & 255u) == 0u) { if (xb_ld(&(bar)[XB_TMO])) break; if (_sp > XB_SPIN_CAP) { atomicAdd(&(bar)[XB_TMO], 1u); break; } } } } while (0)
__device__ __forceinline__ void xcd_barrier_complete(unsigned* bar, unsigned x, unsigned& nloc, unsigned& nx) {
    const unsigned G = gridDim.x;
    unsigned sum, cnt, mine, sp = 0u;
    for (;;) {
        sum = 0u; cnt = 0u; mine = 0u;
#pragma unroll
        for (unsigned j = 0; j < 16; ++j) { const unsigned c = xb_ld(&bar[XB_XCNT(j)]); sum += c; cnt += (c > 0u) ? 1u : 0u; mine = (j == x) ? c : mine; }
        if (sum == G) break;
        __builtin_amdgcn_s_sleep(1);
        if ((++sp & 255u) == 0u) { if (xb_ld(&bar[XB_TMO])) break; if (sp > XB_SPIN_CAP) { atomicAdd(&bar[XB_TMO], 1u); break; } }
    }
    nloc = mine > 0u ? mine : 1u; nx = cnt > 0u ? cnt : 1u;
}
__device__ __forceinline__ void xcd_barrier(int wv, unsigned* bar, volatile LAS unsigned* st) {
    asm volatile("s_waitcnt vmcnt(0)" ::: "memory");
    __syncthreads();
    if (otid(wv) == 0) {
        __builtin_amdgcn_s_waitcnt(0);
        const unsigned x = xb_xcc_id();
        unsigned nloc = st[0], nx = st[1];
        if (nloc == 0u) { xcd_barrier_complete(bar, x, nloc, nx); st[0] = nloc; st[1] = nx; }
        const unsigned old = xb_add(&bar[XB_XSUB(x)], 1u);
        const unsigned gen = old / nloc;
        if (old + 1u == (gen + 1u) * nloc) {
            __builtin_amdgcn_fence(__ATOMIC_RELEASE, "agent");
            asm volatile("s_waitcnt vmcnt(0)" ::: "memory");
            const unsigned og = xb_add(&bar[XB_TOP], 1u);
            const unsigned tg = og / nx;
            if (og + 1u == (tg + 1u) * nx) xb_add(&bar[XB_TOPGEN], 1u);
            else XB_SPIN(xb_ld(&bar[XB_TOPGEN]) == tg, bar);
            __builtin_amdgcn_fence(__ATOMIC_ACQUIRE, "agent");
            xb_add(&bar[XB_XGEN(x)], 1u);
            asm volatile("s_waitcnt vmcnt(0)" ::: "memory");
        } else {
            XB_SPIN(xb_ld(&bar[XB_XGEN(x)]) == gen, bar);
            __builtin_amdgcn_fence(__ATOMIC_ACQUIRE, "agent");
            asm volatile("s_waitcnt vmcnt(0)" ::: "memory");
        }
    }
    __syncthreads();
}

#ifndef REP_GEMM
#define REP_GEMM 1
#endif
#ifndef REP_ATTN
#define REP_ATTN 1
#endif
#ifndef REP_CONV
#define REP_CONV 1
#endif
#ifndef REP_ELT
#define REP_ELT 1
#endif
#ifndef REP_CVT
#define REP_CVT 1
#endif
enum { K_G1A = 0, K_E2, K_I3, K_I4, K_G1B, K_G5, K_G6, K_ROW1, K_G8, K_E9, K_G10, K_ROW2, K_PRO, K_ROW0, K_COMB };

__global__ void __launch_bounds__(NTHREADS) fwd_megakernel(Params p) {
    extern __shared__ __attribute__((aligned(16))) unsigned char shm[];
    LAS unsigned char* lds = (LAS unsigned char*)shm;
    cg::grid_group grid = cg::this_grid();
    const int wv = __builtin_amdgcn_readfirstlane((int)(threadIdx.x >> 6));
    volatile LAS unsigned* bst = (volatile LAS unsigned*)(lds + 131072);
    unsigned* bar = (unsigned*)(p.ws + S_BAR);
    if (threadIdx.x == 0) { bst[0] = 0u; bst[1] = 0u; bst[2] = 0u; bst[3] = 0u; (void)xb_add(&bar[XB_XCNT(xb_xcc_id())], 1u); }
    __syncthreads();
#pragma unroll 1
    for (int ph = 0; ph < 3 + 12 * NLAYER; ++ph) {
        int kind, l;
        if (ph == 0) { kind = K_PRO; l = 0; } else if (ph == 1) { kind = K_COMB; l = 0; } else if (ph == 2) { kind = K_ROW0; l = 0; } else { l = (ph - 3) / 12; kind = (ph - 3) - l * 12; }
        unsigned char* ws = p.ws;
        asm volatile("" : "+s"(ws));
        if (kind == K_G1A || kind == K_I3 || kind == K_G1B || kind == K_G8) {
            const bf16_t* A; const bf16_t* Bt; bf16_t* O; int N, K;
            if (kind == K_G1A) { A = (const bf16_t*)(ws + A_H); Bt = (const bf16_t*)(ws + W_IN); O = (bf16_t*)(ws + A_PROJA); N = PA_LD; K = DM; }
            else if (kind == K_I3) { A = (const bf16_t*)(ws + A_CQN); Bt = (const bf16_t*)(ws + W_UQ); O = (bf16_t*)(ws + A_Q); N = 1536; K = 512; }
            else if (kind == K_G1B) { A = (const bf16_t*)(ws + A_H); Bt = (const bf16_t*)(ws + W_IN) + (size_t)PA_LD * DM; O = (bf16_t*)(ws + A_GATES); N = GATE_LD; K = DM; }
            else { A = (const bf16_t*)(ws + A_H); Bt = (const bf16_t*)(ws + W_UP); O = (bf16_t*)(ws + A_UU); N = UU_LD; K = DM; }
            int Mr = MT;
            const int nrep = ((kind == K_I3) ? 2 : 1) * REP_GEMM;
#pragma unroll 1
            for (int rp = 0; rp < nrep; ++rp) {
                if (kind == K_I3 && rp >= REP_GEMM) { A = (const bf16_t*)(ws + A_KEYSC); Bt = (const bf16_t*)(ws + W_UKV); O = (bf16_t*)(ws + A_KN); N = 1024; K = 256; Mr = KROWS; }
                run_gemm(wv, lds, A, Bt, Mr, N, K, pg8::EpiBf16{O, N, O});
            }
        }
        if (kind == K_I3) {
#pragma unroll 1
            for (int rp = 0; rp < REP_GEMM; ++rp)
            run_gemm(wv, lds, (const bf16_t*)(ws + W_UKV) + (size_t)1024 * 256, (const bf16_t*)(ws + A_KEYSC), 1024, KROWS, 256,
                     pg8::EpiVT{(bf16_t*)(ws + A_VT), (bf16_t*)(ws + A_VT) + (size_t)BS * 8 * 128 * LKS});
#pragma unroll 1
            for (int rp = 0; rp < REP_CONV; ++rp) conv_phase(wv, p, l, lds);
        }
        if (kind == K_I4) {
#pragma unroll 1
            for (int rp = 0; rp < REP_ATTN; ++rp) attn_phase(wv, p, lds);
#pragma unroll 1
            for (int rp = 0; rp < REP_ELT; ++rp) e3b_phase(wv, p, lds); }
        if (kind == K_G5) {
#pragma unroll 1
            for (int P3 = 0; P3 < 3 * REP_GEMM; ++P3) { const int P = P3 % 3;
                const bf16_t* A = (const bf16_t*)(ws + (P == 0 ? A_YA : (P == 1 ? A_OATT : A_YC)));
                const bf16_t* Bt = (const bf16_t*)(ws + (P == 0 ? W_BRA : (P == 1 ? W_BRB : W_BRC)));
                run_gemm(wv, lds, A, Bt, MT, DM, 1024, pg8::EpiGateRT{(const bf16_t*)(ws + A_GATES), (float*)(ws + A_M32), (bf16_t*)(ws + A_MBF), P});
            }
        }
        if (kind == K_G6 || kind == K_G10) {
            const bool g6 = (kind == K_G6);
#pragma unroll 1
            for (int rp = 0; rp < REP_GEMM; ++rp)
            run_gemm(wv, lds, (const bf16_t*)(ws + (g6 ? A_MBF : A_ACT)), (const bf16_t*)(ws + (g6 ? W_O : W_DN)), MT, DM, g6 ? DM : DFF, pg8::EpiBf16{(bf16_t*)(ws + (g6 ? A_M32 : A_F32)), DM, (bf16_t*)(ws + (g6 ? A_M32 : A_F32)) + (size_t)MT * DM}, true);
        }
        if (kind == K_E2) {
#pragma unroll 1
            for (int rp = 0; rp < REP_ELT; ++rp) e2_phase(wv, p, l, lds); }
        if (kind == K_E9) {
#pragma unroll 1
            for (int rp = 0; rp < REP_ELT; ++rp) e9_phase(wv, p, l); }
        if (kind == K_ROW0 || kind == K_ROW1 || kind == K_ROW2) row_phase(wv, p, l, kind == K_ROW0 ? 0 : (kind == K_ROW1 ? 1 : 2));
        if (kind == K_COMB) comb_phase(wv, p);
        if (kind == K_PRO) {
            if (obid() == 0) {
                pg8::StaticOrder S; S.init(MT, DM, (int)gridDim.x, 0, true);
                const int t0 = otid(wv);
                if (t0 < S.nwg - S.nfull) { pg8::Unit uu; S.tile_of(S.nfull + t0, uu); atomicOr((unsigned*)(p.ws + S_TAIL) + uu.pm, 1u << uu.pn); }
            }
            ada_phase(wv, p, lds); rope_table_phase(wv, p); }
        if (kind == K_PRO || (kind == K_ROW2 && l + 1 < NLAYER)) { const int ln = (kind == K_PRO) ? 0 : l + 1;
#pragma unroll 1
            for (int rp = 0; rp < REP_CVT; ++rp) { filter_phase(wv, p, ln, lds); convert_layer(wv, p, ln, lds); } }
        if (ph == 0) grid.sync(); else xcd_barrier(wv, bar, bst);
    }
}

extern "C" void kernel_launch(void* const* d_in, const int* in_sizes, int n_in, void* d_out, int out_size, void* d_ws, size_t ws_size, hipStream_t stream) {
    static int grid_blocks = 0;
    if (grid_blocks == 0) {
        if (n_in != N_INPUTS || ws_size < WS_NEED) { fprintf(stderr, "kernel_launch: need %d inputs and %zu bytes of workspace; got %d, %zu\n", N_INPUTS, (size_t)WS_NEED, n_in, ws_size); grid_blocks = -1; return; }
        int dev = 0, cus = 0, per_cu = 0;
        hipGetDevice(&dev);
        hipDeviceGetAttribute(&cus, hipDeviceAttributeMultiprocessorCount, dev);
        if (hipFuncSetAttribute((const void*)fwd_megakernel, hipFuncAttributeMaxDynamicSharedMemorySize, LDS_BYTES) != hipSuccess) { fprintf(stderr, "kernel_launch: hipFuncSetAttribute failed\n"); grid_blocks = -1; return; }
        if (hipOccupancyMaxActiveBlocksPerMultiprocessor(&per_cu, (const void*)fwd_megakernel, NTHREADS, LDS_BYTES) != hipSuccess || per_cu < 1) { fprintf(stderr, "kernel_launch: occupancy query gave %d\n", per_cu); per_cu = 1; }
        (void)hipGetLastError();
        grid_blocks = cus * 1;
    }
    if (grid_blocks < 0) return;
        (void)hipMemsetAsync((unsigned char*)d_ws + S_BAR, 0, 16384, stream);
    (void)hipMemsetAsync((unsigned char*)d_ws + S_TAIL, 0, 512, stream);
    Params p{};
    for (int i = 0; i < N_INPUTS; ++i) p.in[i] = (const float*)d_in[i];
    p.out = (float*)d_out; p.ws = (unsigned char*)d_ws;
    void* args[] = {&p};
    hipError_t e = hipLaunchCooperativeKernel((const void*)fwd_megakernel, dim3(grid_blocks), dim3(NTHREADS), args, LDS_BYTES, stream);
    if (e != hipSuccess) fprintf(stderr, "cooperative launch failed: %s (grid %d)\n", hipGetErrorString(e), grid_blocks);
}
```

```cpp
#include <hip/hip_runtime.h>
#include <hip/hip_cooperative_groups.h>
#include <cstdio>
namespace cg = cooperative_groups;

#define LAS __attribute__((address_space(3)))
typedef unsigned short bf16_t;
typedef short bf16x8 __attribute__((ext_vector_type(8)));
typedef float f32x4 __attribute__((ext_vector_type(4)));
typedef float f32x16 __attribute__((ext_vector_type(16)));
typedef unsigned u32x4 __attribute__((ext_vector_type(4)));
typedef unsigned u32x2 __attribute__((ext_vector_type(2)));
typedef float f32x2 __attribute__((ext_vector_type(2)));

constexpr int DM = 2048, MP = 4096, MS = 16384, MT = 20480, NLAYER = 2;
constexpr int LP = 256, LS = 2048, BP = 16, BS = 8, PAST = 512, LKS = 2560;
constexpr int NIN = 13120, NGATE0 = 6976, PA_LD = 7168, GATE_LD = 6144;
constexpr int DFF = 5632, UU_LD = 11264;
constexpr int KROWS = 24576;
constexpr int NTHREADS = 512;
constexpr int LDS_BYTES = 131072 + 16;

enum { I_XP = 0, I_XS, I_C, I_CCKV, I_CKPE, I_CCTX, I_ADAW, I_ADAB, I_NMPRE, I_NMPOST, I_NFPRE, I_NFPOST, I_WIN, I_HCW, I_HCB,
       I_FW1, I_FB1, I_FW2, I_FB2, I_FW3, I_FB3, I_FFREQ, I_HBIAS, I_QN, I_KVN, I_WUQ, I_WUKV, I_SCW, I_WBRA, I_WBRB, I_WBRC,
       I_WO, I_FUP, I_FCW, I_FCB, I_FDN, N_INPUTS };

constexpr size_t E_WIN = (size_t)13312 * 2048, E_WUQ = (size_t)1536 * 512, E_WUKV = (size_t)2048 * 256, E_WBR = (size_t)2048 * 1024,
                 E_WO = (size_t)2048 * 2048, E_WUP = (size_t)11264 * 2048, E_WDN = (size_t)2048 * 5632;
constexpr size_t W_IN = 0, W_UQ = W_IN + E_WIN * 2, W_UKV = W_UQ + E_WUQ * 2, W_BRA = W_UKV + E_WUKV * 2, W_BRB = W_BRA + E_WBR * 2,
                 W_BRC = W_BRB + E_WBR * 2, W_O = W_BRC + E_WBR * 2, W_UP = W_O + E_WO * 2, W_DN = W_UP + E_WUP * 2, W_END = W_DN + E_WDN * 2;
constexpr size_t S_MOD = W_END, SZ_MOD = (size_t)NLAYER * 16 * 9 * 12288 * 4;
constexpr size_t S_KTS = S_MOD + SZ_MOD, S_KTP = S_KTS + (size_t)1024 * 4096 * 4, S_PARTS = S_KTP + (size_t)1024 * 512 * 4,
                 S_PARTP = S_PARTS + (size_t)64 * 2048 * 4, S_ROPE = S_PARTP + (size_t)8 * 2048 * 4, S_BAR = S_ROPE + (size_t)2 * 2048 * 32 * 4, S_COMB = S_BAR + 16384, S_SCALE = S_COMB + (size_t)NLAYER * 3 * 9 * 3 * 2048 * 4, S_TAIL = S_SCALE + 8192, S_END = S_TAIL + 512;
constexpr size_t AR = S_END;
constexpr size_t SZ_H = (size_t)MT * 2048 * 2;
constexpr size_t A_H = AR, A_UU = AR + SZ_H, A_ACT = A_UU + (size_t)MT * UU_LD * 2, AR_END = A_ACT + (size_t)MT * DFF * 2;
constexpr size_t A_PROJA = A_UU;
constexpr size_t A_Q = A_UU, A_KN = A_Q + (size_t)MT * 1536 * 2, A_VT = A_KN + (size_t)KROWS * 1024 * 2, A_YCT = A_VT + (size_t)KROWS * 1024 * 2;
constexpr size_t A_GATES = A_UU, A_M32 = A_GATES + (size_t)MT * GATE_LD * 2, A_MBF = A_H, A_F32 = A_UU;
constexpr size_t A_S = A_M32 + (size_t)MT * 2048 * 4;
constexpr size_t A_ZZT = A_S, A_X0S = A_ZZT + (size_t)MT * 1024 * 2, A_CQN = A_X0S + (size_t)MT * 1024 * 2, A_KEYSC = A_CQN + (size_t)MT * 512 * 2,
                 A_KPER = A_KEYSC + (size_t)KROWS * 256 * 2, A_YA = A_KPER + (size_t)KROWS * 64 * 2, A_OATT = A_YA + (size_t)MT * 1024 * 2,
                 A_YC = A_OATT + (size_t)MT * 1024 * 2, A_SEND = A_YC + (size_t)MT * 1024 * 2;
constexpr size_t A_RAW = A_M32;
static_assert(A_RAW + (size_t)3 * MT * 2048 * 2 <= A_CQN, "raw branch buffer overlaps live data");
static_assert(A_SEND <= AR_END, "arena overflow");
static_assert(A_YCT + (size_t)MT * 1024 * 2 <= A_M32, "arena overlap");
constexpr size_t WS_NEED = AR_END;
static_assert(WS_NEED <= 967590400ull, "workspace too large");

struct Params {
    const float* in[N_INPUTS];
    float* out;
    unsigned char* ws;
};

__device__ __forceinline__ unsigned cvt_pk_bf16(float lo, float hi) { unsigned r; asm volatile("v_cvt_pk_bf16_f32 %0, %1, %2" : "=v"(r) : "v"(lo), "v"(hi)); return r; }
__device__ __forceinline__ bf16_t f2bf(float f) { return (bf16_t)(cvt_pk_bf16(f, 0.f) & 0xffffu); }
__device__ __forceinline__ float bf_lo(unsigned w) { return __uint_as_float(w << 16); }
__device__ __forceinline__ float bf_hi(unsigned w) { return __uint_as_float(w & 0xffff0000u); }
__device__ __forceinline__ void unpack8(const u32x4 v, float* f) { f[0] = bf_lo(v.x); f[1] = bf_hi(v.x); f[2] = bf_lo(v.y); f[3] = bf_hi(v.y); f[4] = bf_lo(v.z); f[5] = bf_hi(v.z); f[6] = bf_lo(v.w); f[7] = bf_hi(v.w); }
__device__ __forceinline__ u32x4 pack8(const float* f) { u32x4 r; r.x = cvt_pk_bf16(f[0], f[1]); r.y = cvt_pk_bf16(f[2], f[3]); r.z = cvt_pk_bf16(f[4], f[5]); r.w = cvt_pk_bf16(f[6], f[7]); return r; }
__device__ __forceinline__ float shx(float v, int mask, int lane) { return __int_as_float(__builtin_amdgcn_ds_bpermute((lane ^ mask) << 2, __float_as_int(v))); }
__device__ __forceinline__ float wave_sum(float v, int lane) {
#pragma unroll
    for (int o = 32; o >= 1; o >>= 1) v += shx(v, o, lane);
    return v;
}
__device__ __forceinline__ int otid(int wv) { int t; asm volatile("v_mbcnt_lo_u32_b32 %0, -1, 0\n\tv_mbcnt_hi_u32_b32 %0, -1, %0" : "=v"(t)); return wv * 64 + t; }
__device__ __forceinline__ int obid() { int t = blockIdx.x; asm volatile("" : "+s"(t)); return t; }
__device__ __forceinline__ float sigmoidf_(float x) { return 1.0f / (1.0f + __expf(-x)); }
__device__ __forceinline__ float siluf_(float x) { return x / (1.0f + __expf(-x)); }

namespace pg8 {
constexpr int BM = 256, BK = 64, HALF = 128, HTB = HALF * BK * 2, STAGE_BYTES = 8 * HTB, NXCD = 8, WGM = 8;
__host__ __device__ __forceinline__ int lds_byte(int r, int c) { const int st = (r >> 4) * 2 + (c >> 5), rr = r & 15, cc = c & 31, ob = rr * 64 + cc * 2; return st * 1024 + (ob ^ (((ob >> 9) & 1) << 5)); }
__host__ __device__ __forceinline__ void stage_rc(int b, int& R, int& C) { const int st = b / 1024, sb = b % 1024, swz = sb ^ (((sb >> 9) & 1) << 5); R = (st >> 1) * 16 + swz / 64; C = (st & 1) * 32 + (swz % 64) / 2; }
struct Unit { int pm, pn, kh; };
struct Gemm { const bf16_t* A; const bf16_t* Bt; int M, N, K; int nMper; size_t bstride; };
struct StaticOrder {
    int nM, nN, nwg, G, c, nfull;
    __device__ void init(int M, int N, int G_, int c_, bool split = false) { nM = M / BM; nN = N / BM; nwg = nM * nN; G = G_; c = c_;
        nfull = nwg; if (split) { const int rem = nwg % G; if (rem > 0 && 2 * rem <= G) nfull = nwg - rem; } }
    __device__ void tile_of(int wgid, Unit& u) const {
        { const int q = nwg / NXCD, r = nwg % NXCD, xcd = wgid % NXCD, off = wgid / NXCD; wgid = (xcd < r ? xcd * (q + 1) : r * (q + 1) + (xcd - r) * q) + off; }
        const int nig = WGM * nN, gid = wgid / nig, fm = gid * WGM, gsz = (nM - fm) < WGM ? (nM - fm) : WGM;
        u.pm = fm + ((wgid % nig) % gsz); u.pn = (wgid % nig) / gsz;
    }
    __device__ bool next(int i, Unit& u) const {
        const long L = (long)i * G + c;
        int tile = (int)L, kh = -1; bool ok = L < nwg;
        if (L >= nfull) { const long h = L - nfull; ok = h < 2 * (long)(nwg - nfull); tile = nfull + (int)(h >> 1); kh = (int)(h & 1); }
        if (!ok) return false;
        int pm, pn;
        { int wgid = tile; const int q = nwg / NXCD, r = nwg % NXCD, xcd = wgid % NXCD, off = wgid / NXCD; wgid = (xcd < r ? xcd * (q + 1) : r * (q + 1) + (xcd - r) * q) + off;
          const int nig = WGM * nN, gid = wgid / nig, fm = gid * WGM, gsz = (nM - fm) < WGM ? (nM - fm) : WGM;
          pm = fm + ((wgid % nig) % gsz); pn = (wgid % nig) / gsz; }
        u.pm = pm; u.pn = pn; u.kh = kh; return true;
    }
};
template <class Epi>
__device__ __forceinline__ void gemm_phase(int wv, LAS unsigned char* lds, const Gemm g, const StaticOrder& S, const Epi& E) {
    const int tid = otid(wv), wid = __builtin_amdgcn_readfirstlane(tid >> 6), lane = tid & 63, wr = wid >> 2, wc = wid & 3, fr = lane & 15, fq = lane >> 4;
    const int K = g.K, nt = K / BK;
    unsigned voffA[2];
#pragma unroll
    for (int i = 0; i < 2; ++i) { int R, C; stage_rc(tid * 16 + i * 8192, R, C); voffA[i] = (unsigned)(R * K + C) * 2u; }
    const size_t kstep = (size_t)(BK * 2);
    const size_t hstep = (size_t)HALF * K * 2;
    const size_t tstep = 2 * hstep;
    const unsigned ldsw = (unsigned)wid * 1024u;
    const int aoff = lds_byte(wr * 64 + fr, fq * 8), boff = lds_byte(wc * 32 + fr, fq * 8);
#define PG8_SA(b, h) (((b) * 2 + (h)) * HTB)
#define PG8_SB(b, h) ((4 + (b) * 2 + (h)) * HTB)
#define PG8_STAGE(bufoff, gbase, voff) do { _Pragma("unroll") for (int _i = 0; _i < 2; ++_i) \
        __builtin_amdgcn_global_load_lds((const unsigned*)((const char*)(gbase) + (voff)[_i]), (LAS unsigned*)(lds + (bufoff) + ldsw + _i * 8192), 16, 0, 0); } while (0)
#define PG8_LDA(dst, b, h) do { _Pragma("unroll") for (int m = 0; m < 4; ++m) _Pragma("unroll") for (int k = 0; k < 2; ++k) dst[m][k] = *(const LAS bf16x8*)(lds + PG8_SA(b, h) + aoff + m * 2048 + k * 1024); } while (0)
#define PG8_LDB(dst, b, h) do { _Pragma("unroll") for (int n = 0; n < 2; ++n) _Pragma("unroll") for (int k = 0; k < 2; ++k) dst[n][k] = *(const LAS bf16x8*)(lds + PG8_SB(b, h) + boff + n * 2048 + k * 1024); } while (0)
#define PG8_MMA(ai, bj, At, Bt) do { __builtin_amdgcn_s_setprio(1); _Pragma("unroll") for (int m = 0; m < 4; ++m) _Pragma("unroll") for (int n = 0; n < 2; ++n) _Pragma("unroll") for (int k = 0; k < 2; ++k) \
        acc[ai][bj][m][n] = __builtin_amdgcn_mfma_f32_16x16x32_bf16(Bt[n][k], At[m][k], acc[ai][bj][m][n], 0, 0, 0); __builtin_amdgcn_s_setprio(0); } while (0)
#define PG8_WAIT_V(n) asm volatile("s_waitcnt vmcnt(" #n ")" ::: "memory")
#define PG8_WAIT_L(n) asm volatile("s_waitcnt lgkmcnt(" #n ")" ::: "memory")
#define PG8_BAR __builtin_amdgcn_s_barrier()
#define PG8_SCHED __builtin_amdgcn_sched_barrier(0)
    Unit cur, nxt; int ui = 0;
    if (!S.next(0, cur)) return;
    f32x4 acc[2][2][4][2];
#pragma unroll
    for (int a = 0; a < 2; ++a)
#pragma unroll
        for (int b = 0; b < 2; ++b)
#pragma unroll
            for (int m = 0; m < 4; ++m)
#pragma unroll
                for (int n = 0; n < 2; ++n) acc[a][b][m][n] = (f32x4){0.f, 0.f, 0.f, 0.f};
    bf16x8 At[4][2], B0[2][2], B1[2][2];
    const size_t khoff = (size_t)(nt / 2) * kstep;
    const char* cA = (const char*)g.A + (size_t)cur.pm * tstep + (cur.kh == 1 ? khoff : 0); const char* cB = (const char*)g.Bt + (size_t)(cur.pm / g.nMper) * g.bstride + (size_t)cur.pn * tstep + (cur.kh == 1 ? khoff : 0);
    PG8_STAGE(PG8_SB(0, 0), cB, voffA); PG8_STAGE(PG8_SA(0, 0), cA, voffA); PG8_STAGE(PG8_SB(0, 1), cB + hstep, voffA); PG8_STAGE(PG8_SA(0, 1), cA + hstep, voffA);
    if (wr == 1) PG8_BAR;
    PG8_WAIT_V(4); PG8_BAR;
    PG8_STAGE(PG8_SB(1, 0), cB + kstep, voffA); PG8_STAGE(PG8_SA(1, 0), cA + kstep, voffA); PG8_STAGE(PG8_SB(1, 1), cB + hstep + kstep, voffA);
    PG8_WAIT_V(6); PG8_BAR;
    for (;;) {
        const bool has_next = S.next(ui + 1, nxt);
        const char* nA = has_next ? (const char*)g.A + (size_t)nxt.pm * tstep + (nxt.kh == 1 ? khoff : 0) : cA; const char* nB = has_next ? (const char*)g.Bt + (size_t)(nxt.pm / g.nMper) * g.bstride + (size_t)nxt.pn * tstep + (nxt.kh == 1 ? khoff : 0) : cB;
        const int ntu = (cur.kh < 0) ? nt : (nt >> 1);
        for (int t = 0; t < ntu; t += 2) {
            const bool last = (t == ntu - 2);
            const char* a1 = cA + (size_t)(t + 1) * kstep;
            const char* a2 = last ? nA : cA + (size_t)(t + 2) * kstep; const char* b2 = last ? nB : cB + (size_t)(t + 2) * kstep;
            const char* a3 = a2 + kstep; const char* b3 = b2 + kstep;
            PG8_LDB(B0, 0, 0); PG8_SCHED; PG8_LDA(At, 0, 0); PG8_STAGE(PG8_SA(1, 1), a1 + hstep, voffA);
            PG8_WAIT_L(8); PG8_BAR; PG8_WAIT_L(0); PG8_MMA(0, 0, At, B0); PG8_BAR; PG8_SCHED;
            PG8_LDB(B1, 0, 1); PG8_STAGE(PG8_SB(0, 0), b2, voffA);
            PG8_BAR; PG8_WAIT_L(0); PG8_MMA(0, 1, At, B1); PG8_BAR;
            PG8_LDA(At, 0, 1); PG8_STAGE(PG8_SA(0, 0), a2, voffA);
            PG8_BAR; PG8_WAIT_L(0); PG8_MMA(1, 0, At, B0); PG8_BAR; PG8_SCHED;
            PG8_STAGE(PG8_SB(0, 1), b2 + hstep, voffA);
            PG8_WAIT_V(6); PG8_BAR; PG8_MMA(1, 1, At, B1); PG8_BAR;
            PG8_LDB(B0, 1, 0); PG8_SCHED; PG8_LDA(At, 1, 0); PG8_STAGE(PG8_SA(0, 1), a2 + hstep, voffA);
            PG8_WAIT_L(8); PG8_BAR; PG8_WAIT_L(0); PG8_MMA(0, 0, At, B0); PG8_BAR; PG8_SCHED;
            PG8_LDB(B1, 1, 1); PG8_STAGE(PG8_SB(1, 0), b3, voffA);
            PG8_BAR; PG8_WAIT_L(0); PG8_MMA(0, 1, At, B1); PG8_BAR;
            PG8_LDA(At, 1, 1); PG8_STAGE(PG8_SA(1, 0), a3, voffA);
            PG8_BAR; PG8_WAIT_L(0); PG8_MMA(1, 0, At, B0); PG8_BAR; PG8_SCHED;
            PG8_STAGE(PG8_SB(1, 1), b3 + hstep, voffA);
            PG8_WAIT_V(6); PG8_BAR; PG8_MMA(1, 1, At, B1); PG8_BAR;
        }
        { const int t2 = otid(wv); const int l2 = t2 & 63, w2 = __builtin_amdgcn_readfirstlane(t2 >> 6); E(acc, cur, w2 >> 2, w2 & 3, l2 & 15, l2 >> 4); }
        if (!has_next) break;
#pragma unroll
        for (int a = 0; a < 2; ++a)
#pragma unroll
            for (int b = 0; b < 2; ++b)
#pragma unroll
                for (int m = 0; m < 4; ++m)
#pragma unroll
                    for (int n = 0; n < 2; ++n) acc[a][b][m][n] = (f32x4){0.f, 0.f, 0.f, 0.f};
        cur = nxt; cA = nA; cB = nB; ++ui;
    }
    PG8_WAIT_V(0);
    if (wr == 0) PG8_BAR;
    PG8_BAR;
#undef PG8_SA
#undef PG8_SB
#undef PG8_STAGE
#undef PG8_LDA
#undef PG8_LDB
#undef PG8_MMA
#undef PG8_WAIT_V
#undef PG8_WAIT_L
#undef PG8_BAR
#undef PG8_SCHED
}

struct EpiBf16 {
    bf16_t* O; int ldc; bf16_t* O2;
    __device__ __forceinline__ void operator()(const f32x4 (&acc)[2][2][4][2], const Unit& u, int wr, int wc, int fr, int fq) const {
        const int row0 = u.pm * BM + wr * 64 + fr, col0 = u.pn * BM + wc * 32 + 4 * fq;
        bf16_t* Ob = (u.kh == 1) ? O2 : O;
#pragma unroll
        for (int ai = 0; ai < 2; ++ai)
#pragma unroll
            for (int m = 0; m < 4; ++m) { bf16_t* rowp = Ob + (size_t)(row0 + ai * HALF + m * 16) * ldc + col0;
#pragma unroll
                for (int bj = 0; bj < 2; ++bj)
#pragma unroll
                    for (int n = 0; n < 2; ++n) { const f32x4 v = acc[ai][bj][m][n]; u32x2 w; w.x = cvt_pk_bf16(v[0], v[1]); w.y = cvt_pk_bf16(v[2], v[3]); *(u32x2*)(rowp + bj * HALF + n * 16) = w; } }
    }
};
struct EpiF32 {
    float* C; int ldc;
    __device__ __forceinline__ void operator()(const f32x4 (&acc)[2][2][4][2], const Unit& u, int wr, int wc, int fr, int fq) const {
        const int row0 = u.pm * BM + wr * 64 + fr, col0 = u.pn * BM + wc * 32 + 4 * fq;
#pragma unroll
        for (int ai = 0; ai < 2; ++ai)
#pragma unroll
            for (int m = 0; m < 4; ++m) { float* rowp = C + (size_t)(row0 + ai * HALF + m * 16) * ldc + col0;
#pragma unroll
                for (int bj = 0; bj < 2; ++bj)
#pragma unroll
                    for (int n = 0; n < 2; ++n) *(f32x4*)(rowp + bj * HALF + n * 16) = acc[ai][bj][m][n]; }
    }
};
struct EpiVT {
    bf16_t* VTs; bf16_t* VTp;
    __device__ __forceinline__ void operator()(const f32x4 (&acc)[2][2][4][2], const Unit& u, int wr, int wc, int fr, int fq) const {
        const int KR0 = u.pn * BM;
        bf16_t* vt; int Lk;
        if (KR0 < BS * LKS) { const int b = KR0 / LKS; Lk = LKS; vt = VTs + (size_t)b * 1024 * LKS + (KR0 - b * LKS); }
        else { const int b = (KR0 - BS * LKS) >> 8; Lk = LP; vt = VTp + (size_t)b * 1024 * LP; }
        const int row0 = u.pm * BM + wr * 64 + fr, col0 = wc * 32 + 4 * fq;
#pragma unroll
        for (int ai = 0; ai < 2; ++ai)
#pragma unroll
            for (int m = 0; m < 4; ++m) { bf16_t* rowp = vt + (size_t)(row0 + ai * HALF + m * 16) * Lk + col0;
#pragma unroll
                for (int bj = 0; bj < 2; ++bj)
#pragma unroll
                    for (int n = 0; n < 2; ++n) { const f32x4 v = acc[ai][bj][m][n]; u32x2 w; w.x = cvt_pk_bf16(v[0], v[1]); w.y = cvt_pk_bf16(v[2], v[3]); *(u32x2*)(rowp + bj * HALF + n * 16) = w; } }
    }
};
template <int P> struct EpiGate {
    const bf16_t* gates; float* m32; bf16_t* mbf;
    __device__ __forceinline__ void operator()(const f32x4 (&acc)[2][2][4][2], const Unit& u, int wr, int wc, int fr, int fq) const {
        const int row0 = u.pm * BM + wr * 64 + fr, col0 = u.pn * BM + wc * 32 + 4 * fq;
#pragma unroll
        for (int ai = 0; ai < 2; ++ai)
#pragma unroll
            for (int m = 0; m < 4; ++m) {
                const size_t row = (size_t)(row0 + ai * HALF + m * 16);
#pragma unroll
                for (int bj = 0; bj < 2; ++bj)
#pragma unroll
                    for (int n = 0; n < 2; ++n) {
                        const int col = col0 + bj * HALF + n * 16;
                        const u32x2 gw = *(const u32x2*)(gates + row * GATE_LD + P * 2048 + col);
                        f32x4 v = acc[ai][bj][m][n];
                        v[0] *= sigmoidf_(bf_lo(gw.x)); v[1] *= sigmoidf_(bf_hi(gw.x)); v[2] *= sigmoidf_(bf_lo(gw.y)); v[3] *= sigmoidf_(bf_hi(gw.y));
                        float* mp = m32 + row * 2048 + col;
                        if (P == 0) { *(f32x4*)mp = v; }
                        else if (P == 1) { const f32x4 o = *(const f32x4*)mp; *(f32x4*)mp = o + v; }
                        else { const f32x4 o = *(const f32x4*)mp; v = v + o; u32x2 w; w.x = cvt_pk_bf16(v[0], v[1]); w.y = cvt_pk_bf16(v[2], v[3]); *(u32x2*)(mbf + row * 2048 + col) = w; }
                    }
            }
    }
};
}

template <class Epi>
__device__ __forceinline__ void run_gemm(int wv, LAS unsigned char* lds, const bf16_t* A, const bf16_t* Bt, int M, int N, int K, const Epi& E, bool split = false, int nMper = 1 << 28, size_t bstride = 0) {
    pg8::Gemm g; g.A = A; g.Bt = Bt; g.M = M; g.N = N; g.K = K; g.nMper = nMper; g.bstride = bstride;
    pg8::StaticOrder S; S.init(M, N, (int)gridDim.x, obid(), split);
    pg8::gemm_phase<Epi>(wv, lds, g, S, E);
    __syncthreads();
}

__device__ __forceinline__ void convT(int wv, const float* __restrict__ src, int K, int N, bf16_t* __restrict__ dst, int gate_shift, LAS unsigned char* lds) {
    const int tid = otid(wv), lane = tid & 63, kq = lane & 7, ng = lane >> 3;
    const int tn = N / 32, tk = K / 64, ntile = tn * tk, nwaves = gridDim.x * 8;
    for (int tile = obid() * 8 + (tid >> 6); tile < ntile; tile += 2 * nwaves) {
        const int tile2 = tile + nwaves; const bool has2 = tile2 < ntile;
        const int tkk = tile / tn, tnn = tile - tkk * tn, k0 = tkk * 64 + 8 * kq, n0 = tnn * 32 + 4 * ng;
        const int tkk2 = has2 ? tile2 / tn : tkk, tnn2 = has2 ? tile2 - tkk2 * tn : tnn, k02 = tkk2 * 64 + 8 * kq, n02 = tnn2 * 32 + 4 * ng;
        f32x4 v[8], v2[8];
#pragma unroll
        for (int i = 0; i < 8; ++i) v[i] = *(const f32x4*)(src + (size_t)(k0 + i) * N + n0);
#pragma unroll
        for (int i = 0; i < 8; ++i) v2[i] = *(const f32x4*)(src + (size_t)(k02 + i) * N + n02);
#pragma unroll
        for (int j = 0; j < 4; ++j) {
            int nd = n0 + j; if (gate_shift == 1 && nd >= NGATE0) nd += 192; if (gate_shift == 2) { const int hd = nd >> 8, wi = nd & 255; nd = (wi < 128) ? hd * 128 + wi : 1024 + hd * 128 + (wi - 128); }
            u32x4 w; w.x = cvt_pk_bf16(v[0][j], v[1][j]); w.y = cvt_pk_bf16(v[2][j], v[3][j]); w.z = cvt_pk_bf16(v[4][j], v[5][j]); w.w = cvt_pk_bf16(v[6][j], v[7][j]);
            *(u32x4*)(dst + (size_t)nd * K + k0) = w;
        }
        if (has2) {
#pragma unroll
            for (int j = 0; j < 4; ++j) {
                int nd = n02 + j; if (gate_shift == 1 && nd >= NGATE0) nd += 192; if (gate_shift == 2) { const int hd = nd >> 8, wi = nd & 255; nd = (wi < 128) ? hd * 128 + wi : 1024 + hd * 128 + (wi - 128); }
                u32x4 w; w.x = cvt_pk_bf16(v2[0][j], v2[1][j]); w.y = cvt_pk_bf16(v2[2][j], v2[3][j]); w.z = cvt_pk_bf16(v2[4][j], v2[5][j]); w.w = cvt_pk_bf16(v2[6][j], v2[7][j]);
                *(u32x4*)(dst + (size_t)nd * K + k02) = w;
            }
        }
    }
}

__device__ __forceinline__ void ada_phase(int wv, const Params& p, LAS unsigned char* lds) {
    LAS float* sl = (LAS float*)lds;
    float* mod = (float*)(p.ws + S_MOD);
    const int tid = otid(wv);
    for (int u = obid(); u < NLAYER * 6 * 16; u += gridDim.x) {
        const int l = u / 96, r = u % 96, cb = r % 6, kc = r / 6, k0 = kc * 128;
        for (int i = tid; i < 9 * 128; i += NTHREADS) { const int v = i >> 7, k = i & 127; const float x = (v == 0) ? p.in[I_CCTX][k0 + k] : p.in[I_C][(v - 1) * DM + k0 + k]; sl[i] = siluf_(x); }
        __syncthreads();
        const int col = cb * 2048 + tid * 4;
        f32x4 acc[9];
#pragma unroll
        for (int i = 0; i < 9; ++i) acc[i] = (f32x4){0.f, 0.f, 0.f, 0.f};
        const float* wp = p.in[I_ADAW] + ((size_t)l * DM + k0) * 12288 + col;
#pragma unroll 8
        for (int k = 0; k < 128; ++k) {
            const f32x4 w = *(const f32x4*)(wp + (size_t)k * 12288);
#pragma unroll
            for (int i = 0; i < 9; ++i) acc[i] += sl[i * 128 + k] * w;
        }
#pragma unroll
        for (int i = 0; i < 9; ++i) *(f32x4*)(mod + ((size_t)(l * 16 + kc) * 9 + i) * 12288 + col) = acc[i];
        __syncthreads();
    }
}

__device__ __forceinline__ void filter_phase(int wv, const Params& p, int l, LAS unsigned char* lds) {
    LAS float* z = (LAS float*)lds;
    LAS float* H1 = z + 32 * 33;
    LAS float* H2 = H1 + 32 * 64;
    LAS float* W1 = H2 + 32 * 64;
    LAS float* W2 = W1 + 33 * 64;
    LAS float* BF = W2 + 64 * 64;
    const int tid = otid(wv);
    const float* w3 = p.in[I_FW3] + (size_t)l * 64 * 2048; const float* b3 = p.in[I_FB3] + l * 2048;
    for (int u = obid(); u < 72; u += gridDim.x) {
        const int g = (u < 64) ? 1 : 0; const int tc = g ? u : u - 64; const int L = g ? LS : LP; const int t0 = tc * 32;
        float* kT = (float*)(p.ws + (g ? S_KTS : S_KTP)); float* part = (float*)(p.ws + (g ? S_PARTS : S_PARTP));
        for (int i = tid; i < 33 * 64; i += NTHREADS) W1[i] = p.in[I_FW1][(size_t)l * 33 * 64 + i];
        for (int i = tid; i < 64 * 64; i += NTHREADS) W2[i] = p.in[I_FW2][(size_t)l * 64 * 64 + i];
        if (tid < 64) BF[tid] = p.in[I_FB1][l * 64 + tid]; else if (tid < 128) BF[tid] = p.in[I_FB2][l * 64 + tid - 64]; else if (tid < 256) BF[tid] = p.in[I_FFREQ][l * 128 + tid - 128];
        for (int i = tid; i < 32 * 33; i += NTHREADS) {
            const int t = i / 33, e = i - t * 33; const float tf = (float)(t0 + t);
            float v;
            if (e == 0) v = tf / (float)(L - 1);
            else { const int k = (e - 1) & 15; const float band = 1e-4f + (float)k * ((15.0f - 1e-4f) / 15.0f); const float w = (6.283185307179586f * tf) / (float)L; const float ang = w * band;
                   v = (e <= 16) ? cosf(ang) : -sinf(ang); }
            z[i] = v;
        }
        __syncthreads();
#pragma unroll
        for (int q = 0; q < 4; ++q) { const int i = tid + q * NTHREADS; const int t = i >> 6, j = i & 63; float s = BF[j];
#pragma unroll
            for (int e = 0; e < 33; ++e) s += z[t * 33 + e] * W1[e * 64 + j];
            H1[i] = sinf(BF[128 + j] * s); }
        __syncthreads();
#pragma unroll
        for (int q = 0; q < 4; ++q) { const int i = tid + q * NTHREADS; const int t = i >> 6, j = i & 63; float s = BF[64 + j];
#pragma unroll 16
            for (int e = 0; e < 64; ++e) s += H1[t * 64 + e] * W2[e * 64 + j];
            H2[i] = sinf(BF[192 + j] * s); }
        __syncthreads();
        const int c = tid * 4;
        const f32x4 bias = *(const f32x4*)(b3 + c);
        f32x4 delta;
#pragma unroll
        for (int j = 0; j < 4; ++j) { const int d = (c + j) & 1023; const float mn = -3.0701134573253945f, mx = -15.350567286626973f; delta[j] = fabsf(mn + (float)d * ((mx - mn) / 1023.0f)); }
        f32x4 psum = (f32x4){0.f, 0.f, 0.f, 0.f};
        for (int tb = 0; tb < 2; ++tb) {
            f32x4 acc[16];
#pragma unroll
            for (int i = 0; i < 16; ++i) acc[i] = bias;
#pragma unroll 8
            for (int k = 0; k < 64; ++k) {
                const f32x4 w = *(const f32x4*)(w3 + (size_t)k * 2048 + c);
#pragma unroll
                for (int i = 0; i < 16; ++i) acc[i] += H2[(tb * 16 + i) * 64 + k] * w;
            }
#pragma unroll
            for (int i = 0; i < 16; ++i) {
                const int t = t0 + tb * 16 + i; const float tn = (float)t / (float)(L - 1);
#pragma unroll
                for (int j = 0; j < 4; ++j) {
                    const float v = acc[i][j] * __expf(-tn * delta[j]);
                    const int cc = c + j;
                    if (cc < 1024) { kT[(size_t)cc * (2 * L) + t] = v; psum[j] += fabsf(v); }
                    else { const int d = cc - 1024; if (t == 0) kT[(size_t)d * (2 * L) + L] = 0.f; else { kT[(size_t)d * (2 * L) + 2 * L - t] = v; psum[j] += fabsf(v); } }
                }
            }
        }
        *(f32x4*)(part + (size_t)tc * 2048 + c) = psum;
        __syncthreads();
    }
}

__device__ __forceinline__ void row_sel(const Params& p, int l, int mode, int& l2, int& shi, int& sci, const float*& prew, bool& wh, int& gi, const float*& pw) {
    wh = true;
    if (mode == 0) { l2 = l; shi = 0; sci = 1; prew = p.in[I_NMPRE] + l * DM; }
    else if (mode == 1) { l2 = l; shi = 3; sci = 4; prew = p.in[I_NFPRE] + l * DM; }
    else { l2 = l + 1; shi = 0; sci = 1; wh = (l + 1 < NLAYER); if (!wh) l2 = l; prew = p.in[I_NMPRE] + l2 * DM; }
    gi = (mode == 1) ? 2 : 5;
    pw = p.in[mode == 1 ? I_NMPOST : I_NFPOST] + l * DM;
}
__device__ __forceinline__ void comb_phase(int wv, const Params& p) {
    const int tid = otid(wv);
    const float* mod = (const float*)(p.ws + S_MOD); float* comb = (float*)(p.ws + S_COMB);
    for (int idx = obid() * NTHREADS + tid; idx < NLAYER * 3 * 9 * 2048; idx += gridDim.x * NTHREADS) {
        const int c = idx & 2047, q = idx >> 11, mi = q % 9, q2 = q / 9, mode = q2 % 3, l = q2 / 3;
        int l2, shi, sci, gi; const float* prew; const float* pw; bool wh;
        row_sel(p, l, mode, l2, shi, sci, prew, wh, gi, pw);
        float g = 0.f, sc = 0.f, sh = 0.f;
        for (int kc = 0; kc < 16; ++kc) {
            g += mod[((size_t)(l * 16 + kc) * 9 + mi) * 12288 + gi * 2048 + c];
            sc += mod[((size_t)(l2 * 16 + kc) * 9 + mi) * 12288 + sci * 2048 + c];
            sh += mod[((size_t)(l2 * 16 + kc) * 9 + mi) * 12288 + shi * 2048 + c];
        }
        g += p.in[I_ADAB][(size_t)l * 12288 + gi * 2048 + c];
        sc += p.in[I_ADAB][(size_t)l2 * 12288 + sci * 2048 + c];
        sh += p.in[I_ADAB][(size_t)l2 * 12288 + shi * 2048 + c];
        float* o = comb + (size_t)q * 3 * 2048 + c;
        o[0] = g * pw[c]; o[2048] = prew[c] * (1.0f + sc); o[4096] = sh;
    }
}
__device__ __forceinline__ void row_phase(int wv, const Params& p, int l, int mode) {
    const int tid = otid(wv); const int wave = obid() * 8 + (tid >> 6), nw = gridDim.x * 8, lane = tid & 63;
    float* X = p.out;
    bf16_t* H = (bf16_t*)(p.ws + A_H);
    const bool wh = !(mode == 2 && l + 1 >= NLAYER);
    const int rows_per = (MT + nw - 1) / nw;
    for (int rr = 0; rr < rows_per; ++rr) {
        const int row = wave * rows_per + rr;
        if (row >= MT) break;
        const int mi = row < MP ? 0 : 1 + ((row - MP) >> 11);
        const float* cb = (const float*)(p.ws + S_COMB) + (size_t)((l * 3 + mode) * 9 + mi) * 3 * 2048 + lane * 4;
        f32x4 x[8];
        const float* xs = (mode == 0) ? (row < MP ? p.in[I_XP] + (size_t)row * DM : p.in[I_XS] + (size_t)(row - MP) * DM) : X + (size_t)row * DM;
#pragma unroll
        for (int i = 0; i < 8; ++i) x[i] = *(const f32x4*)(xs + i * 256 + lane * 4);
        if (mode != 0) {
            const bf16_t* o = (const bf16_t*)(p.ws + (mode == 1 ? A_M32 : A_F32)) + (size_t)row * DM;
            const unsigned tm = ((const unsigned*)(p.ws + S_TAIL))[row >> 8];
            f32x4 ovv[8]; float ss = 0.f;
#pragma unroll
            for (int i = 0; i < 8; ++i) { const u32x2 w = *(const u32x2*)(o + i * 256 + lane * 4); ovv[i] = (f32x4){bf_lo(w.x), bf_hi(w.x), bf_lo(w.y), bf_hi(w.y)};
                if ((tm >> i) & 1u) { const u32x2 w2 = *(const u32x2*)(o + (size_t)MT * DM + i * 256 + lane * 4); ovv[i] += (f32x4){bf_lo(w2.x), bf_hi(w2.x), bf_lo(w2.y), bf_hi(w2.y)}; }
                ss += ovv[i][0] * ovv[i][0] + ovv[i][1] * ovv[i][1] + ovv[i][2] * ovv[i][2] + ovv[i][3] * ovv[i][3]; }
            ss = wave_sum(ss, lane);
            const float rstd = rsqrtf(ss * (1.0f / DM) + 1e-6f);
#pragma unroll
            for (int i = 0; i < 8; ++i) x[i] += *(const f32x4*)(cb + i * 256) * (ovv[i] * rstd);
        }
#pragma unroll
        for (int i = 0; i < 8; ++i) *(f32x4*)(X + (size_t)row * DM + i * 256 + lane * 4) = x[i];
        if (wh) {
            float ss = 0.f;
#pragma unroll
            for (int i = 0; i < 8; ++i) ss += x[i][0] * x[i][0] + x[i][1] * x[i][1] + x[i][2] * x[i][2] + x[i][3] * x[i][3];
            ss = wave_sum(ss, lane);
            const float rstd = rsqrtf(ss * (1.0f / DM) + 1e-6f);
#pragma unroll
            for (int i = 0; i < 8; ++i) {
                const f32x4 hv = (x[i] * rstd) * *(const f32x4*)(cb + 2048 + i * 256) + *(const f32x4*)(cb + 4096 + i * 256);
                u32x2 o; o.x = cvt_pk_bf16(hv[0], hv[1]); o.y = cvt_pk_bf16(hv[2], hv[3]);
                *(u32x2*)(H + (size_t)row * DM + i * 256 + lane * 4) = o;
            }
        }
    }
}

__device__ __forceinline__ void rope_table_phase(int wv, const Params& p) {
    float* C = (float*)(p.ws + S_ROPE); float* Sn = C + 2048 * 32;
    const int tid = otid(wv);
    for (int idx = obid() * NTHREADS + tid; idx < 2048 * 32; idx += gridDim.x * NTHREADS) {
        const int t = idx >> 5, i = idx & 31, k = i & 15;
        const float inv = exp2f(-(float)k * 0.8304820237218406f);
        const float pos = (i < 16) ? (float)(t >> 6) : (float)(t & 63);
        const float ang = pos * inv; C[idx] = cosf(ang); Sn[idx] = sinf(ang);
    }
}
__device__ __forceinline__ void e2_phase(int wv, const Params& p, int l, LAS unsigned char* lds) {
    const bf16_t* PA = (const bf16_t*)(p.ws + A_PROJA);
    const int tid = otid(wv), lane = tid & 63;
    {
        const int gidx = obid() * NTHREADS + tid;
        if (gidx < 2048) {
            const int g = gidx >> 10, d = gidx & 1023; const int NU = g ? 64 : 8;
            const float* part = (const float*)(p.ws + (g ? S_PARTS : S_PARTP));
            float tot = 0.f;
            for (int i = 0; i < NU; ++i) tot += part[i * 2048 + d] + part[i * 2048 + 1024 + d];
            ((float*)(p.ws + S_SCALE))[gidx] = 1.0f / tot;
        }
    }
    {
        bf16_t* CQN = (bf16_t*)(p.ws + A_CQN); bf16_t* KC = (bf16_t*)(p.ws + A_KEYSC); bf16_t* KP = (bf16_t*)(p.ws + A_KPER);
        float* out_ckv = p.out + (size_t)MT * DM; float* out_kpe = out_ckv + (size_t)BP * NLAYER * LP * 256;
        const int wave = obid() * 8 + (tid >> 6), nw = gridDim.x * 8;
        for (int row = wave; row < MT + BS * PAST; row += nw) {
            if (row < MT) {
                const bf16_t* pr = PA + (size_t)row * PA_LD;
                { const u32x4 v = *(const u32x4*)(pr + 3072 + lane * 8); float f[8]; unpack8(v, f); float ss = 0.f;
#pragma unroll
                  for (int j = 0; j < 8; ++j) ss += f[j] * f[j];
                  ss = wave_sum(ss, lane); const float rstd = rsqrtf(ss * (1.0f / 512.0f) + 1e-6f);
                  const float* qn = p.in[I_QN] + l * 512 + lane * 8;
#pragma unroll
                  for (int j = 0; j < 8; ++j) f[j] = f[j] * rstd * qn[j];
                  *(u32x4*)(CQN + (size_t)row * 512 + lane * 8) = pack8(f); }
                int KR, t; const bool isp = row < MP; int b;
                if (isp) { b = row >> 8; t = row & 255; KR = BS * LKS + row; } else { const int r2 = row - MP; b = r2 >> 11; t = r2 & 2047; KR = b * LKS + t; }
                { const u32x2 v = *(const u32x2*)(pr + 3584 + lane * 4); float f[4] = {bf_lo(v.x), bf_hi(v.x), bf_lo(v.y), bf_hi(v.y)};
                  float ss = f[0] * f[0] + f[1] * f[1] + f[2] * f[2] + f[3] * f[3]; ss = wave_sum(ss, lane); const float rstd = rsqrtf(ss * (1.0f / 256.0f) + 1e-6f);
                  const float* kn = p.in[I_KVN] + l * 256 + lane * 4;
#pragma unroll
                  for (int j = 0; j < 4; ++j) f[j] = f[j] * rstd * kn[j];
                  if (isp) *(f32x4*)(out_ckv + ((size_t)(b * NLAYER + l) * LP + t) * 256 + lane * 4) = (f32x4){f[0], f[1], f[2], f[3]};
                  u32x2 w; w.x = cvt_pk_bf16(f[0], f[1]); w.y = cvt_pk_bf16(f[2], f[3]); *(u32x2*)(KC + (size_t)KR * 256 + lane * 4) = w; }
                { const float v = __uint_as_float(((unsigned)pr[3840 + lane]) << 16);
                  float o = v;
                  if (isp) out_kpe[((size_t)(b * NLAYER + l) * LP + t) * 64 + lane] = v;
                  else { const float pv = shx(v, 32, lane); const float* rc = (const float*)(p.ws + S_ROPE); const float cs = rc[t * 32 + (lane & 31)], sn = rc[2048 * 32 + t * 32 + (lane & 31)]; o = (lane < 32) ? (v * cs - pv * sn) : (pv * sn + v * cs); }
                  KP[(size_t)KR * 64 + lane] = f2bf(o); }
            } else {
                const int r2 = row - MT, b = r2 >> 9, j = r2 & 511; const int KR = b * LKS + LS + j;
                const float* cc = p.in[I_CCKV] + ((size_t)(b * NLAYER + l) * PAST + j) * 256 + lane * 4;
                const f32x4 v = *(const f32x4*)cc; u32x2 w; w.x = cvt_pk_bf16(v[0], v[1]); w.y = cvt_pk_bf16(v[2], v[3]); *(u32x2*)(KC + (size_t)KR * 256 + lane * 4) = w;
                KP[(size_t)KR * 64 + lane] = f2bf(p.in[I_CKPE][((size_t)(b * NLAYER + l) * PAST + j) * 64 + lane]);
            }
        }
    }
    {
        bf16_t* YC = (bf16_t*)(p.ws + A_YC); const float* scw = p.in[I_SCW] + (size_t)l * 3 * 1024;
        for (int it = obid() * NTHREADS + tid; it < (MT / 4) * 128; it += gridDim.x * NTHREADS) {
            const int ch = it >> 7, d0 = (it & 127) * 8, row0 = ch * 4;
            const int t0 = row0 < MP ? (row0 & 255) : ((row0 - MP) & 2047); const int L = row0 < MP ? LP : LS;
            float w0[8], w1[8], w2[8];
            { const f32x4 a = *(const f32x4*)(scw + d0), b = *(const f32x4*)(scw + d0 + 4), c = *(const f32x4*)(scw + 1024 + d0), d = *(const f32x4*)(scw + 1024 + d0 + 4),
                          e2 = *(const f32x4*)(scw + 2048 + d0), f = *(const f32x4*)(scw + 2048 + d0 + 4);
#pragma unroll
              for (int j = 0; j < 4; ++j) { w0[j] = a[j]; w0[4 + j] = b[j]; w1[j] = c[j]; w1[4 + j] = d[j]; w2[j] = e2[j]; w2[4 + j] = f[j]; } }
            const bf16_t* pr = PA + (size_t)row0 * PA_LD;
            float pp[8], pc[8], pn[8];
#pragma unroll
            for (int j = 0; j < 8; ++j) pp[j] = 0.f;
            if (t0 > 0) { float cg[8], uu[8]; unpack8(*(const u32x4*)(pr - PA_LD + 4928 + d0), cg); unpack8(*(const u32x4*)(pr - PA_LD + 5952 + d0), uu);
#pragma unroll
                for (int j = 0; j < 8; ++j) pp[j] = cg[j] * uu[j]; }
            { float cg[8], uu[8]; unpack8(*(const u32x4*)(pr + 4928 + d0), cg); unpack8(*(const u32x4*)(pr + 5952 + d0), uu);
#pragma unroll
              for (int j = 0; j < 8; ++j) pc[j] = cg[j] * uu[j]; }
#pragma unroll
            for (int i = 0; i < 4; ++i) {
#pragma unroll
                for (int j = 0; j < 8; ++j) pn[j] = 0.f;
                if (t0 + i + 1 < L) { float cg[8], uu[8]; unpack8(*(const u32x4*)(pr + (size_t)(i + 1) * PA_LD + 4928 + d0), cg); unpack8(*(const u32x4*)(pr + (size_t)(i + 1) * PA_LD + 5952 + d0), uu);
#pragma unroll
                    for (int j = 0; j < 8; ++j) pn[j] = cg[j] * uu[j]; }
                float bg[8], o[8]; unpack8(*(const u32x4*)(pr + (size_t)i * PA_LD + 3904 + d0), bg);
#pragma unroll
                for (int j = 0; j < 8; ++j) { o[j] = bg[j] * (w0[j] * pp[j] + w1[j] * pc[j] + w2[j] * pn[j]); pp[j] = pc[j]; pc[j] = pn[j]; }
                *(u32x4*)(YC + (size_t)(row0 + i) * 1024 + d0) = pack8(o);
            }
        }
    }
    {
        bf16_t* X0S = (bf16_t*)(p.ws + A_X0S); bf16_t* ZZT = (bf16_t*)(p.ws + A_ZZT);
        const float* hw = p.in[I_HCW] + (size_t)l * 3 * 3072; const float* hb = p.in[I_HCB] + (size_t)l * 3072;
        LAS bf16_t* zt = (LAS bf16_t*)lds;
        for (int u = obid(); u < (MT / 256) * 16; u += gridDim.x) {
            const int rt = u >> 4, dt = u & 15; const int row0 = rt * 256;
            const int dg = tid & 7, rb = tid >> 3, d0 = dt * 64 + dg * 8; const int rowb = row0 + rb * 4;
            const int L = row0 < MP ? LP : LS; const int tb = (row0 < MP ? (row0 & 255) : ((row0 - MP) & 2047)) + rb * 4;
            float wgt[3][3][8], bs[3][8];
#pragma unroll
            for (int g = 0; g < 3; ++g) {
#pragma unroll
                for (int o = 0; o < 3; ++o) { const f32x4 a = *(const f32x4*)(hw + o * 3072 + g * 1024 + d0), b = *(const f32x4*)(hw + o * 3072 + g * 1024 + d0 + 4);
#pragma unroll
                    for (int j = 0; j < 4; ++j) { wgt[g][o][j] = a[j]; wgt[g][o][4 + j] = b[j]; } }
                const f32x4 a = *(const f32x4*)(hb + g * 1024 + d0), b = *(const f32x4*)(hb + g * 1024 + d0 + 4);
#pragma unroll
                for (int j = 0; j < 4; ++j) { bs[g][j] = a[j]; bs[g][4 + j] = b[j]; }
            }
            const bf16_t* pr = PA + (size_t)rowb * PA_LD + d0;
            u32x4 wp[3], wc[3], wn[3];
#pragma unroll
            for (int g = 0; g < 3; ++g) { wp[g] = (u32x4){0u, 0u, 0u, 0u}; if (tb > 0) wp[g] = *(const u32x4*)(pr - PA_LD + g * 1024); wc[g] = *(const u32x4*)(pr + g * 1024); }
#pragma unroll
            for (int i = 0; i < 4; ++i) {
#pragma unroll
                for (int g = 0; g < 3; ++g) { wn[g] = (u32x4){0u, 0u, 0u, 0u}; if (tb + i + 1 < L) wn[g] = *(const u32x4*)(pr + (size_t)(i + 1) * PA_LD + g * 1024); }
                float hv[3][8];
#pragma unroll
                for (int g = 0; g < 3; ++g) { float a[8], b[8], c[8]; unpack8(wp[g], a); unpack8(wc[g], b); unpack8(wn[g], c);
#pragma unroll
                    for (int j = 0; j < 8; ++j) hv[g][j] = bs[g][j] + wgt[g][0][j] * a[j] + wgt[g][1][j] * b[j] + wgt[g][2][j] * c[j];
                    wp[g] = wc[g]; wc[g] = wn[g]; }
                *(u32x4*)(X0S + (size_t)(rowb + i) * 1024 + d0) = pack8(hv[0]);
#pragma unroll
                for (int j = 0; j < 8; ++j) zt[(dg * 8 + j) * 264 + rb * 4 + i] = f2bf(hv[1][j] * hv[2][j]);
            }
            __syncthreads();
#pragma unroll
            for (int i = 0; i < 4; ++i) {
                const int chunk = tid + i * NTHREADS; const int dl = chunk >> 5, tch = chunk & 31; const int d = dt * 64 + dl;
                size_t base; int t0;
                if (row0 < MP) { const int b = row0 >> 8; t0 = 0; base = ((size_t)b * 1024 + d) * LP; }
                else { const int r2 = row0 - MP; const int b = r2 >> 11; t0 = r2 & 2047; base = (size_t)BP * 1024 * LP + ((size_t)b * 1024 + d) * LS; }
                *(u32x4*)(ZZT + base + t0 + tch * 8) = *(const LAS u32x4*)(zt + dl * 264 + tch * 8);
            }
            __syncthreads();
        }
    }
}

__device__ __forceinline__ void conv_phase(int wv, const Params& p, int l, LAS unsigned char* lds) {
    const int tid = otid(wv), wid = tid >> 6, lane = tid & 63, r = lane & 31, hh = lane >> 5;
    const bf16_t* ZZT = (const bf16_t*)(p.ws + A_ZZT); bf16_t* YCT = (bf16_t*)(p.ws + A_YCT);
    const float* hbias = p.in[I_HBIAS] + l * 1024;
    LAS bf16_t* cp = (LAS bf16_t*)lds;
    LAS bf16_t* zz = (LAS bf16_t*)(lds + 65536);
    LAS float* kf = (LAS float*)(lds + 98304);
    for (int u = obid(); u < 2048; u += gridDim.x) {
        const int g = (u < 1024) ? 1 : 0, d = u & 1023;
        const int L = g ? LS : LP, B = g ? BS : BP, L2 = 2 * L, NB = L / 32, NI = 32 / B, NT = NB / NI, lgB = g ? 3 : 4;
        const float* kT = (const float*)(p.ws + (g ? S_KTS : S_KTP)) + (size_t)d * L2;
        const float scale = ((const float*)(p.ws + S_SCALE))[g * 1024 + d]; const float bias = hbias[d];
        for (int i = tid; i < L2 / 4; i += NTHREADS) { f32x4 v = *(const f32x4*)(kT + i * 4); v *= scale; if (i == 0) v[0] += bias; *(LAS f32x4*)(kf + i * 4) = v; }
        const size_t zbase = g ? (size_t)BP * 1024 * LP : 0;
        for (int ch = tid; ch < B * L / 8; ch += NTHREADS) {
            const int b = ch / (L / 8), s8 = ch - b * (L / 8);
            *(LAS u32x4*)(zz + b * L + s8 * 8) = *(const u32x4*)(ZZT + zbase + ((size_t)b * 1024 + d) * L + s8 * 8);
        }
        __syncthreads();
        for (int ck = tid; ck < L2; ck += NTHREADS) {
            const int c = ck / (L2 / 8), m0 = (ck - c * (L2 / 8)) * 8;
            float f[8];
#pragma unroll
            for (int j = 0; j < 8; ++j) f[j] = kf[(L2 - (m0 + c + j)) & (L2 - 1)];
            *(LAS u32x4*)(cp + c * L2 + m0) = pack8(f);
        }
        __syncthreads();
        const int Iloc = r >> lgB, b = r & (B - 1);
        for (int nt = wid * 2; nt < NT; nt += 16) {
            const int I0 = nt * NI;
            f32x16 acc0, acc1;
#pragma unroll
            for (int i = 0; i < 16; ++i) { acc0[i] = 0.f; acc1[i] = 0.f; }
            for (int dl = I0 - (NB - 1); dl <= I0 + 2 * NI - 1; ++dl) {
                const int J0 = I0 + Iloc - dl, J1 = J0 + NI; const bool v0 = (J0 >= 0) && (J0 < NB), v1 = (J1 >= 0) && (J1 < NB);
#pragma unroll
                for (int ks = 0; ks < 2; ++ks) {
                    const int i0 = (16 * ks + 8 * hh - 32 * dl - r) & (L2 - 1); const int c = i0 & 7, q = i0 >> 3;
                    const bf16x8 Af = *(const LAS bf16x8*)(cp + c * L2 + q * 8);
                    bf16x8 B0 = (bf16x8){0, 0, 0, 0, 0, 0, 0, 0}, B1 = B0;
                    if (v0) B0 = *(const LAS bf16x8*)(zz + b * L + 32 * J0 + 16 * ks + 8 * hh);
                    if (v1) B1 = *(const LAS bf16x8*)(zz + b * L + 32 * J1 + 16 * ks + 8 * hh);
                    acc0 = __builtin_amdgcn_mfma_f32_32x32x16_bf16(Af, B0, acc0, 0, 0, 0);
                    acc1 = __builtin_amdgcn_mfma_f32_32x32x16_bf16(Af, B1, acc1, 0, 0, 0);
                }
            }
            bf16_t* op = YCT + zbase + ((size_t)b * 1024 + d) * L + 32 * (I0 + Iloc) + 4 * hh;
#pragma unroll
            for (int g4 = 0; g4 < 4; ++g4) {
                u32x2 w; w.x = cvt_pk_bf16(acc0[4 * g4], acc0[4 * g4 + 1]); w.y = cvt_pk_bf16(acc0[4 * g4 + 2], acc0[4 * g4 + 3]); *(u32x2*)(op + 8 * g4) = w;
                u32x2 w1; w1.x = cvt_pk_bf16(acc1[4 * g4], acc1[4 * g4 + 1]); w1.y = cvt_pk_bf16(acc1[4 * g4 + 2], acc1[4 * g4 + 3]); *(u32x2*)(op + 32 * NI + 8 * g4) = w1;
            }
        }
        __syncthreads();
    }
}

__device__ __forceinline__ void e3b_phase(int wv, const Params& p, LAS unsigned char* lds) {
    const int tid = otid(wv);
    const bf16_t* X0S = (const bf16_t*)(p.ws + A_X0S); const bf16_t* YCT = (const bf16_t*)(p.ws + A_YCT); bf16_t* YA = (bf16_t*)(p.ws + A_YA);
    LAS bf16_t* yt = (LAS bf16_t*)lds;
    for (int u = obid(); u < (MT / 64) * 16; u += gridDim.x) {
        const int rt = u >> 4, dt = u & 15; const int row0 = rt * 64;
        {
            const int dl = tid >> 3, tch = tid & 7; const int d = dt * 64 + dl;
            size_t base; int t0;
            if (row0 < MP) { const int b = row0 >> 8; t0 = row0 & 255; base = ((size_t)b * 1024 + d) * LP; }
            else { const int r2 = row0 - MP; const int b = r2 >> 11; t0 = r2 & 2047; base = (size_t)BP * 1024 * LP + ((size_t)b * 1024 + d) * LS; }
            const u32x4 v = *(const u32x4*)(YCT + base + t0 + tch * 8);
            const unsigned w[4] = {v.x, v.y, v.z, v.w};
#pragma unroll
            for (int j = 0; j < 4; ++j) { yt[(tch * 8 + 2 * j) * 72 + dl] = (bf16_t)(w[j] & 0xffffu); yt[(tch * 8 + 2 * j + 1) * 72 + dl] = (bf16_t)(w[j] >> 16); }
        }
        __syncthreads();
        {
            const int tl = tid >> 3, dg = tid & 7; const int row = row0 + tl, d0 = dt * 64 + dg * 8;
            float a[8], b[8]; unpack8(*(const LAS u32x4*)(yt + tl * 72 + dg * 8), a); unpack8(*(const u32x4*)(X0S + (size_t)row * 1024 + d0), b);
#pragma unroll
            for (int j = 0; j < 8; ++j) a[j] *= b[j];
            *(u32x4*)(YA + (size_t)row * 1024 + d0) = pack8(a);
        }
        __syncthreads();
    }
}

__device__ __forceinline__ void attn_phase(int wv, const Params& p, LAS unsigned char* lds) {
    const bf16_t* Q = (const bf16_t*)(p.ws + A_Q); const bf16_t* KN = (const bf16_t*)(p.ws + A_KN); const bf16_t* KP = (const bf16_t*)(p.ws + A_KPER);
    const bf16_t* VT = (const bf16_t*)(p.ws + A_VT); bf16_t* O = (bf16_t*)(p.ws + A_OATT);
    LAS unsigned char* Ks = lds;
    LAS unsigned char* Vs = lds + 64 * 400;
    const float sc2 = 0.07216878364870322f * 1.4426950408889634f;
    for (int u = obid(); u < 512 + 128; u += gridDim.x) {
        const int tid = otid(wv), wid = tid >> 6, lane = tid & 63, r = lane & 31, hh = lane >> 5;
        int b, h, row0, Lk, KR0; size_t vtb; bool samp;
        if (u < 512) { samp = true; b = u >> 6; h = (u >> 3) & 7; const int qb = u & 7; row0 = MP + b * LS + qb * 256; Lk = LKS; KR0 = b * LKS; vtb = (size_t)(b * 8 + h) * 128 * LKS; }
        else { samp = false; const int u2 = u - 512; b = u2 >> 3; h = u2 & 7; row0 = b * LP; Lk = LP; KR0 = BS * LKS + b * LP; vtb = (size_t)BS * 8 * 128 * LKS + (size_t)(b * 8 + h) * 128 * LP; }
        const int qrow = row0 + wid * 32 + r;
        bf16x8 qf[12];
        {
            const bf16_t* qp = Q + (size_t)qrow * 1536 + h * 192 + 8 * hh;
            u32x4 qv[12];
#pragma unroll
            for (int s = 0; s < 12; ++s) qv[s] = *(const u32x4*)(qp + 16 * s);
            if (samp) {
                const int t = (qrow - MP) & 2047;
#pragma unroll
                for (int s2 = 0; s2 < 2; ++s2) {
                    float x1[8], x2[8]; unpack8(qv[8 + s2], x1); unpack8(qv[10 + s2], x2);
                    const float* rc = (const float*)(p.ws + S_ROPE) + t * 32 + 16 * s2 + 8 * hh;
                    const f32x4 c0 = *(const f32x4*)rc, c1 = *(const f32x4*)(rc + 4), s0 = *(const f32x4*)(rc + 2048 * 32), s1 = *(const f32x4*)(rc + 2048 * 32 + 4);
#pragma unroll
                    for (int j = 0; j < 8; ++j) { const float cs = (j < 4) ? c0[j & 3] : c1[j & 3], sn = (j < 4) ? s0[j & 3] : s1[j & 3]; const float a = x1[j], c = x2[j]; x1[j] = a * cs - c * sn; x2[j] = a * sn + c * cs; }
                    qv[8 + s2] = pack8(x1); qv[10 + s2] = pack8(x2);
                }
            }
#pragma unroll
            for (int s = 0; s < 12; ++s) qf[s] = __builtin_bit_cast(bf16x8, qv[s]);
        }
        f32x16 oacc[4];
#pragma unroll
        for (int ct = 0; ct < 4; ++ct)
#pragma unroll
            for (int i = 0; i < 16; ++i) oacc[ct][i] = 0.f;
        float mrun = -1e30f, lrun = 0.f;
        const int nkt = Lk / 64;
        u32x4 kst[3], vst[2];
#pragma unroll
        for (int i = 0; i < 3; ++i) { const int ck = tid + i * NTHREADS; const int key = ck / 24, part = ck - key * 24;
            kst[i] = (part < 16) ? *(const u32x4*)(KN + (size_t)(KR0 + key) * 1024 + h * 128 + part * 8) : *(const u32x4*)(KP + (size_t)(KR0 + key) * 64 + (part - 16) * 8); }
#pragma unroll
        for (int i = 0; i < 2; ++i) { const int cv = tid + i * NTHREADS; const int v = cv >> 3, kc = cv & 7; vst[i] = *(const u32x4*)(VT + vtb + (size_t)v * Lk + kc * 8); }
        for (int kt = 0; kt < nkt; ++kt) {
            __syncthreads();
#pragma unroll
            for (int i = 0; i < 3; ++i) { const int ck = tid + i * NTHREADS; const int key = ck / 24, part = ck - key * 24; *(LAS u32x4*)(Ks + key * 400 + part * 16) = kst[i]; }
#pragma unroll
            for (int i = 0; i < 2; ++i) { const int cv = tid + i * NTHREADS; const int v = cv >> 3, kc = cv & 7; *(LAS u32x4*)(Vs + v * 144 + kc * 16) = vst[i]; }
            __syncthreads();
            if (kt + 1 < nkt) {
                const int k0 = (kt + 1) * 64;
#pragma unroll
                for (int i = 0; i < 3; ++i) { const int ck = tid + i * NTHREADS; const int key = ck / 24, part = ck - key * 24;
                    kst[i] = (part < 16) ? *(const u32x4*)(KN + (size_t)(KR0 + k0 + key) * 1024 + h * 128 + part * 8) : *(const u32x4*)(KP + (size_t)(KR0 + k0 + key) * 64 + (part - 16) * 8); }
#pragma unroll
                for (int i = 0; i < 2; ++i) { const int cv = tid + i * NTHREADS; const int v = cv >> 3, kc = cv & 7; vst[i] = *(const u32x4*)(VT + vtb + (size_t)v * Lk + k0 + kc * 8); }
            }
            f32x16 sacc[2];
#pragma unroll
            for (int kk = 0; kk < 2; ++kk) {
#pragma unroll
                for (int i = 0; i < 16; ++i) sacc[kk][i] = 0.f;
#pragma unroll
                for (int s = 0; s < 12; ++s) {
                    const bf16x8 kf = *(const LAS bf16x8*)(Ks + (32 * kk + r) * 400 + (16 * s + 8 * hh) * 2);
                    sacc[kk] = __builtin_amdgcn_mfma_f32_32x32x16_bf16(kf, qf[s], sacc[kk], 0, 0, 0);
                }
            }
            float mx0 = fmaxf(sacc[0][0], sacc[1][0]), mx1 = fmaxf(sacc[0][1], sacc[1][1]);
#pragma unroll
            for (int i = 2; i < 16; i += 2) { mx0 = __builtin_fmaxf(__builtin_fmaxf(mx0, sacc[0][i]), sacc[1][i]); mx1 = __builtin_fmaxf(__builtin_fmaxf(mx1, sacc[0][i + 1]), sacc[1][i + 1]); }
            float mx = fmaxf(mx0, mx1);
            mx = fmaxf(mx, shx(mx, 32, lane));
            const float mnew = fmaxf(mrun, mx);
            const bool resc = __builtin_amdgcn_ballot_w64(mnew != mrun) != 0ull;
            const float alpha = __builtin_amdgcn_exp2f((mrun - mnew) * sc2);
            mrun = mnew;
            const float nm = -mnew * sc2;
            f32x2 ps2 = (f32x2){0.f, 0.f};
#pragma unroll
            for (int kk = 0; kk < 2; ++kk)
#pragma unroll
                for (int i = 0; i < 16; i += 2) {
                    f32x2 a = (f32x2){sacc[kk][i], sacc[kk][i + 1]}; a = a * sc2 + nm;
                    a.x = __builtin_amdgcn_exp2f(a.x); a.y = __builtin_amdgcn_exp2f(a.y);
                    sacc[kk][i] = a.x; sacc[kk][i + 1] = a.y; ps2 += a;
                }
            lrun = lrun * alpha + (ps2.x + ps2.y);
            if (resc) {
#pragma unroll
                for (int ct = 0; ct < 4; ++ct)
#pragma unroll
                    for (int i = 0; i < 16; ++i) oacc[ct][i] *= alpha;
            }
#pragma unroll
            for (int ks = 0; ks < 4; ++ks) {
                const int kk = ks >> 1, s2 = ks & 1;
                u32x4 pw;
                pw.x = cvt_pk_bf16(sacc[kk][8 * s2 + 0], sacc[kk][8 * s2 + 1]); pw.y = cvt_pk_bf16(sacc[kk][8 * s2 + 2], sacc[kk][8 * s2 + 3]);
                pw.z = cvt_pk_bf16(sacc[kk][8 * s2 + 4], sacc[kk][8 * s2 + 5]); pw.w = cvt_pk_bf16(sacc[kk][8 * s2 + 6], sacc[kk][8 * s2 + 7]);
                const bf16x8 pf = __builtin_bit_cast(bf16x8, pw);
#pragma unroll
                for (int ct = 0; ct < 4; ++ct) {
                    const LAS unsigned char* vp = Vs + (32 * ct + r) * 144 + (32 * kk + 16 * s2 + 4 * hh) * 2;
                    const u32x2 lo = *(const LAS u32x2*)vp, hi = *(const LAS u32x2*)(vp + 16);
                    u32x4 vw; vw.x = lo.x; vw.y = lo.y; vw.z = hi.x; vw.w = hi.y;
                    oacc[ct] = __builtin_amdgcn_mfma_f32_32x32x16_bf16(__builtin_bit_cast(bf16x8, vw), pf, oacc[ct], 0, 0, 0);
                }
            }
        }
        lrun += shx(lrun, 32, lane);
        const float invl = 1.0f / lrun;
        const int tid2 = otid(wv); const int qrow2 = row0 + (tid2 >> 6) * 32 + (tid2 & 31);
        bf16_t* op = O + (size_t)qrow2 * 1024 + h * 128 + 4 * ((tid2 >> 5) & 1);
#pragma unroll
        for (int ct = 0; ct < 4; ++ct)
#pragma unroll
            for (int g4 = 0; g4 < 4; ++g4) {
                u32x2 w; w.x = cvt_pk_bf16(oacc[ct][4 * g4] * invl, oacc[ct][4 * g4 + 1] * invl); w.y = cvt_pk_bf16(oacc[ct][4 * g4 + 2] * invl, oacc[ct][4 * g4 + 3] * invl);
                *(u32x2*)(op + 32 * ct + 8 * g4) = w;
            }
        __syncthreads();
    }
}

__device__ __forceinline__ void e9_phase(int wv, const Params& p, int l) {
    const bf16_t* UU = (const bf16_t*)(p.ws + A_UU); bf16_t* ACT = (bf16_t*)(p.ws + A_ACT);
    const float* cw = p.in[I_FCW] + (size_t)l * 3 * UU_LD; const float* cb = p.in[I_FCB] + (size_t)l * UU_LD;
    const int tid9 = otid(wv);
    constexpr int RC = 16, NCG = DFF / 8;
    for (int it = obid() * NTHREADS + tid9; it < (MT / RC) * NCG; it += gridDim.x * NTHREADS) {
        const int ch = it / NCG, c0 = (it - ch * NCG) * 8, row0 = ch * RC;
        const int t0 = row0 < MP ? (row0 & 255) : ((row0 - MP) & 2047); const int L = row0 < MP ? LP : LS;
        float wg[3][8], wx[3][8], bg[8], bx[8];
#pragma unroll
        for (int o = 0; o < 3; ++o) { const f32x4 a = *(const f32x4*)(cw + o * UU_LD + c0), b = *(const f32x4*)(cw + o * UU_LD + c0 + 4), c = *(const f32x4*)(cw + o * UU_LD + DFF + c0), d = *(const f32x4*)(cw + o * UU_LD + DFF + c0 + 4);
#pragma unroll
            for (int j = 0; j < 4; ++j) { wg[o][j] = a[j]; wg[o][4 + j] = b[j]; wx[o][j] = c[j]; wx[o][4 + j] = d[j]; } }
        { const f32x4 a = *(const f32x4*)(cb + c0), b = *(const f32x4*)(cb + c0 + 4), c = *(const f32x4*)(cb + DFF + c0), d = *(const f32x4*)(cb + DFF + c0 + 4);
#pragma unroll
          for (int j = 0; j < 4; ++j) { bg[j] = a[j]; bg[4 + j] = b[j]; bx[j] = c[j]; bx[4 + j] = d[j]; } }
        const bf16_t* pr = UU + (size_t)row0 * UU_LD + c0;
        u32x4 gp = (u32x4){0u, 0u, 0u, 0u}, xp = gp, gc, xc, gn, xn;
        if (t0 > 0) { gp = *(const u32x4*)(pr - UU_LD); xp = *(const u32x4*)(pr - UU_LD + DFF); }
        gc = *(const u32x4*)pr; xc = *(const u32x4*)(pr + DFF);
#pragma unroll 4
        for (int i = 0; i < RC; ++i) {
            gn = (u32x4){0u, 0u, 0u, 0u}; xn = gn;
            if (t0 + i + 1 < L) { gn = *(const u32x4*)(pr + (size_t)(i + 1) * UU_LD); xn = *(const u32x4*)(pr + (size_t)(i + 1) * UU_LD + DFF); }
            float a[8], b[8], c[8], ga[8], va[8];
            unpack8(gp, a); unpack8(gc, b); unpack8(gn, c);
#pragma unroll
            for (int j = 0; j < 8; ++j) ga[j] = bg[j] + wg[0][j] * a[j] + wg[1][j] * b[j] + wg[2][j] * c[j];
            unpack8(xp, a); unpack8(xc, b); unpack8(xn, c);
#pragma unroll
            for (int j = 0; j < 8; ++j) va[j] = bx[j] + wx[0][j] * a[j] + wx[1][j] * b[j] + wx[2][j] * c[j];
#pragma unroll
            for (int j = 0; j < 8; ++j) ga[j] = siluf_(ga[j]) * va[j];
            *(u32x4*)(ACT + (size_t)(row0 + i) * DFF + c0) = pack8(ga);
            gp = gc; gc = gn; xp = xc; xc = xn;
        }
    }
}

__device__ __forceinline__ void merge_phase(int wv, const Params& p) {
    const bf16_t* RAW = (const bf16_t*)(p.ws + A_RAW); const bf16_t* G = (const bf16_t*)(p.ws + A_GATES); bf16_t* MB = (bf16_t*)(p.ws + A_MBF);
    const int tid = otid(wv);
    for (int it = obid() * NTHREADS + tid; it < MT * 256; it += gridDim.x * NTHREADS) {
        const int row = it >> 8, c0 = (it & 255) * 8;
        float acc[8];
#pragma unroll
        for (int j = 0; j < 8; ++j) acc[j] = 0.f;
#pragma unroll
        for (int P = 0; P < 3; ++P) {
            float r[8], g[8];
            unpack8(*(const u32x4*)(RAW + ((size_t)P * MT + row) * DM + c0), r); unpack8(*(const u32x4*)(G + (size_t)row * GATE_LD + P * 2048 + c0), g);
#pragma unroll
            for (int j = 0; j < 8; ++j) acc[j] += sigmoidf_(g[j]) * r[j];
        }
        *(u32x4*)(MB + (size_t)row * DM + c0) = pack8(acc);
    }
}

__device__ __forceinline__ void convert_layer(int wv, const Params& p, int l, LAS unsigned char* lds) {
    unsigned char* ws = p.ws;
    convT(wv, p.in[I_WIN] + (size_t)l * DM * NIN, DM, NIN, (bf16_t*)(ws + W_IN), 1, lds);
    convT(wv, p.in[I_WUQ] + (size_t)l * 512 * 1536, 512, 1536, (bf16_t*)(ws + W_UQ), 0, lds);
    convT(wv, p.in[I_WUKV] + (size_t)l * 256 * 2048, 256, 2048, (bf16_t*)(ws + W_UKV), 2, lds);
    convT(wv, p.in[I_WBRA] + (size_t)l * 1024 * 2048, 1024, 2048, (bf16_t*)(ws + W_BRA), 0, lds);
    convT(wv, p.in[I_WBRB] + (size_t)l * 1024 * 2048, 1024, 2048, (bf16_t*)(ws + W_BRB), 0, lds);
    convT(wv, p.in[I_WBRC] + (size_t)l * 1024 * 2048, 1024, 2048, (bf16_t*)(ws + W_BRC), 0, lds);
    convT(wv, p.in[I_WO] + (size_t)l * 2048 * 2048, 2048, 2048, (bf16_t*)(ws + W_O), 0, lds);
    convT(wv, p.in[I_FUP] + (size_t)l * 2048 * UU_LD, 2048, UU_LD, (bf16_t*)(ws + W_UP), 0, lds);
    convT(wv, p.in[I_FDN] + (size_t)l * DFF * 2048, DFF, 2048, (bf16_t*)(ws + W_DN), 0, lds);
}

namespace pg8 {
struct EpiGateRT {
    const bf16_t* gates; float* m32; bf16_t* mbf; int P;
    __device__ __forceinline__ void operator()(const f32x4 (&acc)[2][2][4][2], const Unit& u, int wr, int wc, int fr, int fq) const {
        const int row0 = u.pm * BM + wr * 64 + fr, col0 = u.pn * BM + wc * 32 + 4 * fq;
#pragma unroll
        for (int ai = 0; ai < 2; ++ai)
#pragma unroll
            for (int m = 0; m < 4; ++m) {
                const size_t row = (size_t)(row0 + ai * HALF + m * 16);
#pragma unroll
                for (int bj = 0; bj < 2; ++bj)
#pragma unroll
                    for (int n = 0; n < 2; ++n) {
                        const int col = col0 + bj * HALF + n * 16;
                        const u32x2 gw = *(const u32x2*)(gates + row * GATE_LD + P * 2048 + col);
                        f32x4 v = acc[ai][bj][m][n];
                        v[0] *= sigmoidf_(bf_lo(gw.x)); v[1] *= sigmoidf_(bf_hi(gw.x)); v[2] *= sigmoidf_(bf_lo(gw.y)); v[3] *= sigmoidf_(bf_hi(gw.y));
                        float* mp = m32 + row * 2048 + col;
                        if (P != 0) { const f32x4 o = *(const f32x4*)mp; v = v + o; }
                        if (P != 2) { *(f32x4*)mp = v; }
                        else { u32x2 w; w.x = cvt_pk_bf16(v[0], v[1]); w.y = cvt_pk_bf16(v[2], v[3]); *(u32x2*)(mbf + row * 2048 + col) = w; }
                    }
            }
    }
};
}


#define XB_TMO      128
#define XB_XCNT(j)  (256  + 64 * (j))
#define XB_XSUB(j)  (1280 + 64 * (j))
#define XB_XGEN(j)  (2304 + 64 * (j))
#define XB_TOP      3328
#define XB_TOPGEN   3392
#define XCD_BAR_WORDS 3456
#define XB_SPIN_CAP (1u << 20)
__device__ __forceinline__ unsigned xb_ld(unsigned* p)              { return __hip_atomic_load(p, __ATOMIC_RELAXED, __HIP_MEMORY_SCOPE_AGENT); }
__device__ __forceinline__ unsigned xb_add(unsigned* p, unsigned v) { return __hip_atomic_fetch_add(p, v, __ATOMIC_RELAXED, __HIP_MEMORY_SCOPE_AGENT); }
__device__ __forceinline__ unsigned xb_xcc_id() { return (unsigned)__builtin_amdgcn_s_getreg((3 << 11) | 20) & 0xFu; }
#define XB_SPIN(cond, bar) do { unsigned _sp = 0; while (cond) { __builtin_amdgcn_s_sleep(1); \
    if ((++_sp & 255u) == 0u) { if (xb_ld(&(bar)[XB_TMO])) break; if (_sp > XB_SPIN_CAP) { atomicAdd(&(bar)[XB_TMO], 1u); break; } } } } while (0)
__device__ __forceinline__ void xcd_barrier_complete(unsigned* bar, unsigned x, unsigned& nloc, unsigned& nx) {
    const unsigned G = gridDim.x;
    unsigned sum, cnt, mine, sp = 0u;
    for (;;) {
        sum = 0u; cnt = 0u; mine = 0u;
#pragma unroll
        for (unsigned j = 0; j < 16; ++j) { const unsigned c = xb_ld(&bar[XB_XCNT(j)]); sum += c; cnt += (c > 0u) ? 1u : 0u; mine = (j == x) ? c : mine; }
        if (sum == G) break;
        __builtin_amdgcn_s_sleep(1);
        if ((++sp & 255u) == 0u) { if (xb_ld(&bar[XB_TMO])) break; if (sp > XB_SPIN_CAP) { atomicAdd(&bar[XB_TMO], 1u); break; } }
    }
    nloc = mine > 0u ? mine : 1u; nx = cnt > 0u ? cnt : 1u;
}
__device__ __forceinline__ void xcd_barrier(int wv, unsigned* bar, volatile LAS unsigned* st) {
    asm volatile("s_waitcnt vmcnt(0)" ::: "memory");
    __syncthreads();
    if (otid(wv) == 0) {
        __builtin_amdgcn_s_waitcnt(0);
        const unsigned x = xb_xcc_id();
        unsigned nloc = st[0], nx = st[1];
        if (nloc == 0u) { xcd_barrier_complete(bar, x, nloc, nx); st[0] = nloc; st[1] = nx; }
        const unsigned old = xb_add(&bar[XB_XSUB(x)], 1u);
        const unsigned gen = old / nloc;
        if (old + 1u == (gen + 1u) * nloc) {
            __builtin_amdgcn_fence(__ATOMIC_RELEASE, "agent");
            asm volatile("s_waitcnt vmcnt(0)" ::: "memory");
            const unsigned og = xb_add(&bar[XB_TOP], 1u);
            const unsigned tg = og / nx;
            if (og + 1u == (tg + 1u) * nx) xb_add(&bar[XB_TOPGEN], 1u);
            else XB_SPIN(xb_ld(&bar[XB_TOPGEN]) == tg, bar);
            __builtin_amdgcn_fence(__ATOMIC_ACQUIRE, "agent");
            xb_add(&bar[XB_XGEN(x)], 1u);
            asm volatile("s_waitcnt vmcnt(0)" ::: "memory");
        } else {
            XB_SPIN(xb_ld(&bar[XB_XGEN(x)]) == gen, bar);
            __builtin_amdgcn_fence(__ATOMIC_ACQUIRE, "agent");
            asm volatile("s_waitcnt vmcnt(0)" ::: "memory");
        }
    }
    __syncthreads();
}

#ifndef REP_GEMM
#define REP_GEMM 1
#endif
#ifndef REP_ATTN
#define REP_ATTN 1
#endif
#ifndef REP_CONV
#define REP_CONV 1
#endif
#ifndef REP_ELT
#define REP_ELT 1
#endif
#ifndef REP_CVT
#define REP_CVT 1
#endif
enum { K_G1A = 0, K_E2, K_I3, K_I4, K_G1B, K_G5, K_G6, K_ROW1, K_G8, K_E9, K_G10, K_ROW2, K_PRO, K_ROW0, K_COMB };

__global__ void __launch_bounds__(NTHREADS) fwd_megakernel(Params p) {
    extern __shared__ __attribute__((aligned(16))) unsigned char shm[];
    LAS unsigned char* lds = (LAS unsigned char*)shm;
    cg::grid_group grid = cg::this_grid();
    const int wv = __builtin_amdgcn_readfirstlane((int)(threadIdx.x >> 6));
    volatile LAS unsigned* bst = (volatile LAS unsigned*)(lds + 131072);
    unsigned* bar = (unsigned*)(p.ws + S_BAR);
    if (threadIdx.x == 0) { bst[0] = 0u; bst[1] = 0u; bst[2] = 0u; bst[3] = 0u; (void)xb_add(&bar[XB_XCNT(xb_xcc_id())], 1u); }
    __syncthreads();
#pragma unroll 1
    for (int ph = 0; ph < 3 + 12 * NLAYER; ++ph) {
        int kind, l;
        if (ph == 0) { kind = K_PRO; l = 0; } else if (ph == 1) { kind = K_COMB; l = 0; } else if (ph == 2) { kind = K_ROW0; l = 0; } else { l = (ph - 3) / 12; kind = (ph - 3) - l * 12; }
        unsigned char* ws = p.ws;
        asm volatile("" : "+s"(ws));
        if (kind == K_G1A || kind == K_I3 || kind == K_G1B || kind == K_G8) {
            const bf16_t* A; const bf16_t* Bt; bf16_t* O; int N, K;
            if (kind == K_G1A) { A = (const bf16_t*)(ws + A_H); Bt = (const bf16_t*)(ws + W_IN); O = (bf16_t*)(ws + A_PROJA); N = PA_LD; K = DM; }
            else if (kind == K_I3) { A = (const bf16_t*)(ws + A_CQN); Bt = (const bf16_t*)(ws + W_UQ); O = (bf16_t*)(ws + A_Q); N = 1536; K = 512; }
            else if (kind == K_G1B) { A = (const bf16_t*)(ws + A_H); Bt = (const bf16_t*)(ws + W_IN) + (size_t)PA_LD * DM; O = (bf16_t*)(ws + A_GATES); N = GATE_LD; K = DM; }
            else { A = (const bf16_t*)(ws + A_H); Bt = (const bf16_t*)(ws + W_UP); O = (bf16_t*)(ws + A_UU); N = UU_LD; K = DM; }
            int Mr = MT;
            const int nrep = ((kind == K_I3) ? 2 : 1) * REP_GEMM;
#pragma unroll 1
            for (int rp = 0; rp < nrep; ++rp) {
                if (kind == K_I3 && rp >= REP_GEMM) { A = (const bf16_t*)(ws + A_KEYSC); Bt = (const bf16_t*)(ws + W_UKV); O = (bf16_t*)(ws + A_KN); N = 1024; K = 256; Mr = KROWS; }
                run_gemm(wv, lds, A, Bt, Mr, N, K, pg8::EpiBf16{O, N, O});
            }
        }
        if (kind == K_I3) {
#pragma unroll 1
            for (int rp = 0; rp < REP_GEMM; ++rp)
            run_gemm(wv, lds, (const bf16_t*)(ws + W_UKV) + (size_t)1024 * 256, (const bf16_t*)(ws + A_KEYSC), 1024, KROWS, 256,
                     pg8::EpiVT{(bf16_t*)(ws + A_VT), (bf16_t*)(ws + A_VT) + (size_t)BS * 8 * 128 * LKS});
#pragma unroll 1
            for (int rp = 0; rp < REP_CONV; ++rp) conv_phase(wv, p, l, lds);
        }
        if (kind == K_I4) {
#pragma unroll 1
            for (int rp = 0; rp < REP_ATTN; ++rp) attn_phase(wv, p, lds);
#pragma unroll 1
            for (int rp = 0; rp < REP_ELT; ++rp) e3b_phase(wv, p, lds); }
        if (kind == K_G5) {
#pragma unroll 1
            for (int rp = 0; rp < REP_GEMM; ++rp)
            run_gemm(wv, lds, (const bf16_t*)(ws + A_YA), (const bf16_t*)(ws + W_BRA), 3 * MT, DM, 1024, pg8::EpiBf16{(bf16_t*)(ws + A_RAW), DM, (bf16_t*)(ws + A_RAW)}, false, MT / 256, E_WBR * 2);
            xcd_barrier(wv, bar, bst);
            merge_phase(wv, p);
        }
        if (kind == K_G6 || kind == K_G10) {
            const bool g6 = (kind == K_G6);
#pragma unroll 1
            for (int rp = 0; rp < REP_GEMM; ++rp)
            run_gemm(wv, lds, (const bf16_t*)(ws + (g6 ? A_MBF : A_ACT)), (const bf16_t*)(ws + (g6 ? W_O : W_DN)), MT, DM, g6 ? DM : DFF, pg8::EpiBf16{(bf16_t*)(ws + (g6 ? A_M32 : A_F32)), DM, (bf16_t*)(ws + (g6 ? A_M32 : A_F32)) + (size_t)MT * DM}, true);
        }
        if (kind == K_E2) {
#pragma unroll 1
            for (int rp = 0; rp < REP_ELT; ++rp) e2_phase(wv, p, l, lds); }
        if (kind == K_E9) {
#pragma unroll 1
            for (int rp = 0; rp < REP_ELT; ++rp) e9_phase(wv, p, l); }
        if (kind == K_ROW0 || kind == K_ROW1 || kind == K_ROW2) row_phase(wv, p, l, kind == K_ROW0 ? 0 : (kind == K_ROW1 ? 1 : 2));
        if (kind == K_COMB) comb_phase(wv, p);
        if (kind == K_PRO) {
            if (obid() == 0) {
                pg8::StaticOrder S; S.init(MT, DM, (int)gridDim.x, 0, true);
                const int t0 = otid(wv);
                if (t0 < S.nwg - S.nfull) { pg8::Unit uu; S.tile_of(S.nfull + t0, uu); atomicOr((unsigned*)(p.ws + S_TAIL) + uu.pm, 1u << uu.pn); }
            }
            ada_phase(wv, p, lds); rope_table_phase(wv, p); }
        if (kind == K_PRO || (kind == K_ROW2 && l + 1 < NLAYER)) { const int ln = (kind == K_PRO) ? 0 : l + 1;
#pragma unroll 1
            for (int rp = 0; rp < REP_CVT; ++rp) { filter_phase(wv, p, ln, lds); convert_layer(wv, p, ln, lds); } }
        if (p.ws == nullptr) grid.sync();
        xcd_barrier(wv, bar, bst);
    }
}

extern "C" void kernel_launch(void* const* d_in, const int* in_sizes, int n_in, void* d_out, int out_size, void* d_ws, size_t ws_size, hipStream_t stream) {
    static int grid_blocks = 0;
    if (grid_blocks == 0) {
        if (n_in != N_INPUTS || ws_size < WS_NEED) { fprintf(stderr, "kernel_launch: need %d inputs and %zu bytes of workspace; got %d, %zu\n", N_INPUTS, (size_t)WS_NEED, n_in, ws_size); grid_blocks = -1; return; }
        int dev = 0, cus = 0, per_cu = 0;
        hipGetDevice(&dev);
        hipDeviceGetAttribute(&cus, hipDeviceAttributeMultiprocessorCount, dev);
        if (hipFuncSetAttribute((const void*)fwd_megakernel, hipFuncAttributeMaxDynamicSharedMemorySize, LDS_BYTES) != hipSuccess) { fprintf(stderr, "kernel_launch: hipFuncSetAttribute failed\n"); grid_blocks = -1; return; }
        if (hipOccupancyMaxActiveBlocksPerMultiprocessor(&per_cu, (const void*)fwd_megakernel, NTHREADS, LDS_BYTES) != hipSuccess || per_cu < 1) { fprintf(stderr, "kernel_launch: occupancy query gave %d\n", per_cu); per_cu = 1; }
        (void)hipGetLastError();
        grid_blocks = cus * 1;
    }
    if (grid_blocks < 0) return;
        (void)hipMemsetAsync((unsigned char*)d_ws + S_BAR, 0, 16384, stream);
    (void)hipMemsetAsync((unsigned char*)d_ws + S_TAIL, 0, 512, stream);
    Params p{};
    for (int i = 0; i < N_INPUTS; ++i) p.in[i] = (const float*)d_in[i];
    p.out = (float*)d_out; p.ws = (unsigned char*)d_ws;
    void* args[] = {&p};
    hipError_t e = hipLaunchCooperativeKernel((const void*)fwd_megakernel, dim3(grid_blocks), dim3(NTHREADS), args, LDS_BYTES, stream);
    if (e != hipSuccess) fprintf(stderr, "cooperative launch failed: %s (grid %d)\n", hipGetErrorString(e), grid_blocks);
}
```

```cpp
#include <hip/hip_runtime.h>
#include <hip/hip_cooperative_groups.h>
#include <cstdio>
namespace cg = cooperative_groups;

#define LAS __attribute__((address_space(3)))
typedef unsigned short bf16_t;
typedef short bf16x8 __attribute__((ext_vector_type(8)));
typedef float f32x4 __attribute__((ext_vector_type(4)));
typedef float f32x16 __attribute__((ext_vector_type(16)));
typedef unsigned u32x4 __attribute__((ext_vector_type(4)));
typedef unsigned u32x2 __attribute__((ext_vector_type(2)));
typedef float f32x2 __attribute__((ext_vector_type(2)));

constexpr int DM = 2048, MP = 4096, MS = 16384, MT = 20480, NLAYER = 2;
constexpr int LP = 256, LS = 2048, BP = 16, BS = 8, PAST = 512, LKS = 2560;
constexpr int NIN = 13120, NGATE0 = 6976, PA_LD = 7168, GATE_LD = 6144;
constexpr int DFF = 5632, UU_LD = 11264;
constexpr int KROWS = 24576;
constexpr int NTHREADS = 512;
constexpr int LDS_BYTES = 131072 + 16;

enum { I_XP = 0, I_XS, I_C, I_CCKV, I_CKPE, I_CCTX, I_ADAW, I_ADAB, I_NMPRE, I_NMPOST, I_NFPRE, I_NFPOST, I_WIN, I_HCW, I_HCB,
       I_FW1, I_FB1, I_FW2, I_FB2, I_FW3, I_FB3, I_FFREQ, I_HBIAS, I_QN, I_KVN, I_WUQ, I_WUKV, I_SCW, I_WBRA, I_WBRB, I_WBRC,
       I_WO, I_FUP, I_FCW, I_FCB, I_FDN, N_INPUTS };

constexpr size_t E_WIN = (size_t)13312 * 2048, E_WUQ = (size_t)1536 * 512, E_WUKV = (size_t)2048 * 256, E_WBR = (size_t)2048 * 1024,
                 E_WO = (size_t)2048 * 2048, E_WUP = (size_t)11264 * 2048, E_WDN = (size_t)2048 * 5632;
constexpr size_t W_IN = 0, W_UQ = W_IN + E_WIN * 2, W_UKV = W_UQ + E_WUQ * 2, W_BRA = W_UKV + E_WUKV * 2, W_BRB = W_BRA + E_WBR * 2,
                 W_BRC = W_BRB + E_WBR * 2, W_O = W_BRC + E_WBR * 2, W_UP = W_O + E_WO * 2, W_DN = W_UP + E_WUP * 2, W_END = W_DN + E_WDN * 2;
constexpr size_t S_MOD = W_END, SZ_MOD = (size_t)NLAYER * 16 * 9 * 12288 * 4;
constexpr size_t S_KTS = S_MOD + SZ_MOD, S_KTP = S_KTS + (size_t)1024 * 4096 * 4, S_PARTS = S_KTP + (size_t)1024 * 512 * 4,
                 S_PARTP = S_PARTS + (size_t)64 * 2048 * 4, S_ROPE = S_PARTP + (size_t)8 * 2048 * 4, S_BAR = S_ROPE + (size_t)2 * 2048 * 32 * 4, S_COMB = S_BAR + 16384, S_SCALE = S_COMB + (size_t)NLAYER * 3 * 9 * 3 * 2048 * 4, S_TAIL = S_SCALE + 8192, S_END = S_TAIL + 512;
constexpr size_t AR = S_END;
constexpr size_t SZ_H = (size_t)MT * 2048 * 2;
constexpr size_t A_H = AR, A_UU = AR + SZ_H, A_ACT = A_UU + (size_t)MT * UU_LD * 2, AR_END = A_ACT + (size_t)MT * DFF * 2;
constexpr size_t A_PROJA = A_UU;
constexpr size_t A_Q = A_UU, A_KN = A_Q + (size_t)MT * 1536 * 2, A_VT = A_KN + (size_t)KROWS * 1024 * 2, A_YCT = A_VT + (size_t)KROWS * 1024 * 2;
constexpr size_t A_GATES = A_UU, A_M32 = A_GATES + (size_t)MT * GATE_LD * 2, A_MBF = A_H, A_F32 = A_UU;
constexpr size_t A_S = A_M32 + (size_t)MT * 2048 * 4;
constexpr size_t A_ZZT = A_S, A_X0S = A_ZZT + (size_t)MT * 1024 * 2, A_CQN = A_X0S + (size_t)MT * 1024 * 2, A_KEYSC = A_CQN + (size_t)MT * 512 * 2,
                 A_KPER = A_KEYSC + (size_t)KROWS * 256 * 2, A_YA = A_KPER + (size_t)KROWS * 64 * 2, A_OATT = A_YA + (size_t)MT * 1024 * 2,
                 A_YC = A_OATT + (size_t)MT * 1024 * 2, A_SEND = A_YC + (size_t)MT * 1024 * 2;
constexpr size_t A_RAW = A_M32;
static_assert(A_RAW + (size_t)3 * MT * 2048 * 2 <= A_CQN, "raw branch buffer overlaps live data");
static_assert(A_SEND <= AR_END, "arena overflow");
static_assert(A_YCT + (size_t)MT * 1024 * 2 <= A_M32, "arena overlap");
constexpr size_t WS_NEED = AR_END;
static_assert(WS_NEED <= 967590400ull, "workspace too large");

struct Params {
    const float* in[N_INPUTS];
    float* out;
    unsigned char* ws;
};

__device__ __forceinline__ unsigned cvt_pk_bf16(float lo, float hi) { unsigned r; asm volatile("v_cvt_pk_bf16_f32 %0, %1, %2" : "=v"(r) : "v"(lo), "v"(hi)); return r; }
__device__ __forceinline__ bf16_t f2bf(float f) { return (bf16_t)(cvt_pk_bf16(f, 0.f) & 0xffffu); }
__device__ __forceinline__ float bf_lo(unsigned w) { return __uint_as_float(w << 16); }
__device__ __forceinline__ float bf_hi(unsigned w) { return __uint_as_float(w & 0xffff0000u); }
__device__ __forceinline__ void unpack8(const u32x4 v, float* f) { f[0] = bf_lo(v.x); f[1] = bf_hi(v.x); f[2] = bf_lo(v.y); f[3] = bf_hi(v.y); f[4] = bf_lo(v.z); f[5] = bf_hi(v.z); f[6] = bf_lo(v.w); f[7] = bf_hi(v.w); }
__device__ __forceinline__ u32x4 pack8(const float* f) { u32x4 r; r.x = cvt_pk_bf16(f[0], f[1]); r.y = cvt_pk_bf16(f[2], f[3]); r.z = cvt_pk_bf16(f[4], f[5]); r.w = cvt_pk_bf16(f[6], f[7]); return r; }
__device__ __forceinline__ float shx(float v, int mask, int lane) { return __int_as_float(__builtin_amdgcn_ds_bpermute((lane ^ mask) << 2, __float_as_int(v))); }
__device__ __forceinline__ float wave_sum(float v, int lane) {
#pragma unroll
    for (int o = 32; o >= 1; o >>= 1) v += shx(v, o, lane);
    return v;
}
__device__ __forceinline__ int otid(int wv) { int t; asm volatile("v_mbcnt_lo_u32_b32 %0, -1, 0\n\tv_mbcnt_hi_u32_b32 %0, -1, %0" : "=v"(t)); return wv * 64 + t; }
__device__ __forceinline__ int obid() { int t = blockIdx.x; asm volatile("" : "+s"(t)); return t; }
__device__ __forceinline__ float sigmoidf_(float x) { return 1.0f / (1.0f + __expf(-x)); }
__device__ __forceinline__ float siluf_(float x) { return x / (1.0f + __expf(-x)); }

namespace pg8 {
constexpr int BM = 256, BK = 64, HALF = 128, HTB = HALF * BK * 2, STAGE_BYTES = 8 * HTB, NXCD = 8, WGM = 8;
__host__ __device__ __forceinline__ int lds_byte(int r, int c) { const int st = (r >> 4) * 2 + (c >> 5), rr = r & 15, cc = c & 31, ob = rr * 64 + cc * 2; return st * 1024 + (ob ^ (((ob >> 9) & 1) << 5)); }
__host__ __device__ __forceinline__ void stage_rc(int b, int& R, int& C) { const int st = b / 1024, sb = b % 1024, swz = sb ^ (((sb >> 9) & 1) << 5); R = (st >> 1) * 16 + swz / 64; C = (st & 1) * 32 + (swz % 64) / 2; }
__host__ __device__ __forceinline__ int perm32(int rho) { const int n = rho >> 4, i = rho & 15; return 8 * (i >> 2) + 4 * n + (i & 3); }
struct Unit { int pm, pn, kh; };
struct Gemm { const bf16_t* A; const bf16_t* Bt; int M, N, K; int nMper; size_t bstride; };
struct StaticOrder {
    int nM, nN, nwg, G, c, nfull;
    __device__ void init(int M, int N, int G_, int c_, bool split = false) { nM = M / BM; nN = N / BM; nwg = nM * nN; G = G_; c = c_;
        nfull = nwg; if (split) { const int rem = nwg % G; if (rem > 0 && 2 * rem <= G) nfull = nwg - rem; } }
    __device__ void tile_of(int wgid, Unit& u) const {
        { const int q = nwg / NXCD, r = nwg % NXCD, xcd = wgid % NXCD, off = wgid / NXCD; wgid = (xcd < r ? xcd * (q + 1) : r * (q + 1) + (xcd - r) * q) + off; }
        const int nig = WGM * nN, gid = wgid / nig, fm = gid * WGM, gsz = (nM - fm) < WGM ? (nM - fm) : WGM;
        u.pm = fm + ((wgid % nig) % gsz); u.pn = (wgid % nig) / gsz;
    }
    __device__ bool next(int i, Unit& u) const {
        const long L = (long)i * G + c;
        int tile = (int)L, kh = -1; bool ok = L < nwg;
        if (L >= nfull) { const long h = L - nfull; ok = h < 2 * (long)(nwg - nfull); tile = nfull + (int)(h >> 1); kh = (int)(h & 1); }
        if (!ok) return false;
        int pm, pn;
        { int wgid = tile; const int q = nwg / NXCD, r = nwg % NXCD, xcd = wgid % NXCD, off = wgid / NXCD; wgid = (xcd < r ? xcd * (q + 1) : r * (q + 1) + (xcd - r) * q) + off;
          const int nig = WGM * nN, gid = wgid / nig, fm = gid * WGM, gsz = (nM - fm) < WGM ? (nM - fm) : WGM;
          pm = fm + ((wgid % nig) % gsz); pn = (wgid % nig) / gsz; }
        u.pm = pm; u.pn = pn; u.kh = kh; return true;
    }
};
template <class Epi>
__device__ __forceinline__ void gemm_phase(int wv, LAS unsigned char* lds, const Gemm g, const StaticOrder& S, const Epi& E) {
    const int tid = otid(wv), wid = __builtin_amdgcn_readfirstlane(tid >> 6), lane = tid & 63, wr = wid >> 2, wc = wid & 3, fr = lane & 15, fq = lane >> 4;
    const int K = g.K, nt = K / BK;
    unsigned voffA[2], voffB[2];
#pragma unroll
    for (int i = 0; i < 2; ++i) { int R, C; stage_rc(tid * 16 + i * 8192, R, C); const int Rb = (R & ~31) + perm32(R & 31); voffA[i] = (unsigned)(R * K + C) * 2u; voffB[i] = (unsigned)(Rb * K + C) * 2u; }
    const size_t kstep = (size_t)(BK * 2);
    const size_t hstep = (size_t)HALF * K * 2;
    const size_t tstep = 2 * hstep;
    const unsigned ldsw = (unsigned)wid * 1024u;
    const int aoff = lds_byte(wr * 64 + fr, fq * 8), boff = lds_byte(wc * 32 + fr, fq * 8);
#define PG8_SA(b, h) (((b) * 2 + (h)) * HTB)
#define PG8_SB(b, h) ((4 + (b) * 2 + (h)) * HTB)
#define PG8_STAGE(bufoff, gbase, voff) do { _Pragma("unroll") for (int _i = 0; _i < 2; ++_i) \
        __builtin_amdgcn_global_load_lds((const unsigned*)((const char*)(gbase) + (voff)[_i]), (LAS unsigned*)(lds + (bufoff) + ldsw + _i * 8192), 16, 0, 0); } while (0)
#define PG8_LDA(dst, b, h) do { _Pragma("unroll") for (int m = 0; m < 4; ++m) _Pragma("unroll") for (int k = 0; k < 2; ++k) dst[m][k] = *(const LAS bf16x8*)(lds + PG8_SA(b, h) + aoff + m * 2048 + k * 1024); } while (0)
#define PG8_LDB(dst, b, h) do { _Pragma("unroll") for (int n = 0; n < 2; ++n) _Pragma("unroll") for (int k = 0; k < 2; ++k) dst[n][k] = *(const LAS bf16x8*)(lds + PG8_SB(b, h) + boff + n * 2048 + k * 1024); } while (0)
#define PG8_MMA(ai, bj, At, Bt) do { __builtin_amdgcn_s_setprio(1); _Pragma("unroll") for (int m = 0; m < 4; ++m) _Pragma("unroll") for (int n = 0; n < 2; ++n) _Pragma("unroll") for (int k = 0; k < 2; ++k) \
        acc[ai][bj][m][n] = __builtin_amdgcn_mfma_f32_16x16x32_bf16(Bt[n][k], At[m][k], acc[ai][bj][m][n], 0, 0, 0); __builtin_amdgcn_s_setprio(0); } while (0)
#define PG8_WAIT_V(n) asm volatile("s_waitcnt vmcnt(" #n ")" ::: "memory")
#define PG8_WAIT_L(n) asm volatile("s_waitcnt lgkmcnt(" #n ")" ::: "memory")
#define PG8_BAR __builtin_amdgcn_s_barrier()
#define PG8_SCHED __builtin_amdgcn_sched_barrier(0)
    Unit cur, nxt; int ui = 0;
    if (!S.next(0, cur)) return;
    f32x4 acc[2][2][4][2];
#pragma unroll
    for (int a = 0; a < 2; ++a)
#pragma unroll
        for (int b = 0; b < 2; ++b)
#pragma unroll
            for (int m = 0; m < 4; ++m)
#pragma unroll
                for (int n = 0; n < 2; ++n) acc[a][b][m][n] = (f32x4){0.f, 0.f, 0.f, 0.f};
    bf16x8 At[4][2], B0[2][2], B1[2][2];
    const size_t khoff = (size_t)(nt / 2) * kstep;
    const char* cA = (const char*)g.A + (size_t)cur.pm * tstep + (cur.kh == 1 ? khoff : 0); const char* cB = (const char*)g.Bt + (size_t)(cur.pm / g.nMper) * g.bstride + (size_t)cur.pn * tstep + (cur.kh == 1 ? khoff : 0);
    PG8_STAGE(PG8_SB(0, 0), cB, voffB); PG8_STAGE(PG8_SA(0, 0), cA, voffA); PG8_STAGE(PG8_SB(0, 1), cB + hstep, voffB); PG8_STAGE(PG8_SA(0, 1), cA + hstep, voffA);
    if (wr == 1) PG8_BAR;
    PG8_WAIT_V(4); PG8_BAR;
    PG8_STAGE(PG8_SB(1, 0), cB + kstep, voffB); PG8_STAGE(PG8_SA(1, 0), cA + kstep, voffA); PG8_STAGE(PG8_SB(1, 1), cB + hstep + kstep, voffB);
    PG8_WAIT_V(6); PG8_BAR;
    for (;;) {
        const bool has_next = S.next(ui + 1, nxt);
        const char* nA = has_next ? (const char*)g.A + (size_t)nxt.pm * tstep + (nxt.kh == 1 ? khoff : 0) : cA; const char* nB = has_next ? (const char*)g.Bt + (size_t)(nxt.pm / g.nMper) * g.bstride + (size_t)nxt.pn * tstep + (nxt.kh == 1 ? khoff : 0) : cB;
        const int ntu = (cur.kh < 0) ? nt : (nt >> 1);
        for (int t = 0; t < ntu; t += 2) {
            const bool last = (t == ntu - 2);
            const char* a1 = cA + (size_t)(t + 1) * kstep;
            const char* a2 = last ? nA : cA + (size_t)(t + 2) * kstep; const char* b2 = last ? nB : cB + (size_t)(t + 2) * kstep;
            const char* a3 = a2 + kstep; const char* b3 = b2 + kstep;
            PG8_LDB(B0, 0, 0); PG8_SCHED; PG8_LDA(At, 0, 0); PG8_STAGE(PG8_SA(1, 1), a1 + hstep, voffA);
            PG8_WAIT_L(8); PG8_BAR; PG8_WAIT_L(0); PG8_MMA(0, 0, At, B0); PG8_BAR; PG8_SCHED;
            PG8_LDB(B1, 0, 1); PG8_STAGE(PG8_SB(0, 0), b2, voffB);
            PG8_BAR; PG8_WAIT_L(0); PG8_MMA(0, 1, At, B1); PG8_BAR;
            PG8_LDA(At, 0, 1); PG8_STAGE(PG8_SA(0, 0), a2, voffA);
            PG8_BAR; PG8_WAIT_L(0); PG8_MMA(1, 0, At, B0); PG8_BAR; PG8_SCHED;
            PG8_STAGE(PG8_SB(0, 1), b2 + hstep, voffB);
            PG8_WAIT_V(6); PG8_BAR; PG8_MMA(1, 1, At, B1); PG8_BAR;
            PG8_LDB(B0, 1, 0); PG8_SCHED; PG8_LDA(At, 1, 0); PG8_STAGE(PG8_SA(0, 1), a2 + hstep, voffA);
            PG8_WAIT_L(8); PG8_BAR; PG8_WAIT_L(0); PG8_MMA(0, 0, At, B0); PG8_BAR; PG8_SCHED;
            PG8_LDB(B1, 1, 1); PG8_STAGE(PG8_SB(1, 0), b3, voffB);
            PG8_BAR; PG8_WAIT_L(0); PG8_MMA(0, 1, At, B1); PG8_BAR;
            PG8_LDA(At, 1, 1); PG8_STAGE(PG8_SA(1, 0), a3, voffA);
            PG8_BAR; PG8_WAIT_L(0); PG8_MMA(1, 0, At, B0); PG8_BAR; PG8_SCHED;
            PG8_STAGE(PG8_SB(1, 1), b3 + hstep, voffB);
            PG8_WAIT_V(6); PG8_BAR; PG8_MMA(1, 1, At, B1); PG8_BAR;
        }
        { const int t2 = otid(wv); const int l2 = t2 & 63, w2 = __builtin_amdgcn_readfirstlane(t2 >> 6); E(acc, cur, w2 >> 2, w2 & 3, l2 & 15, l2 >> 4); }
        if (!has_next) break;
#pragma unroll
        for (int a = 0; a < 2; ++a)
#pragma unroll
            for (int b = 0; b < 2; ++b)
#pragma unroll
                for (int m = 0; m < 4; ++m)
#pragma unroll
                    for (int n = 0; n < 2; ++n) acc[a][b][m][n] = (f32x4){0.f, 0.f, 0.f, 0.f};
        cur = nxt; cA = nA; cB = nB; ++ui;
    }
    PG8_WAIT_V(0);
    if (wr == 0) PG8_BAR;
    PG8_BAR;
#undef PG8_SA
#undef PG8_SB
#undef PG8_STAGE
#undef PG8_LDA
#undef PG8_LDB
#undef PG8_MMA
#undef PG8_WAIT_V
#undef PG8_WAIT_L
#undef PG8_BAR
#undef PG8_SCHED
}

struct EpiBf16 {
    bf16_t* O; int ldc; bf16_t* O2;
    __device__ __forceinline__ void operator()(const f32x4 (&acc)[2][2][4][2], const Unit& u, int wr, int wc, int fr, int fq) const {
        const int row0 = u.pm * BM + wr * 64 + fr, col0 = u.pn * BM + wc * 32 + 8 * fq;
        bf16_t* Ob = (u.kh == 1) ? O2 : O;
#pragma unroll
        for (int ai = 0; ai < 2; ++ai)
#pragma unroll
            for (int m = 0; m < 4; ++m) { bf16_t* rowp = Ob + (size_t)(row0 + ai * HALF + m * 16) * ldc + col0;
#pragma unroll
                for (int bj = 0; bj < 2; ++bj) { const f32x4 v0 = acc[ai][bj][m][0], v1 = acc[ai][bj][m][1];
                    u32x4 w; w.x = cvt_pk_bf16(v0[0], v0[1]); w.y = cvt_pk_bf16(v0[2], v0[3]); w.z = cvt_pk_bf16(v1[0], v1[1]); w.w = cvt_pk_bf16(v1[2], v1[3]);
                    *(u32x4*)(rowp + bj * HALF) = w; } }
    }
};
struct EpiF32 {
    float* C; int ldc;
    __device__ __forceinline__ void operator()(const f32x4 (&acc)[2][2][4][2], const Unit& u, int wr, int wc, int fr, int fq) const {
        const int row0 = u.pm * BM + wr * 64 + fr, col0 = u.pn * BM + wc * 32 + 4 * fq;
#pragma unroll
        for (int ai = 0; ai < 2; ++ai)
#pragma unroll
            for (int m = 0; m < 4; ++m) { float* rowp = C + (size_t)(row0 + ai * HALF + m * 16) * ldc + col0;
#pragma unroll
                for (int bj = 0; bj < 2; ++bj)
#pragma unroll
                    for (int n = 0; n < 2; ++n) *(f32x4*)(rowp + bj * HALF + n * 16) = acc[ai][bj][m][n]; }
    }
};
struct EpiVT {
    bf16_t* VTs; bf16_t* VTp;
    __device__ __forceinline__ void operator()(const f32x4 (&acc)[2][2][4][2], const Unit& u, int wr, int wc, int fr, int fq) const {
        const int KR0 = u.pn * BM;
        bf16_t* vt; int Lk;
        if (KR0 < BS * LKS) { const int b = KR0 / LKS; Lk = LKS; vt = VTs + (size_t)b * 1024 * LKS + (KR0 - b * LKS); }
        else { const int b = (KR0 - BS * LKS) >> 8; Lk = LP; vt = VTp + (size_t)b * 1024 * LP; }
        const int row0 = u.pm * BM + wr * 64 + fr, col0 = wc * 32 + 8 * fq;
#pragma unroll
        for (int ai = 0; ai < 2; ++ai)
#pragma unroll
            for (int m = 0; m < 4; ++m) { bf16_t* rowp = vt + (size_t)(row0 + ai * HALF + m * 16) * Lk + col0;
#pragma unroll
                for (int bj = 0; bj < 2; ++bj) { const f32x4 v0 = acc[ai][bj][m][0], v1 = acc[ai][bj][m][1];
                    u32x4 w; w.x = cvt_pk_bf16(v0[0], v0[1]); w.y = cvt_pk_bf16(v0[2], v0[3]); w.z = cvt_pk_bf16(v1[0], v1[1]); w.w = cvt_pk_bf16(v1[2], v1[3]);
                    *(u32x4*)(rowp + bj * HALF) = w; } }
    }
};
template <int P> struct EpiGate {
    const bf16_t* gates; float* m32; bf16_t* mbf;
    __device__ __forceinline__ void operator()(const f32x4 (&acc)[2][2][4][2], const Unit& u, int wr, int wc, int fr, int fq) const {
        const int row0 = u.pm * BM + wr * 64 + fr, col0 = u.pn * BM + wc * 32 + 4 * fq;
#pragma unroll
        for (int ai = 0; ai < 2; ++ai)
#pragma unroll
            for (int m = 0; m < 4; ++m) {
                const size_t row = (size_t)(row0 + ai * HALF + m * 16);
#pragma unroll
                for (int bj = 0; bj < 2; ++bj)
#pragma unroll
                    for (int n = 0; n < 2; ++n) {
                        const int col = col0 + bj * HALF + n * 16;
                        const u32x2 gw = *(const u32x2*)(gates + row * GATE_LD + P * 2048 + col);
                        f32x4 v = acc[ai][bj][m][n];
                        v[0] *= sigmoidf_(bf_lo(gw.x)); v[1] *= sigmoidf_(bf_hi(gw.x)); v[2] *= sigmoidf_(bf_lo(gw.y)); v[3] *= sigmoidf_(bf_hi(gw.y));
                        float* mp = m32 + row * 2048 + col;
                        if (P == 0) { *(f32x4*)mp = v; }
                        else if (P == 1) { const f32x4 o = *(const f32x4*)mp; *(f32x4*)mp = o + v; }
                        else { const f32x4 o = *(const f32x4*)mp; v = v + o; u32x2 w; w.x = cvt_pk_bf16(v[0], v[1]); w.y = cvt_pk_bf16(v[2], v[3]); *(u32x2*)(mbf + row * 2048 + col) = w; }
                    }
            }
    }
};
}

template <class Epi>
__device__ __forceinline__ void run_gemm(int wv, LAS unsigned char* lds, const bf16_t* A, const bf16_t* Bt, int M, int N, int K, const Epi& E, bool split = false, int nMper = 1 << 28, size_t bstride = 0) {
    pg8::Gemm g; g.A = A; g.Bt = Bt; g.M = M; g.N = N; g.K = K; g.nMper = nMper; g.bstride = bstride;
    pg8::StaticOrder S; S.init(M, N, (int)gridDim.x, obid(), split);
    pg8::gemm_phase<Epi>(wv, lds, g, S, E);
    __syncthreads();
}

__device__ __forceinline__ void convT(int wv, const float* __restrict__ src, int K, int N, bf16_t* __restrict__ dst, int gate_shift, LAS unsigned char* lds) {
    const int tid = otid(wv), lane = tid & 63, kq = lane & 7, ng = lane >> 3;
    const int tn = N / 32, tk = K / 64, ntile = tn * tk, nwaves = gridDim.x * 8;
    for (int tile = obid() * 8 + (tid >> 6); tile < ntile; tile += 2 * nwaves) {
        const int tile2 = tile + nwaves; const bool has2 = tile2 < ntile;
        const int tkk = tile / tn, tnn = tile - tkk * tn, k0 = tkk * 64 + 8 * kq, n0 = tnn * 32 + 4 * ng;
        const int tkk2 = has2 ? tile2 / tn : tkk, tnn2 = has2 ? tile2 - tkk2 * tn : tnn, k02 = tkk2 * 64 + 8 * kq, n02 = tnn2 * 32 + 4 * ng;
        f32x4 v[8], v2[8];
#pragma unroll
        for (int i = 0; i < 8; ++i) v[i] = *(const f32x4*)(src + (size_t)(k0 + i) * N + n0);
#pragma unroll
        for (int i = 0; i < 8; ++i) v2[i] = *(const f32x4*)(src + (size_t)(k02 + i) * N + n02);
#pragma unroll
        for (int j = 0; j < 4; ++j) {
            int nd = n0 + j; if (gate_shift == 1 && nd >= NGATE0) nd += 192; if (gate_shift == 2) { const int hd = nd >> 8, wi = nd & 255; nd = (wi < 128) ? hd * 128 + wi : 1024 + hd * 128 + (wi - 128); }
            u32x4 w; w.x = cvt_pk_bf16(v[0][j], v[1][j]); w.y = cvt_pk_bf16(v[2][j], v[3][j]); w.z = cvt_pk_bf16(v[4][j], v[5][j]); w.w = cvt_pk_bf16(v[6][j], v[7][j]);
            *(u32x4*)(dst + (size_t)nd * K + k0) = w;
        }
        if (has2) {
#pragma unroll
            for (int j = 0; j < 4; ++j) {
                int nd = n02 + j; if (gate_shift == 1 && nd >= NGATE0) nd += 192; if (gate_shift == 2) { const int hd = nd >> 8, wi = nd & 255; nd = (wi < 128) ? hd * 128 + wi : 1024 + hd * 128 + (wi - 128); }
                u32x4 w; w.x = cvt_pk_bf16(v2[0][j], v2[1][j]); w.y = cvt_pk_bf16(v2[2][j], v2[3][j]); w.z = cvt_pk_bf16(v2[4][j], v2[5][j]); w.w = cvt_pk_bf16(v2[6][j], v2[7][j]);
                *(u32x4*)(dst + (size_t)nd * K + k02) = w;
            }
        }
    }
}

__device__ __forceinline__ void ada_phase(int wv, const Params& p, LAS unsigned char* lds) {
    LAS float* sl = (LAS float*)lds;
    float* mod = (float*)(p.ws + S_MOD);
    const int tid = otid(wv);
    for (int u = obid(); u < NLAYER * 6 * 16; u += gridDim.x) {
        const int l = u / 96, r = u % 96, cb = r % 6, kc = r / 6, k0 = kc * 128;
        for (int i = tid; i < 9 * 128; i += NTHREADS) { const int v = i >> 7, k = i & 127; const float x = (v == 0) ? p.in[I_CCTX][k0 + k] : p.in[I_C][(v - 1) * DM + k0 + k]; sl[i] = siluf_(x); }
        __syncthreads();
        const int col = cb * 2048 + tid * 4;
        f32x4 acc[9];
#pragma unroll
        for (int i = 0; i < 9; ++i) acc[i] = (f32x4){0.f, 0.f, 0.f, 0.f};
        const float* wp = p.in[I_ADAW] + ((size_t)l * DM + k0) * 12288 + col;
#pragma unroll 8
        for (int k = 0; k < 128; ++k) {
            const f32x4 w = *(const f32x4*)(wp + (size_t)k * 12288);
#pragma unroll
            for (int i = 0; i < 9; ++i) acc[i] += sl[i * 128 + k] * w;
        }
#pragma unroll
        for (int i = 0; i < 9; ++i) *(f32x4*)(mod + ((size_t)(l * 16 + kc) * 9 + i) * 12288 + col) = acc[i];
        __syncthreads();
    }
}

__device__ __forceinline__ void filter_phase(int wv, const Params& p, int l, LAS unsigned char* lds) {
    LAS float* z = (LAS float*)lds;
    LAS float* H1 = z + 32 * 33;
    LAS float* H2 = H1 + 32 * 64;
    LAS float* W1 = H2 + 32 * 64;
    LAS float* W2 = W1 + 33 * 64;
    LAS float* BF = W2 + 64 * 64;
    const int tid = otid(wv);
    const float* w3 = p.in[I_FW3] + (size_t)l * 64 * 2048; const float* b3 = p.in[I_FB3] + l * 2048;
    for (int u = obid(); u < 72; u += gridDim.x) {
        const int g = (u < 64) ? 1 : 0; const int tc = g ? u : u - 64; const int L = g ? LS : LP; const int t0 = tc * 32;
        float* kT = (float*)(p.ws + (g ? S_KTS : S_KTP)); float* part = (float*)(p.ws + (g ? S_PARTS : S_PARTP));
        for (int i = tid; i < 33 * 64; i += NTHREADS) W1[i] = p.in[I_FW1][(size_t)l * 33 * 64 + i];
        for (int i = tid; i < 64 * 64; i += NTHREADS) W2[i] = p.in[I_FW2][(size_t)l * 64 * 64 + i];
        if (tid < 64) BF[tid] = p.in[I_FB1][l * 64 + tid]; else if (tid < 128) BF[tid] = p.in[I_FB2][l * 64 + tid - 64]; else if (tid < 256) BF[tid] = p.in[I_FFREQ][l * 128 + tid - 128];
        for (int i = tid; i < 32 * 33; i += NTHREADS) {
            const int t = i / 33, e = i - t * 33; const float tf = (float)(t0 + t);
            float v;
            if (e == 0) v = tf / (float)(L - 1);
            else { const int k = (e - 1) & 15; const float band = 1e-4f + (float)k * ((15.0f - 1e-4f) / 15.0f); const float w = (6.283185307179586f * tf) / (float)L; const float ang = w * band;
                   v = (e <= 16) ? cosf(ang) : -sinf(ang); }
            z[i] = v;
        }
        __syncthreads();
#pragma unroll
        for (int q = 0; q < 4; ++q) { const int i = tid + q * NTHREADS; const int t = i >> 6, j = i & 63; float s = BF[j];
#pragma unroll
            for (int e = 0; e < 33; ++e) s += z[t * 33 + e] * W1[e * 64 + j];
            H1[i] = sinf(BF[128 + j] * s); }
        __syncthreads();
#pragma unroll
        for (int q = 0; q < 4; ++q) { const int i = tid + q * NTHREADS; const int t = i >> 6, j = i & 63; float s = BF[64 + j];
#pragma unroll 16
            for (int e = 0; e < 64; ++e) s += H1[t * 64 + e] * W2[e * 64 + j];
            H2[i] = sinf(BF[192 + j] * s); }
        __syncthreads();
        const int c = tid * 4;
        const f32x4 bias = *(const f32x4*)(b3 + c);
        f32x4 delta;
#pragma unroll
        for (int j = 0; j < 4; ++j) { const int d = (c + j) & 1023; const float mn = -3.0701134573253945f, mx = -15.350567286626973f; delta[j] = fabsf(mn + (float)d * ((mx - mn) / 1023.0f)); }
        f32x4 psum = (f32x4){0.f, 0.f, 0.f, 0.f};
        for (int tb = 0; tb < 2; ++tb) {
            f32x4 acc[16];
#pragma unroll
            for (int i = 0; i < 16; ++i) acc[i] = bias;
#pragma unroll 8
            for (int k = 0; k < 64; ++k) {
                const f32x4 w = *(const f32x4*)(w3 + (size_t)k * 2048 + c);
#pragma unroll
                for (int i = 0; i < 16; ++i) acc[i] += H2[(tb * 16 + i) * 64 + k] * w;
            }
#pragma unroll
            for (int i = 0; i < 16; ++i) {
                const int t = t0 + tb * 16 + i; const float tn = (float)t / (float)(L - 1);
#pragma unroll
                for (int j = 0; j < 4; ++j) {
                    const float v = acc[i][j] * __expf(-tn * delta[j]);
                    const int cc = c + j;
                    if (cc < 1024) { kT[(size_t)cc * (2 * L) + t] = v; psum[j] += fabsf(v); }
                    else { const int d = cc - 1024; if (t == 0) kT[(size_t)d * (2 * L) + L] = 0.f; else { kT[(size_t)d * (2 * L) + 2 * L - t] = v; psum[j] += fabsf(v); } }
                }
            }
        }
        *(f32x4*)(part + (size_t)tc * 2048 + c) = psum;
        __syncthreads();
    }
}

__device__ __forceinline__ void row_sel(const Params& p, int l, int mode, int& l2, int& shi, int& sci, const float*& prew, bool& wh, int& gi, const float*& pw) {
    wh = true;
    if (mode == 0) { l2 = l; shi = 0; sci = 1; prew = p.in[I_NMPRE] + l * DM; }
    else if (mode == 1) { l2 = l; shi = 3; sci = 4; prew = p.in[I_NFPRE] + l * DM; }
    else { l2 = l + 1; shi = 0; sci = 1; wh = (l + 1 < NLAYER); if (!wh) l2 = l; prew = p.in[I_NMPRE] + l2 * DM; }
    gi = (mode == 1) ? 2 : 5;
    pw = p.in[mode == 1 ? I_NMPOST : I_NFPOST] + l * DM;
}
__device__ __forceinline__ void comb_phase(int wv, const Params& p) {
    const int tid = otid(wv);
    const float* mod = (const float*)(p.ws + S_MOD); float* comb = (float*)(p.ws + S_COMB);
    for (int idx = obid() * NTHREADS + tid; idx < NLAYER * 3 * 9 * 2048; idx += gridDim.x * NTHREADS) {
        const int c = idx & 2047, q = idx >> 11, mi = q % 9, q2 = q / 9, mode = q2 % 3, l = q2 / 3;
        int l2, shi, sci, gi; const float* prew; const float* pw; bool wh;
        row_sel(p, l, mode, l2, shi, sci, prew, wh, gi, pw);
        float g = 0.f, sc = 0.f, sh = 0.f;
        for (int kc = 0; kc < 16; ++kc) {
            g += mod[((size_t)(l * 16 + kc) * 9 + mi) * 12288 + gi * 2048 + c];
            sc += mod[((size_t)(l2 * 16 + kc) * 9 + mi) * 12288 + sci * 2048 + c];
            sh += mod[((size_t)(l2 * 16 + kc) * 9 + mi) * 12288 + shi * 2048 + c];
        }
        g += p.in[I_ADAB][(size_t)l * 12288 + gi * 2048 + c];
        sc += p.in[I_ADAB][(size_t)l2 * 12288 + sci * 2048 + c];
        sh += p.in[I_ADAB][(size_t)l2 * 12288 + shi * 2048 + c];
        float* o = comb + (size_t)q * 3 * 2048 + c;
        o[0] = g * pw[c]; o[2048] = prew[c] * (1.0f + sc); o[4096] = sh;
    }
}
__device__ __forceinline__ void row_phase(int wv, const Params& p, int l, int mode) {
    const int tid = otid(wv); const int wave = obid() * 8 + (tid >> 6), nw = gridDim.x * 8, lane = tid & 63;
    float* X = p.out;
    bf16_t* H = (bf16_t*)(p.ws + A_H);
    const bool wh = !(mode == 2 && l + 1 >= NLAYER);
    const int rows_per = (MT + nw - 1) / nw;
    for (int rr = 0; rr < rows_per; ++rr) {
        const int row = wave * rows_per + rr;
        if (row >= MT) break;
        const int mi = row < MP ? 0 : 1 + ((row - MP) >> 11);
        const float* cb = (const float*)(p.ws + S_COMB) + (size_t)((l * 3 + mode) * 9 + mi) * 3 * 2048 + lane * 4;
        f32x4 x[8];
        const float* xs = (mode == 0) ? (row < MP ? p.in[I_XP] + (size_t)row * DM : p.in[I_XS] + (size_t)(row - MP) * DM) : X + (size_t)row * DM;
#pragma unroll
        for (int i = 0; i < 8; ++i) x[i] = *(const f32x4*)(xs + i * 256 + lane * 4);
        if (mode != 0) {
            const bf16_t* o = (const bf16_t*)(p.ws + (mode == 1 ? A_M32 : A_F32)) + (size_t)row * DM;
            const unsigned tm = ((const unsigned*)(p.ws + S_TAIL))[row >> 8];
            f32x4 ovv[8]; float ss = 0.f;
#pragma unroll
            for (int i = 0; i < 8; ++i) { const u32x2 w = *(const u32x2*)(o + i * 256 + lane * 4); ovv[i] = (f32x4){bf_lo(w.x), bf_hi(w.x), bf_lo(w.y), bf_hi(w.y)};
                if ((tm >> i) & 1u) { const u32x2 w2 = *(const u32x2*)(o + (size_t)MT * DM + i * 256 + lane * 4); ovv[i] += (f32x4){bf_lo(w2.x), bf_hi(w2.x), bf_lo(w2.y), bf_hi(w2.y)}; }
                ss += ovv[i][0] * ovv[i][0] + ovv[i][1] * ovv[i][1] + ovv[i][2] * ovv[i][2] + ovv[i][3] * ovv[i][3]; }
            ss = wave_sum(ss, lane);
            const float rstd = rsqrtf(ss * (1.0f / DM) + 1e-6f);
#pragma unroll
            for (int i = 0; i < 8; ++i) x[i] += *(const f32x4*)(cb + i * 256) * (ovv[i] * rstd);
        }
#pragma unroll
        for (int i = 0; i < 8; ++i) *(f32x4*)(X + (size_t)row * DM + i * 256 + lane * 4) = x[i];
        if (wh) {
            float ss = 0.f;
#pragma unroll
            for (int i = 0; i < 8; ++i) ss += x[i][0] * x[i][0] + x[i][1] * x[i][1] + x[i][2] * x[i][2] + x[i][3] * x[i][3];
            ss = wave_sum(ss, lane);
            const float rstd = rsqrtf(ss * (1.0f / DM) + 1e-6f);
#pragma unroll
            for (int i = 0; i < 8; ++i) {
                const f32x4 hv = (x[i] * rstd) * *(const f32x4*)(cb + 2048 + i * 256) + *(const f32x4*)(cb + 4096 + i * 256);
                u32x2 o; o.x = cvt_pk_bf16(hv[0], hv[1]); o.y = cvt_pk_bf16(hv[2], hv[3]);
                *(u32x2*)(H + (size_t)row * DM + i * 256 + lane * 4) = o;
            }
        }
    }
}

__device__ __forceinline__ void rope_table_phase(int wv, const Params& p) {
    float* C = (float*)(p.ws + S_ROPE); float* Sn = C + 2048 * 32;
    const int tid = otid(wv);
    for (int idx = obid() * NTHREADS + tid; idx < 2048 * 32; idx += gridDim.x * NTHREADS) {
        const int t = idx >> 5, i = idx & 31, k = i & 15;
        const float inv = exp2f(-(float)k * 0.8304820237218406f);
        const float pos = (i < 16) ? (float)(t >> 6) : (float)(t & 63);
        const float ang = pos * inv; C[idx] = cosf(ang); Sn[idx] = sinf(ang);
    }
}
__device__ __forceinline__ void e2_phase(int wv, const Params& p, int l, LAS unsigned char* lds) {
    const bf16_t* PA = (const bf16_t*)(p.ws + A_PROJA);
    const int tid = otid(wv), lane = tid & 63;
    {
        const int gidx = obid() * NTHREADS + tid;
        if (gidx < 2048) {
            const int g = gidx >> 10, d = gidx & 1023; const int NU = g ? 64 : 8;
            const float* part = (const float*)(p.ws + (g ? S_PARTS : S_PARTP));
            float tot = 0.f;
            for (int i = 0; i < NU; ++i) tot += part[i * 2048 + d] + part[i * 2048 + 1024 + d];
            ((float*)(p.ws + S_SCALE))[gidx] = 1.0f / tot;
        }
    }
    {
        bf16_t* CQN = (bf16_t*)(p.ws + A_CQN); bf16_t* KC = (bf16_t*)(p.ws + A_KEYSC); bf16_t* KP = (bf16_t*)(p.ws + A_KPER);
        float* out_ckv = p.out + (size_t)MT * DM; float* out_kpe = out_ckv + (size_t)BP * NLAYER * LP * 256;
        const int wave = obid() * 8 + (tid >> 6), nw = gridDim.x * 8;
        for (int row = wave; row < MT + BS * PAST; row += nw) {
            if (row < MT) {
                const bf16_t* pr = PA + (size_t)row * PA_LD;
                { const u32x4 v = *(const u32x4*)(pr + 3072 + lane * 8); float f[8]; unpack8(v, f); float ss = 0.f;
#pragma unroll
                  for (int j = 0; j < 8; ++j) ss += f[j] * f[j];
                  ss = wave_sum(ss, lane); const float rstd = rsqrtf(ss * (1.0f / 512.0f) + 1e-6f);
                  const float* qn = p.in[I_QN] + l * 512 + lane * 8;
#pragma unroll
                  for (int j = 0; j < 8; ++j) f[j] = f[j] * rstd * qn[j];
                  *(u32x4*)(CQN + (size_t)row * 512 + lane * 8) = pack8(f); }
                int KR, t; const bool isp = row < MP; int b;
                if (isp) { b = row >> 8; t = row & 255; KR = BS * LKS + row; } else { const int r2 = row - MP; b = r2 >> 11; t = r2 & 2047; KR = b * LKS + t; }
                { const u32x2 v = *(const u32x2*)(pr + 3584 + lane * 4); float f[4] = {bf_lo(v.x), bf_hi(v.x), bf_lo(v.y), bf_hi(v.y)};
                  float ss = f[0] * f[0] + f[1] * f[1] + f[2] * f[2] + f[3] * f[3]; ss = wave_sum(ss, lane); const float rstd = rsqrtf(ss * (1.0f / 256.0f) + 1e-6f);
                  const float* kn = p.in[I_KVN] + l * 256 + lane * 4;
#pragma unroll
                  for (int j = 0; j < 4; ++j) f[j] = f[j] * rstd * kn[j];
                  if (isp) *(f32x4*)(out_ckv + ((size_t)(b * NLAYER + l) * LP + t) * 256 + lane * 4) = (f32x4){f[0], f[1], f[2], f[3]};
                  u32x2 w; w.x = cvt_pk_bf16(f[0], f[1]); w.y = cvt_pk_bf16(f[2], f[3]); *(u32x2*)(KC + (size_t)KR * 256 + lane * 4) = w; }
                { const float v = __uint_as_float(((unsigned)pr[3840 + lane]) << 16);
                  float o = v;
                  if (isp) out_kpe[((size_t)(b * NLAYER + l) * LP + t) * 64 + lane] = v;
                  else { const float pv = shx(v, 32, lane); const float* rc = (const float*)(p.ws + S_ROPE); const float cs = rc[t * 32 + (lane & 31)], sn = rc[2048 * 32 + t * 32 + (lane & 31)]; o = (lane < 32) ? (v * cs - pv * sn) : (pv * sn + v * cs); }
                  KP[(size_t)KR * 64 + lane] = f2bf(o); }
            } else {
                const int r2 = row - MT, b = r2 >> 9, j = r2 & 511; const int KR = b * LKS + LS + j;
                const float* cc = p.in[I_CCKV] + ((size_t)(b * NLAYER + l) * PAST + j) * 256 + lane * 4;
                const f32x4 v = *(const f32x4*)cc; u32x2 w; w.x = cvt_pk_bf16(v[0], v[1]); w.y = cvt_pk_bf16(v[2], v[3]); *(u32x2*)(KC + (size_t)KR * 256 + lane * 4) = w;
                KP[(size_t)KR * 64 + lane] = f2bf(p.in[I_CKPE][((size_t)(b * NLAYER + l) * PAST + j) * 64 + lane]);
            }
        }
    }
    {
        bf16_t* YC = (bf16_t*)(p.ws + A_YC); const float* scw = p.in[I_SCW] + (size_t)l * 3 * 1024;
        for (int it = obid() * NTHREADS + tid; it < (MT / 4) * 128; it += gridDim.x * NTHREADS) {
            const int ch = it >> 7, d0 = (it & 127) * 8, row0 = ch * 4;
            const int t0 = row0 < MP ? (row0 & 255) : ((row0 - MP) & 2047); const int L = row0 < MP ? LP : LS;
            float w0[8], w1[8], w2[8];
            { const f32x4 a = *(const f32x4*)(scw + d0), b = *(const f32x4*)(scw + d0 + 4), c = *(const f32x4*)(scw + 1024 + d0), d = *(const f32x4*)(scw + 1024 + d0 + 4),
                          e2 = *(const f32x4*)(scw + 2048 + d0), f = *(const f32x4*)(scw + 2048 + d0 + 4);
#pragma unroll
              for (int j = 0; j < 4; ++j) { w0[j] = a[j]; w0[4 + j] = b[j]; w1[j] = c[j]; w1[4 + j] = d[j]; w2[j] = e2[j]; w2[4 + j] = f[j]; } }
            const bf16_t* pr = PA + (size_t)row0 * PA_LD;
            float pp[8], pc[8], pn[8];
#pragma unroll
            for (int j = 0; j < 8; ++j) pp[j] = 0.f;
            if (t0 > 0) { float cg[8], uu[8]; unpack8(*(const u32x4*)(pr - PA_LD + 4928 + d0), cg); unpack8(*(const u32x4*)(pr - PA_LD + 5952 + d0), uu);
#pragma unroll
                for (int j = 0; j < 8; ++j) pp[j] = cg[j] * uu[j]; }
            { float cg[8], uu[8]; unpack8(*(const u32x4*)(pr + 4928 + d0), cg); unpack8(*(const u32x4*)(pr + 5952 + d0), uu);
#pragma unroll
              for (int j = 0; j < 8; ++j) pc[j] = cg[j] * uu[j]; }
#pragma unroll
            for (int i = 0; i < 4; ++i) {
#pragma unroll
                for (int j = 0; j < 8; ++j) pn[j] = 0.f;
                if (t0 + i + 1 < L) { float cg[8], uu[8]; unpack8(*(const u32x4*)(pr + (size_t)(i + 1) * PA_LD + 4928 + d0), cg); unpack8(*(const u32x4*)(pr + (size_t)(i + 1) * PA_LD + 5952 + d0), uu);
#pragma unroll
                    for (int j = 0; j < 8; ++j) pn[j] = cg[j] * uu[j]; }
                float bg[8], o[8]; unpack8(*(const u32x4*)(pr + (size_t)i * PA_LD + 3904 + d0), bg);
#pragma unroll
                for (int j = 0; j < 8; ++j) { o[j] = bg[j] * (w0[j] * pp[j] + w1[j] * pc[j] + w2[j] * pn[j]); pp[j] = pc[j]; pc[j] = pn[j]; }
                *(u32x4*)(YC + (size_t)(row0 + i) * 1024 + d0) = pack8(o);
            }
        }
    }
    {
        bf16_t* X0S = (bf16_t*)(p.ws + A_X0S); bf16_t* ZZT = (bf16_t*)(p.ws + A_ZZT);
        const float* hw = p.in[I_HCW] + (size_t)l * 3 * 3072; const float* hb = p.in[I_HCB] + (size_t)l * 3072;
        LAS bf16_t* zt = (LAS bf16_t*)lds;
        for (int u = obid(); u < (MT / 256) * 16; u += gridDim.x) {
            const int rt = u >> 4, dt = u & 15; const int row0 = rt * 256;
            const int dg = tid & 7, rb = tid >> 3, d0 = dt * 64 + dg * 8; const int rowb = row0 + rb * 4;
            const int L = row0 < MP ? LP : LS; const int tb = (row0 < MP ? (row0 & 255) : ((row0 - MP) & 2047)) + rb * 4;
            float wgt[3][3][8], bs[3][8];
#pragma unroll
            for (int g = 0; g < 3; ++g) {
#pragma unroll
                for (int o = 0; o < 3; ++o) { const f32x4 a = *(const f32x4*)(hw + o * 3072 + g * 1024 + d0), b = *(const f32x4*)(hw + o * 3072 + g * 1024 + d0 + 4);
#pragma unroll
                    for (int j = 0; j < 4; ++j) { wgt[g][o][j] = a[j]; wgt[g][o][4 + j] = b[j]; } }
                const f32x4 a = *(const f32x4*)(hb + g * 1024 + d0), b = *(const f32x4*)(hb + g * 1024 + d0 + 4);
#pragma unroll
                for (int j = 0; j < 4; ++j) { bs[g][j] = a[j]; bs[g][4 + j] = b[j]; }
            }
            const bf16_t* pr = PA + (size_t)rowb * PA_LD + d0;
            u32x4 wp[3], wc[3], wn[3];
#pragma unroll
            for (int g = 0; g < 3; ++g) { wp[g] = (u32x4){0u, 0u, 0u, 0u}; if (tb > 0) wp[g] = *(const u32x4*)(pr - PA_LD + g * 1024); wc[g] = *(const u32x4*)(pr + g * 1024); }
#pragma unroll
            for (int i = 0; i < 4; ++i) {
#pragma unroll
                for (int g = 0; g < 3; ++g) { wn[g] = (u32x4){0u, 0u, 0u, 0u}; if (tb + i + 1 < L) wn[g] = *(const u32x4*)(pr + (size_t)(i + 1) * PA_LD + g * 1024); }
                float hv[3][8];
#pragma unroll
                for (int g = 0; g < 3; ++g) { float a[8], b[8], c[8]; unpack8(wp[g], a); unpack8(wc[g], b); unpack8(wn[g], c);
#pragma unroll
                    for (int j = 0; j < 8; ++j) hv[g][j] = bs[g][j] + wgt[g][0][j] * a[j] + wgt[g][1][j] * b[j] + wgt[g][2][j] * c[j];
                    wp[g] = wc[g]; wc[g] = wn[g]; }
                *(u32x4*)(X0S + (size_t)(rowb + i) * 1024 + d0) = pack8(hv[0]);
#pragma unroll
                for (int j = 0; j < 8; ++j) zt[(dg * 8 + j) * 264 + rb * 4 + i] = f2bf(hv[1][j] * hv[2][j]);
            }
            __syncthreads();
#pragma unroll
            for (int i = 0; i < 4; ++i) {
                const int chunk = tid + i * NTHREADS; const int dl = chunk >> 5, tch = chunk & 31; const int d = dt * 64 + dl;
                size_t base; int t0;
                if (row0 < MP) { const int b = row0 >> 8; t0 = 0; base = ((size_t)b * 1024 + d) * LP; }
                else { const int r2 = row0 - MP; const int b = r2 >> 11; t0 = r2 & 2047; base = (size_t)BP * 1024 * LP + ((size_t)b * 1024 + d) * LS; }
                *(u32x4*)(ZZT + base + t0 + tch * 8) = *(const LAS u32x4*)(zt + dl * 264 + tch * 8);
            }
            __syncthreads();
        }
    }
}

__device__ __forceinline__ void conv_phase(int wv, const Params& p, int l, LAS unsigned char* lds) {
    const int tid = otid(wv), wid = tid >> 6, lane = tid & 63, r = lane & 31, hh = lane >> 5;
    const bf16_t* ZZT = (const bf16_t*)(p.ws + A_ZZT); bf16_t* YCT = (bf16_t*)(p.ws + A_YCT);
    const float* hbias = p.in[I_HBIAS] + l * 1024;
    LAS bf16_t* cp = (LAS bf16_t*)lds;
    LAS bf16_t* zz = (LAS bf16_t*)(lds + 65536);
    LAS float* kf = (LAS float*)(lds + 98304);
    for (int u = obid(); u < 2048; u += gridDim.x) {
        const int g = (u < 1024) ? 1 : 0, d = u & 1023;
        const int L = g ? LS : LP, B = g ? BS : BP, L2 = 2 * L, NB = L / 32, NI = 32 / B, NT = NB / NI, lgB = g ? 3 : 4;
        const float* kT = (const float*)(p.ws + (g ? S_KTS : S_KTP)) + (size_t)d * L2;
        const float scale = ((const float*)(p.ws + S_SCALE))[g * 1024 + d]; const float bias = hbias[d];
        for (int i = tid; i < L2 / 4; i += NTHREADS) { f32x4 v = *(const f32x4*)(kT + i * 4); v *= scale; if (i == 0) v[0] += bias; *(LAS f32x4*)(kf + i * 4) = v; }
        const size_t zbase = g ? (size_t)BP * 1024 * LP : 0;
        for (int ch = tid; ch < B * L / 8; ch += NTHREADS) {
            const int b = ch / (L / 8), s8 = ch - b * (L / 8);
            *(LAS u32x4*)(zz + b * L + s8 * 8) = *(const u32x4*)(ZZT + zbase + ((size_t)b * 1024 + d) * L + s8 * 8);
        }
        __syncthreads();
        for (int ck = tid; ck < L2; ck += NTHREADS) {
            const int c = ck / (L2 / 8), m0 = (ck - c * (L2 / 8)) * 8;
            float f[8];
#pragma unroll
            for (int j = 0; j < 8; ++j) f[j] = kf[(L2 - (m0 + c + j)) & (L2 - 1)];
            *(LAS u32x4*)(cp + c * L2 + m0) = pack8(f);
        }
        __syncthreads();
        const int Iloc = r >> lgB, b = r & (B - 1);
        for (int nt = wid * 2; nt < NT; nt += 16) {
            const int I0 = nt * NI;
            f32x16 acc0, acc1;
#pragma unroll
            for (int i = 0; i < 16; ++i) { acc0[i] = 0.f; acc1[i] = 0.f; }
            for (int dl = I0 - (NB - 1); dl <= I0 + 2 * NI - 1; ++dl) {
                const int J0 = I0 + Iloc - dl, J1 = J0 + NI; const bool v0 = (J0 >= 0) && (J0 < NB), v1 = (J1 >= 0) && (J1 < NB);
#pragma unroll
                for (int ks = 0; ks < 2; ++ks) {
                    const int i0 = (16 * ks + 8 * hh - 32 * dl - r) & (L2 - 1); const int c = i0 & 7, q = i0 >> 3;
                    const bf16x8 Af = *(const LAS bf16x8*)(cp + c * L2 + q * 8);
                    bf16x8 B0 = (bf16x8){0, 0, 0, 0, 0, 0, 0, 0}, B1 = B0;
                    if (v0) B0 = *(const LAS bf16x8*)(zz + b * L + 32 * J0 + 16 * ks + 8 * hh);
                    if (v1) B1 = *(const LAS bf16x8*)(zz + b * L + 32 * J1 + 16 * ks + 8 * hh);
                    acc0 = __builtin_amdgcn_mfma_f32_32x32x16_bf16(Af, B0, acc0, 0, 0, 0);
                    acc1 = __builtin_amdgcn_mfma_f32_32x32x16_bf16(Af, B1, acc1, 0, 0, 0);
                }
            }
            bf16_t* op = YCT + zbase + ((size_t)b * 1024 + d) * L + 32 * (I0 + Iloc) + 4 * hh;
#pragma unroll
            for (int g4 = 0; g4 < 4; ++g4) {
                u32x2 w; w.x = cvt_pk_bf16(acc0[4 * g4], acc0[4 * g4 + 1]); w.y = cvt_pk_bf16(acc0[4 * g4 + 2], acc0[4 * g4 + 3]); *(u32x2*)(op + 8 * g4) = w;
                u32x2 w1; w1.x = cvt_pk_bf16(acc1[4 * g4], acc1[4 * g4 + 1]); w1.y = cvt_pk_bf16(acc1[4 * g4 + 2], acc1[4 * g4 + 3]); *(u32x2*)(op + 32 * NI + 8 * g4) = w1;
            }
        }
        __syncthreads();
    }
}

__device__ __forceinline__ void e3b_phase(int wv, const Params& p, LAS unsigned char* lds) {
    const int tid = otid(wv);
    const bf16_t* X0S = (const bf16_t*)(p.ws + A_X0S); const bf16_t* YCT = (const bf16_t*)(p.ws + A_YCT); bf16_t* YA = (bf16_t*)(p.ws + A_YA);
    LAS bf16_t* yt = (LAS bf16_t*)lds;
    for (int u = obid(); u < (MT / 64) * 16; u += gridDim.x) {
        const int rt = u >> 4, dt = u & 15; const int row0 = rt * 64;
        {
            const int dl = tid >> 3, tch = tid & 7; const int d = dt * 64 + dl;
            size_t base; int t0;
            if (row0 < MP) { const int b = row0 >> 8; t0 = row0 & 255; base = ((size_t)b * 1024 + d) * LP; }
            else { const int r2 = row0 - MP; const int b = r2 >> 11; t0 = r2 & 2047; base = (size_t)BP * 1024 * LP + ((size_t)b * 1024 + d) * LS; }
            const u32x4 v = *(const u32x4*)(YCT + base + t0 + tch * 8);
            const unsigned w[4] = {v.x, v.y, v.z, v.w};
#pragma unroll
            for (int j = 0; j < 4; ++j) { yt[(tch * 8 + 2 * j) * 72 + dl] = (bf16_t)(w[j] & 0xffffu); yt[(tch * 8 + 2 * j + 1) * 72 + dl] = (bf16_t)(w[j] >> 16); }
        }
        __syncthreads();
        {
            const int tl = tid >> 3, dg = tid & 7; const int row = row0 + tl, d0 = dt * 64 + dg * 8;
            float a[8], b[8]; unpack8(*(const LAS u32x4*)(yt + tl * 72 + dg * 8), a); unpack8(*(const u32x4*)(X0S + (size_t)row * 1024 + d0), b);
#pragma unroll
            for (int j = 0; j < 8; ++j) a[j] *= b[j];
            *(u32x4*)(YA + (size_t)row * 1024 + d0) = pack8(a);
        }
        __syncthreads();
    }
}

__device__ __forceinline__ void attn_phase(int wv, const Params& p, LAS unsigned char* lds) {
    const bf16_t* Q = (const bf16_t*)(p.ws + A_Q); const bf16_t* KN = (const bf16_t*)(p.ws + A_KN); const bf16_t* KP = (const bf16_t*)(p.ws + A_KPER);
    const bf16_t* VT = (const bf16_t*)(p.ws + A_VT); bf16_t* O = (bf16_t*)(p.ws + A_OATT);
    LAS unsigned char* Ks = lds;
    LAS unsigned char* Vs = lds + 64 * 400;
    const float sc2 = 0.07216878364870322f * 1.4426950408889634f;
    for (int u = obid(); u < 512 + 128; u += gridDim.x) {
        const int tid = otid(wv), wid = tid >> 6, lane = tid & 63, r = lane & 31, hh = lane >> 5;
        int b, h, row0, Lk, KR0; size_t vtb; bool samp;
        if (u < 512) { samp = true; b = u >> 6; h = (u >> 3) & 7; const int qb = u & 7; row0 = MP + b * LS + qb * 256; Lk = LKS; KR0 = b * LKS; vtb = (size_t)(b * 8 + h) * 128 * LKS; }
        else { samp = false; const int u2 = u - 512; b = u2 >> 3; h = u2 & 7; row0 = b * LP; Lk = LP; KR0 = BS * LKS + b * LP; vtb = (size_t)BS * 8 * 128 * LKS + (size_t)(b * 8 + h) * 128 * LP; }
        const int qrow = row0 + wid * 32 + r;
        bf16x8 qf[12];
        {
            const bf16_t* qp = Q + (size_t)qrow * 1536 + h * 192 + 8 * hh;
            u32x4 qv[12];
#pragma unroll
            for (int s = 0; s < 12; ++s) qv[s] = *(const u32x4*)(qp + 16 * s);
            if (samp) {
                const int t = (qrow - MP) & 2047;
#pragma unroll
                for (int s2 = 0; s2 < 2; ++s2) {
                    float x1[8], x2[8]; unpack8(qv[8 + s2], x1); unpack8(qv[10 + s2], x2);
                    const float* rc = (const float*)(p.ws + S_ROPE) + t * 32 + 16 * s2 + 8 * hh;
                    const f32x4 c0 = *(const f32x4*)rc, c1 = *(const f32x4*)(rc + 4), s0 = *(const f32x4*)(rc + 2048 * 32), s1 = *(const f32x4*)(rc + 2048 * 32 + 4);
#pragma unroll
                    for (int j = 0; j < 8; ++j) { const float cs = (j < 4) ? c0[j & 3] : c1[j & 3], sn = (j < 4) ? s0[j & 3] : s1[j & 3]; const float a = x1[j], c = x2[j]; x1[j] = a * cs - c * sn; x2[j] = a * sn + c * cs; }
                    qv[8 + s2] = pack8(x1); qv[10 + s2] = pack8(x2);
                }
            }
#pragma unroll
            for (int s = 0; s < 12; ++s) qf[s] = __builtin_bit_cast(bf16x8, qv[s]);
        }
        f32x16 oacc[4];
#pragma unroll
        for (int ct = 0; ct < 4; ++ct)
#pragma unroll
            for (int i = 0; i < 16; ++i) oacc[ct][i] = 0.f;
        float mrun = -1e30f, lrun = 0.f;
        const int nkt = Lk / 64;
        u32x4 kst[3], vst[2];
#pragma unroll
        for (int i = 0; i < 3; ++i) { const int ck = tid + i * NTHREADS; const int key = ck / 24, part = ck - key * 24;
            kst[i] = (part < 16) ? *(const u32x4*)(KN + (size_t)(KR0 + key) * 1024 + h * 128 + part * 8) : *(const u32x4*)(KP + (size_t)(KR0 + key) * 64 + (part - 16) * 8); }
#pragma unroll
        for (int i = 0; i < 2; ++i) { const int cv = tid + i * NTHREADS; const int v = cv >> 3, kc = cv & 7; vst[i] = *(const u32x4*)(VT + vtb + (size_t)v * Lk + kc * 8); }
        for (int kt = 0; kt < nkt; ++kt) {
            __syncthreads();
#pragma unroll
            for (int i = 0; i < 3; ++i) { const int ck = tid + i * NTHREADS; const int key = ck / 24, part = ck - key * 24; *(LAS u32x4*)(Ks + key * 400 + part * 16) = kst[i]; }
#pragma unroll
            for (int i = 0; i < 2; ++i) { const int cv = tid + i * NTHREADS; const int v = cv >> 3, kc = cv & 7; *(LAS u32x4*)(Vs + v * 144 + kc * 16) = vst[i]; }
            __syncthreads();
            if (kt + 1 < nkt) {
                const int k0 = (kt + 1) * 64;
#pragma unroll
                for (int i = 0; i < 3; ++i) { const int ck = tid + i * NTHREADS; const int key = ck / 24, part = ck - key * 24;
                    kst[i] = (part < 16) ? *(const u32x4*)(KN + (size_t)(KR0 + k0 + key) * 1024 + h * 128 + part * 8) : *(const u32x4*)(KP + (size_t)(KR0 + k0 + key) * 64 + (part - 16) * 8); }
#pragma unroll
                for (int i = 0; i < 2; ++i) { const int cv = tid + i * NTHREADS; const int v = cv >> 3, kc = cv & 7; vst[i] = *(const u32x4*)(VT + vtb + (size_t)v * Lk + k0 + kc * 8); }
            }
            f32x16 sacc[2];
#pragma unroll
            for (int kk = 0; kk < 2; ++kk) {
#pragma unroll
                for (int i = 0; i < 16; ++i) sacc[kk][i] = 0.f;
#pragma unroll
                for (int s = 0; s < 12; ++s) {
                    const bf16x8 kf = *(const LAS bf16x8*)(Ks + (32 * kk + r) * 400 + (16 * s + 8 * hh) * 2);
                    sacc[kk] = __builtin_amdgcn_mfma_f32_32x32x16_bf16(kf, qf[s], sacc[kk], 0, 0, 0);
                }
            }
            float mx0 = fmaxf(sacc[0][0], sacc[1][0]), mx1 = fmaxf(sacc[0][1], sacc[1][1]);
#pragma unroll
            for (int i = 2; i < 16; i += 2) { mx0 = __builtin_fmaxf(__builtin_fmaxf(mx0, sacc[0][i]), sacc[1][i]); mx1 = __builtin_fmaxf(__builtin_fmaxf(mx1, sacc[0][i + 1]), sacc[1][i + 1]); }
            float mx = fmaxf(mx0, mx1);
            mx = fmaxf(mx, shx(mx, 32, lane));
            const float mnew = fmaxf(mrun, mx);
            const bool resc = __builtin_amdgcn_ballot_w64(mnew != mrun) != 0ull;
            const float alpha = __builtin_amdgcn_exp2f((mrun - mnew) * sc2);
            mrun = mnew;
            const float nm = -mnew * sc2;
            f32x2 ps2 = (f32x2){0.f, 0.f};
#pragma unroll
            for (int kk = 0; kk < 2; ++kk)
#pragma unroll
                for (int i = 0; i < 16; i += 2) {
                    f32x2 a = (f32x2){sacc[kk][i], sacc[kk][i + 1]}; a = a * sc2 + nm;
                    a.x = __builtin_amdgcn_exp2f(a.x); a.y = __builtin_amdgcn_exp2f(a.y);
                    sacc[kk][i] = a.x; sacc[kk][i + 1] = a.y; ps2 += a;
                }
            lrun = lrun * alpha + (ps2.x + ps2.y);
            if (resc) {
#pragma unroll
                for (int ct = 0; ct < 4; ++ct)
#pragma unroll
                    for (int i = 0; i < 16; ++i) oacc[ct][i] *= alpha;
            }
#pragma unroll
            for (int ks = 0; ks < 4; ++ks) {
                const int kk = ks >> 1, s2 = ks & 1;
                u32x4 pw;
                pw.x = cvt_pk_bf16(sacc[kk][8 * s2 + 0], sacc[kk][8 * s2 + 1]); pw.y = cvt_pk_bf16(sacc[kk][8 * s2 + 2], sacc[kk][8 * s2 + 3]);
                pw.z = cvt_pk_bf16(sacc[kk][8 * s2 + 4], sacc[kk][8 * s2 + 5]); pw.w = cvt_pk_bf16(sacc[kk][8 * s2 + 6], sacc[kk][8 * s2 + 7]);
                const bf16x8 pf = __builtin_bit_cast(bf16x8, pw);
#pragma unroll
                for (int ct = 0; ct < 4; ++ct) {
                    const LAS unsigned char* vp = Vs + (32 * ct + r) * 144 + (32 * kk + 16 * s2 + 4 * hh) * 2;
                    const u32x2 lo = *(const LAS u32x2*)vp, hi = *(const LAS u32x2*)(vp + 16);
                    u32x4 vw; vw.x = lo.x; vw.y = lo.y; vw.z = hi.x; vw.w = hi.y;
                    oacc[ct] = __builtin_amdgcn_mfma_f32_32x32x16_bf16(__builtin_bit_cast(bf16x8, vw), pf, oacc[ct], 0, 0, 0);
                }
            }
        }
        lrun += shx(lrun, 32, lane);
        const float invl = 1.0f / lrun;
        const int tid2 = otid(wv); const int qrow2 = row0 + (tid2 >> 6) * 32 + (tid2 & 31);
        bf16_t* op = O + (size_t)qrow2 * 1024 + h * 128 + 4 * ((tid2 >> 5) & 1);
#pragma unroll
        for (int ct = 0; ct < 4; ++ct)
#pragma unroll
            for (int g4 = 0; g4 < 4; ++g4) {
                u32x2 w; w.x = cvt_pk_bf16(oacc[ct][4 * g4] * invl, oacc[ct][4 * g4 + 1] * invl); w.y = cvt_pk_bf16(oacc[ct][4 * g4 + 2] * invl, oacc[ct][4 * g4 + 3] * invl);
                *(u32x2*)(op + 32 * ct + 8 * g4) = w;
            }
        __syncthreads();
    }
}

__device__ __forceinline__ void e9_phase(int wv, const Params& p, int l) {
    const bf16_t* UU = (const bf16_t*)(p.ws + A_UU); bf16_t* ACT = (bf16_t*)(p.ws + A_ACT);
    const float* cw = p.in[I_FCW] + (size_t)l * 3 * UU_LD; const float* cb = p.in[I_FCB] + (size_t)l * UU_LD;
    const int tid9 = otid(wv);
    constexpr int RC = 16, NCG = DFF / 8;
    for (int it = obid() * NTHREADS + tid9; it < (MT / RC) * NCG; it += gridDim.x * NTHREADS) {
        const int ch = it / NCG, c0 = (it - ch * NCG) * 8, row0 = ch * RC;
        const int t0 = row0 < MP ? (row0 & 255) : ((row0 - MP) & 2047); const int L = row0 < MP ? LP : LS;
        float wg[3][8], wx[3][8], bg[8], bx[8];
#pragma unroll
        for (int o = 0; o < 3; ++o) { const f32x4 a = *(const f32x4*)(cw + o * UU_LD + c0), b = *(const f32x4*)(cw + o * UU_LD + c0 + 4), c = *(const f32x4*)(cw + o * UU_LD + DFF + c0), d = *(const f32x4*)(cw + o * UU_LD + DFF + c0 + 4);
#pragma unroll
            for (int j = 0; j < 4; ++j) { wg[o][j] = a[j]; wg[o][4 + j] = b[j]; wx[o][j] = c[j]; wx[o][4 + j] = d[j]; } }
        { const f32x4 a = *(const f32x4*)(cb + c0), b = *(const f32x4*)(cb + c0 + 4), c = *(const f32x4*)(cb + DFF + c0), d = *(const f32x4*)(cb + DFF + c0 + 4);
#pragma unroll
          for (int j = 0; j < 4; ++j) { bg[j] = a[j]; bg[4 + j] = b[j]; bx[j] = c[j]; bx[4 + j] = d[j]; } }
        const bf16_t* pr = UU + (size_t)row0 * UU_LD + c0;
        u32x4 gp = (u32x4){0u, 0u, 0u, 0u}, xp = gp, gc, xc, gn, xn;
        if (t0 > 0) { gp = *(const u32x4*)(pr - UU_LD); xp = *(const u32x4*)(pr - UU_LD + DFF); }
        gc = *(const u32x4*)pr; xc = *(const u32x4*)(pr + DFF);
#pragma unroll 4
        for (int i = 0; i < RC; ++i) {
            gn = (u32x4){0u, 0u, 0u, 0u}; xn = gn;
            if (t0 + i + 1 < L) { gn = *(const u32x4*)(pr + (size_t)(i + 1) * UU_LD); xn = *(const u32x4*)(pr + (size_t)(i + 1) * UU_LD + DFF); }
            float a[8], b[8], c[8], ga[8], va[8];
            unpack8(gp, a); unpack8(gc, b); unpack8(gn, c);
#pragma unroll
            for (int j = 0; j < 8; ++j) ga[j] = bg[j] + wg[0][j] * a[j] + wg[1][j] * b[j] + wg[2][j] * c[j];
            unpack8(xp, a); unpack8(xc, b); unpack8(xn, c);
#pragma unroll
            for (int j = 0; j < 8; ++j) va[j] = bx[j] + wx[0][j] * a[j] + wx[1][j] * b[j] + wx[2][j] * c[j];
#pragma unroll
            for (int j = 0; j < 8; ++j) ga[j] = siluf_(ga[j]) * va[j];
            *(u32x4*)(ACT + (size_t)(row0 + i) * DFF + c0) = pack8(ga);
            gp = gc; gc = gn; xp = xc; xc = xn;
        }
    }
}

__device__ __forceinline__ void merge_phase(int wv, const Params& p) {
    const bf16_t* RAW = (const bf16_t*)(p.ws + A_RAW); const bf16_t* G = (const bf16_t*)(p.ws + A_GATES); bf16_t* MB = (bf16_t*)(p.ws + A_MBF);
    const int tid = otid(wv);
    for (int it = obid() * NTHREADS + tid; it < MT * 256; it += gridDim.x * NTHREADS) {
        const int row = it >> 8, c0 = (it & 255) * 8;
        float acc[8];
#pragma unroll
        for (int j = 0; j < 8; ++j) acc[j] = 0.f;
#pragma unroll
        for (int P = 0; P < 3; ++P) {
            float r[8], g[8];
            unpack8(*(const u32x4*)(RAW + ((size_t)P * MT + row) * DM + c0), r); unpack8(*(const u32x4*)(G + (size_t)row * GATE_LD + P * 2048 + c0), g);
#pragma unroll
            for (int j = 0; j < 8; ++j) acc[j] += sigmoidf_(g[j]) * r[j];
        }
        *(u32x4*)(MB + (size_t)row * DM + c0) = pack8(acc);
    }
}

__device__ __forceinline__ void convert_layer(int wv, const Params& p, int l, LAS unsigned char* lds) {
    unsigned char* ws = p.ws;
    convT(wv, p.in[I_WIN] + (size_t)l * DM * NIN, DM, NIN, (bf16_t*)(ws + W_IN), 1, lds);
    convT(wv, p.in[I_WUQ] + (size_t)l * 512 * 1536, 512, 1536, (bf16_t*)(ws + W_UQ), 0, lds);
    convT(wv, p.in[I_WUKV] + (size_t)l * 256 * 2048, 256, 2048, (bf16_t*)(ws + W_UKV), 2, lds);
    convT(wv, p.in[I_WBRA] + (size_t)l * 1024 * 2048, 1024, 2048, (bf16_t*)(ws + W_BRA), 0, lds);
    convT(wv, p.in[I_WBRB] + (size_t)l * 1024 * 2048, 1024, 2048, (bf16_t*)(ws + W_BRB), 0, lds);
    convT(wv, p.in[I_WBRC] + (size_t)l * 1024 * 2048, 1024, 2048, (bf16_t*)(ws + W_BRC), 0, lds);
    convT(wv, p.in[I_WO] + (size_t)l * 2048 * 2048, 2048, 2048, (bf16_t*)(ws + W_O), 0, lds);
    convT(wv, p.in[I_FUP] + (size_t)l * 2048 * UU_LD, 2048, UU_LD, (bf16_t*)(ws + W_UP), 0, lds);
    convT(wv, p.in[I_FDN] + (size_t)l * DFF * 2048, DFF, 2048, (bf16_t*)(ws + W_DN), 0, lds);
}

namespace pg8 {
struct EpiGateRT {
    const bf16_t* gates; float* m32; bf16_t* mbf; int P;
    __device__ __forceinline__ void operator()(const f32x4 (&acc)[2][2][4][2], const Unit& u, int wr, int wc, int fr, int fq) const {
        const int row0 = u.pm * BM + wr * 64 + fr, col0 = u.pn * BM + wc * 32 + 4 * fq;
#pragma unroll
        for (int ai = 0; ai < 2; ++ai)
#pragma unroll
            for (int m = 0; m < 4; ++m) {
                const size_t row = (size_t)(row0 + ai * HALF + m * 16);
#pragma unroll
                for (int bj = 0; bj < 2; ++bj)
#pragma unroll
                    for (int n = 0; n < 2; ++n) {
                        const int col = col0 + bj * HALF + n * 16;
                        const u32x2 gw = *(const u32x2*)(gates + row * GATE_LD + P * 2048 + col);
                        f32x4 v = acc[ai][bj][m][n];
                        v[0] *= sigmoidf_(bf_lo(gw.x)); v[1] *= sigmoidf_(bf_hi(gw.x)); v[2] *= sigmoidf_(bf_lo(gw.y)); v[3] *= sigmoidf_(bf_hi(gw.y));
                        float* mp = m32 + row * 2048 + col;
                        if (P != 0) { const f32x4 o = *(const f32x4*)mp; v = v + o; }
                        if (P != 2) { *(f32x4*)mp = v; }
                        else { u32x2 w; w.x = cvt_pk_bf16(v[0], v[1]); w.y = cvt_pk_bf16(v[2], v[3]); *(u32x2*)(mbf + row * 2048 + col) = w; }
                    }
            }
    }
};
}


#define XB_TMO      128
#define XB_XCNT(j)  (256  + 64 * (j))
#define XB_XSUB(j)  (1280 + 64 * (j))
#define XB_XGEN(j)  (2304 + 64 * (j))
#define XB_TOP      3328
#define XB_TOPGEN   3392
#define XCD_BAR_WORDS 3456
#define XB_SPIN_CAP (1u << 20)
__device__ __forceinline__ unsigned xb_ld(unsigned* p)              { return __hip_atomic_load(p, __ATOMIC_RELAXED, __HIP_MEMORY_SCOPE_AGENT); }
__device__ __forceinline__ unsigned xb_add(unsigned* p, unsigned v) { return __hip_atomic_fetch_add(p, v, __ATOMIC_RELAXED, __HIP_MEMORY_SCOPE_AGENT); }
__device__ __forceinline__ unsigned xb_xcc_id() { return (unsigned)__builtin_amdgcn_s_getreg((3 << 11) | 20) & 0xFu; }
#define XB_SPIN(cond, bar) do { unsigned _sp = 0; while (cond) { __builtin_amdgcn_s_sleep(1); \
    if ((++_sp & 255u) == 0u) { if (xb_ld(&(bar)[XB_TMO])) break; if (_sp > XB_SPIN_CAP) { atomicAdd(&(bar)[XB_TMO], 1u); break; } } } } while (0)
__device__ __forceinline__ void xcd_barrier_complete(unsigned* bar, unsigned x, unsigned& nloc, unsigned& nx) {
    const unsigned G = gridDim.x;
    unsigned sum, cnt, mine, sp = 0u;
    for (;;) {
        sum = 0u; cnt = 0u; mine = 0u;
#pragma unroll
        for (unsigned j = 0; j < 16; ++j) { const unsigned c = xb_ld(&bar[XB_XCNT(j)]); sum += c; cnt += (c > 0u) ? 1u : 0u; mine = (j == x) ? c : mine; }
        if (sum == G) break;
        __builtin_amdgcn_s_sleep(1);
        if ((++sp & 255u) == 0u) { if (xb_ld(&bar[XB_TMO])) break; if (sp > XB_SPIN_CAP) { atomicAdd(&bar[XB_TMO], 1u); break; } }
    }
    nloc = mine > 0u ? mine : 1u; nx = cnt > 0u ? cnt : 1u;
}
__device__ __forceinline__ void xcd_barrier(int wv, unsigned* bar, volatile LAS unsigned* st) {
    asm volatile("s_waitcnt vmcnt(0)" ::: "memory");
    __syncthreads();
    if (otid(wv) == 0) {
        __builtin_amdgcn_s_waitcnt(0);
        const unsigned x = xb_xcc_id();
        unsigned nloc = st[0], nx = st[1];
        if (nloc == 0u) { xcd_barrier_complete(bar, x, nloc, nx); st[0] = nloc; st[1] = nx; }
        const unsigned old = xb_add(&bar[XB_XSUB(x)], 1u);
        const unsigned gen = old / nloc;
        if (old + 1u == (gen + 1u) * nloc) {
            __builtin_amdgcn_fence(__ATOMIC_RELEASE, "agent");
            asm volatile("s_waitcnt vmcnt(0)" ::: "memory");
            const unsigned og = xb_add(&bar[XB_TOP], 1u);
            const unsigned tg = og / nx;
            if (og + 1u == (tg + 1u) * nx) xb_add(&bar[XB_TOPGEN], 1u);
            else XB_SPIN(xb_ld(&bar[XB_TOPGEN]) == tg, bar);
            __builtin_amdgcn_fence(__ATOMIC_ACQUIRE, "agent");
            xb_add(&bar[XB_XGEN(x)], 1u);
            asm volatile("s_waitcnt vmcnt(0)" ::: "memory");
        } else {
            XB_SPIN(xb_ld(&bar[XB_XGEN(x)]) == gen, bar);
            __builtin_amdgcn_fence(__ATOMIC_ACQUIRE, "agent");
            asm volatile("s_waitcnt vmcnt(0)" ::: "memory");
        }
    }
    __syncthreads();
}

#ifndef REP_GEMM
#define REP_GEMM 1
#endif
#ifndef REP_ATTN
#define REP_ATTN 1
#endif
#ifndef REP_CONV
#define REP_CONV 1
#endif
#ifndef REP_ELT
#define REP_ELT 1
#endif
#ifndef REP_CVT
#define REP_CVT 1
#endif
enum { K_G1A = 0, K_E2, K_I3, K_I4, K_G1B, K_G5, K_G6, K_ROW1, K_G8, K_E9, K_G10, K_ROW2, K_PRO, K_ROW0, K_COMB };

__global__ void __launch_bounds__(NTHREADS) fwd_megakernel(Params p) {
    extern __shared__ __attribute__((aligned(16))) unsigned char shm[];
    LAS unsigned char* lds = (LAS unsigned char*)shm;
    cg::grid_group grid = cg::this_grid();
    const int wv = __builtin_amdgcn_readfirstlane((int)(threadIdx.x >> 6));
    volatile LAS unsigned* bst = (volatile LAS unsigned*)(lds + 131072);
    unsigned* bar = (unsigned*)(p.ws + S_BAR);
    if (threadIdx.x == 0) { bst[0] = 0u; bst[1] = 0u; bst[2] = 0u; bst[3] = 0u; (void)xb_add(&bar[XB_XCNT(xb_xcc_id())], 1u); }
    __syncthreads();
#pragma unroll 1
    for (int ph = 0; ph < 3 + 12 * NLAYER; ++ph) {
        int kind, l;
        if (ph == 0) { kind = K_PRO; l = 0; } else if (ph == 1) { kind = K_COMB; l = 0; } else if (ph == 2) { kind = K_ROW0; l = 0; } else { l = (ph - 3) / 12; kind = (ph - 3) - l * 12; }
        unsigned char* ws = p.ws;
        asm volatile("" : "+s"(ws));
        if (kind == K_G1A || kind == K_I3 || kind == K_G1B || kind == K_G8) {
            const bf16_t* A; const bf16_t* Bt; bf16_t* O; int N, K;
            if (kind == K_G1A) { A = (const bf16_t*)(ws + A_H); Bt = (const bf16_t*)(ws + W_IN); O = (bf16_t*)(ws + A_PROJA); N = PA_LD; K = DM; }
            else if (kind == K_I3) { A = (const bf16_t*)(ws + A_CQN); Bt = (const bf16_t*)(ws + W_UQ); O = (bf16_t*)(ws + A_Q); N = 1536; K = 512; }
            else if (kind == K_G1B) { A = (const bf16_t*)(ws + A_H); Bt = (const bf16_t*)(ws + W_IN) + (size_t)PA_LD * DM; O = (bf16_t*)(ws + A_GATES); N = GATE_LD; K = DM; }
            else { A = (const bf16_t*)(ws + A_H); Bt = (const bf16_t*)(ws + W_UP); O = (bf16_t*)(ws + A_UU); N = UU_LD; K = DM; }
            int Mr = MT;
            const int nrep = ((kind == K_I3) ? 2 : 1) * REP_GEMM;
#pragma unroll 1
            for (int rp = 0; rp < nrep; ++rp) {
                if (kind == K_I3 && rp >= REP_GEMM) { A = (const bf16_t*)(ws + A_KEYSC); Bt = (const bf16_t*)(ws + W_UKV); O = (bf16_t*)(ws + A_KN); N = 1024; K = 256; Mr = KROWS; }
                run_gemm(wv, lds, A, Bt, Mr, N, K, pg8::EpiBf16{O, N, O});
            }
        }
        if (kind == K_I3) {
#pragma unroll 1
            for (int rp = 0; rp < REP_GEMM; ++rp)
            run_gemm(wv, lds, (const bf16_t*)(ws + W_UKV) + (size_t)1024 * 256, (const bf16_t*)(ws + A_KEYSC), 1024, KROWS, 256,
                     pg8::EpiVT{(bf16_t*)(ws + A_VT), (bf16_t*)(ws + A_VT) + (size_t)BS * 8 * 128 * LKS});
#pragma unroll 1
            for (int rp = 0; rp < REP_CONV; ++rp) conv_phase(wv, p, l, lds);
        }
        if (kind == K_I4) {
#pragma unroll 1
            for (int rp = 0; rp < REP_ATTN; ++rp) attn_phase(wv, p, lds);
#pragma unroll 1
            for (int rp = 0; rp < REP_ELT; ++rp) e3b_phase(wv, p, lds); }
        if (kind == K_G5) {
#pragma unroll 1
            for (int rp = 0; rp < REP_GEMM; ++rp)
            run_gemm(wv, lds, (const bf16_t*)(ws + A_YA), (const bf16_t*)(ws + W_BRA), 3 * MT, DM, 1024, pg8::EpiBf16{(bf16_t*)(ws + A_RAW), DM, (bf16_t*)(ws + A_RAW)}, false, MT / 256, E_WBR * 2);
            xcd_barrier(wv, bar, bst);
            merge_phase(wv, p);
        }
        if (kind == K_G6 || kind == K_G10) {
            const bool g6 = (kind == K_G6);
#pragma unroll 1
            for (int rp = 0; rp < REP_GEMM; ++rp)
            run_gemm(wv, lds, (const bf16_t*)(ws + (g6 ? A_MBF : A_ACT)), (const bf16_t*)(ws + (g6 ? W_O : W_DN)), MT, DM, g6 ? DM : DFF, pg8::EpiBf16{(bf16_t*)(ws + (g6 ? A_M32 : A_F32)), DM, (bf16_t*)(ws + (g6 ? A_M32 : A_F32)) + (size_t)MT * DM}, true);
        }
        if (kind == K_E2) {
#pragma unroll 1
            for (int rp = 0; rp < REP_ELT; ++rp) e2_phase(wv, p, l, lds); }
        if (kind == K_E9) {
#pragma unroll 1
            for (int rp = 0; rp < REP_ELT; ++rp) e9_phase(wv, p, l); }
        if (kind == K_ROW0 || kind == K_ROW1 || kind == K_ROW2) row_phase(wv, p, l, kind == K_ROW0 ? 0 : (kind == K_ROW1 ? 1 : 2));
        if (kind == K_COMB) comb_phase(wv, p);
        if (kind == K_PRO) {
            if (obid() == 0) {
                pg8::StaticOrder S; S.init(MT, DM, (int)gridDim.x, 0, true);
                const int t0 = otid(wv);
                if (t0 < S.nwg - S.nfull) { pg8::Unit uu; S.tile_of(S.nfull + t0, uu); atomicOr((unsigned*)(p.ws + S_TAIL) + uu.pm, 1u << uu.pn); }
            }
            ada_phase(wv, p, lds); rope_table_phase(wv, p); }
        if (kind == K_PRO || (kind == K_ROW2 && l + 1 < NLAYER)) { const int ln = (kind == K_PRO) ? 0 : l + 1;
#pragma unroll 1
            for (int rp = 0; rp < REP_CVT; ++rp) { filter_phase(wv, p, ln, lds); convert_layer(wv, p, ln, lds); } }
        if (p.ws == nullptr) grid.sync();
        xcd_barrier(wv, bar, bst);
    }
}

extern "C" void kernel_launch(void* const* d_in, const int* in_sizes, int n_in, void* d_out, int out_size, void* d_ws, size_t ws_size, hipStream_t stream) {
    static int grid_blocks = 0;
    if (grid_blocks == 0) {
        if (n_in != N_INPUTS || ws_size < WS_NEED) { fprintf(stderr, "kernel_launch: need %d inputs and %zu bytes of workspace; got %d, %zu\n", N_INPUTS, (size_t)WS_NEED, n_in, ws_size); grid_blocks = -1; return; }
        int dev = 0, cus = 0, per_cu = 0;
        hipGetDevice(&dev);
        hipDeviceGetAttribute(&cus, hipDeviceAttributeMultiprocessorCount, dev);
        if (hipFuncSetAttribute((const void*)fwd_megakernel, hipFuncAttributeMaxDynamicSharedMemorySize, LDS_BYTES) != hipSuccess) { fprintf(stderr, "kernel_launch: hipFuncSetAttribute failed\n"); grid_blocks = -1; return; }
        if (hipOccupancyMaxActiveBlocksPerMultiprocessor(&per_cu, (const void*)fwd_megakernel, NTHREADS, LDS_BYTES) != hipSuccess || per_cu < 1) { fprintf(stderr, "kernel_launch: occupancy query gave %d\n", per_cu); per_cu = 1; }
        (void)hipGetLastError();
        grid_blocks = cus * 1;
    }
    if (grid_blocks < 0) return;
        (void)hipMemsetAsync((unsigned char*)d_ws + S_BAR, 0, 16384, stream);
    (void)hipMemsetAsync((unsigned char*)d_ws + S_TAIL, 0, 512, stream);
    Params p{};
    for (int i = 0; i < N_INPUTS; ++i) p.in[i] = (const float*)d_in[i];
    p.out = (float*)d_out; p.ws = (unsigned char*)d_ws;
    void* args[] = {&p};
    hipError_t e = hipLaunchCooperativeKernel((const void*)fwd_megakernel, dim3(grid_blocks), dim3(NTHREADS), args, LDS_BYTES, stream);
    if (e != hipSuccess) fprintf(stderr, "cooperative launch failed: %s (grid %d)\n", hipGetErrorString(e), grid_blocks);
}
```

```cpp
#include <hip/hip_runtime.h>
#include <hip/hip_cooperative_groups.h>
#include <cstdio>
namespace cg = cooperative_groups;

#define LAS __attribute__((address_space(3)))
typedef unsigned short bf16_t;
typedef short bf16x8 __attribute__((ext_vector_type(8)));
typedef float f32x4 __attribute__((ext_vector_type(4)));
typedef float f32x16 __attribute__((ext_vector_type(16)));
typedef unsigned u32x4 __attribute__((ext_vector_type(4)));
typedef unsigned u32x2 __attribute__((ext_vector_type(2)));
typedef float f32x2 __attribute__((ext_vector_type(2)));

constexpr int DM = 2048, MP = 4096, MS = 16384, MT = 20480, NLAYER = 2;
constexpr int LP = 256, LS = 2048, BP = 16, BS = 8, PAST = 512, LKS = 2560;
constexpr int NIN = 13120, NGATE0 = 6976, PA_LD = 7168, GATE_LD = 6144;
constexpr int DFF = 5632, UU_LD = 11264;
constexpr int KROWS = 24576;
constexpr int NTHREADS = 512;
constexpr int LDS_BYTES = 131072 + 16;

enum { I_XP = 0, I_XS, I_C, I_CCKV, I_CKPE, I_CCTX, I_ADAW, I_ADAB, I_NMPRE, I_NMPOST, I_NFPRE, I_NFPOST, I_WIN, I_HCW, I_HCB,
       I_FW1, I_FB1, I_FW2, I_FB2, I_FW3, I_FB3, I_FFREQ, I_HBIAS, I_QN, I_KVN, I_WUQ, I_WUKV, I_SCW, I_WBRA, I_WBRB, I_WBRC,
       I_WO, I_FUP, I_FCW, I_FCB, I_FDN, N_INPUTS };

constexpr size_t E_WIN = (size_t)13312 * 2048, E_WUQ = (size_t)1536 * 512, E_WUKV = (size_t)2048 * 256, E_WBR = (size_t)2048 * 1024,
                 E_WO = (size_t)2048 * 2048, E_WUP = (size_t)11264 * 2048, E_WDN = (size_t)2048 * 5632;
constexpr size_t W_IN = 0, W_UQ = W_IN + E_WIN * 2, W_UKV = W_UQ + E_WUQ * 2, W_BRA = W_UKV + E_WUKV * 2, W_BRB = W_BRA + E_WBR * 2,
                 W_BRC = W_BRB + E_WBR * 2, W_O = W_BRC + E_WBR * 2, W_UP = W_O + E_WO * 2, W_DN = W_UP + E_WUP * 2, W_END = W_DN + E_WDN * 2;
constexpr size_t S_MOD = W_END, SZ_MOD = (size_t)NLAYER * 16 * 9 * 12288 * 4;
constexpr size_t S_KTS = S_MOD + SZ_MOD, S_KTP = S_KTS + (size_t)1024 * 4096 * 4, S_PARTS = S_KTP + (size_t)1024 * 512 * 4,
                 S_PARTP = S_PARTS + (size_t)64 * 2048 * 4, S_ROPE = S_PARTP + (size_t)8 * 2048 * 4, S_BAR = S_ROPE + (size_t)2 * 2048 * 32 * 4, S_COMB = S_BAR + 16384, S_SCALE = S_COMB + (size_t)NLAYER * 3 * 9 * 3 * 2048 * 4, S_TAIL = S_SCALE + 8192, S_END = S_TAIL + 512;
constexpr size_t AR = S_END;
constexpr size_t SZ_H = (size_t)MT * 2048 * 2;
constexpr size_t A_H = AR, A_UU = AR + SZ_H, A_ACT = A_UU + (size_t)MT * UU_LD * 2, AR_END = A_ACT + (size_t)MT * DFF * 2;
constexpr size_t A_PROJA = A_UU;
constexpr size_t A_Q = A_UU, A_KN = A_Q + (size_t)MT * 1536 * 2, A_VT = A_KN + (size_t)KROWS * 1024 * 2, A_YCT = A_VT + (size_t)KROWS * 1024 * 2;
constexpr size_t A_GATES = A_UU, A_M32 = A_GATES + (size_t)MT * GATE_LD * 2, A_MBF = A_H, A_F32 = A_UU;
constexpr size_t A_S = A_M32 + (size_t)MT * 2048 * 4;
constexpr size_t A_ZZT = A_S, A_X0S = A_ZZT + (size_t)MT * 1024 * 2, A_CQN = A_X0S + (size_t)MT * 1024 * 2, A_KEYSC = A_CQN + (size_t)MT * 512 * 2,
                 A_KPER = A_KEYSC + (size_t)KROWS * 256 * 2, A_YA = A_KPER + (size_t)KROWS * 64 * 2, A_OATT = A_YA + (size_t)MT * 1024 * 2,
                 A_YC = A_OATT + (size_t)MT * 1024 * 2, A_SEND = A_YC + (size_t)MT * 1024 * 2;
constexpr size_t A_RAW = A_M32;
static_assert(A_RAW + (size_t)3 * MT * 2048 * 2 <= A_CQN, "raw branch buffer overlaps live data");
static_assert(A_SEND <= AR_END, "arena overflow");
static_assert(A_YCT + (size_t)MT * 1024 * 2 <= A_M32, "arena overlap");
constexpr size_t WS_NEED = AR_END;
static_assert(WS_NEED <= 967590400ull, "workspace too large");

struct Params {
    const float* in[N_INPUTS];
    float* out;
    unsigned char* ws;
};

__device__ __forceinline__ unsigned cvt_pk_bf16(float lo, float hi) { unsigned r; asm volatile("v_cvt_pk_bf16_f32 %0, %1, %2" : "=v"(r) : "v"(lo), "v"(hi)); return r; }
__device__ __forceinline__ bf16_t f2bf(float f) { return (bf16_t)(cvt_pk_bf16(f, 0.f) & 0xffffu); }
__device__ __forceinline__ float bf_lo(unsigned w) { return __uint_as_float(w << 16); }
__device__ __forceinline__ float bf_hi(unsigned w) { return __uint_as_float(w & 0xffff0000u); }
__device__ __forceinline__ void unpack8(const u32x4 v, float* f) { f[0] = bf_lo(v.x); f[1] = bf_hi(v.x); f[2] = bf_lo(v.y); f[3] = bf_hi(v.y); f[4] = bf_lo(v.z); f[5] = bf_hi(v.z); f[6] = bf_lo(v.w); f[7] = bf_hi(v.w); }
__device__ __forceinline__ u32x4 pack8(const float* f) { u32x4 r; r.x = cvt_pk_bf16(f[0], f[1]); r.y = cvt_pk_bf16(f[2], f[3]); r.z = cvt_pk_bf16(f[4], f[5]); r.w = cvt_pk_bf16(f[6], f[7]); return r; }
__device__ __forceinline__ float shx(float v, int mask, int lane) { return __int_as_float(__builtin_amdgcn_ds_bpermute((lane ^ mask) << 2, __float_as_int(v))); }
__device__ __forceinline__ float wave_sum(float v, int lane) {
#pragma unroll
    for (int o = 32; o >= 1; o >>= 1) v += shx(v, o, lane);
    return v;
}
__device__ __forceinline__ int otid(int wv) { int t; asm volatile("v_mbcnt_lo_u32_b32 %0, -1, 0\n\tv_mbcnt_hi_u32_b32 %0, -1, %0" : "=v"(t)); return wv * 64 + t; }
__device__ __forceinline__ int obid() { int t = blockIdx.x; asm volatile("" : "+s"(t)); return t; }
__device__ __forceinline__ float sigmoidf_(float x) { return 1.0f / (1.0f + __expf(-x)); }
__device__ __forceinline__ float siluf_(float x) { return x / (1.0f + __expf(-x)); }

namespace pg8 {
constexpr int BM = 256, BK = 64, HALF = 128, HTB = HALF * BK * 2, STAGE_BYTES = 8 * HTB, NXCD = 8, WGM = 8;
__host__ __device__ __forceinline__ int lds_byte(int r, int c) { const int st = (r >> 4) * 2 + (c >> 5), rr = r & 15, cc = c & 31, ob = rr * 64 + cc * 2; return st * 1024 + (ob ^ (((ob >> 9) & 1) << 5)); }
__host__ __device__ __forceinline__ void stage_rc(int b, int& R, int& C) { const int st = b / 1024, sb = b % 1024, swz = sb ^ (((sb >> 9) & 1) << 5); R = (st >> 1) * 16 + swz / 64; C = (st & 1) * 32 + (swz % 64) / 2; }
__host__ __device__ __forceinline__ int perm32(int rho) { const int n = rho >> 4, i = rho & 15; return 8 * (i >> 2) + 4 * n + (i & 3); }
struct Unit { int pm, pn, kh; };
struct Gemm { const bf16_t* A; const bf16_t* Bt; int M, N, K; int nMper; size_t bstride; };
struct StaticOrder {
    int nM, nN, nwg, G, c, nfull;
    __device__ void init(int M, int N, int G_, int c_, bool split = false) { nM = M / BM; nN = N / BM; nwg = nM * nN; G = G_; c = c_;
        nfull = nwg; if (split) { const int rem = nwg % G; if (rem > 0 && 2 * rem <= G) nfull = nwg - rem; } }
    __device__ void tile_of(int wgid, Unit& u) const {
        { const int q = nwg / NXCD, r = nwg % NXCD, xcd = wgid % NXCD, off = wgid / NXCD; wgid = (xcd < r ? xcd * (q + 1) : r * (q + 1) + (xcd - r) * q) + off; }
        const int nig = WGM * nN, gid = wgid / nig, fm = gid * WGM, gsz = (nM - fm) < WGM ? (nM - fm) : WGM;
        u.pm = fm + ((wgid % nig) % gsz); u.pn = (wgid % nig) / gsz;
    }
    __device__ bool next(int i, Unit& u) const {
        const long L = (long)i * G + c;
        int tile = (int)L, kh = -1; bool ok = L < nwg;
        if (L >= nfull) { const long h = L - nfull; ok = h < 2 * (long)(nwg - nfull); tile = nfull + (int)(h >> 1); kh = (int)(h & 1); }
        if (!ok) return false;
        int pm, pn;
        { int wgid = tile; const int q = nwg / NXCD, r = nwg % NXCD, xcd = wgid % NXCD, off = wgid / NXCD; wgid = (xcd < r ? xcd * (q + 1) : r * (q + 1) + (xcd - r) * q) + off;
          const int nig = WGM * nN, gid = wgid / nig, fm = gid * WGM, gsz = (nM - fm) < WGM ? (nM - fm) : WGM;
          pm = fm + ((wgid % nig) % gsz); pn = (wgid % nig) / gsz; }
        u.pm = pm; u.pn = pn; u.kh = kh; return true;
    }
};
template <class Epi>
__device__ __forceinline__ void gemm_phase(int wv, LAS unsigned char* lds, const Gemm g, const StaticOrder& S, const Epi& E) {
    const int tid = otid(wv), wid = __builtin_amdgcn_readfirstlane(tid >> 6), lane = tid & 63, wr = wid >> 2, wc = wid & 3, fr = lane & 15, fq = lane >> 4;
    const int K = g.K, nt = K / BK;
    unsigned voffA[2], voffB[2];
#pragma unroll
    for (int i = 0; i < 2; ++i) { int R, C; stage_rc(tid * 16 + i * 8192, R, C); const int Rb = (R & ~31) + perm32(R & 31); voffA[i] = (unsigned)(R * K + C) * 2u; voffB[i] = (unsigned)(Rb * K + C) * 2u; }
    const size_t kstep = (size_t)(BK * 2);
    const size_t hstep = (size_t)HALF * K * 2;
    const size_t tstep = 2 * hstep;
    const unsigned ldsw = (unsigned)wid * 1024u;
    const int aoff = lds_byte(wr * 64 + fr, fq * 8), boff = lds_byte(wc * 32 + fr, fq * 8);
#define PG8_SA(b, h) (((b) * 2 + (h)) * HTB)
#define PG8_SB(b, h) ((4 + (b) * 2 + (h)) * HTB)
#define PG8_STAGE(bufoff, gbase, voff) do { _Pragma("unroll") for (int _i = 0; _i < 2; ++_i) \
        __builtin_amdgcn_global_load_lds((const unsigned*)((const char*)(gbase) + (voff)[_i]), (LAS unsigned*)(lds + (bufoff) + ldsw + _i * 8192), 16, 0, 0); } while (0)
#define PG8_LDA(dst, b, h) do { _Pragma("unroll") for (int m = 0; m < 4; ++m) _Pragma("unroll") for (int k = 0; k < 2; ++k) dst[m][k] = *(const LAS bf16x8*)(lds + PG8_SA(b, h) + aoff + m * 2048 + k * 1024); } while (0)
#define PG8_LDB(dst, b, h) do { _Pragma("unroll") for (int n = 0; n < 2; ++n) _Pragma("unroll") for (int k = 0; k < 2; ++k) dst[n][k] = *(const LAS bf16x8*)(lds + PG8_SB(b, h) + boff + n * 2048 + k * 1024); } while (0)
#define PG8_MMA(ai, bj, At, Bt) do { __builtin_amdgcn_s_setprio(1); _Pragma("unroll") for (int m = 0; m < 4; ++m) _Pragma("unroll") for (int n = 0; n < 2; ++n) _Pragma("unroll") for (int k = 0; k < 2; ++k) \
        acc[ai][bj][m][n] = __builtin_amdgcn_mfma_f32_16x16x32_bf16(Bt[n][k], At[m][k], acc[ai][bj][m][n], 0, 0, 0); __builtin_amdgcn_s_setprio(0); } while (0)
#define PG8_WAIT_V(n) asm volatile("s_waitcnt vmcnt(" #n ")" ::: "memory")
#define PG8_WAIT_L(n) asm volatile("s_waitcnt lgkmcnt(" #n ")" ::: "memory")
#define PG8_BAR __builtin_amdgcn_s_barrier()
#define PG8_SCHED __builtin_amdgcn_sched_barrier(0)
    Unit cur, nxt; int ui = 0;
    if (!S.next(0, cur)) return;
    f32x4 acc[2][2][4][2];
#pragma unroll
    for (int a = 0; a < 2; ++a)
#pragma unroll
        for (int b = 0; b < 2; ++b)
#pragma unroll
            for (int m = 0; m < 4; ++m)
#pragma unroll
                for (int n = 0; n < 2; ++n) acc[a][b][m][n] = (f32x4){0.f, 0.f, 0.f, 0.f};
    bf16x8 At[4][2], B0[2][2], B1[2][2];
    const size_t khoff = (size_t)(nt / 2) * kstep;
    const char* cA = (const char*)g.A + (size_t)cur.pm * tstep + (cur.kh == 1 ? khoff : 0); const char* cB = (const char*)g.Bt + (size_t)(cur.pm / g.nMper) * g.bstride + (size_t)cur.pn * tstep + (cur.kh == 1 ? khoff : 0);
    PG8_STAGE(PG8_SB(0, 0), cB, voffB); PG8_STAGE(PG8_SA(0, 0), cA, voffA); PG8_STAGE(PG8_SB(0, 1), cB + hstep, voffB); PG8_STAGE(PG8_SA(0, 1), cA + hstep, voffA);
    if (wr == 1) PG8_BAR;
    PG8_WAIT_V(4); PG8_BAR;
    PG8_STAGE(PG8_SB(1, 0), cB + kstep, voffB); PG8_STAGE(PG8_SA(1, 0), cA + kstep, voffA); PG8_STAGE(PG8_SB(1, 1), cB + hstep + kstep, voffB);
    PG8_WAIT_V(6); PG8_BAR;
    for (;;) {
        const bool has_next = S.next(ui + 1, nxt);
        const char* nA = has_next ? (const char*)g.A + (size_t)nxt.pm * tstep + (nxt.kh == 1 ? khoff : 0) : cA; const char* nB = has_next ? (const char*)g.Bt + (size_t)(nxt.pm / g.nMper) * g.bstride + (size_t)nxt.pn * tstep + (nxt.kh == 1 ? khoff : 0) : cB;
        const int ntu = (cur.kh < 0) ? nt : (nt >> 1);
        for (int t = 0; t < ntu; t += 2) {
            const bool last = (t == ntu - 2);
            const char* a1 = cA + (size_t)(t + 1) * kstep;
            const char* a2 = last ? nA : cA + (size_t)(t + 2) * kstep; const char* b2 = last ? nB : cB + (size_t)(t + 2) * kstep;
            const char* a3 = a2 + kstep; const char* b3 = b2 + kstep;
            PG8_LDB(B0, 0, 0); PG8_SCHED; PG8_LDA(At, 0, 0); PG8_STAGE(PG8_SA(1, 1), a1 + hstep, voffA);
            PG8_WAIT_L(8); PG8_BAR; PG8_WAIT_L(0); PG8_MMA(0, 0, At, B0); PG8_BAR; PG8_SCHED;
            PG8_LDB(B1, 0, 1); PG8_STAGE(PG8_SB(0, 0), b2, voffB);
            PG8_BAR; PG8_WAIT_L(0); PG8_MMA(0, 1, At, B1); PG8_BAR;
            PG8_LDA(At, 0, 1); PG8_STAGE(PG8_SA(0, 0), a2, voffA);
            PG8_BAR; PG8_WAIT_L(0); PG8_MMA(1, 0, At, B0); PG8_BAR; PG8_SCHED;
            PG8_STAGE(PG8_SB(0, 1), b2 + hstep, voffB);
            PG8_WAIT_V(6); PG8_BAR; PG8_MMA(1, 1, At, B1); PG8_BAR;
            PG8_LDB(B0, 1, 0); PG8_SCHED; PG8_LDA(At, 1, 0); PG8_STAGE(PG8_SA(0, 1), a2 + hstep, voffA);
            PG8_WAIT_L(8); PG8_BAR; PG8_WAIT_L(0); PG8_MMA(0, 0, At, B0); PG8_BAR; PG8_SCHED;
            PG8_LDB(B1, 1, 1); PG8_STAGE(PG8_SB(1, 0), b3, voffB);
            PG8_BAR; PG8_WAIT_L(0); PG8_MMA(0, 1, At, B1); PG8_BAR;
            PG8_LDA(At, 1, 1); PG8_STAGE(PG8_SA(1, 0), a3, voffA);
            PG8_BAR; PG8_WAIT_L(0); PG8_MMA(1, 0, At, B0); PG8_BAR; PG8_SCHED;
            PG8_STAGE(PG8_SB(1, 1), b3 + hstep, voffB);
            PG8_WAIT_V(6); PG8_BAR; PG8_MMA(1, 1, At, B1); PG8_BAR;
        }
        { const int t2 = otid(wv); const int l2 = t2 & 63, w2 = __builtin_amdgcn_readfirstlane(t2 >> 6); E(acc, cur, w2 >> 2, w2 & 3, l2 & 15, l2 >> 4); }
        if (!has_next) break;
#pragma unroll
        for (int a = 0; a < 2; ++a)
#pragma unroll
            for (int b = 0; b < 2; ++b)
#pragma unroll
                for (int m = 0; m < 4; ++m)
#pragma unroll
                    for (int n = 0; n < 2; ++n) acc[a][b][m][n] = (f32x4){0.f, 0.f, 0.f, 0.f};
        cur = nxt; cA = nA; cB = nB; ++ui;
    }
    PG8_WAIT_V(0);
    if (wr == 0) PG8_BAR;
    PG8_BAR;
#undef PG8_SA
#undef PG8_SB
#undef PG8_STAGE
#undef PG8_LDA
#undef PG8_LDB
#undef PG8_MMA
#undef PG8_WAIT_V
#undef PG8_WAIT_L
#undef PG8_BAR
#undef PG8_SCHED
}

struct EpiBf16 {
    bf16_t* O; int ldc; bf16_t* O2;
    __device__ __forceinline__ void operator()(const f32x4 (&acc)[2][2][4][2], const Unit& u, int wr, int wc, int fr, int fq) const {
        const int row0 = u.pm * BM + wr * 64 + fr, col0 = u.pn * BM + wc * 32 + 8 * fq;
        bf16_t* Ob = (u.kh == 1) ? O2 : O;
#pragma unroll
        for (int ai = 0; ai < 2; ++ai)
#pragma unroll
            for (int m = 0; m < 4; ++m) { bf16_t* rowp = Ob + (size_t)(row0 + ai * HALF + m * 16) * ldc + col0;
#pragma unroll
                for (int bj = 0; bj < 2; ++bj) { const f32x4 v0 = acc[ai][bj][m][0], v1 = acc[ai][bj][m][1];
                    u32x4 w; w.x = cvt_pk_bf16(v0[0], v0[1]); w.y = cvt_pk_bf16(v0[2], v0[3]); w.z = cvt_pk_bf16(v1[0], v1[1]); w.w = cvt_pk_bf16(v1[2], v1[3]);
                    *(u32x4*)(rowp + bj * HALF) = w; } }
    }
};
struct EpiF32 {
    float* C; int ldc;
    __device__ __forceinline__ void operator()(const f32x4 (&acc)[2][2][4][2], const Unit& u, int wr, int wc, int fr, int fq) const {
        const int row0 = u.pm * BM + wr * 64 + fr, col0 = u.pn * BM + wc * 32 + 4 * fq;
#pragma unroll
        for (int ai = 0; ai < 2; ++ai)
#pragma unroll
            for (int m = 0; m < 4; ++m) { float* rowp = C + (size_t)(row0 + ai * HALF + m * 16) * ldc + col0;
#pragma unroll
                for (int bj = 0; bj < 2; ++bj)
#pragma unroll
                    for (int n = 0; n < 2; ++n) *(f32x4*)(rowp + bj * HALF + n * 16) = acc[ai][bj][m][n]; }
    }
};
struct EpiVT {
    bf16_t* VTs; bf16_t* VTp;
    __device__ __forceinline__ void operator()(const f32x4 (&acc)[2][2][4][2], const Unit& u, int wr, int wc, int fr, int fq) const {
        const int KR0 = u.pn * BM;
        bf16_t* vt; int Lk;
        if (KR0 < BS * LKS) { const int b = KR0 / LKS; Lk = LKS; vt = VTs + (size_t)b * 1024 * LKS + (KR0 - b * LKS); }
        else { const int b = (KR0 - BS * LKS) >> 8; Lk = LP; vt = VTp + (size_t)b * 1024 * LP; }
        const int row0 = u.pm * BM + wr * 64 + fr, col0 = wc * 32 + 8 * fq;
#pragma unroll
        for (int ai = 0; ai < 2; ++ai)
#pragma unroll
            for (int m = 0; m < 4; ++m) { bf16_t* rowp = vt + (size_t)(row0 + ai * HALF + m * 16) * Lk + col0;
#pragma unroll
                for (int bj = 0; bj < 2; ++bj) { const f32x4 v0 = acc[ai][bj][m][0], v1 = acc[ai][bj][m][1];
                    u32x4 w; w.x = cvt_pk_bf16(v0[0], v0[1]); w.y = cvt_pk_bf16(v0[2], v0[3]); w.z = cvt_pk_bf16(v1[0], v1[1]); w.w = cvt_pk_bf16(v1[2], v1[3]);
                    *(u32x4*)(rowp + bj * HALF) = w; } }
    }
};
template <int P> struct EpiGate {
    const bf16_t* gates; float* m32; bf16_t* mbf;
    __device__ __forceinline__ void operator()(const f32x4 (&acc)[2][2][4][2], const Unit& u, int wr, int wc, int fr, int fq) const {
        const int row0 = u.pm * BM + wr * 64 + fr, col0 = u.pn * BM + wc * 32 + 4 * fq;
#pragma unroll
        for (int ai = 0; ai < 2; ++ai)
#pragma unroll
            for (int m = 0; m < 4; ++m) {
                const size_t row = (size_t)(row0 + ai * HALF + m * 16);
#pragma unroll
                for (int bj = 0; bj < 2; ++bj)
#pragma unroll
                    for (int n = 0; n < 2; ++n) {
                        const int col = col0 + bj * HALF + n * 16;
                        const u32x2 gw = *(const u32x2*)(gates + row * GATE_LD + P * 2048 + col);
                        f32x4 v = acc[ai][bj][m][n];
                        v[0] *= sigmoidf_(bf_lo(gw.x)); v[1] *= sigmoidf_(bf_hi(gw.x)); v[2] *= sigmoidf_(bf_lo(gw.y)); v[3] *= sigmoidf_(bf_hi(gw.y));
                        float* mp = m32 + row * 2048 + col;
                        if (P == 0) { *(f32x4*)mp = v; }
                        else if (P == 1) { const f32x4 o = *(const f32x4*)mp; *(f32x4*)mp = o + v; }
                        else { const f32x4 o = *(const f32x4*)mp; v = v + o; u32x2 w; w.x = cvt_pk_bf16(v[0], v[1]); w.y = cvt_pk_bf16(v[2], v[3]); *(u32x2*)(mbf + row * 2048 + col) = w; }
                    }
            }
    }
};
}

template <class Epi>
__device__ __forceinline__ void run_gemm(int wv, LAS unsigned char* lds, const bf16_t* A, const bf16_t* Bt, int M, int N, int K, const Epi& E, bool split = false, int nMper = 1 << 28, size_t bstride = 0) {
    pg8::Gemm g; g.A = A; g.Bt = Bt; g.M = M; g.N = N; g.K = K; g.nMper = nMper; g.bstride = bstride;
    pg8::StaticOrder S; S.init(M, N, (int)gridDim.x, obid(), split);
    pg8::gemm_phase<Epi>(wv, lds, g, S, E);
    __syncthreads();
}

__device__ __forceinline__ void convT(int wv, const float* __restrict__ src, int K, int N, bf16_t* __restrict__ dst, int gate_shift, LAS unsigned char* lds) {
    const int tid = otid(wv), lane = tid & 63, kq = lane & 7, ng = lane >> 3;
    const int tn = N / 32, tk = K / 64, ntile = tn * tk, nwaves = gridDim.x * 8;
    for (int tile = obid() * 8 + (tid >> 6); tile < ntile; tile += 2 * nwaves) {
        const int tile2 = tile + nwaves; const bool has2 = tile2 < ntile;
        const int tkk = tile / tn, tnn = tile - tkk * tn, k0 = tkk * 64 + 8 * kq, n0 = tnn * 32 + 4 * ng;
        const int tkk2 = has2 ? tile2 / tn : tkk, tnn2 = has2 ? tile2 - tkk2 * tn : tnn, k02 = tkk2 * 64 + 8 * kq, n02 = tnn2 * 32 + 4 * ng;
        f32x4 v[8], v2[8];
#pragma unroll
        for (int i = 0; i < 8; ++i) v[i] = *(const f32x4*)(src + (size_t)(k0 + i) * N + n0);
#pragma unroll
        for (int i = 0; i < 8; ++i) v2[i] = *(const f32x4*)(src + (size_t)(k02 + i) * N + n02);
#pragma unroll
        for (int j = 0; j < 4; ++j) {
            int nd = n0 + j; if (gate_shift == 1 && nd >= NGATE0) nd += 192; if (gate_shift == 2) { const int hd = nd >> 8, wi = nd & 255; nd = (wi < 128) ? hd * 128 + wi : 1024 + hd * 128 + (wi - 128); }
            u32x4 w; w.x = cvt_pk_bf16(v[0][j], v[1][j]); w.y = cvt_pk_bf16(v[2][j], v[3][j]); w.z = cvt_pk_bf16(v[4][j], v[5][j]); w.w = cvt_pk_bf16(v[6][j], v[7][j]);
            *(u32x4*)(dst + (size_t)nd * K + k0) = w;
        }
        if (has2) {
#pragma unroll
            for (int j = 0; j < 4; ++j) {
                int nd = n02 + j; if (gate_shift == 1 && nd >= NGATE0) nd += 192; if (gate_shift == 2) { const int hd = nd >> 8, wi = nd & 255; nd = (wi < 128) ? hd * 128 + wi : 1024 + hd * 128 + (wi - 128); }
                u32x4 w; w.x = cvt_pk_bf16(v2[0][j], v2[1][j]); w.y = cvt_pk_bf16(v2[2][j], v2[3][j]); w.z = cvt_pk_bf16(v2[4][j], v2[5][j]); w.w = cvt_pk_bf16(v2[6][j], v2[7][j]);
                *(u32x4*)(dst + (size_t)nd * K + k02) = w;
            }
        }
    }
}

__device__ __forceinline__ void ada_phase(int wv, const Params& p, LAS unsigned char* lds) {
    LAS float* sl = (LAS float*)lds;
    float* mod = (float*)(p.ws + S_MOD);
    const int tid = otid(wv);
    for (int u = obid(); u < NLAYER * 6 * 16; u += gridDim.x) {
        const int l = u / 96, r = u % 96, cb = r % 6, kc = r / 6, k0 = kc * 128;
        for (int i = tid; i < 9 * 128; i += NTHREADS) { const int v = i >> 7, k = i & 127; const float x = (v == 0) ? p.in[I_CCTX][k0 + k] : p.in[I_C][(v - 1) * DM + k0 + k]; sl[i] = siluf_(x); }
        __syncthreads();
        const int col = cb * 2048 + tid * 4;
        f32x4 acc[9];
#pragma unroll
        for (int i = 0; i < 9; ++i) acc[i] = (f32x4){0.f, 0.f, 0.f, 0.f};
        const float* wp = p.in[I_ADAW] + ((size_t)l * DM + k0) * 12288 + col;
#pragma unroll 8
        for (int k = 0; k < 128; ++k) {
            const f32x4 w = *(const f32x4*)(wp + (size_t)k * 12288);
#pragma unroll
            for (int i = 0; i < 9; ++i) acc[i] += sl[i * 128 + k] * w;
        }
#pragma unroll
        for (int i = 0; i < 9; ++i) *(f32x4*)(mod + ((size_t)(l * 16 + kc) * 9 + i) * 12288 + col) = acc[i];
        __syncthreads();
    }
}

__device__ __forceinline__ void filter_phase(int wv, const Params& p, int l, LAS unsigned char* lds) {
    LAS float* z = (LAS float*)lds;
    LAS float* H1 = z + 32 * 33;
    LAS float* H2 = H1 + 32 * 64;
    LAS float* W1 = H2 + 32 * 64;
    LAS float* W2 = W1 + 33 * 64;
    LAS float* BF = W2 + 64 * 64;
    const int tid = otid(wv);
    const float* w3 = p.in[I_FW3] + (size_t)l * 64 * 2048; const float* b3 = p.in[I_FB3] + l * 2048;
    for (int u = obid(); u < 72; u += gridDim.x) {
        const int g = (u < 64) ? 1 : 0; const int tc = g ? u : u - 64; const int L = g ? LS : LP; const int t0 = tc * 32;
        float* kT = (float*)(p.ws + (g ? S_KTS : S_KTP)); float* part = (float*)(p.ws + (g ? S_PARTS : S_PARTP));
        for (int i = tid; i < 33 * 64; i += NTHREADS) W1[i] = p.in[I_FW1][(size_t)l * 33 * 64 + i];
        for (int i = tid; i < 64 * 64; i += NTHREADS) W2[i] = p.in[I_FW2][(size_t)l * 64 * 64 + i];
        if (tid < 64) BF[tid] = p.in[I_FB1][l * 64 + tid]; else if (tid < 128) BF[tid] = p.in[I_FB2][l * 64 + tid - 64]; else if (tid < 256) BF[tid] = p.in[I_FFREQ][l * 128 + tid - 128];
        for (int i = tid; i < 32 * 33; i += NTHREADS) {
            const int t = i / 33, e = i - t * 33; const float tf = (float)(t0 + t);
            float v;
            if (e == 0) v = tf / (float)(L - 1);
            else { const int k = (e - 1) & 15; const float band = 1e-4f + (float)k * ((15.0f - 1e-4f) / 15.0f); const float w = (6.283185307179586f * tf) / (float)L; const float ang = w * band;
                   v = (e <= 16) ? cosf(ang) : -sinf(ang); }
            z[i] = v;
        }
        __syncthreads();
#pragma unroll
        for (int q = 0; q < 4; ++q) { const int i = tid + q * NTHREADS; const int t = i >> 6, j = i & 63; float s = BF[j];
#pragma unroll
            for (int e = 0; e < 33; ++e) s += z[t * 33 + e] * W1[e * 64 + j];
            H1[i] = sinf(BF[128 + j] * s); }
        __syncthreads();
#pragma unroll
        for (int q = 0; q < 4; ++q) { const int i = tid + q * NTHREADS; const int t = i >> 6, j = i & 63; float s = BF[64 + j];
#pragma unroll 16
            for (int e = 0; e < 64; ++e) s += H1[t * 64 + e] * W2[e * 64 + j];
            H2[i] = sinf(BF[192 + j] * s); }
        __syncthreads();
        const int c = tid * 4;
        const f32x4 bias = *(const f32x4*)(b3 + c);
        f32x4 delta;
#pragma unroll
        for (int j = 0; j < 4; ++j) { const int d = (c + j) & 1023; const float mn = -3.0701134573253945f, mx = -15.350567286626973f; delta[j] = fabsf(mn + (float)d * ((mx - mn) / 1023.0f)); }
        f32x4 psum = (f32x4){0.f, 0.f, 0.f, 0.f};
        for (int tb = 0; tb < 2; ++tb) {
            f32x4 acc[16];
#pragma unroll
            for (int i = 0; i < 16; ++i) acc[i] = bias;
#pragma unroll 8
            for (int k = 0; k < 64; ++k) {
                const f32x4 w = *(const f32x4*)(w3 + (size_t)k * 2048 + c);
#pragma unroll
                for (int i = 0; i < 16; ++i) acc[i] += H2[(tb * 16 + i) * 64 + k] * w;
            }
#pragma unroll
            for (int i = 0; i < 16; ++i) {
                const int t = t0 + tb * 16 + i; const float tn = (float)t / (float)(L - 1);
#pragma unroll
                for (int j = 0; j < 4; ++j) {
                    const float v = acc[i][j] * __expf(-tn * delta[j]);
                    const int cc = c + j;
                    if (cc < 1024) { kT[(size_t)cc * (2 * L) + t] = v; psum[j] += fabsf(v); }
                    else { const int d = cc - 1024; if (t == 0) kT[(size_t)d * (2 * L) + L] = 0.f; else { kT[(size_t)d * (2 * L) + 2 * L - t] = v; psum[j] += fabsf(v); } }
                }
            }
        }
        *(f32x4*)(part + (size_t)tc * 2048 + c) = psum;
        __syncthreads();
    }
}

__device__ __forceinline__ void row_sel(const Params& p, int l, int mode, int& l2, int& shi, int& sci, const float*& prew, bool& wh, int& gi, const float*& pw) {
    wh = true;
    if (mode == 0) { l2 = l; shi = 0; sci = 1; prew = p.in[I_NMPRE] + l * DM; }
    else if (mode == 1) { l2 = l; shi = 3; sci = 4; prew = p.in[I_NFPRE] + l * DM; }
    else { l2 = l + 1; shi = 0; sci = 1; wh = (l + 1 < NLAYER); if (!wh) l2 = l; prew = p.in[I_NMPRE] + l2 * DM; }
    gi = (mode == 1) ? 2 : 5;
    pw = p.in[mode == 1 ? I_NMPOST : I_NFPOST] + l * DM;
}
__device__ __forceinline__ void comb_phase(int wv, const Params& p) {
    const int tid = otid(wv);
    const float* mod = (const float*)(p.ws + S_MOD); float* comb = (float*)(p.ws + S_COMB);
    for (int idx = obid() * NTHREADS + tid; idx < NLAYER * 3 * 9 * 2048; idx += gridDim.x * NTHREADS) {
        const int c = idx & 2047, q = idx >> 11, mi = q % 9, q2 = q / 9, mode = q2 % 3, l = q2 / 3;
        int l2, shi, sci, gi; const float* prew; const float* pw; bool wh;
        row_sel(p, l, mode, l2, shi, sci, prew, wh, gi, pw);
        float g = 0.f, sc = 0.f, sh = 0.f;
        for (int kc = 0; kc < 16; ++kc) {
            g += mod[((size_t)(l * 16 + kc) * 9 + mi) * 12288 + gi * 2048 + c];
            sc += mod[((size_t)(l2 * 16 + kc) * 9 + mi) * 12288 + sci * 2048 + c];
            sh += mod[((size_t)(l2 * 16 + kc) * 9 + mi) * 12288 + shi * 2048 + c];
        }
        g += p.in[I_ADAB][(size_t)l * 12288 + gi * 2048 + c];
        sc += p.in[I_ADAB][(size_t)l2 * 12288 + sci * 2048 + c];
        sh += p.in[I_ADAB][(size_t)l2 * 12288 + shi * 2048 + c];
        float* o = comb + (size_t)q * 3 * 2048 + c;
        o[0] = g * pw[c]; o[2048] = prew[c] * (1.0f + sc); o[4096] = sh;
    }
}
__device__ __forceinline__ void row_phase(int wv, const Params& p, int l, int mode) {
    const int tid = otid(wv); const int wave = obid() * 8 + (tid >> 6), nw = gridDim.x * 8, lane = tid & 63;
    float* X = p.out;
    bf16_t* H = (bf16_t*)(p.ws + A_H);
    const bool wh = !(mode == 2 && l + 1 >= NLAYER);
    const int rows_per = (MT + nw - 1) / nw;
    for (int rr = 0; rr < rows_per; ++rr) {
        const int row = wave * rows_per + rr;
        if (row >= MT) break;
        const int mi = row < MP ? 0 : 1 + ((row - MP) >> 11);
        const float* cb = (const float*)(p.ws + S_COMB) + (size_t)((l * 3 + mode) * 9 + mi) * 3 * 2048 + lane * 4;
        f32x4 x[8];
        const float* xs = (mode == 0) ? (row < MP ? p.in[I_XP] + (size_t)row * DM : p.in[I_XS] + (size_t)(row - MP) * DM) : X + (size_t)row * DM;
#pragma unroll
        for (int i = 0; i < 8; ++i) x[i] = *(const f32x4*)(xs + i * 256 + lane * 4);
        if (mode != 0) {
            const bf16_t* o = (const bf16_t*)(p.ws + (mode == 1 ? A_M32 : A_F32)) + (size_t)row * DM;
            const unsigned tm = ((const unsigned*)(p.ws + S_TAIL))[row >> 8];
            f32x4 ovv[8]; float ss = 0.f;
#pragma unroll
            for (int i = 0; i < 8; ++i) { const u32x2 w = *(const u32x2*)(o + i * 256 + lane * 4); ovv[i] = (f32x4){bf_lo(w.x), bf_hi(w.x), bf_lo(w.y), bf_hi(w.y)};
                if ((tm >> i) & 1u) { const u32x2 w2 = *(const u32x2*)(o + (size_t)MT * DM + i * 256 + lane * 4); ovv[i] += (f32x4){bf_lo(w2.x), bf_hi(w2.x), bf_lo(w2.y), bf_hi(w2.y)}; }
                ss += ovv[i][0] * ovv[i][0] + ovv[i][1] * ovv[i][1] + ovv[i][2] * ovv[i][2] + ovv[i][3] * ovv[i][3]; }
            ss = wave_sum(ss, lane);
            const float rstd = rsqrtf(ss * (1.0f / DM) + 1e-6f);
#pragma unroll
            for (int i = 0; i < 8; ++i) x[i] += *(const f32x4*)(cb + i * 256) * (ovv[i] * rstd);
        }
#pragma unroll
        for (int i = 0; i < 8; ++i) *(f32x4*)(X + (size_t)row * DM + i * 256 + lane * 4) = x[i];
        if (wh) {
            float ss = 0.f;
#pragma unroll
            for (int i = 0; i < 8; ++i) ss += x[i][0] * x[i][0] + x[i][1] * x[i][1] + x[i][2] * x[i][2] + x[i][3] * x[i][3];
            ss = wave_sum(ss, lane);
            const float rstd = rsqrtf(ss * (1.0f / DM) + 1e-6f);
#pragma unroll
            for (int i = 0; i < 8; ++i) {
                const f32x4 hv = (x[i] * rstd) * *(const f32x4*)(cb + 2048 + i * 256) + *(const f32x4*)(cb + 4096 + i * 256);
                u32x2 o; o.x = cvt_pk_bf16(hv[0], hv[1]); o.y = cvt_pk_bf16(hv[2], hv[3]);
                *(u32x2*)(H + (size_t)row * DM + i * 256 + lane * 4) = o;
            }
        }
    }
}

__device__ __forceinline__ void rope_table_phase(int wv, const Params& p) {
    float* C = (float*)(p.ws + S_ROPE); float* Sn = C + 2048 * 32;
    const int tid = otid(wv);
    for (int idx = obid() * NTHREADS + tid; idx < 2048 * 32; idx += gridDim.x * NTHREADS) {
        const int t = idx >> 5, i = idx & 31, k = i & 15;
        const float inv = exp2f(-(float)k * 0.8304820237218406f);
        const float pos = (i < 16) ? (float)(t >> 6) : (float)(t & 63);
        const float ang = pos * inv; C[idx] = cosf(ang); Sn[idx] = sinf(ang);
    }
}
__device__ __forceinline__ void e2_phase(int wv, const Params& p, int l, LAS unsigned char* lds) {
    const bf16_t* PA = (const bf16_t*)(p.ws + A_PROJA);
    const int tid = otid(wv), lane = tid & 63;
    {
        const int gidx = obid() * NTHREADS + tid;
        if (gidx < 2048) {
            const int g = gidx >> 10, d = gidx & 1023; const int NU = g ? 64 : 8;
            const float* part = (const float*)(p.ws + (g ? S_PARTS : S_PARTP));
            float tot = 0.f;
            for (int i = 0; i < NU; ++i) tot += part[i * 2048 + d] + part[i * 2048 + 1024 + d];
            ((float*)(p.ws + S_SCALE))[gidx] = 1.0f / tot;
        }
    }
    {
        bf16_t* CQN = (bf16_t*)(p.ws + A_CQN); bf16_t* KC = (bf16_t*)(p.ws + A_KEYSC); bf16_t* KP = (bf16_t*)(p.ws + A_KPER);
        float* out_ckv = p.out + (size_t)MT * DM; float* out_kpe = out_ckv + (size_t)BP * NLAYER * LP * 256;
        const int wave = obid() * 8 + (tid >> 6), nw = gridDim.x * 8;
        for (int row = wave; row < MT + BS * PAST; row += nw) {
            if (row < MT) {
                const bf16_t* pr = PA + (size_t)row * PA_LD;
                { const u32x4 v = *(const u32x4*)(pr + 3072 + lane * 8); float f[8]; unpack8(v, f); float ss = 0.f;
#pragma unroll
                  for (int j = 0; j < 8; ++j) ss += f[j] * f[j];
                  ss = wave_sum(ss, lane); const float rstd = rsqrtf(ss * (1.0f / 512.0f) + 1e-6f);
                  const float* qn = p.in[I_QN] + l * 512 + lane * 8;
#pragma unroll
                  for (int j = 0; j < 8; ++j) f[j] = f[j] * rstd * qn[j];
                  *(u32x4*)(CQN + (size_t)row * 512 + lane * 8) = pack8(f); }
                int KR, t; const bool isp = row < MP; int b;
                if (isp) { b = row >> 8; t = row & 255; KR = BS * LKS + row; } else { const int r2 = row - MP; b = r2 >> 11; t = r2 & 2047; KR = b * LKS + t; }
                { const u32x2 v = *(const u32x2*)(pr + 3584 + lane * 4); float f[4] = {bf_lo(v.x), bf_hi(v.x), bf_lo(v.y), bf_hi(v.y)};
                  float ss = f[0] * f[0] + f[1] * f[1] + f[2] * f[2] + f[3] * f[3]; ss = wave_sum(ss, lane); const float rstd = rsqrtf(ss * (1.0f / 256.0f) + 1e-6f);
                  const float* kn = p.in[I_KVN] + l * 256 + lane * 4;
#pragma unroll
                  for (int j = 0; j < 4; ++j) f[j] = f[j] * rstd * kn[j];
                  if (isp) *(f32x4*)(out_ckv + ((size_t)(b * NLAYER + l) * LP + t) * 256 + lane * 4) = (f32x4){f[0], f[1], f[2], f[3]};
                  u32x2 w; w.x = cvt_pk_bf16(f[0], f[1]); w.y = cvt_pk_bf16(f[2], f[3]); *(u32x2*)(KC + (size_t)KR * 256 + lane * 4) = w; }
                { const float v = __uint_as_float(((unsigned)pr[3840 + lane]) << 16);
                  float o = v;
                  if (isp) out_kpe[((size_t)(b * NLAYER + l) * LP + t) * 64 + lane] = v;
                  else { const float pv = shx(v, 32, lane); const float* rc = (const float*)(p.ws + S_ROPE); const float cs = rc[t * 32 + (lane & 31)], sn = rc[2048 * 32 + t * 32 + (lane & 31)]; o = (lane < 32) ? (v * cs - pv * sn) : (pv * sn + v * cs); }
                  KP[(size_t)KR * 64 + lane] = f2bf(o); }
            } else {
                const int r2 = row - MT, b = r2 >> 9, j = r2 & 511; const int KR = b * LKS + LS + j;
                const float* cc = p.in[I_CCKV] + ((size_t)(b * NLAYER + l) * PAST + j) * 256 + lane * 4;
                const f32x4 v = *(const f32x4*)cc; u32x2 w; w.x = cvt_pk_bf16(v[0], v[1]); w.y = cvt_pk_bf16(v[2], v[3]); *(u32x2*)(KC + (size_t)KR * 256 + lane * 4) = w;
                KP[(size_t)KR * 64 + lane] = f2bf(p.in[I_CKPE][((size_t)(b * NLAYER + l) * PAST + j) * 64 + lane]);
            }
        }
    }
    {
        bf16_t* YC = (bf16_t*)(p.ws + A_YC); const float* scw = p.in[I_SCW] + (size_t)l * 3 * 1024;
        for (int it = obid() * NTHREADS + tid; it < (MT / 4) * 128; it += gridDim.x * NTHREADS) {
            const int ch = it >> 7, d0 = (it & 127) * 8, row0 = ch * 4;
            const int t0 = row0 < MP ? (row0 & 255) : ((row0 - MP) & 2047); const int L = row0 < MP ? LP : LS;
            float w0[8], w1[8], w2[8];
            { const f32x4 a = *(const f32x4*)(scw + d0), b = *(const f32x4*)(scw + d0 + 4), c = *(const f32x4*)(scw + 1024 + d0), d = *(const f32x4*)(scw + 1024 + d0 + 4),
                          e2 = *(const f32x4*)(scw + 2048 + d0), f = *(const f32x4*)(scw + 2048 + d0 + 4);
#pragma unroll
              for (int j = 0; j < 4; ++j) { w0[j] = a[j]; w0[4 + j] = b[j]; w1[j] = c[j]; w1[4 + j] = d[j]; w2[j] = e2[j]; w2[4 + j] = f[j]; } }
            const bf16_t* pr = PA + (size_t)row0 * PA_LD;
            float pp[8], pc[8], pn[8];
#pragma unroll
            for (int j = 0; j < 8; ++j) pp[j] = 0.f;
            if (t0 > 0) { float cg[8], uu[8]; unpack8(*(const u32x4*)(pr - PA_LD + 4928 + d0), cg); unpack8(*(const u32x4*)(pr - PA_LD + 5952 + d0), uu);
#pragma unroll
                for (int j = 0; j < 8; ++j) pp[j] = cg[j] * uu[j]; }
            { float cg[8], uu[8]; unpack8(*(const u32x4*)(pr + 4928 + d0), cg); unpack8(*(const u32x4*)(pr + 5952 + d0), uu);
#pragma unroll
              for (int j = 0; j < 8; ++j) pc[j] = cg[j] * uu[j]; }
#pragma unroll
            for (int i = 0; i < 4; ++i) {
#pragma unroll
                for (int j = 0; j < 8; ++j) pn[j] = 0.f;
                if (t0 + i + 1 < L) { float cg[8], uu[8]; unpack8(*(const u32x4*)(pr + (size_t)(i + 1) * PA_LD + 4928 + d0), cg); unpack8(*(const u32x4*)(pr + (size_t)(i + 1) * PA_LD + 5952 + d0), uu);
#pragma unroll
                    for (int j = 0; j < 8; ++j) pn[j] = cg[j] * uu[j]; }
                float bg[8], o[8]; unpack8(*(const u32x4*)(pr + (size_t)i * PA_LD + 3904 + d0), bg);
#pragma unroll
                for (int j = 0; j < 8; ++j) { o[j] = bg[j] * (w0[j] * pp[j] + w1[j] * pc[j] + w2[j] * pn[j]); pp[j] = pc[j]; pc[j] = pn[j]; }
                *(u32x4*)(YC + (size_t)(row0 + i) * 1024 + d0) = pack8(o);
            }
        }
    }
    {
        bf16_t* X0S = (bf16_t*)(p.ws + A_X0S); bf16_t* ZZT = (bf16_t*)(p.ws + A_ZZT);
        const float* hw = p.in[I_HCW] + (size_t)l * 3 * 3072; const float* hb = p.in[I_HCB] + (size_t)l * 3072;
        LAS bf16_t* zt = (LAS bf16_t*)lds;
        for (int u = obid(); u < (MT / 256) * 16; u += gridDim.x) {
            const int rt = u >> 4, dt = u & 15; const int row0 = rt * 256;
            const int dg = tid & 7, rb = tid >> 3, d0 = dt * 64 + dg * 8; const int rowb = row0 + rb * 4;
            const int L = row0 < MP ? LP : LS; const int tb = (row0 < MP ? (row0 & 255) : ((row0 - MP) & 2047)) + rb * 4;
            float wgt[3][3][8], bs[3][8];
#pragma unroll
            for (int g = 0; g < 3; ++g) {
#pragma unroll
                for (int o = 0; o < 3; ++o) { const f32x4 a = *(const f32x4*)(hw + o * 3072 + g * 1024 + d0), b = *(const f32x4*)(hw + o * 3072 + g * 1024 + d0 + 4);
#pragma unroll
                    for (int j = 0; j < 4; ++j) { wgt[g][o][j] = a[j]; wgt[g][o][4 + j] = b[j]; } }
                const f32x4 a = *(const f32x4*)(hb + g * 1024 + d0), b = *(const f32x4*)(hb + g * 1024 + d0 + 4);
#pragma unroll
                for (int j = 0; j < 4; ++j) { bs[g][j] = a[j]; bs[g][4 + j] = b[j]; }
            }
            const bf16_t* pr = PA + (size_t)rowb * PA_LD + d0;
            u32x4 wp[3], wc[3], wn[3];
#pragma unroll
            for (int g = 0; g < 3; ++g) { wp[g] = (u32x4){0u, 0u, 0u, 0u}; if (tb > 0) wp[g] = *(const u32x4*)(pr - PA_LD + g * 1024); wc[g] = *(const u32x4*)(pr + g * 1024); }
#pragma unroll
            for (int i = 0; i < 4; ++i) {
#pragma unroll
                for (int g = 0; g < 3; ++g) { wn[g] = (u32x4){0u, 0u, 0u, 0u}; if (tb + i + 1 < L) wn[g] = *(const u32x4*)(pr + (size_t)(i + 1) * PA_LD + g * 1024); }
                float hv[3][8];
#pragma unroll
                for (int g = 0; g < 3; ++g) { float a[8], b[8], c[8]; unpack8(wp[g], a); unpack8(wc[g], b); unpack8(wn[g], c);
#pragma unroll
                    for (int j = 0; j < 8; ++j) hv[g][j] = bs[g][j] + wgt[g][0][j] * a[j] + wgt[g][1][j] * b[j] + wgt[g][2][j] * c[j];
                    wp[g] = wc[g]; wc[g] = wn[g]; }
                *(u32x4*)(X0S + (size_t)(rowb + i) * 1024 + d0) = pack8(hv[0]);
#pragma unroll
                for (int j = 0; j < 8; ++j) zt[(dg * 8 + j) * 264 + rb * 4 + i] = f2bf(hv[1][j] * hv[2][j]);
            }
            __syncthreads();
#pragma unroll
            for (int i = 0; i < 4; ++i) {
                const int chunk = tid + i * NTHREADS; const int dl = chunk >> 5, tch = chunk & 31; const int d = dt * 64 + dl;
                size_t base; int t0;
                if (row0 < MP) { const int b = row0 >> 8; t0 = 0; base = ((size_t)b * 1024 + d) * LP; }
                else { const int r2 = row0 - MP; const int b = r2 >> 11; t0 = r2 & 2047; base = (size_t)BP * 1024 * LP + ((size_t)b * 1024 + d) * LS; }
                *(u32x4*)(ZZT + base + t0 + tch * 8) = *(const LAS u32x4*)(zt + dl * 264 + tch * 8);
            }
            __syncthreads();
        }
    }
}

__device__ __forceinline__ void conv_phase(int wv, const Params& p, int l, LAS unsigned char* lds) {
    const int tid = otid(wv), wid = tid >> 6, lane = tid & 63, r = lane & 31, hh = lane >> 5;
    const bf16_t* ZZT = (const bf16_t*)(p.ws + A_ZZT); bf16_t* YCT = (bf16_t*)(p.ws + A_YCT);
    const float* hbias = p.in[I_HBIAS] + l * 1024;
    LAS bf16_t* cp = (LAS bf16_t*)lds;
    LAS bf16_t* zz = (LAS bf16_t*)(lds + 65536);
    LAS float* kf = (LAS float*)(lds + 98304);
    for (int u = obid(); u < 2048; u += gridDim.x) {
        const int g = (u < 1024) ? 1 : 0, d = u & 1023;
        const int L = g ? LS : LP, B = g ? BS : BP, L2 = 2 * L, NB = L / 32, NI = 32 / B, NT = NB / NI, lgB = g ? 3 : 4;
        const float* kT = (const float*)(p.ws + (g ? S_KTS : S_KTP)) + (size_t)d * L2;
        const float scale = ((const float*)(p.ws + S_SCALE))[g * 1024 + d]; const float bias = hbias[d];
        for (int i = tid; i < L2 / 4; i += NTHREADS) { f32x4 v = *(const f32x4*)(kT + i * 4); v *= scale; if (i == 0) v[0] += bias; *(LAS f32x4*)(kf + i * 4) = v; }
        const size_t zbase = g ? (size_t)BP * 1024 * LP : 0;
        for (int ch = tid; ch < B * L / 8; ch += NTHREADS) {
            const int b = ch / (L / 8), s8 = ch - b * (L / 8);
            *(LAS u32x4*)(zz + b * L + s8 * 8) = *(const u32x4*)(ZZT + zbase + ((size_t)b * 1024 + d) * L + s8 * 8);
        }
        __syncthreads();
        for (int ck = tid; ck < L2; ck += NTHREADS) {
            const int c = ck / (L2 / 8), m0 = (ck - c * (L2 / 8)) * 8;
            float f[8];
#pragma unroll
            for (int j = 0; j < 8; ++j) f[j] = kf[(L2 - (m0 + c + j)) & (L2 - 1)];
            *(LAS u32x4*)(cp + c * L2 + m0) = pack8(f);
        }
        __syncthreads();
        const int Iloc = r >> lgB, b = r & (B - 1);
        for (int nt = wid * 2; nt < NT; nt += 16) {
            const int I0 = nt * NI;
            f32x16 acc0, acc1;
#pragma unroll
            for (int i = 0; i < 16; ++i) { acc0[i] = 0.f; acc1[i] = 0.f; }
            for (int dl = I0 - (NB - 1); dl <= I0 + 2 * NI - 1; ++dl) {
                const int J0 = I0 + Iloc - dl, J1 = J0 + NI; const bool v0 = (J0 >= 0) && (J0 < NB), v1 = (J1 >= 0) && (J1 < NB);
#pragma unroll
                for (int ks = 0; ks < 2; ++ks) {
                    const int i0 = (16 * ks + 8 * hh - 32 * dl - r) & (L2 - 1); const int c = i0 & 7, q = i0 >> 3;
                    const bf16x8 Af = *(const LAS bf16x8*)(cp + c * L2 + q * 8);
                    bf16x8 B0 = (bf16x8){0, 0, 0, 0, 0, 0, 0, 0}, B1 = B0;
                    if (v0) B0 = *(const LAS bf16x8*)(zz + b * L + 32 * J0 + 16 * ks + 8 * hh);
                    if (v1) B1 = *(const LAS bf16x8*)(zz + b * L + 32 * J1 + 16 * ks + 8 * hh);
                    acc0 = __builtin_amdgcn_mfma_f32_32x32x16_bf16(Af, B0, acc0, 0, 0, 0);
                    acc1 = __builtin_amdgcn_mfma_f32_32x32x16_bf16(Af, B1, acc1, 0, 0, 0);
                }
            }
            bf16_t* op = YCT + zbase + ((size_t)b * 1024 + d) * L + 32 * (I0 + Iloc) + 4 * hh;
#pragma unroll
            for (int g4 = 0; g4 < 4; ++g4) {
                u32x2 w; w.x = cvt_pk_bf16(acc0[4 * g4], acc0[4 * g4 + 1]); w.y = cvt_pk_bf16(acc0[4 * g4 + 2], acc0[4 * g4 + 3]); *(u32x2*)(op + 8 * g4) = w;
                u32x2 w1; w1.x = cvt_pk_bf16(acc1[4 * g4], acc1[4 * g4 + 1]); w1.y = cvt_pk_bf16(acc1[4 * g4 + 2], acc1[4 * g4 + 3]); *(u32x2*)(op + 32 * NI + 8 * g4) = w1;
            }
        }
        __syncthreads();
    }
}

__device__ __forceinline__ void e3b_phase(int wv, const Params& p, LAS unsigned char* lds) {
    const int tid = otid(wv);
    const bf16_t* X0S = (const bf16_t*)(p.ws + A_X0S); const bf16_t* YCT = (const bf16_t*)(p.ws + A_YCT); bf16_t* YA = (bf16_t*)(p.ws + A_YA);
    LAS bf16_t* yt = (LAS bf16_t*)lds;
    for (int u = obid(); u < (MT / 64) * 16; u += gridDim.x) {
        const int rt = u >> 4, dt = u & 15; const int row0 = rt * 64;
        {
            const int dl = tid >> 3, tch = tid & 7; const int d = dt * 64 + dl;
            size_t base; int t0;
            if (row0 < MP) { const int b = row0 >> 8; t0 = row0 & 255; base = ((size_t)b * 1024 + d) * LP; }
            else { const int r2 = row0 - MP; const int b = r2 >> 11; t0 = r2 & 2047; base = (size_t)BP * 1024 * LP + ((size_t)b * 1024 + d) * LS; }
            const u32x4 v = *(const u32x4*)(YCT + base + t0 + tch * 8);
            const unsigned w[4] = {v.x, v.y, v.z, v.w};
#pragma unroll
            for (int j = 0; j < 4; ++j) { yt[(tch * 8 + 2 * j) * 72 + dl] = (bf16_t)(w[j] & 0xffffu); yt[(tch * 8 + 2 * j + 1) * 72 + dl] = (bf16_t)(w[j] >> 16); }
        }
        __syncthreads();
        {
            const int tl = tid >> 3, dg = tid & 7; const int row = row0 + tl, d0 = dt * 64 + dg * 8;
            float a[8], b[8]; unpack8(*(const LAS u32x4*)(yt + tl * 72 + dg * 8), a); unpack8(*(const u32x4*)(X0S + (size_t)row * 1024 + d0), b);
#pragma unroll
            for (int j = 0; j < 8; ++j) a[j] *= b[j];
            *(u32x4*)(YA + (size_t)row * 1024 + d0) = pack8(a);
        }
        __syncthreads();
    }
}

__device__ __forceinline__ void attn_phase(int wv, const Params& p, LAS unsigned char* lds) {
    const bf16_t* Q = (const bf16_t*)(p.ws + A_Q); const bf16_t* KN = (const bf16_t*)(p.ws + A_KN); const bf16_t* KP = (const bf16_t*)(p.ws + A_KPER);
    const bf16_t* VT = (const bf16_t*)(p.ws + A_VT); bf16_t* O = (bf16_t*)(p.ws + A_OATT);
    LAS unsigned char* Ks = lds;
    LAS unsigned char* Vs = lds + 64 * 400;
    const float sc2 = 0.07216878364870322f * 1.4426950408889634f;
    for (int u = obid(); u < 512 + 128; u += gridDim.x) {
        const int tid = otid(wv), wid = tid >> 6, lane = tid & 63, r = lane & 31, hh = lane >> 5;
        int b, h, row0, Lk, KR0; size_t vtb; bool samp;
        if (u < 512) { samp = true; b = u >> 6; h = (u >> 3) & 7; const int qb = u & 7; row0 = MP + b * LS + qb * 256; Lk = LKS; KR0 = b * LKS; vtb = (size_t)(b * 8 + h) * 128 * LKS; }
        else { samp = false; const int u2 = u - 512; b = u2 >> 3; h = u2 & 7; row0 = b * LP; Lk = LP; KR0 = BS * LKS + b * LP; vtb = (size_t)BS * 8 * 128 * LKS + (size_t)(b * 8 + h) * 128 * LP; }
        const int qrow = row0 + wid * 32 + r;
        bf16x8 qf[12];
        {
            const bf16_t* qp = Q + (size_t)qrow * 1536 + h * 192 + 8 * hh;
            u32x4 qv[12];
#pragma unroll
            for (int s = 0; s < 12; ++s) qv[s] = *(const u32x4*)(qp + 16 * s);
            if (samp) {
                const int t = (qrow - MP) & 2047;
#pragma unroll
                for (int s2 = 0; s2 < 2; ++s2) {
                    float x1[8], x2[8]; unpack8(qv[8 + s2], x1); unpack8(qv[10 + s2], x2);
                    const float* rc = (const float*)(p.ws + S_ROPE) + t * 32 + 16 * s2 + 8 * hh;
                    const f32x4 c0 = *(const f32x4*)rc, c1 = *(const f32x4*)(rc + 4), s0 = *(const f32x4*)(rc + 2048 * 32), s1 = *(const f32x4*)(rc + 2048 * 32 + 4);
#pragma unroll
                    for (int j = 0; j < 8; ++j) { const float cs = (j < 4) ? c0[j & 3] : c1[j & 3], sn = (j < 4) ? s0[j & 3] : s1[j & 3]; const float a = x1[j], c = x2[j]; x1[j] = a * cs - c * sn; x2[j] = a * sn + c * cs; }
                    qv[8 + s2] = pack8(x1); qv[10 + s2] = pack8(x2);
                }
            }
#pragma unroll
            for (int s = 0; s < 12; ++s) qf[s] = __builtin_bit_cast(bf16x8, qv[s]);
        }
        f32x16 oacc[4];
#pragma unroll
        for (int ct = 0; ct < 4; ++ct)
#pragma unroll
            for (int i = 0; i < 16; ++i) oacc[ct][i] = 0.f;
        float mrun = -1e30f, lrun = 0.f;
        const int nkt = Lk / 64;
        u32x4 kst[3], vst[2];
#pragma unroll
        for (int i = 0; i < 3; ++i) { const int ck = tid + i * NTHREADS; const int key = ck / 24, part = ck - key * 24;
            kst[i] = (part < 16) ? *(const u32x4*)(KN + (size_t)(KR0 + key) * 1024 + h * 128 + part * 8) : *(const u32x4*)(KP + (size_t)(KR0 + key) * 64 + (part - 16) * 8); }
#pragma unroll
        for (int i = 0; i < 2; ++i) { const int cv = tid + i * NTHREADS; const int v = cv >> 3, kc = cv & 7; vst[i] = *(const u32x4*)(VT + vtb + (size_t)v * Lk + kc * 8); }
        for (int kt = 0; kt < nkt; ++kt) {
            __syncthreads();
#pragma unroll
            for (int i = 0; i < 3; ++i) { const int ck = tid + i * NTHREADS; const int key = ck / 24, part = ck - key * 24; *(LAS u32x4*)(Ks + key * 400 + part * 16) = kst[i]; }
#pragma unroll
            for (int i = 0; i < 2; ++i) { const int cv = tid + i * NTHREADS; const int v = cv >> 3, kc = cv & 7;
                LAS unsigned char* vp = Vs + v * 144 + (kc >> 1) * 32 + (kc & 1) * 8;
                *(LAS u32x2*)vp = (u32x2){vst[i].x, vst[i].y}; *(LAS u32x2*)(vp + 16) = (u32x2){vst[i].z, vst[i].w}; }
            __syncthreads();
            if (kt + 1 < nkt) {
                const int k0 = (kt + 1) * 64;
#pragma unroll
                for (int i = 0; i < 3; ++i) { const int ck = tid + i * NTHREADS; const int key = ck / 24, part = ck - key * 24;
                    kst[i] = (part < 16) ? *(const u32x4*)(KN + (size_t)(KR0 + k0 + key) * 1024 + h * 128 + part * 8) : *(const u32x4*)(KP + (size_t)(KR0 + k0 + key) * 64 + (part - 16) * 8); }
#pragma unroll
                for (int i = 0; i < 2; ++i) { const int cv = tid + i * NTHREADS; const int v = cv >> 3, kc = cv & 7; vst[i] = *(const u32x4*)(VT + vtb + (size_t)v * Lk + k0 + kc * 8); }
            }
            f32x16 sacc[2];
#pragma unroll
            for (int i = 0; i < 16; ++i) { sacc[0][i] = 0.f; sacc[1][i] = 0.f; }
#pragma unroll
            for (int s = 0; s < 12; ++s) {
                const bf16x8 kf0 = *(const LAS bf16x8*)(Ks + r * 400 + (16 * s + 8 * hh) * 2);
                const bf16x8 kf1 = *(const LAS bf16x8*)(Ks + (32 + r) * 400 + (16 * s + 8 * hh) * 2);
                sacc[0] = __builtin_amdgcn_mfma_f32_32x32x16_bf16(kf0, qf[s], sacc[0], 0, 0, 0);
                sacc[1] = __builtin_amdgcn_mfma_f32_32x32x16_bf16(kf1, qf[s], sacc[1], 0, 0, 0);
            }
            float mx0 = fmaxf(sacc[0][0], sacc[1][0]), mx1 = fmaxf(sacc[0][1], sacc[1][1]);
#pragma unroll
            for (int i = 2; i < 16; i += 2) { mx0 = __builtin_fmaxf(__builtin_fmaxf(mx0, sacc[0][i]), sacc[1][i]); mx1 = __builtin_fmaxf(__builtin_fmaxf(mx1, sacc[0][i + 1]), sacc[1][i + 1]); }
            float mx = fmaxf(mx0, mx1);
            mx = fmaxf(mx, shx(mx, 32, lane));
            const float mnew = fmaxf(mrun, mx);
            const bool resc = __builtin_amdgcn_ballot_w64(mnew != mrun) != 0ull;
            const float alpha = __builtin_amdgcn_exp2f((mrun - mnew) * sc2);
            mrun = mnew;
            const float nm = -mnew * sc2;
            f32x2 ps2 = (f32x2){0.f, 0.f};
#pragma unroll
            for (int kk = 0; kk < 2; ++kk)
#pragma unroll
                for (int i = 0; i < 16; i += 2) {
                    f32x2 a = (f32x2){sacc[kk][i], sacc[kk][i + 1]}; a = a * sc2 + nm;
                    a.x = __builtin_amdgcn_exp2f(a.x); a.y = __builtin_amdgcn_exp2f(a.y);
                    sacc[kk][i] = a.x; sacc[kk][i + 1] = a.y; ps2 += a;
                }
            lrun = lrun * alpha + (ps2.x + ps2.y);
            if (resc) {
#pragma unroll
                for (int ct = 0; ct < 4; ++ct)
#pragma unroll
                    for (int i = 0; i < 16; ++i) oacc[ct][i] *= alpha;
            }
#pragma unroll
            for (int ks = 0; ks < 4; ++ks) {
                const int kk = ks >> 1, s2 = ks & 1;
                u32x4 pw;
                pw.x = cvt_pk_bf16(sacc[kk][8 * s2 + 0], sacc[kk][8 * s2 + 1]); pw.y = cvt_pk_bf16(sacc[kk][8 * s2 + 2], sacc[kk][8 * s2 + 3]);
                pw.z = cvt_pk_bf16(sacc[kk][8 * s2 + 4], sacc[kk][8 * s2 + 5]); pw.w = cvt_pk_bf16(sacc[kk][8 * s2 + 6], sacc[kk][8 * s2 + 7]);
                const bf16x8 pf = __builtin_bit_cast(bf16x8, pw);
#pragma unroll
                for (int ct = 0; ct < 4; ++ct) {
                    const bf16x8 vf = *(const LAS bf16x8*)(Vs + (32 * ct + r) * 144 + (32 * kk + 16 * s2) * 2 + 16 * hh);
                    oacc[ct] = __builtin_amdgcn_mfma_f32_32x32x16_bf16(vf, pf, oacc[ct], 0, 0, 0);
                }
            }
        }
        lrun += shx(lrun, 32, lane);
        const float invl = 1.0f / lrun;
        const int tid2 = otid(wv); const int qrow2 = row0 + (tid2 >> 6) * 32 + (tid2 & 31);
        bf16_t* op = O + (size_t)qrow2 * 1024 + h * 128 + 4 * ((tid2 >> 5) & 1);
#pragma unroll
        for (int ct = 0; ct < 4; ++ct)
#pragma unroll
            for (int g4 = 0; g4 < 4; ++g4) {
                u32x2 w; w.x = cvt_pk_bf16(oacc[ct][4 * g4] * invl, oacc[ct][4 * g4 + 1] * invl); w.y = cvt_pk_bf16(oacc[ct][4 * g4 + 2] * invl, oacc[ct][4 * g4 + 3] * invl);
                *(u32x2*)(op + 32 * ct + 8 * g4) = w;
            }
        __syncthreads();
    }
}

__device__ __forceinline__ void e9_phase(int wv, const Params& p, int l) {
    const bf16_t* UU = (const bf16_t*)(p.ws + A_UU); bf16_t* ACT = (bf16_t*)(p.ws + A_ACT);
    const float* cw = p.in[I_FCW] + (size_t)l * 3 * UU_LD; const float* cb = p.in[I_FCB] + (size_t)l * UU_LD;
    const int tid9 = otid(wv);
    constexpr int RC = 16, NCG = DFF / 8;
    for (int it = obid() * NTHREADS + tid9; it < (MT / RC) * NCG; it += gridDim.x * NTHREADS) {
        const int ch = it / NCG, c0 = (it - ch * NCG) * 8, row0 = ch * RC;
        const int t0 = row0 < MP ? (row0 & 255) : ((row0 - MP) & 2047); const int L = row0 < MP ? LP : LS;
        float wg[3][8], wx[3][8], bg[8], bx[8];
#pragma unroll
        for (int o = 0; o < 3; ++o) { const f32x4 a = *(const f32x4*)(cw + o * UU_LD + c0), b = *(const f32x4*)(cw + o * UU_LD + c0 + 4), c = *(const f32x4*)(cw + o * UU_LD + DFF + c0), d = *(const f32x4*)(cw + o * UU_LD + DFF + c0 + 4);
#pragma unroll
            for (int j = 0; j < 4; ++j) { wg[o][j] = a[j]; wg[o][4 + j] = b[j]; wx[o][j] = c[j]; wx[o][4 + j] = d[j]; } }
        { const f32x4 a = *(const f32x4*)(cb + c0), b = *(const f32x4*)(cb + c0 + 4), c = *(const f32x4*)(cb + DFF + c0), d = *(const f32x4*)(cb + DFF + c0 + 4);
#pragma unroll
          for (int j = 0; j < 4; ++j) { bg[j] = a[j]; bg[4 + j] = b[j]; bx[j] = c[j]; bx[4 + j] = d[j]; } }
        const bf16_t* pr = UU + (size_t)row0 * UU_LD + c0;
        u32x4 gp = (u32x4){0u, 0u, 0u, 0u}, xp = gp, gc, xc, gn, xn;
        if (t0 > 0) { gp = *(const u32x4*)(pr - UU_LD); xp = *(const u32x4*)(pr - UU_LD + DFF); }
        gc = *(const u32x4*)pr; xc = *(const u32x4*)(pr + DFF);
#pragma unroll 4
        for (int i = 0; i < RC; ++i) {
            gn = (u32x4){0u, 0u, 0u, 0u}; xn = gn;
            if (t0 + i + 1 < L) { gn = *(const u32x4*)(pr + (size_t)(i + 1) * UU_LD); xn = *(const u32x4*)(pr + (size_t)(i + 1) * UU_LD + DFF); }
            float a[8], b[8], c[8], ga[8], va[8];
            unpack8(gp, a); unpack8(gc, b); unpack8(gn, c);
#pragma unroll
            for (int j = 0; j < 8; ++j) ga[j] = bg[j] + wg[0][j] * a[j] + wg[1][j] * b[j] + wg[2][j] * c[j];
            unpack8(xp, a); unpack8(xc, b); unpack8(xn, c);
#pragma unroll
            for (int j = 0; j < 8; ++j) va[j] = bx[j] + wx[0][j] * a[j] + wx[1][j] * b[j] + wx[2][j] * c[j];
#pragma unroll
            for (int j = 0; j < 8; ++j) ga[j] = siluf_(ga[j]) * va[j];
            *(u32x4*)(ACT + (size_t)(row0 + i) * DFF + c0) = pack8(ga);
            gp = gc; gc = gn; xp = xc; xc = xn;
        }
    }
}

__device__ __forceinline__ void merge_phase(int wv, const Params& p) {
    const bf16_t* RAW = (const bf16_t*)(p.ws + A_RAW); const bf16_t* G = (const bf16_t*)(p.ws + A_GATES); bf16_t* MB = (bf16_t*)(p.ws + A_MBF);
    const int tid = otid(wv);
    for (int it = obid() * NTHREADS + tid; it < MT * 256; it += gridDim.x * NTHREADS) {
        const int row = it >> 8, c0 = (it & 255) * 8;
        float acc[8];
#pragma unroll
        for (int j = 0; j < 8; ++j) acc[j] = 0.f;
#pragma unroll
        for (int P = 0; P < 3; ++P) {
            float r[8], g[8];
            unpack8(*(const u32x4*)(RAW + ((size_t)P * MT + row) * DM + c0), r); unpack8(*(const u32x4*)(G + (size_t)row * GATE_LD + P * 2048 + c0), g);
#pragma unroll
            for (int j = 0; j < 8; ++j) acc[j] += sigmoidf_(g[j]) * r[j];
        }
        *(u32x4*)(MB + (size_t)row * DM + c0) = pack8(acc);
    }
}

__device__ __forceinline__ void convert_layer(int wv, const Params& p, int l, LAS unsigned char* lds) {
    unsigned char* ws = p.ws;
    convT(wv, p.in[I_WIN] + (size_t)l * DM * NIN, DM, NIN, (bf16_t*)(ws + W_IN), 1, lds);
    convT(wv, p.in[I_WUQ] + (size_t)l * 512 * 1536, 512, 1536, (bf16_t*)(ws + W_UQ), 0, lds);
    convT(wv, p.in[I_WUKV] + (size_t)l * 256 * 2048, 256, 2048, (bf16_t*)(ws + W_UKV), 2, lds);
    convT(wv, p.in[I_WBRA] + (size_t)l * 1024 * 2048, 1024, 2048, (bf16_t*)(ws + W_BRA), 0, lds);
    convT(wv, p.in[I_WBRB] + (size_t)l * 1024 * 2048, 1024, 2048, (bf16_t*)(ws + W_BRB), 0, lds);
    convT(wv, p.in[I_WBRC] + (size_t)l * 1024 * 2048, 1024, 2048, (bf16_t*)(ws + W_BRC), 0, lds);
    convT(wv, p.in[I_WO] + (size_t)l * 2048 * 2048, 2048, 2048, (bf16_t*)(ws + W_O), 0, lds);
    convT(wv, p.in[I_FUP] + (size_t)l * 2048 * UU_LD, 2048, UU_LD, (bf16_t*)(ws + W_UP), 0, lds);
    convT(wv, p.in[I_FDN] + (size_t)l * DFF * 2048, DFF, 2048, (bf16_t*)(ws + W_DN), 0, lds);
}

namespace pg8 {
struct EpiGateRT {
    const bf16_t* gates; float* m32; bf16_t* mbf; int P;
    __device__ __forceinline__ void operator()(const f32x4 (&acc)[2][2][4][2], const Unit& u, int wr, int wc, int fr, int fq) const {
        const int row0 = u.pm * BM + wr * 64 + fr, col0 = u.pn * BM + wc * 32 + 4 * fq;
#pragma unroll
        for (int ai = 0; ai < 2; ++ai)
#pragma unroll
            for (int m = 0; m < 4; ++m) {
                const size_t row = (size_t)(row0 + ai * HALF + m * 16);
#pragma unroll
                for (int bj = 0; bj < 2; ++bj)
#pragma unroll
                    for (int n = 0; n < 2; ++n) {
                        const int col = col0 + bj * HALF + n * 16;
                        const u32x2 gw = *(const u32x2*)(gates + row * GATE_LD + P * 2048 + col);
                        f32x4 v = acc[ai][bj][m][n];
                        v[0] *= sigmoidf_(bf_lo(gw.x)); v[1] *= sigmoidf_(bf_hi(gw.x)); v[2] *= sigmoidf_(bf_lo(gw.y)); v[3] *= sigmoidf_(bf_hi(gw.y));
                        float* mp = m32 + row * 2048 + col;
                        if (P != 0) { const f32x4 o = *(const f32x4*)mp; v = v + o; }
                        if (P != 2) { *(f32x4*)mp = v; }
                        else { u32x2 w; w.x = cvt_pk_bf16(v[0], v[1]); w.y = cvt_pk_bf16(v[2], v[3]); *(u32x2*)(mbf + row * 2048 + col) = w; }
                    }
            }
    }
};
}


#define XB_TMO      128
#define XB_XCNT(j)  (256  + 64 * (j))
#define XB_XSUB(j)  (1280 + 64 * (j))
#define XB_XGEN(j)  (2304 + 64 * (j))
#define XB_TOP      3328
#define XB_TOPGEN   3392
#define XCD_BAR_WORDS 3456
#define XB_SPIN_CAP (1u << 20)
__device__ __forceinline__ unsigned xb_ld(unsigned* p)              { return __hip_atomic_load(p, __ATOMIC_RELAXED, __HIP_MEMORY_SCOPE_AGENT); }
__device__ __forceinline__ unsigned xb_add(unsigned* p, unsigned v) { return __hip_atomic_fetch_add(p, v, __ATOMIC_RELAXED, __HIP_MEMORY_SCOPE_AGENT); }
__device__ __forceinline__ unsigned xb_xcc_id() { return (unsigned)__builtin_amdgcn_s_getreg((3 << 11) | 20) & 0xFu; }
#define XB_SPIN(cond, bar) do { unsigned _sp = 0; while (cond) { __builtin_amdgcn_s_sleep(1); \
    if ((++_sp & 255u) == 0u) { if (xb_ld(&(bar)[XB_TMO])) break; if (_sp > XB_SPIN_CAP) { atomicAdd(&(bar)[XB_TMO], 1u); break; } } } } while (0)
__device__ __forceinline__ void xcd_barrier_complete(unsigned* bar, unsigned x, unsigned& nloc, unsigned& nx) {
    const unsigned G = gridDim.x;
    unsigned sum, cnt, mine, sp = 0u;
    for (;;) {
        sum = 0u; cnt = 0u; mine = 0u;
#pragma unroll
        for (unsigned j = 0; j < 16; ++j) { const unsigned c = xb_ld(&bar[XB_XCNT(j)]); sum += c; cnt += (c > 0u) ? 1u : 0u; mine = (j == x) ? c : mine; }
        if (sum == G) break;
        __builtin_amdgcn_s_sleep(1);
        if ((++sp & 255u) == 0u) { if (xb_ld(&bar[XB_TMO])) break; if (sp > XB_SPIN_CAP) { atomicAdd(&bar[XB_TMO], 1u); break; } }
    }
    nloc = mine > 0u ? mine : 1u; nx = cnt > 0u ? cnt : 1u;
}
__device__ __forceinline__ void xcd_barrier(int wv, unsigned* bar, volatile LAS unsigned* st) {
    asm volatile("s_waitcnt vmcnt(0)" ::: "memory");
    __syncthreads();
    if (otid(wv) == 0) {
        __builtin_amdgcn_s_waitcnt(0);
        const unsigned x = xb_xcc_id();
        unsigned nloc = st[0], nx = st[1];
        if (nloc == 0u) { xcd_barrier_complete(bar, x, nloc, nx); st[0] = nloc; st[1] = nx; }
        const unsigned old = xb_add(&bar[XB_XSUB(x)], 1u);
        const unsigned gen = old / nloc;
        if (old + 1u == (gen + 1u) * nloc) {
            __builtin_amdgcn_fence(__ATOMIC_RELEASE, "agent");
            asm volatile("s_waitcnt vmcnt(0)" ::: "memory");
            const unsigned og = xb_add(&bar[XB_TOP], 1u);
            const unsigned tg = og / nx;
            if (og + 1u == (tg + 1u) * nx) xb_add(&bar[XB_TOPGEN], 1u);
            else XB_SPIN(xb_ld(&bar[XB_TOPGEN]) == tg, bar);
            __builtin_amdgcn_fence(__ATOMIC_ACQUIRE, "agent");
            xb_add(&bar[XB_XGEN(x)], 1u);
            asm volatile("s_waitcnt vmcnt(0)" ::: "memory");
        } else {
            XB_SPIN(xb_ld(&bar[XB_XGEN(x)]) == gen, bar);
            __builtin_amdgcn_fence(__ATOMIC_ACQUIRE, "agent");
            asm volatile("s_waitcnt vmcnt(0)" ::: "memory");
        }
    }
    __syncthreads();
}

#ifndef REP_GEMM
#define REP_GEMM 1
#endif
#ifndef REP_ATTN
#define REP_ATTN 1
#endif
#ifndef REP_CONV
#define REP_CONV 1
#endif
#ifndef REP_ELT
#define REP_ELT 1
#endif
#ifndef REP_CVT
#define REP_CVT 1
#endif
enum { K_G1A = 0, K_E2, K_I3, K_I4, K_G1B, K_G5, K_G6, K_ROW1, K_G8, K_E9, K_G10, K_ROW2, K_PRO, K_ROW0, K_COMB };

__global__ void __launch_bounds__(NTHREADS) fwd_megakernel(Params p) {
    extern __shared__ __attribute__((aligned(16))) unsigned char shm[];
    LAS unsigned char* lds = (LAS unsigned char*)shm;
    cg::grid_group grid = cg::this_grid();
    const int wv = __builtin_amdgcn_readfirstlane((int)(threadIdx.x >> 6));
    volatile LAS unsigned* bst = (volatile LAS unsigned*)(lds + 131072);
    unsigned* bar = (unsigned*)(p.ws + S_BAR);
    if (threadIdx.x == 0) { bst[0] = 0u; bst[1] = 0u; bst[2] = 0u; bst[3] = 0u; (void)xb_add(&bar[XB_XCNT(xb_xcc_id())], 1u); }
    __syncthreads();
#pragma unroll 1
    for (int ph = 0; ph < 3 + 12 * NLAYER; ++ph) {
        int kind, l;
        if (ph == 0) { kind = K_PRO; l = 0; } else if (ph == 1) { kind = K_COMB; l = 0; } else if (ph == 2) { kind = K_ROW0; l = 0; } else { l = (ph - 3) / 12; kind = (ph - 3) - l * 12; }
        unsigned char* ws = p.ws;
        asm volatile("" : "+s"(ws));
        if (kind == K_G1A || kind == K_I3 || kind == K_G1B || kind == K_G8) {
            const bf16_t* A; const bf16_t* Bt; bf16_t* O; int N, K;
            if (kind == K_G1A) { A = (const bf16_t*)(ws + A_H); Bt = (const bf16_t*)(ws + W_IN); O = (bf16_t*)(ws + A_PROJA); N = PA_LD; K = DM; }
            else if (kind == K_I3) { A = (const bf16_t*)(ws + A_CQN); Bt = (const bf16_t*)(ws + W_UQ); O = (bf16_t*)(ws + A_Q); N = 1536; K = 512; }
            else if (kind == K_G1B) { A = (const bf16_t*)(ws + A_H); Bt = (const bf16_t*)(ws + W_IN) + (size_t)PA_LD * DM; O = (bf16_t*)(ws + A_GATES); N = GATE_LD; K = DM; }
            else { A = (const bf16_t*)(ws + A_H); Bt = (const bf16_t*)(ws + W_UP); O = (bf16_t*)(ws + A_UU); N = UU_LD; K = DM; }
            int Mr = MT;
            const int nrep = ((kind == K_I3) ? 2 : 1) * REP_GEMM;
#pragma unroll 1
            for (int rp = 0; rp < nrep; ++rp) {
                if (kind == K_I3 && rp >= REP_GEMM) { A = (const bf16_t*)(ws + A_KEYSC); Bt = (const bf16_t*)(ws + W_UKV); O = (bf16_t*)(ws + A_KN); N = 1024; K = 256; Mr = KROWS; }
                run_gemm(wv, lds, A, Bt, Mr, N, K, pg8::EpiBf16{O, N, O});
            }
        }
        if (kind == K_I3) {
#pragma unroll 1
            for (int rp = 0; rp < REP_GEMM; ++rp)
            run_gemm(wv, lds, (const bf16_t*)(ws + W_UKV) + (size_t)1024 * 256, (const bf16_t*)(ws + A_KEYSC), 1024, KROWS, 256,
                     pg8::EpiVT{(bf16_t*)(ws + A_VT), (bf16_t*)(ws + A_VT) + (size_t)BS * 8 * 128 * LKS});
#pragma unroll 1
            for (int rp = 0; rp < REP_CONV; ++rp) conv_phase(wv, p, l, lds);
        }
        if (kind == K_I4) {
#pragma unroll 1
            for (int rp = 0; rp < REP_ATTN; ++rp) attn_phase(wv, p, lds);
#pragma unroll 1
            for (int rp = 0; rp < REP_ELT; ++rp) e3b_phase(wv, p, lds); }
        if (kind == K_G5) {
#pragma unroll 1
            for (int rp = 0; rp < REP_GEMM; ++rp)
            run_gemm(wv, lds, (const bf16_t*)(ws + A_YA), (const bf16_t*)(ws + W_BRA), 3 * MT, DM, 1024, pg8::EpiBf16{(bf16_t*)(ws + A_RAW), DM, (bf16_t*)(ws + A_RAW)}, false, MT / 256, E_WBR * 2);
            xcd_barrier(wv, bar, bst);
            merge_phase(wv, p);
        }
        if (kind == K_G6 || kind == K_G10) {
            const bool g6 = (kind == K_G6);
#pragma unroll 1
            for (int rp = 0; rp < REP_GEMM; ++rp)
            run_gemm(wv, lds, (const bf16_t*)(ws + (g6 ? A_MBF : A_ACT)), (const bf16_t*)(ws + (g6 ? W_O : W_DN)), MT, DM, g6 ? DM : DFF, pg8::EpiBf16{(bf16_t*)(ws + (g6 ? A_M32 : A_F32)), DM, (bf16_t*)(ws + (g6 ? A_M32 : A_F32)) + (size_t)MT * DM}, true);
        }
        if (kind == K_E2) {
#pragma unroll 1
            for (int rp = 0; rp < REP_ELT; ++rp) e2_phase(wv, p, l, lds); }
        if (kind == K_E9) {
#pragma unroll 1
            for (int rp = 0; rp < REP_ELT; ++rp) e9_phase(wv, p, l); }
        if (kind == K_ROW0 || kind == K_ROW1 || kind == K_ROW2) row_phase(wv, p, l, kind == K_ROW0 ? 0 : (kind == K_ROW1 ? 1 : 2));
        if (kind == K_COMB) comb_phase(wv, p);
        if (kind == K_PRO) {
            if (obid() == 0) {
                pg8::StaticOrder S; S.init(MT, DM, (int)gridDim.x, 0, true);
                const int t0 = otid(wv);
                if (t0 < S.nwg - S.nfull) { pg8::Unit uu; S.tile_of(S.nfull + t0, uu); atomicOr((unsigned*)(p.ws + S_TAIL) + uu.pm, 1u << uu.pn); }
            }
            ada_phase(wv, p, lds); rope_table_phase(wv, p); }
        if (kind == K_PRO || (kind == K_ROW2 && l + 1 < NLAYER)) { const int ln = (kind == K_PRO) ? 0 : l + 1;
#pragma unroll 1
            for (int rp = 0; rp < REP_CVT; ++rp) { filter_phase(wv, p, ln, lds); convert_layer(wv, p, ln, lds); } }
        if (p.ws == nullptr) grid.sync();
        xcd_barrier(wv, bar, bst);
    }
}

extern "C" void kernel_launch(void* const* d_in, const int* in_sizes, int n_in, void* d_out, int out_size, void* d_ws, size_t ws_size, hipStream_t stream) {
    static int grid_blocks = 0;
    if (grid_blocks == 0) {
        if (n_in != N_INPUTS || ws_size < WS_NEED) { fprintf(stderr, "kernel_launch: need %d inputs and %zu bytes of workspace; got %d, %zu\n", N_INPUTS, (size_t)WS_NEED, n_in, ws_size); grid_blocks = -1; return; }
        int dev = 0, cus = 0, per_cu = 0;
        hipGetDevice(&dev);
        hipDeviceGetAttribute(&cus, hipDeviceAttributeMultiprocessorCount, dev);
        if (hipFuncSetAttribute((const void*)fwd_megakernel, hipFuncAttributeMaxDynamicSharedMemorySize, LDS_BYTES) != hipSuccess) { fprintf(stderr, "kernel_launch: hipFuncSetAttribute failed\n"); grid_blocks = -1; return; }
        if (hipOccupancyMaxActiveBlocksPerMultiprocessor(&per_cu, (const void*)fwd_megakernel, NTHREADS, LDS_BYTES) != hipSuccess || per_cu < 1) { fprintf(stderr, "kernel_launch: occupancy query gave %d\n", per_cu); per_cu = 1; }
        (void)hipGetLastError();
        grid_blocks = cus * 1;
    }
    if (grid_blocks < 0) return;
        (void)hipMemsetAsync((unsigned char*)d_ws + S_BAR, 0, 16384, stream);
    (void)hipMemsetAsync((unsigned char*)d_ws + S_TAIL, 0, 512, stream);
    Params p{};
    for (int i = 0; i < N_INPUTS; ++i) p.in[i] = (const float*)d_in[i];
    p.out = (float*)d_out; p.ws = (unsigned char*)d_ws;
    void* args[] = {&p};
    hipError_t e = hipLaunchCooperativeKernel((const void*)fwd_megakernel, dim3(grid_blocks), dim3(NTHREADS), args, LDS_BYTES, stream);
    if (e != hipSuccess) fprintf(stderr, "cooperative launch failed: %s (grid %d)\n", hipGetErrorString(e), grid_blocks);
}
```

```cpp
#include <hip/hip_runtime.h>
#include <hip/hip_cooperative_groups.h>
#include <cstdio>
namespace cg = cooperative_groups;

#define LAS __attribute__((address_space(3)))
typedef unsigned short bf16_t;
typedef short bf16x8 __attribute__((ext_vector_type(8)));
typedef float f32x4 __attribute__((ext_vector_type(4)));
typedef float f32x16 __attribute__((ext_vector_type(16)));
typedef unsigned u32x4 __attribute__((ext_vector_type(4)));
typedef unsigned u32x2 __attribute__((ext_vector_type(2)));
typedef float f32x2 __attribute__((ext_vector_type(2)));

constexpr int DM = 2048, MP = 4096, MS = 16384, MT = 20480, NLAYER = 2;
constexpr int LP = 256, LS = 2048, BP = 16, BS = 8, PAST = 512, LKS = 2560;
constexpr int NIN = 13120, NGATE0 = 6976, PA_LD = 7168, GATE_LD = 6144;
constexpr int DFF = 5632, UU_LD = 11264;
constexpr int KROWS = 24576;
constexpr int NTHREADS = 512;
constexpr int LDS_BYTES = 131072 + 16;

enum { I_XP = 0, I_XS, I_C, I_CCKV, I_CKPE, I_CCTX, I_ADAW, I_ADAB, I_NMPRE, I_NMPOST, I_NFPRE, I_NFPOST, I_WIN, I_HCW, I_HCB,
       I_FW1, I_FB1, I_FW2, I_FB2, I_FW3, I_FB3, I_FFREQ, I_HBIAS, I_QN, I_KVN, I_WUQ, I_WUKV, I_SCW, I_WBRA, I_WBRB, I_WBRC,
       I_WO, I_FUP, I_FCW, I_FCB, I_FDN, N_INPUTS };

constexpr size_t E_WIN = (size_t)13312 * 2048, E_WUQ = (size_t)1536 * 512, E_WUKV = (size_t)2048 * 256, E_WBR = (size_t)2048 * 1024,
                 E_WO = (size_t)2048 * 2048, E_WUP = (size_t)11264 * 2048, E_WDN = (size_t)2048 * 5632;
constexpr size_t W_IN = 0, W_UQ = W_IN + E_WIN * 2, W_UKV = W_UQ + E_WUQ * 2, W_BRA = W_UKV + E_WUKV * 2, W_BRB = W_BRA + E_WBR * 2,
                 W_BRC = W_BRB + E_WBR * 2, W_O = W_BRC + E_WBR * 2, W_UP = W_O + E_WO * 2, W_DN = W_UP + E_WUP * 2, W_END = W_DN + E_WDN * 2;
constexpr size_t S_MOD = W_END, SZ_MOD = (size_t)NLAYER * 16 * 9 * 12288 * 4;
constexpr size_t S_KTS = S_MOD + SZ_MOD, S_KTP = S_KTS + (size_t)1024 * 4096 * 4, S_PARTS = S_KTP + (size_t)1024 * 512 * 4,
                 S_PARTP = S_PARTS + (size_t)64 * 2048 * 4, S_ROPE = S_PARTP + (size_t)8 * 2048 * 4, S_BAR = S_ROPE + (size_t)2 * 2048 * 32 * 4, S_COMB = S_BAR + 16384, S_SCALE = S_COMB + (size_t)NLAYER * 3 * 9 * 3 * 2048 * 4, S_TAIL = S_SCALE + 8192, S_END = S_TAIL + 512;
constexpr size_t AR = S_END;
constexpr size_t SZ_H = (size_t)MT * 2048 * 2;
constexpr size_t A_H = AR, A_UU = AR + SZ_H, A_ACT = A_UU + (size_t)MT * UU_LD * 2, AR_END = A_ACT + (size_t)MT * DFF * 2;
constexpr size_t A_PROJA = A_UU;
constexpr size_t A_Q = A_UU, A_KN = A_Q + (size_t)MT * 1536 * 2, A_VT = A_KN + (size_t)KROWS * 1024 * 2, A_YCT = A_VT + (size_t)KROWS * 1024 * 2;
constexpr size_t A_GATES = A_UU, A_M32 = A_GATES + (size_t)MT * GATE_LD * 2, A_MBF = A_H, A_F32 = A_UU;
constexpr size_t A_S = A_M32 + (size_t)MT * 2048 * 4;
constexpr size_t A_ZZT = A_S, A_X0S = A_ZZT + (size_t)MT * 1024 * 2, A_CQN = A_X0S + (size_t)MT * 1024 * 2, A_KEYSC = A_CQN + (size_t)MT * 512 * 2,
                 A_KPER = A_KEYSC + (size_t)KROWS * 256 * 2, A_YA = A_KPER + (size_t)KROWS * 64 * 2, A_OATT = A_YA + (size_t)MT * 1024 * 2,
                 A_YC = A_OATT + (size_t)MT * 1024 * 2, A_SEND = A_YC + (size_t)MT * 1024 * 2;
constexpr size_t A_RAW = A_M32;
static_assert(A_RAW + (size_t)3 * MT * 2048 * 2 <= A_CQN, "raw branch buffer overlaps live data");
static_assert(A_SEND <= AR_END, "arena overflow");
static_assert(A_YCT + (size_t)MT * 1024 * 2 <= A_M32, "arena overlap");
constexpr size_t WS_NEED = AR_END;
static_assert(WS_NEED <= 967590400ull, "workspace too large");

struct Params {
    const float* in[N_INPUTS];
    float* out;
    unsigned char* ws;
};

__device__ __forceinline__ unsigned cvt_pk_bf16(float lo, float hi) { unsigned r; asm volatile("v_cvt_pk_bf16_f32 %0, %1, %2" : "=v"(r) : "v"(lo), "v"(hi)); return r; }
__device__ __forceinline__ bf16_t f2bf(float f) { return (bf16_t)(cvt_pk_bf16(f, 0.f) & 0xffffu); }
__device__ __forceinline__ float bf_lo(unsigned w) { return __uint_as_float(w << 16); }
__device__ __forceinline__ float bf_hi(unsigned w) { return __uint_as_float(w & 0xffff0000u); }
__device__ __forceinline__ void unpack8(const u32x4 v, float* f) { f[0] = bf_lo(v.x); f[1] = bf_hi(v.x); f[2] = bf_lo(v.y); f[3] = bf_hi(v.y); f[4] = bf_lo(v.z); f[5] = bf_hi(v.z); f[6] = bf_lo(v.w); f[7] = bf_hi(v.w); }
__device__ __forceinline__ u32x4 pack8(const float* f) { u32x4 r; r.x = cvt_pk_bf16(f[0], f[1]); r.y = cvt_pk_bf16(f[2], f[3]); r.z = cvt_pk_bf16(f[4], f[5]); r.w = cvt_pk_bf16(f[6], f[7]); return r; }
__device__ __forceinline__ float shx(float v, int mask, int lane) { return __int_as_float(__builtin_amdgcn_ds_bpermute((lane ^ mask) << 2, __float_as_int(v))); }
__device__ __forceinline__ float wave_sum(float v, int lane) {
#pragma unroll
    for (int o = 32; o >= 1; o >>= 1) v += shx(v, o, lane);
    return v;
}
__device__ __forceinline__ int otid(int wv) { int t; asm volatile("v_mbcnt_lo_u32_b32 %0, -1, 0\n\tv_mbcnt_hi_u32_b32 %0, -1, %0" : "=v"(t)); return wv * 64 + t; }
__device__ __forceinline__ int obid() { int t = blockIdx.x; asm volatile("" : "+s"(t)); return t; }
__device__ __forceinline__ float sigmoidf_(float x) { return 1.0f / (1.0f + __expf(-x)); }
__device__ __forceinline__ float siluf_(float x) { return x / (1.0f + __expf(-x)); }

namespace pg8 {
constexpr int BM = 256, BK = 64, HALF = 128, HTB = HALF * BK * 2, STAGE_BYTES = 8 * HTB, NXCD = 8, WGM = 8;
__host__ __device__ __forceinline__ int lds_byte(int r, int c) { const int st = (r >> 4) * 2 + (c >> 5), rr = r & 15, cc = c & 31, ob = rr * 64 + cc * 2; return st * 1024 + (ob ^ (((ob >> 9) & 1) << 5)); }
__host__ __device__ __forceinline__ void stage_rc(int b, int& R, int& C) { const int st = b / 1024, sb = b % 1024, swz = sb ^ (((sb >> 9) & 1) << 5); R = (st >> 1) * 16 + swz / 64; C = (st & 1) * 32 + (swz % 64) / 2; }
__host__ __device__ __forceinline__ int perm32(int rho) { const int n = rho >> 4, i = rho & 15; return 8 * (i >> 2) + 4 * n + (i & 3); }
struct Unit { int pm, pn, kh; };
struct Gemm { const bf16_t* A; const bf16_t* Bt; int M, N, K; int nMper; size_t bstride; };
struct StaticOrder {
    int nM, nN, nwg, G, c, nfull;
    __device__ void init(int M, int N, int G_, int c_, bool split = false) { nM = M / BM; nN = N / BM; nwg = nM * nN; G = G_; c = c_;
        nfull = nwg; if (split) { const int rem = nwg % G; if (rem > 0 && 2 * rem <= G) nfull = nwg - rem; } }
    __device__ void tile_of(int wgid, Unit& u) const {
        { const int q = nwg / NXCD, r = nwg % NXCD, xcd = wgid % NXCD, off = wgid / NXCD; wgid = (xcd < r ? xcd * (q + 1) : r * (q + 1) + (xcd - r) * q) + off; }
        const int nig = WGM * nN, gid = wgid / nig, fm = gid * WGM, gsz = (nM - fm) < WGM ? (nM - fm) : WGM;
        u.pm = fm + ((wgid % nig) % gsz); u.pn = (wgid % nig) / gsz;
    }
    __device__ bool next(int i, Unit& u) const {
        const long L = (long)i * G + c;
        int tile = (int)L, kh = -1; bool ok = L < nwg;
        if (L >= nfull) { const long h = L - nfull; ok = h < 2 * (long)(nwg - nfull); tile = nfull + (int)(h >> 1); kh = (int)(h & 1); }
        if (!ok) return false;
        int pm, pn;
        { int wgid = tile; const int q = nwg / NXCD, r = nwg % NXCD, xcd = wgid % NXCD, off = wgid / NXCD; wgid = (xcd < r ? xcd * (q + 1) : r * (q + 1) + (xcd - r) * q) + off;
          const int nig = WGM * nN, gid = wgid / nig, fm = gid * WGM, gsz = (nM - fm) < WGM ? (nM - fm) : WGM;
          pm = fm + ((wgid % nig) % gsz); pn = (wgid % nig) / gsz; }
        u.pm = pm; u.pn = pn; u.kh = kh; return true;
    }
};
template <class Epi>
__device__ __forceinline__ void gemm_phase(int wv, LAS unsigned char* lds, const Gemm g, const StaticOrder& S, const Epi& E) {
    const int tid = otid(wv), wid = __builtin_amdgcn_readfirstlane(tid >> 6), lane = tid & 63, wr = wid >> 2, wc = wid & 3, fr = lane & 15, fq = lane >> 4;
    const int K = g.K, nt = K / BK;
    unsigned voffA[2], voffB[2];
#pragma unroll
    for (int i = 0; i < 2; ++i) { int R, C; stage_rc(tid * 16 + i * 8192, R, C); const int Rb = (R & ~31) + perm32(R & 31); voffA[i] = (unsigned)(R * K + C) * 2u; voffB[i] = (unsigned)(Rb * K + C) * 2u; }
    const size_t kstep = (size_t)(BK * 2);
    const size_t hstep = (size_t)HALF * K * 2;
    const size_t tstep = 2 * hstep;
    const unsigned ldsw = (unsigned)wid * 1024u;
    const int aoff = lds_byte(wr * 64 + fr, fq * 8), boff = lds_byte(wc * 32 + fr, fq * 8);
#define PG8_SA(b, h) (((b) * 2 + (h)) * HTB)
#define PG8_SB(b, h) ((4 + (b) * 2 + (h)) * HTB)
#define PG8_STAGE(bufoff, gbase, voff) do { _Pragma("unroll") for (int _i = 0; _i < 2; ++_i) \
        __builtin_amdgcn_global_load_lds((const unsigned*)((const char*)(gbase) + (voff)[_i]), (LAS unsigned*)(lds + (bufoff) + ldsw + _i * 8192), 16, 0, 0); } while (0)
#define PG8_LDA(dst, b, h) do { _Pragma("unroll") for (int m = 0; m < 4; ++m) _Pragma("unroll") for (int k = 0; k < 2; ++k) dst[m][k] = *(const LAS bf16x8*)(lds + PG8_SA(b, h) + aoff + m * 2048 + k * 1024); } while (0)
#define PG8_LDB(dst, b, h) do { _Pragma("unroll") for (int n = 0; n < 2; ++n) _Pragma("unroll") for (int k = 0; k < 2; ++k) dst[n][k] = *(const LAS bf16x8*)(lds + PG8_SB(b, h) + boff + n * 2048 + k * 1024); } while (0)
#define PG8_MMA(ai, bj, At, Bt) do { __builtin_amdgcn_s_setprio(1); _Pragma("unroll") for (int m = 0; m < 4; ++m) _Pragma("unroll") for (int n = 0; n < 2; ++n) _Pragma("unroll") for (int k = 0; k < 2; ++k) \
        acc[ai][bj][m][n] = __builtin_amdgcn_mfma_f32_16x16x32_bf16(Bt[n][k], At[m][k], acc[ai][bj][m][n], 0, 0, 0); __builtin_amdgcn_s_setprio(0); } while (0)
#define PG8_WAIT_V(n) asm volatile("s_waitcnt vmcnt(" #n ")" ::: "memory")
#define PG8_WAIT_L(n) asm volatile("s_waitcnt lgkmcnt(" #n ")" ::: "memory")
#define PG8_BAR __builtin_amdgcn_s_barrier()
#define PG8_SCHED __builtin_amdgcn_sched_barrier(0)
    Unit cur, nxt; int ui = 0;
    if (!S.next(0, cur)) return;
    f32x4 acc[2][2][4][2];
#pragma unroll
    for (int a = 0; a < 2; ++a)
#pragma unroll
        for (int b = 0; b < 2; ++b)
#pragma unroll
            for (int m = 0; m < 4; ++m)
#pragma unroll
                for (int n = 0; n < 2; ++n) acc[a][b][m][n] = (f32x4){0.f, 0.f, 0.f, 0.f};
    bf16x8 At[4][2], B0[2][2], B1[2][2];
    const size_t khoff = (size_t)(nt / 2) * kstep;
    const char* cA = (const char*)g.A + (size_t)cur.pm * tstep + (cur.kh == 1 ? khoff : 0); const char* cB = (const char*)g.Bt + (size_t)(cur.pm / g.nMper) * g.bstride + (size_t)cur.pn * tstep + (cur.kh == 1 ? khoff : 0);
    PG8_STAGE(PG8_SB(0, 0), cB, voffB); PG8_STAGE(PG8_SA(0, 0), cA, voffA); PG8_STAGE(PG8_SB(0, 1), cB + hstep, voffB); PG8_STAGE(PG8_SA(0, 1), cA + hstep, voffA);
    if (wr == 1) PG8_BAR;
    PG8_WAIT_V(4); PG8_BAR;
    PG8_STAGE(PG8_SB(1, 0), cB + kstep, voffB); PG8_STAGE(PG8_SA(1, 0), cA + kstep, voffA); PG8_STAGE(PG8_SB(1, 1), cB + hstep + kstep, voffB);
    PG8_WAIT_V(6); PG8_BAR;
    for (;;) {
        const bool has_next = S.next(ui + 1, nxt);
        const char* nA = has_next ? (const char*)g.A + (size_t)nxt.pm * tstep + (nxt.kh == 1 ? khoff : 0) : cA; const char* nB = has_next ? (const char*)g.Bt + (size_t)(nxt.pm / g.nMper) * g.bstride + (size_t)nxt.pn * tstep + (nxt.kh == 1 ? khoff : 0) : cB;
        const int ntu = (cur.kh < 0) ? nt : (nt >> 1);
        for (int t = 0; t < ntu; t += 2) {
            const bool last = (t == ntu - 2);
            const char* a1 = cA + (size_t)(t + 1) * kstep;
            const char* a2 = last ? nA : cA + (size_t)(t + 2) * kstep; const char* b2 = last ? nB : cB + (size_t)(t + 2) * kstep;
            const char* a3 = a2 + kstep; const char* b3 = b2 + kstep;
            PG8_LDB(B0, 0, 0); PG8_SCHED; PG8_LDA(At, 0, 0); PG8_STAGE(PG8_SA(1, 1), a1 + hstep, voffA);
            PG8_WAIT_L(8); PG8_BAR; PG8_WAIT_L(0); PG8_MMA(0, 0, At, B0); PG8_BAR; PG8_SCHED;
            PG8_LDB(B1, 0, 1); PG8_STAGE(PG8_SB(0, 0), b2, voffB);
            PG8_BAR; PG8_WAIT_L(0); PG8_MMA(0, 1, At, B1); PG8_BAR;
            PG8_LDA(At, 0, 1); PG8_STAGE(PG8_SA(0, 0), a2, voffA);
            PG8_BAR; PG8_WAIT_L(0); PG8_MMA(1, 0, At, B0); PG8_BAR; PG8_SCHED;
            PG8_STAGE(PG8_SB(0, 1), b2 + hstep, voffB);
            PG8_WAIT_V(6); PG8_BAR; PG8_MMA(1, 1, At, B1); PG8_BAR;
            PG8_LDB(B0, 1, 0); PG8_SCHED; PG8_LDA(At, 1, 0); PG8_STAGE(PG8_SA(0, 1), a2 + hstep, voffA);
            PG8_WAIT_L(8); PG8_BAR; PG8_WAIT_L(0); PG8_MMA(0, 0, At, B0); PG8_BAR; PG8_SCHED;
            PG8_LDB(B1, 1, 1); PG8_STAGE(PG8_SB(1, 0), b3, voffB);
            PG8_BAR; PG8_WAIT_L(0); PG8_MMA(0, 1, At, B1); PG8_BAR;
            PG8_LDA(At, 1, 1); PG8_STAGE(PG8_SA(1, 0), a3, voffA);
            PG8_BAR; PG8_WAIT_L(0); PG8_MMA(1, 0, At, B0); PG8_BAR; PG8_SCHED;
            PG8_STAGE(PG8_SB(1, 1), b3 + hstep, voffB);
            PG8_WAIT_V(6); PG8_BAR; PG8_MMA(1, 1, At, B1); PG8_BAR;
        }
        { const int t2 = otid(wv); const int l2 = t2 & 63, w2 = __builtin_amdgcn_readfirstlane(t2 >> 6); E(acc, cur, w2 >> 2, w2 & 3, l2 & 15, l2 >> 4); }
        if (!has_next) break;
#pragma unroll
        for (int a = 0; a < 2; ++a)
#pragma unroll
            for (int b = 0; b < 2; ++b)
#pragma unroll
                for (int m = 0; m < 4; ++m)
#pragma unroll
                    for (int n = 0; n < 2; ++n) acc[a][b][m][n] = (f32x4){0.f, 0.f, 0.f, 0.f};
        cur = nxt; cA = nA; cB = nB; ++ui;
    }
    PG8_WAIT_V(0);
    if (wr == 0) PG8_BAR;
    PG8_BAR;
#undef PG8_SA
#undef PG8_SB
#undef PG8_STAGE
#undef PG8_LDA
#undef PG8_LDB
#undef PG8_MMA
#undef PG8_WAIT_V
#undef PG8_WAIT_L
#undef PG8_BAR
#undef PG8_SCHED
}

struct EpiBf16 {
    bf16_t* O; int ldc; bf16_t* O2;
    __device__ __forceinline__ void operator()(const f32x4 (&acc)[2][2][4][2], const Unit& u, int wr, int wc, int fr, int fq) const {
        const int row0 = u.pm * BM + wr * 64 + fr, col0 = u.pn * BM + wc * 32 + 8 * fq;
        bf16_t* Ob = (u.kh == 1) ? O2 : O;
#pragma unroll
        for (int ai = 0; ai < 2; ++ai)
#pragma unroll
            for (int m = 0; m < 4; ++m) { bf16_t* rowp = Ob + (size_t)(row0 + ai * HALF + m * 16) * ldc + col0;
#pragma unroll
                for (int bj = 0; bj < 2; ++bj) { const f32x4 v0 = acc[ai][bj][m][0], v1 = acc[ai][bj][m][1];
                    u32x4 w; w.x = cvt_pk_bf16(v0[0], v0[1]); w.y = cvt_pk_bf16(v0[2], v0[3]); w.z = cvt_pk_bf16(v1[0], v1[1]); w.w = cvt_pk_bf16(v1[2], v1[3]);
                    *(u32x4*)(rowp + bj * HALF) = w; } }
    }
};
struct EpiF32 {
    float* C; int ldc;
    __device__ __forceinline__ void operator()(const f32x4 (&acc)[2][2][4][2], const Unit& u, int wr, int wc, int fr, int fq) const {
        const int row0 = u.pm * BM + wr * 64 + fr, col0 = u.pn * BM + wc * 32 + 4 * fq;
#pragma unroll
        for (int ai = 0; ai < 2; ++ai)
#pragma unroll
            for (int m = 0; m < 4; ++m) { float* rowp = C + (size_t)(row0 + ai * HALF + m * 16) * ldc + col0;
#pragma unroll
                for (int bj = 0; bj < 2; ++bj)
#pragma unroll
                    for (int n = 0; n < 2; ++n) *(f32x4*)(rowp + bj * HALF + n * 16) = acc[ai][bj][m][n]; }
    }
};
struct EpiVT {
    bf16_t* VTs; bf16_t* VTp;
    __device__ __forceinline__ void operator()(const f32x4 (&acc)[2][2][4][2], const Unit& u, int wr, int wc, int fr, int fq) const {
        const int KR0 = u.pn * BM;
        bf16_t* vt; int Lk;
        if (KR0 < BS * LKS) { const int b = KR0 / LKS; Lk = LKS; vt = VTs + (size_t)b * 1024 * LKS + (KR0 - b * LKS); }
        else { const int b = (KR0 - BS * LKS) >> 8; Lk = LP; vt = VTp + (size_t)b * 1024 * LP; }
        const int row0 = u.pm * BM + wr * 64 + fr, col0 = wc * 32 + 8 * fq;
#pragma unroll
        for (int ai = 0; ai < 2; ++ai)
#pragma unroll
            for (int m = 0; m < 4; ++m) { bf16_t* rowp = vt + (size_t)(row0 + ai * HALF + m * 16) * Lk + col0;
#pragma unroll
                for (int bj = 0; bj < 2; ++bj) { const f32x4 v0 = acc[ai][bj][m][0], v1 = acc[ai][bj][m][1];
                    u32x4 w; w.x = cvt_pk_bf16(v0[0], v0[1]); w.y = cvt_pk_bf16(v0[2], v0[3]); w.z = cvt_pk_bf16(v1[0], v1[1]); w.w = cvt_pk_bf16(v1[2], v1[3]);
                    *(u32x4*)(rowp + bj * HALF) = w; } }
    }
};
template <int P> struct EpiGate {
    const bf16_t* gates; float* m32; bf16_t* mbf;
    __device__ __forceinline__ void operator()(const f32x4 (&acc)[2][2][4][2], const Unit& u, int wr, int wc, int fr, int fq) const {
        const int row0 = u.pm * BM + wr * 64 + fr, col0 = u.pn * BM + wc * 32 + 4 * fq;
#pragma unroll
        for (int ai = 0; ai < 2; ++ai)
#pragma unroll
            for (int m = 0; m < 4; ++m) {
                const size_t row = (size_t)(row0 + ai * HALF + m * 16);
#pragma unroll
                for (int bj = 0; bj < 2; ++bj)
#pragma unroll
                    for (int n = 0; n < 2; ++n) {
                        const int col = col0 + bj * HALF + n * 16;
                        const u32x2 gw = *(const u32x2*)(gates + row * GATE_LD + P * 2048 + col);
                        f32x4 v = acc[ai][bj][m][n];
                        v[0] *= sigmoidf_(bf_lo(gw.x)); v[1] *= sigmoidf_(bf_hi(gw.x)); v[2] *= sigmoidf_(bf_lo(gw.y)); v[3] *= sigmoidf_(bf_hi(gw.y));
                        float* mp = m32 + row * 2048 + col;
                        if (P == 0) { *(f32x4*)mp = v; }
                        else if (P == 1) { const f32x4 o = *(const f32x4*)mp; *(f32x4*)mp = o + v; }
                        else { const f32x4 o = *(const f32x4*)mp; v = v + o; u32x2 w; w.x = cvt_pk_bf16(v[0], v[1]); w.y = cvt_pk_bf16(v[2], v[3]); *(u32x2*)(mbf + row * 2048 + col) = w; }
                    }
            }
    }
};
}

template <class Epi>
__device__ __forceinline__ void run_gemm(int wv, LAS unsigned char* lds, const bf16_t* A, const bf16_t* Bt, int M, int N, int K, const Epi& E, bool split = false, int nMper = 1 << 28, size_t bstride = 0) {
    pg8::Gemm g; g.A = A; g.Bt = Bt; g.M = M; g.N = N; g.K = K; g.nMper = nMper; g.bstride = bstride;
    pg8::StaticOrder S; S.init(M, N, (int)gridDim.x, obid(), split);
    pg8::gemm_phase<Epi>(wv, lds, g, S, E);
    __syncthreads();
}

__device__ __forceinline__ void convT(int wv, const float* __restrict__ src, int K, int N, bf16_t* __restrict__ dst, int gate_shift, LAS unsigned char* lds) {
    const int tid = otid(wv), lane = tid & 63, kq = lane & 7, ng = lane >> 3;
    const int tn = N / 32, tk = K / 64, ntile = tn * tk, nwaves = gridDim.x * 8;
    for (int tile = obid() * 8 + (tid >> 6); tile < ntile; tile += 2 * nwaves) {
        const int tile2 = tile + nwaves; const bool has2 = tile2 < ntile;
        const int tkk = tile / tn, tnn = tile - tkk * tn, k0 = tkk * 64 + 8 * kq, n0 = tnn * 32 + 4 * ng;
        const int tkk2 = has2 ? tile2 / tn : tkk, tnn2 = has2 ? tile2 - tkk2 * tn : tnn, k02 = tkk2 * 64 + 8 * kq, n02 = tnn2 * 32 + 4 * ng;
        f32x4 v[8], v2[8];
#pragma unroll
        for (int i = 0; i < 8; ++i) v[i] = *(const f32x4*)(src + (size_t)(k0 + i) * N + n0);
#pragma unroll
        for (int i = 0; i < 8; ++i) v2[i] = *(const f32x4*)(src + (size_t)(k02 + i) * N + n02);
#pragma unroll
        for (int j = 0; j < 4; ++j) {
            int nd = n0 + j; if (gate_shift == 1 && nd >= NGATE0) nd += 192; if (gate_shift == 2) { const int hd = nd >> 8, wi = nd & 255; nd = (wi < 128) ? hd * 128 + wi : 1024 + hd * 128 + (wi - 128); }
            u32x4 w; w.x = cvt_pk_bf16(v[0][j], v[1][j]); w.y = cvt_pk_bf16(v[2][j], v[3][j]); w.z = cvt_pk_bf16(v[4][j], v[5][j]); w.w = cvt_pk_bf16(v[6][j], v[7][j]);
            *(u32x4*)(dst + (size_t)nd * K + k0) = w;
        }
        if (has2) {
#pragma unroll
            for (int j = 0; j < 4; ++j) {
                int nd = n02 + j; if (gate_shift == 1 && nd >= NGATE0) nd += 192; if (gate_shift == 2) { const int hd = nd >> 8, wi = nd & 255; nd = (wi < 128) ? hd * 128 + wi : 1024 + hd * 128 + (wi - 128); }
                u32x4 w; w.x = cvt_pk_bf16(v2[0][j], v2[1][j]); w.y = cvt_pk_bf16(v2[2][j], v2[3][j]); w.z = cvt_pk_bf16(v2[4][j], v2[5][j]); w.w = cvt_pk_bf16(v2[6][j], v2[7][j]);
                *(u32x4*)(dst + (size_t)nd * K + k02) = w;
            }
        }
    }
}

__device__ __forceinline__ void ada_phase(int wv, const Params& p, LAS unsigned char* lds) {
    LAS float* sl = (LAS float*)lds;
    float* mod = (float*)(p.ws + S_MOD);
    const int tid = otid(wv);
    for (int u = obid(); u < NLAYER * 6 * 16; u += gridDim.x) {
        const int l = u / 96, r = u % 96, cb = r % 6, kc = r / 6, k0 = kc * 128;
        for (int i = tid; i < 9 * 128; i += NTHREADS) { const int v = i >> 7, k = i & 127; const float x = (v == 0) ? p.in[I_CCTX][k0 + k] : p.in[I_C][(v - 1) * DM + k0 + k]; sl[i] = siluf_(x); }
        __syncthreads();
        const int col = cb * 2048 + tid * 4;
        f32x4 acc[9];
#pragma unroll
        for (int i = 0; i < 9; ++i) acc[i] = (f32x4){0.f, 0.f, 0.f, 0.f};
        const float* wp = p.in[I_ADAW] + ((size_t)l * DM + k0) * 12288 + col;
#pragma unroll 8
        for (int k = 0; k < 128; ++k) {
            const f32x4 w = *(const f32x4*)(wp + (size_t)k * 12288);
#pragma unroll
            for (int i = 0; i < 9; ++i) acc[i] += sl[i * 128 + k] * w;
        }
#pragma unroll
        for (int i = 0; i < 9; ++i) *(f32x4*)(mod + ((size_t)(l * 16 + kc) * 9 + i) * 12288 + col) = acc[i];
        __syncthreads();
    }
}

__device__ __forceinline__ void filter_phase(int wv, const Params& p, int l, LAS unsigned char* lds) {
    LAS float* z = (LAS float*)lds;
    LAS float* H1 = z + 32 * 33;
    LAS float* H2 = H1 + 32 * 64;
    LAS float* W1 = H2 + 32 * 64;
    LAS float* W2 = W1 + 33 * 64;
    LAS float* BF = W2 + 64 * 64;
    const int tid = otid(wv);
    const float* w3 = p.in[I_FW3] + (size_t)l * 64 * 2048; const float* b3 = p.in[I_FB3] + l * 2048;
    for (int u = obid(); u < 72; u += gridDim.x) {
        const int g = (u < 64) ? 1 : 0; const int tc = g ? u : u - 64; const int L = g ? LS : LP; const int t0 = tc * 32;
        float* kT = (float*)(p.ws + (g ? S_KTS : S_KTP)); float* part = (float*)(p.ws + (g ? S_PARTS : S_PARTP));
        for (int i = tid; i < 33 * 64; i += NTHREADS) W1[i] = p.in[I_FW1][(size_t)l * 33 * 64 + i];
        for (int i = tid; i < 64 * 64; i += NTHREADS) W2[i] = p.in[I_FW2][(size_t)l * 64 * 64 + i];
        if (tid < 64) BF[tid] = p.in[I_FB1][l * 64 + tid]; else if (tid < 128) BF[tid] = p.in[I_FB2][l * 64 + tid - 64]; else if (tid < 256) BF[tid] = p.in[I_FFREQ][l * 128 + tid - 128];
        for (int i = tid; i < 32 * 33; i += NTHREADS) {
            const int t = i / 33, e = i - t * 33; const float tf = (float)(t0 + t);
            float v;
            if (e == 0) v = tf / (float)(L - 1);
            else { const int k = (e - 1) & 15; const float band = 1e-4f + (float)k * ((15.0f - 1e-4f) / 15.0f); const float w = (6.283185307179586f * tf) / (float)L; const float ang = w * band;
                   v = (e <= 16) ? cosf(ang) : -sinf(ang); }
            z[i] = v;
        }
        __syncthreads();
#pragma unroll
        for (int q = 0; q < 4; ++q) { const int i = tid + q * NTHREADS; const int t = i >> 6, j = i & 63; float s = BF[j];
#pragma unroll
            for (int e = 0; e < 33; ++e) s += z[t * 33 + e] * W1[e * 64 + j];
            H1[i] = sinf(BF[128 + j] * s); }
        __syncthreads();
#pragma unroll
        for (int q = 0; q < 4; ++q) { const int i = tid + q * NTHREADS; const int t = i >> 6, j = i & 63; float s = BF[64 + j];
#pragma unroll 16
            for (int e = 0; e < 64; ++e) s += H1[t * 64 + e] * W2[e * 64 + j];
            H2[i] = sinf(BF[192 + j] * s); }
        __syncthreads();
        const int c = tid * 4;
        const f32x4 bias = *(const f32x4*)(b3 + c);
        f32x4 delta;
#pragma unroll
        for (int j = 0; j < 4; ++j) { const int d = (c + j) & 1023; const float mn = -3.0701134573253945f, mx = -15.350567286626973f; delta[j] = fabsf(mn + (float)d * ((mx - mn) / 1023.0f)); }
        f32x4 psum = (f32x4){0.f, 0.f, 0.f, 0.f};
        for (int tb = 0; tb < 2; ++tb) {
            f32x4 acc[16];
#pragma unroll
            for (int i = 0; i < 16; ++i) acc[i] = bias;
#pragma unroll 8
            for (int k = 0; k < 64; ++k) {
                const f32x4 w = *(const f32x4*)(w3 + (size_t)k * 2048 + c);
#pragma unroll
                for (int i = 0; i < 16; ++i) acc[i] += H2[(tb * 16 + i) * 64 + k] * w;
            }
#pragma unroll
            for (int i = 0; i < 16; ++i) {
                const int t = t0 + tb * 16 + i; const float tn = (float)t / (float)(L - 1);
#pragma unroll
                for (int j = 0; j < 4; ++j) {
                    const float v = acc[i][j] * __expf(-tn * delta[j]);
                    const int cc = c + j;
                    if (cc < 1024) { kT[(size_t)cc * (2 * L) + t] = v; psum[j] += fabsf(v); }
                    else { const int d = cc - 1024; if (t == 0) kT[(size_t)d * (2 * L) + L] = 0.f; else { kT[(size_t)d * (2 * L) + 2 * L - t] = v; psum[j] += fabsf(v); } }
                }
            }
        }
        *(f32x4*)(part + (size_t)tc * 2048 + c) = psum;
        __syncthreads();
    }
}

__device__ __forceinline__ void row_sel(const Params& p, int l, int mode, int& l2, int& shi, int& sci, const float*& prew, bool& wh, int& gi, const float*& pw) {
    wh = true;
    if (mode == 0) { l2 = l; shi = 0; sci = 1; prew = p.in[I_NMPRE] + l * DM; }
    else if (mode == 1) { l2 = l; shi = 3; sci = 4; prew = p.in[I_NFPRE] + l * DM; }
    else { l2 = l + 1; shi = 0; sci = 1; wh = (l + 1 < NLAYER); if (!wh) l2 = l; prew = p.in[I_NMPRE] + l2 * DM; }
    gi = (mode == 1) ? 2 : 5;
    pw = p.in[mode == 1 ? I_NMPOST : I_NFPOST] + l * DM;
}
__device__ __forceinline__ void comb_phase(int wv, const Params& p) {
    const int tid = otid(wv);
    const float* mod = (const float*)(p.ws + S_MOD); float* comb = (float*)(p.ws + S_COMB);
    for (int idx = obid() * NTHREADS + tid; idx < NLAYER * 3 * 9 * 2048; idx += gridDim.x * NTHREADS) {
        const int c = idx & 2047, q = idx >> 11, mi = q % 9, q2 = q / 9, mode = q2 % 3, l = q2 / 3;
        int l2, shi, sci, gi; const float* prew; const float* pw; bool wh;
        row_sel(p, l, mode, l2, shi, sci, prew, wh, gi, pw);
        float g = 0.f, sc = 0.f, sh = 0.f;
        for (int kc = 0; kc < 16; ++kc) {
            g += mod[((size_t)(l * 16 + kc) * 9 + mi) * 12288 + gi * 2048 + c];
            sc += mod[((size_t)(l2 * 16 + kc) * 9 + mi) * 12288 + sci * 2048 + c];
            sh += mod[((size_t)(l2 * 16 + kc) * 9 + mi) * 12288 + shi * 2048 + c];
        }
        g += p.in[I_ADAB][(size_t)l * 12288 + gi * 2048 + c];
        sc += p.in[I_ADAB][(size_t)l2 * 12288 + sci * 2048 + c];
        sh += p.in[I_ADAB][(size_t)l2 * 12288 + shi * 2048 + c];
        float* o = comb + (size_t)q * 3 * 2048 + c;
        o[0] = g * pw[c]; o[2048] = prew[c] * (1.0f + sc); o[4096] = sh;
    }
}
__device__ __forceinline__ void row_phase(int wv, const Params& p, int l, int mode) {
    const int tid = otid(wv); const int wave = obid() * 8 + (tid >> 6), nw = gridDim.x * 8, lane = tid & 63;
    float* X = p.out;
    bf16_t* H = (bf16_t*)(p.ws + A_H);
    const bool wh = !(mode == 2 && l + 1 >= NLAYER);
    const int rows_per = (MT + nw - 1) / nw;
    for (int rr = 0; rr < rows_per; ++rr) {
        const int row = wave * rows_per + rr;
        if (row >= MT) break;
        const int mi = row < MP ? 0 : 1 + ((row - MP) >> 11);
        const float* cb = (const float*)(p.ws + S_COMB) + (size_t)((l * 3 + mode) * 9 + mi) * 3 * 2048 + lane * 4;
        f32x4 x[8];
        const float* xs = (mode == 0) ? (row < MP ? p.in[I_XP] + (size_t)row * DM : p.in[I_XS] + (size_t)(row - MP) * DM) : X + (size_t)row * DM;
#pragma unroll
        for (int i = 0; i < 8; ++i) x[i] = *(const f32x4*)(xs + i * 256 + lane * 4);
        if (mode != 0) {
            const bf16_t* o = (const bf16_t*)(p.ws + (mode == 1 ? A_M32 : A_F32)) + (size_t)row * DM;
            const unsigned tm = ((const unsigned*)(p.ws + S_TAIL))[row >> 8];
            f32x4 ovv[8]; float ss = 0.f;
#pragma unroll
            for (int i = 0; i < 8; ++i) { const u32x2 w = *(const u32x2*)(o + i * 256 + lane * 4); ovv[i] = (f32x4){bf_lo(w.x), bf_hi(w.x), bf_lo(w.y), bf_hi(w.y)};
                if ((tm >> i) & 1u) { const u32x2 w2 = *(const u32x2*)(o + (size_t)MT * DM + i * 256 + lane * 4); ovv[i] += (f32x4){bf_lo(w2.x), bf_hi(w2.x), bf_lo(w2.y), bf_hi(w2.y)}; }
                ss += ovv[i][0] * ovv[i][0] + ovv[i][1] * ovv[i][1] + ovv[i][2] * ovv[i][2] + ovv[i][3] * ovv[i][3]; }
            ss = wave_sum(ss, lane);
            const float rstd = rsqrtf(ss * (1.0f / DM) + 1e-6f);
#pragma unroll
            for (int i = 0; i < 8; ++i) x[i] += *(const f32x4*)(cb + i * 256) * (ovv[i] * rstd);
        }
#pragma unroll
        for (int i = 0; i < 8; ++i) *(f32x4*)(X + (size_t)row * DM + i * 256 + lane * 4) = x[i];
        if (wh) {
            float ss = 0.f;
#pragma unroll
            for (int i = 0; i < 8; ++i) ss += x[i][0] * x[i][0] + x[i][1] * x[i][1] + x[i][2] * x[i][2] + x[i][3] * x[i][3];
            ss = wave_sum(ss, lane);
            const float rstd = rsqrtf(ss * (1.0f / DM) + 1e-6f);
#pragma unroll
            for (int i = 0; i < 8; ++i) {
                const f32x4 hv = (x[i] * rstd) * *(const f32x4*)(cb + 2048 + i * 256) + *(const f32x4*)(cb + 4096 + i * 256);
                u32x2 o; o.x = cvt_pk_bf16(hv[0], hv[1]); o.y = cvt_pk_bf16(hv[2], hv[3]);
                *(u32x2*)(H + (size_t)row * DM + i * 256 + lane * 4) = o;
            }
        }
    }
}

__device__ __forceinline__ void rope_table_phase(int wv, const Params& p) {
    float* C = (float*)(p.ws + S_ROPE); float* Sn = C + 2048 * 32;
    const int tid = otid(wv);
    for (int idx = obid() * NTHREADS + tid; idx < 2048 * 32; idx += gridDim.x * NTHREADS) {
        const int t = idx >> 5, i = idx & 31, k = i & 15;
        const float inv = exp2f(-(float)k * 0.8304820237218406f);
        const float pos = (i < 16) ? (float)(t >> 6) : (float)(t & 63);
        const float ang = pos * inv; C[idx] = cosf(ang); Sn[idx] = sinf(ang);
    }
}
__device__ __forceinline__ void e2_phase(int wv, const Params& p, int l, LAS unsigned char* lds) {
    const bf16_t* PA = (const bf16_t*)(p.ws + A_PROJA);
    const int tid = otid(wv), lane = tid & 63;
    {
        const int gidx = obid() * NTHREADS + tid;
        if (gidx < 2048) {
            const int g = gidx >> 10, d = gidx & 1023; const int NU = g ? 64 : 8;
            const float* part = (const float*)(p.ws + (g ? S_PARTS : S_PARTP));
            float tot = 0.f;
            for (int i = 0; i < NU; ++i) tot += part[i * 2048 + d] + part[i * 2048 + 1024 + d];
            ((float*)(p.ws + S_SCALE))[gidx] = 1.0f / tot;
        }
    }
    {
        bf16_t* CQN = (bf16_t*)(p.ws + A_CQN); bf16_t* KC = (bf16_t*)(p.ws + A_KEYSC); bf16_t* KP = (bf16_t*)(p.ws + A_KPER);
        float* out_ckv = p.out + (size_t)MT * DM; float* out_kpe = out_ckv + (size_t)BP * NLAYER * LP * 256;
        const int wave = obid() * 8 + (tid >> 6), nw = gridDim.x * 8;
        for (int row = wave; row < MT + BS * PAST; row += nw) {
            if (row < MT) {
                const bf16_t* pr = PA + (size_t)row * PA_LD;
                { const u32x4 v = *(const u32x4*)(pr + 3072 + lane * 8); float f[8]; unpack8(v, f); float ss = 0.f;
#pragma unroll
                  for (int j = 0; j < 8; ++j) ss += f[j] * f[j];
                  ss = wave_sum(ss, lane); const float rstd = rsqrtf(ss * (1.0f / 512.0f) + 1e-6f);
                  const float* qn = p.in[I_QN] + l * 512 + lane * 8;
#pragma unroll
                  for (int j = 0; j < 8; ++j) f[j] = f[j] * rstd * qn[j];
                  *(u32x4*)(CQN + (size_t)row * 512 + lane * 8) = pack8(f); }
                int KR, t; const bool isp = row < MP; int b;
                if (isp) { b = row >> 8; t = row & 255; KR = BS * LKS + row; } else { const int r2 = row - MP; b = r2 >> 11; t = r2 & 2047; KR = b * LKS + t; }
                { const u32x2 v = *(const u32x2*)(pr + 3584 + lane * 4); float f[4] = {bf_lo(v.x), bf_hi(v.x), bf_lo(v.y), bf_hi(v.y)};
                  float ss = f[0] * f[0] + f[1] * f[1] + f[2] * f[2] + f[3] * f[3]; ss = wave_sum(ss, lane); const float rstd = rsqrtf(ss * (1.0f / 256.0f) + 1e-6f);
                  const float* kn = p.in[I_KVN] + l * 256 + lane * 4;
#pragma unroll
                  for (int j = 0; j < 4; ++j) f[j] = f[j] * rstd * kn[j];
                  if (isp) *(f32x4*)(out_ckv + ((size_t)(b * NLAYER + l) * LP + t) * 256 + lane * 4) = (f32x4){f[0], f[1], f[2], f[3]};
                  u32x2 w; w.x = cvt_pk_bf16(f[0], f[1]); w.y = cvt_pk_bf16(f[2], f[3]); *(u32x2*)(KC + (size_t)KR * 256 + lane * 4) = w; }
                { const float v = __uint_as_float(((unsigned)pr[3840 + lane]) << 16);
                  float o = v;
                  if (isp) out_kpe[((size_t)(b * NLAYER + l) * LP + t) * 64 + lane] = v;
                  else { const float pv = shx(v, 32, lane); const float* rc = (const float*)(p.ws + S_ROPE); const float cs = rc[t * 32 + (lane & 31)], sn = rc[2048 * 32 + t * 32 + (lane & 31)]; o = (lane < 32) ? (v * cs - pv * sn) : (pv * sn + v * cs); }
                  KP[(size_t)KR * 64 + lane] = f2bf(o); }
            } else {
                const int r2 = row - MT, b = r2 >> 9, j = r2 & 511; const int KR = b * LKS + LS + j;
                const float* cc = p.in[I_CCKV] + ((size_t)(b * NLAYER + l) * PAST + j) * 256 + lane * 4;
                const f32x4 v = *(const f32x4*)cc; u32x2 w; w.x = cvt_pk_bf16(v[0], v[1]); w.y = cvt_pk_bf16(v[2], v[3]); *(u32x2*)(KC + (size_t)KR * 256 + lane * 4) = w;
                KP[(size_t)KR * 64 + lane] = f2bf(p.in[I_CKPE][((size_t)(b * NLAYER + l) * PAST + j) * 64 + lane]);
            }
        }
    }
    {
        bf16_t* YC = (bf16_t*)(p.ws + A_YC); const float* scw = p.in[I_SCW] + (size_t)l * 3 * 1024;
        for (int it = obid() * NTHREADS + tid; it < (MT / 4) * 128; it += gridDim.x * NTHREADS) {
            const int ch = it >> 7, d0 = (it & 127) * 8, row0 = ch * 4;
            const int t0 = row0 < MP ? (row0 & 255) : ((row0 - MP) & 2047); const int L = row0 < MP ? LP : LS;
            float w0[8], w1[8], w2[8];
            { const f32x4 a = *(const f32x4*)(scw + d0), b = *(const f32x4*)(scw + d0 + 4), c = *(const f32x4*)(scw + 1024 + d0), d = *(const f32x4*)(scw + 1024 + d0 + 4),
                          e2 = *(const f32x4*)(scw + 2048 + d0), f = *(const f32x4*)(scw + 2048 + d0 + 4);
#pragma unroll
              for (int j = 0; j < 4; ++j) { w0[j] = a[j]; w0[4 + j] = b[j]; w1[j] = c[j]; w1[4 + j] = d[j]; w2[j] = e2[j]; w2[4 + j] = f[j]; } }
            const bf16_t* pr = PA + (size_t)row0 * PA_LD;
            float pp[8], pc[8], pn[8];
#pragma unroll
            for (int j = 0; j < 8; ++j) pp[j] = 0.f;
            if (t0 > 0) { float cg[8], uu[8]; unpack8(*(const u32x4*)(pr - PA_LD + 4928 + d0), cg); unpack8(*(const u32x4*)(pr - PA_LD + 5952 + d0), uu);
#pragma unroll
                for (int j = 0; j < 8; ++j) pp[j] = cg[j] * uu[j]; }
            { float cg[8], uu[8]; unpack8(*(const u32x4*)(pr + 4928 + d0), cg); unpack8(*(const u32x4*)(pr + 5952 + d0), uu);
#pragma unroll
              for (int j = 0; j < 8; ++j) pc[j] = cg[j] * uu[j]; }
#pragma unroll
            for (int i = 0; i < 4; ++i) {
#pragma unroll
                for (int j = 0; j < 8; ++j) pn[j] = 0.f;
                if (t0 + i + 1 < L) { float cg[8], uu[8]; unpack8(*(const u32x4*)(pr + (size_t)(i + 1) * PA_LD + 4928 + d0), cg); unpack8(*(const u32x4*)(pr + (size_t)(i + 1) * PA_LD + 5952 + d0), uu);
#pragma unroll
                    for (int j = 0; j < 8; ++j) pn[j] = cg[j] * uu[j]; }
                float bg[8], o[8]; unpack8(*(const u32x4*)(pr + (size_t)i * PA_LD + 3904 + d0), bg);
#pragma unroll
                for (int j = 0; j < 8; ++j) { o[j] = bg[j] * (w0[j] * pp[j] + w1[j] * pc[j] + w2[j] * pn[j]); pp[j] = pc[j]; pc[j] = pn[j]; }
                *(u32x4*)(YC + (size_t)(row0 + i) * 1024 + d0) = pack8(o);
            }
        }
    }
    {
        bf16_t* X0S = (bf16_t*)(p.ws + A_X0S); bf16_t* ZZT = (bf16_t*)(p.ws + A_ZZT);
        const float* hw = p.in[I_HCW] + (size_t)l * 3 * 3072; const float* hb = p.in[I_HCB] + (size_t)l * 3072;
        LAS bf16_t* zt = (LAS bf16_t*)lds;
        for (int u = obid(); u < (MT / 256) * 16; u += gridDim.x) {
            const int rt = u >> 4, dt = u & 15; const int row0 = rt * 256;
            const int dg = tid & 7, rb = tid >> 3, d0 = dt * 64 + dg * 8; const int rowb = row0 + rb * 4;
            const int L = row0 < MP ? LP : LS; const int tb = (row0 < MP ? (row0 & 255) : ((row0 - MP) & 2047)) + rb * 4;
            float wgt[3][3][8], bs[3][8];
#pragma unroll
            for (int g = 0; g < 3; ++g) {
#pragma unroll
                for (int o = 0; o < 3; ++o) { const f32x4 a = *(const f32x4*)(hw + o * 3072 + g * 1024 + d0), b = *(const f32x4*)(hw + o * 3072 + g * 1024 + d0 + 4);
#pragma unroll
                    for (int j = 0; j < 4; ++j) { wgt[g][o][j] = a[j]; wgt[g][o][4 + j] = b[j]; } }
                const f32x4 a = *(const f32x4*)(hb + g * 1024 + d0), b = *(const f32x4*)(hb + g * 1024 + d0 + 4);
#pragma unroll
                for (int j = 0; j < 4; ++j) { bs[g][j] = a[j]; bs[g][4 + j] = b[j]; }
            }
            const bf16_t* pr = PA + (size_t)rowb * PA_LD + d0;
            u32x4 wp[3], wc[3], wn[3];
#pragma unroll
            for (int g = 0; g < 3; ++g) { wp[g] = (u32x4){0u, 0u, 0u, 0u}; if (tb > 0) wp[g] = *(const u32x4*)(pr - PA_LD + g * 1024); wc[g] = *(const u32x4*)(pr + g * 1024); }
#pragma unroll
            for (int i = 0; i < 4; ++i) {
#pragma unroll
                for (int g = 0; g < 3; ++g) { wn[g] = (u32x4){0u, 0u, 0u, 0u}; if (tb + i + 1 < L) wn[g] = *(const u32x4*)(pr + (size_t)(i + 1) * PA_LD + g * 1024); }
                float hv[3][8];
#pragma unroll
                for (int g = 0; g < 3; ++g) { float a[8], b[8], c[8]; unpack8(wp[g], a); unpack8(wc[g], b); unpack8(wn[g], c);
#pragma unroll
                    for (int j = 0; j < 8; ++j) hv[g][j] = bs[g][j] + wgt[g][0][j] * a[j] + wgt[g][1][j] * b[j] + wgt[g][2][j] * c[j];
                    wp[g] = wc[g]; wc[g] = wn[g]; }
                *(u32x4*)(X0S + (size_t)(rowb + i) * 1024 + d0) = pack8(hv[0]);
#pragma unroll
                for (int j = 0; j < 8; ++j) zt[(dg * 8 + j) * 264 + rb * 4 + i] = f2bf(hv[1][j] * hv[2][j]);
            }
            __syncthreads();
#pragma unroll
            for (int i = 0; i < 4; ++i) {
                const int chunk = tid + i * NTHREADS; const int dl = chunk >> 5, tch = chunk & 31; const int d = dt * 64 + dl;
                size_t base; int t0;
                if (row0 < MP) { const int b = row0 >> 8; t0 = 0; base = ((size_t)b * 1024 + d) * LP; }
                else { const int r2 = row0 - MP; const int b = r2 >> 11; t0 = r2 & 2047; base = (size_t)BP * 1024 * LP + ((size_t)b * 1024 + d) * LS; }
                *(u32x4*)(ZZT + base + t0 + tch * 8) = *(const LAS u32x4*)(zt + dl * 264 + tch * 8);
            }
            __syncthreads();
        }
    }
}

__device__ __forceinline__ void conv_phase(int wv, const Params& p, int l, LAS unsigned char* lds) {
    const int tid = otid(wv), wid = tid >> 6, lane = tid & 63, r = lane & 31, hh = lane >> 5;
    const bf16_t* ZZT = (const bf16_t*)(p.ws + A_ZZT); bf16_t* YCT = (bf16_t*)(p.ws + A_YCT);
    const float* hbias = p.in[I_HBIAS] + l * 1024;
    LAS bf16_t* cp = (LAS bf16_t*)lds;
    LAS bf16_t* zz = (LAS bf16_t*)(lds + 65536);
    LAS float* kf = (LAS float*)(lds + 98304);
    for (int u = obid(); u < 2048; u += gridDim.x) {
        const int g = (u < 1024) ? 1 : 0, d = u & 1023;
        const int L = g ? LS : LP, B = g ? BS : BP, L2 = 2 * L, NB = L / 32, NI = 32 / B, NT = NB / NI, lgB = g ? 3 : 4;
        const float* kT = (const float*)(p.ws + (g ? S_KTS : S_KTP)) + (size_t)d * L2;
        const float scale = ((const float*)(p.ws + S_SCALE))[g * 1024 + d]; const float bias = hbias[d];
        for (int i = tid; i < L2 / 4; i += NTHREADS) { f32x4 v = *(const f32x4*)(kT + i * 4); v *= scale; if (i == 0) v[0] += bias; *(LAS f32x4*)(kf + i * 4) = v; }
        const size_t zbase = g ? (size_t)BP * 1024 * LP : 0;
        for (int ch = tid; ch < B * L / 8; ch += NTHREADS) {
            const int b = ch / (L / 8), s8 = ch - b * (L / 8);
            *(LAS u32x4*)(zz + b * L + s8 * 8) = *(const u32x4*)(ZZT + zbase + ((size_t)b * 1024 + d) * L + s8 * 8);
        }
        __syncthreads();
        for (int ck = tid; ck < L2; ck += NTHREADS) {
            const int c = ck / (L2 / 8), m0 = (ck - c * (L2 / 8)) * 8;
            float f[8];
#pragma unroll
            for (int j = 0; j < 8; ++j) f[j] = kf[(L2 - (m0 + c + j)) & (L2 - 1)];
            *(LAS u32x4*)(cp + c * L2 + m0) = pack8(f);
        }
        __syncthreads();
        const int Iloc = r >> lgB, b = r & (B - 1);
        for (int nt = wid * 2; nt < NT; nt += 16) {
            const int I0 = nt * NI;
            f32x16 acc0, acc1;
#pragma unroll
            for (int i = 0; i < 16; ++i) { acc0[i] = 0.f; acc1[i] = 0.f; }
            const bf16x8 zero8 = (bf16x8){0, 0, 0, 0, 0, 0, 0, 0};
            bf16x8 prev[4][2];
#pragma unroll
            for (int i = 0; i < 4; ++i) { prev[i][0] = zero8; prev[i][1] = zero8; }
            const int dl0 = I0 - (NB - 1), nsteps = NB + 2 * NI - 1;
            if (NI == 4) {
                for (int c4 = 0; c4 < nsteps; c4 += 4) {
                    bf16x8 cur[4][2];
#pragma unroll
                    for (int i = 0; i < 4; ++i) {
                        const int dl = dl0 + c4 + i; const int J0 = I0 + Iloc - dl; const bool v0 = (J0 >= 0) && (J0 < NB);
#pragma unroll
                        for (int ks = 0; ks < 2; ++ks) {
                            const int i0 = (16 * ks + 8 * hh - 32 * dl - r) & (L2 - 1); const int c = i0 & 7, q = i0 >> 3;
                            const bf16x8 Af = *(const LAS bf16x8*)(cp + c * L2 + q * 8);
                            cur[i][ks] = zero8;
                            if (v0) cur[i][ks] = *(const LAS bf16x8*)(zz + b * L + 32 * J0 + 16 * ks + 8 * hh);
                            acc0 = __builtin_amdgcn_mfma_f32_32x32x16_bf16(Af, cur[i][ks], acc0, 0, 0, 0);
                            acc1 = __builtin_amdgcn_mfma_f32_32x32x16_bf16(Af, prev[i][ks], acc1, 0, 0, 0);
                        }
                    }
#pragma unroll
                    for (int i = 0; i < 4; ++i) { prev[i][0] = cur[i][0]; prev[i][1] = cur[i][1]; }
                }
            } else {
                for (int c2 = 0; c2 < nsteps + 1; c2 += 2) {
                    bf16x8 cur[2][2];
#pragma unroll
                    for (int i = 0; i < 2; ++i) {
                        const int dl = dl0 + c2 + i; const int J0 = I0 + Iloc - dl; const bool v0 = (J0 >= 0) && (J0 < NB);
#pragma unroll
                        for (int ks = 0; ks < 2; ++ks) {
                            const int i0 = (16 * ks + 8 * hh - 32 * dl - r) & (L2 - 1); const int c = i0 & 7, q = i0 >> 3;
                            const bf16x8 Af = *(const LAS bf16x8*)(cp + c * L2 + q * 8);
                            cur[i][ks] = zero8;
                            if (v0) cur[i][ks] = *(const LAS bf16x8*)(zz + b * L + 32 * J0 + 16 * ks + 8 * hh);
                            acc0 = __builtin_amdgcn_mfma_f32_32x32x16_bf16(Af, cur[i][ks], acc0, 0, 0, 0);
                            acc1 = __builtin_amdgcn_mfma_f32_32x32x16_bf16(Af, prev[i][ks], acc1, 0, 0, 0);
                        }
                    }
#pragma unroll
                    for (int i = 0; i < 2; ++i) { prev[i][0] = cur[i][0]; prev[i][1] = cur[i][1]; }
                }
            }
            bf16_t* op = YCT + zbase + ((size_t)b * 1024 + d) * L + 32 * (I0 + Iloc) + 4 * hh;
#pragma unroll
            for (int g4 = 0; g4 < 4; ++g4) {
                u32x2 w; w.x = cvt_pk_bf16(acc0[4 * g4], acc0[4 * g4 + 1]); w.y = cvt_pk_bf16(acc0[4 * g4 + 2], acc0[4 * g4 + 3]); *(u32x2*)(op + 8 * g4) = w;
                u32x2 w1; w1.x = cvt_pk_bf16(acc1[4 * g4], acc1[4 * g4 + 1]); w1.y = cvt_pk_bf16(acc1[4 * g4 + 2], acc1[4 * g4 + 3]); *(u32x2*)(op + 32 * NI + 8 * g4) = w1;
            }
        }
        __syncthreads();
    }
}

__device__ __forceinline__ void e3b_phase(int wv, const Params& p, LAS unsigned char* lds) {
    const int tid = otid(wv);
    const bf16_t* X0S = (const bf16_t*)(p.ws + A_X0S); const bf16_t* YCT = (const bf16_t*)(p.ws + A_YCT); bf16_t* YA = (bf16_t*)(p.ws + A_YA);
    LAS bf16_t* yt = (LAS bf16_t*)lds;
    for (int u = obid(); u < (MT / 64) * 16; u += gridDim.x) {
        const int rt = u >> 4, dt = u & 15; const int row0 = rt * 64;
        {
            const int dl = tid >> 3, tch = tid & 7; const int d = dt * 64 + dl;
            size_t base; int t0;
            if (row0 < MP) { const int b = row0 >> 8; t0 = row0 & 255; base = ((size_t)b * 1024 + d) * LP; }
            else { const int r2 = row0 - MP; const int b = r2 >> 11; t0 = r2 & 2047; base = (size_t)BP * 1024 * LP + ((size_t)b * 1024 + d) * LS; }
            const u32x4 v = *(const u32x4*)(YCT + base + t0 + tch * 8);
            const unsigned w[4] = {v.x, v.y, v.z, v.w};
#pragma unroll
            for (int j = 0; j < 4; ++j) { yt[(tch * 8 + 2 * j) * 72 + dl] = (bf16_t)(w[j] & 0xffffu); yt[(tch * 8 + 2 * j + 1) * 72 + dl] = (bf16_t)(w[j] >> 16); }
        }
        __syncthreads();
        {
            const int tl = tid >> 3, dg = tid & 7; const int row = row0 + tl, d0 = dt * 64 + dg * 8;
            float a[8], b[8]; unpack8(*(const LAS u32x4*)(yt + tl * 72 + dg * 8), a); unpack8(*(const u32x4*)(X0S + (size_t)row * 1024 + d0), b);
#pragma unroll
            for (int j = 0; j < 8; ++j) a[j] *= b[j];
            *(u32x4*)(YA + (size_t)row * 1024 + d0) = pack8(a);
        }
        __syncthreads();
    }
}

__device__ __forceinline__ void attn_phase(int wv, const Params& p, LAS unsigned char* lds) {
    const bf16_t* Q = (const bf16_t*)(p.ws + A_Q); const bf16_t* KN = (const bf16_t*)(p.ws + A_KN); const bf16_t* KP = (const bf16_t*)(p.ws + A_KPER);
    const bf16_t* VT = (const bf16_t*)(p.ws + A_VT); bf16_t* O = (bf16_t*)(p.ws + A_OATT);
    LAS unsigned char* Ks = lds;
    LAS unsigned char* Vs = lds + 64 * 400;
    const float sc2 = 0.07216878364870322f * 1.4426950408889634f;
    for (int u = obid(); u < 512 + 128; u += gridDim.x) {
        const int tid = otid(wv), wid = tid >> 6, lane = tid & 63, r = lane & 31, hh = lane >> 5;
        int b, h, row0, Lk, KR0; size_t vtb; bool samp;
        if (u < 512) { samp = true; b = u >> 6; h = (u >> 3) & 7; const int qb = u & 7; row0 = MP + b * LS + qb * 256; Lk = LKS; KR0 = b * LKS; vtb = (size_t)(b * 8 + h) * 128 * LKS; }
        else { samp = false; const int u2 = u - 512; b = u2 >> 3; h = u2 & 7; row0 = b * LP; Lk = LP; KR0 = BS * LKS + b * LP; vtb = (size_t)BS * 8 * 128 * LKS + (size_t)(b * 8 + h) * 128 * LP; }
        const int qrow = row0 + wid * 32 + r;
        bf16x8 qf[12];
        {
            const bf16_t* qp = Q + (size_t)qrow * 1536 + h * 192 + 8 * hh;
            u32x4 qv[12];
#pragma unroll
            for (int s = 0; s < 12; ++s) qv[s] = *(const u32x4*)(qp + 16 * s);
            if (samp) {
                const int t = (qrow - MP) & 2047;
#pragma unroll
                for (int s2 = 0; s2 < 2; ++s2) {
                    float x1[8], x2[8]; unpack8(qv[8 + s2], x1); unpack8(qv[10 + s2], x2);
                    const float* rc = (const float*)(p.ws + S_ROPE) + t * 32 + 16 * s2 + 8 * hh;
                    const f32x4 c0 = *(const f32x4*)rc, c1 = *(const f32x4*)(rc + 4), s0 = *(const f32x4*)(rc + 2048 * 32), s1 = *(const f32x4*)(rc + 2048 * 32 + 4);
#pragma unroll
                    for (int j = 0; j < 8; ++j) { const float cs = (j < 4) ? c0[j & 3] : c1[j & 3], sn = (j < 4) ? s0[j & 3] : s1[j & 3]; const float a = x1[j], c = x2[j]; x1[j] = a * cs - c * sn; x2[j] = a * sn + c * cs; }
                    qv[8 + s2] = pack8(x1); qv[10 + s2] = pack8(x2);
                }
            }
#pragma unroll
            for (int s = 0; s < 12; ++s) qf[s] = __builtin_bit_cast(bf16x8, qv[s]);
        }
        f32x16 oacc[4];
#pragma unroll
        for (int ct = 0; ct < 4; ++ct)
#pragma unroll
            for (int i = 0; i < 16; ++i) oacc[ct][i] = 0.f;
        float mrun = -1e30f, lrun = 0.f;
        const int nkt = Lk / 64;
        u32x4 kst[3], vst[2];
#pragma unroll
        for (int i = 0; i < 3; ++i) { const int ck = tid + i * NTHREADS; const int key = ck / 24, part = ck - key * 24;
            kst[i] = (part < 16) ? *(const u32x4*)(KN + (size_t)(KR0 + key) * 1024 + h * 128 + part * 8) : *(const u32x4*)(KP + (size_t)(KR0 + key) * 64 + (part - 16) * 8); }
#pragma unroll
        for (int i = 0; i < 2; ++i) { const int cv = tid + i * NTHREADS; const int v = cv >> 3, kc = cv & 7; vst[i] = *(const u32x4*)(VT + vtb + (size_t)v * Lk + kc * 8); }
        for (int kt = 0; kt < nkt; ++kt) {
            __syncthreads();
#pragma unroll
            for (int i = 0; i < 3; ++i) { const int ck = tid + i * NTHREADS; const int key = ck / 24, part = ck - key * 24; *(LAS u32x4*)(Ks + key * 400 + part * 16) = kst[i]; }
#pragma unroll
            for (int i = 0; i < 2; ++i) { const int cv = tid + i * NTHREADS; const int v = cv >> 3, kc = cv & 7;
                LAS unsigned char* vp = Vs + v * 144 + (kc >> 1) * 32 + (kc & 1) * 8;
                *(LAS u32x2*)vp = (u32x2){vst[i].x, vst[i].y}; *(LAS u32x2*)(vp + 16) = (u32x2){vst[i].z, vst[i].w}; }
            __syncthreads();
            if (kt + 1 < nkt) {
                const int k0 = (kt + 1) * 64;
#pragma unroll
                for (int i = 0; i < 3; ++i) { const int ck = tid + i * NTHREADS; const int key = ck / 24, part = ck - key * 24;
                    kst[i] = (part < 16) ? *(const u32x4*)(KN + (size_t)(KR0 + k0 + key) * 1024 + h * 128 + part * 8) : *(const u32x4*)(KP + (size_t)(KR0 + k0 + key) * 64 + (part - 16) * 8); }
#pragma unroll
                for (int i = 0; i < 2; ++i) { const int cv = tid + i * NTHREADS; const int v = cv >> 3, kc = cv & 7; vst[i] = *(const u32x4*)(VT + vtb + (size_t)v * Lk + k0 + kc * 8); }
            }
            f32x16 sacc[2];
#pragma unroll
            for (int i = 0; i < 16; ++i) { sacc[0][i] = 0.f; sacc[1][i] = 0.f; }
#pragma unroll
            for (int s = 0; s < 12; ++s) {
                const bf16x8 kf0 = *(const LAS bf16x8*)(Ks + r * 400 + (16 * s + 8 * hh) * 2);
                const bf16x8 kf1 = *(const LAS bf16x8*)(Ks + (32 + r) * 400 + (16 * s + 8 * hh) * 2);
                sacc[0] = __builtin_amdgcn_mfma_f32_32x32x16_bf16(kf0, qf[s], sacc[0], 0, 0, 0);
                sacc[1] = __builtin_amdgcn_mfma_f32_32x32x16_bf16(kf1, qf[s], sacc[1], 0, 0, 0);
            }
            float mx0 = fmaxf(sacc[0][0], sacc[1][0]), mx1 = fmaxf(sacc[0][1], sacc[1][1]);
#pragma unroll
            for (int i = 2; i < 16; i += 2) { mx0 = __builtin_fmaxf(__builtin_fmaxf(mx0, sacc[0][i]), sacc[1][i]); mx1 = __builtin_fmaxf(__builtin_fmaxf(mx1, sacc[0][i + 1]), sacc[1][i + 1]); }
            float mx = fmaxf(mx0, mx1);
            mx = fmaxf(mx, shx(mx, 32, lane));
            const float mnew = fmaxf(mrun, mx);
            const bool resc = __builtin_amdgcn_ballot_w64(mnew != mrun) != 0ull;
            const float alpha = __builtin_amdgcn_exp2f((mrun - mnew) * sc2);
            mrun = mnew;
            const float nm = -mnew * sc2;
            f32x2 ps2 = (f32x2){0.f, 0.f};
#pragma unroll
            for (int kk = 0; kk < 2; ++kk)
#pragma unroll
                for (int i = 0; i < 16; i += 2) {
                    f32x2 a = (f32x2){sacc[kk][i], sacc[kk][i + 1]}; a = a * sc2 + nm;
                    a.x = __builtin_amdgcn_exp2f(a.x); a.y = __builtin_amdgcn_exp2f(a.y);
                    sacc[kk][i] = a.x; sacc[kk][i + 1] = a.y; ps2 += a;
                }
            lrun = lrun * alpha + (ps2.x + ps2.y);
            if (resc) {
#pragma unroll
                for (int ct = 0; ct < 4; ++ct)
#pragma unroll
                    for (int i = 0; i < 16; ++i) oacc[ct][i] *= alpha;
            }
#pragma unroll
            for (int ks = 0; ks < 4; ++ks) {
                const int kk = ks >> 1, s2 = ks & 1;
                u32x4 pw;
                pw.x = cvt_pk_bf16(sacc[kk][8 * s2 + 0], sacc[kk][8 * s2 + 1]); pw.y = cvt_pk_bf16(sacc[kk][8 * s2 + 2], sacc[kk][8 * s2 + 3]);
                pw.z = cvt_pk_bf16(sacc[kk][8 * s2 + 4], sacc[kk][8 * s2 + 5]); pw.w = cvt_pk_bf16(sacc[kk][8 * s2 + 6], sacc[kk][8 * s2 + 7]);
                const bf16x8 pf = __builtin_bit_cast(bf16x8, pw);
#pragma unroll
                for (int ct = 0; ct < 4; ++ct) {
                    const bf16x8 vf = *(const LAS bf16x8*)(Vs + (32 * ct + r) * 144 + (32 * kk + 16 * s2) * 2 + 16 * hh);
                    oacc[ct] = __builtin_amdgcn_mfma_f32_32x32x16_bf16(vf, pf, oacc[ct], 0, 0, 0);
                }
            }
        }
        lrun += shx(lrun, 32, lane);
        const float invl = 1.0f / lrun;
        const int tid2 = otid(wv); const int qrow2 = row0 + (tid2 >> 6) * 32 + (tid2 & 31);
        bf16_t* op = O + (size_t)qrow2 * 1024 + h * 128 + 4 * ((tid2 >> 5) & 1);
#pragma unroll
        for (int ct = 0; ct < 4; ++ct)
#pragma unroll
            for (int g4 = 0; g4 < 4; ++g4) {
                u32x2 w; w.x = cvt_pk_bf16(oacc[ct][4 * g4] * invl, oacc[ct][4 * g4 + 1] * invl); w.y = cvt_pk_bf16(oacc[ct][4 * g4 + 2] * invl, oacc[ct][4 * g4 + 3] * invl);
                *(u32x2*)(op + 32 * ct + 8 * g4) = w;
            }
        __syncthreads();
    }
}

__device__ __forceinline__ void e9_phase(int wv, const Params& p, int l) {
    const bf16_t* UU = (const bf16_t*)(p.ws + A_UU); bf16_t* ACT = (bf16_t*)(p.ws + A_ACT);
    const float* cw = p.in[I_FCW] + (size_t)l * 3 * UU_LD; const float* cb = p.in[I_FCB] + (size_t)l * UU_LD;
    const int tid9 = otid(wv);
    constexpr int RC = 16, NCG = DFF / 8;
    for (int it = obid() * NTHREADS + tid9; it < (MT / RC) * NCG; it += gridDim.x * NTHREADS) {
        const int ch = it / NCG, c0 = (it - ch * NCG) * 8, row0 = ch * RC;
        const int t0 = row0 < MP ? (row0 & 255) : ((row0 - MP) & 2047); const int L = row0 < MP ? LP : LS;
        float wg[3][8], wx[3][8], bg[8], bx[8];
#pragma unroll
        for (int o = 0; o < 3; ++o) { const f32x4 a = *(const f32x4*)(cw + o * UU_LD + c0), b = *(const f32x4*)(cw + o * UU_LD + c0 + 4), c = *(const f32x4*)(cw + o * UU_LD + DFF + c0), d = *(const f32x4*)(cw + o * UU_LD + DFF + c0 + 4);
#pragma unroll
            for (int j = 0; j < 4; ++j) { wg[o][j] = a[j]; wg[o][4 + j] = b[j]; wx[o][j] = c[j]; wx[o][4 + j] = d[j]; } }
        { const f32x4 a = *(const f32x4*)(cb + c0), b = *(const f32x4*)(cb + c0 + 4), c = *(const f32x4*)(cb + DFF + c0), d = *(const f32x4*)(cb + DFF + c0 + 4);
#pragma unroll
          for (int j = 0; j < 4; ++j) { bg[j] = a[j]; bg[4 + j] = b[j]; bx[j] = c[j]; bx[4 + j] = d[j]; } }
        const bf16_t* pr = UU + (size_t)row0 * UU_LD + c0;
        u32x4 gp = (u32x4){0u, 0u, 0u, 0u}, xp = gp, gc, xc, gn, xn;
        if (t0 > 0) { gp = *(const u32x4*)(pr - UU_LD); xp = *(const u32x4*)(pr - UU_LD + DFF); }
        gc = *(const u32x4*)pr; xc = *(const u32x4*)(pr + DFF);
#pragma unroll 4
        for (int i = 0; i < RC; ++i) {
            gn = (u32x4){0u, 0u, 0u, 0u}; xn = gn;
            if (t0 + i + 1 < L) { gn = *(const u32x4*)(pr + (size_t)(i + 1) * UU_LD); xn = *(const u32x4*)(pr + (size_t)(i + 1) * UU_LD + DFF); }
            float a[8], b[8], c[8], ga[8], va[8];
            unpack8(gp, a); unpack8(gc, b); unpack8(gn, c);
#pragma unroll
            for (int j = 0; j < 8; ++j) ga[j] = bg[j] + wg[0][j] * a[j] + wg[1][j] * b[j] + wg[2][j] * c[j];
            unpack8(xp, a); unpack8(xc, b); unpack8(xn, c);
#pragma unroll
            for (int j = 0; j < 8; ++j) va[j] = bx[j] + wx[0][j] * a[j] + wx[1][j] * b[j] + wx[2][j] * c[j];
#pragma unroll
            for (int j = 0; j < 8; ++j) ga[j] = siluf_(ga[j]) * va[j];
            *(u32x4*)(ACT + (size_t)(row0 + i) * DFF + c0) = pack8(ga);
            gp = gc; gc = gn; xp = xc; xc = xn;
        }
    }
}

__device__ __forceinline__ void merge_phase(int wv, const Params& p) {
    const bf16_t* RAW = (const bf16_t*)(p.ws + A_RAW); const bf16_t* G = (const bf16_t*)(p.ws + A_GATES); bf16_t* MB = (bf16_t*)(p.ws + A_MBF);
    const int tid = otid(wv);
    for (int it = obid() * NTHREADS + tid; it < MT * 256; it += gridDim.x * NTHREADS) {
        const int row = it >> 8, c0 = (it & 255) * 8;
        float acc[8];
#pragma unroll
        for (int j = 0; j < 8; ++j) acc[j] = 0.f;
#pragma unroll
        for (int P = 0; P < 3; ++P) {
            float r[8], g[8];
            unpack8(*(const u32x4*)(RAW + ((size_t)P * MT + row) * DM + c0), r); unpack8(*(const u32x4*)(G + (size_t)row * GATE_LD + P * 2048 + c0), g);
#pragma unroll
            for (int j = 0; j < 8; ++j) acc[j] += sigmoidf_(g[j]) * r[j];
        }
        *(u32x4*)(MB + (size_t)row * DM + c0) = pack8(acc);
    }
}

__device__ __forceinline__ void convert_layer(int wv, const Params& p, int l, LAS unsigned char* lds) {
    unsigned char* ws = p.ws;
    convT(wv, p.in[I_WIN] + (size_t)l * DM * NIN, DM, NIN, (bf16_t*)(ws + W_IN), 1, lds);
    convT(wv, p.in[I_WUQ] + (size_t)l * 512 * 1536, 512, 1536, (bf16_t*)(ws + W_UQ), 0, lds);
    convT(wv, p.in[I_WUKV] + (size_t)l * 256 * 2048, 256, 2048, (bf16_t*)(ws + W_UKV), 2, lds);
    convT(wv, p.in[I_WBRA] + (size_t)l * 1024 * 2048, 1024, 2048, (bf16_t*)(ws + W_BRA), 0, lds);
    convT(wv, p.in[I_WBRB] + (size_t)l * 1024 * 2048, 1024, 2048, (bf16_t*)(ws + W_BRB), 0, lds);
    convT(wv, p.in[I_WBRC] + (size_t)l * 1024 * 2048, 1024, 2048, (bf16_t*)(ws + W_BRC), 0, lds);
    convT(wv, p.in[I_WO] + (size_t)l * 2048 * 2048, 2048, 2048, (bf16_t*)(ws + W_O), 0, lds);
    convT(wv, p.in[I_FUP] + (size_t)l * 2048 * UU_LD, 2048, UU_LD, (bf16_t*)(ws + W_UP), 0, lds);
    convT(wv, p.in[I_FDN] + (size_t)l * DFF * 2048, DFF, 2048, (bf16_t*)(ws + W_DN), 0, lds);
}

namespace pg8 {
struct EpiGateRT {
    const bf16_t* gates; float* m32; bf16_t* mbf; int P;
    __device__ __forceinline__ void operator()(const f32x4 (&acc)[2][2][4][2], const Unit& u, int wr, int wc, int fr, int fq) const {
        const int row0 = u.pm * BM + wr * 64 + fr, col0 = u.pn * BM + wc * 32 + 4 * fq;
#pragma unroll
        for (int ai = 0; ai < 2; ++ai)
#pragma unroll
            for (int m = 0; m < 4; ++m) {
                const size_t row = (size_t)(row0 + ai * HALF + m * 16);
#pragma unroll
                for (int bj = 0; bj < 2; ++bj)
#pragma unroll
                    for (int n = 0; n < 2; ++n) {
                        const int col = col0 + bj * HALF + n * 16;
                        const u32x2 gw = *(const u32x2*)(gates + row * GATE_LD + P * 2048 + col);
                        f32x4 v = acc[ai][bj][m][n];
                        v[0] *= sigmoidf_(bf_lo(gw.x)); v[1] *= sigmoidf_(bf_hi(gw.x)); v[2] *= sigmoidf_(bf_lo(gw.y)); v[3] *= sigmoidf_(bf_hi(gw.y));
                        float* mp = m32 + row * 2048 + col;
                        if (P != 0) { const f32x4 o = *(const f32x4*)mp; v = v + o; }
                        if (P != 2) { *(f32x4*)mp = v; }
                        else { u32x2 w; w.x = cvt_pk_bf16(v[0], v[1]); w.y = cvt_pk_bf16(v[2], v[3]); *(u32x2*)(mbf + row * 2048 + col) = w; }
                    }
            }
    }
};
}


#define XB_TMO      128
#define XB_XCNT(j)  (256  + 64 * (j))
#define XB_XSUB(j)  (1280 + 64 * (j))
#define XB_XGEN(j)  (2304 + 64 * (j))
#define XB_TOP      3328
#define XB_TOPGEN   3392
#define XCD_BAR_WORDS 3456
#define XB_SPIN_CAP (1u << 20)
__device__ __forceinline__ unsigned xb_ld(unsigned* p)              { return __hip_atomic_load(p, __ATOMIC_RELAXED, __HIP_MEMORY_SCOPE_AGENT); }
__device__ __forceinline__ unsigned xb_add(unsigned* p, unsigned v) { return __hip_atomic_fetch_add(p, v, __ATOMIC_RELAXED, __HIP_MEMORY_SCOPE_AGENT); }
__device__ __forceinline__ unsigned xb_xcc_id() { return (unsigned)__builtin_amdgcn_s_getreg((3 << 11) | 20) & 0xFu; }
#define XB_SPIN(cond, bar) do { unsigned _sp = 0; while (cond) { __builtin_amdgcn_s_sleep(1); \
    if ((++_sp & 255u) == 0u) { if (xb_ld(&(bar)[XB_TMO])) break; if (_sp > XB_SPIN_CAP) { atomicAdd(&(bar)[XB_TMO], 1u); break; } } } } while (0)
__device__ __forceinline__ void xcd_barrier_complete(unsigned* bar, unsigned x, unsigned& nloc, unsigned& nx) {
    const unsigned G = gridDim.x;
    unsigned sum, cnt, mine, sp = 0u;
    for (;;) {
        sum = 0u; cnt = 0u; mine = 0u;
#pragma unroll
        for (unsigned j = 0; j < 16; ++j) { const unsigned c = xb_ld(&bar[XB_XCNT(j)]); sum += c; cnt += (c > 0u) ? 1u : 0u; mine = (j == x) ? c : mine; }
        if (sum == G) break;
        __builtin_amdgcn_s_sleep(1);
        if ((++sp & 255u) == 0u) { if (xb_ld(&bar[XB_TMO])) break; if (sp > XB_SPIN_CAP) { atomicAdd(&bar[XB_TMO], 1u); break; } }
    }
    nloc = mine > 0u ? mine : 1u; nx = cnt > 0u ? cnt : 1u;
}
__device__ __forceinline__ void xcd_barrier(int wv, unsigned* bar, volatile LAS unsigned* st) {
    asm volatile("s_waitcnt vmcnt(0)" ::: "memory");
    __syncthreads();
    if (otid(wv) == 0) {
        __builtin_amdgcn_s_waitcnt(0);
        const unsigned x = xb_xcc_id();
        unsigned nloc = st[0], nx = st[1];
        if (nloc == 0u) { xcd_barrier_complete(bar, x, nloc, nx); st[0] = nloc; st[1] = nx; }
        const unsigned old = xb_add(&bar[XB_XSUB(x)], 1u);
        const unsigned gen = old / nloc;
        if (old + 1u == (gen + 1u) * nloc) {
            __builtin_amdgcn_fence(__ATOMIC_RELEASE, "agent");
            asm volatile("s_waitcnt vmcnt(0)" ::: "memory");
            const unsigned og = xb_add(&bar[XB_TOP], 1u);
            const unsigned tg = og / nx;
            if (og + 1u == (tg + 1u) * nx) xb_add(&bar[XB_TOPGEN], 1u);
            else XB_SPIN(xb_ld(&bar[XB_TOPGEN]) == tg, bar);
            __builtin_amdgcn_fence(__ATOMIC_ACQUIRE, "agent");
            xb_add(&bar[XB_XGEN(x)], 1u);
            asm volatile("s_waitcnt vmcnt(0)" ::: "memory");
        } else {
            XB_SPIN(xb_ld(&bar[XB_XGEN(x)]) == gen, bar);
            __builtin_amdgcn_fence(__ATOMIC_ACQUIRE, "agent");
            asm volatile("s_waitcnt vmcnt(0)" ::: "memory");
        }
    }
    __syncthreads();
}

#ifndef REP_GEMM
#define REP_GEMM 1
#endif
#ifndef REP_ATTN
#define REP_ATTN 1
#endif
#ifndef REP_CONV
#define REP_CONV 1
#endif
#ifndef REP_ELT
#define REP_ELT 1
#endif
#ifndef REP_CVT
#define REP_CVT 1
#endif
enum { K_G1A = 0, K_E2, K_I3, K_I4, K_G1B, K_G5, K_G6, K_ROW1, K_G8, K_E9, K_G10, K_ROW2, K_PRO, K_ROW0, K_COMB };

__global__ void __launch_bounds__(NTHREADS) fwd_megakernel(Params p) {
    extern __shared__ __attribute__((aligned(16))) unsigned char shm[];
    LAS unsigned char* lds = (LAS unsigned char*)shm;
    cg::grid_group grid = cg::this_grid();
    const int wv = __builtin_amdgcn_readfirstlane((int)(threadIdx.x >> 6));
    volatile LAS unsigned* bst = (volatile LAS unsigned*)(lds + 131072);
    unsigned* bar = (unsigned*)(p.ws + S_BAR);
    if (threadIdx.x == 0) { bst[0] = 0u; bst[1] = 0u; bst[2] = 0u; bst[3] = 0u; (void)xb_add(&bar[XB_XCNT(xb_xcc_id())], 1u); }
    __syncthreads();
#pragma unroll 1
    for (int ph = 0; ph < 3 + 12 * NLAYER; ++ph) {
        int kind, l;
        if (ph == 0) { kind = K_PRO; l = 0; } else if (ph == 1) { kind = K_COMB; l = 0; } else if (ph == 2) { kind = K_ROW0; l = 0; } else { l = (ph - 3) / 12; kind = (ph - 3) - l * 12; }
        unsigned char* ws = p.ws;
        asm volatile("" : "+s"(ws));
        if (kind == K_G1A || kind == K_I3 || kind == K_G1B || kind == K_G8) {
            const bf16_t* A; const bf16_t* Bt; bf16_t* O; int N, K;
            if (kind == K_G1A) { A = (const bf16_t*)(ws + A_H); Bt = (const bf16_t*)(ws + W_IN); O = (bf16_t*)(ws + A_PROJA); N = PA_LD; K = DM; }
            else if (kind == K_I3) { A = (const bf16_t*)(ws + A_CQN); Bt = (const bf16_t*)(ws + W_UQ); O = (bf16_t*)(ws + A_Q); N = 1536; K = 512; }
            else if (kind == K_G1B) { A = (const bf16_t*)(ws + A_H); Bt = (const bf16_t*)(ws + W_IN) + (size_t)PA_LD * DM; O = (bf16_t*)(ws + A_GATES); N = GATE_LD; K = DM; }
            else { A = (const bf16_t*)(ws + A_H); Bt = (const bf16_t*)(ws + W_UP); O = (bf16_t*)(ws + A_UU); N = UU_LD; K = DM; }
            int Mr = MT;
            const int nrep = ((kind == K_I3) ? 2 : 1) * REP_GEMM;
#pragma unroll 1
            for (int rp = 0; rp < nrep; ++rp) {
                if (kind == K_I3 && rp >= REP_GEMM) { A = (const bf16_t*)(ws + A_KEYSC); Bt = (const bf16_t*)(ws + W_UKV); O = (bf16_t*)(ws + A_KN); N = 1024; K = 256; Mr = KROWS; }
                run_gemm(wv, lds, A, Bt, Mr, N, K, pg8::EpiBf16{O, N, O});
            }
        }
        if (kind == K_I3) {
#pragma unroll 1
            for (int rp = 0; rp < REP_GEMM; ++rp)
            run_gemm(wv, lds, (const bf16_t*)(ws + W_UKV) + (size_t)1024 * 256, (const bf16_t*)(ws + A_KEYSC), 1024, KROWS, 256,
                     pg8::EpiVT{(bf16_t*)(ws + A_VT), (bf16_t*)(ws + A_VT) + (size_t)BS * 8 * 128 * LKS});
#pragma unroll 1
            for (int rp = 0; rp < REP_CONV; ++rp) conv_phase(wv, p, l, lds);
        }
        if (kind == K_I4) {
#pragma unroll 1
            for (int rp = 0; rp < REP_ATTN; ++rp) attn_phase(wv, p, lds);
#pragma unroll 1
            for (int rp = 0; rp < REP_ELT; ++rp) e3b_phase(wv, p, lds); }
        if (kind == K_G5) {
#pragma unroll 1
            for (int rp = 0; rp < REP_GEMM; ++rp)
            run_gemm(wv, lds, (const bf16_t*)(ws + A_YA), (const bf16_t*)(ws + W_BRA), 3 * MT, DM, 1024, pg8::EpiBf16{(bf16_t*)(ws + A_RAW), DM, (bf16_t*)(ws + A_RAW)}, false, MT / 256, E_WBR * 2);
            xcd_barrier(wv, bar, bst);
            merge_phase(wv, p);
        }
        if (kind == K_G6 || kind == K_G10) {
            const bool g6 = (kind == K_G6);
#pragma unroll 1
            for (int rp = 0; rp < REP_GEMM; ++rp)
            run_gemm(wv, lds, (const bf16_t*)(ws + (g6 ? A_MBF : A_ACT)), (const bf16_t*)(ws + (g6 ? W_O : W_DN)), MT, DM, g6 ? DM : DFF, pg8::EpiBf16{(bf16_t*)(ws + (g6 ? A_M32 : A_F32)), DM, (bf16_t*)(ws + (g6 ? A_M32 : A_F32)) + (size_t)MT * DM}, true);
        }
        if (kind == K_E2) {
#pragma unroll 1
            for (int rp = 0; rp < REP_ELT; ++rp) e2_phase(wv, p, l, lds); }
        if (kind == K_E9) {
#pragma unroll 1
            for (int rp = 0; rp < REP_ELT; ++rp) e9_phase(wv, p, l); }
        if (kind == K_ROW0 || kind == K_ROW1 || kind == K_ROW2) row_phase(wv, p, l, kind == K_ROW0 ? 0 : (kind == K_ROW1 ? 1 : 2));
        if (kind == K_COMB) comb_phase(wv, p);
        if (kind == K_PRO) {
            if (obid() == 0) {
                pg8::StaticOrder S; S.init(MT, DM, (int)gridDim.x, 0, true);
                const int t0 = otid(wv);
                if (t0 < S.nwg - S.nfull) { pg8::Unit uu; S.tile_of(S.nfull + t0, uu); atomicOr((unsigned*)(p.ws + S_TAIL) + uu.pm, 1u << uu.pn); }
            }
            ada_phase(wv, p, lds); rope_table_phase(wv, p); }
        if (kind == K_PRO || (kind == K_ROW2 && l + 1 < NLAYER)) { const int ln = (kind == K_PRO) ? 0 : l + 1;
#pragma unroll 1
            for (int rp = 0; rp < REP_CVT; ++rp) { filter_phase(wv, p, ln, lds); convert_layer(wv, p, ln, lds); } }
        if (p.ws == nullptr) grid.sync();
        xcd_barrier(wv, bar, bst);
    }
}

extern "C" void kernel_launch(void* const* d_in, const int* in_sizes, int n_in, void* d_out, int out_size, void* d_ws, size_t ws_size, hipStream_t stream) {
    static int grid_blocks = 0;
    if (grid_blocks == 0) {
        if (n_in != N_INPUTS || ws_size < WS_NEED) { fprintf(stderr, "kernel_launch: need %d inputs and %zu bytes of workspace; got %d, %zu\n", N_INPUTS, (size_t)WS_NEED, n_in, ws_size); grid_blocks = -1; return; }
        int dev = 0, cus = 0, per_cu = 0;
        hipGetDevice(&dev);
        hipDeviceGetAttribute(&cus, hipDeviceAttributeMultiprocessorCount, dev);
        if (hipFuncSetAttribute((const void*)fwd_megakernel, hipFuncAttributeMaxDynamicSharedMemorySize, LDS_BYTES) != hipSuccess) { fprintf(stderr, "kernel_launch: hipFuncSetAttribute failed\n"); grid_blocks = -1; return; }
        if (hipOccupancyMaxActiveBlocksPerMultiprocessor(&per_cu, (const void*)fwd_megakernel, NTHREADS, LDS_BYTES) != hipSuccess || per_cu < 1) { fprintf(stderr, "kernel_launch: occupancy query gave %d\n", per_cu); per_cu = 1; }
        (void)hipGetLastError();
        grid_blocks = cus * 1;
    }
    if (grid_blocks < 0) return;
        (void)hipMemsetAsync((unsigned char*)d_ws + S_BAR, 0, 16384, stream);
    (void)hipMemsetAsync((unsigned char*)d_ws + S_TAIL, 0, 512, stream);
    Params p{};
    for (int i = 0; i < N_INPUTS; ++i) p.in[i] = (const float*)d_in[i];
    p.out = (float*)d_out; p.ws = (unsigned char*)d_ws;
    void* args[] = {&p};
    hipError_t e = hipLaunchCooperativeKernel((const void*)fwd_megakernel, dim3(grid_blocks), dim3(NTHREADS), args, LDS_BYTES, stream);
    if (e != hipSuccess) fprintf(stderr, "cooperative launch failed: %s (grid %d)\n", hipGetErrorString(e), grid_blocks);
}
```

```cpp
#include <hip/hip_runtime.h>
#include <hip/hip_cooperative_groups.h>
#include <cstdio>
namespace cg = cooperative_groups;

#define LAS __attribute__((address_space(3)))
typedef unsigned short bf16_t;
typedef short bf16x8 __attribute__((ext_vector_type(8)));
typedef float f32x4 __attribute__((ext_vector_type(4)));
typedef float f32x16 __attribute__((ext_vector_type(16)));
typedef unsigned u32x4 __attribute__((ext_vector_type(4)));
typedef unsigned u32x2 __attribute__((ext_vector_type(2)));
typedef float f32x2 __attribute__((ext_vector_type(2)));

constexpr int DM = 2048, MP = 4096, MS = 16384, MT = 20480, NLAYER = 2;
constexpr int LP = 256, LS = 2048, BP = 16, BS = 8, PAST = 512, LKS = 2560;
constexpr int NIN = 13120, NGATE0 = 6976, PA_LD = 7168, GATE_LD = 6144;
constexpr int DFF = 5632, UU_LD = 11264;
constexpr int KROWS = 24576;
constexpr int NTHREADS = 512;
constexpr int LDS_BYTES = 131072 + 16;

enum { I_XP = 0, I_XS, I_C, I_CCKV, I_CKPE, I_CCTX, I_ADAW, I_ADAB, I_NMPRE, I_NMPOST, I_NFPRE, I_NFPOST, I_WIN, I_HCW, I_HCB,
       I_FW1, I_FB1, I_FW2, I_FB2, I_FW3, I_FB3, I_FFREQ, I_HBIAS, I_QN, I_KVN, I_WUQ, I_WUKV, I_SCW, I_WBRA, I_WBRB, I_WBRC,
       I_WO, I_FUP, I_FCW, I_FCB, I_FDN, N_INPUTS };

constexpr size_t E_WIN = (size_t)13312 * 2048, E_WUQ = (size_t)1536 * 512, E_WUKV = (size_t)2048 * 256, E_WBR = (size_t)2048 * 1024,
                 E_WO = (size_t)2048 * 2048, E_WUP = (size_t)11264 * 2048, E_WDN = (size_t)2048 * 5632;
constexpr size_t W_IN = 0, W_UQ = W_IN + E_WIN * 2, W_UKV = W_UQ + E_WUQ * 2, W_BRA = W_UKV + E_WUKV * 2, W_BRB = W_BRA + E_WBR * 2,
                 W_BRC = W_BRB + E_WBR * 2, W_O = W_BRC + E_WBR * 2, W_UP = W_O + E_WO * 2, W_DN = W_UP + E_WUP * 2, W_END = W_DN + E_WDN * 2;
constexpr size_t S_MOD = W_END, SZ_MOD = (size_t)NLAYER * 16 * 9 * 12288 * 4;
constexpr size_t S_KTS = S_MOD + SZ_MOD, S_KTP = S_KTS + (size_t)1024 * 4096 * 4, S_PARTS = S_KTP + (size_t)1024 * 512 * 4,
                 S_PARTP = S_PARTS + (size_t)64 * 2048 * 4, S_ROPE = S_PARTP + (size_t)8 * 2048 * 4, S_BAR = S_ROPE + (size_t)2 * 2048 * 32 * 4, S_COMB = S_BAR + 16384, S_SCALE = S_COMB + (size_t)NLAYER * 3 * 9 * 3 * 2048 * 4, S_TAIL = S_SCALE + 8192, S_END = S_TAIL + 512;
constexpr size_t AR = S_END;
constexpr size_t SZ_H = (size_t)MT * 2048 * 2;
constexpr size_t A_H = AR, A_UU = AR + SZ_H, A_ACT = A_UU + (size_t)MT * UU_LD * 2, AR_END = A_ACT + (size_t)MT * DFF * 2;
constexpr size_t A_PROJA = A_UU;
constexpr size_t A_Q = A_UU, A_KN = A_Q + (size_t)MT * 1536 * 2, A_VT = A_KN + (size_t)KROWS * 1024 * 2, A_YCT = A_VT + (size_t)KROWS * 1024 * 2;
constexpr size_t A_GATES = A_UU, A_M32 = A_GATES + (size_t)MT * GATE_LD * 2, A_MBF = A_H, A_F32 = A_UU;
constexpr size_t A_S = A_M32 + (size_t)MT * 2048 * 4;
constexpr size_t A_ZZT = A_S, A_X0S = A_ZZT + (size_t)MT * 1024 * 2, A_CQN = A_X0S + (size_t)MT * 1024 * 2, A_KEYSC = A_CQN + (size_t)MT * 512 * 2,
                 A_KPER = A_KEYSC + (size_t)KROWS * 256 * 2, A_YA = A_KPER + (size_t)KROWS * 64 * 2, A_OATT = A_YA + (size_t)MT * 1024 * 2,
                 A_YC = A_OATT + (size_t)MT * 1024 * 2, A_SEND = A_YC + (size_t)MT * 1024 * 2;
constexpr size_t A_RAW = A_M32;
static_assert(A_RAW + (size_t)3 * MT * 2048 * 2 <= A_CQN, "raw branch buffer overlaps live data");
static_assert(A_SEND <= AR_END, "arena overflow");
static_assert(A_YCT + (size_t)MT * 1024 * 2 <= A_M32, "arena overlap");
constexpr size_t WS_NEED = AR_END;
static_assert(WS_NEED <= 967590400ull, "workspace too large");

struct Params {
    const float* in[N_INPUTS];
    float* out;
    unsigned char* ws;
};

__device__ __forceinline__ unsigned cvt_pk_bf16(float lo, float hi) { unsigned r; asm volatile("v_cvt_pk_bf16_f32 %0, %1, %2" : "=v"(r) : "v"(lo), "v"(hi)); return r; }
__device__ __forceinline__ bf16_t f2bf(float f) { return (bf16_t)(cvt_pk_bf16(f, 0.f) & 0xffffu); }
__device__ __forceinline__ float bf_lo(unsigned w) { return __uint_as_float(w << 16); }
__device__ __forceinline__ float bf_hi(unsigned w) { return __uint_as_float(w & 0xffff0000u); }
__device__ __forceinline__ void unpack8(const u32x4 v, float* f) { f[0] = bf_lo(v.x); f[1] = bf_hi(v.x); f[2] = bf_lo(v.y); f[3] = bf_hi(v.y); f[4] = bf_lo(v.z); f[5] = bf_hi(v.z); f[6] = bf_lo(v.w); f[7] = bf_hi(v.w); }
__device__ __forceinline__ u32x4 pack8(const float* f) { u32x4 r; r.x = cvt_pk_bf16(f[0], f[1]); r.y = cvt_pk_bf16(f[2], f[3]); r.z = cvt_pk_bf16(f[4], f[5]); r.w = cvt_pk_bf16(f[6], f[7]); return r; }
__device__ __forceinline__ float shx(float v, int mask, int lane) { return __int_as_float(__builtin_amdgcn_ds_bpermute((lane ^ mask) << 2, __float_as_int(v))); }
__device__ __forceinline__ float wave_sum(float v, int lane) {
#pragma unroll
    for (int o = 32; o >= 1; o >>= 1) v += shx(v, o, lane);
    return v;
}
__device__ __forceinline__ int otid(int wv) { int t; asm volatile("v_mbcnt_lo_u32_b32 %0, -1, 0\n\tv_mbcnt_hi_u32_b32 %0, -1, %0" : "=v"(t)); return wv * 64 + t; }
__device__ __forceinline__ int obid() { int t = blockIdx.x; asm volatile("" : "+s"(t)); return t; }
__device__ __forceinline__ float sigmoidf_(float x) { return 1.0f / (1.0f + __expf(-x)); }
__device__ __forceinline__ float siluf_(float x) { return x / (1.0f + __expf(-x)); }

namespace pg8 {
constexpr int BM = 256, BK = 64, HALF = 128, HTB = HALF * BK * 2, STAGE_BYTES = 8 * HTB, NXCD = 8, WGM = 8;
__host__ __device__ __forceinline__ int lds_byte(int r, int c) { const int st = (r >> 4) * 2 + (c >> 5), rr = r & 15, cc = c & 31, ob = rr * 64 + cc * 2; return st * 1024 + (ob ^ (((ob >> 9) & 1) << 5)); }
__host__ __device__ __forceinline__ void stage_rc(int b, int& R, int& C) { const int st = b / 1024, sb = b % 1024, swz = sb ^ (((sb >> 9) & 1) << 5); R = (st >> 1) * 16 + swz / 64; C = (st & 1) * 32 + (swz % 64) / 2; }
__host__ __device__ __forceinline__ int perm32(int rho) { const int n = rho >> 4, i = rho & 15; return 8 * (i >> 2) + 4 * n + (i & 3); }
struct Unit { int pm, pn, kh; };
struct Gemm { const bf16_t* A; const bf16_t* Bt; int M, N, K; int nMper; size_t bstride; };
struct StaticOrder {
    int nM, nN, nwg, G, c, nfull;
    __device__ void init(int M, int N, int G_, int c_, bool split = false) { nM = M / BM; nN = N / BM; nwg = nM * nN; G = G_; c = c_;
        nfull = nwg; if (split) { const int rem = nwg % G; if (rem > 0 && 2 * rem <= G) nfull = nwg - rem; } }
    __device__ void tile_of(int wgid, Unit& u) const {
        { const int q = nwg / NXCD, r = nwg % NXCD, xcd = wgid % NXCD, off = wgid / NXCD; wgid = (xcd < r ? xcd * (q + 1) : r * (q + 1) + (xcd - r) * q) + off; }
        const int nig = WGM * nN, gid = wgid / nig, fm = gid * WGM, gsz = (nM - fm) < WGM ? (nM - fm) : WGM;
        u.pm = fm + ((wgid % nig) % gsz); u.pn = (wgid % nig) / gsz;
    }
    __device__ bool next(int i, Unit& u) const {
        const long L = (long)i * G + c;
        int tile = (int)L, kh = -1; bool ok = L < nwg;
        if (L >= nfull) { const long h = L - nfull; ok = h < 2 * (long)(nwg - nfull); tile = nfull + (int)(h >> 1); kh = (int)(h & 1); }
        if (!ok) return false;
        int pm, pn;
        { int wgid = tile; const int q = nwg / NXCD, r = nwg % NXCD, xcd = wgid % NXCD, off = wgid / NXCD; wgid = (xcd < r ? xcd * (q + 1) : r * (q + 1) + (xcd - r) * q) + off;
          const int nig = WGM * nN, gid = wgid / nig, fm = gid * WGM, gsz = (nM - fm) < WGM ? (nM - fm) : WGM;
          pm = fm + ((wgid % nig) % gsz); pn = (wgid % nig) / gsz; }
        u.pm = pm; u.pn = pn; u.kh = kh; return true;
    }
};
template <class Epi>
__device__ __forceinline__ void gemm_phase(int wv, LAS unsigned char* lds, const Gemm g, const StaticOrder& S, const Epi& E) {
    const int tid = otid(wv), wid = __builtin_amdgcn_readfirstlane(tid >> 6), lane = tid & 63, wr = wid >> 2, wc = wid & 3, fr = lane & 15, fq = lane >> 4;
    const int K = g.K, nt = K / BK;
    unsigned voffA[2], voffB[2];
#pragma unroll
    for (int i = 0; i < 2; ++i) { int R, C; stage_rc(tid * 16 + i * 8192, R, C); const int Rb = (R & ~31) + perm32(R & 31); voffA[i] = (unsigned)(R * K + C) * 2u; voffB[i] = (unsigned)(Rb * K + C) * 2u; }
    const size_t kstep = (size_t)(BK * 2);
    const size_t hstep = (size_t)HALF * K * 2;
    const size_t tstep = 2 * hstep;
    const unsigned ldsw = (unsigned)wid * 1024u;
    const int aoff = lds_byte(wr * 64 + fr, fq * 8), boff = lds_byte(wc * 32 + fr, fq * 8);
#define PG8_SA(b, h) (((b) * 2 + (h)) * HTB)
#define PG8_SB(b, h) ((4 + (b) * 2 + (h)) * HTB)
#define PG8_STAGE(bufoff, gbase, voff) do { _Pragma("unroll") for (int _i = 0; _i < 2; ++_i) \
        __builtin_amdgcn_global_load_lds((const unsigned*)((const char*)(gbase) + (voff)[_i]), (LAS unsigned*)(lds + (bufoff) + ldsw + _i * 8192), 16, 0, 0); } while (0)
#define PG8_LDA(dst, b, h) do { _Pragma("unroll") for (int m = 0; m < 4; ++m) _Pragma("unroll") for (int k = 0; k < 2; ++k) dst[m][k] = *(const LAS bf16x8*)(lds + PG8_SA(b, h) + aoff + m * 2048 + k * 1024); } while (0)
#define PG8_LDB(dst, b, h) do { _Pragma("unroll") for (int n = 0; n < 2; ++n) _Pragma("unroll") for (int k = 0; k < 2; ++k) dst[n][k] = *(const LAS bf16x8*)(lds + PG8_SB(b, h) + boff + n * 2048 + k * 1024); } while (0)
#define PG8_MMA(ai, bj, At, Bt) do { __builtin_amdgcn_s_setprio(1); _Pragma("unroll") for (int m = 0; m < 4; ++m) _Pragma("unroll") for (int n = 0; n < 2; ++n) _Pragma("unroll") for (int k = 0; k < 2; ++k) \
        acc[ai][bj][m][n] = __builtin_amdgcn_mfma_f32_16x16x32_bf16(Bt[n][k], At[m][k], acc[ai][bj][m][n], 0, 0, 0); __builtin_amdgcn_s_setprio(0); } while (0)
#define PG8_WAIT_V(n) asm volatile("s_waitcnt vmcnt(" #n ")" ::: "memory")
#define PG8_WAIT_L(n) asm volatile("s_waitcnt lgkmcnt(" #n ")" ::: "memory")
#define PG8_BAR __builtin_amdgcn_s_barrier()
#define PG8_SCHED __builtin_amdgcn_sched_barrier(0)
    Unit cur, nxt; int ui = 0;
    if (!S.next(0, cur)) return;
    f32x4 acc[2][2][4][2];
#pragma unroll
    for (int a = 0; a < 2; ++a)
#pragma unroll
        for (int b = 0; b < 2; ++b)
#pragma unroll
            for (int m = 0; m < 4; ++m)
#pragma unroll
                for (int n = 0; n < 2; ++n) acc[a][b][m][n] = (f32x4){0.f, 0.f, 0.f, 0.f};
    bf16x8 At[4][2], B0[2][2], B1[2][2];
    const size_t khoff = (size_t)(nt / 2) * kstep;
    const char* cA = (const char*)g.A + (size_t)cur.pm * tstep + (cur.kh == 1 ? khoff : 0); const char* cB = (const char*)g.Bt + (size_t)(cur.pm / g.nMper) * g.bstride + (size_t)cur.pn * tstep + (cur.kh == 1 ? khoff : 0);
    PG8_STAGE(PG8_SB(0, 0), cB, voffB); PG8_STAGE(PG8_SA(0, 0), cA, voffA); PG8_STAGE(PG8_SB(0, 1), cB + hstep, voffB); PG8_STAGE(PG8_SA(0, 1), cA + hstep, voffA);
    if (wr == 1) PG8_BAR;
    PG8_WAIT_V(4); PG8_BAR;
    PG8_STAGE(PG8_SB(1, 0), cB + kstep, voffB); PG8_STAGE(PG8_SA(1, 0), cA + kstep, voffA); PG8_STAGE(PG8_SB(1, 1), cB + hstep + kstep, voffB);
    PG8_WAIT_V(6); PG8_BAR;
    for (;;) {
        const bool has_next = S.next(ui + 1, nxt);
        const char* nA = has_next ? (const char*)g.A + (size_t)nxt.pm * tstep + (nxt.kh == 1 ? khoff : 0) : cA; const char* nB = has_next ? (const char*)g.Bt + (size_t)(nxt.pm / g.nMper) * g.bstride + (size_t)nxt.pn * tstep + (nxt.kh == 1 ? khoff : 0) : cB;
        const int ntu = (cur.kh < 0) ? nt : (nt >> 1);
        for (int t = 0; t < ntu; t += 2) {
            const bool last = (t == ntu - 2);
            const char* a1 = cA + (size_t)(t + 1) * kstep;
            const char* a2 = last ? nA : cA + (size_t)(t + 2) * kstep; const char* b2 = last ? nB : cB + (size_t)(t + 2) * kstep;
            const char* a3 = a2 + kstep; const char* b3 = b2 + kstep;
            PG8_LDB(B0, 0, 0); PG8_SCHED; PG8_LDA(At, 0, 0); PG8_STAGE(PG8_SA(1, 1), a1 + hstep, voffA);
            PG8_WAIT_L(8); PG8_BAR; PG8_WAIT_L(0); PG8_MMA(0, 0, At, B0); PG8_BAR; PG8_SCHED;
            PG8_LDB(B1, 0, 1); PG8_STAGE(PG8_SB(0, 0), b2, voffB);
            PG8_BAR; PG8_WAIT_L(0); PG8_MMA(0, 1, At, B1); PG8_BAR;
            PG8_LDA(At, 0, 1); PG8_STAGE(PG8_SA(0, 0), a2, voffA);
            PG8_BAR; PG8_WAIT_L(0); PG8_MMA(1, 0, At, B0); PG8_BAR; PG8_SCHED;
            PG8_STAGE(PG8_SB(0, 1), b2 + hstep, voffB);
            PG8_WAIT_V(6); PG8_BAR; PG8_MMA(1, 1, At, B1); PG8_BAR;
            PG8_LDB(B0, 1, 0); PG8_SCHED; PG8_LDA(At, 1, 0); PG8_STAGE(PG8_SA(0, 1), a2 + hstep, voffA);
            PG8_WAIT_L(8); PG8_BAR; PG8_WAIT_L(0); PG8_MMA(0, 0, At, B0); PG8_BAR; PG8_SCHED;
            PG8_LDB(B1, 1, 1); PG8_STAGE(PG8_SB(1, 0), b3, voffB);
            PG8_BAR; PG8_WAIT_L(0); PG8_MMA(0, 1, At, B1); PG8_BAR;
            PG8_LDA(At, 1, 1); PG8_STAGE(PG8_SA(1, 0), a3, voffA);
            PG8_BAR; PG8_WAIT_L(0); PG8_MMA(1, 0, At, B0); PG8_BAR; PG8_SCHED;
            PG8_STAGE(PG8_SB(1, 1), b3 + hstep, voffB);
            PG8_WAIT_V(6); PG8_BAR; PG8_MMA(1, 1, At, B1); PG8_BAR;
        }
        { const int t2 = otid(wv); const int l2 = t2 & 63, w2 = __builtin_amdgcn_readfirstlane(t2 >> 6); E(acc, cur, w2 >> 2, w2 & 3, l2 & 15, l2 >> 4); }
        if (!has_next) break;
#pragma unroll
        for (int a = 0; a < 2; ++a)
#pragma unroll
            for (int b = 0; b < 2; ++b)
#pragma unroll
                for (int m = 0; m < 4; ++m)
#pragma unroll
                    for (int n = 0; n < 2; ++n) acc[a][b][m][n] = (f32x4){0.f, 0.f, 0.f, 0.f};
        cur = nxt; cA = nA; cB = nB; ++ui;
    }
    PG8_WAIT_V(0);
    if (wr == 0) PG8_BAR;
    PG8_BAR;
#undef PG8_SA
#undef PG8_SB
#undef PG8_STAGE
#undef PG8_LDA
#undef PG8_LDB
#undef PG8_MMA
#undef PG8_WAIT_V
#undef PG8_WAIT_L
#undef PG8_BAR
#undef PG8_SCHED
}

struct EpiBf16 {
    bf16_t* O; int ldc; bf16_t* O2;
    __device__ __forceinline__ void operator()(const f32x4 (&acc)[2][2][4][2], const Unit& u, int wr, int wc, int fr, int fq) const {
        const int row0 = u.pm * BM + wr * 64 + fr, col0 = u.pn * BM + wc * 32 + 8 * fq;
        bf16_t* Ob = (u.kh == 1) ? O2 : O;
#pragma unroll
        for (int ai = 0; ai < 2; ++ai)
#pragma unroll
            for (int m = 0; m < 4; ++m) { bf16_t* rowp = Ob + (size_t)(row0 + ai * HALF + m * 16) * ldc + col0;
#pragma unroll
                for (int bj = 0; bj < 2; ++bj) { const f32x4 v0 = acc[ai][bj][m][0], v1 = acc[ai][bj][m][1];
                    u32x4 w; w.x = cvt_pk_bf16(v0[0], v0[1]); w.y = cvt_pk_bf16(v0[2], v0[3]); w.z = cvt_pk_bf16(v1[0], v1[1]); w.w = cvt_pk_bf16(v1[2], v1[3]);
                    *(u32x4*)(rowp + bj * HALF) = w; } }
    }
};
struct EpiF32 {
    float* C; int ldc;
    __device__ __forceinline__ void operator()(const f32x4 (&acc)[2][2][4][2], const Unit& u, int wr, int wc, int fr, int fq) const {
        const int row0 = u.pm * BM + wr * 64 + fr, col0 = u.pn * BM + wc * 32 + 4 * fq;
#pragma unroll
        for (int ai = 0; ai < 2; ++ai)
#pragma unroll
            for (int m = 0; m < 4; ++m) { float* rowp = C + (size_t)(row0 + ai * HALF + m * 16) * ldc + col0;
#pragma unroll
                for (int bj = 0; bj < 2; ++bj)
#pragma unroll
                    for (int n = 0; n < 2; ++n) *(f32x4*)(rowp + bj * HALF + n * 16) = acc[ai][bj][m][n]; }
    }
};
struct EpiVT {
    bf16_t* VTs; bf16_t* VTp;
    __device__ __forceinline__ void operator()(const f32x4 (&acc)[2][2][4][2], const Unit& u, int wr, int wc, int fr, int fq) const {
        const int KR0 = u.pn * BM;
        bf16_t* vt; int Lk;
        if (KR0 < BS * LKS) { const int b = KR0 / LKS; Lk = LKS; vt = VTs + (size_t)b * 1024 * LKS + (KR0 - b * LKS); }
        else { const int b = (KR0 - BS * LKS) >> 8; Lk = LP; vt = VTp + (size_t)b * 1024 * LP; }
        const int row0 = u.pm * BM + wr * 64 + fr, col0 = wc * 32 + 8 * fq;
#pragma unroll
        for (int ai = 0; ai < 2; ++ai)
#pragma unroll
            for (int m = 0; m < 4; ++m) { bf16_t* rowp = vt + (size_t)(row0 + ai * HALF + m * 16) * Lk + col0;
#pragma unroll
                for (int bj = 0; bj < 2; ++bj) { const f32x4 v0 = acc[ai][bj][m][0], v1 = acc[ai][bj][m][1];
                    u32x4 w; w.x = cvt_pk_bf16(v0[0], v0[1]); w.y = cvt_pk_bf16(v0[2], v0[3]); w.z = cvt_pk_bf16(v1[0], v1[1]); w.w = cvt_pk_bf16(v1[2], v1[3]);
                    *(u32x4*)(rowp + bj * HALF) = w; } }
    }
};
template <int P> struct EpiGate {
    const bf16_t* gates; float* m32; bf16_t* mbf;
    __device__ __forceinline__ void operator()(const f32x4 (&acc)[2][2][4][2], const Unit& u, int wr, int wc, int fr, int fq) const {
        const int row0 = u.pm * BM + wr * 64 + fr, col0 = u.pn * BM + wc * 32 + 4 * fq;
#pragma unroll
        for (int ai = 0; ai < 2; ++ai)
#pragma unroll
            for (int m = 0; m < 4; ++m) {
                const size_t row = (size_t)(row0 + ai * HALF + m * 16);
#pragma unroll
                for (int bj = 0; bj < 2; ++bj)
#pragma unroll
                    for (int n = 0; n < 2; ++n) {
                        const int col = col0 + bj * HALF + n * 16;
                        const u32x2 gw = *(const u32x2*)(gates + row * GATE_LD + P * 2048 + col);
                        f32x4 v = acc[ai][bj][m][n];
                        v[0] *= sigmoidf_(bf_lo(gw.x)); v[1] *= sigmoidf_(bf_hi(gw.x)); v[2] *= sigmoidf_(bf_lo(gw.y)); v[3] *= sigmoidf_(bf_hi(gw.y));
                        float* mp = m32 + row * 2048 + col;
                        if (P == 0) { *(f32x4*)mp = v; }
                        else if (P == 1) { const f32x4 o = *(const f32x4*)mp; *(f32x4*)mp = o + v; }
                        else { const f32x4 o = *(const f32x4*)mp; v = v + o; u32x2 w; w.x = cvt_pk_bf16(v[0], v[1]); w.y = cvt_pk_bf16(v[2], v[3]); *(u32x2*)(mbf + row * 2048 + col) = w; }
                    }
            }
    }
};
}

template <class Epi>
__device__ __forceinline__ void run_gemm(int wv, LAS unsigned char* lds, const bf16_t* A, const bf16_t* Bt, int M, int N, int K, const Epi& E, bool split = false, int nMper = 1 << 28, size_t bstride = 0, bool rev = false) {
    pg8::Gemm g; g.A = A; g.Bt = Bt; g.M = M; g.N = N; g.K = K; g.nMper = nMper; g.bstride = bstride;
    pg8::StaticOrder S; S.init(M, N, (int)gridDim.x, rev ? (int)gridDim.x - 1 - obid() : obid(), split);
    pg8::gemm_phase<Epi>(wv, lds, g, S, E);
    __syncthreads();
}

__device__ __forceinline__ void convT(int wv, const float* __restrict__ src, int K, int N, bf16_t* __restrict__ dst, int gate_shift, LAS unsigned char* lds) {
    const int tid = otid(wv), lane = tid & 63, kq = lane & 7, ng = lane >> 3;
    const int tn = N / 32, tk = K / 64, ntile = tn * tk, nwaves = gridDim.x * 8;
    for (int tile = obid() * 8 + (tid >> 6); tile < ntile; tile += 2 * nwaves) {
        const int tile2 = tile + nwaves; const bool has2 = tile2 < ntile;
        const int tkk = tile / tn, tnn = tile - tkk * tn, k0 = tkk * 64 + 8 * kq, n0 = tnn * 32 + 4 * ng;
        const int tkk2 = has2 ? tile2 / tn : tkk, tnn2 = has2 ? tile2 - tkk2 * tn : tnn, k02 = tkk2 * 64 + 8 * kq, n02 = tnn2 * 32 + 4 * ng;
        f32x4 v[8], v2[8];
#pragma unroll
        for (int i = 0; i < 8; ++i) v[i] = *(const f32x4*)(src + (size_t)(k0 + i) * N + n0);
#pragma unroll
        for (int i = 0; i < 8; ++i) v2[i] = *(const f32x4*)(src + (size_t)(k02 + i) * N + n02);
#pragma unroll
        for (int j = 0; j < 4; ++j) {
            int nd = n0 + j; if (gate_shift == 1 && nd >= NGATE0) nd += 192; if (gate_shift == 2) { const int hd = nd >> 8, wi = nd & 255; nd = (wi < 128) ? hd * 128 + wi : 1024 + hd * 128 + (wi - 128); }
            u32x4 w; w.x = cvt_pk_bf16(v[0][j], v[1][j]); w.y = cvt_pk_bf16(v[2][j], v[3][j]); w.z = cvt_pk_bf16(v[4][j], v[5][j]); w.w = cvt_pk_bf16(v[6][j], v[7][j]);
            *(u32x4*)(dst + (size_t)nd * K + k0) = w;
        }
        if (has2) {
#pragma unroll
            for (int j = 0; j < 4; ++j) {
                int nd = n02 + j; if (gate_shift == 1 && nd >= NGATE0) nd += 192; if (gate_shift == 2) { const int hd = nd >> 8, wi = nd & 255; nd = (wi < 128) ? hd * 128 + wi : 1024 + hd * 128 + (wi - 128); }
                u32x4 w; w.x = cvt_pk_bf16(v2[0][j], v2[1][j]); w.y = cvt_pk_bf16(v2[2][j], v2[3][j]); w.z = cvt_pk_bf16(v2[4][j], v2[5][j]); w.w = cvt_pk_bf16(v2[6][j], v2[7][j]);
                *(u32x4*)(dst + (size_t)nd * K + k02) = w;
            }
        }
    }
}

__device__ __forceinline__ void ada_phase(int wv, const Params& p, LAS unsigned char* lds) {
    LAS float* sl = (LAS float*)lds;
    float* mod = (float*)(p.ws + S_MOD);
    const int tid = otid(wv);
    for (int u = obid(); u < NLAYER * 6 * 16; u += gridDim.x) {
        const int l = u / 96, r = u % 96, cb = r % 6, kc = r / 6, k0 = kc * 128;
        for (int i = tid; i < 9 * 128; i += NTHREADS) { const int v = i >> 7, k = i & 127; const float x = (v == 0) ? p.in[I_CCTX][k0 + k] : p.in[I_C][(v - 1) * DM + k0 + k]; sl[i] = siluf_(x); }
        __syncthreads();
        const int col = cb * 2048 + tid * 4;
        f32x4 acc[9];
#pragma unroll
        for (int i = 0; i < 9; ++i) acc[i] = (f32x4){0.f, 0.f, 0.f, 0.f};
        const float* wp = p.in[I_ADAW] + ((size_t)l * DM + k0) * 12288 + col;
#pragma unroll 8
        for (int k = 0; k < 128; ++k) {
            const f32x4 w = *(const f32x4*)(wp + (size_t)k * 12288);
#pragma unroll
            for (int i = 0; i < 9; ++i) acc[i] += sl[i * 128 + k] * w;
        }
#pragma unroll
        for (int i = 0; i < 9; ++i) *(f32x4*)(mod + ((size_t)(l * 16 + kc) * 9 + i) * 12288 + col) = acc[i];
        __syncthreads();
    }
}

__device__ __forceinline__ void filter_phase(int wv, const Params& p, int l, LAS unsigned char* lds) {
    LAS float* z = (LAS float*)lds;
    LAS float* H1 = z + 32 * 33;
    LAS float* H2 = H1 + 32 * 64;
    LAS float* W1 = H2 + 32 * 64;
    LAS float* W2 = W1 + 33 * 64;
    LAS float* BF = W2 + 64 * 64;
    const int tid = otid(wv);
    const float* w3 = p.in[I_FW3] + (size_t)l * 64 * 2048; const float* b3 = p.in[I_FB3] + l * 2048;
    for (int u = obid(); u < 72; u += gridDim.x) {
        const int g = (u < 64) ? 1 : 0; const int tc = g ? u : u - 64; const int L = g ? LS : LP; const int t0 = tc * 32;
        float* kT = (float*)(p.ws + (g ? S_KTS : S_KTP)); float* part = (float*)(p.ws + (g ? S_PARTS : S_PARTP));
        for (int i = tid; i < 33 * 64; i += NTHREADS) W1[i] = p.in[I_FW1][(size_t)l * 33 * 64 + i];
        for (int i = tid; i < 64 * 64; i += NTHREADS) W2[i] = p.in[I_FW2][(size_t)l * 64 * 64 + i];
        if (tid < 64) BF[tid] = p.in[I_FB1][l * 64 + tid]; else if (tid < 128) BF[tid] = p.in[I_FB2][l * 64 + tid - 64]; else if (tid < 256) BF[tid] = p.in[I_FFREQ][l * 128 + tid - 128];
        for (int i = tid; i < 32 * 33; i += NTHREADS) {
            const int t = i / 33, e = i - t * 33; const float tf = (float)(t0 + t);
            float v;
            if (e == 0) v = tf / (float)(L - 1);
            else { const int k = (e - 1) & 15; const float band = 1e-4f + (float)k * ((15.0f - 1e-4f) / 15.0f); const float w = (6.283185307179586f * tf) / (float)L; const float ang = w * band;
                   v = (e <= 16) ? cosf(ang) : -sinf(ang); }
            z[i] = v;
        }
        __syncthreads();
#pragma unroll
        for (int q = 0; q < 4; ++q) { const int i = tid + q * NTHREADS; const int t = i >> 6, j = i & 63; float s = BF[j];
#pragma unroll
            for (int e = 0; e < 33; ++e) s += z[t * 33 + e] * W1[e * 64 + j];
            H1[i] = sinf(BF[128 + j] * s); }
        __syncthreads();
#pragma unroll
        for (int q = 0; q < 4; ++q) { const int i = tid + q * NTHREADS; const int t = i >> 6, j = i & 63; float s = BF[64 + j];
#pragma unroll 16
            for (int e = 0; e < 64; ++e) s += H1[t * 64 + e] * W2[e * 64 + j];
            H2[i] = sinf(BF[192 + j] * s); }
        __syncthreads();
        const int c = tid * 4;
        const f32x4 bias = *(const f32x4*)(b3 + c);
        f32x4 delta;
#pragma unroll
        for (int j = 0; j < 4; ++j) { const int d = (c + j) & 1023; const float mn = -3.0701134573253945f, mx = -15.350567286626973f; delta[j] = fabsf(mn + (float)d * ((mx - mn) / 1023.0f)); }
        f32x4 psum = (f32x4){0.f, 0.f, 0.f, 0.f};
        for (int tb = 0; tb < 2; ++tb) {
            f32x4 acc[16];
#pragma unroll
            for (int i = 0; i < 16; ++i) acc[i] = bias;
#pragma unroll 8
            for (int k = 0; k < 64; ++k) {
                const f32x4 w = *(const f32x4*)(w3 + (size_t)k * 2048 + c);
#pragma unroll
                for (int i = 0; i < 16; ++i) acc[i] += H2[(tb * 16 + i) * 64 + k] * w;
            }
#pragma unroll
            for (int i = 0; i < 16; ++i) {
                const int t = t0 + tb * 16 + i; const float tn = (float)t / (float)(L - 1);
#pragma unroll
                for (int j = 0; j < 4; ++j) {
                    const float v = acc[i][j] * __expf(-tn * delta[j]);
                    const int cc = c + j;
                    if (cc < 1024) { kT[(size_t)cc * (2 * L) + t] = v; psum[j] += fabsf(v); }
                    else { const int d = cc - 1024; if (t == 0) kT[(size_t)d * (2 * L) + L] = 0.f; else { kT[(size_t)d * (2 * L) + 2 * L - t] = v; psum[j] += fabsf(v); } }
                }
            }
        }
        *(f32x4*)(part + (size_t)tc * 2048 + c) = psum;
        __syncthreads();
    }
}

__device__ __forceinline__ void row_sel(const Params& p, int l, int mode, int& l2, int& shi, int& sci, const float*& prew, bool& wh, int& gi, const float*& pw) {
    wh = true;
    if (mode == 0) { l2 = l; shi = 0; sci = 1; prew = p.in[I_NMPRE] + l * DM; }
    else if (mode == 1) { l2 = l; shi = 3; sci = 4; prew = p.in[I_NFPRE] + l * DM; }
    else { l2 = l + 1; shi = 0; sci = 1; wh = (l + 1 < NLAYER); if (!wh) l2 = l; prew = p.in[I_NMPRE] + l2 * DM; }
    gi = (mode == 1) ? 2 : 5;
    pw = p.in[mode == 1 ? I_NMPOST : I_NFPOST] + l * DM;
}
__device__ __forceinline__ void comb_phase(int wv, const Params& p) {
    const int tid = otid(wv);
    const float* mod = (const float*)(p.ws + S_MOD); float* comb = (float*)(p.ws + S_COMB);
    for (int idx = obid() * NTHREADS + tid; idx < NLAYER * 3 * 9 * 2048; idx += gridDim.x * NTHREADS) {
        const int c = idx & 2047, q = idx >> 11, mi = q % 9, q2 = q / 9, mode = q2 % 3, l = q2 / 3;
        int l2, shi, sci, gi; const float* prew; const float* pw; bool wh;
        row_sel(p, l, mode, l2, shi, sci, prew, wh, gi, pw);
        float g = 0.f, sc = 0.f, sh = 0.f;
        for (int kc = 0; kc < 16; ++kc) {
            g += mod[((size_t)(l * 16 + kc) * 9 + mi) * 12288 + gi * 2048 + c];
            sc += mod[((size_t)(l2 * 16 + kc) * 9 + mi) * 12288 + sci * 2048 + c];
            sh += mod[((size_t)(l2 * 16 + kc) * 9 + mi) * 12288 + shi * 2048 + c];
        }
        g += p.in[I_ADAB][(size_t)l * 12288 + gi * 2048 + c];
        sc += p.in[I_ADAB][(size_t)l2 * 12288 + sci * 2048 + c];
        sh += p.in[I_ADAB][(size_t)l2 * 12288 + shi * 2048 + c];
        float* o = comb + (size_t)q * 3 * 2048 + c;
        o[0] = g * pw[c]; o[2048] = prew[c] * (1.0f + sc); o[4096] = sh;
    }
}
__device__ __forceinline__ void row_phase(int wv, const Params& p, int l, int mode) {
    const int tid = otid(wv); const int wave = obid() * 8 + (tid >> 6), nw = gridDim.x * 8, lane = tid & 63;
    float* X = p.out;
    bf16_t* H = (bf16_t*)(p.ws + A_H);
    const bool wh = !(mode == 2 && l + 1 >= NLAYER);
    const int rows_per = (MT + nw - 1) / nw;
    for (int rr = 0; rr < rows_per; ++rr) {
        const int row = wave * rows_per + rr;
        if (row >= MT) break;
        const int mi = row < MP ? 0 : 1 + ((row - MP) >> 11);
        const float* cb = (const float*)(p.ws + S_COMB) + (size_t)((l * 3 + mode) * 9 + mi) * 3 * 2048 + lane * 4;
        f32x4 x[8];
        const float* xs = (mode == 0) ? (row < MP ? p.in[I_XP] + (size_t)row * DM : p.in[I_XS] + (size_t)(row - MP) * DM) : X + (size_t)row * DM;
#pragma unroll
        for (int i = 0; i < 8; ++i) x[i] = *(const f32x4*)(xs + i * 256 + lane * 4);
        if (mode != 0) {
            const bf16_t* o = (const bf16_t*)(p.ws + (mode == 1 ? A_M32 : A_F32)) + (size_t)row * DM;
            const unsigned tm = ((const unsigned*)(p.ws + S_TAIL))[row >> 8];
            f32x4 ovv[8]; float ss = 0.f;
#pragma unroll
            for (int i = 0; i < 8; ++i) { const u32x2 w = *(const u32x2*)(o + i * 256 + lane * 4); ovv[i] = (f32x4){bf_lo(w.x), bf_hi(w.x), bf_lo(w.y), bf_hi(w.y)};
                if ((tm >> i) & 1u) { const u32x2 w2 = *(const u32x2*)(o + (size_t)MT * DM + i * 256 + lane * 4); ovv[i] += (f32x4){bf_lo(w2.x), bf_hi(w2.x), bf_lo(w2.y), bf_hi(w2.y)}; }
                ss += ovv[i][0] * ovv[i][0] + ovv[i][1] * ovv[i][1] + ovv[i][2] * ovv[i][2] + ovv[i][3] * ovv[i][3]; }
            ss = wave_sum(ss, lane);
            const float rstd = rsqrtf(ss * (1.0f / DM) + 1e-6f);
#pragma unroll
            for (int i = 0; i < 8; ++i) x[i] += *(const f32x4*)(cb + i * 256) * (ovv[i] * rstd);
        }
#pragma unroll
        for (int i = 0; i < 8; ++i) *(f32x4*)(X + (size_t)row * DM + i * 256 + lane * 4) = x[i];
        if (wh) {
            float ss = 0.f;
#pragma unroll
            for (int i = 0; i < 8; ++i) ss += x[i][0] * x[i][0] + x[i][1] * x[i][1] + x[i][2] * x[i][2] + x[i][3] * x[i][3];
            ss = wave_sum(ss, lane);
            const float rstd = rsqrtf(ss * (1.0f / DM) + 1e-6f);
#pragma unroll
            for (int i = 0; i < 8; ++i) {
                const f32x4 hv = (x[i] * rstd) * *(const f32x4*)(cb + 2048 + i * 256) + *(const f32x4*)(cb + 4096 + i * 256);
                u32x2 o; o.x = cvt_pk_bf16(hv[0], hv[1]); o.y = cvt_pk_bf16(hv[2], hv[3]);
                *(u32x2*)(H + (size_t)row * DM + i * 256 + lane * 4) = o;
            }
        }
    }
}

__device__ __forceinline__ void rope_table_phase(int wv, const Params& p) {
    float* C = (float*)(p.ws + S_ROPE); float* Sn = C + 2048 * 32;
    const int tid = otid(wv);
    for (int idx = obid() * NTHREADS + tid; idx < 2048 * 32; idx += gridDim.x * NTHREADS) {
        const int t = idx >> 5, i = idx & 31, k = i & 15;
        const float inv = exp2f(-(float)k * 0.8304820237218406f);
        const float pos = (i < 16) ? (float)(t >> 6) : (float)(t & 63);
        const float ang = pos * inv; C[idx] = cosf(ang); Sn[idx] = sinf(ang);
    }
}
__device__ __forceinline__ void e2_phase(int wv, const Params& p, int l, LAS unsigned char* lds) {
    const bf16_t* PA = (const bf16_t*)(p.ws + A_PROJA);
    const int tid = otid(wv), lane = tid & 63;
    {
        const int gidx = obid() * NTHREADS + tid;
        if (gidx < 2048) {
            const int g = gidx >> 10, d = gidx & 1023; const int NU = g ? 64 : 8;
            const float* part = (const float*)(p.ws + (g ? S_PARTS : S_PARTP));
            float tot = 0.f;
            for (int i = 0; i < NU; ++i) tot += part[i * 2048 + d] + part[i * 2048 + 1024 + d];
            ((float*)(p.ws + S_SCALE))[gidx] = 1.0f / tot;
        }
    }
    {
        bf16_t* CQN = (bf16_t*)(p.ws + A_CQN); bf16_t* KC = (bf16_t*)(p.ws + A_KEYSC); bf16_t* KP = (bf16_t*)(p.ws + A_KPER);
        float* out_ckv = p.out + (size_t)MT * DM; float* out_kpe = out_ckv + (size_t)BP * NLAYER * LP * 256;
        const int wave = obid() * 8 + (tid >> 6), nw = gridDim.x * 8;
        for (int row = wave; row < MT + BS * PAST; row += nw) {
            if (row < MT) {
                const bf16_t* pr = PA + (size_t)row * PA_LD;
                { const u32x4 v = *(const u32x4*)(pr + 3072 + lane * 8); float f[8]; unpack8(v, f); float ss = 0.f;
#pragma unroll
                  for (int j = 0; j < 8; ++j) ss += f[j] * f[j];
                  ss = wave_sum(ss, lane); const float rstd = rsqrtf(ss * (1.0f / 512.0f) + 1e-6f);
                  const float* qn = p.in[I_QN] + l * 512 + lane * 8;
#pragma unroll
                  for (int j = 0; j < 8; ++j) f[j] = f[j] * rstd * qn[j];
                  *(u32x4*)(CQN + (size_t)row * 512 + lane * 8) = pack8(f); }
                int KR, t; const bool isp = row < MP; int b;
                if (isp) { b = row >> 8; t = row & 255; KR = BS * LKS + row; } else { const int r2 = row - MP; b = r2 >> 11; t = r2 & 2047; KR = b * LKS + t; }
                { const u32x2 v = *(const u32x2*)(pr + 3584 + lane * 4); float f[4] = {bf_lo(v.x), bf_hi(v.x), bf_lo(v.y), bf_hi(v.y)};
                  float ss = f[0] * f[0] + f[1] * f[1] + f[2] * f[2] + f[3] * f[3]; ss = wave_sum(ss, lane); const float rstd = rsqrtf(ss * (1.0f / 256.0f) + 1e-6f);
                  const float* kn = p.in[I_KVN] + l * 256 + lane * 4;
#pragma unroll
                  for (int j = 0; j < 4; ++j) f[j] = f[j] * rstd * kn[j];
                  if (isp) *(f32x4*)(out_ckv + ((size_t)(b * NLAYER + l) * LP + t) * 256 + lane * 4) = (f32x4){f[0], f[1], f[2], f[3]};
                  u32x2 w; w.x = cvt_pk_bf16(f[0], f[1]); w.y = cvt_pk_bf16(f[2], f[3]); *(u32x2*)(KC + (size_t)KR * 256 + lane * 4) = w; }
                { const float v = __uint_as_float(((unsigned)pr[3840 + lane]) << 16);
                  float o = v;
                  if (isp) out_kpe[((size_t)(b * NLAYER + l) * LP + t) * 64 + lane] = v;
                  else { const float pv = shx(v, 32, lane); const float* rc = (const float*)(p.ws + S_ROPE); const float cs = rc[t * 32 + (lane & 31)], sn = rc[2048 * 32 + t * 32 + (lane & 31)]; o = (lane < 32) ? (v * cs - pv * sn) : (pv * sn + v * cs); }
                  KP[(size_t)KR * 64 + lane] = f2bf(o); }
            } else {
                const int r2 = row - MT, b = r2 >> 9, j = r2 & 511; const int KR = b * LKS + LS + j;
                const float* cc = p.in[I_CCKV] + ((size_t)(b * NLAYER + l) * PAST + j) * 256 + lane * 4;
                const f32x4 v = *(const f32x4*)cc; u32x2 w; w.x = cvt_pk_bf16(v[0], v[1]); w.y = cvt_pk_bf16(v[2], v[3]); *(u32x2*)(KC + (size_t)KR * 256 + lane * 4) = w;
                KP[(size_t)KR * 64 + lane] = f2bf(p.in[I_CKPE][((size_t)(b * NLAYER + l) * PAST + j) * 64 + lane]);
            }
        }
    }
    {
        bf16_t* YC = (bf16_t*)(p.ws + A_YC); const float* scw = p.in[I_SCW] + (size_t)l * 3 * 1024;
        for (int it = obid() * NTHREADS + tid; it < (MT / 4) * 128; it += gridDim.x * NTHREADS) {
            const int ch = it >> 7, d0 = (it & 127) * 8, row0 = ch * 4;
            const int t0 = row0 < MP ? (row0 & 255) : ((row0 - MP) & 2047); const int L = row0 < MP ? LP : LS;
            float w0[8], w1[8], w2[8];
            { const f32x4 a = *(const f32x4*)(scw + d0), b = *(const f32x4*)(scw + d0 + 4), c = *(const f32x4*)(scw + 1024 + d0), d = *(const f32x4*)(scw + 1024 + d0 + 4),
                          e2 = *(const f32x4*)(scw + 2048 + d0), f = *(const f32x4*)(scw + 2048 + d0 + 4);
#pragma unroll
              for (int j = 0; j < 4; ++j) { w0[j] = a[j]; w0[4 + j] = b[j]; w1[j] = c[j]; w1[4 + j] = d[j]; w2[j] = e2[j]; w2[4 + j] = f[j]; } }
            const bf16_t* pr = PA + (size_t)row0 * PA_LD;
            float pp[8], pc[8], pn[8];
#pragma unroll
            for (int j = 0; j < 8; ++j) pp[j] = 0.f;
            if (t0 > 0) { float cg[8], uu[8]; unpack8(*(const u32x4*)(pr - PA_LD + 4928 + d0), cg); unpack8(*(const u32x4*)(pr - PA_LD + 5952 + d0), uu);
#pragma unroll
                for (int j = 0; j < 8; ++j) pp[j] = cg[j] * uu[j]; }
            { float cg[8], uu[8]; unpack8(*(const u32x4*)(pr + 4928 + d0), cg); unpack8(*(const u32x4*)(pr + 5952 + d0), uu);
#pragma unroll
              for (int j = 0; j < 8; ++j) pc[j] = cg[j] * uu[j]; }
#pragma unroll
            for (int i = 0; i < 4; ++i) {
#pragma unroll
                for (int j = 0; j < 8; ++j) pn[j] = 0.f;
                if (t0 + i + 1 < L) { float cg[8], uu[8]; unpack8(*(const u32x4*)(pr + (size_t)(i + 1) * PA_LD + 4928 + d0), cg); unpack8(*(const u32x4*)(pr + (size_t)(i + 1) * PA_LD + 5952 + d0), uu);
#pragma unroll
                    for (int j = 0; j < 8; ++j) pn[j] = cg[j] * uu[j]; }
                float bg[8], o[8]; unpack8(*(const u32x4*)(pr + (size_t)i * PA_LD + 3904 + d0), bg);
#pragma unroll
                for (int j = 0; j < 8; ++j) { o[j] = bg[j] * (w0[j] * pp[j] + w1[j] * pc[j] + w2[j] * pn[j]); pp[j] = pc[j]; pc[j] = pn[j]; }
                *(u32x4*)(YC + (size_t)(row0 + i) * 1024 + d0) = pack8(o);
            }
        }
    }
    {
        bf16_t* X0S = (bf16_t*)(p.ws + A_X0S); bf16_t* ZZT = (bf16_t*)(p.ws + A_ZZT);
        const float* hw = p.in[I_HCW] + (size_t)l * 3 * 3072; const float* hb = p.in[I_HCB] + (size_t)l * 3072;
        LAS bf16_t* zt = (LAS bf16_t*)lds;
        for (int u = obid(); u < (MT / 256) * 16; u += gridDim.x) {
            const int rt = u >> 4, dt = u & 15; const int row0 = rt * 256;
            const int dg = tid & 7, rb = tid >> 3, d0 = dt * 64 + dg * 8; const int rowb = row0 + rb * 4;
            const int L = row0 < MP ? LP : LS; const int tb = (row0 < MP ? (row0 & 255) : ((row0 - MP) & 2047)) + rb * 4;
            float wgt[3][3][8], bs[3][8];
#pragma unroll
            for (int g = 0; g < 3; ++g) {
#pragma unroll
                for (int o = 0; o < 3; ++o) { const f32x4 a = *(const f32x4*)(hw + o * 3072 + g * 1024 + d0), b = *(const f32x4*)(hw + o * 3072 + g * 1024 + d0 + 4);
#pragma unroll
                    for (int j = 0; j < 4; ++j) { wgt[g][o][j] = a[j]; wgt[g][o][4 + j] = b[j]; } }
                const f32x4 a = *(const f32x4*)(hb + g * 1024 + d0), b = *(const f32x4*)(hb + g * 1024 + d0 + 4);
#pragma unroll
                for (int j = 0; j < 4; ++j) { bs[g][j] = a[j]; bs[g][4 + j] = b[j]; }
            }
            const bf16_t* pr = PA + (size_t)rowb * PA_LD + d0;
            u32x4 wp[3], wc[3], wn[3];
#pragma unroll
            for (int g = 0; g < 3; ++g) { wp[g] = (u32x4){0u, 0u, 0u, 0u}; if (tb > 0) wp[g] = *(const u32x4*)(pr - PA_LD + g * 1024); wc[g] = *(const u32x4*)(pr + g * 1024); }
#pragma unroll
            for (int i = 0; i < 4; ++i) {
#pragma unroll
                for (int g = 0; g < 3; ++g) { wn[g] = (u32x4){0u, 0u, 0u, 0u}; if (tb + i + 1 < L) wn[g] = *(const u32x4*)(pr + (size_t)(i + 1) * PA_LD + g * 1024); }
                float hv[3][8];
#pragma unroll
                for (int g = 0; g < 3; ++g) { float a[8], b[8], c[8]; unpack8(wp[g], a); unpack8(wc[g], b); unpack8(wn[g], c);
#pragma unroll
                    for (int j = 0; j < 8; ++j) hv[g][j] = bs[g][j] + wgt[g][0][j] * a[j] + wgt[g][1][j] * b[j] + wgt[g][2][j] * c[j];
                    wp[g] = wc[g]; wc[g] = wn[g]; }
                *(u32x4*)(X0S + (size_t)(rowb + i) * 1024 + d0) = pack8(hv[0]);
#pragma unroll
                for (int j = 0; j < 8; ++j) zt[(dg * 8 + j) * 264 + rb * 4 + i] = f2bf(hv[1][j] * hv[2][j]);
            }
            __syncthreads();
#pragma unroll
            for (int i = 0; i < 4; ++i) {
                const int chunk = tid + i * NTHREADS; const int dl = chunk >> 5, tch = chunk & 31; const int d = dt * 64 + dl;
                size_t base; int t0;
                if (row0 < MP) { const int b = row0 >> 8; t0 = 0; base = ((size_t)b * 1024 + d) * LP; }
                else { const int r2 = row0 - MP; const int b = r2 >> 11; t0 = r2 & 2047; base = (size_t)BP * 1024 * LP + ((size_t)b * 1024 + d) * LS; }
                *(u32x4*)(ZZT + base + t0 + tch * 8) = *(const LAS u32x4*)(zt + dl * 264 + tch * 8);
            }
            __syncthreads();
        }
    }
}

__device__ __forceinline__ void conv_phase(int wv, const Params& p, int l, LAS unsigned char* lds) {
    const int tid = otid(wv), wid = tid >> 6, lane = tid & 63, r = lane & 31, hh = lane >> 5;
    const bf16_t* ZZT = (const bf16_t*)(p.ws + A_ZZT); bf16_t* YCT = (bf16_t*)(p.ws + A_YCT);
    const float* hbias = p.in[I_HBIAS] + l * 1024;
    LAS bf16_t* cp = (LAS bf16_t*)lds;
    LAS bf16_t* zz = (LAS bf16_t*)(lds + 65536);
    LAS float* kf = (LAS float*)(lds + 98304);
    for (int u = obid(); u < 2048; u += gridDim.x) {
        const int g = (u < 1024) ? 1 : 0, d = u & 1023;
        const int L = g ? LS : LP, B = g ? BS : BP, L2 = 2 * L, NB = L / 32, NI = 32 / B, NT = NB / NI, lgB = g ? 3 : 4;
        const float* kT = (const float*)(p.ws + (g ? S_KTS : S_KTP)) + (size_t)d * L2;
        const float scale = ((const float*)(p.ws + S_SCALE))[g * 1024 + d]; const float bias = hbias[d];
        for (int i = tid; i < L2 / 4; i += NTHREADS) { f32x4 v = *(const f32x4*)(kT + i * 4); v *= scale; if (i == 0) v[0] += bias; *(LAS f32x4*)(kf + i * 4) = v; }
        const size_t zbase = g ? (size_t)BP * 1024 * LP : 0;
        for (int ch = tid; ch < B * L / 8; ch += NTHREADS) {
            const int b = ch / (L / 8), s8 = ch - b * (L / 8);
            *(LAS u32x4*)(zz + b * L + s8 * 8) = *(const u32x4*)(ZZT + zbase + ((size_t)b * 1024 + d) * L + s8 * 8);
        }
        __syncthreads();
        for (int ck = tid; ck < L2; ck += NTHREADS) {
            const int c = ck / (L2 / 8), m0 = (ck - c * (L2 / 8)) * 8;
            float f[8];
#pragma unroll
            for (int j = 0; j < 8; ++j) f[j] = kf[(L2 - (m0 + c + j)) & (L2 - 1)];
            *(LAS u32x4*)(cp + c * L2 + m0) = pack8(f);
        }
        __syncthreads();
        const int Iloc = r >> lgB, b = r & (B - 1);
        for (int nt = wid * 2; nt < NT; nt += 16) {
            const int I0 = nt * NI;
            f32x16 acc0, acc1;
#pragma unroll
            for (int i = 0; i < 16; ++i) { acc0[i] = 0.f; acc1[i] = 0.f; }
            const bf16x8 zero8 = (bf16x8){0, 0, 0, 0, 0, 0, 0, 0};
            bf16x8 prev[4][2];
#pragma unroll
            for (int i = 0; i < 4; ++i) { prev[i][0] = zero8; prev[i][1] = zero8; }
            const int dl0 = I0 - (NB - 1), nsteps = NB + 2 * NI - 1;
            if (NI == 4) {
                for (int c4 = 0; c4 < nsteps; c4 += 4) {
                    bf16x8 cur[4][2];
#pragma unroll
                    for (int i = 0; i < 4; ++i) {
                        const int dl = dl0 + c4 + i; const int J0 = I0 + Iloc - dl; const bool v0 = (J0 >= 0) && (J0 < NB);
#pragma unroll
                        for (int ks = 0; ks < 2; ++ks) {
                            const int i0 = (16 * ks + 8 * hh - 32 * dl - r) & (L2 - 1); const int c = i0 & 7, q = i0 >> 3;
                            const bf16x8 Af = *(const LAS bf16x8*)(cp + c * L2 + q * 8);
                            cur[i][ks] = zero8;
                            if (v0) cur[i][ks] = *(const LAS bf16x8*)(zz + b * L + 32 * J0 + 16 * ks + 8 * hh);
                            acc0 = __builtin_amdgcn_mfma_f32_32x32x16_bf16(Af, cur[i][ks], acc0, 0, 0, 0);
                            acc1 = __builtin_amdgcn_mfma_f32_32x32x16_bf16(Af, prev[i][ks], acc1, 0, 0, 0);
                        }
                    }
#pragma unroll
                    for (int i = 0; i < 4; ++i) { prev[i][0] = cur[i][0]; prev[i][1] = cur[i][1]; }
                }
            } else {
                for (int c2 = 0; c2 < nsteps + 1; c2 += 2) {
                    bf16x8 cur[2][2];
#pragma unroll
                    for (int i = 0; i < 2; ++i) {
                        const int dl = dl0 + c2 + i; const int J0 = I0 + Iloc - dl; const bool v0 = (J0 >= 0) && (J0 < NB);
#pragma unroll
                        for (int ks = 0; ks < 2; ++ks) {
                            const int i0 = (16 * ks + 8 * hh - 32 * dl - r) & (L2 - 1); const int c = i0 & 7, q = i0 >> 3;
                            const bf16x8 Af = *(const LAS bf16x8*)(cp + c * L2 + q * 8);
                            cur[i][ks] = zero8;
                            if (v0) cur[i][ks] = *(const LAS bf16x8*)(zz + b * L + 32 * J0 + 16 * ks + 8 * hh);
                            acc0 = __builtin_amdgcn_mfma_f32_32x32x16_bf16(Af, cur[i][ks], acc0, 0, 0, 0);
                            acc1 = __builtin_amdgcn_mfma_f32_32x32x16_bf16(Af, prev[i][ks], acc1, 0, 0, 0);
                        }
                    }
#pragma unroll
                    for (int i = 0; i < 2; ++i) { prev[i][0] = cur[i][0]; prev[i][1] = cur[i][1]; }
                }
            }
            bf16_t* op = YCT + zbase + ((size_t)b * 1024 + d) * L + 32 * (I0 + Iloc) + 4 * hh;
#pragma unroll
            for (int g4 = 0; g4 < 4; ++g4) {
                u32x2 w; w.x = cvt_pk_bf16(acc0[4 * g4], acc0[4 * g4 + 1]); w.y = cvt_pk_bf16(acc0[4 * g4 + 2], acc0[4 * g4 + 3]); *(u32x2*)(op + 8 * g4) = w;
                u32x2 w1; w1.x = cvt_pk_bf16(acc1[4 * g4], acc1[4 * g4 + 1]); w1.y = cvt_pk_bf16(acc1[4 * g4 + 2], acc1[4 * g4 + 3]); *(u32x2*)(op + 32 * NI + 8 * g4) = w1;
            }
        }
        __syncthreads();
    }
}

__device__ __forceinline__ void e3b_phase(int wv, const Params& p, LAS unsigned char* lds) {
    const int tid = otid(wv);
    const bf16_t* X0S = (const bf16_t*)(p.ws + A_X0S); const bf16_t* YCT = (const bf16_t*)(p.ws + A_YCT); bf16_t* YA = (bf16_t*)(p.ws + A_YA);
    LAS bf16_t* yt = (LAS bf16_t*)lds;
    for (int u = obid(); u < (MT / 64) * 16; u += gridDim.x) {
        const int rt = u >> 4, dt = u & 15; const int row0 = rt * 64;
        {
            const int dl = tid >> 3, tch = tid & 7; const int d = dt * 64 + dl;
            size_t base; int t0;
            if (row0 < MP) { const int b = row0 >> 8; t0 = row0 & 255; base = ((size_t)b * 1024 + d) * LP; }
            else { const int r2 = row0 - MP; const int b = r2 >> 11; t0 = r2 & 2047; base = (size_t)BP * 1024 * LP + ((size_t)b * 1024 + d) * LS; }
            const u32x4 v = *(const u32x4*)(YCT + base + t0 + tch * 8);
            const unsigned w[4] = {v.x, v.y, v.z, v.w};
#pragma unroll
            for (int j = 0; j < 4; ++j) { yt[(tch * 8 + 2 * j) * 72 + dl] = (bf16_t)(w[j] & 0xffffu); yt[(tch * 8 + 2 * j + 1) * 72 + dl] = (bf16_t)(w[j] >> 16); }
        }
        __syncthreads();
        {
            const int tl = tid >> 3, dg = tid & 7; const int row = row0 + tl, d0 = dt * 64 + dg * 8;
            float a[8], b[8]; unpack8(*(const LAS u32x4*)(yt + tl * 72 + dg * 8), a); unpack8(*(const u32x4*)(X0S + (size_t)row * 1024 + d0), b);
#pragma unroll
            for (int j = 0; j < 8; ++j) a[j] *= b[j];
            *(u32x4*)(YA + (size_t)row * 1024 + d0) = pack8(a);
        }
        __syncthreads();
    }
}

__device__ __forceinline__ void attn_phase(int wv, const Params& p, LAS unsigned char* lds) {
    const bf16_t* Q = (const bf16_t*)(p.ws + A_Q); const bf16_t* KN = (const bf16_t*)(p.ws + A_KN); const bf16_t* KP = (const bf16_t*)(p.ws + A_KPER);
    const bf16_t* VT = (const bf16_t*)(p.ws + A_VT); bf16_t* O = (bf16_t*)(p.ws + A_OATT);
    LAS unsigned char* Ks = lds;
    LAS unsigned char* Vs = lds + 64 * 400;
    const float sc2 = 0.07216878364870322f * 1.4426950408889634f;
    for (int u = obid(); u < 512 + 128; u += gridDim.x) {
        const int tid = otid(wv), wid = tid >> 6, lane = tid & 63, r = lane & 31, hh = lane >> 5;
        int b, h, row0, Lk, KR0; size_t vtb; bool samp;
        if (u < 512) { samp = true; b = u >> 6; h = (u >> 3) & 7; const int qb = u & 7; row0 = MP + b * LS + qb * 256; Lk = LKS; KR0 = b * LKS; vtb = (size_t)(b * 8 + h) * 128 * LKS; }
        else { samp = false; const int u2 = u - 512; b = u2 >> 3; h = u2 & 7; row0 = b * LP; Lk = LP; KR0 = BS * LKS + b * LP; vtb = (size_t)BS * 8 * 128 * LKS + (size_t)(b * 8 + h) * 128 * LP; }
        const int qrow = row0 + wid * 32 + r;
        bf16x8 qf[12];
        {
            const bf16_t* qp = Q + (size_t)qrow * 1536 + h * 192 + 8 * hh;
            u32x4 qv[12];
#pragma unroll
            for (int s = 0; s < 12; ++s) qv[s] = *(const u32x4*)(qp + 16 * s);
            if (samp) {
                const int t = (qrow - MP) & 2047;
#pragma unroll
                for (int s2 = 0; s2 < 2; ++s2) {
                    float x1[8], x2[8]; unpack8(qv[8 + s2], x1); unpack8(qv[10 + s2], x2);
                    const float* rc = (const float*)(p.ws + S_ROPE) + t * 32 + 16 * s2 + 8 * hh;
                    const f32x4 c0 = *(const f32x4*)rc, c1 = *(const f32x4*)(rc + 4), s0 = *(const f32x4*)(rc + 2048 * 32), s1 = *(const f32x4*)(rc + 2048 * 32 + 4);
#pragma unroll
                    for (int j = 0; j < 8; ++j) { const float cs = (j < 4) ? c0[j & 3] : c1[j & 3], sn = (j < 4) ? s0[j & 3] : s1[j & 3]; const float a = x1[j], c = x2[j]; x1[j] = a * cs - c * sn; x2[j] = a * sn + c * cs; }
                    qv[8 + s2] = pack8(x1); qv[10 + s2] = pack8(x2);
                }
            }
#pragma unroll
            for (int s = 0; s < 12; ++s) qf[s] = __builtin_bit_cast(bf16x8, qv[s]);
        }
        f32x16 oacc[4];
#pragma unroll
        for (int ct = 0; ct < 4; ++ct)
#pragma unroll
            for (int i = 0; i < 16; ++i) oacc[ct][i] = 0.f;
        float mrun = -1e30f, lrun = 0.f;
        const int nkt = Lk / 64;
        u32x4 kst[3], vst[2];
#pragma unroll
        for (int i = 0; i < 3; ++i) { const int ck = tid + i * NTHREADS; const int key = ck / 24, part = ck - key * 24;
            kst[i] = (part < 16) ? *(const u32x4*)(KN + (size_t)(KR0 + key) * 1024 + h * 128 + part * 8) : *(const u32x4*)(KP + (size_t)(KR0 + key) * 64 + (part - 16) * 8); }
#pragma unroll
        for (int i = 0; i < 2; ++i) { const int cv = tid + i * NTHREADS; const int v = cv >> 3, kc = cv & 7; vst[i] = *(const u32x4*)(VT + vtb + (size_t)v * Lk + kc * 8); }
        for (int kt = 0; kt < nkt; ++kt) {
            __syncthreads();
#pragma unroll
            for (int i = 0; i < 3; ++i) { const int ck = tid + i * NTHREADS; const int key = ck / 24, part = ck - key * 24; *(LAS u32x4*)(Ks + key * 400 + part * 16) = kst[i]; }
#pragma unroll
            for (int i = 0; i < 2; ++i) { const int cv = tid + i * NTHREADS; const int v = cv >> 3, kc = cv & 7;
                LAS unsigned char* vp = Vs + v * 144 + (kc >> 1) * 32 + (kc & 1) * 8;
                *(LAS u32x2*)vp = (u32x2){vst[i].x, vst[i].y}; *(LAS u32x2*)(vp + 16) = (u32x2){vst[i].z, vst[i].w}; }
            __syncthreads();
            if (kt + 1 < nkt) {
                const int k0 = (kt + 1) * 64;
#pragma unroll
                for (int i = 0; i < 3; ++i) { const int ck = tid + i * NTHREADS; const int key = ck / 24, part = ck - key * 24;
                    kst[i] = (part < 16) ? *(const u32x4*)(KN + (size_t)(KR0 + k0 + key) * 1024 + h * 128 + part * 8) : *(const u32x4*)(KP + (size_t)(KR0 + k0 + key) * 64 + (part - 16) * 8); }
#pragma unroll
                for (int i = 0; i < 2; ++i) { const int cv = tid + i * NTHREADS; const int v = cv >> 3, kc = cv & 7; vst[i] = *(const u32x4*)(VT + vtb + (size_t)v * Lk + k0 + kc * 8); }
            }
            f32x16 sacc[2];
#pragma unroll
            for (int i = 0; i < 16; ++i) { sacc[0][i] = 0.f; sacc[1][i] = 0.f; }
#pragma unroll
            for (int s = 0; s < 12; ++s) {
                const bf16x8 kf0 = *(const LAS bf16x8*)(Ks + r * 400 + (16 * s + 8 * hh) * 2);
                const bf16x8 kf1 = *(const LAS bf16x8*)(Ks + (32 + r) * 400 + (16 * s + 8 * hh) * 2);
                sacc[0] = __builtin_amdgcn_mfma_f32_32x32x16_bf16(kf0, qf[s], sacc[0], 0, 0, 0);
                sacc[1] = __builtin_amdgcn_mfma_f32_32x32x16_bf16(kf1, qf[s], sacc[1], 0, 0, 0);
            }
            float mx0 = fmaxf(sacc[0][0], sacc[1][0]), mx1 = fmaxf(sacc[0][1], sacc[1][1]);
#pragma unroll
            for (int i = 2; i < 16; i += 2) { mx0 = __builtin_fmaxf(__builtin_fmaxf(mx0, sacc[0][i]), sacc[1][i]); mx1 = __builtin_fmaxf(__builtin_fmaxf(mx1, sacc[0][i + 1]), sacc[1][i + 1]); }
            float mx = fmaxf(mx0, mx1);
            mx = fmaxf(mx, shx(mx, 32, lane));
            const float mnew = fmaxf(mrun, mx);
            const bool resc = __builtin_amdgcn_ballot_w64(mnew != mrun) != 0ull;
            const float alpha = __builtin_amdgcn_exp2f((mrun - mnew) * sc2);
            mrun = mnew;
            const float nm = -mnew * sc2;
            f32x2 ps2 = (f32x2){0.f, 0.f};
#pragma unroll
            for (int kk = 0; kk < 2; ++kk)
#pragma unroll
                for (int i = 0; i < 16; i += 2) {
                    f32x2 a = (f32x2){sacc[kk][i], sacc[kk][i + 1]}; a = a * sc2 + nm;
                    a.x = __builtin_amdgcn_exp2f(a.x); a.y = __builtin_amdgcn_exp2f(a.y);
                    sacc[kk][i] = a.x; sacc[kk][i + 1] = a.y; ps2 += a;
                }
            lrun = lrun * alpha + (ps2.x + ps2.y);
            if (resc) {
#pragma unroll
                for (int ct = 0; ct < 4; ++ct)
#pragma unroll
                    for (int i = 0; i < 16; ++i) oacc[ct][i] *= alpha;
            }
#pragma unroll
            for (int ks = 0; ks < 4; ++ks) {
                const int kk = ks >> 1, s2 = ks & 1;
                u32x4 pw;
                pw.x = cvt_pk_bf16(sacc[kk][8 * s2 + 0], sacc[kk][8 * s2 + 1]); pw.y = cvt_pk_bf16(sacc[kk][8 * s2 + 2], sacc[kk][8 * s2 + 3]);
                pw.z = cvt_pk_bf16(sacc[kk][8 * s2 + 4], sacc[kk][8 * s2 + 5]); pw.w = cvt_pk_bf16(sacc[kk][8 * s2 + 6], sacc[kk][8 * s2 + 7]);
                const bf16x8 pf = __builtin_bit_cast(bf16x8, pw);
#pragma unroll
                for (int ct = 0; ct < 4; ++ct) {
                    const bf16x8 vf = *(const LAS bf16x8*)(Vs + (32 * ct + r) * 144 + (32 * kk + 16 * s2) * 2 + 16 * hh);
                    oacc[ct] = __builtin_amdgcn_mfma_f32_32x32x16_bf16(vf, pf, oacc[ct], 0, 0, 0);
                }
            }
        }
        lrun += shx(lrun, 32, lane);
        const float invl = 1.0f / lrun;
        const int tid2 = otid(wv); const int qrow2 = row0 + (tid2 >> 6) * 32 + (tid2 & 31);
        bf16_t* op = O + (size_t)qrow2 * 1024 + h * 128 + 4 * ((tid2 >> 5) & 1);
#pragma unroll
        for (int ct = 0; ct < 4; ++ct)
#pragma unroll
            for (int g4 = 0; g4 < 4; ++g4) {
                u32x2 w; w.x = cvt_pk_bf16(oacc[ct][4 * g4] * invl, oacc[ct][4 * g4 + 1] * invl); w.y = cvt_pk_bf16(oacc[ct][4 * g4 + 2] * invl, oacc[ct][4 * g4 + 3] * invl);
                *(u32x2*)(op + 32 * ct + 8 * g4) = w;
            }
        __syncthreads();
    }
}

__device__ __forceinline__ void e9_phase(int wv, const Params& p, int l) {
    const bf16_t* UU = (const bf16_t*)(p.ws + A_UU); bf16_t* ACT = (bf16_t*)(p.ws + A_ACT);
    const float* cw = p.in[I_FCW] + (size_t)l * 3 * UU_LD; const float* cb = p.in[I_FCB] + (size_t)l * UU_LD;
    const int tid9 = otid(wv);
    constexpr int RC = 16, NCG = DFF / 8;
    for (int it = obid() * NTHREADS + tid9; it < (MT / RC) * NCG; it += gridDim.x * NTHREADS) {
        const int ch = it / NCG, c0 = (it - ch * NCG) * 8, row0 = ch * RC;
        const int t0 = row0 < MP ? (row0 & 255) : ((row0 - MP) & 2047); const int L = row0 < MP ? LP : LS;
        float wg[3][8], wx[3][8], bg[8], bx[8];
#pragma unroll
        for (int o = 0; o < 3; ++o) { const f32x4 a = *(const f32x4*)(cw + o * UU_LD + c0), b = *(const f32x4*)(cw + o * UU_LD + c0 + 4), c = *(const f32x4*)(cw + o * UU_LD + DFF + c0), d = *(const f32x4*)(cw + o * UU_LD + DFF + c0 + 4);
#pragma unroll
            for (int j = 0; j < 4; ++j) { wg[o][j] = a[j]; wg[o][4 + j] = b[j]; wx[o][j] = c[j]; wx[o][4 + j] = d[j]; } }
        { const f32x4 a = *(const f32x4*)(cb + c0), b = *(const f32x4*)(cb + c0 + 4), c = *(const f32x4*)(cb + DFF + c0), d = *(const f32x4*)(cb + DFF + c0 + 4);
#pragma unroll
          for (int j = 0; j < 4; ++j) { bg[j] = a[j]; bg[4 + j] = b[j]; bx[j] = c[j]; bx[4 + j] = d[j]; } }
        const bf16_t* pr = UU + (size_t)row0 * UU_LD + c0;
        u32x4 gp = (u32x4){0u, 0u, 0u, 0u}, xp = gp, gc, xc, gn, xn;
        if (t0 > 0) { gp = *(const u32x4*)(pr - UU_LD); xp = *(const u32x4*)(pr - UU_LD + DFF); }
        gc = *(const u32x4*)pr; xc = *(const u32x4*)(pr + DFF);
#pragma unroll 4
        for (int i = 0; i < RC; ++i) {
            gn = (u32x4){0u, 0u, 0u, 0u}; xn = gn;
            if (t0 + i + 1 < L) { gn = *(const u32x4*)(pr + (size_t)(i + 1) * UU_LD); xn = *(const u32x4*)(pr + (size_t)(i + 1) * UU_LD + DFF); }
            float a[8], b[8], c[8], ga[8], va[8];
            unpack8(gp, a); unpack8(gc, b); unpack8(gn, c);
#pragma unroll
            for (int j = 0; j < 8; ++j) ga[j] = bg[j] + wg[0][j] * a[j] + wg[1][j] * b[j] + wg[2][j] * c[j];
            unpack8(xp, a); unpack8(xc, b); unpack8(xn, c);
#pragma unroll
            for (int j = 0; j < 8; ++j) va[j] = bx[j] + wx[0][j] * a[j] + wx[1][j] * b[j] + wx[2][j] * c[j];
#pragma unroll
            for (int j = 0; j < 8; ++j) ga[j] = siluf_(ga[j]) * va[j];
            *(u32x4*)(ACT + (size_t)(row0 + i) * DFF + c0) = pack8(ga);
            gp = gc; gc = gn; xp = xc; xc = xn;
        }
    }
}

__device__ __forceinline__ void merge_phase(int wv, const Params& p) {
    const bf16_t* RAW = (const bf16_t*)(p.ws + A_RAW); const bf16_t* G = (const bf16_t*)(p.ws + A_GATES); bf16_t* MB = (bf16_t*)(p.ws + A_MBF);
    const int tid = otid(wv);
    for (int it = obid() * NTHREADS + tid; it < MT * 256; it += gridDim.x * NTHREADS) {
        const int row = it >> 8, c0 = (it & 255) * 8;
        float acc[8];
#pragma unroll
        for (int j = 0; j < 8; ++j) acc[j] = 0.f;
#pragma unroll
        for (int P = 0; P < 3; ++P) {
            float r[8], g[8];
            unpack8(*(const u32x4*)(RAW + ((size_t)P * MT + row) * DM + c0), r); unpack8(*(const u32x4*)(G + (size_t)row * GATE_LD + P * 2048 + c0), g);
#pragma unroll
            for (int j = 0; j < 8; ++j) acc[j] += sigmoidf_(g[j]) * r[j];
        }
        *(u32x4*)(MB + (size_t)row * DM + c0) = pack8(acc);
    }
}

__device__ __forceinline__ void convert_layer(int wv, const Params& p, int l, LAS unsigned char* lds) {
    unsigned char* ws = p.ws;
    convT(wv, p.in[I_WIN] + (size_t)l * DM * NIN, DM, NIN, (bf16_t*)(ws + W_IN), 1, lds);
    convT(wv, p.in[I_WUQ] + (size_t)l * 512 * 1536, 512, 1536, (bf16_t*)(ws + W_UQ), 0, lds);
    convT(wv, p.in[I_WUKV] + (size_t)l * 256 * 2048, 256, 2048, (bf16_t*)(ws + W_UKV), 2, lds);
    convT(wv, p.in[I_WBRA] + (size_t)l * 1024 * 2048, 1024, 2048, (bf16_t*)(ws + W_BRA), 0, lds);
    convT(wv, p.in[I_WBRB] + (size_t)l * 1024 * 2048, 1024, 2048, (bf16_t*)(ws + W_BRB), 0, lds);
    convT(wv, p.in[I_WBRC] + (size_t)l * 1024 * 2048, 1024, 2048, (bf16_t*)(ws + W_BRC), 0, lds);
    convT(wv, p.in[I_WO] + (size_t)l * 2048 * 2048, 2048, 2048, (bf16_t*)(ws + W_O), 0, lds);
    convT(wv, p.in[I_FUP] + (size_t)l * 2048 * UU_LD, 2048, UU_LD, (bf16_t*)(ws + W_UP), 0, lds);
    convT(wv, p.in[I_FDN] + (size_t)l * DFF * 2048, DFF, 2048, (bf16_t*)(ws + W_DN), 0, lds);
}

namespace pg8 {
struct EpiGateRT {
    const bf16_t* gates; float* m32; bf16_t* mbf; int P;
    __device__ __forceinline__ void operator()(const f32x4 (&acc)[2][2][4][2], const Unit& u, int wr, int wc, int fr, int fq) const {
        const int row0 = u.pm * BM + wr * 64 + fr, col0 = u.pn * BM + wc * 32 + 4 * fq;
#pragma unroll
        for (int ai = 0; ai < 2; ++ai)
#pragma unroll
            for (int m = 0; m < 4; ++m) {
                const size_t row = (size_t)(row0 + ai * HALF + m * 16);
#pragma unroll
                for (int bj = 0; bj < 2; ++bj)
#pragma unroll
                    for (int n = 0; n < 2; ++n) {
                        const int col = col0 + bj * HALF + n * 16;
                        const u32x2 gw = *(const u32x2*)(gates + row * GATE_LD + P * 2048 + col);
                        f32x4 v = acc[ai][bj][m][n];
                        v[0] *= sigmoidf_(bf_lo(gw.x)); v[1] *= sigmoidf_(bf_hi(gw.x)); v[2] *= sigmoidf_(bf_lo(gw.y)); v[3] *= sigmoidf_(bf_hi(gw.y));
                        float* mp = m32 + row * 2048 + col;
                        if (P != 0) { const f32x4 o = *(const f32x4*)mp; v = v + o; }
                        if (P != 2) { *(f32x4*)mp = v; }
                        else { u32x2 w; w.x = cvt_pk_bf16(v[0], v[1]); w.y = cvt_pk_bf16(v[2], v[3]); *(u32x2*)(mbf + row * 2048 + col) = w; }
                    }
            }
    }
};
}


#define XB_TMO      128
#define XB_XCNT(j)  (256  + 64 * (j))
#define XB_XSUB(j)  (1280 + 64 * (j))
#define XB_XGEN(j)  (2304 + 64 * (j))
#define XB_TOP      3328
#define XB_TOPGEN   3392
#define XCD_BAR_WORDS 3456
#define XB_SPIN_CAP (1u << 20)
__device__ __forceinline__ unsigned xb_ld(unsigned* p)              { return __hip_atomic_load(p, __ATOMIC_RELAXED, __HIP_MEMORY_SCOPE_AGENT); }
__device__ __forceinline__ unsigned xb_add(unsigned* p, unsigned v) { return __hip_atomic_fetch_add(p, v, __ATOMIC_RELAXED, __HIP_MEMORY_SCOPE_AGENT); }
__device__ __forceinline__ unsigned xb_xcc_id() { return (unsigned)__builtin_amdgcn_s_getreg((3 << 11) | 20) & 0xFu; }
#define XB_SPIN(cond, bar) do { unsigned _sp = 0; while (cond) { __builtin_amdgcn_s_sleep(1); \
    if ((++_sp & 255u) == 0u) { if (xb_ld(&(bar)[XB_TMO])) break; if (_sp > XB_SPIN_CAP) { atomicAdd(&(bar)[XB_TMO], 1u); break; } } } } while (0)
__device__ __forceinline__ void xcd_barrier_complete(unsigned* bar, unsigned x, unsigned& nloc, unsigned& nx) {
    const unsigned G = gridDim.x;
    unsigned sum, cnt, mine, sp = 0u;
    for (;;) {
        sum = 0u; cnt = 0u; mine = 0u;
#pragma unroll
        for (unsigned j = 0; j < 16; ++j) { const unsigned c = xb_ld(&bar[XB_XCNT(j)]); sum += c; cnt += (c > 0u) ? 1u : 0u; mine = (j == x) ? c : mine; }
        if (sum == G) break;
        __builtin_amdgcn_s_sleep(1);
        if ((++sp & 255u) == 0u) { if (xb_ld(&bar[XB_TMO])) break; if (sp > XB_SPIN_CAP) { atomicAdd(&bar[XB_TMO], 1u); break; } }
    }
    nloc = mine > 0u ? mine : 1u; nx = cnt > 0u ? cnt : 1u;
}
__device__ __forceinline__ void xcd_barrier(int wv, unsigned* bar, volatile LAS unsigned* st) {
    asm volatile("s_waitcnt vmcnt(0)" ::: "memory");
    __syncthreads();
    if (otid(wv) == 0) {
        __builtin_amdgcn_s_waitcnt(0);
        const unsigned x = xb_xcc_id();
        unsigned nloc = st[0], nx = st[1];
        if (nloc == 0u) { xcd_barrier_complete(bar, x, nloc, nx); st[0] = nloc; st[1] = nx; }
        const unsigned old = xb_add(&bar[XB_XSUB(x)], 1u);
        const unsigned gen = old / nloc;
        if (old + 1u == (gen + 1u) * nloc) {
            __builtin_amdgcn_fence(__ATOMIC_RELEASE, "agent");
            asm volatile("s_waitcnt vmcnt(0)" ::: "memory");
            const unsigned og = xb_add(&bar[XB_TOP], 1u);
            const unsigned tg = og / nx;
            if (og + 1u == (tg + 1u) * nx) xb_add(&bar[XB_TOPGEN], 1u);
            else XB_SPIN(xb_ld(&bar[XB_TOPGEN]) == tg, bar);
            __builtin_amdgcn_fence(__ATOMIC_ACQUIRE, "agent");
            xb_add(&bar[XB_XGEN(x)], 1u);
            asm volatile("s_waitcnt vmcnt(0)" ::: "memory");
        } else {
            XB_SPIN(xb_ld(&bar[XB_XGEN(x)]) == gen, bar);
            __builtin_amdgcn_fence(__ATOMIC_ACQUIRE, "agent");
            asm volatile("s_waitcnt vmcnt(0)" ::: "memory");
        }
    }
    __syncthreads();
}

#ifndef REP_GEMM
#define REP_GEMM 1
#endif
#ifndef REP_ATTN
#define REP_ATTN 1
#endif
#ifndef REP_CONV
#define REP_CONV 1
#endif
#ifndef REP_ELT
#define REP_ELT 1
#endif
#ifndef REP_CVT
#define REP_CVT 1
#endif
enum { K_G1A = 0, K_E2, K_I3, K_I4, K_G1B, K_G5, K_G6, K_ROW1, K_G8, K_E9, K_G10, K_ROW2, K_PRO, K_ROW0, K_COMB };

__global__ void __launch_bounds__(NTHREADS) fwd_megakernel(Params p) {
    extern __shared__ __attribute__((aligned(16))) unsigned char shm[];
    LAS unsigned char* lds = (LAS unsigned char*)shm;
    cg::grid_group grid = cg::this_grid();
    const int wv = __builtin_amdgcn_readfirstlane((int)(threadIdx.x >> 6));
    volatile LAS unsigned* bst = (volatile LAS unsigned*)(lds + 131072);
    unsigned* bar = (unsigned*)(p.ws + S_BAR);
    if (threadIdx.x == 0) { bst[0] = 0u; bst[1] = 0u; bst[2] = 0u; bst[3] = 0u; (void)xb_add(&bar[XB_XCNT(xb_xcc_id())], 1u); }
    __syncthreads();
#pragma unroll 1
    for (int ph = 0; ph < 3 + 12 * NLAYER; ++ph) {
        int kind, l;
        if (ph == 0) { kind = K_PRO; l = 0; } else if (ph == 1) { kind = K_COMB; l = 0; } else if (ph == 2) { kind = K_ROW0; l = 0; } else { l = (ph - 3) / 12; kind = (ph - 3) - l * 12; }
        unsigned char* ws = p.ws;
        asm volatile("" : "+s"(ws));
        if (kind == K_G1A || kind == K_I3 || kind == K_G1B || kind == K_G8) {
            const bf16_t* A; const bf16_t* Bt; bf16_t* O; int N, K;
            if (kind == K_G1A) { A = (const bf16_t*)(ws + A_H); Bt = (const bf16_t*)(ws + W_IN); O = (bf16_t*)(ws + A_PROJA); N = PA_LD; K = DM; }
            else if (kind == K_I3) { A = (const bf16_t*)(ws + A_CQN); Bt = (const bf16_t*)(ws + W_UQ); O = (bf16_t*)(ws + A_Q); N = 1536; K = 512; }
            else if (kind == K_G1B) { A = (const bf16_t*)(ws + A_H); Bt = (const bf16_t*)(ws + W_IN) + (size_t)PA_LD * DM; O = (bf16_t*)(ws + A_GATES); N = GATE_LD; K = DM; }
            else { A = (const bf16_t*)(ws + A_H); Bt = (const bf16_t*)(ws + W_UP); O = (bf16_t*)(ws + A_UU); N = UU_LD; K = DM; }
            int Mr = MT;
            const int nrep = ((kind == K_I3) ? 2 : 1) * REP_GEMM;
#pragma unroll 1
            for (int rp = 0; rp < nrep; ++rp) {
                if (kind == K_I3 && rp >= REP_GEMM) { A = (const bf16_t*)(ws + A_KEYSC); Bt = (const bf16_t*)(ws + W_UKV); O = (bf16_t*)(ws + A_KN); N = 1024; K = 256; Mr = KROWS; }
                run_gemm(wv, lds, A, Bt, Mr, N, K, pg8::EpiBf16{O, N, O});
            }
        }
        if (kind == K_I3) {
#pragma unroll 1
            for (int rp = 0; rp < REP_GEMM; ++rp)
            run_gemm(wv, lds, (const bf16_t*)(ws + W_UKV) + (size_t)1024 * 256, (const bf16_t*)(ws + A_KEYSC), 1024, KROWS, 256,
                     pg8::EpiVT{(bf16_t*)(ws + A_VT), (bf16_t*)(ws + A_VT) + (size_t)BS * 8 * 128 * LKS});
#pragma unroll 1
            for (int rp = 0; rp < REP_CONV; ++rp) conv_phase(wv, p, l, lds);
        }
        if (kind == K_I4) {
#pragma unroll 1
            for (int rp = 0; rp < REP_ATTN; ++rp) attn_phase(wv, p, lds);
#pragma unroll 1
            for (int rp = 0; rp < REP_ELT; ++rp) e3b_phase(wv, p, lds); }
        if (kind == K_G1B) {
#pragma unroll 1
            for (int rp = 0; rp < REP_GEMM; ++rp)
            run_gemm(wv, lds, (const bf16_t*)(ws + A_YA), (const bf16_t*)(ws + W_BRA), 3 * MT, DM, 1024, pg8::EpiBf16{(bf16_t*)(ws + A_RAW), DM, (bf16_t*)(ws + A_RAW)}, false, MT / 256, E_WBR * 2, true);
        }
        if (kind == K_G5) merge_phase(wv, p);
        if (kind == K_G6 || kind == K_G10) {
            const bool g6 = (kind == K_G6);
#pragma unroll 1
            for (int rp = 0; rp < REP_GEMM; ++rp)
            run_gemm(wv, lds, (const bf16_t*)(ws + (g6 ? A_MBF : A_ACT)), (const bf16_t*)(ws + (g6 ? W_O : W_DN)), MT, DM, g6 ? DM : DFF, pg8::EpiBf16{(bf16_t*)(ws + (g6 ? A_M32 : A_F32)), DM, (bf16_t*)(ws + (g6 ? A_M32 : A_F32)) + (size_t)MT * DM}, true);
        }
        if (kind == K_E2) {
#pragma unroll 1
            for (int rp = 0; rp < REP_ELT; ++rp) e2_phase(wv, p, l, lds); }
        if (kind == K_E9) {
#pragma unroll 1
            for (int rp = 0; rp < REP_ELT; ++rp) e9_phase(wv, p, l); }
        if (kind == K_ROW0 || kind == K_ROW1 || kind == K_ROW2) row_phase(wv, p, l, kind == K_ROW0 ? 0 : (kind == K_ROW1 ? 1 : 2));
        if (kind == K_COMB) comb_phase(wv, p);
        if (kind == K_PRO) {
            if (obid() == 0) {
                pg8::StaticOrder S; S.init(MT, DM, (int)gridDim.x, 0, true);
                const int t0 = otid(wv);
                if (t0 < S.nwg - S.nfull) { pg8::Unit uu; S.tile_of(S.nfull + t0, uu); atomicOr((unsigned*)(p.ws + S_TAIL) + uu.pm, 1u << uu.pn); }
            }
            ada_phase(wv, p, lds); rope_table_phase(wv, p); }
        if (kind == K_PRO || (kind == K_ROW2 && l + 1 < NLAYER)) { const int ln = (kind == K_PRO) ? 0 : l + 1;
#pragma unroll 1
            for (int rp = 0; rp < REP_CVT; ++rp) { filter_phase(wv, p, ln, lds); convert_layer(wv, p, ln, lds); } }
        if (p.ws == nullptr) grid.sync();
        xcd_barrier(wv, bar, bst);
    }
}

extern "C" void kernel_launch(void* const* d_in, const int* in_sizes, int n_in, void* d_out, int out_size, void* d_ws, size_t ws_size, hipStream_t stream) {
    static int grid_blocks = 0;
    if (grid_blocks == 0) {
        if (n_in != N_INPUTS || ws_size < WS_NEED) { fprintf(stderr, "kernel_launch: need %d inputs and %zu bytes of workspace; got %d, %zu\n", N_INPUTS, (size_t)WS_NEED, n_in, ws_size); grid_blocks = -1; return; }
        int dev = 0, cus = 0, per_cu = 0;
        hipGetDevice(&dev);
        hipDeviceGetAttribute(&cus, hipDeviceAttributeMultiprocessorCount, dev);
        if (hipFuncSetAttribute((const void*)fwd_megakernel, hipFuncAttributeMaxDynamicSharedMemorySize, LDS_BYTES) != hipSuccess) { fprintf(stderr, "kernel_launch: hipFuncSetAttribute failed\n"); grid_blocks = -1; return; }
        if (hipOccupancyMaxActiveBlocksPerMultiprocessor(&per_cu, (const void*)fwd_megakernel, NTHREADS, LDS_BYTES) != hipSuccess || per_cu < 1) { fprintf(stderr, "kernel_launch: occupancy query gave %d\n", per_cu); per_cu = 1; }
        (void)hipGetLastError();
        grid_blocks = cus * 1;
    }
    if (grid_blocks < 0) return;
        (void)hipMemsetAsync((unsigned char*)d_ws + S_BAR, 0, 16384, stream);
    (void)hipMemsetAsync((unsigned char*)d_ws + S_TAIL, 0, 512, stream);
    Params p{};
    for (int i = 0; i < N_INPUTS; ++i) p.in[i] = (const float*)d_in[i];
    p.out = (float*)d_out; p.ws = (unsigned char*)d_ws;
    void* args[] = {&p};
    hipError_t e = hipLaunchCooperativeKernel((const void*)fwd_megakernel, dim3(grid_blocks), dim3(NTHREADS), args, LDS_BYTES, stream);
    if (e != hipSuccess) fprintf(stderr, "cooperative launch failed: %s (grid %d)\n", hipGetErrorString(e), grid_blocks);
}
```

```cpp
#include <hip/hip_runtime.h>
#include <hip/hip_cooperative_groups.h>
#include <cstdio>
namespace cg = cooperative_groups;

#define LAS __attribute__((address_space(3)))
typedef unsigned short bf16_t;
typedef short bf16x8 __attribute__((ext_vector_type(8)));
typedef float f32x4 __attribute__((ext_vector_type(4)));
typedef float f32x16 __attribute__((ext_vector_type(16)));
typedef unsigned u32x4 __attribute__((ext_vector_type(4)));
typedef unsigned u32x2 __attribute__((ext_vector_type(2)));
typedef float f32x2 __attribute__((ext_vector_type(2)));

constexpr int DM = 2048, MP = 4096, MS = 16384, MT = 20480, NLAYER = 2;
constexpr int LP = 256, LS = 2048, BP = 16, BS = 8, PAST = 512, LKS = 2560;
constexpr int NIN = 13120, NGATE0 = 6976, PA_LD = 7168, GATE_LD = 6144;
constexpr int DFF = 5632, UU_LD = 11264;
constexpr int KROWS = 24576;
constexpr int NTHREADS = 512;
constexpr int LDS_BYTES = 131072 + 16;

enum { I_XP = 0, I_XS, I_C, I_CCKV, I_CKPE, I_CCTX, I_ADAW, I_ADAB, I_NMPRE, I_NMPOST, I_NFPRE, I_NFPOST, I_WIN, I_HCW, I_HCB,
       I_FW1, I_FB1, I_FW2, I_FB2, I_FW3, I_FB3, I_FFREQ, I_HBIAS, I_QN, I_KVN, I_WUQ, I_WUKV, I_SCW, I_WBRA, I_WBRB, I_WBRC,
       I_WO, I_FUP, I_FCW, I_FCB, I_FDN, N_INPUTS };

constexpr size_t E_WIN = (size_t)13312 * 2048, E_WUQ = (size_t)1536 * 512, E_WUKV = (size_t)2048 * 256, E_WBR = (size_t)2048 * 1024,
                 E_WO = (size_t)2048 * 2048, E_WUP = (size_t)11264 * 2048, E_WDN = (size_t)2048 * 5632;
constexpr size_t W_IN = 0, W_UQ = W_IN + E_WIN * 2, W_UKV = W_UQ + E_WUQ * 2, W_BRA = W_UKV + E_WUKV * 2, W_BRB = W_BRA + E_WBR * 2,
                 W_BRC = W_BRB + E_WBR * 2, W_O = W_BRC + E_WBR * 2, W_UP = W_O + E_WO * 2, W_DN = W_UP + E_WUP * 2, W_END = W_DN + E_WDN * 2;
constexpr size_t S_MOD = W_END, SZ_MOD = (size_t)NLAYER * 16 * 9 * 12288 * 4;
constexpr size_t S_KTS = S_MOD + SZ_MOD, S_KTP = S_KTS + (size_t)1024 * 4096 * 4, S_PARTS = S_KTP + (size_t)1024 * 512 * 4,
                 S_PARTP = S_PARTS + (size_t)64 * 2048 * 4, S_ROPE = S_PARTP + (size_t)8 * 2048 * 4, S_BAR = S_ROPE + (size_t)2 * 2048 * 32 * 4, S_COMB = S_BAR + 16384, S_SCALE = S_COMB + (size_t)NLAYER * 3 * 9 * 3 * 2048 * 4, S_TAIL = S_SCALE + 8192, S_END = S_TAIL + 512;
constexpr size_t AR = S_END;
constexpr size_t SZ_H = (size_t)MT * 2048 * 2;
constexpr size_t A_H = AR, A_UU = AR + SZ_H, A_ACT = A_UU + (size_t)MT * UU_LD * 2, AR_END = A_ACT + (size_t)MT * DFF * 2;
constexpr size_t A_PROJA = A_UU;
constexpr size_t A_Q = A_UU, A_KN = A_Q + (size_t)MT * 1536 * 2, A_VT = A_KN + (size_t)KROWS * 1024 * 2, A_YCT = A_VT + (size_t)KROWS * 1024 * 2;
constexpr size_t A_GATES = A_UU, A_M32 = A_GATES + (size_t)MT * GATE_LD * 2, A_MBF = A_H, A_F32 = A_UU;
constexpr size_t A_S = A_M32 + (size_t)MT * 2048 * 4;
constexpr size_t A_ZZT = A_S, A_X0S = A_ZZT + (size_t)MT * 1024 * 2, A_CQN = A_X0S + (size_t)MT * 1024 * 2, A_KEYSC = A_CQN + (size_t)MT * 512 * 2,
                 A_KPER = A_KEYSC + (size_t)KROWS * 256 * 2, A_YA = A_KPER + (size_t)KROWS * 64 * 2, A_OATT = A_YA + (size_t)MT * 1024 * 2,
                 A_YC = A_OATT + (size_t)MT * 1024 * 2, A_SEND = A_YC + (size_t)MT * 1024 * 2;
constexpr size_t A_RAW = A_M32;
static_assert(A_RAW + (size_t)3 * MT * 2048 * 2 <= A_CQN, "raw branch buffer overlaps live data");
static_assert(A_SEND <= AR_END, "arena overflow");
static_assert(A_YCT + (size_t)MT * 1024 * 2 <= A_M32, "arena overlap");
constexpr size_t WS_NEED = AR_END;
static_assert(WS_NEED <= 967590400ull, "workspace too large");

struct Params {
    const float* in[N_INPUTS];
    float* out;
    unsigned char* ws;
};

__device__ __forceinline__ unsigned cvt_pk_bf16(float lo, float hi) { unsigned r; asm volatile("v_cvt_pk_bf16_f32 %0, %1, %2" : "=v"(r) : "v"(lo), "v"(hi)); return r; }
__device__ __forceinline__ bf16_t f2bf(float f) { return (bf16_t)(cvt_pk_bf16(f, 0.f) & 0xffffu); }
__device__ __forceinline__ float bf_lo(unsigned w) { return __uint_as_float(w << 16); }
__device__ __forceinline__ float bf_hi(unsigned w) { return __uint_as_float(w & 0xffff0000u); }
__device__ __forceinline__ void unpack8(const u32x4 v, float* f) { f[0] = bf_lo(v.x); f[1] = bf_hi(v.x); f[2] = bf_lo(v.y); f[3] = bf_hi(v.y); f[4] = bf_lo(v.z); f[5] = bf_hi(v.z); f[6] = bf_lo(v.w); f[7] = bf_hi(v.w); }
__device__ __forceinline__ u32x4 pack8(const float* f) { u32x4 r; r.x = cvt_pk_bf16(f[0], f[1]); r.y = cvt_pk_bf16(f[2], f[3]); r.z = cvt_pk_bf16(f[4], f[5]); r.w = cvt_pk_bf16(f[6], f[7]); return r; }
__device__ __forceinline__ float shx(float v, int mask, int lane) { return __int_as_float(__builtin_amdgcn_ds_bpermute((lane ^ mask) << 2, __float_as_int(v))); }
__device__ __forceinline__ float wave_sum(float v, int lane) {
#pragma unroll
    for (int o = 32; o >= 1; o >>= 1) v += shx(v, o, lane);
    return v;
}
__device__ __forceinline__ int otid(int wv) { int t; asm volatile("v_mbcnt_lo_u32_b32 %0, -1, 0\n\tv_mbcnt_hi_u32_b32 %0, -1, %0" : "=v"(t)); return wv * 64 + t; }
__device__ __forceinline__ int obid() { int t = blockIdx.x; asm volatile("" : "+s"(t)); return t; }
__device__ __forceinline__ float sigmoidf_(float x) { return __builtin_amdgcn_rcpf(1.0f + __builtin_amdgcn_exp2f(-1.4426950408889634f * x)); }
__device__ __forceinline__ float siluf_(float x) { return x * sigmoidf_(x); }

namespace pg8 {
constexpr int BM = 256, BK = 64, HALF = 128, HTB = HALF * BK * 2, STAGE_BYTES = 8 * HTB, NXCD = 8, WGM = 8;
__host__ __device__ __forceinline__ int lds_byte(int r, int c) { const int st = (r >> 4) * 2 + (c >> 5), rr = r & 15, cc = c & 31, ob = rr * 64 + cc * 2; return st * 1024 + (ob ^ (((ob >> 9) & 1) << 5)); }
__host__ __device__ __forceinline__ void stage_rc(int b, int& R, int& C) { const int st = b / 1024, sb = b % 1024, swz = sb ^ (((sb >> 9) & 1) << 5); R = (st >> 1) * 16 + swz / 64; C = (st & 1) * 32 + (swz % 64) / 2; }
__host__ __device__ __forceinline__ int perm32(int rho) { const int n = rho >> 4, i = rho & 15; return 8 * (i >> 2) + 4 * n + (i & 3); }
struct Unit { int pm, pn, kh; };
struct Gemm { const bf16_t* A; const bf16_t* Bt; int M, N, K; int nMper; size_t bstride; };
struct StaticOrder {
    int nM, nN, nwg, G, c, nfull;
    __device__ void init(int M, int N, int G_, int c_, bool split = false) { nM = M / BM; nN = N / BM; nwg = nM * nN; G = G_; c = c_;
        nfull = nwg; if (split) { const int rem = nwg % G; if (rem > 0 && 2 * rem <= G) nfull = nwg - rem; } }
    __device__ void tile_of(int wgid, Unit& u) const {
        { const int q = nwg / NXCD, r = nwg % NXCD, xcd = wgid % NXCD, off = wgid / NXCD; wgid = (xcd < r ? xcd * (q + 1) : r * (q + 1) + (xcd - r) * q) + off; }
        const int nig = WGM * nN, gid = wgid / nig, fm = gid * WGM, gsz = (nM - fm) < WGM ? (nM - fm) : WGM;
        u.pm = fm + ((wgid % nig) % gsz); u.pn = (wgid % nig) / gsz;
    }
    __device__ bool next(int i, Unit& u) const {
        const long L = (long)i * G + c;
        int tile = (int)L, kh = -1; bool ok = L < nwg;
        if (L >= nfull) { const long h = L - nfull; ok = h < 2 * (long)(nwg - nfull); tile = nfull + (int)(h >> 1); kh = (int)(h & 1); }
        if (!ok) return false;
        int pm, pn;
        { int wgid = tile; const int q = nwg / NXCD, r = nwg % NXCD, xcd = wgid % NXCD, off = wgid / NXCD; wgid = (xcd < r ? xcd * (q + 1) : r * (q + 1) + (xcd - r) * q) + off;
          const int nig = WGM * nN, gid = wgid / nig, fm = gid * WGM, gsz = (nM - fm) < WGM ? (nM - fm) : WGM;
          pm = fm + ((wgid % nig) % gsz); pn = (wgid % nig) / gsz; }
        u.pm = pm; u.pn = pn; u.kh = kh; return true;
    }
};
template <class Epi>
__device__ __forceinline__ void gemm_phase(int wv, LAS unsigned char* lds, const Gemm g, const StaticOrder& S, const Epi& E) {
    const int tid = otid(wv), wid = __builtin_amdgcn_readfirstlane(tid >> 6), lane = tid & 63, wr = wid >> 2, wc = wid & 3, fr = lane & 15, fq = lane >> 4;
    const int K = g.K, nt = K / BK;
    unsigned voffA[2], voffB[2];
#pragma unroll
    for (int i = 0; i < 2; ++i) { int R, C; stage_rc(tid * 16 + i * 8192, R, C); const int Rb = (R & ~31) + perm32(R & 31); voffA[i] = (unsigned)(R * K + C) * 2u; voffB[i] = (unsigned)(Rb * K + C) * 2u; }
    const size_t kstep = (size_t)(BK * 2);
    const size_t hstep = (size_t)HALF * K * 2;
    const size_t tstep = 2 * hstep;
    const unsigned ldsw = (unsigned)wid * 1024u;
    const int aoff = lds_byte(wr * 64 + fr, fq * 8), boff = lds_byte(wc * 32 + fr, fq * 8);
#define PG8_SA(b, h) (((b) * 2 + (h)) * HTB)
#define PG8_SB(b, h) ((4 + (b) * 2 + (h)) * HTB)
#define PG8_STAGE(bufoff, gbase, voff) do { _Pragma("unroll") for (int _i = 0; _i < 2; ++_i) \
        __builtin_amdgcn_global_load_lds((const unsigned*)((const char*)(gbase) + (voff)[_i]), (LAS unsigned*)(lds + (bufoff) + ldsw + _i * 8192), 16, 0, 0); } while (0)
#define PG8_LDA(dst, b, h) do { _Pragma("unroll") for (int m = 0; m < 4; ++m) _Pragma("unroll") for (int k = 0; k < 2; ++k) dst[m][k] = *(const LAS bf16x8*)(lds + PG8_SA(b, h) + aoff + m * 2048 + k * 1024); } while (0)
#define PG8_LDB(dst, b, h) do { _Pragma("unroll") for (int n = 0; n < 2; ++n) _Pragma("unroll") for (int k = 0; k < 2; ++k) dst[n][k] = *(const LAS bf16x8*)(lds + PG8_SB(b, h) + boff + n * 2048 + k * 1024); } while (0)
#define PG8_MMA(ai, bj, At, Bt) do { __builtin_amdgcn_s_setprio(1); _Pragma("unroll") for (int m = 0; m < 4; ++m) _Pragma("unroll") for (int n = 0; n < 2; ++n) _Pragma("unroll") for (int k = 0; k < 2; ++k) \
        acc[ai][bj][m][n] = __builtin_amdgcn_mfma_f32_16x16x32_bf16(Bt[n][k], At[m][k], acc[ai][bj][m][n], 0, 0, 0); __builtin_amdgcn_s_setprio(0); } while (0)
#define PG8_WAIT_V(n) asm volatile("s_waitcnt vmcnt(" #n ")" ::: "memory")
#define PG8_WAIT_L(n) asm volatile("s_waitcnt lgkmcnt(" #n ")" ::: "memory")
#define PG8_BAR __builtin_amdgcn_s_barrier()
#define PG8_SCHED __builtin_amdgcn_sched_barrier(0)
    Unit cur, nxt; int ui = 0;
    if (!S.next(0, cur)) return;
    f32x4 acc[2][2][4][2];
#pragma unroll
    for (int a = 0; a < 2; ++a)
#pragma unroll
        for (int b = 0; b < 2; ++b)
#pragma unroll
            for (int m = 0; m < 4; ++m)
#pragma unroll
                for (int n = 0; n < 2; ++n) acc[a][b][m][n] = (f32x4){0.f, 0.f, 0.f, 0.f};
    bf16x8 At[4][2], B0[2][2], B1[2][2];
    const size_t khoff = (size_t)(nt / 2) * kstep;
    const char* cA = (const char*)g.A + (size_t)cur.pm * tstep + (cur.kh == 1 ? khoff : 0); const char* cB = (const char*)g.Bt + (size_t)(cur.pm / g.nMper) * g.bstride + (size_t)cur.pn * tstep + (cur.kh == 1 ? khoff : 0);
    PG8_STAGE(PG8_SB(0, 0), cB, voffB); PG8_STAGE(PG8_SA(0, 0), cA, voffA); PG8_STAGE(PG8_SB(0, 1), cB + hstep, voffB); PG8_STAGE(PG8_SA(0, 1), cA + hstep, voffA);
    if (wr == 1) PG8_BAR;
    PG8_WAIT_V(4); PG8_BAR;
    PG8_STAGE(PG8_SB(1, 0), cB + kstep, voffB); PG8_STAGE(PG8_SA(1, 0), cA + kstep, voffA); PG8_STAGE(PG8_SB(1, 1), cB + hstep + kstep, voffB);
    PG8_WAIT_V(6); PG8_BAR;
    for (;;) {
        const bool has_next = S.next(ui + 1, nxt);
        const char* nA = has_next ? (const char*)g.A + (size_t)nxt.pm * tstep + (nxt.kh == 1 ? khoff : 0) : cA; const char* nB = has_next ? (const char*)g.Bt + (size_t)(nxt.pm / g.nMper) * g.bstride + (size_t)nxt.pn * tstep + (nxt.kh == 1 ? khoff : 0) : cB;
        const int ntu = (cur.kh < 0) ? nt : (nt >> 1);
        for (int t = 0; t < ntu; t += 2) {
            const bool last = (t == ntu - 2);
            const char* a1 = cA + (size_t)(t + 1) * kstep;
            const char* a2 = last ? nA : cA + (size_t)(t + 2) * kstep; const char* b2 = last ? nB : cB + (size_t)(t + 2) * kstep;
            const char* a3 = a2 + kstep; const char* b3 = b2 + kstep;
            PG8_LDB(B0, 0, 0); PG8_SCHED; PG8_LDA(At, 0, 0); PG8_STAGE(PG8_SA(1, 1), a1 + hstep, voffA);
            PG8_WAIT_L(8); PG8_BAR; PG8_WAIT_L(0); PG8_MMA(0, 0, At, B0); PG8_BAR; PG8_SCHED;
            PG8_LDB(B1, 0, 1); PG8_STAGE(PG8_SB(0, 0), b2, voffB);
            PG8_BAR; PG8_WAIT_L(0); PG8_MMA(0, 1, At, B1); PG8_BAR;
            PG8_LDA(At, 0, 1); PG8_STAGE(PG8_SA(0, 0), a2, voffA);
            PG8_BAR; PG8_WAIT_L(0); PG8_MMA(1, 0, At, B0); PG8_BAR; PG8_SCHED;
            PG8_STAGE(PG8_SB(0, 1), b2 + hstep, voffB);
            PG8_WAIT_V(6); PG8_BAR; PG8_MMA(1, 1, At, B1); PG8_BAR;
            PG8_LDB(B0, 1, 0); PG8_SCHED; PG8_LDA(At, 1, 0); PG8_STAGE(PG8_SA(0, 1), a2 + hstep, voffA);
            PG8_WAIT_L(8); PG8_BAR; PG8_WAIT_L(0); PG8_MMA(0, 0, At, B0); PG8_BAR; PG8_SCHED;
            PG8_LDB(B1, 1, 1); PG8_STAGE(PG8_SB(1, 0), b3, voffB);
            PG8_BAR; PG8_WAIT_L(0); PG8_MMA(0, 1, At, B1); PG8_BAR;
            PG8_LDA(At, 1, 1); PG8_STAGE(PG8_SA(1, 0), a3, voffA);
            PG8_BAR; PG8_WAIT_L(0); PG8_MMA(1, 0, At, B0); PG8_BAR; PG8_SCHED;
            PG8_STAGE(PG8_SB(1, 1), b3 + hstep, voffB);
            PG8_WAIT_V(6); PG8_BAR; PG8_MMA(1, 1, At, B1); PG8_BAR;
        }
        { const int t2 = otid(wv); const int l2 = t2 & 63, w2 = __builtin_amdgcn_readfirstlane(t2 >> 6); E(acc, cur, w2 >> 2, w2 & 3, l2 & 15, l2 >> 4); }
        if (!has_next) break;
#pragma unroll
        for (int a = 0; a < 2; ++a)
#pragma unroll
            for (int b = 0; b < 2; ++b)
#pragma unroll
                for (int m = 0; m < 4; ++m)
#pragma unroll
                    for (int n = 0; n < 2; ++n) acc[a][b][m][n] = (f32x4){0.f, 0.f, 0.f, 0.f};
        cur = nxt; cA = nA; cB = nB; ++ui;
    }
    PG8_WAIT_V(0);
    if (wr == 0) PG8_BAR;
    PG8_BAR;
#undef PG8_SA
#undef PG8_SB
#undef PG8_STAGE
#undef PG8_LDA
#undef PG8_LDB
#undef PG8_MMA
#undef PG8_WAIT_V
#undef PG8_WAIT_L
#undef PG8_BAR
#undef PG8_SCHED
}

struct EpiBf16 {
    bf16_t* O; int ldc; bf16_t* O2;
    __device__ __forceinline__ void operator()(const f32x4 (&acc)[2][2][4][2], const Unit& u, int wr, int wc, int fr, int fq) const {
        const int row0 = u.pm * BM + wr * 64 + fr, col0 = u.pn * BM + wc * 32 + 8 * fq;
        bf16_t* Ob = (u.kh == 1) ? O2 : O;
#pragma unroll
        for (int ai = 0; ai < 2; ++ai)
#pragma unroll
            for (int m = 0; m < 4; ++m) { bf16_t* rowp = Ob + (size_t)(row0 + ai * HALF + m * 16) * ldc + col0;
#pragma unroll
                for (int bj = 0; bj < 2; ++bj) { const f32x4 v0 = acc[ai][bj][m][0], v1 = acc[ai][bj][m][1];
                    u32x4 w; w.x = cvt_pk_bf16(v0[0], v0[1]); w.y = cvt_pk_bf16(v0[2], v0[3]); w.z = cvt_pk_bf16(v1[0], v1[1]); w.w = cvt_pk_bf16(v1[2], v1[3]);
                    *(u32x4*)(rowp + bj * HALF) = w; } }
    }
};
struct EpiF32 {
    float* C; int ldc;
    __device__ __forceinline__ void operator()(const f32x4 (&acc)[2][2][4][2], const Unit& u, int wr, int wc, int fr, int fq) const {
        const int row0 = u.pm * BM + wr * 64 + fr, col0 = u.pn * BM + wc * 32 + 4 * fq;
#pragma unroll
        for (int ai = 0; ai < 2; ++ai)
#pragma unroll
            for (int m = 0; m < 4; ++m) { float* rowp = C + (size_t)(row0 + ai * HALF + m * 16) * ldc + col0;
#pragma unroll
                for (int bj = 0; bj < 2; ++bj)
#pragma unroll
                    for (int n = 0; n < 2; ++n) *(f32x4*)(rowp + bj * HALF + n * 16) = acc[ai][bj][m][n]; }
    }
};
struct EpiVT {
    bf16_t* VTs; bf16_t* VTp;
    __device__ __forceinline__ void operator()(const f32x4 (&acc)[2][2][4][2], const Unit& u, int wr, int wc, int fr, int fq) const {
        const int KR0 = u.pn * BM;
        bf16_t* vt; int Lk;
        if (KR0 < BS * LKS) { const int b = KR0 / LKS; Lk = LKS; vt = VTs + (size_t)b * 1024 * LKS + (KR0 - b * LKS); }
        else { const int b = (KR0 - BS * LKS) >> 8; Lk = LP; vt = VTp + (size_t)b * 1024 * LP; }
        const int row0 = u.pm * BM + wr * 64 + fr, col0 = wc * 32 + 8 * fq;
#pragma unroll
        for (int ai = 0; ai < 2; ++ai)
#pragma unroll
            for (int m = 0; m < 4; ++m) { bf16_t* rowp = vt + (size_t)(row0 + ai * HALF + m * 16) * Lk + col0;
#pragma unroll
                for (int bj = 0; bj < 2; ++bj) { const f32x4 v0 = acc[ai][bj][m][0], v1 = acc[ai][bj][m][1];
                    u32x4 w; w.x = cvt_pk_bf16(v0[0], v0[1]); w.y = cvt_pk_bf16(v0[2], v0[3]); w.z = cvt_pk_bf16(v1[0], v1[1]); w.w = cvt_pk_bf16(v1[2], v1[3]);
                    *(u32x4*)(rowp + bj * HALF) = w; } }
    }
};
template <int P> struct EpiGate {
    const bf16_t* gates; float* m32; bf16_t* mbf;
    __device__ __forceinline__ void operator()(const f32x4 (&acc)[2][2][4][2], const Unit& u, int wr, int wc, int fr, int fq) const {
        const int row0 = u.pm * BM + wr * 64 + fr, col0 = u.pn * BM + wc * 32 + 4 * fq;
#pragma unroll
        for (int ai = 0; ai < 2; ++ai)
#pragma unroll
            for (int m = 0; m < 4; ++m) {
                const size_t row = (size_t)(row0 + ai * HALF + m * 16);
#pragma unroll
                for (int bj = 0; bj < 2; ++bj)
#pragma unroll
                    for (int n = 0; n < 2; ++n) {
                        const int col = col0 + bj * HALF + n * 16;
                        const u32x2 gw = *(const u32x2*)(gates + row * GATE_LD + P * 2048 + col);
                        f32x4 v = acc[ai][bj][m][n];
                        v[0] *= sigmoidf_(bf_lo(gw.x)); v[1] *= sigmoidf_(bf_hi(gw.x)); v[2] *= sigmoidf_(bf_lo(gw.y)); v[3] *= sigmoidf_(bf_hi(gw.y));
                        float* mp = m32 + row * 2048 + col;
                        if (P == 0) { *(f32x4*)mp = v; }
                        else if (P == 1) { const f32x4 o = *(const f32x4*)mp; *(f32x4*)mp = o + v; }
                        else { const f32x4 o = *(const f32x4*)mp; v = v + o; u32x2 w; w.x = cvt_pk_bf16(v[0], v[1]); w.y = cvt_pk_bf16(v[2], v[3]); *(u32x2*)(mbf + row * 2048 + col) = w; }
                    }
            }
    }
};
}

template <class Epi>
__device__ __forceinline__ void run_gemm(int wv, LAS unsigned char* lds, const bf16_t* A, const bf16_t* Bt, int M, int N, int K, const Epi& E, bool split = false, int nMper = 1 << 28, size_t bstride = 0, bool rev = false) {
    pg8::Gemm g; g.A = A; g.Bt = Bt; g.M = M; g.N = N; g.K = K; g.nMper = nMper; g.bstride = bstride;
    pg8::StaticOrder S; S.init(M, N, (int)gridDim.x, rev ? (int)gridDim.x - 1 - obid() : obid(), split);
    pg8::gemm_phase<Epi>(wv, lds, g, S, E);
    __syncthreads();
}

__device__ __forceinline__ void convT(int wv, const float* __restrict__ src, int K, int N, bf16_t* __restrict__ dst, int gate_shift, LAS unsigned char* lds) {
    const int tid = otid(wv), lane = tid & 63, kq = lane & 7, ng = lane >> 3;
    const int tn = N / 32, tk = K / 64, ntile = tn * tk, nwaves = gridDim.x * 8;
    for (int tile = obid() * 8 + (tid >> 6); tile < ntile; tile += 2 * nwaves) {
        const int tile2 = tile + nwaves; const bool has2 = tile2 < ntile;
        const int tkk = tile / tn, tnn = tile - tkk * tn, k0 = tkk * 64 + 8 * kq, n0 = tnn * 32 + 4 * ng;
        const int tkk2 = has2 ? tile2 / tn : tkk, tnn2 = has2 ? tile2 - tkk2 * tn : tnn, k02 = tkk2 * 64 + 8 * kq, n02 = tnn2 * 32 + 4 * ng;
        f32x4 v[8], v2[8];
#pragma unroll
        for (int i = 0; i < 8; ++i) v[i] = *(const f32x4*)(src + (size_t)(k0 + i) * N + n0);
#pragma unroll
        for (int i = 0; i < 8; ++i) v2[i] = *(const f32x4*)(src + (size_t)(k02 + i) * N + n02);
#pragma unroll
        for (int j = 0; j < 4; ++j) {
            int nd = n0 + j; if (gate_shift == 1 && nd >= NGATE0) nd += 192; if (gate_shift == 2) { const int hd = nd >> 8, wi = nd & 255; nd = (wi < 128) ? hd * 128 + wi : 1024 + hd * 128 + (wi - 128); }
            u32x4 w; w.x = cvt_pk_bf16(v[0][j], v[1][j]); w.y = cvt_pk_bf16(v[2][j], v[3][j]); w.z = cvt_pk_bf16(v[4][j], v[5][j]); w.w = cvt_pk_bf16(v[6][j], v[7][j]);
            *(u32x4*)(dst + (size_t)nd * K + k0) = w;
        }
        if (has2) {
#pragma unroll
            for (int j = 0; j < 4; ++j) {
                int nd = n02 + j; if (gate_shift == 1 && nd >= NGATE0) nd += 192; if (gate_shift == 2) { const int hd = nd >> 8, wi = nd & 255; nd = (wi < 128) ? hd * 128 + wi : 1024 + hd * 128 + (wi - 128); }
                u32x4 w; w.x = cvt_pk_bf16(v2[0][j], v2[1][j]); w.y = cvt_pk_bf16(v2[2][j], v2[3][j]); w.z = cvt_pk_bf16(v2[4][j], v2[5][j]); w.w = cvt_pk_bf16(v2[6][j], v2[7][j]);
                *(u32x4*)(dst + (size_t)nd * K + k02) = w;
            }
        }
    }
}

__device__ __forceinline__ void ada_phase(int wv, const Params& p, LAS unsigned char* lds) {
    LAS float* sl = (LAS float*)lds;
    float* mod = (float*)(p.ws + S_MOD);
    const int tid = otid(wv);
    for (int u = obid(); u < NLAYER * 6 * 16; u += gridDim.x) {
        const int l = u / 96, r = u % 96, cb = r % 6, kc = r / 6, k0 = kc * 128;
        for (int i = tid; i < 9 * 128; i += NTHREADS) { const int v = i >> 7, k = i & 127; const float x = (v == 0) ? p.in[I_CCTX][k0 + k] : p.in[I_C][(v - 1) * DM + k0 + k]; sl[i] = siluf_(x); }
        __syncthreads();
        const int col = cb * 2048 + tid * 4;
        f32x4 acc[9];
#pragma unroll
        for (int i = 0; i < 9; ++i) acc[i] = (f32x4){0.f, 0.f, 0.f, 0.f};
        const float* wp = p.in[I_ADAW] + ((size_t)l * DM + k0) * 12288 + col;
#pragma unroll 8
        for (int k = 0; k < 128; ++k) {
            const f32x4 w = *(const f32x4*)(wp + (size_t)k * 12288);
#pragma unroll
            for (int i = 0; i < 9; ++i) acc[i] += sl[i * 128 + k] * w;
        }
#pragma unroll
        for (int i = 0; i < 9; ++i) *(f32x4*)(mod + ((size_t)(l * 16 + kc) * 9 + i) * 12288 + col) = acc[i];
        __syncthreads();
    }
}

__device__ __forceinline__ void filter_phase(int wv, const Params& p, int l, LAS unsigned char* lds) {
    LAS float* z = (LAS float*)lds;
    LAS float* H1 = z + 32 * 33;
    LAS float* H2 = H1 + 32 * 64;
    LAS float* W1 = H2 + 32 * 64;
    LAS float* W2 = W1 + 33 * 64;
    LAS float* BF = W2 + 64 * 64;
    const int tid = otid(wv);
    const float* w3 = p.in[I_FW3] + (size_t)l * 64 * 2048; const float* b3 = p.in[I_FB3] + l * 2048;
    for (int u = obid(); u < 72; u += gridDim.x) {
        const int g = (u < 64) ? 1 : 0; const int tc = g ? u : u - 64; const int L = g ? LS : LP; const int t0 = tc * 32;
        float* kT = (float*)(p.ws + (g ? S_KTS : S_KTP)); float* part = (float*)(p.ws + (g ? S_PARTS : S_PARTP));
        for (int i = tid; i < 33 * 64; i += NTHREADS) W1[i] = p.in[I_FW1][(size_t)l * 33 * 64 + i];
        for (int i = tid; i < 64 * 64; i += NTHREADS) W2[i] = p.in[I_FW2][(size_t)l * 64 * 64 + i];
        if (tid < 64) BF[tid] = p.in[I_FB1][l * 64 + tid]; else if (tid < 128) BF[tid] = p.in[I_FB2][l * 64 + tid - 64]; else if (tid < 256) BF[tid] = p.in[I_FFREQ][l * 128 + tid - 128];
        for (int i = tid; i < 32 * 33; i += NTHREADS) {
            const int t = i / 33, e = i - t * 33; const float tf = (float)(t0 + t);
            float v;
            if (e == 0) v = tf / (float)(L - 1);
            else { const int k = (e - 1) & 15; const float band = 1e-4f + (float)k * ((15.0f - 1e-4f) / 15.0f); const float w = (6.283185307179586f * tf) / (float)L; const float ang = w * band;
                   v = (e <= 16) ? cosf(ang) : -sinf(ang); }
            z[i] = v;
        }
        __syncthreads();
#pragma unroll
        for (int q = 0; q < 4; ++q) { const int i = tid + q * NTHREADS; const int t = i >> 6, j = i & 63; float s = BF[j];
#pragma unroll
            for (int e = 0; e < 33; ++e) s += z[t * 33 + e] * W1[e * 64 + j];
            H1[i] = sinf(BF[128 + j] * s); }
        __syncthreads();
#pragma unroll
        for (int q = 0; q < 4; ++q) { const int i = tid + q * NTHREADS; const int t = i >> 6, j = i & 63; float s = BF[64 + j];
#pragma unroll 16
            for (int e = 0; e < 64; ++e) s += H1[t * 64 + e] * W2[e * 64 + j];
            H2[i] = sinf(BF[192 + j] * s); }
        __syncthreads();
        const int c = tid * 4;
        const f32x4 bias = *(const f32x4*)(b3 + c);
        f32x4 delta;
#pragma unroll
        for (int j = 0; j < 4; ++j) { const int d = (c + j) & 1023; const float mn = -3.0701134573253945f, mx = -15.350567286626973f; delta[j] = fabsf(mn + (float)d * ((mx - mn) / 1023.0f)); }
        f32x4 psum = (f32x4){0.f, 0.f, 0.f, 0.f};
        for (int tb = 0; tb < 2; ++tb) {
            f32x4 acc[16];
#pragma unroll
            for (int i = 0; i < 16; ++i) acc[i] = bias;
#pragma unroll 8
            for (int k = 0; k < 64; ++k) {
                const f32x4 w = *(const f32x4*)(w3 + (size_t)k * 2048 + c);
#pragma unroll
                for (int i = 0; i < 16; ++i) acc[i] += H2[(tb * 16 + i) * 64 + k] * w;
            }
#pragma unroll
            for (int i = 0; i < 16; ++i) {
                const int t = t0 + tb * 16 + i; const float tn = (float)t / (float)(L - 1);
#pragma unroll
                for (int j = 0; j < 4; ++j) {
                    const float v = acc[i][j] * __expf(-tn * delta[j]);
                    const int cc = c + j;
                    if (cc < 1024) { kT[(size_t)cc * (2 * L) + t] = v; psum[j] += fabsf(v); }
                    else { const int d = cc - 1024; if (t == 0) kT[(size_t)d * (2 * L) + L] = 0.f; else { kT[(size_t)d * (2 * L) + 2 * L - t] = v; psum[j] += fabsf(v); } }
                }
            }
        }
        *(f32x4*)(part + (size_t)tc * 2048 + c) = psum;
        __syncthreads();
    }
}

__device__ __forceinline__ void row_sel(const Params& p, int l, int mode, int& l2, int& shi, int& sci, const float*& prew, bool& wh, int& gi, const float*& pw) {
    wh = true;
    if (mode == 0) { l2 = l; shi = 0; sci = 1; prew = p.in[I_NMPRE] + l * DM; }
    else if (mode == 1) { l2 = l; shi = 3; sci = 4; prew = p.in[I_NFPRE] + l * DM; }
    else { l2 = l + 1; shi = 0; sci = 1; wh = (l + 1 < NLAYER); if (!wh) l2 = l; prew = p.in[I_NMPRE] + l2 * DM; }
    gi = (mode == 1) ? 2 : 5;
    pw = p.in[mode == 1 ? I_NMPOST : I_NFPOST] + l * DM;
}
__device__ __forceinline__ void comb_phase(int wv, const Params& p) {
    const int tid = otid(wv);
    const float* mod = (const float*)(p.ws + S_MOD); float* comb = (float*)(p.ws + S_COMB);
    for (int idx = obid() * NTHREADS + tid; idx < NLAYER * 3 * 9 * 2048; idx += gridDim.x * NTHREADS) {
        const int c = idx & 2047, q = idx >> 11, mi = q % 9, q2 = q / 9, mode = q2 % 3, l = q2 / 3;
        int l2, shi, sci, gi; const float* prew; const float* pw; bool wh;
        row_sel(p, l, mode, l2, shi, sci, prew, wh, gi, pw);
        float g = 0.f, sc = 0.f, sh = 0.f;
        for (int kc = 0; kc < 16; ++kc) {
            g += mod[((size_t)(l * 16 + kc) * 9 + mi) * 12288 + gi * 2048 + c];
            sc += mod[((size_t)(l2 * 16 + kc) * 9 + mi) * 12288 + sci * 2048 + c];
            sh += mod[((size_t)(l2 * 16 + kc) * 9 + mi) * 12288 + shi * 2048 + c];
        }
        g += p.in[I_ADAB][(size_t)l * 12288 + gi * 2048 + c];
        sc += p.in[I_ADAB][(size_t)l2 * 12288 + sci * 2048 + c];
        sh += p.in[I_ADAB][(size_t)l2 * 12288 + shi * 2048 + c];
        float* o = comb + (size_t)q * 3 * 2048 + c;
        o[0] = g * pw[c]; o[2048] = prew[c] * (1.0f + sc); o[4096] = sh;
    }
}
__device__ __forceinline__ void row_phase(int wv, const Params& p, int l, int mode) {
    const int tid = otid(wv); const int wave = obid() * 8 + (tid >> 6), nw = gridDim.x * 8, lane = tid & 63;
    float* X = p.out;
    bf16_t* H = (bf16_t*)(p.ws + A_H);
    const bool wh = !(mode == 2 && l + 1 >= NLAYER);
    const int rows_per = (MT + nw - 1) / nw;
    for (int rr = 0; rr < rows_per; ++rr) {
        const int row = wave * rows_per + rr;
        if (row >= MT) break;
        const int mi = row < MP ? 0 : 1 + ((row - MP) >> 11);
        const float* cb = (const float*)(p.ws + S_COMB) + (size_t)((l * 3 + mode) * 9 + mi) * 3 * 2048 + lane * 4;
        f32x4 x[8];
        const float* xs = (mode == 0) ? (row < MP ? p.in[I_XP] + (size_t)row * DM : p.in[I_XS] + (size_t)(row - MP) * DM) : X + (size_t)row * DM;
#pragma unroll
        for (int i = 0; i < 8; ++i) x[i] = *(const f32x4*)(xs + i * 256 + lane * 4);
        if (mode != 0) {
            const bf16_t* o = (const bf16_t*)(p.ws + (mode == 1 ? A_M32 : A_F32)) + (size_t)row * DM;
            const unsigned tm = ((const unsigned*)(p.ws + S_TAIL))[row >> 8];
            f32x4 ovv[8]; float ss = 0.f;
#pragma unroll
            for (int i = 0; i < 8; ++i) { const u32x2 w = *(const u32x2*)(o + i * 256 + lane * 4); ovv[i] = (f32x4){bf_lo(w.x), bf_hi(w.x), bf_lo(w.y), bf_hi(w.y)};
                if ((tm >> i) & 1u) { const u32x2 w2 = *(const u32x2*)(o + (size_t)MT * DM + i * 256 + lane * 4); ovv[i] += (f32x4){bf_lo(w2.x), bf_hi(w2.x), bf_lo(w2.y), bf_hi(w2.y)}; }
                ss += ovv[i][0] * ovv[i][0] + ovv[i][1] * ovv[i][1] + ovv[i][2] * ovv[i][2] + ovv[i][3] * ovv[i][3]; }
            ss = wave_sum(ss, lane);
            const float rstd = rsqrtf(ss * (1.0f / DM) + 1e-6f);
#pragma unroll
            for (int i = 0; i < 8; ++i) x[i] += *(const f32x4*)(cb + i * 256) * (ovv[i] * rstd);
        }
#pragma unroll
        for (int i = 0; i < 8; ++i) *(f32x4*)(X + (size_t)row * DM + i * 256 + lane * 4) = x[i];
        if (wh) {
            float ss = 0.f;
#pragma unroll
            for (int i = 0; i < 8; ++i) ss += x[i][0] * x[i][0] + x[i][1] * x[i][1] + x[i][2] * x[i][2] + x[i][3] * x[i][3];
            ss = wave_sum(ss, lane);
            const float rstd = rsqrtf(ss * (1.0f / DM) + 1e-6f);
#pragma unroll
            for (int i = 0; i < 8; ++i) {
                const f32x4 hv = (x[i] * rstd) * *(const f32x4*)(cb + 2048 + i * 256) + *(const f32x4*)(cb + 4096 + i * 256);
                u32x2 o; o.x = cvt_pk_bf16(hv[0], hv[1]); o.y = cvt_pk_bf16(hv[2], hv[3]);
                *(u32x2*)(H + (size_t)row * DM + i * 256 + lane * 4) = o;
            }
        }
    }
}

__device__ __forceinline__ void rope_table_phase(int wv, const Params& p) {
    float* C = (float*)(p.ws + S_ROPE); float* Sn = C + 2048 * 32;
    const int tid = otid(wv);
    for (int idx = obid() * NTHREADS + tid; idx < 2048 * 32; idx += gridDim.x * NTHREADS) {
        const int t = idx >> 5, i = idx & 31, k = i & 15;
        const float inv = exp2f(-(float)k * 0.8304820237218406f);
        const float pos = (i < 16) ? (float)(t >> 6) : (float)(t & 63);
        const float ang = pos * inv; C[idx] = cosf(ang); Sn[idx] = sinf(ang);
    }
}
__device__ __forceinline__ void e2_phase(int wv, const Params& p, int l, LAS unsigned char* lds) {
    const bf16_t* PA = (const bf16_t*)(p.ws + A_PROJA);
    const int tid = otid(wv), lane = tid & 63;
    {
        const int gidx = obid() * NTHREADS + tid;
        if (gidx < 2048) {
            const int g = gidx >> 10, d = gidx & 1023; const int NU = g ? 64 : 8;
            const float* part = (const float*)(p.ws + (g ? S_PARTS : S_PARTP));
            float tot = 0.f;
            for (int i = 0; i < NU; ++i) tot += part[i * 2048 + d] + part[i * 2048 + 1024 + d];
            ((float*)(p.ws + S_SCALE))[gidx] = 1.0f / tot;
        }
    }
    {
        bf16_t* CQN = (bf16_t*)(p.ws + A_CQN); bf16_t* KC = (bf16_t*)(p.ws + A_KEYSC); bf16_t* KP = (bf16_t*)(p.ws + A_KPER);
        float* out_ckv = p.out + (size_t)MT * DM; float* out_kpe = out_ckv + (size_t)BP * NLAYER * LP * 256;
        const int wave = obid() * 8 + (tid >> 6), nw = gridDim.x * 8;
        for (int row = wave; row < MT + BS * PAST; row += nw) {
            if (row < MT) {
                const bf16_t* pr = PA + (size_t)row * PA_LD;
                { const u32x4 v = *(const u32x4*)(pr + 3072 + lane * 8); float f[8]; unpack8(v, f); float ss = 0.f;
#pragma unroll
                  for (int j = 0; j < 8; ++j) ss += f[j] * f[j];
                  ss = wave_sum(ss, lane); const float rstd = rsqrtf(ss * (1.0f / 512.0f) + 1e-6f);
                  const float* qn = p.in[I_QN] + l * 512 + lane * 8;
#pragma unroll
                  for (int j = 0; j < 8; ++j) f[j] = f[j] * rstd * qn[j];
                  *(u32x4*)(CQN + (size_t)row * 512 + lane * 8) = pack8(f); }
                int KR, t; const bool isp = row < MP; int b;
                if (isp) { b = row >> 8; t = row & 255; KR = BS * LKS + row; } else { const int r2 = row - MP; b = r2 >> 11; t = r2 & 2047; KR = b * LKS + t; }
                { const u32x2 v = *(const u32x2*)(pr + 3584 + lane * 4); float f[4] = {bf_lo(v.x), bf_hi(v.x), bf_lo(v.y), bf_hi(v.y)};
                  float ss = f[0] * f[0] + f[1] * f[1] + f[2] * f[2] + f[3] * f[3]; ss = wave_sum(ss, lane); const float rstd = rsqrtf(ss * (1.0f / 256.0f) + 1e-6f);
                  const float* kn = p.in[I_KVN] + l * 256 + lane * 4;
#pragma unroll
                  for (int j = 0; j < 4; ++j) f[j] = f[j] * rstd * kn[j];
                  if (isp) *(f32x4*)(out_ckv + ((size_t)(b * NLAYER + l) * LP + t) * 256 + lane * 4) = (f32x4){f[0], f[1], f[2], f[3]};
                  u32x2 w; w.x = cvt_pk_bf16(f[0], f[1]); w.y = cvt_pk_bf16(f[2], f[3]); *(u32x2*)(KC + (size_t)KR * 256 + lane * 4) = w; }
                { const float v = __uint_as_float(((unsigned)pr[3840 + lane]) << 16);
                  float o = v;
                  if (isp) out_kpe[((size_t)(b * NLAYER + l) * LP + t) * 64 + lane] = v;
                  else { const float pv = shx(v, 32, lane); const float* rc = (const float*)(p.ws + S_ROPE); const float cs = rc[t * 32 + (lane & 31)], sn = rc[2048 * 32 + t * 32 + (lane & 31)]; o = (lane < 32) ? (v * cs - pv * sn) : (pv * sn + v * cs); }
                  KP[(size_t)KR * 64 + lane] = f2bf(o); }
            } else {
                const int r2 = row - MT, b = r2 >> 9, j = r2 & 511; const int KR = b * LKS + LS + j;
                const float* cc = p.in[I_CCKV] + ((size_t)(b * NLAYER + l) * PAST + j) * 256 + lane * 4;
                const f32x4 v = *(const f32x4*)cc; u32x2 w; w.x = cvt_pk_bf16(v[0], v[1]); w.y = cvt_pk_bf16(v[2], v[3]); *(u32x2*)(KC + (size_t)KR * 256 + lane * 4) = w;
                KP[(size_t)KR * 64 + lane] = f2bf(p.in[I_CKPE][((size_t)(b * NLAYER + l) * PAST + j) * 64 + lane]);
            }
        }
    }
    {
        bf16_t* YC = (bf16_t*)(p.ws + A_YC); const float* scw = p.in[I_SCW] + (size_t)l * 3 * 1024;
        for (int it = obid() * NTHREADS + tid; it < (MT / 4) * 128; it += gridDim.x * NTHREADS) {
            const int ch = it >> 7, d0 = (it & 127) * 8, row0 = ch * 4;
            const int t0 = row0 < MP ? (row0 & 255) : ((row0 - MP) & 2047); const int L = row0 < MP ? LP : LS;
            float w0[8], w1[8], w2[8];
            { const f32x4 a = *(const f32x4*)(scw + d0), b = *(const f32x4*)(scw + d0 + 4), c = *(const f32x4*)(scw + 1024 + d0), d = *(const f32x4*)(scw + 1024 + d0 + 4),
                          e2 = *(const f32x4*)(scw + 2048 + d0), f = *(const f32x4*)(scw + 2048 + d0 + 4);
#pragma unroll
              for (int j = 0; j < 4; ++j) { w0[j] = a[j]; w0[4 + j] = b[j]; w1[j] = c[j]; w1[4 + j] = d[j]; w2[j] = e2[j]; w2[4 + j] = f[j]; } }
            const bf16_t* pr = PA + (size_t)row0 * PA_LD;
            float pp[8], pc[8], pn[8];
#pragma unroll
            for (int j = 0; j < 8; ++j) pp[j] = 0.f;
            if (t0 > 0) { float cg[8], uu[8]; unpack8(*(const u32x4*)(pr - PA_LD + 4928 + d0), cg); unpack8(*(const u32x4*)(pr - PA_LD + 5952 + d0), uu);
#pragma unroll
                for (int j = 0; j < 8; ++j) pp[j] = cg[j] * uu[j]; }
            { float cg[8], uu[8]; unpack8(*(const u32x4*)(pr + 4928 + d0), cg); unpack8(*(const u32x4*)(pr + 5952 + d0), uu);
#pragma unroll
              for (int j = 0; j < 8; ++j) pc[j] = cg[j] * uu[j]; }
#pragma unroll
            for (int i = 0; i < 4; ++i) {
#pragma unroll
                for (int j = 0; j < 8; ++j) pn[j] = 0.f;
                if (t0 + i + 1 < L) { float cg[8], uu[8]; unpack8(*(const u32x4*)(pr + (size_t)(i + 1) * PA_LD + 4928 + d0), cg); unpack8(*(const u32x4*)(pr + (size_t)(i + 1) * PA_LD + 5952 + d0), uu);
#pragma unroll
                    for (int j = 0; j < 8; ++j) pn[j] = cg[j] * uu[j]; }
                float bg[8], o[8]; unpack8(*(const u32x4*)(pr + (size_t)i * PA_LD + 3904 + d0), bg);
#pragma unroll
                for (int j = 0; j < 8; ++j) { o[j] = bg[j] * (w0[j] * pp[j] + w1[j] * pc[j] + w2[j] * pn[j]); pp[j] = pc[j]; pc[j] = pn[j]; }
                *(u32x4*)(YC + (size_t)(row0 + i) * 1024 + d0) = pack8(o);
            }
        }
    }
    {
        bf16_t* X0S = (bf16_t*)(p.ws + A_X0S); bf16_t* ZZT = (bf16_t*)(p.ws + A_ZZT);
        const float* hw = p.in[I_HCW] + (size_t)l * 3 * 3072; const float* hb = p.in[I_HCB] + (size_t)l * 3072;
        LAS bf16_t* zt = (LAS bf16_t*)lds;
        for (int u = obid(); u < (MT / 256) * 16; u += gridDim.x) {
            const int rt = u >> 4, dt = u & 15; const int row0 = rt * 256;
            const int dg = tid & 7, rb = tid >> 3, d0 = dt * 64 + dg * 8; const int rowb = row0 + rb * 4;
            const int L = row0 < MP ? LP : LS; const int tb = (row0 < MP ? (row0 & 255) : ((row0 - MP) & 2047)) + rb * 4;
            float wgt[3][3][8], bs[3][8];
#pragma unroll
            for (int g = 0; g < 3; ++g) {
#pragma unroll
                for (int o = 0; o < 3; ++o) { const f32x4 a = *(const f32x4*)(hw + o * 3072 + g * 1024 + d0), b = *(const f32x4*)(hw + o * 3072 + g * 1024 + d0 + 4);
#pragma unroll
                    for (int j = 0; j < 4; ++j) { wgt[g][o][j] = a[j]; wgt[g][o][4 + j] = b[j]; } }
                const f32x4 a = *(const f32x4*)(hb + g * 1024 + d0), b = *(const f32x4*)(hb + g * 1024 + d0 + 4);
#pragma unroll
                for (int j = 0; j < 4; ++j) { bs[g][j] = a[j]; bs[g][4 + j] = b[j]; }
            }
            const bf16_t* pr = PA + (size_t)rowb * PA_LD + d0;
            u32x4 wp[3], wc[3], wn[3];
#pragma unroll
            for (int g = 0; g < 3; ++g) { wp[g] = (u32x4){0u, 0u, 0u, 0u}; if (tb > 0) wp[g] = *(const u32x4*)(pr - PA_LD + g * 1024); wc[g] = *(const u32x4*)(pr + g * 1024); }
#pragma unroll
            for (int i = 0; i < 4; ++i) {
#pragma unroll
                for (int g = 0; g < 3; ++g) { wn[g] = (u32x4){0u, 0u, 0u, 0u}; if (tb + i + 1 < L) wn[g] = *(const u32x4*)(pr + (size_t)(i + 1) * PA_LD + g * 1024); }
                float hv[3][8];
#pragma unroll
                for (int g = 0; g < 3; ++g) { float a[8], b[8], c[8]; unpack8(wp[g], a); unpack8(wc[g], b); unpack8(wn[g], c);
#pragma unroll
                    for (int j = 0; j < 8; ++j) hv[g][j] = bs[g][j] + wgt[g][0][j] * a[j] + wgt[g][1][j] * b[j] + wgt[g][2][j] * c[j];
                    wp[g] = wc[g]; wc[g] = wn[g]; }
                *(u32x4*)(X0S + (size_t)(rowb + i) * 1024 + d0) = pack8(hv[0]);
#pragma unroll
                for (int j = 0; j < 8; ++j) zt[(dg * 8 + j) * 264 + rb * 4 + i] = f2bf(hv[1][j] * hv[2][j]);
            }
            __syncthreads();
#pragma unroll
            for (int i = 0; i < 4; ++i) {
                const int chunk = tid + i * NTHREADS; const int dl = chunk >> 5, tch = chunk & 31; const int d = dt * 64 + dl;
                size_t base; int t0;
                if (row0 < MP) { const int b = row0 >> 8; t0 = 0; base = ((size_t)b * 1024 + d) * LP; }
                else { const int r2 = row0 - MP; const int b = r2 >> 11; t0 = r2 & 2047; base = (size_t)BP * 1024 * LP + ((size_t)b * 1024 + d) * LS; }
                *(u32x4*)(ZZT + base + t0 + tch * 8) = *(const LAS u32x4*)(zt + dl * 264 + tch * 8);
            }
            __syncthreads();
        }
    }
}

__device__ __forceinline__ void conv_phase(int wv, const Params& p, int l, LAS unsigned char* lds) {
    const int tid = otid(wv), wid = tid >> 6, lane = tid & 63, r = lane & 31, hh = lane >> 5;
    const bf16_t* ZZT = (const bf16_t*)(p.ws + A_ZZT); bf16_t* YCT = (bf16_t*)(p.ws + A_YCT);
    const float* hbias = p.in[I_HBIAS] + l * 1024;
    LAS bf16_t* cp = (LAS bf16_t*)lds;
    LAS bf16_t* zz = (LAS bf16_t*)(lds + 65536);
    LAS float* kf = (LAS float*)(lds + 98304);
    for (int u = obid(); u < 2048; u += gridDim.x) {
        const int g = (u < 1024) ? 1 : 0, d = u & 1023;
        const int L = g ? LS : LP, B = g ? BS : BP, L2 = 2 * L, NB = L / 32, NI = 32 / B, NT = NB / NI, lgB = g ? 3 : 4;
        const float* kT = (const float*)(p.ws + (g ? S_KTS : S_KTP)) + (size_t)d * L2;
        const float scale = ((const float*)(p.ws + S_SCALE))[g * 1024 + d]; const float bias = hbias[d];
        for (int i = tid; i < L2 / 4; i += NTHREADS) { f32x4 v = *(const f32x4*)(kT + i * 4); v *= scale; if (i == 0) v[0] += bias; *(LAS f32x4*)(kf + i * 4) = v; }
        const size_t zbase = g ? (size_t)BP * 1024 * LP : 0;
        for (int ch = tid; ch < B * L / 8; ch += NTHREADS) {
            const int b = ch / (L / 8), s8 = ch - b * (L / 8);
            *(LAS u32x4*)(zz + b * L + s8 * 8) = *(const u32x4*)(ZZT + zbase + ((size_t)b * 1024 + d) * L + s8 * 8);
        }
        __syncthreads();
        for (int ck = tid; ck < L2; ck += NTHREADS) {
            const int c = ck / (L2 / 8), m0 = (ck - c * (L2 / 8)) * 8;
            float f[8];
#pragma unroll
            for (int j = 0; j < 8; ++j) f[j] = kf[(L2 - (m0 + c + j)) & (L2 - 1)];
            *(LAS u32x4*)(cp + c * L2 + m0) = pack8(f);
        }
        __syncthreads();
        const int Iloc = r >> lgB, b = r & (B - 1);
        for (int nt = wid * 2; nt < NT; nt += 16) {
            const int I0 = nt * NI;
            f32x16 acc0, acc1;
#pragma unroll
            for (int i = 0; i < 16; ++i) { acc0[i] = 0.f; acc1[i] = 0.f; }
            const bf16x8 zero8 = (bf16x8){0, 0, 0, 0, 0, 0, 0, 0};
            bf16x8 prev[4][2];
#pragma unroll
            for (int i = 0; i < 4; ++i) { prev[i][0] = zero8; prev[i][1] = zero8; }
            const int dl0 = I0 - (NB - 1), nsteps = NB + 2 * NI - 1;
            if (NI == 4) {
                for (int c4 = 0; c4 < nsteps; c4 += 4) {
                    bf16x8 cur[4][2];
#pragma unroll
                    for (int i = 0; i < 4; ++i) {
                        const int dl = dl0 + c4 + i; const int J0 = I0 + Iloc - dl; const bool v0 = (J0 >= 0) && (J0 < NB);
#pragma unroll
                        for (int ks = 0; ks < 2; ++ks) {
                            const int i0 = (16 * ks + 8 * hh - 32 * dl - r) & (L2 - 1); const int c = i0 & 7, q = i0 >> 3;
                            const bf16x8 Af = *(const LAS bf16x8*)(cp + c * L2 + q * 8);
                            cur[i][ks] = zero8;
                            if (v0) cur[i][ks] = *(const LAS bf16x8*)(zz + b * L + 32 * J0 + 16 * ks + 8 * hh);
                            acc0 = __builtin_amdgcn_mfma_f32_32x32x16_bf16(Af, cur[i][ks], acc0, 0, 0, 0);
                            acc1 = __builtin_amdgcn_mfma_f32_32x32x16_bf16(Af, prev[i][ks], acc1, 0, 0, 0);
                        }
                    }
#pragma unroll
                    for (int i = 0; i < 4; ++i) { prev[i][0] = cur[i][0]; prev[i][1] = cur[i][1]; }
                }
            } else {
                for (int c2 = 0; c2 < nsteps + 1; c2 += 2) {
                    bf16x8 cur[2][2];
#pragma unroll
                    for (int i = 0; i < 2; ++i) {
                        const int dl = dl0 + c2 + i; const int J0 = I0 + Iloc - dl; const bool v0 = (J0 >= 0) && (J0 < NB);
#pragma unroll
                        for (int ks = 0; ks < 2; ++ks) {
                            const int i0 = (16 * ks + 8 * hh - 32 * dl - r) & (L2 - 1); const int c = i0 & 7, q = i0 >> 3;
                            const bf16x8 Af = *(const LAS bf16x8*)(cp + c * L2 + q * 8);
                            cur[i][ks] = zero8;
                            if (v0) cur[i][ks] = *(const LAS bf16x8*)(zz + b * L + 32 * J0 + 16 * ks + 8 * hh);
                            acc0 = __builtin_amdgcn_mfma_f32_32x32x16_bf16(Af, cur[i][ks], acc0, 0, 0, 0);
                            acc1 = __builtin_amdgcn_mfma_f32_32x32x16_bf16(Af, prev[i][ks], acc1, 0, 0, 0);
                        }
                    }
#pragma unroll
                    for (int i = 0; i < 2; ++i) { prev[i][0] = cur[i][0]; prev[i][1] = cur[i][1]; }
                }
            }
            bf16_t* op = YCT + zbase + ((size_t)b * 1024 + d) * L + 32 * (I0 + Iloc) + 4 * hh;
#pragma unroll
            for (int g4 = 0; g4 < 4; ++g4) {
                u32x2 w; w.x = cvt_pk_bf16(acc0[4 * g4], acc0[4 * g4 + 1]); w.y = cvt_pk_bf16(acc0[4 * g4 + 2], acc0[4 * g4 + 3]); *(u32x2*)(op + 8 * g4) = w;
                u32x2 w1; w1.x = cvt_pk_bf16(acc1[4 * g4], acc1[4 * g4 + 1]); w1.y = cvt_pk_bf16(acc1[4 * g4 + 2], acc1[4 * g4 + 3]); *(u32x2*)(op + 32 * NI + 8 * g4) = w1;
            }
        }
        __syncthreads();
    }
}

__device__ __forceinline__ void e3b_phase(int wv, const Params& p, LAS unsigned char* lds) {
    const int tid = otid(wv);
    const bf16_t* X0S = (const bf16_t*)(p.ws + A_X0S); const bf16_t* YCT = (const bf16_t*)(p.ws + A_YCT); bf16_t* YA = (bf16_t*)(p.ws + A_YA);
    LAS bf16_t* yt = (LAS bf16_t*)lds;
    for (int u = obid(); u < (MT / 64) * 16; u += gridDim.x) {
        const int rt = u >> 4, dt = u & 15; const int row0 = rt * 64;
        {
            const int dl = tid >> 3, tch = tid & 7; const int d = dt * 64 + dl;
            size_t base; int t0;
            if (row0 < MP) { const int b = row0 >> 8; t0 = row0 & 255; base = ((size_t)b * 1024 + d) * LP; }
            else { const int r2 = row0 - MP; const int b = r2 >> 11; t0 = r2 & 2047; base = (size_t)BP * 1024 * LP + ((size_t)b * 1024 + d) * LS; }
            const u32x4 v = *(const u32x4*)(YCT + base + t0 + tch * 8);
            const unsigned w[4] = {v.x, v.y, v.z, v.w};
#pragma unroll
            for (int j = 0; j < 4; ++j) { yt[(tch * 8 + 2 * j) * 72 + dl] = (bf16_t)(w[j] & 0xffffu); yt[(tch * 8 + 2 * j + 1) * 72 + dl] = (bf16_t)(w[j] >> 16); }
        }
        __syncthreads();
        {
            const int tl = tid >> 3, dg = tid & 7; const int row = row0 + tl, d0 = dt * 64 + dg * 8;
            float a[8], b[8]; unpack8(*(const LAS u32x4*)(yt + tl * 72 + dg * 8), a); unpack8(*(const u32x4*)(X0S + (size_t)row * 1024 + d0), b);
#pragma unroll
            for (int j = 0; j < 8; ++j) a[j] *= b[j];
            *(u32x4*)(YA + (size_t)row * 1024 + d0) = pack8(a);
        }
        __syncthreads();
    }
}

__device__ __forceinline__ void attn_phase(int wv, const Params& p, LAS unsigned char* lds) {
    const bf16_t* Q = (const bf16_t*)(p.ws + A_Q); const bf16_t* KN = (const bf16_t*)(p.ws + A_KN); const bf16_t* KP = (const bf16_t*)(p.ws + A_KPER);
    const bf16_t* VT = (const bf16_t*)(p.ws + A_VT); bf16_t* O = (bf16_t*)(p.ws + A_OATT);
    LAS unsigned char* Ks = lds;
    LAS unsigned char* Vs = lds + 64 * 400;
    const float sc2 = 0.07216878364870322f * 1.4426950408889634f;
    for (int u = obid(); u < 512 + 128; u += gridDim.x) {
        const int tid = otid(wv), wid = tid >> 6, lane = tid & 63, r = lane & 31, hh = lane >> 5;
        int b, h, row0, Lk, KR0; size_t vtb; bool samp;
        if (u < 512) { samp = true; b = u >> 6; h = (u >> 3) & 7; const int qb = u & 7; row0 = MP + b * LS + qb * 256; Lk = LKS; KR0 = b * LKS; vtb = (size_t)(b * 8 + h) * 128 * LKS; }
        else { samp = false; const int u2 = u - 512; b = u2 >> 3; h = u2 & 7; row0 = b * LP; Lk = LP; KR0 = BS * LKS + b * LP; vtb = (size_t)BS * 8 * 128 * LKS + (size_t)(b * 8 + h) * 128 * LP; }
        const int qrow = row0 + wid * 32 + r;
        bf16x8 qf[12];
        {
            const bf16_t* qp = Q + (size_t)qrow * 1536 + h * 192 + 8 * hh;
            u32x4 qv[12];
#pragma unroll
            for (int s = 0; s < 12; ++s) qv[s] = *(const u32x4*)(qp + 16 * s);
            if (samp) {
                const int t = (qrow - MP) & 2047;
#pragma unroll
                for (int s2 = 0; s2 < 2; ++s2) {
                    float x1[8], x2[8]; unpack8(qv[8 + s2], x1); unpack8(qv[10 + s2], x2);
                    const float* rc = (const float*)(p.ws + S_ROPE) + t * 32 + 16 * s2 + 8 * hh;
                    const f32x4 c0 = *(const f32x4*)rc, c1 = *(const f32x4*)(rc + 4), s0 = *(const f32x4*)(rc + 2048 * 32), s1 = *(const f32x4*)(rc + 2048 * 32 + 4);
#pragma unroll
                    for (int j = 0; j < 8; ++j) { const float cs = (j < 4) ? c0[j & 3] : c1[j & 3], sn = (j < 4) ? s0[j & 3] : s1[j & 3]; const float a = x1[j], c = x2[j]; x1[j] = a * cs - c * sn; x2[j] = a * sn + c * cs; }
                    qv[8 + s2] = pack8(x1); qv[10 + s2] = pack8(x2);
                }
            }
#pragma unroll
            for (int s = 0; s < 12; ++s) qf[s] = __builtin_bit_cast(bf16x8, qv[s]);
        }
        f32x16 oacc[4];
#pragma unroll
        for (int ct = 0; ct < 4; ++ct)
#pragma unroll
            for (int i = 0; i < 16; ++i) oacc[ct][i] = 0.f;
        float mrun = -1e30f, lrun = 0.f;
        const int nkt = Lk / 64;
        u32x4 kst[3], vst[2];
#pragma unroll
        for (int i = 0; i < 3; ++i) { const int ck = tid + i * NTHREADS; const int key = ck / 24, part = ck - key * 24;
            kst[i] = (part < 16) ? *(const u32x4*)(KN + (size_t)(KR0 + key) * 1024 + h * 128 + part * 8) : *(const u32x4*)(KP + (size_t)(KR0 + key) * 64 + (part - 16) * 8); }
#pragma unroll
        for (int i = 0; i < 2; ++i) { const int cv = tid + i * NTHREADS; const int v = cv >> 3, kc = cv & 7; vst[i] = *(const u32x4*)(VT + vtb + (size_t)v * Lk + kc * 8); }
        for (int kt = 0; kt < nkt; ++kt) {
            __syncthreads();
#pragma unroll
            for (int i = 0; i < 3; ++i) { const int ck = tid + i * NTHREADS; const int key = ck / 24, part = ck - key * 24; *(LAS u32x4*)(Ks + key * 400 + part * 16) = kst[i]; }
#pragma unroll
            for (int i = 0; i < 2; ++i) { const int cv = tid + i * NTHREADS; const int v = cv >> 3, kc = cv & 7;
                LAS unsigned char* vp = Vs + v * 144 + (kc >> 1) * 32 + (kc & 1) * 8;
                *(LAS u32x2*)vp = (u32x2){vst[i].x, vst[i].y}; *(LAS u32x2*)(vp + 16) = (u32x2){vst[i].z, vst[i].w}; }
            __syncthreads();
            if (kt + 1 < nkt) {
                const int k0 = (kt + 1) * 64;
#pragma unroll
                for (int i = 0; i < 3; ++i) { const int ck = tid + i * NTHREADS; const int key = ck / 24, part = ck - key * 24;
                    kst[i] = (part < 16) ? *(const u32x4*)(KN + (size_t)(KR0 + k0 + key) * 1024 + h * 128 + part * 8) : *(const u32x4*)(KP + (size_t)(KR0 + k0 + key) * 64 + (part - 16) * 8); }
#pragma unroll
                for (int i = 0; i < 2; ++i) { const int cv = tid + i * NTHREADS; const int v = cv >> 3, kc = cv & 7; vst[i] = *(const u32x4*)(VT + vtb + (size_t)v * Lk + k0 + kc * 8); }
            }
            f32x16 sacc[2];
#pragma unroll
            for (int i = 0; i < 16; ++i) { sacc[0][i] = 0.f; sacc[1][i] = 0.f; }
#pragma unroll
            for (int s = 0; s < 12; ++s) {
                const bf16x8 kf0 = *(const LAS bf16x8*)(Ks + r * 400 + (16 * s + 8 * hh) * 2);
                const bf16x8 kf1 = *(const LAS bf16x8*)(Ks + (32 + r) * 400 + (16 * s + 8 * hh) * 2);
                sacc[0] = __builtin_amdgcn_mfma_f32_32x32x16_bf16(kf0, qf[s], sacc[0], 0, 0, 0);
                sacc[1] = __builtin_amdgcn_mfma_f32_32x32x16_bf16(kf1, qf[s], sacc[1], 0, 0, 0);
            }
            float mx0 = fmaxf(sacc[0][0], sacc[1][0]), mx1 = fmaxf(sacc[0][1], sacc[1][1]);
#pragma unroll
            for (int i = 2; i < 16; i += 2) { mx0 = __builtin_fmaxf(__builtin_fmaxf(mx0, sacc[0][i]), sacc[1][i]); mx1 = __builtin_fmaxf(__builtin_fmaxf(mx1, sacc[0][i + 1]), sacc[1][i + 1]); }
            float mx = fmaxf(mx0, mx1);
            mx = fmaxf(mx, shx(mx, 32, lane));
            const float mnew = fmaxf(mrun, mx);
            const bool resc = __builtin_amdgcn_ballot_w64(mnew != mrun) != 0ull;
            const float alpha = __builtin_amdgcn_exp2f((mrun - mnew) * sc2);
            mrun = mnew;
            const float nm = -mnew * sc2;
            f32x2 ps2 = (f32x2){0.f, 0.f};
#pragma unroll
            for (int kk = 0; kk < 2; ++kk)
#pragma unroll
                for (int i = 0; i < 16; i += 2) {
                    f32x2 a = (f32x2){sacc[kk][i], sacc[kk][i + 1]}; a = a * sc2 + nm;
                    a.x = __builtin_amdgcn_exp2f(a.x); a.y = __builtin_amdgcn_exp2f(a.y);
                    sacc[kk][i] = a.x; sacc[kk][i + 1] = a.y; ps2 += a;
                }
            lrun = lrun * alpha + (ps2.x + ps2.y);
            if (resc) {
#pragma unroll
                for (int ct = 0; ct < 4; ++ct)
#pragma unroll
                    for (int i = 0; i < 16; ++i) oacc[ct][i] *= alpha;
            }
#pragma unroll
            for (int ks = 0; ks < 4; ++ks) {
                const int kk = ks >> 1, s2 = ks & 1;
                u32x4 pw;
                pw.x = cvt_pk_bf16(sacc[kk][8 * s2 + 0], sacc[kk][8 * s2 + 1]); pw.y = cvt_pk_bf16(sacc[kk][8 * s2 + 2], sacc[kk][8 * s2 + 3]);
                pw.z = cvt_pk_bf16(sacc[kk][8 * s2 + 4], sacc[kk][8 * s2 + 5]); pw.w = cvt_pk_bf16(sacc[kk][8 * s2 + 6], sacc[kk][8 * s2 + 7]);
                const bf16x8 pf = __builtin_bit_cast(bf16x8, pw);
#pragma unroll
                for (int ct = 0; ct < 4; ++ct) {
                    const bf16x8 vf = *(const LAS bf16x8*)(Vs + (32 * ct + r) * 144 + (32 * kk + 16 * s2) * 2 + 16 * hh);
                    oacc[ct] = __builtin_amdgcn_mfma_f32_32x32x16_bf16(vf, pf, oacc[ct], 0, 0, 0);
                }
            }
        }
        lrun += shx(lrun, 32, lane);
        const float invl = 1.0f / lrun;
        const int tid2 = otid(wv); const int qrow2 = row0 + (tid2 >> 6) * 32 + (tid2 & 31);
        bf16_t* op = O + (size_t)qrow2 * 1024 + h * 128 + 4 * ((tid2 >> 5) & 1);
#pragma unroll
        for (int ct = 0; ct < 4; ++ct)
#pragma unroll
            for (int g4 = 0; g4 < 4; ++g4) {
                u32x2 w; w.x = cvt_pk_bf16(oacc[ct][4 * g4] * invl, oacc[ct][4 * g4 + 1] * invl); w.y = cvt_pk_bf16(oacc[ct][4 * g4 + 2] * invl, oacc[ct][4 * g4 + 3] * invl);
                *(u32x2*)(op + 32 * ct + 8 * g4) = w;
            }
        __syncthreads();
    }
}

__device__ __forceinline__ void e9_phase(int wv, const Params& p, int l) {
    const bf16_t* UU = (const bf16_t*)(p.ws + A_UU); bf16_t* ACT = (bf16_t*)(p.ws + A_ACT);
    const float* cw = p.in[I_FCW] + (size_t)l * 3 * UU_LD; const float* cb = p.in[I_FCB] + (size_t)l * UU_LD;
    const int tid9 = otid(wv);
    constexpr int RC = 16, NCG = DFF / 8;
    for (int it = obid() * NTHREADS + tid9; it < (MT / RC) * NCG; it += gridDim.x * NTHREADS) {
        const int ch = it / NCG, c0 = (it - ch * NCG) * 8, row0 = ch * RC;
        const int t0 = row0 < MP ? (row0 & 255) : ((row0 - MP) & 2047); const int L = row0 < MP ? LP : LS;
        float wg[3][8], wx[3][8], bg[8], bx[8];
#pragma unroll
        for (int o = 0; o < 3; ++o) { const f32x4 a = *(const f32x4*)(cw + o * UU_LD + c0), b = *(const f32x4*)(cw + o * UU_LD + c0 + 4), c = *(const f32x4*)(cw + o * UU_LD + DFF + c0), d = *(const f32x4*)(cw + o * UU_LD + DFF + c0 + 4);
#pragma unroll
            for (int j = 0; j < 4; ++j) { wg[o][j] = a[j]; wg[o][4 + j] = b[j]; wx[o][j] = c[j]; wx[o][4 + j] = d[j]; } }
        { const f32x4 a = *(const f32x4*)(cb + c0), b = *(const f32x4*)(cb + c0 + 4), c = *(const f32x4*)(cb + DFF + c0), d = *(const f32x4*)(cb + DFF + c0 + 4);
#pragma unroll
          for (int j = 0; j < 4; ++j) { bg[j] = a[j]; bg[4 + j] = b[j]; bx[j] = c[j]; bx[4 + j] = d[j]; } }
        const bf16_t* pr = UU + (size_t)row0 * UU_LD + c0;
        u32x4 gp = (u32x4){0u, 0u, 0u, 0u}, xp = gp, gc, xc, gn, xn;
        if (t0 > 0) { gp = *(const u32x4*)(pr - UU_LD); xp = *(const u32x4*)(pr - UU_LD + DFF); }
        gc = *(const u32x4*)pr; xc = *(const u32x4*)(pr + DFF);
#pragma unroll 4
        for (int i = 0; i < RC; ++i) {
            gn = (u32x4){0u, 0u, 0u, 0u}; xn = gn;
            if (t0 + i + 1 < L) { gn = *(const u32x4*)(pr + (size_t)(i + 1) * UU_LD); xn = *(const u32x4*)(pr + (size_t)(i + 1) * UU_LD + DFF); }
            float a[8], b[8], c[8], ga[8], va[8];
            unpack8(gp, a); unpack8(gc, b); unpack8(gn, c);
#pragma unroll
            for (int j = 0; j < 8; ++j) ga[j] = bg[j] + wg[0][j] * a[j] + wg[1][j] * b[j] + wg[2][j] * c[j];
            unpack8(xp, a); unpack8(xc, b); unpack8(xn, c);
#pragma unroll
            for (int j = 0; j < 8; ++j) va[j] = bx[j] + wx[0][j] * a[j] + wx[1][j] * b[j] + wx[2][j] * c[j];
#pragma unroll
            for (int j = 0; j < 8; ++j) ga[j] = siluf_(ga[j]) * va[j];
            *(u32x4*)(ACT + (size_t)(row0 + i) * DFF + c0) = pack8(ga);
            gp = gc; gc = gn; xp = xc; xc = xn;
        }
    }
}

__device__ __forceinline__ void merge_phase(int wv, const Params& p) {
    const bf16_t* RAW = (const bf16_t*)(p.ws + A_RAW); const bf16_t* G = (const bf16_t*)(p.ws + A_GATES); bf16_t* MB = (bf16_t*)(p.ws + A_MBF);
    const int tid = otid(wv);
    for (int it = obid() * NTHREADS + tid; it < MT * 256; it += gridDim.x * NTHREADS) {
        const int row = it >> 8, c0 = (it & 255) * 8;
        float acc[8];
#pragma unroll
        for (int j = 0; j < 8; ++j) acc[j] = 0.f;
#pragma unroll
        for (int P = 0; P < 3; ++P) {
            float r[8], g[8];
            unpack8(*(const u32x4*)(RAW + ((size_t)P * MT + row) * DM + c0), r); unpack8(*(const u32x4*)(G + (size_t)row * GATE_LD + P * 2048 + c0), g);
#pragma unroll
            for (int j = 0; j < 8; ++j) acc[j] += sigmoidf_(g[j]) * r[j];
        }
        *(u32x4*)(MB + (size_t)row * DM + c0) = pack8(acc);
    }
}

__device__ __forceinline__ void convert_layer(int wv, const Params& p, int l, LAS unsigned char* lds) {
    unsigned char* ws = p.ws;
    convT(wv, p.in[I_WIN] + (size_t)l * DM * NIN, DM, NIN, (bf16_t*)(ws + W_IN), 1, lds);
    convT(wv, p.in[I_WUQ] + (size_t)l * 512 * 1536, 512, 1536, (bf16_t*)(ws + W_UQ), 0, lds);
    convT(wv, p.in[I_WUKV] + (size_t)l * 256 * 2048, 256, 2048, (bf16_t*)(ws + W_UKV), 2, lds);
    convT(wv, p.in[I_WBRA] + (size_t)l * 1024 * 2048, 1024, 2048, (bf16_t*)(ws + W_BRA), 0, lds);
    convT(wv, p.in[I_WBRB] + (size_t)l * 1024 * 2048, 1024, 2048, (bf16_t*)(ws + W_BRB), 0, lds);
    convT(wv, p.in[I_WBRC] + (size_t)l * 1024 * 2048, 1024, 2048, (bf16_t*)(ws + W_BRC), 0, lds);
    convT(wv, p.in[I_WO] + (size_t)l * 2048 * 2048, 2048, 2048, (bf16_t*)(ws + W_O), 0, lds);
    convT(wv, p.in[I_FUP] + (size_t)l * 2048 * UU_LD, 2048, UU_LD, (bf16_t*)(ws + W_UP), 0, lds);
    convT(wv, p.in[I_FDN] + (size_t)l * DFF * 2048, DFF, 2048, (bf16_t*)(ws + W_DN), 0, lds);
}

namespace pg8 {
struct EpiGateRT {
    const bf16_t* gates; float* m32; bf16_t* mbf; int P;
    __device__ __forceinline__ void operator()(const f32x4 (&acc)[2][2][4][2], const Unit& u, int wr, int wc, int fr, int fq) const {
        const int row0 = u.pm * BM + wr * 64 + fr, col0 = u.pn * BM + wc * 32 + 4 * fq;
#pragma unroll
        for (int ai = 0; ai < 2; ++ai)
#pragma unroll
            for (int m = 0; m < 4; ++m) {
                const size_t row = (size_t)(row0 + ai * HALF + m * 16);
#pragma unroll
                for (int bj = 0; bj < 2; ++bj)
#pragma unroll
                    for (int n = 0; n < 2; ++n) {
                        const int col = col0 + bj * HALF + n * 16;
                        const u32x2 gw = *(const u32x2*)(gates + row * GATE_LD + P * 2048 + col);
                        f32x4 v = acc[ai][bj][m][n];
                        v[0] *= sigmoidf_(bf_lo(gw.x)); v[1] *= sigmoidf_(bf_hi(gw.x)); v[2] *= sigmoidf_(bf_lo(gw.y)); v[3] *= sigmoidf_(bf_hi(gw.y));
                        float* mp = m32 + row * 2048 + col;
                        if (P != 0) { const f32x4 o = *(const f32x4*)mp; v = v + o; }
                        if (P != 2) { *(f32x4*)mp = v; }
                        else { u32x2 w; w.x = cvt_pk_bf16(v[0], v[1]); w.y = cvt_pk_bf16(v[2], v[3]); *(u32x2*)(mbf + row * 2048 + col) = w; }
                    }
            }
    }
};
}


#define XB_TMO      128
#define XB_XCNT(j)  (256  + 64 * (j))
#define XB_XSUB(j)  (1280 + 64 * (j))
#define XB_XGEN(j)  (2304 + 64 * (j))
#define XB_TOP      3328
#define XB_TOPGEN   3392
#define XCD_BAR_WORDS 3456
#define XB_SPIN_CAP (1u << 20)
__device__ __forceinline__ unsigned xb_ld(unsigned* p)              { return __hip_atomic_load(p, __ATOMIC_RELAXED, __HIP_MEMORY_SCOPE_AGENT); }
__device__ __forceinline__ unsigned xb_add(unsigned* p, unsigned v) { return __hip_atomic_fetch_add(p, v, __ATOMIC_RELAXED, __HIP_MEMORY_SCOPE_AGENT); }
__device__ __forceinline__ unsigned xb_xcc_id() { return (unsigned)__builtin_amdgcn_s_getreg((3 << 11) | 20) & 0xFu; }
#define XB_SPIN(cond, bar) do { unsigned _sp = 0; while (cond) { __builtin_amdgcn_s_sleep(1); \
    if ((++_sp & 255u) == 0u) { if (xb_ld(&(bar)[XB_TMO])) break; if (_sp > XB_SPIN_CAP) { atomicAdd(&(bar)[XB_TMO], 1u); break; } } } } while (0)
__device__ __forceinline__ void xcd_barrier_complete(unsigned* bar, unsigned x, unsigned& nloc, unsigned& nx) {
    const unsigned G = gridDim.x;
    unsigned sum, cnt, mine, sp = 0u;
    for (;;) {
        sum = 0u; cnt = 0u; mine = 0u;
#pragma unroll
        for (unsigned j = 0; j < 16; ++j) { const unsigned c = xb_ld(&bar[XB_XCNT(j)]); sum += c; cnt += (c > 0u) ? 1u : 0u; mine = (j == x) ? c : mine; }
        if (sum == G) break;
        __builtin_amdgcn_s_sleep(1);
        if ((++sp & 255u) == 0u) { if (xb_ld(&bar[XB_TMO])) break; if (sp > XB_SPIN_CAP) { atomicAdd(&bar[XB_TMO], 1u); break; } }
    }
    nloc = mine > 0u ? mine : 1u; nx = cnt > 0u ? cnt : 1u;
}
__device__ __forceinline__ void xcd_barrier(int wv, unsigned* bar, volatile LAS unsigned* st) {
    asm volatile("s_waitcnt vmcnt(0)" ::: "memory");
    __syncthreads();
    if (otid(wv) == 0) {
        __builtin_amdgcn_s_waitcnt(0);
        const unsigned x = xb_xcc_id();
        unsigned nloc = st[0], nx = st[1];
        if (nloc == 0u) { xcd_barrier_complete(bar, x, nloc, nx); st[0] = nloc; st[1] = nx; }
        const unsigned old = xb_add(&bar[XB_XSUB(x)], 1u);
        const unsigned gen = old / nloc;
        if (old + 1u == (gen + 1u) * nloc) {
            __builtin_amdgcn_fence(__ATOMIC_RELEASE, "agent");
            asm volatile("s_waitcnt vmcnt(0)" ::: "memory");
            const unsigned og = xb_add(&bar[XB_TOP], 1u);
            const unsigned tg = og / nx;
            if (og + 1u == (tg + 1u) * nx) xb_add(&bar[XB_TOPGEN], 1u);
            else XB_SPIN(xb_ld(&bar[XB_TOPGEN]) == tg, bar);
            __builtin_amdgcn_fence(__ATOMIC_ACQUIRE, "agent");
            xb_add(&bar[XB_XGEN(x)], 1u);
            asm volatile("s_waitcnt vmcnt(0)" ::: "memory");
        } else {
            XB_SPIN(xb_ld(&bar[XB_XGEN(x)]) == gen, bar);
            __builtin_amdgcn_fence(__ATOMIC_ACQUIRE, "agent");
            asm volatile("s_waitcnt vmcnt(0)" ::: "memory");
        }
    }
    __syncthreads();
}

#ifndef REP_GEMM
#define REP_GEMM 1
#endif
#ifndef REP_ATTN
#define REP_ATTN 1
#endif
#ifndef REP_CONV
#define REP_CONV 1
#endif
#ifndef REP_ELT
#define REP_ELT 1
#endif
#ifndef REP_CVT
#define REP_CVT 1
#endif
enum { K_G1A = 0, K_E2, K_I3, K_I4, K_G1B, K_G5, K_G6, K_ROW1, K_G8, K_E9, K_G10, K_ROW2, K_PRO, K_ROW0, K_COMB };

__global__ void __launch_bounds__(NTHREADS) fwd_megakernel(Params p) {
    extern __shared__ __attribute__((aligned(16))) unsigned char shm[];
    LAS unsigned char* lds = (LAS unsigned char*)shm;
    cg::grid_group grid = cg::this_grid();
    const int wv = __builtin_amdgcn_readfirstlane((int)(threadIdx.x >> 6));
    volatile LAS unsigned* bst = (volatile LAS unsigned*)(lds + 131072);
    unsigned* bar = (unsigned*)(p.ws + S_BAR);
    if (threadIdx.x == 0) { bst[0] = 0u; bst[1] = 0u; bst[2] = 0u; bst[3] = 0u; (void)xb_add(&bar[XB_XCNT(xb_xcc_id())], 1u); }
    __syncthreads();
#pragma unroll 1
    for (int ph = 0; ph < 3 + 12 * NLAYER; ++ph) {
        int kind, l;
        if (ph == 0) { kind = K_PRO; l = 0; } else if (ph == 1) { kind = K_COMB; l = 0; } else if (ph == 2) { kind = K_ROW0; l = 0; } else { l = (ph - 3) / 12; kind = (ph - 3) - l * 12; }
        unsigned char* ws = p.ws;
        asm volatile("" : "+s"(ws));
        if (kind == K_G1A || kind == K_I3 || kind == K_G1B || kind == K_G8) {
            const bf16_t* A; const bf16_t* Bt; bf16_t* O; int N, K;
            if (kind == K_G1A) { A = (const bf16_t*)(ws + A_H); Bt = (const bf16_t*)(ws + W_IN); O = (bf16_t*)(ws + A_PROJA); N = PA_LD; K = DM; }
            else if (kind == K_I3) { A = (const bf16_t*)(ws + A_CQN); Bt = (const bf16_t*)(ws + W_UQ); O = (bf16_t*)(ws + A_Q); N = 1536; K = 512; }
            else if (kind == K_G1B) { A = (const bf16_t*)(ws + A_H); Bt = (const bf16_t*)(ws + W_IN) + (size_t)PA_LD * DM; O = (bf16_t*)(ws + A_GATES); N = GATE_LD; K = DM; }
            else { A = (const bf16_t*)(ws + A_H); Bt = (const bf16_t*)(ws + W_UP); O = (bf16_t*)(ws + A_UU); N = UU_LD; K = DM; }
            int Mr = MT;
            const int nrep = ((kind == K_I3) ? 2 : 1) * REP_GEMM;
#pragma unroll 1
            for (int rp = 0; rp < nrep; ++rp) {
                if (kind == K_I3 && rp >= REP_GEMM) { A = (const bf16_t*)(ws + A_KEYSC); Bt = (const bf16_t*)(ws + W_UKV); O = (bf16_t*)(ws + A_KN); N = 1024; K = 256; Mr = KROWS; }
                run_gemm(wv, lds, A, Bt, Mr, N, K, pg8::EpiBf16{O, N, O});
            }
        }
        if (kind == K_I3) {
#pragma unroll 1
            for (int rp = 0; rp < REP_GEMM; ++rp)
            run_gemm(wv, lds, (const bf16_t*)(ws + W_UKV) + (size_t)1024 * 256, (const bf16_t*)(ws + A_KEYSC), 1024, KROWS, 256,
                     pg8::EpiVT{(bf16_t*)(ws + A_VT), (bf16_t*)(ws + A_VT) + (size_t)BS * 8 * 128 * LKS});
#pragma unroll 1
            for (int rp = 0; rp < REP_CONV; ++rp) conv_phase(wv, p, l, lds);
        }
        if (kind == K_I4) {
#pragma unroll 1
            for (int rp = 0; rp < REP_ATTN; ++rp) attn_phase(wv, p, lds);
#pragma unroll 1
            for (int rp = 0; rp < REP_ELT; ++rp) e3b_phase(wv, p, lds); }
        if (kind == K_G1B) {
#pragma unroll 1
            for (int rp = 0; rp < REP_GEMM; ++rp)
            run_gemm(wv, lds, (const bf16_t*)(ws + A_YA), (const bf16_t*)(ws + W_BRA), 3 * MT, DM, 1024, pg8::EpiBf16{(bf16_t*)(ws + A_RAW), DM, (bf16_t*)(ws + A_RAW)}, false, MT / 256, E_WBR * 2, true);
        }
        if (kind == K_G5) merge_phase(wv, p);
        if (kind == K_G6 || kind == K_G10) {
            const bool g6 = (kind == K_G6);
#pragma unroll 1
            for (int rp = 0; rp < REP_GEMM; ++rp)
            run_gemm(wv, lds, (const bf16_t*)(ws + (g6 ? A_MBF : A_ACT)), (const bf16_t*)(ws + (g6 ? W_O : W_DN)), MT, DM, g6 ? DM : DFF, pg8::EpiBf16{(bf16_t*)(ws + (g6 ? A_M32 : A_F32)), DM, (bf16_t*)(ws + (g6 ? A_M32 : A_F32)) + (size_t)MT * DM}, true);
        }
        if (kind == K_E2) {
#pragma unroll 1
            for (int rp = 0; rp < REP_ELT; ++rp) e2_phase(wv, p, l, lds); }
        if (kind == K_E9) {
#pragma unroll 1
            for (int rp = 0; rp < REP_ELT; ++rp) e9_phase(wv, p, l); }
        if (kind == K_ROW0 || kind == K_ROW1 || kind == K_ROW2) row_phase(wv, p, l, kind == K_ROW0 ? 0 : (kind == K_ROW1 ? 1 : 2));
        if (kind == K_COMB) comb_phase(wv, p);
        if (kind == K_PRO) {
            if (obid() == 0) {
                pg8::StaticOrder S; S.init(MT, DM, (int)gridDim.x, 0, true);
                const int t0 = otid(wv);
                if (t0 < S.nwg - S.nfull) { pg8::Unit uu; S.tile_of(S.nfull + t0, uu); atomicOr((unsigned*)(p.ws + S_TAIL) + uu.pm, 1u << uu.pn); }
            }
            ada_phase(wv, p, lds); rope_table_phase(wv, p); }
        if (kind == K_PRO || (kind == K_ROW2 && l + 1 < NLAYER)) { const int ln = (kind == K_PRO) ? 0 : l + 1;
#pragma unroll 1
            for (int rp = 0; rp < REP_CVT; ++rp) { filter_phase(wv, p, ln, lds); convert_layer(wv, p, ln, lds); } }
        if (p.ws == nullptr) grid.sync();
        xcd_barrier(wv, bar, bst);
    }
}

extern "C" void kernel_launch(void* const* d_in, const int* in_sizes, int n_in, void* d_out, int out_size, void* d_ws, size_t ws_size, hipStream_t stream) {
    static int grid_blocks = 0;
    if (grid_blocks == 0) {
        if (n_in != N_INPUTS || ws_size < WS_NEED) { fprintf(stderr, "kernel_launch: need %d inputs and %zu bytes of workspace; got %d, %zu\n", N_INPUTS, (size_t)WS_NEED, n_in, ws_size); grid_blocks = -1; return; }
        int dev = 0, cus = 0, per_cu = 0;
        hipGetDevice(&dev);
        hipDeviceGetAttribute(&cus, hipDeviceAttributeMultiprocessorCount, dev);
        if (hipFuncSetAttribute((const void*)fwd_megakernel, hipFuncAttributeMaxDynamicSharedMemorySize, LDS_BYTES) != hipSuccess) { fprintf(stderr, "kernel_launch: hipFuncSetAttribute failed\n"); grid_blocks = -1; return; }
        if (hipOccupancyMaxActiveBlocksPerMultiprocessor(&per_cu, (const void*)fwd_megakernel, NTHREADS, LDS_BYTES) != hipSuccess || per_cu < 1) { fprintf(stderr, "kernel_launch: occupancy query gave %d\n", per_cu); per_cu = 1; }
        (void)hipGetLastError();
        grid_blocks = cus * 1;
    }
    if (grid_blocks < 0) return;
        (void)hipMemsetAsync((unsigned char*)d_ws + S_BAR, 0, 16384, stream);
    (void)hipMemsetAsync((unsigned char*)d_ws + S_TAIL, 0, 512, stream);
    Params p{};
    for (int i = 0; i < N_INPUTS; ++i) p.in[i] = (const float*)d_in[i];
    p.out = (float*)d_out; p.ws = (unsigned char*)d_ws;
    void* args[] = {&p};
    hipError_t e = hipLaunchCooperativeKernel((const void*)fwd_megakernel, dim3(grid_blocks), dim3(NTHREADS), args, LDS_BYTES, stream);
    if (e != hipSuccess) fprintf(stderr, "cooperative launch failed: %s (grid %d)\n", hipGetErrorString(e), grid_blocks);
}
```

```cpp
#include <hip/hip_runtime.h>
#include <hip/hip_cooperative_groups.h>
#include <cstdio>
namespace cg = cooperative_groups;

#define LAS __attribute__((address_space(3)))
typedef unsigned short bf16_t;
typedef short bf16x8 __attribute__((ext_vector_type(8)));
typedef float f32x4 __attribute__((ext_vector_type(4)));
typedef float f32x16 __attribute__((ext_vector_type(16)));
typedef unsigned u32x4 __attribute__((ext_vector_type(4)));
typedef unsigned u32x2 __attribute__((ext_vector_type(2)));
typedef float f32x2 __attribute__((ext_vector_type(2)));

constexpr int DM = 2048, MP = 4096, MS = 16384, MT = 20480, NLAYER = 2;
constexpr int LP = 256, LS = 2048, BP = 16, BS = 8, PAST = 512, LKS = 2560;
constexpr int NIN = 13120, NGATE0 = 6976, PA_LD = 7168, GATE_LD = 6144;
constexpr int DFF = 5632, UU_LD = 11264;
constexpr int KROWS = 24576;
constexpr int NTHREADS = 512;
constexpr int LDS_BYTES = 131072 + 16;

enum { I_XP = 0, I_XS, I_C, I_CCKV, I_CKPE, I_CCTX, I_ADAW, I_ADAB, I_NMPRE, I_NMPOST, I_NFPRE, I_NFPOST, I_WIN, I_HCW, I_HCB,
       I_FW1, I_FB1, I_FW2, I_FB2, I_FW3, I_FB3, I_FFREQ, I_HBIAS, I_QN, I_KVN, I_WUQ, I_WUKV, I_SCW, I_WBRA, I_WBRB, I_WBRC,
       I_WO, I_FUP, I_FCW, I_FCB, I_FDN, N_INPUTS };

constexpr size_t E_WIN = (size_t)13312 * 2048, E_WUQ = (size_t)1536 * 512, E_WUKV = (size_t)2048 * 256, E_WBR = (size_t)2048 * 1024,
                 E_WO = (size_t)2048 * 2048, E_WUP = (size_t)11264 * 2048, E_WDN = (size_t)2048 * 5632;
constexpr size_t W_IN = 0, W_UQ = W_IN + E_WIN * 2, W_UKV = W_UQ + E_WUQ * 2, W_BRA = W_UKV + E_WUKV * 2, W_BRB = W_BRA + E_WBR * 2,
                 W_BRC = W_BRB + E_WBR * 2, W_O = W_BRC + E_WBR * 2, W_UP = W_O + E_WO * 2, W_DN = W_UP + E_WUP * 2, W_END = W_DN + E_WDN * 2;
constexpr size_t S_MOD = W_END, SZ_MOD = (size_t)NLAYER * 16 * 9 * 12288 * 4;
constexpr size_t S_KTS = S_MOD + SZ_MOD, S_KTP = S_KTS + (size_t)1024 * 4096 * 4, S_PARTS = S_KTP + (size_t)1024 * 512 * 4,
                 S_PARTP = S_PARTS + (size_t)64 * 2048 * 4, S_ROPE = S_PARTP + (size_t)8 * 2048 * 4, S_BAR = S_ROPE + (size_t)2 * 2048 * 32 * 4, S_COMB = S_BAR + 16384, S_SCALE = S_COMB + (size_t)NLAYER * 3 * 9 * 3 * 2048 * 4, S_TAIL = S_SCALE + 8192, S_END = S_TAIL + 512;
constexpr size_t AR = S_END;
constexpr size_t SZ_H = (size_t)MT * 2048 * 2;
constexpr size_t A_H = AR, A_UU = AR + SZ_H, A_ACT = A_UU + (size_t)MT * UU_LD * 2, AR_END = A_ACT + (size_t)MT * DFF * 2;
constexpr size_t A_PROJA = A_UU;
constexpr size_t A_Q = A_UU, A_KN = A_Q + (size_t)MT * 1536 * 2, A_VT = A_KN + (size_t)KROWS * 1024 * 2, A_YCT = A_VT + (size_t)KROWS * 1024 * 2;
constexpr size_t A_GATES = A_UU, A_M32 = A_GATES + (size_t)MT * GATE_LD * 2, A_MBF = A_H, A_F32 = A_UU;
constexpr size_t A_S = A_M32 + (size_t)MT * 2048 * 4;
constexpr size_t A_ZZT = A_S, A_X0S = A_ZZT + (size_t)MT * 1024 * 2, A_CQN = A_X0S + (size_t)MT * 1024 * 2, A_KEYSC = A_CQN + (size_t)MT * 512 * 2,
                 A_KPER = A_KEYSC + (size_t)KROWS * 256 * 2, A_YA = A_KPER + (size_t)KROWS * 64 * 2, A_OATT = A_YA + (size_t)MT * 1024 * 2,
                 A_YC = A_OATT + (size_t)MT * 1024 * 2, A_SEND = A_YC + (size_t)MT * 1024 * 2;
constexpr size_t A_RAW = A_M32;
static_assert(A_RAW + (size_t)3 * MT * 2048 * 2 <= A_CQN, "raw branch buffer overlaps live data");
static_assert(A_SEND <= AR_END, "arena overflow");
static_assert(A_YCT + (size_t)MT * 1024 * 2 <= A_M32, "arena overlap");
constexpr size_t WS_NEED = AR_END;
static_assert(WS_NEED <= 967590400ull, "workspace too large");

struct Params {
    const float* in[N_INPUTS];
    float* out;
    unsigned char* ws;
};

__device__ __forceinline__ unsigned cvt_pk_bf16(float lo, float hi) { unsigned r; asm volatile("v_cvt_pk_bf16_f32 %0, %1, %2" : "=v"(r) : "v"(lo), "v"(hi)); return r; }
__device__ __forceinline__ bf16_t f2bf(float f) { return (bf16_t)(cvt_pk_bf16(f, 0.f) & 0xffffu); }
__device__ __forceinline__ float bf_lo(unsigned w) { return __uint_as_float(w << 16); }
__device__ __forceinline__ float bf_hi(unsigned w) { return __uint_as_float(w & 0xffff0000u); }
__device__ __forceinline__ void unpack8(const u32x4 v, float* f) { f[0] = bf_lo(v.x); f[1] = bf_hi(v.x); f[2] = bf_lo(v.y); f[3] = bf_hi(v.y); f[4] = bf_lo(v.z); f[5] = bf_hi(v.z); f[6] = bf_lo(v.w); f[7] = bf_hi(v.w); }
__device__ __forceinline__ u32x4 pack8(const float* f) { u32x4 r; r.x = cvt_pk_bf16(f[0], f[1]); r.y = cvt_pk_bf16(f[2], f[3]); r.z = cvt_pk_bf16(f[4], f[5]); r.w = cvt_pk_bf16(f[6], f[7]); return r; }
__device__ __forceinline__ float shx(float v, int mask, int lane) { return __int_as_float(__builtin_amdgcn_ds_bpermute((lane ^ mask) << 2, __float_as_int(v))); }
__device__ __forceinline__ float wave_sum(float v, int lane) {
#pragma unroll
    for (int o = 32; o >= 1; o >>= 1) v += shx(v, o, lane);
    return v;
}
__device__ __forceinline__ int otid(int wv) { int t; asm volatile("v_mbcnt_lo_u32_b32 %0, -1, 0\n\tv_mbcnt_hi_u32_b32 %0, -1, %0" : "=v"(t)); return wv * 64 + t; }
__device__ __forceinline__ int obid() { int t = blockIdx.x; asm volatile("" : "+s"(t)); return t; }
__device__ __forceinline__ float sigmoidf_(float x) { return __builtin_amdgcn_rcpf(1.0f + __builtin_amdgcn_exp2f(-1.4426950408889634f * x)); }
__device__ __forceinline__ float siluf_(float x) { return x * sigmoidf_(x); }

namespace pg8 {
constexpr int BM = 256, BK = 64, HALF = 128, HTB = HALF * BK * 2, STAGE_BYTES = 8 * HTB, NXCD = 8, WGM = 8;
__host__ __device__ __forceinline__ int lds_byte(int r, int c) { const int st = (r >> 4) * 2 + (c >> 5), rr = r & 15, cc = c & 31, ob = rr * 64 + cc * 2; return st * 1024 + (ob ^ (((ob >> 9) & 1) << 5)); }
__host__ __device__ __forceinline__ void stage_rc(int b, int& R, int& C) { const int st = b / 1024, sb = b % 1024, swz = sb ^ (((sb >> 9) & 1) << 5); R = (st >> 1) * 16 + swz / 64; C = (st & 1) * 32 + (swz % 64) / 2; }
__host__ __device__ __forceinline__ int perm32(int rho) { const int n = rho >> 4, i = rho & 15; return 8 * (i >> 2) + 4 * n + (i & 3); }
struct Unit { int pm, pn, kh; };
struct Gemm { const bf16_t* A; const bf16_t* Bt; int M, N, K; int nMper; size_t bstride; };
struct StaticOrder {
    int nM, nN, nwg, G, c, nfull;
    __device__ void init(int M, int N, int G_, int c_, bool split = false) { nM = M / BM; nN = N / BM; nwg = nM * nN; G = G_; c = c_;
        nfull = nwg; if (split) { const int rem = nwg % G; if (rem > 0 && 2 * rem <= G) nfull = nwg - rem; } }
    __device__ void tile_of(int wgid, Unit& u) const {
        { const int q = nwg / NXCD, r = nwg % NXCD, xcd = wgid % NXCD, off = wgid / NXCD; wgid = (xcd < r ? xcd * (q + 1) : r * (q + 1) + (xcd - r) * q) + off; }
        const int nig = WGM * nN, gid = wgid / nig, fm = gid * WGM, gsz = (nM - fm) < WGM ? (nM - fm) : WGM;
        u.pm = fm + ((wgid % nig) % gsz); u.pn = (wgid % nig) / gsz;
    }
    __device__ bool next(int i, Unit& u) const {
        const long L = (long)i * G + c;
        int tile = (int)L, kh = -1; bool ok = L < nwg;
        if (L >= nfull) { const long h = L - nfull; ok = h < 2 * (long)(nwg - nfull); tile = nfull + (int)(h >> 1); kh = (int)(h & 1); }
        if (!ok) return false;
        int pm, pn;
        { int wgid = tile; const int q = nwg / NXCD, r = nwg % NXCD, xcd = wgid % NXCD, off = wgid / NXCD; wgid = (xcd < r ? xcd * (q + 1) : r * (q + 1) + (xcd - r) * q) + off;
          const int nig = WGM * nN, gid = wgid / nig, fm = gid * WGM, gsz = (nM - fm) < WGM ? (nM - fm) : WGM;
          pm = fm + ((wgid % nig) % gsz); pn = (wgid % nig) / gsz; }
        u.pm = pm; u.pn = pn; u.kh = kh; return true;
    }
};
template <class Epi>
__device__ __forceinline__ void gemm_phase(int wv, LAS unsigned char* lds, const Gemm g, const StaticOrder& S, const Epi& E) {
    const int tid = otid(wv), wid = __builtin_amdgcn_readfirstlane(tid >> 6), lane = tid & 63, wr = wid >> 2, wc = wid & 3, fr = lane & 15, fq = lane >> 4;
    const int K = g.K, nt = K / BK;
    unsigned voffA[2], voffB[2];
#pragma unroll
    for (int i = 0; i < 2; ++i) { int R, C; stage_rc(tid * 16 + i * 8192, R, C); const int Rb = (R & ~31) + perm32(R & 31); voffA[i] = (unsigned)(R * K + C) * 2u; voffB[i] = (unsigned)(Rb * K + C) * 2u; }
    const size_t kstep = (size_t)(BK * 2);
    const size_t hstep = (size_t)HALF * K * 2;
    const size_t tstep = 2 * hstep;
    const unsigned ldsw = (unsigned)wid * 1024u;
    const int aoff = lds_byte(wr * 64 + fr, fq * 8), boff = lds_byte(wc * 32 + fr, fq * 8);
#define PG8_SA(b, h) (((b) * 2 + (h)) * HTB)
#define PG8_SB(b, h) ((4 + (b) * 2 + (h)) * HTB)
#define PG8_STAGE(bufoff, gbase, voff) do { _Pragma("unroll") for (int _i = 0; _i < 2; ++_i) \
        __builtin_amdgcn_global_load_lds((const unsigned*)((const char*)(gbase) + (voff)[_i]), (LAS unsigned*)(lds + (bufoff) + ldsw + _i * 8192), 16, 0, 0); } while (0)
#define PG8_LDA(dst, b, h) do { _Pragma("unroll") for (int m = 0; m < 4; ++m) _Pragma("unroll") for (int k = 0; k < 2; ++k) dst[m][k] = *(const LAS bf16x8*)(lds + PG8_SA(b, h) + aoff + m * 2048 + k * 1024); } while (0)
#define PG8_LDB(dst, b, h) do { _Pragma("unroll") for (int n = 0; n < 2; ++n) _Pragma("unroll") for (int k = 0; k < 2; ++k) dst[n][k] = *(const LAS bf16x8*)(lds + PG8_SB(b, h) + boff + n * 2048 + k * 1024); } while (0)
#define PG8_MMA(ai, bj, At, Bt) do { __builtin_amdgcn_s_setprio(1); _Pragma("unroll") for (int m = 0; m < 4; ++m) _Pragma("unroll") for (int n = 0; n < 2; ++n) _Pragma("unroll") for (int k = 0; k < 2; ++k) \
        acc[ai][bj][m][n] = __builtin_amdgcn_mfma_f32_16x16x32_bf16(Bt[n][k], At[m][k], acc[ai][bj][m][n], 0, 0, 0); __builtin_amdgcn_s_setprio(0); } while (0)
#define PG8_WAIT_V(n) asm volatile("s_waitcnt vmcnt(" #n ")" ::: "memory")
#define PG8_WAIT_L(n) asm volatile("s_waitcnt lgkmcnt(" #n ")" ::: "memory")
#define PG8_BAR __builtin_amdgcn_s_barrier()
#define PG8_SCHED __builtin_amdgcn_sched_barrier(0)
    Unit cur, nxt; int ui = 0;
    if (!S.next(0, cur)) return;
    f32x4 acc[2][2][4][2];
#pragma unroll
    for (int a = 0; a < 2; ++a)
#pragma unroll
        for (int b = 0; b < 2; ++b)
#pragma unroll
            for (int m = 0; m < 4; ++m)
#pragma unroll
                for (int n = 0; n < 2; ++n) acc[a][b][m][n] = (f32x4){0.f, 0.f, 0.f, 0.f};
    bf16x8 At[4][2], B0[2][2], B1[2][2];
    const size_t khoff = (size_t)(nt / 2) * kstep;
    const char* cA = (const char*)g.A + (size_t)cur.pm * tstep + (cur.kh == 1 ? khoff : 0); const char* cB = (const char*)g.Bt + (size_t)(cur.pm / g.nMper) * g.bstride + (size_t)cur.pn * tstep + (cur.kh == 1 ? khoff : 0);
    PG8_STAGE(PG8_SB(0, 0), cB, voffB); PG8_STAGE(PG8_SA(0, 0), cA, voffA); PG8_STAGE(PG8_SB(0, 1), cB + hstep, voffB); PG8_STAGE(PG8_SA(0, 1), cA + hstep, voffA);
    if (wr == 1) PG8_BAR;
    PG8_WAIT_V(4); PG8_BAR;
    PG8_STAGE(PG8_SB(1, 0), cB + kstep, voffB); PG8_STAGE(PG8_SA(1, 0), cA + kstep, voffA); PG8_STAGE(PG8_SB(1, 1), cB + hstep + kstep, voffB);
    PG8_WAIT_V(6); PG8_BAR;
    for (;;) {
        const bool has_next = S.next(ui + 1, nxt);
        const char* nA = has_next ? (const char*)g.A + (size_t)nxt.pm * tstep + (nxt.kh == 1 ? khoff : 0) : cA; const char* nB = has_next ? (const char*)g.Bt + (size_t)(nxt.pm / g.nMper) * g.bstride + (size_t)nxt.pn * tstep + (nxt.kh == 1 ? khoff : 0) : cB;
        const int ntu = (cur.kh < 0) ? nt : (nt >> 1);
        for (int t = 0; t < ntu; t += 2) {
            const bool last = (t == ntu - 2);
            const char* a1 = cA + (size_t)(t + 1) * kstep;
            const char* a2 = last ? nA : cA + (size_t)(t + 2) * kstep; const char* b2 = last ? nB : cB + (size_t)(t + 2) * kstep;
            const char* a3 = a2 + kstep; const char* b3 = b2 + kstep;
            PG8_LDB(B0, 0, 0); PG8_SCHED; PG8_LDA(At, 0, 0); PG8_STAGE(PG8_SA(1, 1), a1 + hstep, voffA);
            PG8_WAIT_L(8); PG8_BAR; PG8_WAIT_L(0); PG8_MMA(0, 0, At, B0); PG8_BAR; PG8_SCHED;
            PG8_LDB(B1, 0, 1); PG8_STAGE(PG8_SB(0, 0), b2, voffB);
            PG8_BAR; PG8_WAIT_L(0); PG8_MMA(0, 1, At, B1); PG8_BAR;
            PG8_LDA(At, 0, 1); PG8_STAGE(PG8_SA(0, 0), a2, voffA);
            PG8_BAR; PG8_WAIT_L(0); PG8_MMA(1, 0, At, B0); PG8_BAR; PG8_SCHED;
            PG8_STAGE(PG8_SB(0, 1), b2 + hstep, voffB);
            PG8_WAIT_V(6); PG8_BAR; PG8_MMA(1, 1, At, B1); PG8_BAR;
            PG8_LDB(B0, 1, 0); PG8_SCHED; PG8_LDA(At, 1, 0); PG8_STAGE(PG8_SA(0, 1), a2 + hstep, voffA);
            PG8_WAIT_L(8); PG8_BAR; PG8_WAIT_L(0); PG8_MMA(0, 0, At, B0); PG8_BAR; PG8_SCHED;
            PG8_LDB(B1, 1, 1); PG8_STAGE(PG8_SB(1, 0), b3, voffB);
            PG8_BAR; PG8_WAIT_L(0); PG8_MMA(0, 1, At, B1); PG8_BAR;
            PG8_LDA(At, 1, 1); PG8_STAGE(PG8_SA(1, 0), a3, voffA);
            PG8_BAR; PG8_WAIT_L(0); PG8_MMA(1, 0, At, B0); PG8_BAR; PG8_SCHED;
            PG8_STAGE(PG8_SB(1, 1), b3 + hstep, voffB);
            PG8_WAIT_V(6); PG8_BAR; PG8_MMA(1, 1, At, B1); PG8_BAR;
        }
        { const int t2 = otid(wv); const int l2 = t2 & 63, w2 = __builtin_amdgcn_readfirstlane(t2 >> 6); E(acc, cur, w2 >> 2, w2 & 3, l2 & 15, l2 >> 4); }
        if (!has_next) break;
#pragma unroll
        for (int a = 0; a < 2; ++a)
#pragma unroll
            for (int b = 0; b < 2; ++b)
#pragma unroll
                for (int m = 0; m < 4; ++m)
#pragma unroll
                    for (int n = 0; n < 2; ++n) acc[a][b][m][n] = (f32x4){0.f, 0.f, 0.f, 0.f};
        cur = nxt; cA = nA; cB = nB; ++ui;
    }
    PG8_WAIT_V(0);
    if (wr == 0) PG8_BAR;
    PG8_BAR;
#undef PG8_SA
#undef PG8_SB
#undef PG8_STAGE
#undef PG8_LDA
#undef PG8_LDB
#undef PG8_MMA
#undef PG8_WAIT_V
#undef PG8_WAIT_L
#undef PG8_BAR
#undef PG8_SCHED
}

struct EpiBf16 {
    bf16_t* O; int ldc; bf16_t* O2;
    __device__ __forceinline__ void operator()(const f32x4 (&acc)[2][2][4][2], const Unit& u, int wr, int wc, int fr, int fq) const {
        const int row0 = u.pm * BM + wr * 64 + fr, col0 = u.pn * BM + wc * 32 + 8 * fq;
        bf16_t* Ob = (u.kh == 1) ? O2 : O;
#pragma unroll
        for (int ai = 0; ai < 2; ++ai)
#pragma unroll
            for (int m = 0; m < 4; ++m) { bf16_t* rowp = Ob + (size_t)(row0 + ai * HALF + m * 16) * ldc + col0;
#pragma unroll
                for (int bj = 0; bj < 2; ++bj) { const f32x4 v0 = acc[ai][bj][m][0], v1 = acc[ai][bj][m][1];
                    u32x4 w; w.x = cvt_pk_bf16(v0[0], v0[1]); w.y = cvt_pk_bf16(v0[2], v0[3]); w.z = cvt_pk_bf16(v1[0], v1[1]); w.w = cvt_pk_bf16(v1[2], v1[3]);
                    *(u32x4*)(rowp + bj * HALF) = w; } }
    }
};
struct EpiF32 {
    float* C; int ldc;
    __device__ __forceinline__ void operator()(const f32x4 (&acc)[2][2][4][2], const Unit& u, int wr, int wc, int fr, int fq) const {
        const int row0 = u.pm * BM + wr * 64 + fr, col0 = u.pn * BM + wc * 32 + 4 * fq;
#pragma unroll
        for (int ai = 0; ai < 2; ++ai)
#pragma unroll
            for (int m = 0; m < 4; ++m) { float* rowp = C + (size_t)(row0 + ai * HALF + m * 16) * ldc + col0;
#pragma unroll
                for (int bj = 0; bj < 2; ++bj)
#pragma unroll
                    for (int n = 0; n < 2; ++n) *(f32x4*)(rowp + bj * HALF + n * 16) = acc[ai][bj][m][n]; }
    }
};
struct EpiVT {
    bf16_t* VTs; bf16_t* VTp;
    __device__ __forceinline__ void operator()(const f32x4 (&acc)[2][2][4][2], const Unit& u, int wr, int wc, int fr, int fq) const {
        const int KR0 = u.pn * BM;
        bf16_t* vt; int Lk;
        if (KR0 < BS * LKS) { const int b = KR0 / LKS; Lk = LKS; vt = VTs + (size_t)b * 1024 * LKS + (KR0 - b * LKS); }
        else { const int b = (KR0 - BS * LKS) >> 8; Lk = LP; vt = VTp + (size_t)b * 1024 * LP; }
        const int row0 = u.pm * BM + wr * 64 + fr, col0 = wc * 32 + 8 * fq;
#pragma unroll
        for (int ai = 0; ai < 2; ++ai)
#pragma unroll
            for (int m = 0; m < 4; ++m) { bf16_t* rowp = vt + (size_t)(row0 + ai * HALF + m * 16) * Lk + col0;
#pragma unroll
                for (int bj = 0; bj < 2; ++bj) { const f32x4 v0 = acc[ai][bj][m][0], v1 = acc[ai][bj][m][1];
                    u32x4 w; w.x = cvt_pk_bf16(v0[0], v0[1]); w.y = cvt_pk_bf16(v0[2], v0[3]); w.z = cvt_pk_bf16(v1[0], v1[1]); w.w = cvt_pk_bf16(v1[2], v1[3]);
                    *(u32x4*)(rowp + bj * HALF) = w; } }
    }
};
template <int P> struct EpiGate {
    const bf16_t* gates; float* m32; bf16_t* mbf;
    __device__ __forceinline__ void operator()(const f32x4 (&acc)[2][2][4][2], const Unit& u, int wr, int wc, int fr, int fq) const {
        const int row0 = u.pm * BM + wr * 64 + fr, col0 = u.pn * BM + wc * 32 + 4 * fq;
#pragma unroll
        for (int ai = 0; ai < 2; ++ai)
#pragma unroll
            for (int m = 0; m < 4; ++m) {
                const size_t row = (size_t)(row0 + ai * HALF + m * 16);
#pragma unroll
                for (int bj = 0; bj < 2; ++bj)
#pragma unroll
                    for (int n = 0; n < 2; ++n) {
                        const int col = col0 + bj * HALF + n * 16;
                        const u32x2 gw = *(const u32x2*)(gates + row * GATE_LD + P * 2048 + col);
                        f32x4 v = acc[ai][bj][m][n];
                        v[0] *= sigmoidf_(bf_lo(gw.x)); v[1] *= sigmoidf_(bf_hi(gw.x)); v[2] *= sigmoidf_(bf_lo(gw.y)); v[3] *= sigmoidf_(bf_hi(gw.y));
                        float* mp = m32 + row * 2048 + col;
                        if (P == 0) { *(f32x4*)mp = v; }
                        else if (P == 1) { const f32x4 o = *(const f32x4*)mp; *(f32x4*)mp = o + v; }
                        else { const f32x4 o = *(const f32x4*)mp; v = v + o; u32x2 w; w.x = cvt_pk_bf16(v[0], v[1]); w.y = cvt_pk_bf16(v[2], v[3]); *(u32x2*)(mbf + row * 2048 + col) = w; }
                    }
            }
    }
};
}

template <class Epi>
__device__ __forceinline__ void run_gemm(int wv, LAS unsigned char* lds, const bf16_t* A, const bf16_t* Bt, int M, int N, int K, const Epi& E, bool split = false, int nMper = 1 << 28, size_t bstride = 0, bool rev = false) {
    pg8::Gemm g; g.A = A; g.Bt = Bt; g.M = M; g.N = N; g.K = K; g.nMper = nMper; g.bstride = bstride;
    pg8::StaticOrder S; S.init(M, N, (int)gridDim.x, rev ? (int)gridDim.x - 1 - obid() : obid(), split);
    pg8::gemm_phase<Epi>(wv, lds, g, S, E);
    __syncthreads();
}

__device__ __forceinline__ void convT(int wv, const float* __restrict__ src, int K, int N, bf16_t* __restrict__ dst, int gate_shift, LAS unsigned char* lds) {
    const int tid = otid(wv), lane = tid & 63, kq = lane & 7, ng = lane >> 3;
    const int tn = N / 32, tk = K / 64, ntile = tn * tk, nwaves = gridDim.x * 8;
    for (int tile = obid() * 8 + (tid >> 6); tile < ntile; tile += 2 * nwaves) {
        const int tile2 = tile + nwaves; const bool has2 = tile2 < ntile;
        const int tkk = tile / tn, tnn = tile - tkk * tn, k0 = tkk * 64 + 8 * kq, n0 = tnn * 32 + 4 * ng;
        const int tkk2 = has2 ? tile2 / tn : tkk, tnn2 = has2 ? tile2 - tkk2 * tn : tnn, k02 = tkk2 * 64 + 8 * kq, n02 = tnn2 * 32 + 4 * ng;
        f32x4 v[8], v2[8];
#pragma unroll
        for (int i = 0; i < 8; ++i) v[i] = *(const f32x4*)(src + (size_t)(k0 + i) * N + n0);
#pragma unroll
        for (int i = 0; i < 8; ++i) v2[i] = *(const f32x4*)(src + (size_t)(k02 + i) * N + n02);
#pragma unroll
        for (int j = 0; j < 4; ++j) {
            int nd = n0 + j; if (gate_shift == 1 && nd >= NGATE0) nd += 192; if (gate_shift == 2) { const int hd = nd >> 8, wi = nd & 255; nd = (wi < 128) ? hd * 128 + wi : 1024 + hd * 128 + (wi - 128); }
            u32x4 w; w.x = cvt_pk_bf16(v[0][j], v[1][j]); w.y = cvt_pk_bf16(v[2][j], v[3][j]); w.z = cvt_pk_bf16(v[4][j], v[5][j]); w.w = cvt_pk_bf16(v[6][j], v[7][j]);
            *(u32x4*)(dst + (size_t)nd * K + k0) = w;
        }
        if (has2) {
#pragma unroll
            for (int j = 0; j < 4; ++j) {
                int nd = n02 + j; if (gate_shift == 1 && nd >= NGATE0) nd += 192; if (gate_shift == 2) { const int hd = nd >> 8, wi = nd & 255; nd = (wi < 128) ? hd * 128 + wi : 1024 + hd * 128 + (wi - 128); }
                u32x4 w; w.x = cvt_pk_bf16(v2[0][j], v2[1][j]); w.y = cvt_pk_bf16(v2[2][j], v2[3][j]); w.z = cvt_pk_bf16(v2[4][j], v2[5][j]); w.w = cvt_pk_bf16(v2[6][j], v2[7][j]);
                *(u32x4*)(dst + (size_t)nd * K + k02) = w;
            }
        }
    }
}

__device__ __forceinline__ void ada_phase(int wv, const Params& p, LAS unsigned char* lds) {
    LAS float* sl = (LAS float*)lds;
    float* mod = (float*)(p.ws + S_MOD);
    const int tid = otid(wv);
    for (int u = obid(); u < NLAYER * 6 * 16; u += gridDim.x) {
        const int l = u / 96, r = u % 96, cb = r % 6, kc = r / 6, k0 = kc * 128;
        for (int i = tid; i < 9 * 128; i += NTHREADS) { const int v = i >> 7, k = i & 127; const float x = (v == 0) ? p.in[I_CCTX][k0 + k] : p.in[I_C][(v - 1) * DM + k0 + k]; sl[i] = siluf_(x); }
        __syncthreads();
        const int col = cb * 2048 + tid * 4;
        f32x4 acc[9];
#pragma unroll
        for (int i = 0; i < 9; ++i) acc[i] = (f32x4){0.f, 0.f, 0.f, 0.f};
        const float* wp = p.in[I_ADAW] + ((size_t)l * DM + k0) * 12288 + col;
#pragma unroll 8
        for (int k = 0; k < 128; ++k) {
            const f32x4 w = *(const f32x4*)(wp + (size_t)k * 12288);
#pragma unroll
            for (int i = 0; i < 9; ++i) acc[i] += sl[i * 128 + k] * w;
        }
#pragma unroll
        for (int i = 0; i < 9; ++i) *(f32x4*)(mod + ((size_t)(l * 16 + kc) * 9 + i) * 12288 + col) = acc[i];
        __syncthreads();
    }
}

__device__ __forceinline__ void filter_phase(int wv, const Params& p, int l, LAS unsigned char* lds) {
    LAS float* z = (LAS float*)lds;
    LAS float* H1 = z + 32 * 33;
    LAS float* H2 = H1 + 32 * 64;
    LAS float* W1 = H2 + 32 * 64;
    LAS float* W2 = W1 + 33 * 64;
    LAS float* BF = W2 + 64 * 64;
    const int tid = otid(wv);
    const float* w3 = p.in[I_FW3] + (size_t)l * 64 * 2048; const float* b3 = p.in[I_FB3] + l * 2048;
    for (int u = obid(); u < 72; u += gridDim.x) {
        const int g = (u < 64) ? 1 : 0; const int tc = g ? u : u - 64; const int L = g ? LS : LP; const int t0 = tc * 32;
        float* kT = (float*)(p.ws + (g ? S_KTS : S_KTP)); float* part = (float*)(p.ws + (g ? S_PARTS : S_PARTP));
        for (int i = tid; i < 33 * 64; i += NTHREADS) W1[i] = p.in[I_FW1][(size_t)l * 33 * 64 + i];
        for (int i = tid; i < 64 * 64; i += NTHREADS) W2[i] = p.in[I_FW2][(size_t)l * 64 * 64 + i];
        if (tid < 64) BF[tid] = p.in[I_FB1][l * 64 + tid]; else if (tid < 128) BF[tid] = p.in[I_FB2][l * 64 + tid - 64]; else if (tid < 256) BF[tid] = p.in[I_FFREQ][l * 128 + tid - 128];
        for (int i = tid; i < 32 * 33; i += NTHREADS) {
            const int t = i / 33, e = i - t * 33; const float tf = (float)(t0 + t);
            float v;
            if (e == 0) v = tf / (float)(L - 1);
            else { const int k = (e - 1) & 15; const float band = 1e-4f + (float)k * ((15.0f - 1e-4f) / 15.0f); const float w = (6.283185307179586f * tf) / (float)L; const float ang = w * band;
                   v = (e <= 16) ? cosf(ang) : -sinf(ang); }
            z[i] = v;
        }
        __syncthreads();
#pragma unroll
        for (int q = 0; q < 4; ++q) { const int i = tid + q * NTHREADS; const int t = i >> 6, j = i & 63; float s = BF[j];
#pragma unroll
            for (int e = 0; e < 33; ++e) s += z[t * 33 + e] * W1[e * 64 + j];
            H1[i] = sinf(BF[128 + j] * s); }
        __syncthreads();
#pragma unroll
        for (int q = 0; q < 4; ++q) { const int i = tid + q * NTHREADS; const int t = i >> 6, j = i & 63; float s = BF[64 + j];
#pragma unroll 16
            for (int e = 0; e < 64; ++e) s += H1[t * 64 + e] * W2[e * 64 + j];
            H2[i] = sinf(BF[192 + j] * s); }
        __syncthreads();
        const int c = tid * 4;
        const f32x4 bias = *(const f32x4*)(b3 + c);
        f32x4 delta;
#pragma unroll
        for (int j = 0; j < 4; ++j) { const int d = (c + j) & 1023; const float mn = -3.0701134573253945f, mx = -15.350567286626973f; delta[j] = fabsf(mn + (float)d * ((mx - mn) / 1023.0f)); }
        f32x4 psum = (f32x4){0.f, 0.f, 0.f, 0.f};
        for (int tb = 0; tb < 2; ++tb) {
            f32x4 acc[16];
#pragma unroll
            for (int i = 0; i < 16; ++i) acc[i] = bias;
#pragma unroll 8
            for (int k = 0; k < 64; ++k) {
                const f32x4 w = *(const f32x4*)(w3 + (size_t)k * 2048 + c);
#pragma unroll
                for (int i = 0; i < 16; ++i) acc[i] += H2[(tb * 16 + i) * 64 + k] * w;
            }
#pragma unroll
            for (int i = 0; i < 16; ++i) {
                const int t = t0 + tb * 16 + i; const float tn = (float)t / (float)(L - 1);
#pragma unroll
                for (int j = 0; j < 4; ++j) {
                    const float v = acc[i][j] * __expf(-tn * delta[j]);
                    const int cc = c + j;
                    if (cc < 1024) { kT[(size_t)cc * (2 * L) + t] = v; psum[j] += fabsf(v); }
                    else { const int d = cc - 1024; if (t == 0) kT[(size_t)d * (2 * L) + L] = 0.f; else { kT[(size_t)d * (2 * L) + 2 * L - t] = v; psum[j] += fabsf(v); } }
                }
            }
        }
        *(f32x4*)(part + (size_t)tc * 2048 + c) = psum;
        __syncthreads();
    }
}

__device__ __forceinline__ void row_sel(const Params& p, int l, int mode, int& l2, int& shi, int& sci, const float*& prew, bool& wh, int& gi, const float*& pw) {
    wh = true;
    if (mode == 0) { l2 = l; shi = 0; sci = 1; prew = p.in[I_NMPRE] + l * DM; }
    else if (mode == 1) { l2 = l; shi = 3; sci = 4; prew = p.in[I_NFPRE] + l * DM; }
    else { l2 = l + 1; shi = 0; sci = 1; wh = (l + 1 < NLAYER); if (!wh) l2 = l; prew = p.in[I_NMPRE] + l2 * DM; }
    gi = (mode == 1) ? 2 : 5;
    pw = p.in[mode == 1 ? I_NMPOST : I_NFPOST] + l * DM;
}
__device__ __forceinline__ void comb_phase(int wv, const Params& p) {
    const int tid = otid(wv);
    const float* mod = (const float*)(p.ws + S_MOD); float* comb = (float*)(p.ws + S_COMB);
    for (int idx = obid() * NTHREADS + tid; idx < NLAYER * 3 * 9 * 2048; idx += gridDim.x * NTHREADS) {
        const int c = idx & 2047, q = idx >> 11, mi = q % 9, q2 = q / 9, mode = q2 % 3, l = q2 / 3;
        int l2, shi, sci, gi; const float* prew; const float* pw; bool wh;
        row_sel(p, l, mode, l2, shi, sci, prew, wh, gi, pw);
        float g = 0.f, sc = 0.f, sh = 0.f;
        for (int kc = 0; kc < 16; ++kc) {
            g += mod[((size_t)(l * 16 + kc) * 9 + mi) * 12288 + gi * 2048 + c];
            sc += mod[((size_t)(l2 * 16 + kc) * 9 + mi) * 12288 + sci * 2048 + c];
            sh += mod[((size_t)(l2 * 16 + kc) * 9 + mi) * 12288 + shi * 2048 + c];
        }
        g += p.in[I_ADAB][(size_t)l * 12288 + gi * 2048 + c];
        sc += p.in[I_ADAB][(size_t)l2 * 12288 + sci * 2048 + c];
        sh += p.in[I_ADAB][(size_t)l2 * 12288 + shi * 2048 + c];
        float* o = comb + (size_t)q * 3 * 2048 + c;
        o[0] = g * pw[c]; o[2048] = prew[c] * (1.0f + sc); o[4096] = sh;
    }
}
__device__ __forceinline__ void row_phase(int wv, const Params& p, int l, int mode) {
    const int tid = otid(wv); const int wave = obid() * 8 + (tid >> 6), nw = gridDim.x * 8, lane = tid & 63;
    float* X = p.out;
    bf16_t* H = (bf16_t*)(p.ws + A_H);
    const bool wh = !(mode == 2 && l + 1 >= NLAYER);
    const int rows_per = (MT + nw - 1) / nw;
    int cur_mi = -1; f32x4 cpre[8], csh[8], cgv[8];
    for (int rr = 0; rr < rows_per; ++rr) {
        const int row = wave * rows_per + rr;
        if (row >= MT) break;
        const int mi = row < MP ? 0 : 1 + ((row - MP) >> 11);
        const float* cb = (const float*)(p.ws + S_COMB) + (size_t)((l * 3 + mode) * 9 + mi) * 3 * 2048 + lane * 4;
        if (mi != cur_mi) { cur_mi = mi;
#pragma unroll
            for (int i = 0; i < 8; ++i) { cpre[i] = *(const f32x4*)(cb + 2048 + i * 256); csh[i] = *(const f32x4*)(cb + 4096 + i * 256); if (mode != 0) cgv[i] = *(const f32x4*)(cb + i * 256); } }
        f32x4 x[8];
        const float* xs = (mode == 0) ? (row < MP ? p.in[I_XP] + (size_t)row * DM : p.in[I_XS] + (size_t)(row - MP) * DM) : X + (size_t)row * DM;
#pragma unroll
        for (int i = 0; i < 8; ++i) x[i] = *(const f32x4*)(xs + i * 256 + lane * 4);
        if (mode != 0) {
            const bf16_t* o = (const bf16_t*)(p.ws + (mode == 1 ? A_M32 : A_F32)) + (size_t)row * DM;
            const unsigned tm = ((const unsigned*)(p.ws + S_TAIL))[row >> 8];
            f32x4 ovv[8]; float ss = 0.f;
#pragma unroll
            for (int i = 0; i < 8; ++i) { const u32x2 w = *(const u32x2*)(o + i * 256 + lane * 4); ovv[i] = (f32x4){bf_lo(w.x), bf_hi(w.x), bf_lo(w.y), bf_hi(w.y)};
                if ((tm >> i) & 1u) { const u32x2 w2 = *(const u32x2*)(o + (size_t)MT * DM + i * 256 + lane * 4); ovv[i] += (f32x4){bf_lo(w2.x), bf_hi(w2.x), bf_lo(w2.y), bf_hi(w2.y)}; }
                ss += ovv[i][0] * ovv[i][0] + ovv[i][1] * ovv[i][1] + ovv[i][2] * ovv[i][2] + ovv[i][3] * ovv[i][3]; }
            ss = wave_sum(ss, lane);
            const float rstd = rsqrtf(ss * (1.0f / DM) + 1e-6f);
#pragma unroll
            for (int i = 0; i < 8; ++i) x[i] += cgv[i] * (ovv[i] * rstd);
        }
#pragma unroll
        for (int i = 0; i < 8; ++i) *(f32x4*)(X + (size_t)row * DM + i * 256 + lane * 4) = x[i];
        if (wh) {
            float ss = 0.f;
#pragma unroll
            for (int i = 0; i < 8; ++i) ss += x[i][0] * x[i][0] + x[i][1] * x[i][1] + x[i][2] * x[i][2] + x[i][3] * x[i][3];
            ss = wave_sum(ss, lane);
            const float rstd = rsqrtf(ss * (1.0f / DM) + 1e-6f);
#pragma unroll
            for (int i = 0; i < 8; ++i) {
                const f32x4 hv = (x[i] * rstd) * cpre[i] + csh[i];
                u32x2 o; o.x = cvt_pk_bf16(hv[0], hv[1]); o.y = cvt_pk_bf16(hv[2], hv[3]);
                *(u32x2*)(H + (size_t)row * DM + i * 256 + lane * 4) = o;
            }
        }
    }
}

__device__ __forceinline__ void rope_table_phase(int wv, const Params& p) {
    float* C = (float*)(p.ws + S_ROPE); float* Sn = C + 2048 * 32;
    const int tid = otid(wv);
    for (int idx = obid() * NTHREADS + tid; idx < 2048 * 32; idx += gridDim.x * NTHREADS) {
        const int t = idx >> 5, i = idx & 31, k = i & 15;
        const float inv = exp2f(-(float)k * 0.8304820237218406f);
        const float pos = (i < 16) ? (float)(t >> 6) : (float)(t & 63);
        const float ang = pos * inv; C[idx] = cosf(ang); Sn[idx] = sinf(ang);
    }
}
__device__ __forceinline__ void e2_phase(int wv, const Params& p, int l, LAS unsigned char* lds) {
    const bf16_t* PA = (const bf16_t*)(p.ws + A_PROJA);
    const int tid = otid(wv), lane = tid & 63;
    {
        const int gidx = obid() * NTHREADS + tid;
        if (gidx < 2048) {
            const int g = gidx >> 10, d = gidx & 1023; const int NU = g ? 64 : 8;
            const float* part = (const float*)(p.ws + (g ? S_PARTS : S_PARTP));
            float tot = 0.f;
            for (int i = 0; i < NU; ++i) tot += part[i * 2048 + d] + part[i * 2048 + 1024 + d];
            ((float*)(p.ws + S_SCALE))[gidx] = 1.0f / tot;
        }
    }
    {
        bf16_t* CQN = (bf16_t*)(p.ws + A_CQN); bf16_t* KC = (bf16_t*)(p.ws + A_KEYSC); bf16_t* KP = (bf16_t*)(p.ws + A_KPER);
        float* out_ckv = p.out + (size_t)MT * DM; float* out_kpe = out_ckv + (size_t)BP * NLAYER * LP * 256;
        const int wave = obid() * 8 + (tid >> 6), nw = gridDim.x * 8;
        for (int row = wave; row < MT + BS * PAST; row += nw) {
            if (row < MT) {
                const bf16_t* pr = PA + (size_t)row * PA_LD;
                { const u32x4 v = *(const u32x4*)(pr + 3072 + lane * 8); float f[8]; unpack8(v, f); float ss = 0.f;
#pragma unroll
                  for (int j = 0; j < 8; ++j) ss += f[j] * f[j];
                  ss = wave_sum(ss, lane); const float rstd = rsqrtf(ss * (1.0f / 512.0f) + 1e-6f);
                  const float* qn = p.in[I_QN] + l * 512 + lane * 8;
#pragma unroll
                  for (int j = 0; j < 8; ++j) f[j] = f[j] * rstd * qn[j];
                  *(u32x4*)(CQN + (size_t)row * 512 + lane * 8) = pack8(f); }
                int KR, t; const bool isp = row < MP; int b;
                if (isp) { b = row >> 8; t = row & 255; KR = BS * LKS + row; } else { const int r2 = row - MP; b = r2 >> 11; t = r2 & 2047; KR = b * LKS + t; }
                { const u32x2 v = *(const u32x2*)(pr + 3584 + lane * 4); float f[4] = {bf_lo(v.x), bf_hi(v.x), bf_lo(v.y), bf_hi(v.y)};
                  float ss = f[0] * f[0] + f[1] * f[1] + f[2] * f[2] + f[3] * f[3]; ss = wave_sum(ss, lane); const float rstd = rsqrtf(ss * (1.0f / 256.0f) + 1e-6f);
                  const float* kn = p.in[I_KVN] + l * 256 + lane * 4;
#pragma unroll
                  for (int j = 0; j < 4; ++j) f[j] = f[j] * rstd * kn[j];
                  if (isp) *(f32x4*)(out_ckv + ((size_t)(b * NLAYER + l) * LP + t) * 256 + lane * 4) = (f32x4){f[0], f[1], f[2], f[3]};
                  u32x2 w; w.x = cvt_pk_bf16(f[0], f[1]); w.y = cvt_pk_bf16(f[2], f[3]); *(u32x2*)(KC + (size_t)KR * 256 + lane * 4) = w; }
                { const float v = __uint_as_float(((unsigned)pr[3840 + lane]) << 16);
                  float o = v;
                  if (isp) out_kpe[((size_t)(b * NLAYER + l) * LP + t) * 64 + lane] = v;
                  else { const float pv = shx(v, 32, lane); const float* rc = (const float*)(p.ws + S_ROPE); const float cs = rc[t * 32 + (lane & 31)], sn = rc[2048 * 32 + t * 32 + (lane & 31)]; o = (lane < 32) ? (v * cs - pv * sn) : (pv * sn + v * cs); }
                  KP[(size_t)KR * 64 + lane] = f2bf(o); }
            } else {
                const int r2 = row - MT, b = r2 >> 9, j = r2 & 511; const int KR = b * LKS + LS + j;
                const float* cc = p.in[I_CCKV] + ((size_t)(b * NLAYER + l) * PAST + j) * 256 + lane * 4;
                const f32x4 v = *(const f32x4*)cc; u32x2 w; w.x = cvt_pk_bf16(v[0], v[1]); w.y = cvt_pk_bf16(v[2], v[3]); *(u32x2*)(KC + (size_t)KR * 256 + lane * 4) = w;
                KP[(size_t)KR * 64 + lane] = f2bf(p.in[I_CKPE][((size_t)(b * NLAYER + l) * PAST + j) * 64 + lane]);
            }
        }
    }
    {
        bf16_t* YC = (bf16_t*)(p.ws + A_YC); const float* scw = p.in[I_SCW] + (size_t)l * 3 * 1024;
        float w0[8], w1[8], w2[8]; int cur_d0 = -1;
        for (int it = obid() * NTHREADS + tid; it < (MT / 4) * 128; it += gridDim.x * NTHREADS) {
            const int ch = it >> 7, d0 = (it & 127) * 8, row0 = ch * 4;
            const int t0 = row0 < MP ? (row0 & 255) : ((row0 - MP) & 2047); const int L = row0 < MP ? LP : LS;
            if (d0 != cur_d0) { cur_d0 = d0; const f32x4 a = *(const f32x4*)(scw + d0), b = *(const f32x4*)(scw + d0 + 4), c = *(const f32x4*)(scw + 1024 + d0), d = *(const f32x4*)(scw + 1024 + d0 + 4),
                          e2 = *(const f32x4*)(scw + 2048 + d0), f = *(const f32x4*)(scw + 2048 + d0 + 4);
#pragma unroll
              for (int j = 0; j < 4; ++j) { w0[j] = a[j]; w0[4 + j] = b[j]; w1[j] = c[j]; w1[4 + j] = d[j]; w2[j] = e2[j]; w2[4 + j] = f[j]; } }
            const bf16_t* pr = PA + (size_t)row0 * PA_LD;
            float pp[8], pc[8], pn[8];
#pragma unroll
            for (int j = 0; j < 8; ++j) pp[j] = 0.f;
            if (t0 > 0) { float cg[8], uu[8]; unpack8(*(const u32x4*)(pr - PA_LD + 4928 + d0), cg); unpack8(*(const u32x4*)(pr - PA_LD + 5952 + d0), uu);
#pragma unroll
                for (int j = 0; j < 8; ++j) pp[j] = cg[j] * uu[j]; }
            { float cg[8], uu[8]; unpack8(*(const u32x4*)(pr + 4928 + d0), cg); unpack8(*(const u32x4*)(pr + 5952 + d0), uu);
#pragma unroll
              for (int j = 0; j < 8; ++j) pc[j] = cg[j] * uu[j]; }
#pragma unroll
            for (int i = 0; i < 4; ++i) {
#pragma unroll
                for (int j = 0; j < 8; ++j) pn[j] = 0.f;
                if (t0 + i + 1 < L) { float cg[8], uu[8]; unpack8(*(const u32x4*)(pr + (size_t)(i + 1) * PA_LD + 4928 + d0), cg); unpack8(*(const u32x4*)(pr + (size_t)(i + 1) * PA_LD + 5952 + d0), uu);
#pragma unroll
                    for (int j = 0; j < 8; ++j) pn[j] = cg[j] * uu[j]; }
                float bg[8], o[8]; unpack8(*(const u32x4*)(pr + (size_t)i * PA_LD + 3904 + d0), bg);
#pragma unroll
                for (int j = 0; j < 8; ++j) { o[j] = bg[j] * (w0[j] * pp[j] + w1[j] * pc[j] + w2[j] * pn[j]); pp[j] = pc[j]; pc[j] = pn[j]; }
                *(u32x4*)(YC + (size_t)(row0 + i) * 1024 + d0) = pack8(o);
            }
        }
    }
    {
        bf16_t* X0S = (bf16_t*)(p.ws + A_X0S); bf16_t* ZZT = (bf16_t*)(p.ws + A_ZZT);
        const float* hw = p.in[I_HCW] + (size_t)l * 3 * 3072; const float* hb = p.in[I_HCB] + (size_t)l * 3072;
        LAS bf16_t* zt = (LAS bf16_t*)lds;
        float wgt[3][3][8], bs[3][8]; int cur_dt = -1;
        for (int u = obid(); u < (MT / 256) * 16; u += gridDim.x) {
            const int rt = u >> 4, dt = u & 15; const int row0 = rt * 256;
            const int dg = tid & 7, rb = tid >> 3, d0 = dt * 64 + dg * 8; const int rowb = row0 + rb * 4;
            const int L = row0 < MP ? LP : LS; const int tb = (row0 < MP ? (row0 & 255) : ((row0 - MP) & 2047)) + rb * 4;
            const bool reload = (dt != cur_dt); cur_dt = dt;
            if (reload)
#pragma unroll
            for (int g = 0; g < 3; ++g) {
#pragma unroll
                for (int o = 0; o < 3; ++o) { const f32x4 a = *(const f32x4*)(hw + o * 3072 + g * 1024 + d0), b = *(const f32x4*)(hw + o * 3072 + g * 1024 + d0 + 4);
#pragma unroll
                    for (int j = 0; j < 4; ++j) { wgt[g][o][j] = a[j]; wgt[g][o][4 + j] = b[j]; } }
                const f32x4 a = *(const f32x4*)(hb + g * 1024 + d0), b = *(const f32x4*)(hb + g * 1024 + d0 + 4);
#pragma unroll
                for (int j = 0; j < 4; ++j) { bs[g][j] = a[j]; bs[g][4 + j] = b[j]; }
            }
            const bf16_t* pr = PA + (size_t)rowb * PA_LD + d0;
            u32x4 wp[3], wc[3], wn[3];
#pragma unroll
            for (int g = 0; g < 3; ++g) { wp[g] = (u32x4){0u, 0u, 0u, 0u}; if (tb > 0) wp[g] = *(const u32x4*)(pr - PA_LD + g * 1024); wc[g] = *(const u32x4*)(pr + g * 1024); }
#pragma unroll
            for (int i = 0; i < 4; ++i) {
#pragma unroll
                for (int g = 0; g < 3; ++g) { wn[g] = (u32x4){0u, 0u, 0u, 0u}; if (tb + i + 1 < L) wn[g] = *(const u32x4*)(pr + (size_t)(i + 1) * PA_LD + g * 1024); }
                float hv[3][8];
#pragma unroll
                for (int g = 0; g < 3; ++g) { float a[8], b[8], c[8]; unpack8(wp[g], a); unpack8(wc[g], b); unpack8(wn[g], c);
#pragma unroll
                    for (int j = 0; j < 8; ++j) hv[g][j] = bs[g][j] + wgt[g][0][j] * a[j] + wgt[g][1][j] * b[j] + wgt[g][2][j] * c[j];
                    wp[g] = wc[g]; wc[g] = wn[g]; }
                *(u32x4*)(X0S + (size_t)(rowb + i) * 1024 + d0) = pack8(hv[0]);
#pragma unroll
                for (int j = 0; j < 8; ++j) zt[(dg * 8 + j) * 264 + rb * 4 + i] = f2bf(hv[1][j] * hv[2][j]);
            }
            __syncthreads();
#pragma unroll
            for (int i = 0; i < 4; ++i) {
                const int chunk = tid + i * NTHREADS; const int dl = chunk >> 5, tch = chunk & 31; const int d = dt * 64 + dl;
                size_t base; int t0;
                if (row0 < MP) { const int b = row0 >> 8; t0 = 0; base = ((size_t)b * 1024 + d) * LP; }
                else { const int r2 = row0 - MP; const int b = r2 >> 11; t0 = r2 & 2047; base = (size_t)BP * 1024 * LP + ((size_t)b * 1024 + d) * LS; }
                *(u32x4*)(ZZT + base + t0 + tch * 8) = *(const LAS u32x4*)(zt + dl * 264 + tch * 8);
            }
            __syncthreads();
        }
    }
}

__device__ __forceinline__ void conv_phase(int wv, const Params& p, int l, LAS unsigned char* lds) {
    const int tid = otid(wv), wid = tid >> 6, lane = tid & 63, r = lane & 31, hh = lane >> 5;
    const bf16_t* ZZT = (const bf16_t*)(p.ws + A_ZZT); bf16_t* YCT = (bf16_t*)(p.ws + A_YCT);
    const float* hbias = p.in[I_HBIAS] + l * 1024;
    LAS bf16_t* cp = (LAS bf16_t*)lds;
    LAS bf16_t* zz = (LAS bf16_t*)(lds + 65536);
    LAS float* kf = (LAS float*)(lds + 98304);
    for (int u = obid(); u < 2048; u += gridDim.x) {
        const int g = (u < 1024) ? 1 : 0, d = u & 1023;
        const int L = g ? LS : LP, B = g ? BS : BP, L2 = 2 * L, NB = L / 32, NI = 32 / B, NT = NB / NI, lgB = g ? 3 : 4;
        const float* kT = (const float*)(p.ws + (g ? S_KTS : S_KTP)) + (size_t)d * L2;
        const float scale = ((const float*)(p.ws + S_SCALE))[g * 1024 + d]; const float bias = hbias[d];
        for (int i = tid; i < L2 / 4; i += NTHREADS) { f32x4 v = *(const f32x4*)(kT + i * 4); v *= scale; if (i == 0) v[0] += bias; *(LAS f32x4*)(kf + i * 4) = v; }
        const size_t zbase = g ? (size_t)BP * 1024 * LP : 0;
        for (int ch = tid; ch < B * L / 8; ch += NTHREADS) {
            const int b = ch / (L / 8), s8 = ch - b * (L / 8);
            *(LAS u32x4*)(zz + b * L + s8 * 8) = *(const u32x4*)(ZZT + zbase + ((size_t)b * 1024 + d) * L + s8 * 8);
        }
        __syncthreads();
        for (int ck = tid; ck < L2; ck += NTHREADS) {
            const int c = ck / (L2 / 8), m0 = (ck - c * (L2 / 8)) * 8;
            float f[8];
#pragma unroll
            for (int j = 0; j < 8; ++j) f[j] = kf[(L2 - (m0 + c + j)) & (L2 - 1)];
            *(LAS u32x4*)(cp + c * L2 + m0) = pack8(f);
        }
        __syncthreads();
        const int Iloc = r >> lgB, b = r & (B - 1);
        for (int nt = wid * 2; nt < NT; nt += 16) {
            const int I0 = nt * NI;
            f32x16 acc0, acc1;
#pragma unroll
            for (int i = 0; i < 16; ++i) { acc0[i] = 0.f; acc1[i] = 0.f; }
            const bf16x8 zero8 = (bf16x8){0, 0, 0, 0, 0, 0, 0, 0};
            bf16x8 prev[4][2];
#pragma unroll
            for (int i = 0; i < 4; ++i) { prev[i][0] = zero8; prev[i][1] = zero8; }
            const int dl0 = I0 - (NB - 1), nsteps = NB + 2 * NI - 1;
            if (NI == 4) {
                for (int c4 = 0; c4 < nsteps; c4 += 4) {
                    bf16x8 cur[4][2];
#pragma unroll
                    for (int i = 0; i < 4; ++i) {
                        const int dl = dl0 + c4 + i; const int J0 = I0 + Iloc - dl; const bool v0 = (J0 >= 0) && (J0 < NB);
#pragma unroll
                        for (int ks = 0; ks < 2; ++ks) {
                            const int i0 = (16 * ks + 8 * hh - 32 * dl - r) & (L2 - 1); const int c = i0 & 7, q = i0 >> 3;
                            const bf16x8 Af = *(const LAS bf16x8*)(cp + c * L2 + q * 8);
                            cur[i][ks] = zero8;
                            if (v0) cur[i][ks] = *(const LAS bf16x8*)(zz + b * L + 32 * J0 + 16 * ks + 8 * hh);
                            acc0 = __builtin_amdgcn_mfma_f32_32x32x16_bf16(Af, cur[i][ks], acc0, 0, 0, 0);
                            acc1 = __builtin_amdgcn_mfma_f32_32x32x16_bf16(Af, prev[i][ks], acc1, 0, 0, 0);
                        }
                    }
#pragma unroll
                    for (int i = 0; i < 4; ++i) { prev[i][0] = cur[i][0]; prev[i][1] = cur[i][1]; }
                }
            } else {
                for (int c2 = 0; c2 < nsteps + 1; c2 += 2) {
                    bf16x8 cur[2][2];
#pragma unroll
                    for (int i = 0; i < 2; ++i) {
                        const int dl = dl0 + c2 + i; const int J0 = I0 + Iloc - dl; const bool v0 = (J0 >= 0) && (J0 < NB);
#pragma unroll
                        for (int ks = 0; ks < 2; ++ks) {
                            const int i0 = (16 * ks + 8 * hh - 32 * dl - r) & (L2 - 1); const int c = i0 & 7, q = i0 >> 3;
                            const bf16x8 Af = *(const LAS bf16x8*)(cp + c * L2 + q * 8);
                            cur[i][ks] = zero8;
                            if (v0) cur[i][ks] = *(const LAS bf16x8*)(zz + b * L + 32 * J0 + 16 * ks + 8 * hh);
                            acc0 = __builtin_amdgcn_mfma_f32_32x32x16_bf16(Af, cur[i][ks], acc0, 0, 0, 0);
                            acc1 = __builtin_amdgcn_mfma_f32_32x32x16_bf16(Af, prev[i][ks], acc1, 0, 0, 0);
                        }
                    }
#pragma unroll
                    for (int i = 0; i < 2; ++i) { prev[i][0] = cur[i][0]; prev[i][1] = cur[i][1]; }
                }
            }
            bf16_t* op = YCT + zbase + ((size_t)b * 1024 + d) * L + 32 * (I0 + Iloc) + 4 * hh;
#pragma unroll
            for (int g4 = 0; g4 < 4; ++g4) {
                u32x2 w; w.x = cvt_pk_bf16(acc0[4 * g4], acc0[4 * g4 + 1]); w.y = cvt_pk_bf16(acc0[4 * g4 + 2], acc0[4 * g4 + 3]); *(u32x2*)(op + 8 * g4) = w;
                u32x2 w1; w1.x = cvt_pk_bf16(acc1[4 * g4], acc1[4 * g4 + 1]); w1.y = cvt_pk_bf16(acc1[4 * g4 + 2], acc1[4 * g4 + 3]); *(u32x2*)(op + 32 * NI + 8 * g4) = w1;
            }
        }
        __syncthreads();
    }
}

__device__ __forceinline__ void e3b_phase(int wv, const Params& p, LAS unsigned char* lds) {
    const int tid = otid(wv);
    const bf16_t* X0S = (const bf16_t*)(p.ws + A_X0S); const bf16_t* YCT = (const bf16_t*)(p.ws + A_YCT); bf16_t* YA = (bf16_t*)(p.ws + A_YA);
    LAS bf16_t* yt = (LAS bf16_t*)lds;
    for (int u = obid(); u < (MT / 64) * 16; u += gridDim.x) {
        const int rt = u >> 4, dt = u & 15; const int row0 = rt * 64;
        {
            const int dl = tid >> 3, tch = tid & 7; const int d = dt * 64 + dl;
            size_t base; int t0;
            if (row0 < MP) { const int b = row0 >> 8; t0 = row0 & 255; base = ((size_t)b * 1024 + d) * LP; }
            else { const int r2 = row0 - MP; const int b = r2 >> 11; t0 = r2 & 2047; base = (size_t)BP * 1024 * LP + ((size_t)b * 1024 + d) * LS; }
            const u32x4 v = *(const u32x4*)(YCT + base + t0 + tch * 8);
            const unsigned w[4] = {v.x, v.y, v.z, v.w};
#pragma unroll
            for (int j = 0; j < 4; ++j) { yt[(tch * 8 + 2 * j) * 72 + dl] = (bf16_t)(w[j] & 0xffffu); yt[(tch * 8 + 2 * j + 1) * 72 + dl] = (bf16_t)(w[j] >> 16); }
        }
        __syncthreads();
        {
            const int tl = tid >> 3, dg = tid & 7; const int row = row0 + tl, d0 = dt * 64 + dg * 8;
            float a[8], b[8]; unpack8(*(const LAS u32x4*)(yt + tl * 72 + dg * 8), a); unpack8(*(const u32x4*)(X0S + (size_t)row * 1024 + d0), b);
#pragma unroll
            for (int j = 0; j < 8; ++j) a[j] *= b[j];
            *(u32x4*)(YA + (size_t)row * 1024 + d0) = pack8(a);
        }
        __syncthreads();
    }
}

__device__ __forceinline__ void attn_phase(int wv, const Params& p, LAS unsigned char* lds) {
    const bf16_t* Q = (const bf16_t*)(p.ws + A_Q); const bf16_t* KN = (const bf16_t*)(p.ws + A_KN); const bf16_t* KP = (const bf16_t*)(p.ws + A_KPER);
    const bf16_t* VT = (const bf16_t*)(p.ws + A_VT); bf16_t* O = (bf16_t*)(p.ws + A_OATT);
    LAS unsigned char* Ks = lds;
    LAS unsigned char* Vs = lds + 64 * 400;
    const float sc2 = 0.07216878364870322f * 1.4426950408889634f;
    for (int u = obid(); u < 512 + 128; u += gridDim.x) {
        const int tid = otid(wv), wid = tid >> 6, lane = tid & 63, r = lane & 31, hh = lane >> 5;
        int b, h, row0, Lk, KR0; size_t vtb; bool samp;
        if (u < 512) { samp = true; b = u >> 6; h = (u >> 3) & 7; const int qb = u & 7; row0 = MP + b * LS + qb * 256; Lk = LKS; KR0 = b * LKS; vtb = (size_t)(b * 8 + h) * 128 * LKS; }
        else { samp = false; const int u2 = u - 512; b = u2 >> 3; h = u2 & 7; row0 = b * LP; Lk = LP; KR0 = BS * LKS + b * LP; vtb = (size_t)BS * 8 * 128 * LKS + (size_t)(b * 8 + h) * 128 * LP; }
        const int qrow = row0 + wid * 32 + r;
        bf16x8 qf[12];
        {
            const bf16_t* qp = Q + (size_t)qrow * 1536 + h * 192 + 8 * hh;
            u32x4 qv[12];
#pragma unroll
            for (int s = 0; s < 12; ++s) qv[s] = *(const u32x4*)(qp + 16 * s);
            if (samp) {
                const int t = (qrow - MP) & 2047;
#pragma unroll
                for (int s2 = 0; s2 < 2; ++s2) {
                    float x1[8], x2[8]; unpack8(qv[8 + s2], x1); unpack8(qv[10 + s2], x2);
                    const float* rc = (const float*)(p.ws + S_ROPE) + t * 32 + 16 * s2 + 8 * hh;
                    const f32x4 c0 = *(const f32x4*)rc, c1 = *(const f32x4*)(rc + 4), s0 = *(const f32x4*)(rc + 2048 * 32), s1 = *(const f32x4*)(rc + 2048 * 32 + 4);
#pragma unroll
                    for (int j = 0; j < 8; ++j) { const float cs = (j < 4) ? c0[j & 3] : c1[j & 3], sn = (j < 4) ? s0[j & 3] : s1[j & 3]; const float a = x1[j], c = x2[j]; x1[j] = a * cs - c * sn; x2[j] = a * sn + c * cs; }
                    qv[8 + s2] = pack8(x1); qv[10 + s2] = pack8(x2);
                }
            }
#pragma unroll
            for (int s = 0; s < 12; ++s) qf[s] = __builtin_bit_cast(bf16x8, qv[s]);
        }
        f32x16 oacc[4];
#pragma unroll
        for (int ct = 0; ct < 4; ++ct)
#pragma unroll
            for (int i = 0; i < 16; ++i) oacc[ct][i] = 0.f;
        float mrun = -1e30f, lrun = 0.f;
        const int nkt = Lk / 64;
        u32x4 kst[3], vst[2];
#pragma unroll
        for (int i = 0; i < 3; ++i) { const int ck = tid + i * NTHREADS; const int key = ck / 24, part = ck - key * 24;
            kst[i] = (part < 16) ? *(const u32x4*)(KN + (size_t)(KR0 + key) * 1024 + h * 128 + part * 8) : *(const u32x4*)(KP + (size_t)(KR0 + key) * 64 + (part - 16) * 8); }
#pragma unroll
        for (int i = 0; i < 2; ++i) { const int cv = tid + i * NTHREADS; const int v = cv >> 3, kc = cv & 7; vst[i] = *(const u32x4*)(VT + vtb + (size_t)v * Lk + kc * 8); }
        for (int kt = 0; kt < nkt; ++kt) {
            __syncthreads();
#pragma unroll
            for (int i = 0; i < 3; ++i) { const int ck = tid + i * NTHREADS; const int key = ck / 24, part = ck - key * 24; *(LAS u32x4*)(Ks + key * 400 + part * 16) = kst[i]; }
#pragma unroll
            for (int i = 0; i < 2; ++i) { const int cv = tid + i * NTHREADS; const int v = cv >> 3, kc = cv & 7;
                LAS unsigned char* vp = Vs + v * 144 + (kc >> 1) * 32 + (kc & 1) * 8;
                *(LAS u32x2*)vp = (u32x2){vst[i].x, vst[i].y}; *(LAS u32x2*)(vp + 16) = (u32x2){vst[i].z, vst[i].w}; }
            __syncthreads();
            if (kt + 1 < nkt) {
                const int k0 = (kt + 1) * 64;
#pragma unroll
                for (int i = 0; i < 3; ++i) { const int ck = tid + i * NTHREADS; const int key = ck / 24, part = ck - key * 24;
                    kst[i] = (part < 16) ? *(const u32x4*)(KN + (size_t)(KR0 + k0 + key) * 1024 + h * 128 + part * 8) : *(const u32x4*)(KP + (size_t)(KR0 + k0 + key) * 64 + (part - 16) * 8); }
#pragma unroll
                for (int i = 0; i < 2; ++i) { const int cv = tid + i * NTHREADS; const int v = cv >> 3, kc = cv & 7; vst[i] = *(const u32x4*)(VT + vtb + (size_t)v * Lk + k0 + kc * 8); }
            }
            f32x16 sacc[2];
#pragma unroll
            for (int i = 0; i < 16; ++i) { sacc[0][i] = 0.f; sacc[1][i] = 0.f; }
#pragma unroll
            for (int s = 0; s < 12; ++s) {
                const bf16x8 kf0 = *(const LAS bf16x8*)(Ks + r * 400 + (16 * s + 8 * hh) * 2);
                const bf16x8 kf1 = *(const LAS bf16x8*)(Ks + (32 + r) * 400 + (16 * s + 8 * hh) * 2);
                sacc[0] = __builtin_amdgcn_mfma_f32_32x32x16_bf16(kf0, qf[s], sacc[0], 0, 0, 0);
                sacc[1] = __builtin_amdgcn_mfma_f32_32x32x16_bf16(kf1, qf[s], sacc[1], 0, 0, 0);
            }
            float mx0 = fmaxf(sacc[0][0], sacc[1][0]), mx1 = fmaxf(sacc[0][1], sacc[1][1]);
#pragma unroll
            for (int i = 2; i < 16; i += 2) { mx0 = __builtin_fmaxf(__builtin_fmaxf(mx0, sacc[0][i]), sacc[1][i]); mx1 = __builtin_fmaxf(__builtin_fmaxf(mx1, sacc[0][i + 1]), sacc[1][i + 1]); }
            float mx = fmaxf(mx0, mx1);
            mx = fmaxf(mx, shx(mx, 32, lane));
            const float mnew = fmaxf(mrun, mx);
            const bool resc = __builtin_amdgcn_ballot_w64(mnew != mrun) != 0ull;
            const float alpha = __builtin_amdgcn_exp2f((mrun - mnew) * sc2);
            mrun = mnew;
            const float nm = -mnew * sc2;
            f32x2 ps2 = (f32x2){0.f, 0.f};
#pragma unroll
            for (int kk = 0; kk < 2; ++kk)
#pragma unroll
                for (int i = 0; i < 16; i += 2) {
                    f32x2 a = (f32x2){sacc[kk][i], sacc[kk][i + 1]}; a = a * sc2 + nm;
                    a.x = __builtin_amdgcn_exp2f(a.x); a.y = __builtin_amdgcn_exp2f(a.y);
                    sacc[kk][i] = a.x; sacc[kk][i + 1] = a.y; ps2 += a;
                }
            lrun = lrun * alpha + (ps2.x + ps2.y);
            if (resc) {
#pragma unroll
                for (int ct = 0; ct < 4; ++ct)
#pragma unroll
                    for (int i = 0; i < 16; ++i) oacc[ct][i] *= alpha;
            }
#pragma unroll
            for (int ks = 0; ks < 4; ++ks) {
                const int kk = ks >> 1, s2 = ks & 1;
                u32x4 pw;
                pw.x = cvt_pk_bf16(sacc[kk][8 * s2 + 0], sacc[kk][8 * s2 + 1]); pw.y = cvt_pk_bf16(sacc[kk][8 * s2 + 2], sacc[kk][8 * s2 + 3]);
                pw.z = cvt_pk_bf16(sacc[kk][8 * s2 + 4], sacc[kk][8 * s2 + 5]); pw.w = cvt_pk_bf16(sacc[kk][8 * s2 + 6], sacc[kk][8 * s2 + 7]);
                const bf16x8 pf = __builtin_bit_cast(bf16x8, pw);
#pragma unroll
                for (int ct = 0; ct < 4; ++ct) {
                    const bf16x8 vf = *(const LAS bf16x8*)(Vs + (32 * ct + r) * 144 + (32 * kk + 16 * s2) * 2 + 16 * hh);
                    oacc[ct] = __builtin_amdgcn_mfma_f32_32x32x16_bf16(vf, pf, oacc[ct], 0, 0, 0);
                }
            }
        }
        lrun += shx(lrun, 32, lane);
        const float invl = 1.0f / lrun;
        const int tid2 = otid(wv); const int qrow2 = row0 + (tid2 >> 6) * 32 + (tid2 & 31);
        bf16_t* op = O + (size_t)qrow2 * 1024 + h * 128 + 4 * ((tid2 >> 5) & 1);
#pragma unroll
        for (int ct = 0; ct < 4; ++ct)
#pragma unroll
            for (int g4 = 0; g4 < 4; ++g4) {
                u32x2 w; w.x = cvt_pk_bf16(oacc[ct][4 * g4] * invl, oacc[ct][4 * g4 + 1] * invl); w.y = cvt_pk_bf16(oacc[ct][4 * g4 + 2] * invl, oacc[ct][4 * g4 + 3] * invl);
                *(u32x2*)(op + 32 * ct + 8 * g4) = w;
            }
        __syncthreads();
    }
}

__device__ __forceinline__ void e9_phase(int wv, const Params& p, int l) {
    const bf16_t* UU = (const bf16_t*)(p.ws + A_UU); bf16_t* ACT = (bf16_t*)(p.ws + A_ACT);
    const float* cw = p.in[I_FCW] + (size_t)l * 3 * UU_LD; const float* cb = p.in[I_FCB] + (size_t)l * UU_LD;
    const int tid9 = otid(wv);
    constexpr int RC = 16, NCG = DFF / 8;
    const int gt = obid() * NTHREADS + tid9, nlr = (int)(gridDim.x * NTHREADS) / NCG;
    const int c0 = (gt % NCG) * 8, lr = gt / NCG;
    float wg[3][8], wx[3][8], bg[8], bx[8];
    if (lr < nlr) {
#pragma unroll
        for (int o = 0; o < 3; ++o) { const f32x4 a = *(const f32x4*)(cw + o * UU_LD + c0), b = *(const f32x4*)(cw + o * UU_LD + c0 + 4), c = *(const f32x4*)(cw + o * UU_LD + DFF + c0), d = *(const f32x4*)(cw + o * UU_LD + DFF + c0 + 4);
#pragma unroll
            for (int j = 0; j < 4; ++j) { wg[o][j] = a[j]; wg[o][4 + j] = b[j]; wx[o][j] = c[j]; wx[o][4 + j] = d[j]; } }
        { const f32x4 a = *(const f32x4*)(cb + c0), b = *(const f32x4*)(cb + c0 + 4), c = *(const f32x4*)(cb + DFF + c0), d = *(const f32x4*)(cb + DFF + c0 + 4);
#pragma unroll
          for (int j = 0; j < 4; ++j) { bg[j] = a[j]; bg[4 + j] = b[j]; bx[j] = c[j]; bx[4 + j] = d[j]; } }
    }
    for (int ch = lr; lr < nlr && ch < MT / RC; ch += nlr) {
        const int row0 = ch * RC;
        const int t0 = row0 < MP ? (row0 & 255) : ((row0 - MP) & 2047); const int L = row0 < MP ? LP : LS;
        const bf16_t* pr = UU + (size_t)row0 * UU_LD + c0;
        u32x4 gp = (u32x4){0u, 0u, 0u, 0u}, xp = gp, gc, xc, gn, xn;
        if (t0 > 0) { gp = *(const u32x4*)(pr - UU_LD); xp = *(const u32x4*)(pr - UU_LD + DFF); }
        gc = *(const u32x4*)pr; xc = *(const u32x4*)(pr + DFF);
#pragma unroll 4
        for (int i = 0; i < RC; ++i) {
            gn = (u32x4){0u, 0u, 0u, 0u}; xn = gn;
            if (t0 + i + 1 < L) { gn = *(const u32x4*)(pr + (size_t)(i + 1) * UU_LD); xn = *(const u32x4*)(pr + (size_t)(i + 1) * UU_LD + DFF); }
            float a[8], b[8], c[8], ga[8], va[8];
            unpack8(gp, a); unpack8(gc, b); unpack8(gn, c);
#pragma unroll
            for (int j = 0; j < 8; ++j) ga[j] = bg[j] + wg[0][j] * a[j] + wg[1][j] * b[j] + wg[2][j] * c[j];
            unpack8(xp, a); unpack8(xc, b); unpack8(xn, c);
#pragma unroll
            for (int j = 0; j < 8; ++j) va[j] = bx[j] + wx[0][j] * a[j] + wx[1][j] * b[j] + wx[2][j] * c[j];
#pragma unroll
            for (int j = 0; j < 8; ++j) ga[j] = siluf_(ga[j]) * va[j];
            *(u32x4*)(ACT + (size_t)(row0 + i) * DFF + c0) = pack8(ga);
            gp = gc; gc = gn; xp = xc; xc = xn;
        }
    }
}

__device__ __forceinline__ void merge_phase(int wv, const Params& p) {
    const bf16_t* RAW = (const bf16_t*)(p.ws + A_RAW); const bf16_t* G = (const bf16_t*)(p.ws + A_GATES); bf16_t* MB = (bf16_t*)(p.ws + A_MBF);
    const int tid = otid(wv);
    for (int it = obid() * NTHREADS + tid; it < MT * 256; it += gridDim.x * NTHREADS) {
        const int row = it >> 8, c0 = (it & 255) * 8;
        float acc[8];
#pragma unroll
        for (int j = 0; j < 8; ++j) acc[j] = 0.f;
#pragma unroll
        for (int P = 0; P < 3; ++P) {
            float r[8], g[8];
            unpack8(*(const u32x4*)(RAW + ((size_t)P * MT + row) * DM + c0), r); unpack8(*(const u32x4*)(G + (size_t)row * GATE_LD + P * 2048 + c0), g);
#pragma unroll
            for (int j = 0; j < 8; ++j) acc[j] += sigmoidf_(g[j]) * r[j];
        }
        *(u32x4*)(MB + (size_t)row * DM + c0) = pack8(acc);
    }
}

__device__ __forceinline__ void convert_layer(int wv, const Params& p, int l, LAS unsigned char* lds) {
    unsigned char* ws = p.ws;
    convT(wv, p.in[I_WIN] + (size_t)l * DM * NIN, DM, NIN, (bf16_t*)(ws + W_IN), 1, lds);
    convT(wv, p.in[I_WUQ] + (size_t)l * 512 * 1536, 512, 1536, (bf16_t*)(ws + W_UQ), 0, lds);
    convT(wv, p.in[I_WUKV] + (size_t)l * 256 * 2048, 256, 2048, (bf16_t*)(ws + W_UKV), 2, lds);
    convT(wv, p.in[I_WBRA] + (size_t)l * 1024 * 2048, 1024, 2048, (bf16_t*)(ws + W_BRA), 0, lds);
    convT(wv, p.in[I_WBRB] + (size_t)l * 1024 * 2048, 1024, 2048, (bf16_t*)(ws + W_BRB), 0, lds);
    convT(wv, p.in[I_WBRC] + (size_t)l * 1024 * 2048, 1024, 2048, (bf16_t*)(ws + W_BRC), 0, lds);
    convT(wv, p.in[I_WO] + (size_t)l * 2048 * 2048, 2048, 2048, (bf16_t*)(ws + W_O), 0, lds);
    convT(wv, p.in[I_FUP] + (size_t)l * 2048 * UU_LD, 2048, UU_LD, (bf16_t*)(ws + W_UP), 0, lds);
    convT(wv, p.in[I_FDN] + (size_t)l * DFF * 2048, DFF, 2048, (bf16_t*)(ws + W_DN), 0, lds);
}

namespace pg8 {
struct EpiGateRT {
    const bf16_t* gates; float* m32; bf16_t* mbf; int P;
    __device__ __forceinline__ void operator()(const f32x4 (&acc)[2][2][4][2], const Unit& u, int wr, int wc, int fr, int fq) const {
        const int row0 = u.pm * BM + wr * 64 + fr, col0 = u.pn * BM + wc * 32 + 4 * fq;
#pragma unroll
        for (int ai = 0; ai < 2; ++ai)
#pragma unroll
            for (int m = 0; m < 4; ++m) {
                const size_t row = (size_t)(row0 + ai * HALF + m * 16);
#pragma unroll
                for (int bj = 0; bj < 2; ++bj)
#pragma unroll
                    for (int n = 0; n < 2; ++n) {
                        const int col = col0 + bj * HALF + n * 16;
                        const u32x2 gw = *(const u32x2*)(gates + row * GATE_LD + P * 2048 + col);
                        f32x4 v = acc[ai][bj][m][n];
                        v[0] *= sigmoidf_(bf_lo(gw.x)); v[1] *= sigmoidf_(bf_hi(gw.x)); v[2] *= sigmoidf_(bf_lo(gw.y)); v[3] *= sigmoidf_(bf_hi(gw.y));
                        float* mp = m32 + row * 2048 + col;
                        if (P != 0) { const f32x4 o = *(const f32x4*)mp; v = v + o; }
                        if (P != 2) { *(f32x4*)mp = v; }
                        else { u32x2 w; w.x = cvt_pk_bf16(v[0], v[1]); w.y = cvt_pk_bf16(v[2], v[3]); *(u32x2*)(mbf + row * 2048 + col) = w; }
                    }
            }
    }
};
}


#define XB_TMO      128
#define XB_XCNT(j)  (256  + 64 * (j))
#define XB_XSUB(j)  (1280 + 64 * (j))
#define XB_XGEN(j)  (2304 + 64 * (j))
#define XB_TOP      3328
#define XB_TOPGEN   3392
#define XCD_BAR_WORDS 3456
#define XB_SPIN_CAP (1u << 20)
__device__ __forceinline__ unsigned xb_ld(unsigned* p)              { return __hip_atomic_load(p, __ATOMIC_RELAXED, __HIP_MEMORY_SCOPE_AGENT); }
__device__ __forceinline__ unsigned xb_add(unsigned* p, unsigned v) { return __hip_atomic_fetch_add(p, v, __ATOMIC_RELAXED, __HIP_MEMORY_SCOPE_AGENT); }
__device__ __forceinline__ unsigned xb_xcc_id() { return (unsigned)__builtin_amdgcn_s_getreg((3 << 11) | 20) & 0xFu; }
#define XB_SPIN(cond, bar) do { unsigned _sp = 0; while (cond) { __builtin_amdgcn_s_sleep(1); \
    if ((++_sp & 255u) == 0u) { if (xb_ld(&(bar)[XB_TMO])) break; if (_sp > XB_SPIN_CAP) { atomicAdd(&(bar)[XB_TMO], 1u); break; } } } } while (0)
__device__ __forceinline__ void xcd_barrier_complete(unsigned* bar, unsigned x, unsigned& nloc, unsigned& nx) {
    const unsigned G = gridDim.x;
    unsigned sum, cnt, mine, sp = 0u;
    for (;;) {
        sum = 0u; cnt = 0u; mine = 0u;
#pragma unroll
        for (unsigned j = 0; j < 16; ++j) { const unsigned c = xb_ld(&bar[XB_XCNT(j)]); sum += c; cnt += (c > 0u) ? 1u : 0u; mine = (j == x) ? c : mine; }
        if (sum == G) break;
        __builtin_amdgcn_s_sleep(1);
        if ((++sp & 255u) == 0u) { if (xb_ld(&bar[XB_TMO])) break; if (sp > XB_SPIN_CAP) { atomicAdd(&bar[XB_TMO], 1u); break; } }
    }
    nloc = mine > 0u ? mine : 1u; nx = cnt > 0u ? cnt : 1u;
}
__device__ __forceinline__ void xcd_barrier(int wv, unsigned* bar, volatile LAS unsigned* st) {
    asm volatile("s_waitcnt vmcnt(0)" ::: "memory");
    __syncthreads();
    if (otid(wv) == 0) {
        __builtin_amdgcn_s_waitcnt(0);
        const unsigned x = xb_xcc_id();
        unsigned nloc = st[0], nx = st[1];
        if (nloc == 0u) { xcd_barrier_complete(bar, x, nloc, nx); st[0] = nloc; st[1] = nx; }
        const unsigned old = xb_add(&bar[XB_XSUB(x)], 1u);
        const unsigned gen = old / nloc;
        if (old + 1u == (gen + 1u) * nloc) {
            __builtin_amdgcn_fence(__ATOMIC_RELEASE, "agent");
            asm volatile("s_waitcnt vmcnt(0)" ::: "memory");
            const unsigned og = xb_add(&bar[XB_TOP], 1u);
            const unsigned tg = og / nx;
            if (og + 1u == (tg + 1u) * nx) xb_add(&bar[XB_TOPGEN], 1u);
            else XB_SPIN(xb_ld(&bar[XB_TOPGEN]) == tg, bar);
            __builtin_amdgcn_fence(__ATOMIC_ACQUIRE, "agent");
            xb_add(&bar[XB_XGEN(x)], 1u);
            asm volatile("s_waitcnt vmcnt(0)" ::: "memory");
        } else {
            XB_SPIN(xb_ld(&bar[XB_XGEN(x)]) == gen, bar);
            __builtin_amdgcn_fence(__ATOMIC_ACQUIRE, "agent");
            asm volatile("s_waitcnt vmcnt(0)" ::: "memory");
        }
    }
    __syncthreads();
}

#ifndef REP_GEMM
#define REP_GEMM 1
#endif
#ifndef REP_ATTN
#define REP_ATTN 1
#endif
#ifndef REP_CONV
#define REP_CONV 1
#endif
#ifndef REP_ELT
#define REP_ELT 1
#endif
#ifndef REP_CVT
#define REP_CVT 1
#endif
enum { K_G1A = 0, K_E2, K_I3, K_I4, K_G1B, K_G5, K_G6, K_ROW1, K_G8, K_E9, K_G10, K_ROW2, K_PRO, K_ROW0, K_COMB };

__global__ void __launch_bounds__(NTHREADS) fwd_megakernel(Params p) {
    extern __shared__ __attribute__((aligned(16))) unsigned char shm[];
    LAS unsigned char* lds = (LAS unsigned char*)shm;
    cg::grid_group grid = cg::this_grid();
    const int wv = __builtin_amdgcn_readfirstlane((int)(threadIdx.x >> 6));
    volatile LAS unsigned* bst = (volatile LAS unsigned*)(lds + 131072);
    unsigned* bar = (unsigned*)(p.ws + S_BAR);
    if (threadIdx.x == 0) { bst[0] = 0u; bst[1] = 0u; bst[2] = 0u; bst[3] = 0u; (void)xb_add(&bar[XB_XCNT(xb_xcc_id())], 1u); }
    __syncthreads();
#pragma unroll 1
    for (int ph = 0; ph < 3 + 12 * NLAYER; ++ph) {
        int kind, l;
        if (ph == 0) { kind = K_PRO; l = 0; } else if (ph == 1) { kind = K_COMB; l = 0; } else if (ph == 2) { kind = K_ROW0; l = 0; } else { l = (ph - 3) / 12; kind = (ph - 3) - l * 12; }
        unsigned char* ws = p.ws;
        asm volatile("" : "+s"(ws));
        if (kind == K_G1A || kind == K_I3 || kind == K_G1B || kind == K_G8) {
            const bf16_t* A; const bf16_t* Bt; bf16_t* O; int N, K;
            if (kind == K_G1A) { A = (const bf16_t*)(ws + A_H); Bt = (const bf16_t*)(ws + W_IN); O = (bf16_t*)(ws + A_PROJA); N = PA_LD; K = DM; }
            else if (kind == K_I3) { A = (const bf16_t*)(ws + A_CQN); Bt = (const bf16_t*)(ws + W_UQ); O = (bf16_t*)(ws + A_Q); N = 1536; K = 512; }
            else if (kind == K_G1B) { A = (const bf16_t*)(ws + A_H); Bt = (const bf16_t*)(ws + W_IN) + (size_t)PA_LD * DM; O = (bf16_t*)(ws + A_GATES); N = GATE_LD; K = DM; }
            else { A = (const bf16_t*)(ws + A_H); Bt = (const bf16_t*)(ws + W_UP); O = (bf16_t*)(ws + A_UU); N = UU_LD; K = DM; }
            int Mr = MT;
            const int nrep = ((kind == K_I3) ? 2 : 1) * REP_GEMM;
#pragma unroll 1
            for (int rp = 0; rp < nrep; ++rp) {
                if (kind == K_I3 && rp >= REP_GEMM) { A = (const bf16_t*)(ws + A_KEYSC); Bt = (const bf16_t*)(ws + W_UKV); O = (bf16_t*)(ws + A_KN); N = 1024; K = 256; Mr = KROWS; }
                run_gemm(wv, lds, A, Bt, Mr, N, K, pg8::EpiBf16{O, N, O});
            }
        }
        if (kind == K_I3) {
#pragma unroll 1
            for (int rp = 0; rp < REP_GEMM; ++rp)
            run_gemm(wv, lds, (const bf16_t*)(ws + W_UKV) + (size_t)1024 * 256, (const bf16_t*)(ws + A_KEYSC), 1024, KROWS, 256,
                     pg8::EpiVT{(bf16_t*)(ws + A_VT), (bf16_t*)(ws + A_VT) + (size_t)BS * 8 * 128 * LKS});
#pragma unroll 1
            for (int rp = 0; rp < REP_CONV; ++rp) conv_phase(wv, p, l, lds);
        }
        if (kind == K_I4) {
#pragma unroll 1
            for (int rp = 0; rp < REP_ATTN; ++rp) attn_phase(wv, p, lds);
#pragma unroll 1
            for (int rp = 0; rp < REP_ELT; ++rp) e3b_phase(wv, p, lds); }
        if (kind == K_G1B) {
#pragma unroll 1
            for (int rp = 0; rp < REP_GEMM; ++rp)
            run_gemm(wv, lds, (const bf16_t*)(ws + A_YA), (const bf16_t*)(ws + W_BRA), 3 * MT, DM, 1024, pg8::EpiBf16{(bf16_t*)(ws + A_RAW), DM, (bf16_t*)(ws + A_RAW)}, false, MT / 256, E_WBR * 2, true);
        }
        if (kind == K_G5) merge_phase(wv, p);
        if (kind == K_G6 || kind == K_G10) {
            const bool g6 = (kind == K_G6);
#pragma unroll 1
            for (int rp = 0; rp < REP_GEMM; ++rp)
            run_gemm(wv, lds, (const bf16_t*)(ws + (g6 ? A_MBF : A_ACT)), (const bf16_t*)(ws + (g6 ? W_O : W_DN)), MT, DM, g6 ? DM : DFF, pg8::EpiBf16{(bf16_t*)(ws + (g6 ? A_M32 : A_F32)), DM, (bf16_t*)(ws + (g6 ? A_M32 : A_F32)) + (size_t)MT * DM}, true);
        }
        if (kind == K_E2) {
#pragma unroll 1
            for (int rp = 0; rp < REP_ELT; ++rp) e2_phase(wv, p, l, lds); }
        if (kind == K_E9) {
#pragma unroll 1
            for (int rp = 0; rp < REP_ELT; ++rp) e9_phase(wv, p, l); }
        if (kind == K_ROW0 || kind == K_ROW1 || kind == K_ROW2) row_phase(wv, p, l, kind == K_ROW0 ? 0 : (kind == K_ROW1 ? 1 : 2));
        if (kind == K_COMB) comb_phase(wv, p);
        if (kind == K_PRO) {
            if (obid() == 0) {
                pg8::StaticOrder S; S.init(MT, DM, (int)gridDim.x, 0, true);
                const int t0 = otid(wv);
                if (t0 < S.nwg - S.nfull) { pg8::Unit uu; S.tile_of(S.nfull + t0, uu); atomicOr((unsigned*)(p.ws + S_TAIL) + uu.pm, 1u << uu.pn); }
            }
            ada_phase(wv, p, lds); rope_table_phase(wv, p); }
        if (kind == K_PRO || (kind == K_ROW2 && l + 1 < NLAYER)) { const int ln = (kind == K_PRO) ? 0 : l + 1;
#pragma unroll 1
            for (int rp = 0; rp < REP_CVT; ++rp) { filter_phase(wv, p, ln, lds); convert_layer(wv, p, ln, lds); } }
        if (p.ws == nullptr) grid.sync();
        xcd_barrier(wv, bar, bst);
    }
}

extern "C" void kernel_launch(void* const* d_in, const int* in_sizes, int n_in, void* d_out, int out_size, void* d_ws, size_t ws_size, hipStream_t stream) {
    static int grid_blocks = 0;
    if (grid_blocks == 0) {
        if (n_in != N_INPUTS || ws_size < WS_NEED) { fprintf(stderr, "kernel_launch: need %d inputs and %zu bytes of workspace; got %d, %zu\n", N_INPUTS, (size_t)WS_NEED, n_in, ws_size); grid_blocks = -1; return; }
        int dev = 0, cus = 0, per_cu = 0;
        hipGetDevice(&dev);
        hipDeviceGetAttribute(&cus, hipDeviceAttributeMultiprocessorCount, dev);
        if (hipFuncSetAttribute((const void*)fwd_megakernel, hipFuncAttributeMaxDynamicSharedMemorySize, LDS_BYTES) != hipSuccess) { fprintf(stderr, "kernel_launch: hipFuncSetAttribute failed\n"); grid_blocks = -1; return; }
        if (hipOccupancyMaxActiveBlocksPerMultiprocessor(&per_cu, (const void*)fwd_megakernel, NTHREADS, LDS_BYTES) != hipSuccess || per_cu < 1) { fprintf(stderr, "kernel_launch: occupancy query gave %d\n", per_cu); per_cu = 1; }
        (void)hipGetLastError();
        grid_blocks = cus * 1;
    }
    if (grid_blocks < 0) return;
        (void)hipMemsetAsync((unsigned char*)d_ws + S_BAR, 0, 16384, stream);
    (void)hipMemsetAsync((unsigned char*)d_ws + S_TAIL, 0, 512, stream);
    Params p{};
    for (int i = 0; i < N_INPUTS; ++i) p.in[i] = (const float*)d_in[i];
    p.out = (float*)d_out; p.ws = (unsigned char*)d_ws;
    void* args[] = {&p};
    hipError_t e = hipLaunchCooperativeKernel((const void*)fwd_megakernel, dim3(grid_blocks), dim3(NTHREADS), args, LDS_BYTES, stream);
    if (e != hipSuccess) fprintf(stderr, "cooperative launch failed: %s (grid %d)\n", hipGetErrorString(e), grid_blocks);
}
```

```cpp
#include <hip/hip_runtime.h>
#include <hip/hip_cooperative_groups.h>
#include <cstdio>
namespace cg = cooperative_groups;

#define LAS __attribute__((address_space(3)))
typedef unsigned short bf16_t;
typedef short bf16x8 __attribute__((ext_vector_type(8)));
typedef float f32x4 __attribute__((ext_vector_type(4)));
typedef float f32x16 __attribute__((ext_vector_type(16)));
typedef unsigned u32x4 __attribute__((ext_vector_type(4)));
typedef unsigned u32x2 __attribute__((ext_vector_type(2)));
typedef float f32x2 __attribute__((ext_vector_type(2)));

constexpr int DM = 2048, MP = 4096, MS = 16384, MT = 20480, NLAYER = 2;
constexpr int LP = 256, LS = 2048, BP = 16, BS = 8, PAST = 512, LKS = 2560;
constexpr int NIN = 13120, NGATE0 = 6976, PA_LD = 7168, GATE_LD = 6144;
constexpr int DFF = 5632, UU_LD = 11264;
constexpr int KROWS = 24576;
constexpr int NTHREADS = 512;
constexpr int LDS_BYTES = 131072 + 16;

enum { I_XP = 0, I_XS, I_C, I_CCKV, I_CKPE, I_CCTX, I_ADAW, I_ADAB, I_NMPRE, I_NMPOST, I_NFPRE, I_NFPOST, I_WIN, I_HCW, I_HCB,
       I_FW1, I_FB1, I_FW2, I_FB2, I_FW3, I_FB3, I_FFREQ, I_HBIAS, I_QN, I_KVN, I_WUQ, I_WUKV, I_SCW, I_WBRA, I_WBRB, I_WBRC,
       I_WO, I_FUP, I_FCW, I_FCB, I_FDN, N_INPUTS };

constexpr size_t E_WIN = (size_t)13312 * 2048, E_WUQ = (size_t)1536 * 512, E_WUKV = (size_t)2048 * 256, E_WBR = (size_t)2048 * 1024,
                 E_WO = (size_t)2048 * 2048, E_WUP = (size_t)11264 * 2048, E_WDN = (size_t)2048 * 5632;
constexpr size_t W_IN = 0, W_UQ = W_IN + E_WIN * 2, W_UKV = W_UQ + E_WUQ * 2, W_BRA = W_UKV + E_WUKV * 2, W_BRB = W_BRA + E_WBR * 2,
                 W_BRC = W_BRB + E_WBR * 2, W_O = W_BRC + E_WBR * 2, W_UP = W_O + E_WO * 2, W_DN = W_UP + E_WUP * 2, W_END = W_DN + E_WDN * 2;
constexpr size_t S_MOD = W_END, SZ_MOD = (size_t)NLAYER * 16 * 9 * 12288 * 4;
constexpr size_t S_KTS = S_MOD + SZ_MOD, S_KTP = S_KTS + (size_t)1024 * 4096 * 4, S_PARTS = S_KTP + (size_t)1024 * 512 * 4,
                 S_PARTP = S_PARTS + (size_t)64 * 2048 * 4, S_ROPE = S_PARTP + (size_t)8 * 2048 * 4, S_BAR = S_ROPE + (size_t)2 * 2048 * 32 * 4, S_COMB = S_BAR + 16384, S_SCALE = S_COMB + (size_t)NLAYER * 3 * 9 * 3 * 2048 * 4, S_TAIL = S_SCALE + 8192, S_END = S_TAIL + 512;
constexpr size_t AR = S_END;
constexpr size_t SZ_H = (size_t)MT * 2048 * 2;
constexpr size_t A_H = AR, A_UU = AR + SZ_H, A_ACT = A_UU + (size_t)MT * UU_LD * 2, AR_END = A_ACT + (size_t)MT * DFF * 2;
constexpr size_t A_PROJA = A_UU;
constexpr size_t A_Q = A_UU, A_KN = A_Q + (size_t)MT * 1536 * 2, A_VT = A_KN + (size_t)KROWS * 1024 * 2, A_YCT = A_VT + (size_t)KROWS * 1024 * 2;
constexpr size_t A_GATES = A_UU, A_M32 = A_GATES + (size_t)MT * GATE_LD * 2, A_MBF = A_H, A_F32 = A_UU;
constexpr size_t A_S = A_M32 + (size_t)MT * 2048 * 4;
constexpr size_t A_ZZT = A_S, A_X0S = A_ZZT + (size_t)MT * 1024 * 2, A_CQN = A_X0S + (size_t)MT * 1024 * 2, A_KEYSC = A_CQN + (size_t)MT * 512 * 2,
                 A_KPER = A_KEYSC + (size_t)KROWS * 256 * 2, A_YA = A_KPER + (size_t)KROWS * 64 * 2, A_OATT = A_YA + (size_t)MT * 1024 * 2,
                 A_YC = A_OATT + (size_t)MT * 1024 * 2, A_SEND = A_YC + (size_t)MT * 1024 * 2;
constexpr size_t A_RAW = A_M32;
static_assert(A_RAW + (size_t)3 * MT * 2048 * 2 <= A_CQN, "raw branch buffer overlaps live data");
static_assert(A_SEND <= AR_END, "arena overflow");
static_assert(A_YCT + (size_t)MT * 1024 * 2 <= A_M32, "arena overlap");
constexpr size_t WS_NEED = AR_END;
static_assert(WS_NEED <= 967590400ull, "workspace too large");

struct Params {
    const float* in[N_INPUTS];
    float* out;
    unsigned char* ws;
};

__device__ __forceinline__ unsigned cvt_pk_bf16(float lo, float hi) { unsigned r; asm volatile("v_cvt_pk_bf16_f32 %0, %1, %2" : "=v"(r) : "v"(lo), "v"(hi)); return r; }
__device__ __forceinline__ bf16_t f2bf(float f) { return (bf16_t)(cvt_pk_bf16(f, 0.f) & 0xffffu); }
__device__ __forceinline__ float bf_lo(unsigned w) { return __uint_as_float(w << 16); }
__device__ __forceinline__ float bf_hi(unsigned w) { return __uint_as_float(w & 0xffff0000u); }
__device__ __forceinline__ void unpack8(const u32x4 v, float* f) { f[0] = bf_lo(v.x); f[1] = bf_hi(v.x); f[2] = bf_lo(v.y); f[3] = bf_hi(v.y); f[4] = bf_lo(v.z); f[5] = bf_hi(v.z); f[6] = bf_lo(v.w); f[7] = bf_hi(v.w); }
__device__ __forceinline__ u32x4 pack8(const float* f) { u32x4 r; r.x = cvt_pk_bf16(f[0], f[1]); r.y = cvt_pk_bf16(f[2], f[3]); r.z = cvt_pk_bf16(f[4], f[5]); r.w = cvt_pk_bf16(f[6], f[7]); return r; }
__device__ __forceinline__ float shx(float v, int mask, int lane) { return __int_as_float(__builtin_amdgcn_ds_bpermute((lane ^ mask) << 2, __float_as_int(v))); }
__device__ __forceinline__ float wave_sum(float v, int lane) {
#pragma unroll
    for (int o = 32; o >= 1; o >>= 1) v += shx(v, o, lane);
    return v;
}
__device__ __forceinline__ int otid(int wv) { int t; asm volatile("v_mbcnt_lo_u32_b32 %0, -1, 0\n\tv_mbcnt_hi_u32_b32 %0, -1, %0" : "=v"(t)); return wv * 64 + t; }
__device__ __forceinline__ int obid() { int t = blockIdx.x; asm volatile("" : "+s"(t)); return t; }
__device__ __forceinline__ float sigmoidf_(float x) { return __builtin_amdgcn_rcpf(1.0f + __builtin_amdgcn_exp2f(-1.4426950408889634f * x)); }
__device__ __forceinline__ float siluf_(float x) { return x * sigmoidf_(x); }

namespace pg8 {
constexpr int BM = 256, BK = 64, HALF = 128, HTB = HALF * BK * 2, STAGE_BYTES = 8 * HTB, NXCD = 8, WGM = 8;
__host__ __device__ __forceinline__ int lds_byte(int r, int c) { const int st = (r >> 4) * 2 + (c >> 5), rr = r & 15, cc = c & 31, ob = rr * 64 + cc * 2; return st * 1024 + (ob ^ (((ob >> 9) & 1) << 5)); }
__host__ __device__ __forceinline__ void stage_rc(int b, int& R, int& C) { const int st = b / 1024, sb = b % 1024, swz = sb ^ (((sb >> 9) & 1) << 5); R = (st >> 1) * 16 + swz / 64; C = (st & 1) * 32 + (swz % 64) / 2; }
__host__ __device__ __forceinline__ int perm32(int rho) { const int n = rho >> 4, i = rho & 15; return 8 * (i >> 2) + 4 * n + (i & 3); }
struct Unit { int pm, pn, kh; };
struct Gemm { const bf16_t* A; const bf16_t* Bt; int M, N, K; int nMper; size_t bstride; };
struct StaticOrder {
    int nM, nN, nwg, G, c, nfull;
    __device__ void init(int M, int N, int G_, int c_, bool split = false) { nM = M / BM; nN = N / BM; nwg = nM * nN; G = G_; c = c_;
        nfull = nwg; if (split) { const int rem = nwg % G; if (rem > 0 && 2 * rem <= G) nfull = nwg - rem; } }
    __device__ void tile_of(int wgid, Unit& u) const {
        { const int q = nwg / NXCD, r = nwg % NXCD, xcd = wgid % NXCD, off = wgid / NXCD; wgid = (xcd < r ? xcd * (q + 1) : r * (q + 1) + (xcd - r) * q) + off; }
        const int nig = WGM * nN, gid = wgid / nig, fm = gid * WGM, gsz = (nM - fm) < WGM ? (nM - fm) : WGM;
        u.pm = fm + ((wgid % nig) % gsz); u.pn = (wgid % nig) / gsz;
    }
    __device__ bool next(int i, Unit& u) const {
        const long L = (long)i * G + c;
        int tile = (int)L, kh = -1; bool ok = L < nwg;
        if (L >= nfull) { const long h = L - nfull; ok = h < 2 * (long)(nwg - nfull); tile = nfull + (int)(h >> 1); kh = (int)(h & 1); }
        if (!ok) return false;
        int pm, pn;
        { int wgid = tile; const int q = nwg / NXCD, r = nwg % NXCD, xcd = wgid % NXCD, off = wgid / NXCD; wgid = (xcd < r ? xcd * (q + 1) : r * (q + 1) + (xcd - r) * q) + off;
          const int nig = WGM * nN, gid = wgid / nig, fm = gid * WGM, gsz = (nM - fm) < WGM ? (nM - fm) : WGM;
          pm = fm + ((wgid % nig) % gsz); pn = (wgid % nig) / gsz; }
        u.pm = pm; u.pn = pn; u.kh = kh; return true;
    }
};
template <class Epi>
__device__ __forceinline__ void gemm_phase(int wv, LAS unsigned char* lds, const Gemm g, const StaticOrder& S, const Epi& E) {
    const int tid = otid(wv), wid = __builtin_amdgcn_readfirstlane(tid >> 6), lane = tid & 63, wr = wid >> 2, wc = wid & 3, fr = lane & 15, fq = lane >> 4;
    const int K = g.K, nt = K / BK;
    unsigned voffA[2], voffB[2];
#pragma unroll
    for (int i = 0; i < 2; ++i) { int R, C; stage_rc(tid * 16 + i * 8192, R, C); const int Rb = (R & ~31) + perm32(R & 31); voffA[i] = (unsigned)(R * K + C) * 2u; voffB[i] = (unsigned)(Rb * K + C) * 2u; }
    const size_t kstep = (size_t)(BK * 2);
    const size_t hstep = (size_t)HALF * K * 2;
    const size_t tstep = 2 * hstep;
    const unsigned ldsw = (unsigned)wid * 1024u;
    const int aoff = lds_byte(wr * 64 + fr, fq * 8), boff = lds_byte(wc * 32 + fr, fq * 8);
#define PG8_SA(b, h) (((b) * 2 + (h)) * HTB)
#define PG8_SB(b, h) ((4 + (b) * 2 + (h)) * HTB)
#define PG8_STAGE(bufoff, gbase, voff) do { _Pragma("unroll") for (int _i = 0; _i < 2; ++_i) \
        __builtin_amdgcn_global_load_lds((const unsigned*)((const char*)(gbase) + (voff)[_i]), (LAS unsigned*)(lds + (bufoff) + ldsw + _i * 8192), 16, 0, 0); } while (0)
#define PG8_LDA(dst, b, h) do { _Pragma("unroll") for (int m = 0; m < 4; ++m) _Pragma("unroll") for (int k = 0; k < 2; ++k) dst[m][k] = *(const LAS bf16x8*)(lds + PG8_SA(b, h) + aoff + m * 2048 + k * 1024); } while (0)
#define PG8_LDB(dst, b, h) do { _Pragma("unroll") for (int n = 0; n < 2; ++n) _Pragma("unroll") for (int k = 0; k < 2; ++k) dst[n][k] = *(const LAS bf16x8*)(lds + PG8_SB(b, h) + boff + n * 2048 + k * 1024); } while (0)
#define PG8_MMA(ai, bj, At, Bt) do { __builtin_amdgcn_s_setprio(1); _Pragma("unroll") for (int m = 0; m < 4; ++m) _Pragma("unroll") for (int n = 0; n < 2; ++n) _Pragma("unroll") for (int k = 0; k < 2; ++k) \
        acc[ai][bj][m][n] = __builtin_amdgcn_mfma_f32_16x16x32_bf16(Bt[n][k], At[m][k], acc[ai][bj][m][n], 0, 0, 0); __builtin_amdgcn_s_setprio(0); } while (0)
#define PG8_WAIT_V(n) asm volatile("s_waitcnt vmcnt(" #n ")" ::: "memory")
#define PG8_WAIT_L(n) asm volatile("s_waitcnt lgkmcnt(" #n ")" ::: "memory")
#define PG8_BAR __builtin_amdgcn_s_barrier()
#define PG8_SCHED __builtin_amdgcn_sched_barrier(0)
    Unit cur, nxt; int ui = 0;
    if (!S.next(0, cur)) return;
    f32x4 acc[2][2][4][2];
#pragma unroll
    for (int a = 0; a < 2; ++a)
#pragma unroll
        for (int b = 0; b < 2; ++b)
#pragma unroll
            for (int m = 0; m < 4; ++m)
#pragma unroll
                for (int n = 0; n < 2; ++n) acc[a][b][m][n] = (f32x4){0.f, 0.f, 0.f, 0.f};
    bf16x8 At[4][2], B0[2][2], B1[2][2];
    const size_t khoff = (size_t)(nt / 2) * kstep;
    const char* cA = (const char*)g.A + (size_t)cur.pm * tstep + (cur.kh == 1 ? khoff : 0); const char* cB = (const char*)g.Bt + (size_t)(cur.pm / g.nMper) * g.bstride + (size_t)cur.pn * tstep + (cur.kh == 1 ? khoff : 0);
    PG8_STAGE(PG8_SB(0, 0), cB, voffB); PG8_STAGE(PG8_SA(0, 0), cA, voffA); PG8_STAGE(PG8_SB(0, 1), cB + hstep, voffB); PG8_STAGE(PG8_SA(0, 1), cA + hstep, voffA);
    if (wr == 1) PG8_BAR;
    PG8_WAIT_V(4); PG8_BAR;
    PG8_STAGE(PG8_SB(1, 0), cB + kstep, voffB); PG8_STAGE(PG8_SA(1, 0), cA + kstep, voffA); PG8_STAGE(PG8_SB(1, 1), cB + hstep + kstep, voffB);
    PG8_WAIT_V(6); PG8_BAR;
    for (;;) {
        const bool has_next = S.next(ui + 1, nxt);
        const char* nA = has_next ? (const char*)g.A + (size_t)nxt.pm * tstep + (nxt.kh == 1 ? khoff : 0) : cA; const char* nB = has_next ? (const char*)g.Bt + (size_t)(nxt.pm / g.nMper) * g.bstride + (size_t)nxt.pn * tstep + (nxt.kh == 1 ? khoff : 0) : cB;
        const int ntu = (cur.kh < 0) ? nt : (nt >> 1);
        for (int t = 0; t < ntu; t += 2) {
            const bool last = (t == ntu - 2);
            const char* a1 = cA + (size_t)(t + 1) * kstep;
            const char* a2 = last ? nA : cA + (size_t)(t + 2) * kstep; const char* b2 = last ? nB : cB + (size_t)(t + 2) * kstep;
            const char* a3 = a2 + kstep; const char* b3 = b2 + kstep;
            PG8_LDB(B0, 0, 0); PG8_SCHED; PG8_LDA(At, 0, 0); PG8_STAGE(PG8_SA(1, 1), a1 + hstep, voffA);
            PG8_WAIT_L(8); PG8_BAR; PG8_WAIT_L(0); PG8_MMA(0, 0, At, B0); PG8_BAR; PG8_SCHED;
            PG8_LDB(B1, 0, 1); PG8_STAGE(PG8_SB(0, 0), b2, voffB);
            PG8_BAR; PG8_WAIT_L(0); PG8_MMA(0, 1, At, B1); PG8_BAR;
            PG8_LDA(At, 0, 1); PG8_STAGE(PG8_SA(0, 0), a2, voffA);
            PG8_BAR; PG8_WAIT_L(0); PG8_MMA(1, 0, At, B0); PG8_BAR; PG8_SCHED;
            PG8_STAGE(PG8_SB(0, 1), b2 + hstep, voffB);
            PG8_WAIT_V(6); PG8_BAR; PG8_MMA(1, 1, At, B1); PG8_BAR;
            PG8_LDB(B0, 1, 0); PG8_SCHED; PG8_LDA(At, 1, 0); PG8_STAGE(PG8_SA(0, 1), a2 + hstep, voffA);
            PG8_WAIT_L(8); PG8_BAR; PG8_WAIT_L(0); PG8_MMA(0, 0, At, B0); PG8_BAR; PG8_SCHED;
            PG8_LDB(B1, 1, 1); PG8_STAGE(PG8_SB(1, 0), b3, voffB);
            PG8_BAR; PG8_WAIT_L(0); PG8_MMA(0, 1, At, B1); PG8_BAR;
            PG8_LDA(At, 1, 1); PG8_STAGE(PG8_SA(1, 0), a3, voffA);
            PG8_BAR; PG8_WAIT_L(0); PG8_MMA(1, 0, At, B0); PG8_BAR; PG8_SCHED;
            PG8_STAGE(PG8_SB(1, 1), b3 + hstep, voffB);
            PG8_WAIT_V(6); PG8_BAR; PG8_MMA(1, 1, At, B1); PG8_BAR;
        }
        { const int t2 = otid(wv); const int l2 = t2 & 63, w2 = __builtin_amdgcn_readfirstlane(t2 >> 6); E(acc, cur, w2 >> 2, w2 & 3, l2 & 15, l2 >> 4); }
        if (!has_next) break;
#pragma unroll
        for (int a = 0; a < 2; ++a)
#pragma unroll
            for (int b = 0; b < 2; ++b)
#pragma unroll
                for (int m = 0; m < 4; ++m)
#pragma unroll
                    for (int n = 0; n < 2; ++n) acc[a][b][m][n] = (f32x4){0.f, 0.f, 0.f, 0.f};
        cur = nxt; cA = nA; cB = nB; ++ui;
    }
    PG8_WAIT_V(0);
    if (wr == 0) PG8_BAR;
    PG8_BAR;
#undef PG8_SA
#undef PG8_SB
#undef PG8_STAGE
#undef PG8_LDA
#undef PG8_LDB
#undef PG8_MMA
#undef PG8_WAIT_V
#undef PG8_WAIT_L
#undef PG8_BAR
#undef PG8_SCHED
}

struct EpiBf16 {
    bf16_t* O; int ldc; bf16_t* O2;
    __device__ __forceinline__ void operator()(const f32x4 (&acc)[2][2][4][2], const Unit& u, int wr, int wc, int fr, int fq) const {
        const int row0 = u.pm * BM + wr * 64 + fr, col0 = u.pn * BM + wc * 32 + 8 * fq;
        bf16_t* Ob = (u.kh == 1) ? O2 : O;
#pragma unroll
        for (int ai = 0; ai < 2; ++ai)
#pragma unroll
            for (int m = 0; m < 4; ++m) { bf16_t* rowp = Ob + (size_t)(row0 + ai * HALF + m * 16) * ldc + col0;
#pragma unroll
                for (int bj = 0; bj < 2; ++bj) { const f32x4 v0 = acc[ai][bj][m][0], v1 = acc[ai][bj][m][1];
                    u32x4 w; w.x = cvt_pk_bf16(v0[0], v0[1]); w.y = cvt_pk_bf16(v0[2], v0[3]); w.z = cvt_pk_bf16(v1[0], v1[1]); w.w = cvt_pk_bf16(v1[2], v1[3]);
                    *(u32x4*)(rowp + bj * HALF) = w; } }
    }
};
struct EpiF32 {
    float* C; int ldc;
    __device__ __forceinline__ void operator()(const f32x4 (&acc)[2][2][4][2], const Unit& u, int wr, int wc, int fr, int fq) const {
        const int row0 = u.pm * BM + wr * 64 + fr, col0 = u.pn * BM + wc * 32 + 4 * fq;
#pragma unroll
        for (int ai = 0; ai < 2; ++ai)
#pragma unroll
            for (int m = 0; m < 4; ++m) { float* rowp = C + (size_t)(row0 + ai * HALF + m * 16) * ldc + col0;
#pragma unroll
                for (int bj = 0; bj < 2; ++bj)
#pragma unroll
                    for (int n = 0; n < 2; ++n) *(f32x4*)(rowp + bj * HALF + n * 16) = acc[ai][bj][m][n]; }
    }
};
struct EpiVT {
    bf16_t* VTs; bf16_t* VTp;
    __device__ __forceinline__ void operator()(const f32x4 (&acc)[2][2][4][2], const Unit& u, int wr, int wc, int fr, int fq) const {
        const int KR0 = u.pn * BM;
        bf16_t* vt; int Lk;
        if (KR0 < BS * LKS) { const int b = KR0 / LKS; Lk = LKS; vt = VTs + (size_t)b * 1024 * LKS + (KR0 - b * LKS); }
        else { const int b = (KR0 - BS * LKS) >> 8; Lk = LP; vt = VTp + (size_t)b * 1024 * LP; }
        const int row0 = u.pm * BM + wr * 64 + fr, col0 = wc * 32 + 8 * fq;
#pragma unroll
        for (int ai = 0; ai < 2; ++ai)
#pragma unroll
            for (int m = 0; m < 4; ++m) { bf16_t* rowp = vt + (size_t)(row0 + ai * HALF + m * 16) * Lk + col0;
#pragma unroll
                for (int bj = 0; bj < 2; ++bj) { const f32x4 v0 = acc[ai][bj][m][0], v1 = acc[ai][bj][m][1];
                    u32x4 w; w.x = cvt_pk_bf16(v0[0], v0[1]); w.y = cvt_pk_bf16(v0[2], v0[3]); w.z = cvt_pk_bf16(v1[0], v1[1]); w.w = cvt_pk_bf16(v1[2], v1[3]);
                    *(u32x4*)(rowp + bj * HALF) = w; } }
    }
};
template <int P> struct EpiGate {
    const bf16_t* gates; float* m32; bf16_t* mbf;
    __device__ __forceinline__ void operator()(const f32x4 (&acc)[2][2][4][2], const Unit& u, int wr, int wc, int fr, int fq) const {
        const int row0 = u.pm * BM + wr * 64 + fr, col0 = u.pn * BM + wc * 32 + 4 * fq;
#pragma unroll
        for (int ai = 0; ai < 2; ++ai)
#pragma unroll
            for (int m = 0; m < 4; ++m) {
                const size_t row = (size_t)(row0 + ai * HALF + m * 16);
#pragma unroll
                for (int bj = 0; bj < 2; ++bj)
#pragma unroll
                    for (int n = 0; n < 2; ++n) {
                        const int col = col0 + bj * HALF + n * 16;
                        const u32x2 gw = *(const u32x2*)(gates + row * GATE_LD + P * 2048 + col);
                        f32x4 v = acc[ai][bj][m][n];
                        v[0] *= sigmoidf_(bf_lo(gw.x)); v[1] *= sigmoidf_(bf_hi(gw.x)); v[2] *= sigmoidf_(bf_lo(gw.y)); v[3] *= sigmoidf_(bf_hi(gw.y));
                        float* mp = m32 + row * 2048 + col;
                        if (P == 0) { *(f32x4*)mp = v; }
                        else if (P == 1) { const f32x4 o = *(const f32x4*)mp; *(f32x4*)mp = o + v; }
                        else { const f32x4 o = *(const f32x4*)mp; v = v + o; u32x2 w; w.x = cvt_pk_bf16(v[0], v[1]); w.y = cvt_pk_bf16(v[2], v[3]); *(u32x2*)(mbf + row * 2048 + col) = w; }
                    }
            }
    }
};
}

template <class Epi>
__device__ __forceinline__ void run_gemm(int wv, LAS unsigned char* lds, const bf16_t* A, const bf16_t* Bt, int M, int N, int K, const Epi& E, bool split = false, int nMper = 1 << 28, size_t bstride = 0, bool rev = false) {
    pg8::Gemm g; g.A = A; g.Bt = Bt; g.M = M; g.N = N; g.K = K; g.nMper = nMper; g.bstride = bstride;
    pg8::StaticOrder S; S.init(M, N, (int)gridDim.x, rev ? (int)gridDim.x - 1 - obid() : obid(), split);
    pg8::gemm_phase<Epi>(wv, lds, g, S, E);
    __syncthreads();
}

__device__ __forceinline__ void convT(int wv, const float* __restrict__ src, int K, int N, bf16_t* __restrict__ dst, int gate_shift, LAS unsigned char* lds) {
    const int tid = otid(wv), lane = tid & 63, kq = lane & 7, ng = lane >> 3;
    const int tn = N / 32, tk = K / 64, ntile = tn * tk, nwaves = gridDim.x * 8;
    for (int tile = obid() * 8 + (tid >> 6); tile < ntile; tile += 2 * nwaves) {
        const int tile2 = tile + nwaves; const bool has2 = tile2 < ntile;
        const int tkk = tile / tn, tnn = tile - tkk * tn, k0 = tkk * 64 + 8 * kq, n0 = tnn * 32 + 4 * ng;
        const int tkk2 = has2 ? tile2 / tn : tkk, tnn2 = has2 ? tile2 - tkk2 * tn : tnn, k02 = tkk2 * 64 + 8 * kq, n02 = tnn2 * 32 + 4 * ng;
        f32x4 v[8], v2[8];
#pragma unroll
        for (int i = 0; i < 8; ++i) v[i] = *(const f32x4*)(src + (size_t)(k0 + i) * N + n0);
#pragma unroll
        for (int i = 0; i < 8; ++i) v2[i] = *(const f32x4*)(src + (size_t)(k02 + i) * N + n02);
#pragma unroll
        for (int j = 0; j < 4; ++j) {
            int nd = n0 + j; if (gate_shift == 1 && nd >= NGATE0) nd += 192; if (gate_shift == 2) { const int hd = nd >> 8, wi = nd & 255; nd = (wi < 128) ? hd * 128 + wi : 1024 + hd * 128 + (wi - 128); }
            u32x4 w; w.x = cvt_pk_bf16(v[0][j], v[1][j]); w.y = cvt_pk_bf16(v[2][j], v[3][j]); w.z = cvt_pk_bf16(v[4][j], v[5][j]); w.w = cvt_pk_bf16(v[6][j], v[7][j]);
            *(u32x4*)(dst + (size_t)nd * K + k0) = w;
        }
        if (has2) {
#pragma unroll
            for (int j = 0; j < 4; ++j) {
                int nd = n02 + j; if (gate_shift == 1 && nd >= NGATE0) nd += 192; if (gate_shift == 2) { const int hd = nd >> 8, wi = nd & 255; nd = (wi < 128) ? hd * 128 + wi : 1024 + hd * 128 + (wi - 128); }
                u32x4 w; w.x = cvt_pk_bf16(v2[0][j], v2[1][j]); w.y = cvt_pk_bf16(v2[2][j], v2[3][j]); w.z = cvt_pk_bf16(v2[4][j], v2[5][j]); w.w = cvt_pk_bf16(v2[6][j], v2[7][j]);
                *(u32x4*)(dst + (size_t)nd * K + k02) = w;
            }
        }
    }
}

__device__ __forceinline__ void ada_phase(int wv, const Params& p, LAS unsigned char* lds) {
    LAS float* sl = (LAS float*)lds;
    float* mod = (float*)(p.ws + S_MOD);
    const int tid = otid(wv);
    for (int u = obid(); u < NLAYER * 6 * 16; u += gridDim.x) {
        const int l = u / 96, r = u % 96, cb = r % 6, kc = r / 6, k0 = kc * 128;
        for (int i = tid; i < 9 * 128; i += NTHREADS) { const int v = i >> 7, k = i & 127; const float x = (v == 0) ? p.in[I_CCTX][k0 + k] : p.in[I_C][(v - 1) * DM + k0 + k]; sl[i] = siluf_(x); }
        __syncthreads();
        const int col = cb * 2048 + tid * 4;
        f32x4 acc[9];
#pragma unroll
        for (int i = 0; i < 9; ++i) acc[i] = (f32x4){0.f, 0.f, 0.f, 0.f};
        const float* wp = p.in[I_ADAW] + ((size_t)l * DM + k0) * 12288 + col;
#pragma unroll 8
        for (int k = 0; k < 128; ++k) {
            const f32x4 w = *(const f32x4*)(wp + (size_t)k * 12288);
#pragma unroll
            for (int i = 0; i < 9; ++i) acc[i] += sl[i * 128 + k] * w;
        }
#pragma unroll
        for (int i = 0; i < 9; ++i) *(f32x4*)(mod + ((size_t)(l * 16 + kc) * 9 + i) * 12288 + col) = acc[i];
        __syncthreads();
    }
}

__device__ __forceinline__ void filter_phase(int wv, const Params& p, int l, LAS unsigned char* lds) {
    LAS float* z = (LAS float*)lds;
    LAS float* H1 = z + 32 * 33;
    LAS float* H2 = H1 + 32 * 64;
    LAS float* W1 = H2 + 32 * 64;
    LAS float* W2 = W1 + 33 * 64;
    LAS float* BF = W2 + 64 * 64;
    const int tid = otid(wv);
    const float* w3 = p.in[I_FW3] + (size_t)l * 64 * 2048; const float* b3 = p.in[I_FB3] + l * 2048;
    for (int u = obid(); u < 72; u += gridDim.x) {
        const int g = (u < 64) ? 1 : 0; const int tc = g ? u : u - 64; const int L = g ? LS : LP; const int t0 = tc * 32;
        float* kT = (float*)(p.ws + (g ? S_KTS : S_KTP)); float* part = (float*)(p.ws + (g ? S_PARTS : S_PARTP));
        for (int i = tid; i < 33 * 64; i += NTHREADS) W1[i] = p.in[I_FW1][(size_t)l * 33 * 64 + i];
        for (int i = tid; i < 64 * 64; i += NTHREADS) W2[i] = p.in[I_FW2][(size_t)l * 64 * 64 + i];
        if (tid < 64) BF[tid] = p.in[I_FB1][l * 64 + tid]; else if (tid < 128) BF[tid] = p.in[I_FB2][l * 64 + tid - 64]; else if (tid < 256) BF[tid] = p.in[I_FFREQ][l * 128 + tid - 128];
        for (int i = tid; i < 32 * 33; i += NTHREADS) {
            const int t = i / 33, e = i - t * 33; const float tf = (float)(t0 + t);
            float v;
            if (e == 0) v = tf / (float)(L - 1);
            else { const int k = (e - 1) & 15; const float band = 1e-4f + (float)k * ((15.0f - 1e-4f) / 15.0f); const float w = (6.283185307179586f * tf) / (float)L; const float ang = w * band;
                   v = (e <= 16) ? cosf(ang) : -sinf(ang); }
            z[i] = v;
        }
        __syncthreads();
#pragma unroll
        for (int q = 0; q < 4; ++q) { const int i = tid + q * NTHREADS; const int t = i >> 6, j = i & 63; float s = BF[j];
#pragma unroll
            for (int e = 0; e < 33; ++e) s += z[t * 33 + e] * W1[e * 64 + j];
            H1[i] = sinf(BF[128 + j] * s); }
        __syncthreads();
#pragma unroll
        for (int q = 0; q < 4; ++q) { const int i = tid + q * NTHREADS; const int t = i >> 6, j = i & 63; float s = BF[64 + j];
#pragma unroll 16
            for (int e = 0; e < 64; ++e) s += H1[t * 64 + e] * W2[e * 64 + j];
            H2[i] = sinf(BF[192 + j] * s); }
        __syncthreads();
        const int c = tid * 4;
        const f32x4 bias = *(const f32x4*)(b3 + c);
        f32x4 delta;
#pragma unroll
        for (int j = 0; j < 4; ++j) { const int d = (c + j) & 1023; const float mn = -3.0701134573253945f, mx = -15.350567286626973f; delta[j] = fabsf(mn + (float)d * ((mx - mn) / 1023.0f)); }
        f32x4 psum = (f32x4){0.f, 0.f, 0.f, 0.f};
        for (int tb = 0; tb < 2; ++tb) {
            f32x4 acc[16];
#pragma unroll
            for (int i = 0; i < 16; ++i) acc[i] = bias;
#pragma unroll 8
            for (int k = 0; k < 64; ++k) {
                const f32x4 w = *(const f32x4*)(w3 + (size_t)k * 2048 + c);
#pragma unroll
                for (int i = 0; i < 16; ++i) acc[i] += H2[(tb * 16 + i) * 64 + k] * w;
            }
#pragma unroll
            for (int i = 0; i < 16; ++i) {
                const int t = t0 + tb * 16 + i; const float tn = (float)t / (float)(L - 1);
#pragma unroll
                for (int j = 0; j < 4; ++j) {
                    const float v = acc[i][j] * __expf(-tn * delta[j]);
                    const int cc = c + j;
                    if (cc < 1024) { kT[(size_t)cc * (2 * L) + t] = v; psum[j] += fabsf(v); }
                    else { const int d = cc - 1024; if (t == 0) kT[(size_t)d * (2 * L) + L] = 0.f; else { kT[(size_t)d * (2 * L) + 2 * L - t] = v; psum[j] += fabsf(v); } }
                }
            }
        }
        *(f32x4*)(part + (size_t)tc * 2048 + c) = psum;
        __syncthreads();
    }
}

__device__ __forceinline__ void row_sel(const Params& p, int l, int mode, int& l2, int& shi, int& sci, const float*& prew, bool& wh, int& gi, const float*& pw) {
    wh = true;
    if (mode == 0) { l2 = l; shi = 0; sci = 1; prew = p.in[I_NMPRE] + l * DM; }
    else if (mode == 1) { l2 = l; shi = 3; sci = 4; prew = p.in[I_NFPRE] + l * DM; }
    else { l2 = l + 1; shi = 0; sci = 1; wh = (l + 1 < NLAYER); if (!wh) l2 = l; prew = p.in[I_NMPRE] + l2 * DM; }
    gi = (mode == 1) ? 2 : 5;
    pw = p.in[mode == 1 ? I_NMPOST : I_NFPOST] + l * DM;
}
__device__ __forceinline__ void comb_phase(int wv, const Params& p) {
    const int tid = otid(wv);
    const float* mod = (const float*)(p.ws + S_MOD); float* comb = (float*)(p.ws + S_COMB);
    for (int idx = obid() * NTHREADS + tid; idx < NLAYER * 3 * 9 * 2048; idx += gridDim.x * NTHREADS) {
        const int c = idx & 2047, q = idx >> 11, mi = q % 9, q2 = q / 9, mode = q2 % 3, l = q2 / 3;
        int l2, shi, sci, gi; const float* prew; const float* pw; bool wh;
        row_sel(p, l, mode, l2, shi, sci, prew, wh, gi, pw);
        float g = 0.f, sc = 0.f, sh = 0.f;
        for (int kc = 0; kc < 16; ++kc) {
            g += mod[((size_t)(l * 16 + kc) * 9 + mi) * 12288 + gi * 2048 + c];
            sc += mod[((size_t)(l2 * 16 + kc) * 9 + mi) * 12288 + sci * 2048 + c];
            sh += mod[((size_t)(l2 * 16 + kc) * 9 + mi) * 12288 + shi * 2048 + c];
        }
        g += p.in[I_ADAB][(size_t)l * 12288 + gi * 2048 + c];
        sc += p.in[I_ADAB][(size_t)l2 * 12288 + sci * 2048 + c];
        sh += p.in[I_ADAB][(size_t)l2 * 12288 + shi * 2048 + c];
        float* o = comb + (size_t)q * 3 * 2048 + c;
        o[0] = g * pw[c]; o[2048] = prew[c] * (1.0f + sc); o[4096] = sh;
    }
}
__device__ __forceinline__ void row_phase(int wv, const Params& p, int l, int mode) {
    const int tid = otid(wv); const int wave = obid() * 8 + (tid >> 6), nw = gridDim.x * 8, lane = tid & 63;
    float* X = p.out;
    bf16_t* H = (bf16_t*)(p.ws + A_H);
    const bool wh = !(mode == 2 && l + 1 >= NLAYER);
    const int rows_per = (MT + nw - 1) / nw;
    int cur_mi = -1; f32x4 cpre[8], csh[8], cgv[8];
    for (int rr = 0; rr < rows_per; ++rr) {
        const int row = wave * rows_per + rr;
        if (row >= MT) break;
        const int mi = row < MP ? 0 : 1 + ((row - MP) >> 11);
        const float* cb = (const float*)(p.ws + S_COMB) + (size_t)((l * 3 + mode) * 9 + mi) * 3 * 2048 + lane * 4;
        if (mi != cur_mi) { cur_mi = mi;
#pragma unroll
            for (int i = 0; i < 8; ++i) { cpre[i] = *(const f32x4*)(cb + 2048 + i * 256); csh[i] = *(const f32x4*)(cb + 4096 + i * 256); if (mode != 0) cgv[i] = *(const f32x4*)(cb + i * 256); } }
        f32x4 x[8];
        const float* xs = (mode == 0) ? (row < MP ? p.in[I_XP] + (size_t)row * DM : p.in[I_XS] + (size_t)(row - MP) * DM) : X + (size_t)row * DM;
#pragma unroll
        for (int i = 0; i < 8; ++i) x[i] = *(const f32x4*)(xs + i * 256 + lane * 4);
        if (mode != 0) {
            const bf16_t* o = (const bf16_t*)(p.ws + (mode == 1 ? A_M32 : A_F32)) + (size_t)row * DM;
            const unsigned tm = ((const unsigned*)(p.ws + S_TAIL))[row >> 8];
            f32x4 ovv[8]; float ss = 0.f;
#pragma unroll
            for (int i = 0; i < 8; ++i) { const u32x2 w = *(const u32x2*)(o + i * 256 + lane * 4); ovv[i] = (f32x4){bf_lo(w.x), bf_hi(w.x), bf_lo(w.y), bf_hi(w.y)};
                if ((tm >> i) & 1u) { const u32x2 w2 = *(const u32x2*)(o + (size_t)MT * DM + i * 256 + lane * 4); ovv[i] += (f32x4){bf_lo(w2.x), bf_hi(w2.x), bf_lo(w2.y), bf_hi(w2.y)}; }
                ss += ovv[i][0] * ovv[i][0] + ovv[i][1] * ovv[i][1] + ovv[i][2] * ovv[i][2] + ovv[i][3] * ovv[i][3]; }
            ss = wave_sum(ss, lane);
            const float rstd = rsqrtf(ss * (1.0f / DM) + 1e-6f);
#pragma unroll
            for (int i = 0; i < 8; ++i) x[i] += cgv[i] * (ovv[i] * rstd);
        }
#pragma unroll
        for (int i = 0; i < 8; ++i) *(f32x4*)(X + (size_t)row * DM + i * 256 + lane * 4) = x[i];
        if (wh) {
            float ss = 0.f;
#pragma unroll
            for (int i = 0; i < 8; ++i) ss += x[i][0] * x[i][0] + x[i][1] * x[i][1] + x[i][2] * x[i][2] + x[i][3] * x[i][3];
            ss = wave_sum(ss, lane);
            const float rstd = rsqrtf(ss * (1.0f / DM) + 1e-6f);
#pragma unroll
            for (int i = 0; i < 8; ++i) {
                const f32x4 hv = (x[i] * rstd) * cpre[i] + csh[i];
                u32x2 o; o.x = cvt_pk_bf16(hv[0], hv[1]); o.y = cvt_pk_bf16(hv[2], hv[3]);
                *(u32x2*)(H + (size_t)row * DM + i * 256 + lane * 4) = o;
            }
        }
    }
}

__device__ __forceinline__ void rope_table_phase(int wv, const Params& p) {
    float* C = (float*)(p.ws + S_ROPE); float* Sn = C + 2048 * 32;
    const int tid = otid(wv);
    for (int idx = obid() * NTHREADS + tid; idx < 2048 * 32; idx += gridDim.x * NTHREADS) {
        const int t = idx >> 5, i = idx & 31, k = i & 15;
        const float inv = exp2f(-(float)k * 0.8304820237218406f);
        const float pos = (i < 16) ? (float)(t >> 6) : (float)(t & 63);
        const float ang = pos * inv; C[idx] = cosf(ang); Sn[idx] = sinf(ang);
    }
}
__device__ __forceinline__ void e2_phase(int wv, const Params& p, int l, LAS unsigned char* lds) {
    const bf16_t* PA = (const bf16_t*)(p.ws + A_PROJA);
    const int tid = otid(wv), lane = tid & 63;
    {
        for (int gw = obid() * 8 + (tid >> 6); gw < 2048; gw += gridDim.x * 8) {
            const int g = gw >> 10, d = gw & 1023; const int NU = g ? 64 : 8;
            const float* part = (const float*)(p.ws + (g ? S_PARTS : S_PARTP));
            float v = 0.f;
            if (lane < NU) v = part[lane * 2048 + d] + part[lane * 2048 + 1024 + d];
            v = wave_sum(v, lane);
            if (lane == 0) ((float*)(p.ws + S_SCALE))[gw] = 1.0f / v;
        }
    }
    {
        bf16_t* CQN = (bf16_t*)(p.ws + A_CQN); bf16_t* KC = (bf16_t*)(p.ws + A_KEYSC); bf16_t* KP = (bf16_t*)(p.ws + A_KPER);
        float* out_ckv = p.out + (size_t)MT * DM; float* out_kpe = out_ckv + (size_t)BP * NLAYER * LP * 256;
        const int wave = obid() * 8 + (tid >> 6), nw = gridDim.x * 8;
        for (int row = wave; row < MT + BS * PAST; row += nw) {
            if (row < MT) {
                const bf16_t* pr = PA + (size_t)row * PA_LD;
                { const u32x4 v = *(const u32x4*)(pr + 3072 + lane * 8); float f[8]; unpack8(v, f); float ss = 0.f;
#pragma unroll
                  for (int j = 0; j < 8; ++j) ss += f[j] * f[j];
                  ss = wave_sum(ss, lane); const float rstd = rsqrtf(ss * (1.0f / 512.0f) + 1e-6f);
                  const float* qn = p.in[I_QN] + l * 512 + lane * 8;
#pragma unroll
                  for (int j = 0; j < 8; ++j) f[j] = f[j] * rstd * qn[j];
                  *(u32x4*)(CQN + (size_t)row * 512 + lane * 8) = pack8(f); }
                int KR, t; const bool isp = row < MP; int b;
                if (isp) { b = row >> 8; t = row & 255; KR = BS * LKS + row; } else { const int r2 = row - MP; b = r2 >> 11; t = r2 & 2047; KR = b * LKS + t; }
                { const u32x2 v = *(const u32x2*)(pr + 3584 + lane * 4); float f[4] = {bf_lo(v.x), bf_hi(v.x), bf_lo(v.y), bf_hi(v.y)};
                  float ss = f[0] * f[0] + f[1] * f[1] + f[2] * f[2] + f[3] * f[3]; ss = wave_sum(ss, lane); const float rstd = rsqrtf(ss * (1.0f / 256.0f) + 1e-6f);
                  const float* kn = p.in[I_KVN] + l * 256 + lane * 4;
#pragma unroll
                  for (int j = 0; j < 4; ++j) f[j] = f[j] * rstd * kn[j];
                  if (isp) *(f32x4*)(out_ckv + ((size_t)(b * NLAYER + l) * LP + t) * 256 + lane * 4) = (f32x4){f[0], f[1], f[2], f[3]};
                  u32x2 w; w.x = cvt_pk_bf16(f[0], f[1]); w.y = cvt_pk_bf16(f[2], f[3]); *(u32x2*)(KC + (size_t)KR * 256 + lane * 4) = w; }
                { const float v = __uint_as_float(((unsigned)pr[3840 + lane]) << 16);
                  float o = v;
                  if (isp) out_kpe[((size_t)(b * NLAYER + l) * LP + t) * 64 + lane] = v;
                  else { const float pv = shx(v, 32, lane); const float* rc = (const float*)(p.ws + S_ROPE); const float cs = rc[t * 32 + (lane & 31)], sn = rc[2048 * 32 + t * 32 + (lane & 31)]; o = (lane < 32) ? (v * cs - pv * sn) : (pv * sn + v * cs); }
                  KP[(size_t)KR * 64 + lane] = f2bf(o); }
            } else {
                const int r2 = row - MT, b = r2 >> 9, j = r2 & 511; const int KR = b * LKS + LS + j;
                const float* cc = p.in[I_CCKV] + ((size_t)(b * NLAYER + l) * PAST + j) * 256 + lane * 4;
                const f32x4 v = *(const f32x4*)cc; u32x2 w; w.x = cvt_pk_bf16(v[0], v[1]); w.y = cvt_pk_bf16(v[2], v[3]); *(u32x2*)(KC + (size_t)KR * 256 + lane * 4) = w;
                KP[(size_t)KR * 64 + lane] = f2bf(p.in[I_CKPE][((size_t)(b * NLAYER + l) * PAST + j) * 64 + lane]);
            }
        }
    }
    {
        bf16_t* YC = (bf16_t*)(p.ws + A_YC); const float* scw = p.in[I_SCW] + (size_t)l * 3 * 1024;
        float w0[8], w1[8], w2[8]; int cur_d0 = -1;
        for (int it = obid() * NTHREADS + tid; it < (MT / 4) * 128; it += gridDim.x * NTHREADS) {
            const int ch = it >> 7, d0 = (it & 127) * 8, row0 = ch * 4;
            const int t0 = row0 < MP ? (row0 & 255) : ((row0 - MP) & 2047); const int L = row0 < MP ? LP : LS;
            if (d0 != cur_d0) { cur_d0 = d0; const f32x4 a = *(const f32x4*)(scw + d0), b = *(const f32x4*)(scw + d0 + 4), c = *(const f32x4*)(scw + 1024 + d0), d = *(const f32x4*)(scw + 1024 + d0 + 4),
                          e2 = *(const f32x4*)(scw + 2048 + d0), f = *(const f32x4*)(scw + 2048 + d0 + 4);
#pragma unroll
              for (int j = 0; j < 4; ++j) { w0[j] = a[j]; w0[4 + j] = b[j]; w1[j] = c[j]; w1[4 + j] = d[j]; w2[j] = e2[j]; w2[4 + j] = f[j]; } }
            const bf16_t* pr = PA + (size_t)row0 * PA_LD;
            float pp[8], pc[8], pn[8];
#pragma unroll
            for (int j = 0; j < 8; ++j) pp[j] = 0.f;
            if (t0 > 0) { float cg[8], uu[8]; unpack8(*(const u32x4*)(pr - PA_LD + 4928 + d0), cg); unpack8(*(const u32x4*)(pr - PA_LD + 5952 + d0), uu);
#pragma unroll
                for (int j = 0; j < 8; ++j) pp[j] = cg[j] * uu[j]; }
            { float cg[8], uu[8]; unpack8(*(const u32x4*)(pr + 4928 + d0), cg); unpack8(*(const u32x4*)(pr + 5952 + d0), uu);
#pragma unroll
              for (int j = 0; j < 8; ++j) pc[j] = cg[j] * uu[j]; }
#pragma unroll
            for (int i = 0; i < 4; ++i) {
#pragma unroll
                for (int j = 0; j < 8; ++j) pn[j] = 0.f;
                if (t0 + i + 1 < L) { float cg[8], uu[8]; unpack8(*(const u32x4*)(pr + (size_t)(i + 1) * PA_LD + 4928 + d0), cg); unpack8(*(const u32x4*)(pr + (size_t)(i + 1) * PA_LD + 5952 + d0), uu);
#pragma unroll
                    for (int j = 0; j < 8; ++j) pn[j] = cg[j] * uu[j]; }
                float bg[8], o[8]; unpack8(*(const u32x4*)(pr + (size_t)i * PA_LD + 3904 + d0), bg);
#pragma unroll
                for (int j = 0; j < 8; ++j) { o[j] = bg[j] * (w0[j] * pp[j] + w1[j] * pc[j] + w2[j] * pn[j]); pp[j] = pc[j]; pc[j] = pn[j]; }
                *(u32x4*)(YC + (size_t)(row0 + i) * 1024 + d0) = pack8(o);
            }
        }
    }
    {
        bf16_t* X0S = (bf16_t*)(p.ws + A_X0S); bf16_t* ZZT = (bf16_t*)(p.ws + A_ZZT);
        const float* hw = p.in[I_HCW] + (size_t)l * 3 * 3072; const float* hb = p.in[I_HCB] + (size_t)l * 3072;
        LAS bf16_t* zt = (LAS bf16_t*)lds;
        float wgt[3][3][8], bs[3][8]; int cur_dt = -1;
        for (int u = obid(); u < (MT / 256) * 16; u += gridDim.x) {
            const int rt = u >> 4, dt = u & 15; const int row0 = rt * 256;
            const int dg = tid & 7, rb = tid >> 3, d0 = dt * 64 + dg * 8; const int rowb = row0 + rb * 4;
            const int L = row0 < MP ? LP : LS; const int tb = (row0 < MP ? (row0 & 255) : ((row0 - MP) & 2047)) + rb * 4;
            const bool reload = (dt != cur_dt); cur_dt = dt;
            if (reload)
#pragma unroll
            for (int g = 0; g < 3; ++g) {
#pragma unroll
                for (int o = 0; o < 3; ++o) { const f32x4 a = *(const f32x4*)(hw + o * 3072 + g * 1024 + d0), b = *(const f32x4*)(hw + o * 3072 + g * 1024 + d0 + 4);
#pragma unroll
                    for (int j = 0; j < 4; ++j) { wgt[g][o][j] = a[j]; wgt[g][o][4 + j] = b[j]; } }
                const f32x4 a = *(const f32x4*)(hb + g * 1024 + d0), b = *(const f32x4*)(hb + g * 1024 + d0 + 4);
#pragma unroll
                for (int j = 0; j < 4; ++j) { bs[g][j] = a[j]; bs[g][4 + j] = b[j]; }
            }
            const bf16_t* pr = PA + (size_t)rowb * PA_LD + d0;
            u32x4 wp[3], wc[3], wn[3];
#pragma unroll
            for (int g = 0; g < 3; ++g) { wp[g] = (u32x4){0u, 0u, 0u, 0u}; if (tb > 0) wp[g] = *(const u32x4*)(pr - PA_LD + g * 1024); wc[g] = *(const u32x4*)(pr + g * 1024); }
#pragma unroll
            for (int i = 0; i < 4; ++i) {
#pragma unroll
                for (int g = 0; g < 3; ++g) { wn[g] = (u32x4){0u, 0u, 0u, 0u}; if (tb + i + 1 < L) wn[g] = *(const u32x4*)(pr + (size_t)(i + 1) * PA_LD + g * 1024); }
                float hv[3][8];
#pragma unroll
                for (int g = 0; g < 3; ++g) { float a[8], b[8], c[8]; unpack8(wp[g], a); unpack8(wc[g], b); unpack8(wn[g], c);
#pragma unroll
                    for (int j = 0; j < 8; ++j) hv[g][j] = bs[g][j] + wgt[g][0][j] * a[j] + wgt[g][1][j] * b[j] + wgt[g][2][j] * c[j];
                    wp[g] = wc[g]; wc[g] = wn[g]; }
                *(u32x4*)(X0S + (size_t)(rowb + i) * 1024 + d0) = pack8(hv[0]);
#pragma unroll
                for (int j = 0; j < 8; ++j) zt[(dg * 8 + j) * 264 + rb * 4 + i] = f2bf(hv[1][j] * hv[2][j]);
            }
            __syncthreads();
#pragma unroll
            for (int i = 0; i < 4; ++i) {
                const int chunk = tid + i * NTHREADS; const int dl = chunk >> 5, tch = chunk & 31; const int d = dt * 64 + dl;
                size_t base; int t0;
                if (row0 < MP) { const int b = row0 >> 8; t0 = 0; base = ((size_t)b * 1024 + d) * LP; }
                else { const int r2 = row0 - MP; const int b = r2 >> 11; t0 = r2 & 2047; base = (size_t)BP * 1024 * LP + ((size_t)b * 1024 + d) * LS; }
                *(u32x4*)(ZZT + base + t0 + tch * 8) = *(const LAS u32x4*)(zt + dl * 264 + tch * 8);
            }
            __syncthreads();
        }
    }
}

__device__ __forceinline__ void conv_phase(int wv, const Params& p, int l, LAS unsigned char* lds) {
    const int tid = otid(wv), wid = tid >> 6, lane = tid & 63, r = lane & 31, hh = lane >> 5;
    const bf16_t* ZZT = (const bf16_t*)(p.ws + A_ZZT); bf16_t* YCT = (bf16_t*)(p.ws + A_YCT);
    const float* hbias = p.in[I_HBIAS] + l * 1024;
    LAS bf16_t* cp = (LAS bf16_t*)lds;
    LAS bf16_t* zz = (LAS bf16_t*)(lds + 65536);
    LAS float* kf = (LAS float*)(lds + 98304);
    for (int u = obid(); u < 2048; u += gridDim.x) {
        const int g = (u < 1024) ? 1 : 0, d = u & 1023;
        const int L = g ? LS : LP, B = g ? BS : BP, L2 = 2 * L, NB = L / 32, NI = 32 / B, NT = NB / NI, lgB = g ? 3 : 4;
        const float* kT = (const float*)(p.ws + (g ? S_KTS : S_KTP)) + (size_t)d * L2;
        const float scale = ((const float*)(p.ws + S_SCALE))[g * 1024 + d]; const float bias = hbias[d];
        for (int i = tid; i < L2 / 4; i += NTHREADS) { f32x4 v = *(const f32x4*)(kT + i * 4); v *= scale; if (i == 0) v[0] += bias; *(LAS f32x4*)(kf + i * 4) = v; }
        const size_t zbase = g ? (size_t)BP * 1024 * LP : 0;
        for (int ch = tid; ch < B * L / 8; ch += NTHREADS) {
            const int b = ch / (L / 8), s8 = ch - b * (L / 8);
            *(LAS u32x4*)(zz + b * L + s8 * 8) = *(const u32x4*)(ZZT + zbase + ((size_t)b * 1024 + d) * L + s8 * 8);
        }
        __syncthreads();
        for (int ck = tid; ck < L2; ck += NTHREADS) {
            const int c = ck / (L2 / 8), m0 = (ck - c * (L2 / 8)) * 8;
            float f[8];
#pragma unroll
            for (int j = 0; j < 8; ++j) f[j] = kf[(L2 - (m0 + c + j)) & (L2 - 1)];
            *(LAS u32x4*)(cp + c * L2 + m0) = pack8(f);
        }
        __syncthreads();
        const int Iloc = r >> lgB, b = r & (B - 1);
        for (int nt = wid * 2; nt < NT; nt += 16) {
            const int I0 = nt * NI;
            f32x16 acc0, acc1;
#pragma unroll
            for (int i = 0; i < 16; ++i) { acc0[i] = 0.f; acc1[i] = 0.f; }
            const bf16x8 zero8 = (bf16x8){0, 0, 0, 0, 0, 0, 0, 0};
            bf16x8 prev[4][2];
#pragma unroll
            for (int i = 0; i < 4; ++i) { prev[i][0] = zero8; prev[i][1] = zero8; }
            const int dl0 = I0 - (NB - 1), nsteps = NB + 2 * NI - 1;
            if (NI == 4) {
                for (int c4 = 0; c4 < nsteps; c4 += 4) {
                    bf16x8 cur[4][2];
#pragma unroll
                    for (int i = 0; i < 4; ++i) {
                        const int dl = dl0 + c4 + i; const int J0 = I0 + Iloc - dl; const bool v0 = (J0 >= 0) && (J0 < NB);
#pragma unroll
                        for (int ks = 0; ks < 2; ++ks) {
                            const int i0 = (16 * ks + 8 * hh - 32 * dl - r) & (L2 - 1); const int c = i0 & 7, q = i0 >> 3;
                            const bf16x8 Af = *(const LAS bf16x8*)(cp + c * L2 + q * 8);
                            cur[i][ks] = zero8;
                            if (v0) cur[i][ks] = *(const LAS bf16x8*)(zz + b * L + 32 * J0 + 16 * ks + 8 * hh);
                            acc0 = __builtin_amdgcn_mfma_f32_32x32x16_bf16(Af, cur[i][ks], acc0, 0, 0, 0);
                            acc1 = __builtin_amdgcn_mfma_f32_32x32x16_bf16(Af, prev[i][ks], acc1, 0, 0, 0);
                        }
                    }
#pragma unroll
                    for (int i = 0; i < 4; ++i) { prev[i][0] = cur[i][0]; prev[i][1] = cur[i][1]; }
                }
            } else {
                for (int c2 = 0; c2 < nsteps + 1; c2 += 2) {
                    bf16x8 cur[2][2];
#pragma unroll
                    for (int i = 0; i < 2; ++i) {
                        const int dl = dl0 + c2 + i; const int J0 = I0 + Iloc - dl; const bool v0 = (J0 >= 0) && (J0 < NB);
#pragma unroll
                        for (int ks = 0; ks < 2; ++ks) {
                            const int i0 = (16 * ks + 8 * hh - 32 * dl - r) & (L2 - 1); const int c = i0 & 7, q = i0 >> 3;
                            const bf16x8 Af = *(const LAS bf16x8*)(cp + c * L2 + q * 8);
                            cur[i][ks] = zero8;
                            if (v0) cur[i][ks] = *(const LAS bf16x8*)(zz + b * L + 32 * J0 + 16 * ks + 8 * hh);
                            acc0 = __builtin_amdgcn_mfma_f32_32x32x16_bf16(Af, cur[i][ks], acc0, 0, 0, 0);
                            acc1 = __builtin_amdgcn_mfma_f32_32x32x16_bf16(Af, prev[i][ks], acc1, 0, 0, 0);
                        }
                    }
#pragma unroll
                    for (int i = 0; i < 2; ++i) { prev[i][0] = cur[i][0]; prev[i][1] = cur[i][1]; }
                }
            }
            bf16_t* op = YCT + zbase + ((size_t)b * 1024 + d) * L + 32 * (I0 + Iloc) + 4 * hh;
#pragma unroll
            for (int g4 = 0; g4 < 4; ++g4) {
                u32x2 w; w.x = cvt_pk_bf16(acc0[4 * g4], acc0[4 * g4 + 1]); w.y = cvt_pk_bf16(acc0[4 * g4 + 2], acc0[4 * g4 + 3]); *(u32x2*)(op + 8 * g4) = w;
                u32x2 w1; w1.x = cvt_pk_bf16(acc1[4 * g4], acc1[4 * g4 + 1]); w1.y = cvt_pk_bf16(acc1[4 * g4 + 2], acc1[4 * g4 + 3]); *(u32x2*)(op + 32 * NI + 8 * g4) = w1;
            }
        }
        __syncthreads();
    }
}

__device__ __forceinline__ void e3b_phase(int wv, const Params& p, LAS unsigned char* lds) {
    const int tid = otid(wv);
    const bf16_t* X0S = (const bf16_t*)(p.ws + A_X0S); const bf16_t* YCT = (const bf16_t*)(p.ws + A_YCT); bf16_t* YA = (bf16_t*)(p.ws + A_YA);
    LAS bf16_t* yt = (LAS bf16_t*)lds;
    for (int u = obid(); u < (MT / 64) * 16; u += gridDim.x) {
        const int rt = u >> 4, dt = u & 15; const int row0 = rt * 64;
        {
            const int dl = tid >> 3, tch = tid & 7; const int d = dt * 64 + dl;
            size_t base; int t0;
            if (row0 < MP) { const int b = row0 >> 8; t0 = row0 & 255; base = ((size_t)b * 1024 + d) * LP; }
            else { const int r2 = row0 - MP; const int b = r2 >> 11; t0 = r2 & 2047; base = (size_t)BP * 1024 * LP + ((size_t)b * 1024 + d) * LS; }
            const u32x4 v = *(const u32x4*)(YCT + base + t0 + tch * 8);
            const unsigned w[4] = {v.x, v.y, v.z, v.w};
#pragma unroll
            for (int j = 0; j < 4; ++j) { yt[(tch * 8 + 2 * j) * 72 + dl] = (bf16_t)(w[j] & 0xffffu); yt[(tch * 8 + 2 * j + 1) * 72 + dl] = (bf16_t)(w[j] >> 16); }
        }
        __syncthreads();
        {
            const int tl = tid >> 3, dg = tid & 7; const int row = row0 + tl, d0 = dt * 64 + dg * 8;
            float a[8], b[8]; unpack8(*(const LAS u32x4*)(yt + tl * 72 + dg * 8), a); unpack8(*(const u32x4*)(X0S + (size_t)row * 1024 + d0), b);
#pragma unroll
            for (int j = 0; j < 8; ++j) a[j] *= b[j];
            *(u32x4*)(YA + (size_t)row * 1024 + d0) = pack8(a);
        }
        __syncthreads();
    }
}

__device__ __forceinline__ void attn_phase(int wv, const Params& p, LAS unsigned char* lds) {
    const bf16_t* Q = (const bf16_t*)(p.ws + A_Q); const bf16_t* KN = (const bf16_t*)(p.ws + A_KN); const bf16_t* KP = (const bf16_t*)(p.ws + A_KPER);
    const bf16_t* VT = (const bf16_t*)(p.ws + A_VT); bf16_t* O = (bf16_t*)(p.ws + A_OATT);
    LAS unsigned char* Ks = lds;
    LAS unsigned char* Vs = lds + 64 * 400;
    const float sc2 = 0.07216878364870322f * 1.4426950408889634f;
    for (int u0 = obid(); u0 < 512 + 128; u0 += gridDim.x) {
        const int tid = otid(wv), wid = tid >> 6, lane = tid & 63, r = lane & 31, hh = lane >> 5;
        int u = u0;
        if (u0 < 512 && gridDim.x == 256) {
            const int c = u0 & 255, xcd = c & 7, j = c >> 3; u = (u0 & ~255) + ((xcd * 4 + (j >> 3)) * 8 + (j & 7));
        }
        int b, h, row0, Lk, KR0; size_t vtb; bool samp;
        if (u < 512) { samp = true; b = u >> 6; h = (u >> 3) & 7; const int qb = u & 7; row0 = MP + b * LS + qb * 256; Lk = LKS; KR0 = b * LKS; vtb = (size_t)(b * 8 + h) * 128 * LKS; }
        else { samp = false; const int u2 = u - 512; b = u2 >> 3; h = u2 & 7; row0 = b * LP; Lk = LP; KR0 = BS * LKS + b * LP; vtb = (size_t)BS * 8 * 128 * LKS + (size_t)(b * 8 + h) * 128 * LP; }
        const int qrow = row0 + wid * 32 + r;
        bf16x8 qf[12];
        {
            const bf16_t* qp = Q + (size_t)qrow * 1536 + h * 192 + 8 * hh;
            u32x4 qv[12];
#pragma unroll
            for (int s = 0; s < 12; ++s) qv[s] = *(const u32x4*)(qp + 16 * s);
            if (samp) {
                const int t = (qrow - MP) & 2047;
#pragma unroll
                for (int s2 = 0; s2 < 2; ++s2) {
                    float x1[8], x2[8]; unpack8(qv[8 + s2], x1); unpack8(qv[10 + s2], x2);
                    const float* rc = (const float*)(p.ws + S_ROPE) + t * 32 + 16 * s2 + 8 * hh;
                    const f32x4 c0 = *(const f32x4*)rc, c1 = *(const f32x4*)(rc + 4), s0 = *(const f32x4*)(rc + 2048 * 32), s1 = *(const f32x4*)(rc + 2048 * 32 + 4);
#pragma unroll
                    for (int j = 0; j < 8; ++j) { const float cs = (j < 4) ? c0[j & 3] : c1[j & 3], sn = (j < 4) ? s0[j & 3] : s1[j & 3]; const float a = x1[j], c = x2[j]; x1[j] = a * cs - c * sn; x2[j] = a * sn + c * cs; }
                    qv[8 + s2] = pack8(x1); qv[10 + s2] = pack8(x2);
                }
            }
#pragma unroll
            for (int s = 0; s < 12; ++s) qf[s] = __builtin_bit_cast(bf16x8, qv[s]);
        }
        f32x16 oacc[4];
#pragma unroll
        for (int ct = 0; ct < 4; ++ct)
#pragma unroll
            for (int i = 0; i < 16; ++i) oacc[ct][i] = 0.f;
        float mrun = -1e30f, lrun = 0.f;
        const int nkt = Lk / 64;
        u32x4 kst[3], vst[2];
#pragma unroll
        for (int i = 0; i < 3; ++i) { const int ck = tid + i * NTHREADS; const int key = ck / 24, part = ck - key * 24;
            kst[i] = (part < 16) ? *(const u32x4*)(KN + (size_t)(KR0 + key) * 1024 + h * 128 + part * 8) : *(const u32x4*)(KP + (size_t)(KR0 + key) * 64 + (part - 16) * 8); }
#pragma unroll
        for (int i = 0; i < 2; ++i) { const int cv = tid + i * NTHREADS; const int v = cv >> 3, kc = cv & 7; vst[i] = *(const u32x4*)(VT + vtb + (size_t)v * Lk + kc * 8); }
        for (int kt = 0; kt < nkt; ++kt) {
            __syncthreads();
#pragma unroll
            for (int i = 0; i < 3; ++i) { const int ck = tid + i * NTHREADS; const int key = ck / 24, part = ck - key * 24; *(LAS u32x4*)(Ks + key * 400 + part * 16) = kst[i]; }
#pragma unroll
            for (int i = 0; i < 2; ++i) { const int cv = tid + i * NTHREADS; const int v = cv >> 3, kc = cv & 7;
                LAS unsigned char* vp = Vs + v * 144 + (kc >> 1) * 32 + (kc & 1) * 8;
                *(LAS u32x2*)vp = (u32x2){vst[i].x, vst[i].y}; *(LAS u32x2*)(vp + 16) = (u32x2){vst[i].z, vst[i].w}; }
            __syncthreads();
            if (kt + 1 < nkt) {
                const int k0 = (kt + 1) * 64;
#pragma unroll
                for (int i = 0; i < 3; ++i) { const int ck = tid + i * NTHREADS; const int key = ck / 24, part = ck - key * 24;
                    kst[i] = (part < 16) ? *(const u32x4*)(KN + (size_t)(KR0 + k0 + key) * 1024 + h * 128 + part * 8) : *(const u32x4*)(KP + (size_t)(KR0 + k0 + key) * 64 + (part - 16) * 8); }
#pragma unroll
                for (int i = 0; i < 2; ++i) { const int cv = tid + i * NTHREADS; const int v = cv >> 3, kc = cv & 7; vst[i] = *(const u32x4*)(VT + vtb + (size_t)v * Lk + k0 + kc * 8); }
            }
            f32x16 sacc[2];
#pragma unroll
            for (int i = 0; i < 16; ++i) { sacc[0][i] = 0.f; sacc[1][i] = 0.f; }
#pragma unroll
            for (int s = 0; s < 12; ++s) {
                const bf16x8 kf0 = *(const LAS bf16x8*)(Ks + r * 400 + (16 * s + 8 * hh) * 2);
                const bf16x8 kf1 = *(const LAS bf16x8*)(Ks + (32 + r) * 400 + (16 * s + 8 * hh) * 2);
                sacc[0] = __builtin_amdgcn_mfma_f32_32x32x16_bf16(kf0, qf[s], sacc[0], 0, 0, 0);
                sacc[1] = __builtin_amdgcn_mfma_f32_32x32x16_bf16(kf1, qf[s], sacc[1], 0, 0, 0);
            }
            float mx0 = fmaxf(sacc[0][0], sacc[1][0]), mx1 = fmaxf(sacc[0][1], sacc[1][1]);
#pragma unroll
            for (int i = 2; i < 16; i += 2) { mx0 = __builtin_fmaxf(__builtin_fmaxf(mx0, sacc[0][i]), sacc[1][i]); mx1 = __builtin_fmaxf(__builtin_fmaxf(mx1, sacc[0][i + 1]), sacc[1][i + 1]); }
            float mx = fmaxf(mx0, mx1);
            mx = fmaxf(mx, shx(mx, 32, lane));
            const float mnew = fmaxf(mrun, mx);
            const bool resc = __builtin_amdgcn_ballot_w64(mnew != mrun) != 0ull;
            const float alpha = __builtin_amdgcn_exp2f((mrun - mnew) * sc2);
            mrun = mnew;
            const float nm = -mnew * sc2;
            f32x2 ps2 = (f32x2){0.f, 0.f};
#pragma unroll
            for (int kk = 0; kk < 2; ++kk)
#pragma unroll
                for (int i = 0; i < 16; i += 2) {
                    f32x2 a = (f32x2){sacc[kk][i], sacc[kk][i + 1]}; a = a * sc2 + nm;
                    a.x = __builtin_amdgcn_exp2f(a.x); a.y = __builtin_amdgcn_exp2f(a.y);
                    sacc[kk][i] = a.x; sacc[kk][i + 1] = a.y; ps2 += a;
                }
            lrun = lrun * alpha + (ps2.x + ps2.y);
            if (resc) {
#pragma unroll
                for (int ct = 0; ct < 4; ++ct)
#pragma unroll
                    for (int i = 0; i < 16; ++i) oacc[ct][i] *= alpha;
            }
#pragma unroll
            for (int ks = 0; ks < 4; ++ks) {
                const int kk = ks >> 1, s2 = ks & 1;
                u32x4 pw;
                pw.x = cvt_pk_bf16(sacc[kk][8 * s2 + 0], sacc[kk][8 * s2 + 1]); pw.y = cvt_pk_bf16(sacc[kk][8 * s2 + 2], sacc[kk][8 * s2 + 3]);
                pw.z = cvt_pk_bf16(sacc[kk][8 * s2 + 4], sacc[kk][8 * s2 + 5]); pw.w = cvt_pk_bf16(sacc[kk][8 * s2 + 6], sacc[kk][8 * s2 + 7]);
                const bf16x8 pf = __builtin_bit_cast(bf16x8, pw);
#pragma unroll
                for (int ct = 0; ct < 4; ++ct) {
                    const bf16x8 vf = *(const LAS bf16x8*)(Vs + (32 * ct + r) * 144 + (32 * kk + 16 * s2) * 2 + 16 * hh);
                    oacc[ct] = __builtin_amdgcn_mfma_f32_32x32x16_bf16(vf, pf, oacc[ct], 0, 0, 0);
                }
            }
        }
        lrun += shx(lrun, 32, lane);
        const float invl = 1.0f / lrun;
        const int tid2 = otid(wv); const int qrow2 = row0 + (tid2 >> 6) * 32 + (tid2 & 31);
        bf16_t* op = O + (size_t)qrow2 * 1024 + h * 128 + 4 * ((tid2 >> 5) & 1);
#pragma unroll
        for (int ct = 0; ct < 4; ++ct)
#pragma unroll
            for (int g4 = 0; g4 < 4; ++g4) {
                u32x2 w; w.x = cvt_pk_bf16(oacc[ct][4 * g4] * invl, oacc[ct][4 * g4 + 1] * invl); w.y = cvt_pk_bf16(oacc[ct][4 * g4 + 2] * invl, oacc[ct][4 * g4 + 3] * invl);
                *(u32x2*)(op + 32 * ct + 8 * g4) = w;
            }
        __syncthreads();
    }
}

__device__ __forceinline__ void e9_phase(int wv, const Params& p, int l) {
    const bf16_t* UU = (const bf16_t*)(p.ws + A_UU); bf16_t* ACT = (bf16_t*)(p.ws + A_ACT);
    const float* cw = p.in[I_FCW] + (size_t)l * 3 * UU_LD; const float* cb = p.in[I_FCB] + (size_t)l * UU_LD;
    const int tid9 = otid(wv);
    constexpr int RC = 16, NCG = DFF / 8;
    const int gt = obid() * NTHREADS + tid9, nlr = (int)(gridDim.x * NTHREADS) / NCG;
    const int c0 = (gt % NCG) * 8, lr = gt / NCG;
    float wg[3][8], wx[3][8], bg[8], bx[8];
    if (lr < nlr) {
#pragma unroll
        for (int o = 0; o < 3; ++o) { const f32x4 a = *(const f32x4*)(cw + o * UU_LD + c0), b = *(const f32x4*)(cw + o * UU_LD + c0 + 4), c = *(const f32x4*)(cw + o * UU_LD + DFF + c0), d = *(const f32x4*)(cw + o * UU_LD + DFF + c0 + 4);
#pragma unroll
            for (int j = 0; j < 4; ++j) { wg[o][j] = a[j]; wg[o][4 + j] = b[j]; wx[o][j] = c[j]; wx[o][4 + j] = d[j]; } }
        { const f32x4 a = *(const f32x4*)(cb + c0), b = *(const f32x4*)(cb + c0 + 4), c = *(const f32x4*)(cb + DFF + c0), d = *(const f32x4*)(cb + DFF + c0 + 4);
#pragma unroll
          for (int j = 0; j < 4; ++j) { bg[j] = a[j]; bg[4 + j] = b[j]; bx[j] = c[j]; bx[4 + j] = d[j]; } }
    }
    for (int ch = lr; lr < nlr && ch < MT / RC; ch += nlr) {
        const int row0 = ch * RC;
        const int t0 = row0 < MP ? (row0 & 255) : ((row0 - MP) & 2047); const int L = row0 < MP ? LP : LS;
        const bf16_t* pr = UU + (size_t)row0 * UU_LD + c0;
        u32x4 gp = (u32x4){0u, 0u, 0u, 0u}, xp = gp, gc, xc, gn, xn;
        if (t0 > 0) { gp = *(const u32x4*)(pr - UU_LD); xp = *(const u32x4*)(pr - UU_LD + DFF); }
        gc = *(const u32x4*)pr; xc = *(const u32x4*)(pr + DFF);
#pragma unroll 4
        for (int i = 0; i < RC; ++i) {
            gn = (u32x4){0u, 0u, 0u, 0u}; xn = gn;
            if (t0 + i + 1 < L) { gn = *(const u32x4*)(pr + (size_t)(i + 1) * UU_LD); xn = *(const u32x4*)(pr + (size_t)(i + 1) * UU_LD + DFF); }
            float a[8], b[8], c[8], ga[8], va[8];
            unpack8(gp, a); unpack8(gc, b); unpack8(gn, c);
#pragma unroll
            for (int j = 0; j < 8; ++j) ga[j] = bg[j] + wg[0][j] * a[j] + wg[1][j] * b[j] + wg[2][j] * c[j];
            unpack8(xp, a); unpack8(xc, b); unpack8(xn, c);
#pragma unroll
            for (int j = 0; j < 8; ++j) va[j] = bx[j] + wx[0][j] * a[j] + wx[1][j] * b[j] + wx[2][j] * c[j];
#pragma unroll
            for (int j = 0; j < 8; ++j) ga[j] = siluf_(ga[j]) * va[j];
            *(u32x4*)(ACT + (size_t)(row0 + i) * DFF + c0) = pack8(ga);
            gp = gc; gc = gn; xp = xc; xc = xn;
        }
    }
}

__device__ __forceinline__ void merge_phase(int wv, const Params& p) {
    const bf16_t* RAW = (const bf16_t*)(p.ws + A_RAW); const bf16_t* G = (const bf16_t*)(p.ws + A_GATES); bf16_t* MB = (bf16_t*)(p.ws + A_MBF);
    const int tid = otid(wv);
    for (int it = obid() * NTHREADS + tid; it < MT * 256; it += gridDim.x * NTHREADS) {
        const int row = it >> 8, c0 = (it & 255) * 8;
        float acc[8];
#pragma unroll
        for (int j = 0; j < 8; ++j) acc[j] = 0.f;
#pragma unroll
        for (int P = 0; P < 3; ++P) {
            float r[8], g[8];
            unpack8(*(const u32x4*)(RAW + ((size_t)P * MT + row) * DM + c0), r); unpack8(*(const u32x4*)(G + (size_t)row * GATE_LD + P * 2048 + c0), g);
#pragma unroll
            for (int j = 0; j < 8; ++j) acc[j] += sigmoidf_(g[j]) * r[j];
        }
        *(u32x4*)(MB + (size_t)row * DM + c0) = pack8(acc);
    }
}

__device__ __forceinline__ void convert_layer(int wv, const Params& p, int l, LAS unsigned char* lds) {
    unsigned char* ws = p.ws;
    convT(wv, p.in[I_WIN] + (size_t)l * DM * NIN, DM, NIN, (bf16_t*)(ws + W_IN), 1, lds);
    convT(wv, p.in[I_WUQ] + (size_t)l * 512 * 1536, 512, 1536, (bf16_t*)(ws + W_UQ), 0, lds);
    convT(wv, p.in[I_WUKV] + (size_t)l * 256 * 2048, 256, 2048, (bf16_t*)(ws + W_UKV), 2, lds);
    convT(wv, p.in[I_WBRA] + (size_t)l * 1024 * 2048, 1024, 2048, (bf16_t*)(ws + W_BRA), 0, lds);
    convT(wv, p.in[I_WBRB] + (size_t)l * 1024 * 2048, 1024, 2048, (bf16_t*)(ws + W_BRB), 0, lds);
    convT(wv, p.in[I_WBRC] + (size_t)l * 1024 * 2048, 1024, 2048, (bf16_t*)(ws + W_BRC), 0, lds);
    convT(wv, p.in[I_WO] + (size_t)l * 2048 * 2048, 2048, 2048, (bf16_t*)(ws + W_O), 0, lds);
    convT(wv, p.in[I_FUP] + (size_t)l * 2048 * UU_LD, 2048, UU_LD, (bf16_t*)(ws + W_UP), 0, lds);
    convT(wv, p.in[I_FDN] + (size_t)l * DFF * 2048, DFF, 2048, (bf16_t*)(ws + W_DN), 0, lds);
}

namespace pg8 {
struct EpiGateRT {
    const bf16_t* gates; float* m32; bf16_t* mbf; int P;
    __device__ __forceinline__ void operator()(const f32x4 (&acc)[2][2][4][2], const Unit& u, int wr, int wc, int fr, int fq) const {
        const int row0 = u.pm * BM + wr * 64 + fr, col0 = u.pn * BM + wc * 32 + 4 * fq;
#pragma unroll
        for (int ai = 0; ai < 2; ++ai)
#pragma unroll
            for (int m = 0; m < 4; ++m) {
                const size_t row = (size_t)(row0 + ai * HALF + m * 16);
#pragma unroll
                for (int bj = 0; bj < 2; ++bj)
#pragma unroll
                    for (int n = 0; n < 2; ++n) {
                        const int col = col0 + bj * HALF + n * 16;
                        const u32x2 gw = *(const u32x2*)(gates + row * GATE_LD + P * 2048 + col);
                        f32x4 v = acc[ai][bj][m][n];
                        v[0] *= sigmoidf_(bf_lo(gw.x)); v[1] *= sigmoidf_(bf_hi(gw.x)); v[2] *= sigmoidf_(bf_lo(gw.y)); v[3] *= sigmoidf_(bf_hi(gw.y));
                        float* mp = m32 + row * 2048 + col;
                        if (P != 0) { const f32x4 o = *(const f32x4*)mp; v = v + o; }
                        if (P != 2) { *(f32x4*)mp = v; }
                        else { u32x2 w; w.x = cvt_pk_bf16(v[0], v[1]); w.y = cvt_pk_bf16(v[2], v[3]); *(u32x2*)(mbf + row * 2048 + col) = w; }
                    }
            }
    }
};
}


#define XB_TMO      128
#define XB_XCNT(j)  (256  + 64 * (j))
#define XB_XSUB(j)  (1280 + 64 * (j))
#define XB_XGEN(j)  (2304 + 64 * (j))
#define XB_TOP      3328
#define XB_TOPGEN   3392
#define XCD_BAR_WORDS 3456
#define XB_SPIN_CAP (1u << 20)
__device__ __forceinline__ unsigned xb_ld(unsigned* p)              { return __hip_atomic_load(p, __ATOMIC_RELAXED, __HIP_MEMORY_SCOPE_AGENT); }
__device__ __forceinline__ unsigned xb_add(unsigned* p, unsigned v) { return __hip_atomic_fetch_add(p, v, __ATOMIC_RELAXED, __HIP_MEMORY_SCOPE_AGENT); }
__device__ __forceinline__ unsigned xb_xcc_id() { return (unsigned)__builtin_amdgcn_s_getreg((3 << 11) | 20) & 0xFu; }
#define XB_SPIN(cond, bar) do { unsigned _sp = 0; while (cond) { __builtin_amdgcn_s_sleep(1); \
    if ((++_sp & 255u) == 0u) { if (xb_ld(&(bar)[XB_TMO])) break; if (_sp > XB_SPIN_CAP) { atomicAdd(&(bar)[XB_TMO], 1u); break; } } } } while (0)
__device__ __forceinline__ void xcd_barrier_complete(unsigned* bar, unsigned x, unsigned& nloc, unsigned& nx) {
    const unsigned G = gridDim.x;
    unsigned sum, cnt, mine, sp = 0u;
    for (;;) {
        sum = 0u; cnt = 0u; mine = 0u;
#pragma unroll
        for (unsigned j = 0; j < 16; ++j) { const unsigned c = xb_ld(&bar[XB_XCNT(j)]); sum += c; cnt += (c > 0u) ? 1u : 0u; mine = (j == x) ? c : mine; }
        if (sum == G) break;
        __builtin_amdgcn_s_sleep(1);
        if ((++sp & 255u) == 0u) { if (xb_ld(&bar[XB_TMO])) break; if (sp > XB_SPIN_CAP) { atomicAdd(&bar[XB_TMO], 1u); break; } }
    }
    nloc = mine > 0u ? mine : 1u; nx = cnt > 0u ? cnt : 1u;
}
__device__ __forceinline__ void xcd_barrier(int wv, unsigned* bar, volatile LAS unsigned* st) {
    asm volatile("s_waitcnt vmcnt(0)" ::: "memory");
    __syncthreads();
    if (otid(wv) == 0) {
        __builtin_amdgcn_s_waitcnt(0);
        const unsigned x = xb_xcc_id();
        unsigned nloc = st[0], nx = st[1];
        if (nloc == 0u) { xcd_barrier_complete(bar, x, nloc, nx); st[0] = nloc; st[1] = nx; }
        const unsigned old = xb_add(&bar[XB_XSUB(x)], 1u);
        const unsigned gen = old / nloc;
        if (old + 1u == (gen + 1u) * nloc) {
            __builtin_amdgcn_fence(__ATOMIC_RELEASE, "agent");
            asm volatile("s_waitcnt vmcnt(0)" ::: "memory");
            const unsigned og = xb_add(&bar[XB_TOP], 1u);
            const unsigned tg = og / nx;
            if (og + 1u == (tg + 1u) * nx) xb_add(&bar[XB_TOPGEN], 1u);
            else XB_SPIN(xb_ld(&bar[XB_TOPGEN]) == tg, bar);
            __builtin_amdgcn_fence(__ATOMIC_ACQUIRE, "agent");
            xb_add(&bar[XB_XGEN(x)], 1u);
            asm volatile("s_waitcnt vmcnt(0)" ::: "memory");
        } else {
            XB_SPIN(xb_ld(&bar[XB_XGEN(x)]) == gen, bar);
            __builtin_amdgcn_fence(__ATOMIC_ACQUIRE, "agent");
            asm volatile("s_waitcnt vmcnt(0)" ::: "memory");
        }
    }
    __syncthreads();
}

#ifndef REP_GEMM
#define REP_GEMM 1
#endif
#ifndef REP_ATTN
#define REP_ATTN 1
#endif
#ifndef REP_CONV
#define REP_CONV 1
#endif
#ifndef REP_ELT
#define REP_ELT 1
#endif
#ifndef REP_CVT
#define REP_CVT 1
#endif
enum { K_G1A = 0, K_E2, K_I3, K_I4, K_G1B, K_G5, K_G6, K_ROW1, K_G8, K_E9, K_G10, K_ROW2, K_PRO, K_ROW0, K_COMB };

__global__ void __launch_bounds__(NTHREADS) fwd_megakernel(Params p) {
    extern __shared__ __attribute__((aligned(16))) unsigned char shm[];
    LAS unsigned char* lds = (LAS unsigned char*)shm;
    cg::grid_group grid = cg::this_grid();
    const int wv = __builtin_amdgcn_readfirstlane((int)(threadIdx.x >> 6));
    volatile LAS unsigned* bst = (volatile LAS unsigned*)(lds + 131072);
    unsigned* bar = (unsigned*)(p.ws + S_BAR);
    if (threadIdx.x == 0) { bst[0] = 0u; bst[1] = 0u; bst[2] = 0u; bst[3] = 0u; (void)xb_add(&bar[XB_XCNT(xb_xcc_id())], 1u); }
    __syncthreads();
#pragma unroll 1
    for (int ph = 0; ph < 3 + 12 * NLAYER; ++ph) {
        int kind, l;
        if (ph == 0) { kind = K_PRO; l = 0; } else if (ph == 1) { kind = K_COMB; l = 0; } else if (ph == 2) { kind = K_ROW0; l = 0; } else { l = (ph - 3) / 12; kind = (ph - 3) - l * 12; }
        unsigned char* ws = p.ws;
        asm volatile("" : "+s"(ws));
        if (kind == K_G1A || kind == K_I3 || kind == K_G1B || kind == K_G8) {
            const bf16_t* A; const bf16_t* Bt; bf16_t* O; int N, K;
            if (kind == K_G1A) { A = (const bf16_t*)(ws + A_H); Bt = (const bf16_t*)(ws + W_IN); O = (bf16_t*)(ws + A_PROJA); N = PA_LD; K = DM; }
            else if (kind == K_I3) { A = (const bf16_t*)(ws + A_CQN); Bt = (const bf16_t*)(ws + W_UQ); O = (bf16_t*)(ws + A_Q); N = 1536; K = 512; }
            else if (kind == K_G1B) { A = (const bf16_t*)(ws + A_H); Bt = (const bf16_t*)(ws + W_IN) + (size_t)PA_LD * DM; O = (bf16_t*)(ws + A_GATES); N = GATE_LD; K = DM; }
            else { A = (const bf16_t*)(ws + A_H); Bt = (const bf16_t*)(ws + W_UP); O = (bf16_t*)(ws + A_UU); N = UU_LD; K = DM; }
            int Mr = MT;
            const int nrep = ((kind == K_I3) ? 2 : 1) * REP_GEMM;
#pragma unroll 1
            for (int rp = 0; rp < nrep; ++rp) {
                if (kind == K_I3 && rp >= REP_GEMM) { A = (const bf16_t*)(ws + A_KEYSC); Bt = (const bf16_t*)(ws + W_UKV); O = (bf16_t*)(ws + A_KN); N = 1024; K = 256; Mr = KROWS; }
                run_gemm(wv, lds, A, Bt, Mr, N, K, pg8::EpiBf16{O, N, O});
            }
        }
        if (kind == K_I3) {
#pragma unroll 1
            for (int rp = 0; rp < REP_GEMM; ++rp)
            run_gemm(wv, lds, (const bf16_t*)(ws + W_UKV) + (size_t)1024 * 256, (const bf16_t*)(ws + A_KEYSC), 1024, KROWS, 256,
                     pg8::EpiVT{(bf16_t*)(ws + A_VT), (bf16_t*)(ws + A_VT) + (size_t)BS * 8 * 128 * LKS});
#pragma unroll 1
            for (int rp = 0; rp < REP_CONV; ++rp) conv_phase(wv, p, l, lds);
        }
        if (kind == K_I4) {
#pragma unroll 1
            for (int rp = 0; rp < REP_ATTN; ++rp) attn_phase(wv, p, lds);
#pragma unroll 1
            for (int rp = 0; rp < REP_ELT; ++rp) e3b_phase(wv, p, lds); }
        if (kind == K_G1B) {
#pragma unroll 1
            for (int rp = 0; rp < REP_GEMM; ++rp)
            run_gemm(wv, lds, (const bf16_t*)(ws + A_YA), (const bf16_t*)(ws + W_BRA), 3 * MT, DM, 1024, pg8::EpiBf16{(bf16_t*)(ws + A_RAW), DM, (bf16_t*)(ws + A_RAW)}, false, MT / 256, E_WBR * 2, true);
        }
        if (kind == K_G5) merge_phase(wv, p);
        if (kind == K_G6 || kind == K_G10) {
            const bool g6 = (kind == K_G6);
#pragma unroll 1
            for (int rp = 0; rp < REP_GEMM; ++rp)
            run_gemm(wv, lds, (const bf16_t*)(ws + (g6 ? A_MBF : A_ACT)), (const bf16_t*)(ws + (g6 ? W_O : W_DN)), MT, DM, g6 ? DM : DFF, pg8::EpiBf16{(bf16_t*)(ws + (g6 ? A_M32 : A_F32)), DM, (bf16_t*)(ws + (g6 ? A_M32 : A_F32)) + (size_t)MT * DM}, true);
        }
        if (kind == K_E2) {
#pragma unroll 1
            for (int rp = 0; rp < REP_ELT; ++rp) e2_phase(wv, p, l, lds); }
        if (kind == K_E9) {
#pragma unroll 1
            for (int rp = 0; rp < REP_ELT; ++rp) e9_phase(wv, p, l); }
        if (kind == K_ROW0 || kind == K_ROW1 || kind == K_ROW2) row_phase(wv, p, l, kind == K_ROW0 ? 0 : (kind == K_ROW1 ? 1 : 2));
        if (kind == K_COMB) comb_phase(wv, p);
        if (kind == K_PRO) {
            if (obid() == 0) {
                pg8::StaticOrder S; S.init(MT, DM, (int)gridDim.x, 0, true);
                const int t0 = otid(wv);
                if (t0 < S.nwg - S.nfull) { pg8::Unit uu; S.tile_of(S.nfull + t0, uu); atomicOr((unsigned*)(p.ws + S_TAIL) + uu.pm, 1u << uu.pn); }
            }
            ada_phase(wv, p, lds); rope_table_phase(wv, p); }
        if (kind == K_PRO || (kind == K_ROW2 && l + 1 < NLAYER)) { const int ln = (kind == K_PRO) ? 0 : l + 1;
#pragma unroll 1
            for (int rp = 0; rp < REP_CVT; ++rp) { filter_phase(wv, p, ln, lds); convert_layer(wv, p, ln, lds); } }
        if (p.ws == nullptr) grid.sync();
        xcd_barrier(wv, bar, bst);
    }
}

extern "C" void kernel_launch(void* const* d_in, const int* in_sizes, int n_in, void* d_out, int out_size, void* d_ws, size_t ws_size, hipStream_t stream) {
    static int grid_blocks = 0;
    if (grid_blocks == 0) {
        if (n_in != N_INPUTS || ws_size < WS_NEED) { fprintf(stderr, "kernel_launch: need %d inputs and %zu bytes of workspace; got %d, %zu\n", N_INPUTS, (size_t)WS_NEED, n_in, ws_size); grid_blocks = -1; return; }
        int dev = 0, cus = 0, per_cu = 0;
        hipGetDevice(&dev);
        hipDeviceGetAttribute(&cus, hipDeviceAttributeMultiprocessorCount, dev);
        if (hipFuncSetAttribute((const void*)fwd_megakernel, hipFuncAttributeMaxDynamicSharedMemorySize, LDS_BYTES) != hipSuccess) { fprintf(stderr, "kernel_launch: hipFuncSetAttribute failed\n"); grid_blocks = -1; return; }
        if (hipOccupancyMaxActiveBlocksPerMultiprocessor(&per_cu, (const void*)fwd_megakernel, NTHREADS, LDS_BYTES) != hipSuccess || per_cu < 1) { fprintf(stderr, "kernel_launch: occupancy query gave %d\n", per_cu); per_cu = 1; }
        (void)hipGetLastError();
        grid_blocks = cus * 1;
    }
    if (grid_blocks < 0) return;
        (void)hipMemsetAsync((unsigned char*)d_ws + S_BAR, 0, 16384, stream);
    (void)hipMemsetAsync((unsigned char*)d_ws + S_TAIL, 0, 512, stream);
    Params p{};
    for (int i = 0; i < N_INPUTS; ++i) p.in[i] = (const float*)d_in[i];
    p.out = (float*)d_out; p.ws = (unsigned char*)d_ws;
    void* args[] = {&p};
    hipError_t e = hipLaunchCooperativeKernel((const void*)fwd_megakernel, dim3(grid_blocks), dim3(NTHREADS), args, LDS_BYTES, stream);
    if (e != hipSuccess) fprintf(stderr, "cooperative launch failed: %s (grid %d)\n", hipGetErrorString(e), grid_blocks);
}
```

```cpp
#include <hip/hip_runtime.h>
#include <hip/hip_cooperative_groups.h>
#include <cstdio>
namespace cg = cooperative_groups;

#define LAS __attribute__((address_space(3)))
typedef unsigned short bf16_t;
typedef short bf16x8 __attribute__((ext_vector_type(8)));
typedef float f32x4 __attribute__((ext_vector_type(4)));
typedef float f32x16 __attribute__((ext_vector_type(16)));
typedef unsigned u32x4 __attribute__((ext_vector_type(4)));
typedef unsigned u32x2 __attribute__((ext_vector_type(2)));
typedef float f32x2 __attribute__((ext_vector_type(2)));

constexpr int DM = 2048, MP = 4096, MS = 16384, MT = 20480, NLAYER = 2;
constexpr int LP = 256, LS = 2048, BP = 16, BS = 8, PAST = 512, LKS = 2560;
constexpr int NIN = 13120, NGATE0 = 6976, PA_LD = 7168, GATE_LD = 6144;
constexpr int DFF = 5632, UU_LD = 11264;
constexpr int KROWS = 24576;
constexpr int NTHREADS = 512;
constexpr int LDS_BYTES = 131072 + 16;

enum { I_XP = 0, I_XS, I_C, I_CCKV, I_CKPE, I_CCTX, I_ADAW, I_ADAB, I_NMPRE, I_NMPOST, I_NFPRE, I_NFPOST, I_WIN, I_HCW, I_HCB,
       I_FW1, I_FB1, I_FW2, I_FB2, I_FW3, I_FB3, I_FFREQ, I_HBIAS, I_QN, I_KVN, I_WUQ, I_WUKV, I_SCW, I_WBRA, I_WBRB, I_WBRC,
       I_WO, I_FUP, I_FCW, I_FCB, I_FDN, N_INPUTS };

constexpr size_t E_WIN = (size_t)13312 * 2048, E_WUQ = (size_t)1536 * 512, E_WUKV = (size_t)2048 * 256, E_WBR = (size_t)2048 * 1024,
                 E_WO = (size_t)2048 * 2048, E_WUP = (size_t)11264 * 2048, E_WDN = (size_t)2048 * 5632;
constexpr size_t W_IN = 0, W_UQ = W_IN + E_WIN * 2, W_UKV = W_UQ + E_WUQ * 2, W_BRA = W_UKV + E_WUKV * 2, W_BRB = W_BRA + E_WBR * 2,
                 W_BRC = W_BRB + E_WBR * 2, W_O = W_BRC + E_WBR * 2, W_UP = W_O + E_WO * 2, W_DN = W_UP + E_WUP * 2, W_END = W_DN + E_WDN * 2;
constexpr size_t S_MOD = W_END, SZ_MOD = (size_t)NLAYER * 16 * 9 * 12288 * 4;
constexpr size_t S_KTS = S_MOD + SZ_MOD, S_KTP = S_KTS + (size_t)1024 * 4096 * 4, S_PARTS = S_KTP + (size_t)1024 * 512 * 4,
                 S_PARTP = S_PARTS + (size_t)64 * 2048 * 4, S_ROPE = S_PARTP + (size_t)8 * 2048 * 4, S_BAR = S_ROPE + (size_t)2 * 2048 * 32 * 4, S_COMB = S_BAR + 16384, S_SCALE = S_COMB + (size_t)NLAYER * 3 * 9 * 3 * 2048 * 4, S_TAIL = S_BAR + 14336, S_END = S_SCALE + 8192;
constexpr size_t AR = S_END;
constexpr size_t SZ_H = (size_t)MT * 2048 * 2;
constexpr size_t A_H = AR, A_UU = AR + SZ_H, A_ACT = A_UU + (size_t)MT * UU_LD * 2, AR_END = A_ACT + (size_t)MT * DFF * 2;
constexpr size_t A_PROJA = A_UU;
constexpr size_t A_Q = A_UU, A_KN = A_Q + (size_t)MT * 1536 * 2, A_VT = A_KN + (size_t)KROWS * 1024 * 2, A_YCT = A_VT + (size_t)KROWS * 1024 * 2;
constexpr size_t A_GATES = A_UU, A_M32 = A_GATES + (size_t)MT * GATE_LD * 2, A_MBF = A_H, A_F32 = A_UU;
constexpr size_t A_S = A_M32 + (size_t)MT * 2048 * 4;
constexpr size_t A_ZZT = A_S, A_X0S = A_ZZT + (size_t)MT * 1024 * 2, A_CQN = A_X0S + (size_t)MT * 1024 * 2, A_KEYSC = A_CQN + (size_t)MT * 512 * 2,
                 A_KPER = A_KEYSC + (size_t)KROWS * 256 * 2, A_YA = A_KPER + (size_t)KROWS * 64 * 2, A_OATT = A_YA + (size_t)MT * 1024 * 2,
                 A_YC = A_OATT + (size_t)MT * 1024 * 2, A_SEND = A_YC + (size_t)MT * 1024 * 2;
constexpr size_t A_RAW = A_M32;
static_assert(A_RAW + (size_t)3 * MT * 2048 * 2 <= A_CQN, "raw branch buffer overlaps live data");
static_assert(A_SEND <= AR_END, "arena overflow");
static_assert(A_YCT + (size_t)MT * 1024 * 2 <= A_M32, "arena overlap");
constexpr size_t WS_NEED = AR_END;
static_assert(WS_NEED <= 967590400ull, "workspace too large");

struct Params {
    const float* in[N_INPUTS];
    float* out;
    unsigned char* ws;
};

__device__ __forceinline__ unsigned cvt_pk_bf16(float lo, float hi) { unsigned r; asm volatile("v_cvt_pk_bf16_f32 %0, %1, %2" : "=v"(r) : "v"(lo), "v"(hi)); return r; }
__device__ __forceinline__ bf16_t f2bf(float f) { return (bf16_t)(cvt_pk_bf16(f, 0.f) & 0xffffu); }
__device__ __forceinline__ float bf_lo(unsigned w) { return __uint_as_float(w << 16); }
__device__ __forceinline__ float bf_hi(unsigned w) { return __uint_as_float(w & 0xffff0000u); }
__device__ __forceinline__ void unpack8(const u32x4 v, float* f) { f[0] = bf_lo(v.x); f[1] = bf_hi(v.x); f[2] = bf_lo(v.y); f[3] = bf_hi(v.y); f[4] = bf_lo(v.z); f[5] = bf_hi(v.z); f[6] = bf_lo(v.w); f[7] = bf_hi(v.w); }
__device__ __forceinline__ u32x4 pack8(const float* f) { u32x4 r; r.x = cvt_pk_bf16(f[0], f[1]); r.y = cvt_pk_bf16(f[2], f[3]); r.z = cvt_pk_bf16(f[4], f[5]); r.w = cvt_pk_bf16(f[6], f[7]); return r; }
__device__ __forceinline__ float shx(float v, int mask, int lane) { return __int_as_float(__builtin_amdgcn_ds_bpermute((lane ^ mask) << 2, __float_as_int(v))); }
__device__ __forceinline__ float wave_sum(float v, int lane) {
#pragma unroll
    for (int o = 32; o >= 1; o >>= 1) v += shx(v, o, lane);
    return v;
}
__device__ __forceinline__ int otid(int wv) { int t; asm volatile("v_mbcnt_lo_u32_b32 %0, -1, 0\n\tv_mbcnt_hi_u32_b32 %0, -1, %0" : "=v"(t)); return wv * 64 + t; }
__device__ __forceinline__ int obid() { int t = blockIdx.x; asm volatile("" : "+s"(t)); return t; }
__device__ __forceinline__ float sigmoidf_(float x) { return __builtin_amdgcn_rcpf(1.0f + __builtin_amdgcn_exp2f(-1.4426950408889634f * x)); }
__device__ __forceinline__ float siluf_(float x) { return x * sigmoidf_(x); }

namespace pg8 {
constexpr int BM = 256, BK = 64, HALF = 128, HTB = HALF * BK * 2, STAGE_BYTES = 8 * HTB, NXCD = 8, WGM = 8;
__host__ __device__ __forceinline__ int lds_byte(int r, int c) { const int st = (r >> 4) * 2 + (c >> 5), rr = r & 15, cc = c & 31, ob = rr * 64 + cc * 2; return st * 1024 + (ob ^ (((ob >> 9) & 1) << 5)); }
__host__ __device__ __forceinline__ void stage_rc(int b, int& R, int& C) { const int st = b / 1024, sb = b % 1024, swz = sb ^ (((sb >> 9) & 1) << 5); R = (st >> 1) * 16 + swz / 64; C = (st & 1) * 32 + (swz % 64) / 2; }
__host__ __device__ __forceinline__ int perm32(int rho) { const int n = rho >> 4, i = rho & 15; return 8 * (i >> 2) + 4 * n + (i & 3); }
struct Unit { int pm, pn, kh; };
struct Gemm { const bf16_t* A; const bf16_t* Bt; int M, N, K; int nMper; size_t bstride; };
struct StaticOrder {
    int nM, nN, nwg, G, c, nfull;
    __device__ void init(int M, int N, int G_, int c_, bool split = false) { nM = M / BM; nN = N / BM; nwg = nM * nN; G = G_; c = c_;
        nfull = nwg; if (split) { const int rem = nwg % G; if (rem > 0 && 2 * rem <= G) nfull = nwg - rem; } }
    __device__ void tile_of(int wgid, Unit& u) const {
        { const int q = nwg / NXCD, r = nwg % NXCD, xcd = wgid % NXCD, off = wgid / NXCD; wgid = (xcd < r ? xcd * (q + 1) : r * (q + 1) + (xcd - r) * q) + off; }
        const int nig = WGM * nN, gid = wgid / nig, fm = gid * WGM, gsz = (nM - fm) < WGM ? (nM - fm) : WGM;
        u.pm = fm + ((wgid % nig) % gsz); u.pn = (wgid % nig) / gsz;
    }
    __device__ bool next(int i, Unit& u) const {
        const long L = (long)i * G + c;
        int tile = (int)L, kh = -1; bool ok = L < nwg;
        if (L >= nfull) { const long h = L - nfull; ok = h < 2 * (long)(nwg - nfull); tile = nfull + (int)(h >> 1); kh = (int)(h & 1); }
        if (!ok) return false;
        int pm, pn;
        { int wgid = tile; const int q = nwg / NXCD, r = nwg % NXCD, xcd = wgid % NXCD, off = wgid / NXCD; wgid = (xcd < r ? xcd * (q + 1) : r * (q + 1) + (xcd - r) * q) + off;
          const int nig = WGM * nN, gid = wgid / nig, fm = gid * WGM, gsz = (nM - fm) < WGM ? (nM - fm) : WGM;
          pm = fm + ((wgid % nig) % gsz); pn = (wgid % nig) / gsz; }
        u.pm = pm; u.pn = pn; u.kh = kh; return true;
    }
};
template <class Epi>
__device__ __forceinline__ void gemm_phase(int wv, LAS unsigned char* lds, const Gemm g, const StaticOrder& S, const Epi& E) {
    const int tid = otid(wv), wid = __builtin_amdgcn_readfirstlane(tid >> 6), lane = tid & 63, wr = wid >> 2, wc = wid & 3, fr = lane & 15, fq = lane >> 4;
    const int K = g.K, nt = K / BK;
    unsigned voffA[2], voffB[2];
#pragma unroll
    for (int i = 0; i < 2; ++i) { int R, C; stage_rc(tid * 16 + i * 8192, R, C); const int Rb = (R & ~31) + perm32(R & 31); voffA[i] = (unsigned)(R * K + C) * 2u; voffB[i] = (unsigned)(Rb * K + C) * 2u; }
    const size_t kstep = (size_t)(BK * 2);
    const size_t hstep = (size_t)HALF * K * 2;
    const size_t tstep = 2 * hstep;
    const unsigned ldsw = (unsigned)wid * 1024u;
    const int aoff = lds_byte(wr * 64 + fr, fq * 8), boff = lds_byte(wc * 32 + fr, fq * 8);
#define PG8_SA(b, h) (((b) * 2 + (h)) * HTB)
#define PG8_SB(b, h) ((4 + (b) * 2 + (h)) * HTB)
#define PG8_STAGE(bufoff, gbase, voff) do { _Pragma("unroll") for (int _i = 0; _i < 2; ++_i) \
        __builtin_amdgcn_global_load_lds((const unsigned*)((const char*)(gbase) + (voff)[_i]), (LAS unsigned*)(lds + (bufoff) + ldsw + _i * 8192), 16, 0, 0); } while (0)
#define PG8_LDA(dst, b, h) do { _Pragma("unroll") for (int m = 0; m < 4; ++m) _Pragma("unroll") for (int k = 0; k < 2; ++k) dst[m][k] = *(const LAS bf16x8*)(lds + PG8_SA(b, h) + aoff + m * 2048 + k * 1024); } while (0)
#define PG8_LDB(dst, b, h) do { _Pragma("unroll") for (int n = 0; n < 2; ++n) _Pragma("unroll") for (int k = 0; k < 2; ++k) dst[n][k] = *(const LAS bf16x8*)(lds + PG8_SB(b, h) + boff + n * 2048 + k * 1024); } while (0)
#define PG8_MMA(ai, bj, At, Bt) do { __builtin_amdgcn_s_setprio(1); _Pragma("unroll") for (int m = 0; m < 4; ++m) _Pragma("unroll") for (int n = 0; n < 2; ++n) _Pragma("unroll") for (int k = 0; k < 2; ++k) \
        acc[ai][bj][m][n] = __builtin_amdgcn_mfma_f32_16x16x32_bf16(Bt[n][k], At[m][k], acc[ai][bj][m][n], 0, 0, 0); __builtin_amdgcn_s_setprio(0); } while (0)
#define PG8_WAIT_V(n) asm volatile("s_waitcnt vmcnt(" #n ")" ::: "memory")
#define PG8_WAIT_L(n) asm volatile("s_waitcnt lgkmcnt(" #n ")" ::: "memory")
#define PG8_BAR __builtin_amdgcn_s_barrier()
#define PG8_SCHED __builtin_amdgcn_sched_barrier(0)
    Unit cur, nxt; int ui = 0;
    if (!S.next(0, cur)) return;
    f32x4 acc[2][2][4][2];
#pragma unroll
    for (int a = 0; a < 2; ++a)
#pragma unroll
        for (int b = 0; b < 2; ++b)
#pragma unroll
            for (int m = 0; m < 4; ++m)
#pragma unroll
                for (int n = 0; n < 2; ++n) acc[a][b][m][n] = (f32x4){0.f, 0.f, 0.f, 0.f};
    bf16x8 At[4][2], B0[2][2], B1[2][2];
    const size_t khoff = (size_t)(nt / 2) * kstep;
    const char* cA = (const char*)g.A + (size_t)cur.pm * tstep + (cur.kh == 1 ? khoff : 0); const char* cB = (const char*)g.Bt + (size_t)(cur.pm / g.nMper) * g.bstride + (size_t)cur.pn * tstep + (cur.kh == 1 ? khoff : 0);
    PG8_STAGE(PG8_SB(0, 0), cB, voffB); PG8_STAGE(PG8_SA(0, 0), cA, voffA); PG8_STAGE(PG8_SB(0, 1), cB + hstep, voffB); PG8_STAGE(PG8_SA(0, 1), cA + hstep, voffA);
    if (wr == 1) PG8_BAR;
    PG8_WAIT_V(4); PG8_BAR;
    PG8_STAGE(PG8_SB(1, 0), cB + kstep, voffB); PG8_STAGE(PG8_SA(1, 0), cA + kstep, voffA); PG8_STAGE(PG8_SB(1, 1), cB + hstep + kstep, voffB);
    PG8_WAIT_V(6); PG8_BAR;
    for (;;) {
        const bool has_next = S.next(ui + 1, nxt);
        const char* nA = has_next ? (const char*)g.A + (size_t)nxt.pm * tstep + (nxt.kh == 1 ? khoff : 0) : cA; const char* nB = has_next ? (const char*)g.Bt + (size_t)(nxt.pm / g.nMper) * g.bstride + (size_t)nxt.pn * tstep + (nxt.kh == 1 ? khoff : 0) : cB;
        const int ntu = (cur.kh < 0) ? nt : (nt >> 1);
        for (int t = 0; t < ntu; t += 2) {
            const bool last = (t == ntu - 2);
            const char* a1 = cA + (size_t)(t + 1) * kstep;
            const char* a2 = last ? nA : cA + (size_t)(t + 2) * kstep; const char* b2 = last ? nB : cB + (size_t)(t + 2) * kstep;
            const char* a3 = a2 + kstep; const char* b3 = b2 + kstep;
            PG8_LDB(B0, 0, 0); PG8_SCHED; PG8_LDA(At, 0, 0); PG8_STAGE(PG8_SA(1, 1), a1 + hstep, voffA);
            PG8_WAIT_L(8); PG8_BAR; PG8_WAIT_L(0); PG8_MMA(0, 0, At, B0); PG8_BAR; PG8_SCHED;
            PG8_LDB(B1, 0, 1); PG8_STAGE(PG8_SB(0, 0), b2, voffB);
            PG8_BAR; PG8_WAIT_L(0); PG8_MMA(0, 1, At, B1); PG8_BAR;
            PG8_LDA(At, 0, 1); PG8_STAGE(PG8_SA(0, 0), a2, voffA);
            PG8_BAR; PG8_WAIT_L(0); PG8_MMA(1, 0, At, B0); PG8_BAR; PG8_SCHED;
            PG8_STAGE(PG8_SB(0, 1), b2 + hstep, voffB);
            PG8_WAIT_V(6); PG8_BAR; PG8_MMA(1, 1, At, B1); PG8_BAR;
            PG8_LDB(B0, 1, 0); PG8_SCHED; PG8_LDA(At, 1, 0); PG8_STAGE(PG8_SA(0, 1), a2 + hstep, voffA);
            PG8_WAIT_L(8); PG8_BAR; PG8_WAIT_L(0); PG8_MMA(0, 0, At, B0); PG8_BAR; PG8_SCHED;
            PG8_LDB(B1, 1, 1); PG8_STAGE(PG8_SB(1, 0), b3, voffB);
            PG8_BAR; PG8_WAIT_L(0); PG8_MMA(0, 1, At, B1); PG8_BAR;
            PG8_LDA(At, 1, 1); PG8_STAGE(PG8_SA(1, 0), a3, voffA);
            PG8_BAR; PG8_WAIT_L(0); PG8_MMA(1, 0, At, B0); PG8_BAR; PG8_SCHED;
            PG8_STAGE(PG8_SB(1, 1), b3 + hstep, voffB);
            PG8_WAIT_V(6); PG8_BAR; PG8_MMA(1, 1, At, B1); PG8_BAR;
        }
        { const int t2 = otid(wv); const int l2 = t2 & 63, w2 = __builtin_amdgcn_readfirstlane(t2 >> 6); E(acc, cur, w2 >> 2, w2 & 3, l2 & 15, l2 >> 4); }
        if (!has_next) break;
#pragma unroll
        for (int a = 0; a < 2; ++a)
#pragma unroll
            for (int b = 0; b < 2; ++b)
#pragma unroll
                for (int m = 0; m < 4; ++m)
#pragma unroll
                    for (int n = 0; n < 2; ++n) acc[a][b][m][n] = (f32x4){0.f, 0.f, 0.f, 0.f};
        cur = nxt; cA = nA; cB = nB; ++ui;
    }
    PG8_WAIT_V(0);
    if (wr == 0) PG8_BAR;
    PG8_BAR;
#undef PG8_SA
#undef PG8_SB
#undef PG8_STAGE
#undef PG8_LDA
#undef PG8_LDB
#undef PG8_MMA
#undef PG8_WAIT_V
#undef PG8_WAIT_L
#undef PG8_BAR
#undef PG8_SCHED
}

struct EpiBf16 {
    bf16_t* O; int ldc; bf16_t* O2;
    __device__ __forceinline__ void operator()(const f32x4 (&acc)[2][2][4][2], const Unit& u, int wr, int wc, int fr, int fq) const {
        const int row0 = u.pm * BM + wr * 64 + fr, col0 = u.pn * BM + wc * 32 + 8 * fq;
        bf16_t* Ob = (u.kh == 1) ? O2 : O;
#pragma unroll
        for (int ai = 0; ai < 2; ++ai)
#pragma unroll
            for (int m = 0; m < 4; ++m) { bf16_t* rowp = Ob + (size_t)(row0 + ai * HALF + m * 16) * ldc + col0;
#pragma unroll
                for (int bj = 0; bj < 2; ++bj) { const f32x4 v0 = acc[ai][bj][m][0], v1 = acc[ai][bj][m][1];
                    u32x4 w; w.x = cvt_pk_bf16(v0[0], v0[1]); w.y = cvt_pk_bf16(v0[2], v0[3]); w.z = cvt_pk_bf16(v1[0], v1[1]); w.w = cvt_pk_bf16(v1[2], v1[3]);
                    *(u32x4*)(rowp + bj * HALF) = w; } }
    }
};
struct EpiF32 {
    float* C; int ldc;
    __device__ __forceinline__ void operator()(const f32x4 (&acc)[2][2][4][2], const Unit& u, int wr, int wc, int fr, int fq) const {
        const int row0 = u.pm * BM + wr * 64 + fr, col0 = u.pn * BM + wc * 32 + 4 * fq;
#pragma unroll
        for (int ai = 0; ai < 2; ++ai)
#pragma unroll
            for (int m = 0; m < 4; ++m) { float* rowp = C + (size_t)(row0 + ai * HALF + m * 16) * ldc + col0;
#pragma unroll
                for (int bj = 0; bj < 2; ++bj)
#pragma unroll
                    for (int n = 0; n < 2; ++n) *(f32x4*)(rowp + bj * HALF + n * 16) = acc[ai][bj][m][n]; }
    }
};
struct EpiVT {
    bf16_t* VTs; bf16_t* VTp;
    __device__ __forceinline__ void operator()(const f32x4 (&acc)[2][2][4][2], const Unit& u, int wr, int wc, int fr, int fq) const {
        const int KR0 = u.pn * BM;
        bf16_t* vt; int Lk;
        if (KR0 < BS * LKS) { const int b = KR0 / LKS; Lk = LKS; vt = VTs + (size_t)b * 1024 * LKS + (KR0 - b * LKS); }
        else { const int b = (KR0 - BS * LKS) >> 8; Lk = LP; vt = VTp + (size_t)b * 1024 * LP; }
        const int row0 = u.pm * BM + wr * 64 + fr, col0 = wc * 32 + 8 * fq;
#pragma unroll
        for (int ai = 0; ai < 2; ++ai)
#pragma unroll
            for (int m = 0; m < 4; ++m) { bf16_t* rowp = vt + (size_t)(row0 + ai * HALF + m * 16) * Lk + col0;
#pragma unroll
                for (int bj = 0; bj < 2; ++bj) { const f32x4 v0 = acc[ai][bj][m][0], v1 = acc[ai][bj][m][1];
                    u32x4 w; w.x = cvt_pk_bf16(v0[0], v0[1]); w.y = cvt_pk_bf16(v0[2], v0[3]); w.z = cvt_pk_bf16(v1[0], v1[1]); w.w = cvt_pk_bf16(v1[2], v1[3]);
                    *(u32x4*)(rowp + bj * HALF) = w; } }
    }
};
template <int P> struct EpiGate {
    const bf16_t* gates; float* m32; bf16_t* mbf;
    __device__ __forceinline__ void operator()(const f32x4 (&acc)[2][2][4][2], const Unit& u, int wr, int wc, int fr, int fq) const {
        const int row0 = u.pm * BM + wr * 64 + fr, col0 = u.pn * BM + wc * 32 + 4 * fq;
#pragma unroll
        for (int ai = 0; ai < 2; ++ai)
#pragma unroll
            for (int m = 0; m < 4; ++m) {
                const size_t row = (size_t)(row0 + ai * HALF + m * 16);
#pragma unroll
                for (int bj = 0; bj < 2; ++bj)
#pragma unroll
                    for (int n = 0; n < 2; ++n) {
                        const int col = col0 + bj * HALF + n * 16;
                        const u32x2 gw = *(const u32x2*)(gates + row * GATE_LD + P * 2048 + col);
                        f32x4 v = acc[ai][bj][m][n];
                        v[0] *= sigmoidf_(bf_lo(gw.x)); v[1] *= sigmoidf_(bf_hi(gw.x)); v[2] *= sigmoidf_(bf_lo(gw.y)); v[3] *= sigmoidf_(bf_hi(gw.y));
                        float* mp = m32 + row * 2048 + col;
                        if (P == 0) { *(f32x4*)mp = v; }
                        else if (P == 1) { const f32x4 o = *(const f32x4*)mp; *(f32x4*)mp = o + v; }
                        else { const f32x4 o = *(const f32x4*)mp; v = v + o; u32x2 w; w.x = cvt_pk_bf16(v[0], v[1]); w.y = cvt_pk_bf16(v[2], v[3]); *(u32x2*)(mbf + row * 2048 + col) = w; }
                    }
            }
    }
};
}

template <class Epi>
__device__ __forceinline__ void run_gemm(int wv, LAS unsigned char* lds, const bf16_t* A, const bf16_t* Bt, int M, int N, int K, const Epi& E, bool split = false, int nMper = 1 << 28, size_t bstride = 0, bool rev = false) {
    pg8::Gemm g; g.A = A; g.Bt = Bt; g.M = M; g.N = N; g.K = K; g.nMper = nMper; g.bstride = bstride;
    pg8::StaticOrder S; S.init(M, N, (int)gridDim.x, rev ? (int)gridDim.x - 1 - obid() : obid(), split);
    pg8::gemm_phase<Epi>(wv, lds, g, S, E);
    __syncthreads();
}

__device__ __forceinline__ void convT(int wv, const float* __restrict__ src, int K, int N, bf16_t* __restrict__ dst, int gate_shift, LAS unsigned char* lds) {
    const int tid = otid(wv), lane = tid & 63, kq = lane & 7, ng = lane >> 3;
    const int tn = N / 32, tk = K / 64, ntile = tn * tk, nwaves = gridDim.x * 8;
    for (int tile = obid() * 8 + (tid >> 6); tile < ntile; tile += 2 * nwaves) {
        const int tile2 = tile + nwaves; const bool has2 = tile2 < ntile;
        const int tkk = tile / tn, tnn = tile - tkk * tn, k0 = tkk * 64 + 8 * kq, n0 = tnn * 32 + 4 * ng;
        const int tkk2 = has2 ? tile2 / tn : tkk, tnn2 = has2 ? tile2 - tkk2 * tn : tnn, k02 = tkk2 * 64 + 8 * kq, n02 = tnn2 * 32 + 4 * ng;
        f32x4 v[8], v2[8];
#pragma unroll
        for (int i = 0; i < 8; ++i) v[i] = *(const f32x4*)(src + (size_t)(k0 + i) * N + n0);
#pragma unroll
        for (int i = 0; i < 8; ++i) v2[i] = *(const f32x4*)(src + (size_t)(k02 + i) * N + n02);
#pragma unroll
        for (int j = 0; j < 4; ++j) {
            int nd = n0 + j; if (gate_shift == 1 && nd >= NGATE0) nd += 192; if (gate_shift == 2) { const int hd = nd >> 8, wi = nd & 255; nd = (wi < 128) ? hd * 128 + wi : 1024 + hd * 128 + (wi - 128); }
            u32x4 w; w.x = cvt_pk_bf16(v[0][j], v[1][j]); w.y = cvt_pk_bf16(v[2][j], v[3][j]); w.z = cvt_pk_bf16(v[4][j], v[5][j]); w.w = cvt_pk_bf16(v[6][j], v[7][j]);
            *(u32x4*)(dst + (size_t)nd * K + k0) = w;
        }
        if (has2) {
#pragma unroll
            for (int j = 0; j < 4; ++j) {
                int nd = n02 + j; if (gate_shift == 1 && nd >= NGATE0) nd += 192; if (gate_shift == 2) { const int hd = nd >> 8, wi = nd & 255; nd = (wi < 128) ? hd * 128 + wi : 1024 + hd * 128 + (wi - 128); }
                u32x4 w; w.x = cvt_pk_bf16(v2[0][j], v2[1][j]); w.y = cvt_pk_bf16(v2[2][j], v2[3][j]); w.z = cvt_pk_bf16(v2[4][j], v2[5][j]); w.w = cvt_pk_bf16(v2[6][j], v2[7][j]);
                *(u32x4*)(dst + (size_t)nd * K + k02) = w;
            }
        }
    }
}

__device__ __forceinline__ void ada_phase(int wv, const Params& p, LAS unsigned char* lds) {
    LAS float* sl = (LAS float*)lds;
    float* mod = (float*)(p.ws + S_MOD);
    const int tid = otid(wv);
    for (int u = obid(); u < NLAYER * 8 * 16; u += gridDim.x) {
        const int l = u / 128, r = u % 128, cb = r % 8, kc = r / 8, k0 = kc * 128;
        for (int i = tid; i < 9 * 128; i += NTHREADS) { const int v = i >> 7, k = i & 127; const float x = (v == 0) ? p.in[I_CCTX][k0 + k] : p.in[I_C][(v - 1) * DM + k0 + k]; sl[i] = siluf_(x); }
        __syncthreads();
        const bool act = tid < 384; const int col = cb * 1536 + (act ? tid : 0) * 4;
        f32x4 acc[9];
#pragma unroll
        for (int i = 0; i < 9; ++i) acc[i] = (f32x4){0.f, 0.f, 0.f, 0.f};
        const float* wp = p.in[I_ADAW] + ((size_t)l * DM + k0) * 12288 + col;
#pragma unroll 8
        for (int k = 0; k < 128; ++k) {
            const f32x4 w = *(const f32x4*)(wp + (size_t)k * 12288);
#pragma unroll
            for (int i = 0; i < 9; ++i) acc[i] += sl[i * 128 + k] * w;
        }
#pragma unroll
        for (int i = 0; i < 9; ++i) if (act) *(f32x4*)(mod + ((size_t)(l * 16 + kc) * 9 + i) * 12288 + col) = acc[i];
        __syncthreads();
    }
}

__device__ __forceinline__ void filter_phase(int wv, const Params& p, int l, LAS unsigned char* lds) {
    LAS float* z = (LAS float*)lds;
    LAS float* H1 = z + 32 * 33;
    LAS float* H2 = H1 + 32 * 64;
    LAS float* W1 = H2 + 32 * 64;
    LAS float* W2 = W1 + 33 * 64;
    LAS float* BF = W2 + 64 * 64;
    const int tid = otid(wv);
    const float* w3 = p.in[I_FW3] + (size_t)l * 64 * 2048; const float* b3 = p.in[I_FB3] + l * 2048;
    for (int u = obid(); u < 72; u += gridDim.x) {
        const int g = (u < 64) ? 1 : 0; const int tc = g ? u : u - 64; const int L = g ? LS : LP; const int t0 = tc * 32;
        float* kT = (float*)(p.ws + (g ? S_KTS : S_KTP)); float* part = (float*)(p.ws + (g ? S_PARTS : S_PARTP));
        for (int i = tid; i < 33 * 64; i += NTHREADS) W1[i] = p.in[I_FW1][(size_t)l * 33 * 64 + i];
        for (int i = tid; i < 64 * 64; i += NTHREADS) W2[i] = p.in[I_FW2][(size_t)l * 64 * 64 + i];
        if (tid < 64) BF[tid] = p.in[I_FB1][l * 64 + tid]; else if (tid < 128) BF[tid] = p.in[I_FB2][l * 64 + tid - 64]; else if (tid < 256) BF[tid] = p.in[I_FFREQ][l * 128 + tid - 128];
        for (int i = tid; i < 32 * 33; i += NTHREADS) {
            const int t = i / 33, e = i - t * 33; const float tf = (float)(t0 + t);
            float v;
            if (e == 0) v = tf / (float)(L - 1);
            else { const int k = (e - 1) & 15; const float band = 1e-4f + (float)k * ((15.0f - 1e-4f) / 15.0f); const float w = (6.283185307179586f * tf) / (float)L; const float ang = w * band;
                   v = (e <= 16) ? cosf(ang) : -sinf(ang); }
            z[i] = v;
        }
        __syncthreads();
#pragma unroll
        for (int q = 0; q < 4; ++q) { const int i = tid + q * NTHREADS; const int t = i >> 6, j = i & 63; float s = BF[j];
#pragma unroll
            for (int e = 0; e < 33; ++e) s += z[t * 33 + e] * W1[e * 64 + j];
            H1[i] = sinf(BF[128 + j] * s); }
        __syncthreads();
#pragma unroll
        for (int q = 0; q < 4; ++q) { const int i = tid + q * NTHREADS; const int t = i >> 6, j = i & 63; float s = BF[64 + j];
#pragma unroll 16
            for (int e = 0; e < 64; ++e) s += H1[t * 64 + e] * W2[e * 64 + j];
            H2[i] = sinf(BF[192 + j] * s); }
        __syncthreads();
        const int c = tid * 4;
        const f32x4 bias = *(const f32x4*)(b3 + c);
        f32x4 delta;
#pragma unroll
        for (int j = 0; j < 4; ++j) { const int d = (c + j) & 1023; const float mn = -3.0701134573253945f, mx = -15.350567286626973f; delta[j] = fabsf(mn + (float)d * ((mx - mn) / 1023.0f)); }
        f32x4 psum = (f32x4){0.f, 0.f, 0.f, 0.f};
        for (int tb = 0; tb < 2; ++tb) {
            f32x4 acc[16];
#pragma unroll
            for (int i = 0; i < 16; ++i) acc[i] = bias;
#pragma unroll 8
            for (int k = 0; k < 64; ++k) {
                const f32x4 w = *(const f32x4*)(w3 + (size_t)k * 2048 + c);
#pragma unroll
                for (int i = 0; i < 16; ++i) acc[i] += H2[(tb * 16 + i) * 64 + k] * w;
            }
#pragma unroll
            for (int i = 0; i < 16; ++i) {
                const int t = t0 + tb * 16 + i; const float tn = (float)t / (float)(L - 1);
#pragma unroll
                for (int j = 0; j < 4; ++j) {
                    const float v = acc[i][j] * __expf(-tn * delta[j]);
                    const int cc = c + j;
                    if (cc < 1024) { kT[(size_t)cc * (2 * L) + t] = v; psum[j] += fabsf(v); }
                    else { const int d = cc - 1024; if (t == 0) kT[(size_t)d * (2 * L) + L] = 0.f; else { kT[(size_t)d * (2 * L) + 2 * L - t] = v; psum[j] += fabsf(v); } }
                }
            }
        }
        *(f32x4*)(part + (size_t)tc * 2048 + c) = psum;
        __syncthreads();
    }
}

__device__ __forceinline__ void row_sel(const Params& p, int l, int mode, int& l2, int& shi, int& sci, const float*& prew, bool& wh, int& gi, const float*& pw) {
    wh = true;
    if (mode == 0) { l2 = l; shi = 0; sci = 1; prew = p.in[I_NMPRE] + l * DM; }
    else if (mode == 1) { l2 = l; shi = 3; sci = 4; prew = p.in[I_NFPRE] + l * DM; }
    else { l2 = l + 1; shi = 0; sci = 1; wh = (l + 1 < NLAYER); if (!wh) l2 = l; prew = p.in[I_NMPRE] + l2 * DM; }
    gi = (mode == 1) ? 2 : 5;
    pw = p.in[mode == 1 ? I_NMPOST : I_NFPOST] + l * DM;
}
__device__ __forceinline__ void comb_phase(int wv, const Params& p) {
    const int tid = otid(wv);
    const float* mod = (const float*)(p.ws + S_MOD); float* comb = (float*)(p.ws + S_COMB);
    for (int idx = obid() * NTHREADS + tid; idx < NLAYER * 3 * 9 * 2048; idx += gridDim.x * NTHREADS) {
        const int c = idx & 2047, q = idx >> 11, mi = q % 9, q2 = q / 9, mode = q2 % 3, l = q2 / 3;
        int l2, shi, sci, gi; const float* prew; const float* pw; bool wh;
        row_sel(p, l, mode, l2, shi, sci, prew, wh, gi, pw);
        float g = 0.f, sc = 0.f, sh = 0.f;
        for (int kc = 0; kc < 16; ++kc) {
            g += mod[((size_t)(l * 16 + kc) * 9 + mi) * 12288 + gi * 2048 + c];
            sc += mod[((size_t)(l2 * 16 + kc) * 9 + mi) * 12288 + sci * 2048 + c];
            sh += mod[((size_t)(l2 * 16 + kc) * 9 + mi) * 12288 + shi * 2048 + c];
        }
        g += p.in[I_ADAB][(size_t)l * 12288 + gi * 2048 + c];
        sc += p.in[I_ADAB][(size_t)l2 * 12288 + sci * 2048 + c];
        sh += p.in[I_ADAB][(size_t)l2 * 12288 + shi * 2048 + c];
        float* o = comb + (size_t)q * 3 * 2048 + c;
        o[0] = g * pw[c]; o[2048] = prew[c] * (1.0f + sc); o[4096] = sh;
    }
}
__device__ __forceinline__ void row_phase(int wv, const Params& p, int l, int mode) {
    const int tid = otid(wv); const int wave = obid() * 8 + (tid >> 6), nw = gridDim.x * 8, lane = tid & 63;
    float* X = p.out;
    bf16_t* H = (bf16_t*)(p.ws + A_H);
    const bool wh = !(mode == 2 && l + 1 >= NLAYER);
    const int rows_per = (MT + nw - 1) / nw;
    int cur_mi = -1; f32x4 cpre[8], csh[8], cgv[8];
    for (int rr = 0; rr < rows_per; ++rr) {
        const int row = wave * rows_per + rr;
        if (row >= MT) break;
        const int mi = row < MP ? 0 : 1 + ((row - MP) >> 11);
        const float* cb = (const float*)(p.ws + S_COMB) + (size_t)((l * 3 + mode) * 9 + mi) * 3 * 2048 + lane * 4;
        if (mi != cur_mi) { cur_mi = mi;
#pragma unroll
            for (int i = 0; i < 8; ++i) { cpre[i] = *(const f32x4*)(cb + 2048 + i * 256); csh[i] = *(const f32x4*)(cb + 4096 + i * 256); if (mode != 0) cgv[i] = *(const f32x4*)(cb + i * 256); } }
        f32x4 x[8];
        const float* xs = (mode == 0) ? (row < MP ? p.in[I_XP] + (size_t)row * DM : p.in[I_XS] + (size_t)(row - MP) * DM) : X + (size_t)row * DM;
#pragma unroll
        for (int i = 0; i < 8; ++i) x[i] = *(const f32x4*)(xs + i * 256 + lane * 4);
        if (mode != 0) {
            const bf16_t* o = (const bf16_t*)(p.ws + (mode == 1 ? A_M32 : A_F32)) + (size_t)row * DM;
            const unsigned tm = ((const unsigned*)(p.ws + S_TAIL))[row >> 8];
            f32x4 ovv[8]; float ss = 0.f;
#pragma unroll
            for (int i = 0; i < 8; ++i) { const u32x2 w = *(const u32x2*)(o + i * 256 + lane * 4); ovv[i] = (f32x4){bf_lo(w.x), bf_hi(w.x), bf_lo(w.y), bf_hi(w.y)};
                if ((tm >> i) & 1u) { const u32x2 w2 = *(const u32x2*)(o + (size_t)MT * DM + i * 256 + lane * 4); ovv[i] += (f32x4){bf_lo(w2.x), bf_hi(w2.x), bf_lo(w2.y), bf_hi(w2.y)}; }
                ss += ovv[i][0] * ovv[i][0] + ovv[i][1] * ovv[i][1] + ovv[i][2] * ovv[i][2] + ovv[i][3] * ovv[i][3]; }
            ss = wave_sum(ss, lane);
            const float rstd = rsqrtf(ss * (1.0f / DM) + 1e-6f);
#pragma unroll
            for (int i = 0; i < 8; ++i) x[i] += cgv[i] * (ovv[i] * rstd);
        }
#pragma unroll
        for (int i = 0; i < 8; ++i) *(f32x4*)(X + (size_t)row * DM + i * 256 + lane * 4) = x[i];
        if (wh) {
            float ss = 0.f;
#pragma unroll
            for (int i = 0; i < 8; ++i) ss += x[i][0] * x[i][0] + x[i][1] * x[i][1] + x[i][2] * x[i][2] + x[i][3] * x[i][3];
            ss = wave_sum(ss, lane);
            const float rstd = rsqrtf(ss * (1.0f / DM) + 1e-6f);
#pragma unroll
            for (int i = 0; i < 8; ++i) {
                const f32x4 hv = (x[i] * rstd) * cpre[i] + csh[i];
                u32x2 o; o.x = cvt_pk_bf16(hv[0], hv[1]); o.y = cvt_pk_bf16(hv[2], hv[3]);
                *(u32x2*)(H + (size_t)row * DM + i * 256 + lane * 4) = o;
            }
        }
    }
}

__device__ __forceinline__ void rope_table_phase(int wv, const Params& p) {
    float* C = (float*)(p.ws + S_ROPE); float* Sn = C + 2048 * 32;
    const int tid = otid(wv);
    for (int idx = obid() * NTHREADS + tid; idx < 2048 * 32; idx += gridDim.x * NTHREADS) {
        const int t = idx >> 5, i = idx & 31, k = i & 15;
        const float inv = exp2f(-(float)k * 0.8304820237218406f);
        const float pos = (i < 16) ? (float)(t >> 6) : (float)(t & 63);
        const float ang = pos * inv; C[idx] = cosf(ang); Sn[idx] = sinf(ang);
    }
}
__device__ __forceinline__ void e2_phase(int wv, const Params& p, int l, LAS unsigned char* lds) {
    const bf16_t* PA = (const bf16_t*)(p.ws + A_PROJA);
    const int tid = otid(wv), lane = tid & 63;
    {
        for (int gw = obid() * 8 + (tid >> 6); gw < 2048; gw += gridDim.x * 8) {
            const int g = gw >> 10, d = gw & 1023; const int NU = g ? 64 : 8;
            const float* part = (const float*)(p.ws + (g ? S_PARTS : S_PARTP));
            float v = 0.f;
            if (lane < NU) v = part[lane * 2048 + d] + part[lane * 2048 + 1024 + d];
            v = wave_sum(v, lane);
            if (lane == 0) ((float*)(p.ws + S_SCALE))[gw] = 1.0f / v;
        }
    }
    {
        bf16_t* CQN = (bf16_t*)(p.ws + A_CQN); bf16_t* KC = (bf16_t*)(p.ws + A_KEYSC); bf16_t* KP = (bf16_t*)(p.ws + A_KPER);
        float* out_ckv = p.out + (size_t)MT * DM; float* out_kpe = out_ckv + (size_t)BP * NLAYER * LP * 256;
        const int wave = obid() * 8 + (tid >> 6), nw = gridDim.x * 8;
        for (int row = wave; row < MT + BS * PAST; row += nw) {
            if (row < MT) {
                const bf16_t* pr = PA + (size_t)row * PA_LD;
                { const u32x4 v = *(const u32x4*)(pr + 3072 + lane * 8); float f[8]; unpack8(v, f); float ss = 0.f;
#pragma unroll
                  for (int j = 0; j < 8; ++j) ss += f[j] * f[j];
                  ss = wave_sum(ss, lane); const float rstd = rsqrtf(ss * (1.0f / 512.0f) + 1e-6f);
                  const float* qn = p.in[I_QN] + l * 512 + lane * 8;
#pragma unroll
                  for (int j = 0; j < 8; ++j) f[j] = f[j] * rstd * qn[j];
                  *(u32x4*)(CQN + (size_t)row * 512 + lane * 8) = pack8(f); }
                int KR, t; const bool isp = row < MP; int b;
                if (isp) { b = row >> 8; t = row & 255; KR = BS * LKS + row; } else { const int r2 = row - MP; b = r2 >> 11; t = r2 & 2047; KR = b * LKS + t; }
                { const u32x2 v = *(const u32x2*)(pr + 3584 + lane * 4); float f[4] = {bf_lo(v.x), bf_hi(v.x), bf_lo(v.y), bf_hi(v.y)};
                  float ss = f[0] * f[0] + f[1] * f[1] + f[2] * f[2] + f[3] * f[3]; ss = wave_sum(ss, lane); const float rstd = rsqrtf(ss * (1.0f / 256.0f) + 1e-6f);
                  const float* kn = p.in[I_KVN] + l * 256 + lane * 4;
#pragma unroll
                  for (int j = 0; j < 4; ++j) f[j] = f[j] * rstd * kn[j];
                  if (isp) *(f32x4*)(out_ckv + ((size_t)(b * NLAYER + l) * LP + t) * 256 + lane * 4) = (f32x4){f[0], f[1], f[2], f[3]};
                  u32x2 w; w.x = cvt_pk_bf16(f[0], f[1]); w.y = cvt_pk_bf16(f[2], f[3]); *(u32x2*)(KC + (size_t)KR * 256 + lane * 4) = w; }
                { const float v = __uint_as_float(((unsigned)pr[3840 + lane]) << 16);
                  float o = v;
                  if (isp) out_kpe[((size_t)(b * NLAYER + l) * LP + t) * 64 + lane] = v;
                  else { const float pv = shx(v, 32, lane); const float* rc = (const float*)(p.ws + S_ROPE); const float cs = rc[t * 32 + (lane & 31)], sn = rc[2048 * 32 + t * 32 + (lane & 31)]; o = (lane < 32) ? (v * cs - pv * sn) : (pv * sn + v * cs); }
                  KP[(size_t)KR * 64 + lane] = f2bf(o); }
            } else {
                const int r2 = row - MT, b = r2 >> 9, j = r2 & 511; const int KR = b * LKS + LS + j;
                const float* cc = p.in[I_CCKV] + ((size_t)(b * NLAYER + l) * PAST + j) * 256 + lane * 4;
                const f32x4 v = *(const f32x4*)cc; u32x2 w; w.x = cvt_pk_bf16(v[0], v[1]); w.y = cvt_pk_bf16(v[2], v[3]); *(u32x2*)(KC + (size_t)KR * 256 + lane * 4) = w;
                KP[(size_t)KR * 64 + lane] = f2bf(p.in[I_CKPE][((size_t)(b * NLAYER + l) * PAST + j) * 64 + lane]);
            }
        }
    }
    {
        bf16_t* YC = (bf16_t*)(p.ws + A_YC); const float* scw = p.in[I_SCW] + (size_t)l * 3 * 1024;
        float w0[8], w1[8], w2[8]; int cur_d0 = -1;
        for (int it = obid() * NTHREADS + tid; it < (MT / 4) * 128; it += gridDim.x * NTHREADS) {
            const int ch = it >> 7, d0 = (it & 127) * 8, row0 = ch * 4;
            const int t0 = row0 < MP ? (row0 & 255) : ((row0 - MP) & 2047); const int L = row0 < MP ? LP : LS;
            if (d0 != cur_d0) { cur_d0 = d0; const f32x4 a = *(const f32x4*)(scw + d0), b = *(const f32x4*)(scw + d0 + 4), c = *(const f32x4*)(scw + 1024 + d0), d = *(const f32x4*)(scw + 1024 + d0 + 4),
                          e2 = *(const f32x4*)(scw + 2048 + d0), f = *(const f32x4*)(scw + 2048 + d0 + 4);
#pragma unroll
              for (int j = 0; j < 4; ++j) { w0[j] = a[j]; w0[4 + j] = b[j]; w1[j] = c[j]; w1[4 + j] = d[j]; w2[j] = e2[j]; w2[4 + j] = f[j]; } }
            const bf16_t* pr = PA + (size_t)row0 * PA_LD;
            float pp[8], pc[8], pn[8];
#pragma unroll
            for (int j = 0; j < 8; ++j) pp[j] = 0.f;
            if (t0 > 0) { float cg[8], uu[8]; unpack8(*(const u32x4*)(pr - PA_LD + 4928 + d0), cg); unpack8(*(const u32x4*)(pr - PA_LD + 5952 + d0), uu);
#pragma unroll
                for (int j = 0; j < 8; ++j) pp[j] = cg[j] * uu[j]; }
            { float cg[8], uu[8]; unpack8(*(const u32x4*)(pr + 4928 + d0), cg); unpack8(*(const u32x4*)(pr + 5952 + d0), uu);
#pragma unroll
              for (int j = 0; j < 8; ++j) pc[j] = cg[j] * uu[j]; }
#pragma unroll
            for (int i = 0; i < 4; ++i) {
#pragma unroll
                for (int j = 0; j < 8; ++j) pn[j] = 0.f;
                if (t0 + i + 1 < L) { float cg[8], uu[8]; unpack8(*(const u32x4*)(pr + (size_t)(i + 1) * PA_LD + 4928 + d0), cg); unpack8(*(const u32x4*)(pr + (size_t)(i + 1) * PA_LD + 5952 + d0), uu);
#pragma unroll
                    for (int j = 0; j < 8; ++j) pn[j] = cg[j] * uu[j]; }
                float bg[8], o[8]; unpack8(*(const u32x4*)(pr + (size_t)i * PA_LD + 3904 + d0), bg);
#pragma unroll
                for (int j = 0; j < 8; ++j) { o[j] = bg[j] * (w0[j] * pp[j] + w1[j] * pc[j] + w2[j] * pn[j]); pp[j] = pc[j]; pc[j] = pn[j]; }
                *(u32x4*)(YC + (size_t)(row0 + i) * 1024 + d0) = pack8(o);
            }
        }
    }
    {
        bf16_t* X0S = (bf16_t*)(p.ws + A_X0S); bf16_t* ZZT = (bf16_t*)(p.ws + A_ZZT);
        const float* hw = p.in[I_HCW] + (size_t)l * 3 * 3072; const float* hb = p.in[I_HCB] + (size_t)l * 3072;
        LAS bf16_t* zt = (LAS bf16_t*)lds;
        float wgt[3][3][8], bs[3][8]; int cur_dt = -1;
        for (int u = obid(); u < (MT / 256) * 16; u += gridDim.x) {
            const int rt = u >> 4, dt = u & 15; const int row0 = rt * 256;
            const int dg = tid & 7, rb = tid >> 3, d0 = dt * 64 + dg * 8; const int rowb = row0 + rb * 4;
            const int L = row0 < MP ? LP : LS; const int tb = (row0 < MP ? (row0 & 255) : ((row0 - MP) & 2047)) + rb * 4;
            const bool reload = (dt != cur_dt); cur_dt = dt;
            if (reload)
#pragma unroll
            for (int g = 0; g < 3; ++g) {
#pragma unroll
                for (int o = 0; o < 3; ++o) { const f32x4 a = *(const f32x4*)(hw + o * 3072 + g * 1024 + d0), b = *(const f32x4*)(hw + o * 3072 + g * 1024 + d0 + 4);
#pragma unroll
                    for (int j = 0; j < 4; ++j) { wgt[g][o][j] = a[j]; wgt[g][o][4 + j] = b[j]; } }
                const f32x4 a = *(const f32x4*)(hb + g * 1024 + d0), b = *(const f32x4*)(hb + g * 1024 + d0 + 4);
#pragma unroll
                for (int j = 0; j < 4; ++j) { bs[g][j] = a[j]; bs[g][4 + j] = b[j]; }
            }
            const bf16_t* pr = PA + (size_t)rowb * PA_LD + d0;
            u32x4 wp[3], wc[3], wn[3];
#pragma unroll
            for (int g = 0; g < 3; ++g) { wp[g] = (u32x4){0u, 0u, 0u, 0u}; if (tb > 0) wp[g] = *(const u32x4*)(pr - PA_LD + g * 1024); wc[g] = *(const u32x4*)(pr + g * 1024); }
#pragma unroll
            for (int i = 0; i < 4; ++i) {
#pragma unroll
                for (int g = 0; g < 3; ++g) { wn[g] = (u32x4){0u, 0u, 0u, 0u}; if (tb + i + 1 < L) wn[g] = *(const u32x4*)(pr + (size_t)(i + 1) * PA_LD + g * 1024); }
                float hv[3][8];
#pragma unroll
                for (int g = 0; g < 3; ++g) { float a[8], b[8], c[8]; unpack8(wp[g], a); unpack8(wc[g], b); unpack8(wn[g], c);
#pragma unroll
                    for (int j = 0; j < 8; ++j) hv[g][j] = bs[g][j] + wgt[g][0][j] * a[j] + wgt[g][1][j] * b[j] + wgt[g][2][j] * c[j];
                    wp[g] = wc[g]; wc[g] = wn[g]; }
                *(u32x4*)(X0S + (size_t)(rowb + i) * 1024 + d0) = pack8(hv[0]);
#pragma unroll
                for (int j = 0; j < 8; ++j) zt[(dg * 8 + j) * 264 + rb * 4 + i] = f2bf(hv[1][j] * hv[2][j]);
            }
            __syncthreads();
#pragma unroll
            for (int i = 0; i < 4; ++i) {
                const int chunk = tid + i * NTHREADS; const int dl = chunk >> 5, tch = chunk & 31; const int d = dt * 64 + dl;
                size_t base; int t0;
                if (row0 < MP) { const int b = row0 >> 8; t0 = 0; base = ((size_t)b * 1024 + d) * LP; }
                else { const int r2 = row0 - MP; const int b = r2 >> 11; t0 = r2 & 2047; base = (size_t)BP * 1024 * LP + ((size_t)b * 1024 + d) * LS; }
                *(u32x4*)(ZZT + base + t0 + tch * 8) = *(const LAS u32x4*)(zt + dl * 264 + tch * 8);
            }
            __syncthreads();
        }
    }
}

__device__ __forceinline__ void conv_phase(int wv, const Params& p, int l, LAS unsigned char* lds) {
    const int tid = otid(wv), wid = tid >> 6, lane = tid & 63, r = lane & 31, hh = lane >> 5;
    const bf16_t* ZZT = (const bf16_t*)(p.ws + A_ZZT); bf16_t* YCT = (bf16_t*)(p.ws + A_YCT);
    const float* hbias = p.in[I_HBIAS] + l * 1024;
    LAS bf16_t* cp = (LAS bf16_t*)lds;
    LAS bf16_t* zz = (LAS bf16_t*)(lds + 65536);
    LAS float* kf = (LAS float*)(lds + 98304);
    for (int u = obid(); u < 2048; u += gridDim.x) {
        const int g = (u < 1024) ? 1 : 0, d = u & 1023;
        const int L = g ? LS : LP, B = g ? BS : BP, L2 = 2 * L, NB = L / 32, NI = 32 / B, NT = NB / NI, lgB = g ? 3 : 4;
        const float* kT = (const float*)(p.ws + (g ? S_KTS : S_KTP)) + (size_t)d * L2;
        const float scale = ((const float*)(p.ws + S_SCALE))[g * 1024 + d]; const float bias = hbias[d];
        for (int i = tid; i < L2 / 4; i += NTHREADS) { f32x4 v = *(const f32x4*)(kT + i * 4); v *= scale; if (i == 0) v[0] += bias; *(LAS f32x4*)(kf + i * 4) = v; }
        const size_t zbase = g ? (size_t)BP * 1024 * LP : 0;
        for (int ch = tid; ch < B * L / 8; ch += NTHREADS) {
            const int b = ch / (L / 8), s8 = ch - b * (L / 8);
            *(LAS u32x4*)(zz + b * L + s8 * 8) = *(const u32x4*)(ZZT + zbase + ((size_t)b * 1024 + d) * L + s8 * 8);
        }
        __syncthreads();
        for (int ck = tid; ck < L2; ck += NTHREADS) {
            const int c = ck / (L2 / 8), m0 = (ck - c * (L2 / 8)) * 8;
            float f[8];
#pragma unroll
            for (int j = 0; j < 8; ++j) f[j] = kf[(L2 - (m0 + c + j)) & (L2 - 1)];
            *(LAS u32x4*)(cp + c * L2 + m0) = pack8(f);
        }
        __syncthreads();
        const int Iloc = r >> lgB, b = r & (B - 1);
        for (int nt = wid * 2; nt < NT; nt += 16) {
            const int I0 = nt * NI;
            f32x16 acc0, acc1;
#pragma unroll
            for (int i = 0; i < 16; ++i) { acc0[i] = 0.f; acc1[i] = 0.f; }
            const bf16x8 zero8 = (bf16x8){0, 0, 0, 0, 0, 0, 0, 0};
            bf16x8 prev[4][2];
#pragma unroll
            for (int i = 0; i < 4; ++i) { prev[i][0] = zero8; prev[i][1] = zero8; }
            const int dl0 = I0 - (NB - 1), nsteps = NB + 2 * NI - 1;
            if (NI == 4) {
                for (int c4 = 0; c4 < nsteps; c4 += 4) {
                    bf16x8 cur[4][2];
#pragma unroll
                    for (int i = 0; i < 4; ++i) {
                        const int dl = dl0 + c4 + i; const int J0 = I0 + Iloc - dl; const bool v0 = (J0 >= 0) && (J0 < NB);
#pragma unroll
                        for (int ks = 0; ks < 2; ++ks) {
                            const int i0 = (16 * ks + 8 * hh - 32 * dl - r) & (L2 - 1); const int c = i0 & 7, q = i0 >> 3;
                            const bf16x8 Af = *(const LAS bf16x8*)(cp + c * L2 + q * 8);
                            cur[i][ks] = zero8;
                            if (v0) cur[i][ks] = *(const LAS bf16x8*)(zz + b * L + 32 * J0 + 16 * ks + 8 * hh);
                            acc0 = __builtin_amdgcn_mfma_f32_32x32x16_bf16(Af, cur[i][ks], acc0, 0, 0, 0);
                            acc1 = __builtin_amdgcn_mfma_f32_32x32x16_bf16(Af, prev[i][ks], acc1, 0, 0, 0);
                        }
                    }
#pragma unroll
                    for (int i = 0; i < 4; ++i) { prev[i][0] = cur[i][0]; prev[i][1] = cur[i][1]; }
                }
            } else {
                for (int c2 = 0; c2 < nsteps + 1; c2 += 2) {
                    bf16x8 cur[2][2];
#pragma unroll
                    for (int i = 0; i < 2; ++i) {
                        const int dl = dl0 + c2 + i; const int J0 = I0 + Iloc - dl; const bool v0 = (J0 >= 0) && (J0 < NB);
#pragma unroll
                        for (int ks = 0; ks < 2; ++ks) {
                            const int i0 = (16 * ks + 8 * hh - 32 * dl - r) & (L2 - 1); const int c = i0 & 7, q = i0 >> 3;
                            const bf16x8 Af = *(const LAS bf16x8*)(cp + c * L2 + q * 8);
                            cur[i][ks] = zero8;
                            if (v0) cur[i][ks] = *(const LAS bf16x8*)(zz + b * L + 32 * J0 + 16 * ks + 8 * hh);
                            acc0 = __builtin_amdgcn_mfma_f32_32x32x16_bf16(Af, cur[i][ks], acc0, 0, 0, 0);
                            acc1 = __builtin_amdgcn_mfma_f32_32x32x16_bf16(Af, prev[i][ks], acc1, 0, 0, 0);
                        }
                    }
#pragma unroll
                    for (int i = 0; i < 2; ++i) { prev[i][0] = cur[i][0]; prev[i][1] = cur[i][1]; }
                }
            }
            bf16_t* op = YCT + zbase + ((size_t)b * 1024 + d) * L + 32 * (I0 + Iloc) + 4 * hh;
#pragma unroll
            for (int g4 = 0; g4 < 4; ++g4) {
                u32x2 w; w.x = cvt_pk_bf16(acc0[4 * g4], acc0[4 * g4 + 1]); w.y = cvt_pk_bf16(acc0[4 * g4 + 2], acc0[4 * g4 + 3]); *(u32x2*)(op + 8 * g4) = w;
                u32x2 w1; w1.x = cvt_pk_bf16(acc1[4 * g4], acc1[4 * g4 + 1]); w1.y = cvt_pk_bf16(acc1[4 * g4 + 2], acc1[4 * g4 + 3]); *(u32x2*)(op + 32 * NI + 8 * g4) = w1;
            }
        }
        __syncthreads();
    }
}

__device__ __forceinline__ void e3b_phase(int wv, const Params& p, LAS unsigned char* lds) {
    const int tid = otid(wv);
    const bf16_t* X0S = (const bf16_t*)(p.ws + A_X0S); const bf16_t* YCT = (const bf16_t*)(p.ws + A_YCT); bf16_t* YA = (bf16_t*)(p.ws + A_YA);
    LAS bf16_t* yt = (LAS bf16_t*)lds;
    for (int u = obid(); u < (MT / 64) * 16; u += gridDim.x) {
        const int rt = u >> 4, dt = u & 15; const int row0 = rt * 64;
        {
            const int dl = tid >> 3, tch = tid & 7; const int d = dt * 64 + dl;
            size_t base; int t0;
            if (row0 < MP) { const int b = row0 >> 8; t0 = row0 & 255; base = ((size_t)b * 1024 + d) * LP; }
            else { const int r2 = row0 - MP; const int b = r2 >> 11; t0 = r2 & 2047; base = (size_t)BP * 1024 * LP + ((size_t)b * 1024 + d) * LS; }
            const u32x4 v = *(const u32x4*)(YCT + base + t0 + tch * 8);
            const unsigned w[4] = {v.x, v.y, v.z, v.w};
#pragma unroll
            for (int j = 0; j < 4; ++j) { yt[(tch * 8 + 2 * j) * 72 + dl] = (bf16_t)(w[j] & 0xffffu); yt[(tch * 8 + 2 * j + 1) * 72 + dl] = (bf16_t)(w[j] >> 16); }
        }
        __syncthreads();
        {
            const int tl = tid >> 3, dg = tid & 7; const int row = row0 + tl, d0 = dt * 64 + dg * 8;
            float a[8], b[8]; unpack8(*(const LAS u32x4*)(yt + tl * 72 + dg * 8), a); unpack8(*(const u32x4*)(X0S + (size_t)row * 1024 + d0), b);
#pragma unroll
            for (int j = 0; j < 8; ++j) a[j] *= b[j];
            *(u32x4*)(YA + (size_t)row * 1024 + d0) = pack8(a);
        }
        __syncthreads();
    }
}

__device__ __forceinline__ void attn_phase(int wv, const Params& p, LAS unsigned char* lds) {
    const bf16_t* Q = (const bf16_t*)(p.ws + A_Q); const bf16_t* KN = (const bf16_t*)(p.ws + A_KN); const bf16_t* KP = (const bf16_t*)(p.ws + A_KPER);
    const bf16_t* VT = (const bf16_t*)(p.ws + A_VT); bf16_t* O = (bf16_t*)(p.ws + A_OATT);
    LAS unsigned char* Ks = lds;
    LAS unsigned char* Vs = lds + 64 * 400;
    const float sc2 = 0.07216878364870322f * 1.4426950408889634f;
    for (int u0 = obid(); u0 < 512 + 128; u0 += gridDim.x) {
        const int tid = otid(wv), wid = tid >> 6, lane = tid & 63, r = lane & 31, hh = lane >> 5;
        int u = u0;
        if (u0 < 512 && gridDim.x == 256) {
            const int c = u0 & 255, xcd = c & 7, j = c >> 3; u = (u0 & ~255) + ((xcd * 4 + (j >> 3)) * 8 + (j & 7));
        }
        int b, h, row0, Lk, KR0; size_t vtb; bool samp;
        if (u < 512) { samp = true; b = u >> 6; h = (u >> 3) & 7; const int qb = u & 7; row0 = MP + b * LS + qb * 256; Lk = LKS; KR0 = b * LKS; vtb = (size_t)(b * 8 + h) * 128 * LKS; }
        else { samp = false; const int u2 = u - 512; b = u2 >> 3; h = u2 & 7; row0 = b * LP; Lk = LP; KR0 = BS * LKS + b * LP; vtb = (size_t)BS * 8 * 128 * LKS + (size_t)(b * 8 + h) * 128 * LP; }
        const int qrow = row0 + wid * 32 + r;
        bf16x8 qf[12];
        {
            const bf16_t* qp = Q + (size_t)qrow * 1536 + h * 192 + 8 * hh;
            u32x4 qv[12];
#pragma unroll
            for (int s = 0; s < 12; ++s) qv[s] = *(const u32x4*)(qp + 16 * s);
            if (samp) {
                const int t = (qrow - MP) & 2047;
#pragma unroll
                for (int s2 = 0; s2 < 2; ++s2) {
                    float x1[8], x2[8]; unpack8(qv[8 + s2], x1); unpack8(qv[10 + s2], x2);
                    const float* rc = (const float*)(p.ws + S_ROPE) + t * 32 + 16 * s2 + 8 * hh;
                    const f32x4 c0 = *(const f32x4*)rc, c1 = *(const f32x4*)(rc + 4), s0 = *(const f32x4*)(rc + 2048 * 32), s1 = *(const f32x4*)(rc + 2048 * 32 + 4);
#pragma unroll
                    for (int j = 0; j < 8; ++j) { const float cs = (j < 4) ? c0[j & 3] : c1[j & 3], sn = (j < 4) ? s0[j & 3] : s1[j & 3]; const float a = x1[j], c = x2[j]; x1[j] = a * cs - c * sn; x2[j] = a * sn + c * cs; }
                    qv[8 + s2] = pack8(x1); qv[10 + s2] = pack8(x2);
                }
            }
#pragma unroll
            for (int s = 0; s < 12; ++s) qf[s] = __builtin_bit_cast(bf16x8, qv[s]);
        }
        f32x16 oacc[4];
#pragma unroll
        for (int ct = 0; ct < 4; ++ct)
#pragma unroll
            for (int i = 0; i < 16; ++i) oacc[ct][i] = 0.f;
        float mrun = -1e30f, lrun = 0.f;
        const int nkt = Lk / 64;
        u32x4 kst[3], vst[2];
#pragma unroll
        for (int i = 0; i < 3; ++i) { const int ck = tid + i * NTHREADS; const int key = ck / 24, part = ck - key * 24;
            kst[i] = (part < 16) ? *(const u32x4*)(KN + (size_t)(KR0 + key) * 1024 + h * 128 + part * 8) : *(const u32x4*)(KP + (size_t)(KR0 + key) * 64 + (part - 16) * 8); }
#pragma unroll
        for (int i = 0; i < 2; ++i) { const int cv = tid + i * NTHREADS; const int v = cv >> 3, kc = cv & 7; vst[i] = *(const u32x4*)(VT + vtb + (size_t)v * Lk + kc * 8); }
        for (int kt = 0; kt < nkt; ++kt) {
            __syncthreads();
#pragma unroll
            for (int i = 0; i < 3; ++i) { const int ck = tid + i * NTHREADS; const int key = ck / 24, part = ck - key * 24; *(LAS u32x4*)(Ks + key * 400 + part * 16) = kst[i]; }
#pragma unroll
            for (int i = 0; i < 2; ++i) { const int cv = tid + i * NTHREADS; const int v = cv >> 3, kc = cv & 7;
                LAS unsigned char* vp = Vs + v * 144 + (kc >> 1) * 32 + (kc & 1) * 8;
                *(LAS u32x2*)vp = (u32x2){vst[i].x, vst[i].y}; *(LAS u32x2*)(vp + 16) = (u32x2){vst[i].z, vst[i].w}; }
            __syncthreads();
            if (kt + 1 < nkt) {
                const int k0 = (kt + 1) * 64;
#pragma unroll
                for (int i = 0; i < 3; ++i) { const int ck = tid + i * NTHREADS; const int key = ck / 24, part = ck - key * 24;
                    kst[i] = (part < 16) ? *(const u32x4*)(KN + (size_t)(KR0 + k0 + key) * 1024 + h * 128 + part * 8) : *(const u32x4*)(KP + (size_t)(KR0 + k0 + key) * 64 + (part - 16) * 8); }
#pragma unroll
                for (int i = 0; i < 2; ++i) { const int cv = tid + i * NTHREADS; const int v = cv >> 3, kc = cv & 7; vst[i] = *(const u32x4*)(VT + vtb + (size_t)v * Lk + k0 + kc * 8); }
            }
            f32x16 sacc[2];
#pragma unroll
            for (int i = 0; i < 16; ++i) { sacc[0][i] = 0.f; sacc[1][i] = 0.f; }
#pragma unroll
            for (int s = 0; s < 12; ++s) {
                const bf16x8 kf0 = *(const LAS bf16x8*)(Ks + r * 400 + (16 * s + 8 * hh) * 2);
                const bf16x8 kf1 = *(const LAS bf16x8*)(Ks + (32 + r) * 400 + (16 * s + 8 * hh) * 2);
                sacc[0] = __builtin_amdgcn_mfma_f32_32x32x16_bf16(kf0, qf[s], sacc[0], 0, 0, 0);
                sacc[1] = __builtin_amdgcn_mfma_f32_32x32x16_bf16(kf1, qf[s], sacc[1], 0, 0, 0);
            }
            float mx0 = fmaxf(sacc[0][0], sacc[1][0]), mx1 = fmaxf(sacc[0][1], sacc[1][1]);
#pragma unroll
            for (int i = 2; i < 16; i += 2) { mx0 = __builtin_fmaxf(__builtin_fmaxf(mx0, sacc[0][i]), sacc[1][i]); mx1 = __builtin_fmaxf(__builtin_fmaxf(mx1, sacc[0][i + 1]), sacc[1][i + 1]); }
            float mx = fmaxf(mx0, mx1);
            mx = fmaxf(mx, shx(mx, 32, lane));
            const float mnew = fmaxf(mrun, mx);
            const bool resc = __builtin_amdgcn_ballot_w64(mnew != mrun) != 0ull;
            const float alpha = __builtin_amdgcn_exp2f((mrun - mnew) * sc2);
            mrun = mnew;
            const float nm = -mnew * sc2;
            f32x2 ps2 = (f32x2){0.f, 0.f};
#pragma unroll
            for (int kk = 0; kk < 2; ++kk)
#pragma unroll
                for (int i = 0; i < 16; i += 2) {
                    f32x2 a = (f32x2){sacc[kk][i], sacc[kk][i + 1]}; a = a * sc2 + nm;
                    a.x = __builtin_amdgcn_exp2f(a.x); a.y = __builtin_amdgcn_exp2f(a.y);
                    sacc[kk][i] = a.x; sacc[kk][i + 1] = a.y; ps2 += a;
                }
            lrun = lrun * alpha + (ps2.x + ps2.y);
            if (resc) {
#pragma unroll
                for (int ct = 0; ct < 4; ++ct)
#pragma unroll
                    for (int i = 0; i < 16; ++i) oacc[ct][i] *= alpha;
            }
#pragma unroll
            for (int ks = 0; ks < 4; ++ks) {
                const int kk = ks >> 1, s2 = ks & 1;
                u32x4 pw;
                pw.x = cvt_pk_bf16(sacc[kk][8 * s2 + 0], sacc[kk][8 * s2 + 1]); pw.y = cvt_pk_bf16(sacc[kk][8 * s2 + 2], sacc[kk][8 * s2 + 3]);
                pw.z = cvt_pk_bf16(sacc[kk][8 * s2 + 4], sacc[kk][8 * s2 + 5]); pw.w = cvt_pk_bf16(sacc[kk][8 * s2 + 6], sacc[kk][8 * s2 + 7]);
                const bf16x8 pf = __builtin_bit_cast(bf16x8, pw);
#pragma unroll
                for (int ct = 0; ct < 4; ++ct) {
                    const bf16x8 vf = *(const LAS bf16x8*)(Vs + (32 * ct + r) * 144 + (32 * kk + 16 * s2) * 2 + 16 * hh);
                    oacc[ct] = __builtin_amdgcn_mfma_f32_32x32x16_bf16(vf, pf, oacc[ct], 0, 0, 0);
                }
            }
        }
        lrun += shx(lrun, 32, lane);
        const float invl = 1.0f / lrun;
        const int tid2 = otid(wv); const int qrow2 = row0 + (tid2 >> 6) * 32 + (tid2 & 31);
        bf16_t* op = O + (size_t)qrow2 * 1024 + h * 128 + 4 * ((tid2 >> 5) & 1);
#pragma unroll
        for (int ct = 0; ct < 4; ++ct)
#pragma unroll
            for (int g4 = 0; g4 < 4; ++g4) {
                u32x2 w; w.x = cvt_pk_bf16(oacc[ct][4 * g4] * invl, oacc[ct][4 * g4 + 1] * invl); w.y = cvt_pk_bf16(oacc[ct][4 * g4 + 2] * invl, oacc[ct][4 * g4 + 3] * invl);
                *(u32x2*)(op + 32 * ct + 8 * g4) = w;
            }
        __syncthreads();
    }
}

__device__ __forceinline__ void e9_phase(int wv, const Params& p, int l) {
    const bf16_t* UU = (const bf16_t*)(p.ws + A_UU); bf16_t* ACT = (bf16_t*)(p.ws + A_ACT);
    const float* cw = p.in[I_FCW] + (size_t)l * 3 * UU_LD; const float* cb = p.in[I_FCB] + (size_t)l * UU_LD;
    const int tid9 = otid(wv);
    constexpr int RC = 16, NCG = DFF / 8;
    const int gt = obid() * NTHREADS + tid9, nlr = (int)(gridDim.x * NTHREADS) / NCG;
    const int c0 = (gt % NCG) * 8, lr = gt / NCG;
    float wg[3][8], wx[3][8], bg[8], bx[8];
    if (lr < nlr) {
#pragma unroll
        for (int o = 0; o < 3; ++o) { const f32x4 a = *(const f32x4*)(cw + o * UU_LD + c0), b = *(const f32x4*)(cw + o * UU_LD + c0 + 4), c = *(const f32x4*)(cw + o * UU_LD + DFF + c0), d = *(const f32x4*)(cw + o * UU_LD + DFF + c0 + 4);
#pragma unroll
            for (int j = 0; j < 4; ++j) { wg[o][j] = a[j]; wg[o][4 + j] = b[j]; wx[o][j] = c[j]; wx[o][4 + j] = d[j]; } }
        { const f32x4 a = *(const f32x4*)(cb + c0), b = *(const f32x4*)(cb + c0 + 4), c = *(const f32x4*)(cb + DFF + c0), d = *(const f32x4*)(cb + DFF + c0 + 4);
#pragma unroll
          for (int j = 0; j < 4; ++j) { bg[j] = a[j]; bg[4 + j] = b[j]; bx[j] = c[j]; bx[4 + j] = d[j]; } }
    }
    for (int ch = lr; lr < nlr && ch < MT / RC; ch += nlr) {
        const int row0 = ch * RC;
        const int t0 = row0 < MP ? (row0 & 255) : ((row0 - MP) & 2047); const int L = row0 < MP ? LP : LS;
        const bf16_t* pr = UU + (size_t)row0 * UU_LD + c0;
        u32x4 gp = (u32x4){0u, 0u, 0u, 0u}, xp = gp, gc, xc, gn, xn;
        if (t0 > 0) { gp = *(const u32x4*)(pr - UU_LD); xp = *(const u32x4*)(pr - UU_LD + DFF); }
        gc = *(const u32x4*)pr; xc = *(const u32x4*)(pr + DFF);
#pragma unroll 4
        for (int i = 0; i < RC; ++i) {
            gn = (u32x4){0u, 0u, 0u, 0u}; xn = gn;
            if (t0 + i + 1 < L) { gn = *(const u32x4*)(pr + (size_t)(i + 1) * UU_LD); xn = *(const u32x4*)(pr + (size_t)(i + 1) * UU_LD + DFF); }
            float a[8], b[8], c[8], ga[8], va[8];
            unpack8(gp, a); unpack8(gc, b); unpack8(gn, c);
#pragma unroll
            for (int j = 0; j < 8; ++j) ga[j] = bg[j] + wg[0][j] * a[j] + wg[1][j] * b[j] + wg[2][j] * c[j];
            unpack8(xp, a); unpack8(xc, b); unpack8(xn, c);
#pragma unroll
            for (int j = 0; j < 8; ++j) va[j] = bx[j] + wx[0][j] * a[j] + wx[1][j] * b[j] + wx[2][j] * c[j];
#pragma unroll
            for (int j = 0; j < 8; ++j) ga[j] = siluf_(ga[j]) * va[j];
            *(u32x4*)(ACT + (size_t)(row0 + i) * DFF + c0) = pack8(ga);
            gp = gc; gc = gn; xp = xc; xc = xn;
        }
    }
}

__device__ __forceinline__ void merge_phase(int wv, const Params& p) {
    const bf16_t* RAW = (const bf16_t*)(p.ws + A_RAW); const bf16_t* G = (const bf16_t*)(p.ws + A_GATES); bf16_t* MB = (bf16_t*)(p.ws + A_MBF);
    const int tid = otid(wv);
    for (int it = obid() * NTHREADS + tid; it < MT * 256; it += gridDim.x * NTHREADS) {
        const int row = it >> 8, c0 = (it & 255) * 8;
        float acc[8];
#pragma unroll
        for (int j = 0; j < 8; ++j) acc[j] = 0.f;
#pragma unroll
        for (int P = 0; P < 3; ++P) {
            float r[8], g[8];
            unpack8(*(const u32x4*)(RAW + ((size_t)P * MT + row) * DM + c0), r); unpack8(*(const u32x4*)(G + (size_t)row * GATE_LD + P * 2048 + c0), g);
#pragma unroll
            for (int j = 0; j < 8; ++j) acc[j] += sigmoidf_(g[j]) * r[j];
        }
        *(u32x4*)(MB + (size_t)row * DM + c0) = pack8(acc);
    }
}

__device__ __forceinline__ void convert_layer(int wv, const Params& p, int l, LAS unsigned char* lds) {
    unsigned char* ws = p.ws;
    convT(wv, p.in[I_WIN] + (size_t)l * DM * NIN, DM, NIN, (bf16_t*)(ws + W_IN), 1, lds);
    convT(wv, p.in[I_WUQ] + (size_t)l * 512 * 1536, 512, 1536, (bf16_t*)(ws + W_UQ), 0, lds);
    convT(wv, p.in[I_WUKV] + (size_t)l * 256 * 2048, 256, 2048, (bf16_t*)(ws + W_UKV), 2, lds);
    convT(wv, p.in[I_WBRA] + (size_t)l * 1024 * 2048, 1024, 2048, (bf16_t*)(ws + W_BRA), 0, lds);
    convT(wv, p.in[I_WBRB] + (size_t)l * 1024 * 2048, 1024, 2048, (bf16_t*)(ws + W_BRB), 0, lds);
    convT(wv, p.in[I_WBRC] + (size_t)l * 1024 * 2048, 1024, 2048, (bf16_t*)(ws + W_BRC), 0, lds);
    convT(wv, p.in[I_WO] + (size_t)l * 2048 * 2048, 2048, 2048, (bf16_t*)(ws + W_O), 0, lds);
    convT(wv, p.in[I_FUP] + (size_t)l * 2048 * UU_LD, 2048, UU_LD, (bf16_t*)(ws + W_UP), 0, lds);
    convT(wv, p.in[I_FDN] + (size_t)l * DFF * 2048, DFF, 2048, (bf16_t*)(ws + W_DN), 0, lds);
}

namespace pg8 {
struct EpiGateRT {
    const bf16_t* gates; float* m32; bf16_t* mbf; int P;
    __device__ __forceinline__ void operator()(const f32x4 (&acc)[2][2][4][2], const Unit& u, int wr, int wc, int fr, int fq) const {
        const int row0 = u.pm * BM + wr * 64 + fr, col0 = u.pn * BM + wc * 32 + 4 * fq;
#pragma unroll
        for (int ai = 0; ai < 2; ++ai)
#pragma unroll
            for (int m = 0; m < 4; ++m) {
                const size_t row = (size_t)(row0 + ai * HALF + m * 16);
#pragma unroll
                for (int bj = 0; bj < 2; ++bj)
#pragma unroll
                    for (int n = 0; n < 2; ++n) {
                        const int col = col0 + bj * HALF + n * 16;
                        const u32x2 gw = *(const u32x2*)(gates + row * GATE_LD + P * 2048 + col);
                        f32x4 v = acc[ai][bj][m][n];
                        v[0] *= sigmoidf_(bf_lo(gw.x)); v[1] *= sigmoidf_(bf_hi(gw.x)); v[2] *= sigmoidf_(bf_lo(gw.y)); v[3] *= sigmoidf_(bf_hi(gw.y));
                        float* mp = m32 + row * 2048 + col;
                        if (P != 0) { const f32x4 o = *(const f32x4*)mp; v = v + o; }
                        if (P != 2) { *(f32x4*)mp = v; }
                        else { u32x2 w; w.x = cvt_pk_bf16(v[0], v[1]); w.y = cvt_pk_bf16(v[2], v[3]); *(u32x2*)(mbf + row * 2048 + col) = w; }
                    }
            }
    }
};
}


#define XB_TMO      128
#define XB_XCNT(j)  (256  + 64 * (j))
#define XB_XSUB(j)  (1280 + 64 * (j))
#define XB_XGEN(j)  (2304 + 64 * (j))
#define XB_TOP      3328
#define XB_TOPGEN   3392
#define XCD_BAR_WORDS 3456
#define XB_SPIN_CAP (1u << 20)
__device__ __forceinline__ unsigned xb_ld(unsigned* p)              { return __hip_atomic_load(p, __ATOMIC_RELAXED, __HIP_MEMORY_SCOPE_AGENT); }
__device__ __forceinline__ unsigned xb_add(unsigned* p, unsigned v) { return __hip_atomic_fetch_add(p, v, __ATOMIC_RELAXED, __HIP_MEMORY_SCOPE_AGENT); }
__device__ __forceinline__ unsigned xb_xcc_id() { return (unsigned)__builtin_amdgcn_s_getreg((3 << 11) | 20) & 0xFu; }
#define XB_SPIN(cond, bar) do { unsigned _sp = 0; while (cond) { __builtin_amdgcn_s_sleep(1); \
    if ((++_sp & 255u) == 0u) { if (xb_ld(&(bar)[XB_TMO])) break; if (_sp > XB_SPIN_CAP) { atomicAdd(&(bar)[XB_TMO], 1u); break; } } } } while (0)
__device__ __forceinline__ void xcd_barrier_complete(unsigned* bar, unsigned x, unsigned& nloc, unsigned& nx) {
    const unsigned G = gridDim.x;
    unsigned sum, cnt, mine, sp = 0u;
    for (;;) {
        sum = 0u; cnt = 0u; mine = 0u;
#pragma unroll
        for (unsigned j = 0; j < 16; ++j) { const unsigned c = xb_ld(&bar[XB_XCNT(j)]); sum += c; cnt += (c > 0u) ? 1u : 0u; mine = (j == x) ? c : mine; }
        if (sum == G) break;
        __builtin_amdgcn_s_sleep(1);
        if ((++sp & 255u) == 0u) { if (xb_ld(&bar[XB_TMO])) break; if (sp > XB_SPIN_CAP) { atomicAdd(&bar[XB_TMO], 1u); break; } }
    }
    nloc = mine > 0u ? mine : 1u; nx = cnt > 0u ? cnt : 1u;
}
__device__ __forceinline__ void xcd_barrier(int wv, unsigned* bar, volatile LAS unsigned* st) {
    asm volatile("s_waitcnt vmcnt(0)" ::: "memory");
    __syncthreads();
    if (otid(wv) == 0) {
        __builtin_amdgcn_s_waitcnt(0);
        const unsigned x = xb_xcc_id();
        unsigned nloc = st[0], nx = st[1];
        if (nloc == 0u) { xcd_barrier_complete(bar, x, nloc, nx); st[0] = nloc; st[1] = nx; }
        const unsigned old = xb_add(&bar[XB_XSUB(x)], 1u);
        const unsigned gen = old / nloc;
        if (old + 1u == (gen + 1u) * nloc) {
            __builtin_amdgcn_fence(__ATOMIC_RELEASE, "agent");
            asm volatile("s_waitcnt vmcnt(0)" ::: "memory");
            const unsigned og = xb_add(&bar[XB_TOP], 1u);
            const unsigned tg = og / nx;
            if (og + 1u == (tg + 1u) * nx) xb_add(&bar[XB_TOPGEN], 1u);
            else XB_SPIN(xb_ld(&bar[XB_TOPGEN]) == tg, bar);
            __builtin_amdgcn_fence(__ATOMIC_ACQUIRE, "agent");
            xb_add(&bar[XB_XGEN(x)], 1u);
            asm volatile("s_waitcnt vmcnt(0)" ::: "memory");
        } else {
            XB_SPIN(xb_ld(&bar[XB_XGEN(x)]) == gen, bar);
            __builtin_amdgcn_fence(__ATOMIC_ACQUIRE, "agent");
            asm volatile("s_waitcnt vmcnt(0)" ::: "memory");
        }
    }
    __syncthreads();
}

#ifndef REP_GEMM
#define REP_GEMM 1
#endif
#ifndef REP_ATTN
#define REP_ATTN 1
#endif
#ifndef REP_CONV
#define REP_CONV 1
#endif
#ifndef REP_ELT
#define REP_ELT 1
#endif
#ifndef REP_CVT
#define REP_CVT 1
#endif
enum { K_G1A = 0, K_E2, K_I3, K_I4, K_G1B, K_G5, K_G6, K_ROW1, K_G8, K_E9, K_G10, K_ROW2, K_PRO, K_ROW0, K_COMB };

__global__ void __launch_bounds__(NTHREADS) fwd_megakernel(Params p) {
    extern __shared__ __attribute__((aligned(16))) unsigned char shm[];
    LAS unsigned char* lds = (LAS unsigned char*)shm;
    cg::grid_group grid = cg::this_grid();
    const int wv = __builtin_amdgcn_readfirstlane((int)(threadIdx.x >> 6));
    volatile LAS unsigned* bst = (volatile LAS unsigned*)(lds + 131072);
    unsigned* bar = (unsigned*)(p.ws + S_BAR);
    if (threadIdx.x == 0) { bst[0] = 0u; bst[1] = 0u; bst[2] = 0u; bst[3] = 0u; (void)xb_add(&bar[XB_XCNT(xb_xcc_id())], 1u); }
    __syncthreads();
#pragma unroll 1
    for (int ph = 0; ph < 3 + 12 * NLAYER; ++ph) {
        int kind, l;
        if (ph == 0) { kind = K_PRO; l = 0; } else if (ph == 1) { kind = K_COMB; l = 0; } else if (ph == 2) { kind = K_ROW0; l = 0; } else { l = (ph - 3) / 12; kind = (ph - 3) - l * 12; }
        unsigned char* ws = p.ws;
        asm volatile("" : "+s"(ws));
        if (kind == K_G1A || kind == K_I3 || kind == K_G1B || kind == K_G8) {
            const bf16_t* A; const bf16_t* Bt; bf16_t* O; int N, K;
            if (kind == K_G1A) { A = (const bf16_t*)(ws + A_H); Bt = (const bf16_t*)(ws + W_IN); O = (bf16_t*)(ws + A_PROJA); N = PA_LD; K = DM; }
            else if (kind == K_I3) { A = (const bf16_t*)(ws + A_CQN); Bt = (const bf16_t*)(ws + W_UQ); O = (bf16_t*)(ws + A_Q); N = 1536; K = 512; }
            else if (kind == K_G1B) { A = (const bf16_t*)(ws + A_H); Bt = (const bf16_t*)(ws + W_IN) + (size_t)PA_LD * DM; O = (bf16_t*)(ws + A_GATES); N = GATE_LD; K = DM; }
            else { A = (const bf16_t*)(ws + A_H); Bt = (const bf16_t*)(ws + W_UP); O = (bf16_t*)(ws + A_UU); N = UU_LD; K = DM; }
            int Mr = MT;
            const int nrep = ((kind == K_I3) ? 2 : 1) * REP_GEMM;
#pragma unroll 1
            for (int rp = 0; rp < nrep; ++rp) {
                if (kind == K_I3 && rp >= REP_GEMM) { A = (const bf16_t*)(ws + A_KEYSC); Bt = (const bf16_t*)(ws + W_UKV); O = (bf16_t*)(ws + A_KN); N = 1024; K = 256; Mr = KROWS; }
                run_gemm(wv, lds, A, Bt, Mr, N, K, pg8::EpiBf16{O, N, O});
            }
        }
        if (kind == K_I3) {
#pragma unroll 1
            for (int rp = 0; rp < REP_GEMM; ++rp)
            run_gemm(wv, lds, (const bf16_t*)(ws + W_UKV) + (size_t)1024 * 256, (const bf16_t*)(ws + A_KEYSC), 1024, KROWS, 256,
                     pg8::EpiVT{(bf16_t*)(ws + A_VT), (bf16_t*)(ws + A_VT) + (size_t)BS * 8 * 128 * LKS});
#pragma unroll 1
            for (int rp = 0; rp < REP_CONV; ++rp) conv_phase(wv, p, l, lds);
        }
        if (kind == K_I4) {
#pragma unroll 1
            for (int rp = 0; rp < REP_ATTN; ++rp) attn_phase(wv, p, lds);
#pragma unroll 1
            for (int rp = 0; rp < REP_ELT; ++rp) e3b_phase(wv, p, lds); }
        if (kind == K_G1B) {
#pragma unroll 1
            for (int rp = 0; rp < REP_GEMM; ++rp)
            run_gemm(wv, lds, (const bf16_t*)(ws + A_YA), (const bf16_t*)(ws + W_BRA), 3 * MT, DM, 1024, pg8::EpiBf16{(bf16_t*)(ws + A_RAW), DM, (bf16_t*)(ws + A_RAW)}, false, MT / 256, E_WBR * 2, true);
        }
        if (kind == K_G5) merge_phase(wv, p);
        if (kind == K_G6 || kind == K_G10) {
            const bool g6 = (kind == K_G6);
#pragma unroll 1
            for (int rp = 0; rp < REP_GEMM; ++rp)
            run_gemm(wv, lds, (const bf16_t*)(ws + (g6 ? A_MBF : A_ACT)), (const bf16_t*)(ws + (g6 ? W_O : W_DN)), MT, DM, g6 ? DM : DFF, pg8::EpiBf16{(bf16_t*)(ws + (g6 ? A_M32 : A_F32)), DM, (bf16_t*)(ws + (g6 ? A_M32 : A_F32)) + (size_t)MT * DM}, true);
        }
        if (kind == K_E2) {
#pragma unroll 1
            for (int rp = 0; rp < REP_ELT; ++rp) e2_phase(wv, p, l, lds); }
        if (kind == K_E9) {
#pragma unroll 1
            for (int rp = 0; rp < REP_ELT; ++rp) e9_phase(wv, p, l); }
        if (kind == K_ROW0 || kind == K_ROW1 || kind == K_ROW2) row_phase(wv, p, l, kind == K_ROW0 ? 0 : (kind == K_ROW1 ? 1 : 2));
        if (kind == K_COMB) comb_phase(wv, p);
        if (kind == K_PRO) {
            if (obid() == 0) {
                pg8::StaticOrder S; S.init(MT, DM, (int)gridDim.x, 0, true);
                const int t0 = otid(wv);
                if (t0 < S.nwg - S.nfull) { pg8::Unit uu; S.tile_of(S.nfull + t0, uu); atomicOr((unsigned*)(p.ws + S_TAIL) + uu.pm, 1u << uu.pn); }
            }
            ada_phase(wv, p, lds); rope_table_phase(wv, p); }
        if (kind == K_PRO || (kind == K_ROW2 && l + 1 < NLAYER)) { const int ln = (kind == K_PRO) ? 0 : l + 1;
#pragma unroll 1
            for (int rp = 0; rp < REP_CVT; ++rp) { filter_phase(wv, p, ln, lds); convert_layer(wv, p, ln, lds); } }
        if (p.ws == nullptr) grid.sync();
        xcd_barrier(wv, bar, bst);
    }
}

extern "C" void kernel_launch(void* const* d_in, const int* in_sizes, int n_in, void* d_out, int out_size, void* d_ws, size_t ws_size, hipStream_t stream) {
    static int grid_blocks = 0;
    if (grid_blocks == 0) {
        if (n_in != N_INPUTS || ws_size < WS_NEED) { fprintf(stderr, "kernel_launch: need %d inputs and %zu bytes of workspace; got %d, %zu\n", N_INPUTS, (size_t)WS_NEED, n_in, ws_size); grid_blocks = -1; return; }
        int dev = 0, cus = 0, per_cu = 0;
        hipGetDevice(&dev);
        hipDeviceGetAttribute(&cus, hipDeviceAttributeMultiprocessorCount, dev);
        if (hipFuncSetAttribute((const void*)fwd_megakernel, hipFuncAttributeMaxDynamicSharedMemorySize, LDS_BYTES) != hipSuccess) { fprintf(stderr, "kernel_launch: hipFuncSetAttribute failed\n"); grid_blocks = -1; return; }
        if (hipOccupancyMaxActiveBlocksPerMultiprocessor(&per_cu, (const void*)fwd_megakernel, NTHREADS, LDS_BYTES) != hipSuccess || per_cu < 1) { fprintf(stderr, "kernel_launch: occupancy query gave %d\n", per_cu); per_cu = 1; }
        (void)hipGetLastError();
        grid_blocks = cus * 1;
    }
    if (grid_blocks < 0) return;
        (void)hipMemsetAsync((unsigned char*)d_ws + S_BAR, 0, 16384, stream);
    Params p{};
    for (int i = 0; i < N_INPUTS; ++i) p.in[i] = (const float*)d_in[i];
    p.out = (float*)d_out; p.ws = (unsigned char*)d_ws;
    void* args[] = {&p};
    hipError_t e = hipLaunchCooperativeKernel((const void*)fwd_megakernel, dim3(grid_blocks), dim3(NTHREADS), args, LDS_BYTES, stream);
    if (e != hipSuccess) fprintf(stderr, "cooperative launch failed: %s (grid %d)\n", hipGetErrorString(e), grid_blocks);
}
```

```cpp
#include <hip/hip_runtime.h>
#include <hip/hip_cooperative_groups.h>
#include <cstdio>
namespace cg = cooperative_groups;

#define LAS __attribute__((address_space(3)))
typedef unsigned short bf16_t;
typedef short bf16x8 __attribute__((ext_vector_type(8)));
typedef float f32x4 __attribute__((ext_vector_type(4)));
typedef float f32x16 __attribute__((ext_vector_type(16)));
typedef unsigned u32x4 __attribute__((ext_vector_type(4)));
typedef unsigned u32x2 __attribute__((ext_vector_type(2)));
typedef float f32x2 __attribute__((ext_vector_type(2)));

constexpr int DM = 2048, MP = 4096, MS = 16384, MT = 20480, NLAYER = 2;
constexpr int LP = 256, LS = 2048, BP = 16, BS = 8, PAST = 512, LKS = 2560;
constexpr int NIN = 13120, NGATE0 = 6976, PA_LD = 7168, GATE_LD = 6144;
constexpr int DFF = 5632, UU_LD = 11264;
constexpr int KROWS = 24576;
constexpr int NTHREADS = 512;
constexpr int LDS_BYTES = 131072 + 16;

enum { I_XP = 0, I_XS, I_C, I_CCKV, I_CKPE, I_CCTX, I_ADAW, I_ADAB, I_NMPRE, I_NMPOST, I_NFPRE, I_NFPOST, I_WIN, I_HCW, I_HCB,
       I_FW1, I_FB1, I_FW2, I_FB2, I_FW3, I_FB3, I_FFREQ, I_HBIAS, I_QN, I_KVN, I_WUQ, I_WUKV, I_SCW, I_WBRA, I_WBRB, I_WBRC,
       I_WO, I_FUP, I_FCW, I_FCB, I_FDN, N_INPUTS };

constexpr size_t E_WIN = (size_t)13312 * 2048, E_WUQ = (size_t)1536 * 512, E_WUKV = (size_t)2048 * 256, E_WBR = (size_t)2048 * 1024,
                 E_WO = (size_t)2048 * 2048, E_WUP = (size_t)11264 * 2048, E_WDN = (size_t)2048 * 5632;
constexpr size_t W_IN = 0, W_UQ = W_IN + E_WIN * 2, W_UKV = W_UQ + E_WUQ * 2, W_BRA = W_UKV + E_WUKV * 2, W_BRB = W_BRA + E_WBR * 2,
                 W_BRC = W_BRB + E_WBR * 2, W_O = W_BRC + E_WBR * 2, W_UP = W_O + E_WO * 2, W_DN = W_UP + E_WUP * 2, W_END = W_DN + E_WDN * 2;
constexpr size_t S_MOD = W_END, SZ_MOD = (size_t)NLAYER * 16 * 9 * 12288 * 4;
constexpr size_t S_KTS = S_MOD + SZ_MOD, S_KTP = S_KTS + (size_t)1024 * 4096 * 4, S_PARTS = S_KTP + (size_t)1024 * 512 * 4,
                 S_PARTP = S_PARTS + (size_t)64 * 2048 * 4, S_ROPE = S_PARTP + (size_t)8 * 2048 * 4, S_BAR = S_ROPE + (size_t)2 * 2048 * 32 * 4, S_COMB = S_BAR + 16384, S_SCALE = S_COMB + (size_t)NLAYER * 3 * 9 * 3 * 2048 * 4, S_TAIL = S_BAR + 14336, S_END = S_SCALE + 8192;
constexpr size_t AR = S_END;
constexpr size_t SZ_H = (size_t)MT * 2048 * 2;
constexpr size_t A_H = AR, A_UU = AR + SZ_H, A_ACT = A_UU + (size_t)MT * UU_LD * 2, AR_END = A_ACT + (size_t)MT * DFF * 2;
constexpr size_t A_PROJA = A_UU;
constexpr size_t A_Q = A_UU, A_KN = A_Q + (size_t)MT * 1536 * 2, A_VT = A_KN + (size_t)KROWS * 1024 * 2, A_YCT = A_VT + (size_t)KROWS * 1024 * 2;
constexpr size_t A_GATES = A_UU, A_M32 = A_GATES + (size_t)MT * GATE_LD * 2, A_MBF = A_H, A_F32 = A_UU;
constexpr size_t A_S = A_M32 + (size_t)MT * 2048 * 4;
constexpr size_t A_ZZT = A_S, A_X0S = A_ZZT + (size_t)MT * 1024 * 2, A_CQN = A_X0S + (size_t)MT * 1024 * 2, A_KEYSC = A_CQN + (size_t)MT * 512 * 2,
                 A_KPER = A_KEYSC + (size_t)KROWS * 256 * 2, A_YA = A_KPER + (size_t)KROWS * 64 * 2, A_OATT = A_YA + (size_t)MT * 1024 * 2,
                 A_YC = A_OATT + (size_t)MT * 1024 * 2, A_SEND = A_YC + (size_t)MT * 1024 * 2;
constexpr size_t A_RAW = A_M32;
static_assert(A_RAW + (size_t)3 * MT * 2048 * 2 <= A_CQN, "raw branch buffer overlaps live data");
static_assert(A_SEND <= AR_END, "arena overflow");
static_assert(A_YCT + (size_t)MT * 1024 * 2 <= A_M32, "arena overlap");
constexpr size_t WS_NEED = AR_END;
static_assert(WS_NEED <= 967590400ull, "workspace too large");

struct Params {
    const float* in[N_INPUTS];
    float* out;
    unsigned char* ws;
};

__device__ __forceinline__ unsigned cvt_pk_bf16(float lo, float hi) { unsigned r; asm volatile("v_cvt_pk_bf16_f32 %0, %1, %2" : "=v"(r) : "v"(lo), "v"(hi)); return r; }
__device__ __forceinline__ bf16_t f2bf(float f) { return (bf16_t)(cvt_pk_bf16(f, 0.f) & 0xffffu); }
__device__ __forceinline__ float bf_lo(unsigned w) { return __uint_as_float(w << 16); }
__device__ __forceinline__ float bf_hi(unsigned w) { return __uint_as_float(w & 0xffff0000u); }
__device__ __forceinline__ void unpack8(const u32x4 v, float* f) { f[0] = bf_lo(v.x); f[1] = bf_hi(v.x); f[2] = bf_lo(v.y); f[3] = bf_hi(v.y); f[4] = bf_lo(v.z); f[5] = bf_hi(v.z); f[6] = bf_lo(v.w); f[7] = bf_hi(v.w); }
__device__ __forceinline__ u32x4 pack8(const float* f) { u32x4 r; r.x = cvt_pk_bf16(f[0], f[1]); r.y = cvt_pk_bf16(f[2], f[3]); r.z = cvt_pk_bf16(f[4], f[5]); r.w = cvt_pk_bf16(f[6], f[7]); return r; }
__device__ __forceinline__ float shx(float v, int mask, int lane) { return __int_as_float(__builtin_amdgcn_ds_bpermute((lane ^ mask) << 2, __float_as_int(v))); }
__device__ __forceinline__ float wave_sum(float v, int lane) {
#pragma unroll
    for (int o = 32; o >= 1; o >>= 1) v += shx(v, o, lane);
    return v;
}
__device__ __forceinline__ int otid(int wv) { int t; asm volatile("v_mbcnt_lo_u32_b32 %0, -1, 0\n\tv_mbcnt_hi_u32_b32 %0, -1, %0" : "=v"(t)); return wv * 64 + t; }
__device__ __forceinline__ int obid() { int t = blockIdx.x; asm volatile("" : "+s"(t)); return t; }
__device__ __forceinline__ float sigmoidf_(float x) { return __builtin_amdgcn_rcpf(1.0f + __builtin_amdgcn_exp2f(-1.4426950408889634f * x)); }
__device__ __forceinline__ float siluf_(float x) { return x * sigmoidf_(x); }

namespace pg8 {
constexpr int BM = 256, BK = 64, HALF = 128, HTB = HALF * BK * 2, STAGE_BYTES = 8 * HTB, NXCD = 8, WGM = 8;
__host__ __device__ __forceinline__ int lds_byte(int r, int c) { const int st = (r >> 4) * 2 + (c >> 5), rr = r & 15, cc = c & 31, ob = rr * 64 + cc * 2; return st * 1024 + (ob ^ (((ob >> 9) & 1) << 5)); }
__host__ __device__ __forceinline__ void stage_rc(int b, int& R, int& C) { const int st = b / 1024, sb = b % 1024, swz = sb ^ (((sb >> 9) & 1) << 5); R = (st >> 1) * 16 + swz / 64; C = (st & 1) * 32 + (swz % 64) / 2; }
__host__ __device__ __forceinline__ int perm32(int rho) { const int n = rho >> 4, i = rho & 15; return 8 * (i >> 2) + 4 * n + (i & 3); }
struct Unit { int pm, pn, kh; };
struct Gemm { const bf16_t* A; const bf16_t* Bt; int M, N, K; int nMper; size_t bstride; };
struct StaticOrder {
    int nM, nN, nwg, G, c, nfull;
    __device__ void init(int M, int N, int G_, int c_, bool split = false) { nM = M / BM; nN = N / BM; nwg = nM * nN; G = G_; c = c_;
        nfull = nwg; if (split) { const int rem = nwg % G; if (rem > 0 && 2 * rem <= G) nfull = nwg - rem; } }
    __device__ void tile_of(int wgid, Unit& u) const {
        { const int q = nwg / NXCD, r = nwg % NXCD, xcd = wgid % NXCD, off = wgid / NXCD; wgid = (xcd < r ? xcd * (q + 1) : r * (q + 1) + (xcd - r) * q) + off; }
        const int nig = WGM * nN, gid = wgid / nig, fm = gid * WGM, gsz = (nM - fm) < WGM ? (nM - fm) : WGM;
        u.pm = fm + ((wgid % nig) % gsz); u.pn = (wgid % nig) / gsz;
    }
    __device__ bool next(int i, Unit& u) const {
        const long L = (long)i * G + c;
        int tile = (int)L, kh = -1; bool ok = L < nwg;
        if (L >= nfull) { const long h = L - nfull; ok = h < 2 * (long)(nwg - nfull); tile = nfull + (int)(h >> 1); kh = (int)(h & 1); }
        if (!ok) return false;
        int pm, pn;
        { int wgid = tile; const int q = nwg / NXCD, r = nwg % NXCD, xcd = wgid % NXCD, off = wgid / NXCD; wgid = (xcd < r ? xcd * (q + 1) : r * (q + 1) + (xcd - r) * q) + off;
          const int nig = WGM * nN, gid = wgid / nig, fm = gid * WGM, gsz = (nM - fm) < WGM ? (nM - fm) : WGM;
          pm = fm + ((wgid % nig) % gsz); pn = (wgid % nig) / gsz; }
        u.pm = pm; u.pn = pn; u.kh = kh; return true;
    }
};
template <class Epi>
__device__ __forceinline__ void gemm_phase(int wv, LAS unsigned char* lds, const Gemm g, const StaticOrder& S, const Epi& E) {
    const int tid = otid(wv), wid = __builtin_amdgcn_readfirstlane(tid >> 6), lane = tid & 63, wr = wid >> 2, wc = wid & 3, fr = lane & 15, fq = lane >> 4;
    const int K = g.K, nt = K / BK;
    unsigned voffA[2], voffB[2];
#pragma unroll
    for (int i = 0; i < 2; ++i) { int R, C; stage_rc(tid * 16 + i * 8192, R, C); const int Rb = (R & ~31) + perm32(R & 31); voffA[i] = (unsigned)(R * K + C) * 2u; voffB[i] = (unsigned)(Rb * K + C) * 2u; }
    const size_t kstep = (size_t)(BK * 2);
    const size_t hstep = (size_t)HALF * K * 2;
    const size_t tstep = 2 * hstep;
    const unsigned ldsw = (unsigned)wid * 1024u;
    const int aoff = lds_byte(wr * 64 + fr, fq * 8), boff = lds_byte(wc * 32 + fr, fq * 8);
#define PG8_SA(b, h) (((b) * 2 + (h)) * HTB)
#define PG8_SB(b, h) ((4 + (b) * 2 + (h)) * HTB)
#define PG8_STAGE(bufoff, gbase, voff) do { _Pragma("unroll") for (int _i = 0; _i < 2; ++_i) \
        __builtin_amdgcn_global_load_lds((const unsigned*)((const char*)(gbase) + (voff)[_i]), (LAS unsigned*)(lds + (bufoff) + ldsw + _i * 8192), 16, 0, 0); } while (0)
#define PG8_LDA(dst, b, h) do { _Pragma("unroll") for (int m = 0; m < 4; ++m) _Pragma("unroll") for (int k = 0; k < 2; ++k) dst[m][k] = *(const LAS bf16x8*)(lds + PG8_SA(b, h) + aoff + m * 2048 + k * 1024); } while (0)
#define PG8_LDB(dst, b, h) do { _Pragma("unroll") for (int n = 0; n < 2; ++n) _Pragma("unroll") for (int k = 0; k < 2; ++k) dst[n][k] = *(const LAS bf16x8*)(lds + PG8_SB(b, h) + boff + n * 2048 + k * 1024); } while (0)
#define PG8_MMA(ai, bj, At, Bt) do { __builtin_amdgcn_s_setprio(1); _Pragma("unroll") for (int m = 0; m < 4; ++m) _Pragma("unroll") for (int n = 0; n < 2; ++n) _Pragma("unroll") for (int k = 0; k < 2; ++k) \
        acc[ai][bj][m][n] = __builtin_amdgcn_mfma_f32_16x16x32_bf16(Bt[n][k], At[m][k], acc[ai][bj][m][n], 0, 0, 0); __builtin_amdgcn_s_setprio(0); } while (0)
#define PG8_WAIT_V(n) asm volatile("s_waitcnt vmcnt(" #n ")" ::: "memory")
#define PG8_WAIT_L(n) asm volatile("s_waitcnt lgkmcnt(" #n ")" ::: "memory")
#define PG8_BAR __builtin_amdgcn_s_barrier()
#define PG8_SCHED __builtin_amdgcn_sched_barrier(0)
    Unit cur, nxt; int ui = 0;
    if (!S.next(0, cur)) return;
    f32x4 acc[2][2][4][2];
#pragma unroll
    for (int a = 0; a < 2; ++a)
#pragma unroll
        for (int b = 0; b < 2; ++b)
#pragma unroll
            for (int m = 0; m < 4; ++m)
#pragma unroll
                for (int n = 0; n < 2; ++n) acc[a][b][m][n] = (f32x4){0.f, 0.f, 0.f, 0.f};
    bf16x8 At[4][2], B0[2][2], B1[2][2];
    const size_t khoff = (size_t)(nt / 2) * kstep;
    const char* cA = (const char*)g.A + (size_t)cur.pm * tstep + (cur.kh == 1 ? khoff : 0); const char* cB = (const char*)g.Bt + (size_t)(cur.pm / g.nMper) * g.bstride + (size_t)cur.pn * tstep + (cur.kh == 1 ? khoff : 0);
    PG8_STAGE(PG8_SB(0, 0), cB, voffB); PG8_STAGE(PG8_SA(0, 0), cA, voffA); PG8_STAGE(PG8_SB(0, 1), cB + hstep, voffB); PG8_STAGE(PG8_SA(0, 1), cA + hstep, voffA);
    if (wr == 1) PG8_BAR;
    PG8_WAIT_V(4); PG8_BAR;
    PG8_STAGE(PG8_SB(1, 0), cB + kstep, voffB); PG8_STAGE(PG8_SA(1, 0), cA + kstep, voffA); PG8_STAGE(PG8_SB(1, 1), cB + hstep + kstep, voffB);
    PG8_WAIT_V(6); PG8_BAR;
    for (;;) {
        const bool has_next = S.next(ui + 1, nxt);
        const char* nA = has_next ? (const char*)g.A + (size_t)nxt.pm * tstep + (nxt.kh == 1 ? khoff : 0) : cA; const char* nB = has_next ? (const char*)g.Bt + (size_t)(nxt.pm / g.nMper) * g.bstride + (size_t)nxt.pn * tstep + (nxt.kh == 1 ? khoff : 0) : cB;
        const int ntu = (cur.kh < 0) ? nt : (nt >> 1);
        for (int t = 0; t < ntu; t += 2) {
            const bool last = (t == ntu - 2);
            const char* a1 = cA + (size_t)(t + 1) * kstep;
            const char* a2 = last ? nA : cA + (size_t)(t + 2) * kstep; const char* b2 = last ? nB : cB + (size_t)(t + 2) * kstep;
            const char* a3 = a2 + kstep; const char* b3 = b2 + kstep;
            PG8_LDB(B0, 0, 0); PG8_SCHED; PG8_LDA(At, 0, 0); PG8_STAGE(PG8_SA(1, 1), a1 + hstep, voffA);
            PG8_WAIT_L(8); PG8_BAR; PG8_WAIT_L(0); PG8_MMA(0, 0, At, B0); PG8_BAR; PG8_SCHED;
            PG8_LDB(B1, 0, 1); PG8_STAGE(PG8_SB(0, 0), b2, voffB);
            PG8_BAR; PG8_WAIT_L(0); PG8_MMA(0, 1, At, B1); PG8_BAR;
            PG8_LDA(At, 0, 1); PG8_STAGE(PG8_SA(0, 0), a2, voffA);
            PG8_BAR; PG8_WAIT_L(0); PG8_MMA(1, 0, At, B0); PG8_BAR; PG8_SCHED;
            PG8_STAGE(PG8_SB(0, 1), b2 + hstep, voffB);
            PG8_WAIT_V(6); PG8_BAR; PG8_MMA(1, 1, At, B1); PG8_BAR;
            PG8_LDB(B0, 1, 0); PG8_SCHED; PG8_LDA(At, 1, 0); PG8_STAGE(PG8_SA(0, 1), a2 + hstep, voffA);
            PG8_WAIT_L(8); PG8_BAR; PG8_WAIT_L(0); PG8_MMA(0, 0, At, B0); PG8_BAR; PG8_SCHED;
            PG8_LDB(B1, 1, 1); PG8_STAGE(PG8_SB(1, 0), b3, voffB);
            PG8_BAR; PG8_WAIT_L(0); PG8_MMA(0, 1, At, B1); PG8_BAR;
            PG8_LDA(At, 1, 1); PG8_STAGE(PG8_SA(1, 0), a3, voffA);
            PG8_BAR; PG8_WAIT_L(0); PG8_MMA(1, 0, At, B0); PG8_BAR; PG8_SCHED;
            PG8_STAGE(PG8_SB(1, 1), b3 + hstep, voffB);
            PG8_WAIT_V(6); PG8_BAR; PG8_MMA(1, 1, At, B1); PG8_BAR;
        }
        { const int t2 = otid(wv); const int l2 = t2 & 63, w2 = __builtin_amdgcn_readfirstlane(t2 >> 6); E(acc, cur, w2 >> 2, w2 & 3, l2 & 15, l2 >> 4); }
        if (!has_next) break;
#pragma unroll
        for (int a = 0; a < 2; ++a)
#pragma unroll
            for (int b = 0; b < 2; ++b)
#pragma unroll
                for (int m = 0; m < 4; ++m)
#pragma unroll
                    for (int n = 0; n < 2; ++n) acc[a][b][m][n] = (f32x4){0.f, 0.f, 0.f, 0.f};
        cur = nxt; cA = nA; cB = nB; ++ui;
    }
    PG8_WAIT_V(0);
    if (wr == 0) PG8_BAR;
    PG8_BAR;
#undef PG8_SA
#undef PG8_SB
#undef PG8_STAGE
#undef PG8_LDA
#undef PG8_LDB
#undef PG8_MMA
#undef PG8_WAIT_V
#undef PG8_WAIT_L
#undef PG8_BAR
#undef PG8_SCHED
}

struct EpiBf16 {
    bf16_t* O; int ldc; bf16_t* O2;
    __device__ __forceinline__ void operator()(const f32x4 (&acc)[2][2][4][2], const Unit& u, int wr, int wc, int fr, int fq) const {
        const int row0 = u.pm * BM + wr * 64 + fr, col0 = u.pn * BM + wc * 32 + 8 * fq;
        bf16_t* Ob = (u.kh == 1) ? O2 : O;
#pragma unroll
        for (int ai = 0; ai < 2; ++ai)
#pragma unroll
            for (int m = 0; m < 4; ++m) { bf16_t* rowp = Ob + (size_t)(row0 + ai * HALF + m * 16) * ldc + col0;
#pragma unroll
                for (int bj = 0; bj < 2; ++bj) { const f32x4 v0 = acc[ai][bj][m][0], v1 = acc[ai][bj][m][1];
                    u32x4 w; w.x = cvt_pk_bf16(v0[0], v0[1]); w.y = cvt_pk_bf16(v0[2], v0[3]); w.z = cvt_pk_bf16(v1[0], v1[1]); w.w = cvt_pk_bf16(v1[2], v1[3]);
                    *(u32x4*)(rowp + bj * HALF) = w; } }
    }
};
struct EpiF32 {
    float* C; int ldc;
    __device__ __forceinline__ void operator()(const f32x4 (&acc)[2][2][4][2], const Unit& u, int wr, int wc, int fr, int fq) const {
        const int row0 = u.pm * BM + wr * 64 + fr, col0 = u.pn * BM + wc * 32 + 4 * fq;
#pragma unroll
        for (int ai = 0; ai < 2; ++ai)
#pragma unroll
            for (int m = 0; m < 4; ++m) { float* rowp = C + (size_t)(row0 + ai * HALF + m * 16) * ldc + col0;
#pragma unroll
                for (int bj = 0; bj < 2; ++bj)
#pragma unroll
                    for (int n = 0; n < 2; ++n) *(f32x4*)(rowp + bj * HALF + n * 16) = acc[ai][bj][m][n]; }
    }
};
struct EpiVT {
    bf16_t* VTs; bf16_t* VTp;
    __device__ __forceinline__ void operator()(const f32x4 (&acc)[2][2][4][2], const Unit& u, int wr, int wc, int fr, int fq) const {
        const int KR0 = u.pn * BM;
        bf16_t* vt; int Lk;
        if (KR0 < BS * LKS) { const int b = KR0 / LKS; Lk = LKS; vt = VTs + (size_t)b * 1024 * LKS + (KR0 - b * LKS); }
        else { const int b = (KR0 - BS * LKS) >> 8; Lk = LP; vt = VTp + (size_t)b * 1024 * LP; }
        const int row0 = u.pm * BM + wr * 64 + fr, col0 = wc * 32 + 8 * fq;
#pragma unroll
        for (int ai = 0; ai < 2; ++ai)
#pragma unroll
            for (int m = 0; m < 4; ++m) { bf16_t* rowp = vt + (size_t)(row0 + ai * HALF + m * 16) * Lk + col0;
#pragma unroll
                for (int bj = 0; bj < 2; ++bj) { const f32x4 v0 = acc[ai][bj][m][0], v1 = acc[ai][bj][m][1];
                    u32x4 w; w.x = cvt_pk_bf16(v0[0], v0[1]); w.y = cvt_pk_bf16(v0[2], v0[3]); w.z = cvt_pk_bf16(v1[0], v1[1]); w.w = cvt_pk_bf16(v1[2], v1[3]);
                    *(u32x4*)(rowp + bj * HALF) = w; } }
    }
};
template <int P> struct EpiGate {
    const bf16_t* gates; float* m32; bf16_t* mbf;
    __device__ __forceinline__ void operator()(const f32x4 (&acc)[2][2][4][2], const Unit& u, int wr, int wc, int fr, int fq) const {
        const int row0 = u.pm * BM + wr * 64 + fr, col0 = u.pn * BM + wc * 32 + 4 * fq;
#pragma unroll
        for (int ai = 0; ai < 2; ++ai)
#pragma unroll
            for (int m = 0; m < 4; ++m) {
                const size_t row = (size_t)(row0 + ai * HALF + m * 16);
#pragma unroll
                for (int bj = 0; bj < 2; ++bj)
#pragma unroll
                    for (int n = 0; n < 2; ++n) {
                        const int col = col0 + bj * HALF + n * 16;
                        const u32x2 gw = *(const u32x2*)(gates + row * GATE_LD + P * 2048 + col);
                        f32x4 v = acc[ai][bj][m][n];
                        v[0] *= sigmoidf_(bf_lo(gw.x)); v[1] *= sigmoidf_(bf_hi(gw.x)); v[2] *= sigmoidf_(bf_lo(gw.y)); v[3] *= sigmoidf_(bf_hi(gw.y));
                        float* mp = m32 + row * 2048 + col;
                        if (P == 0) { *(f32x4*)mp = v; }
                        else if (P == 1) { const f32x4 o = *(const f32x4*)mp; *(f32x4*)mp = o + v; }
                        else { const f32x4 o = *(const f32x4*)mp; v = v + o; u32x2 w; w.x = cvt_pk_bf16(v[0], v[1]); w.y = cvt_pk_bf16(v[2], v[3]); *(u32x2*)(mbf + row * 2048 + col) = w; }
                    }
            }
    }
};
}

template <class Epi>
__device__ __forceinline__ void run_gemm(int wv, LAS unsigned char* lds, const bf16_t* A, const bf16_t* Bt, int M, int N, int K, const Epi& E, bool split = false, int nMper = 1 << 28, size_t bstride = 0, bool rev = false) {
    pg8::Gemm g; g.A = A; g.Bt = Bt; g.M = M; g.N = N; g.K = K; g.nMper = nMper; g.bstride = bstride;
    pg8::StaticOrder S; S.init(M, N, (int)gridDim.x, rev ? (int)gridDim.x - 1 - obid() : obid(), split);
    pg8::gemm_phase<Epi>(wv, lds, g, S, E);
    __syncthreads();
}

__device__ __forceinline__ void convT(int wv, const float* __restrict__ src, int K, int N, bf16_t* __restrict__ dst, int gate_shift, LAS unsigned char* lds) {
    const int tid = otid(wv), lane = tid & 63, kq = lane & 7, ng = lane >> 3;
    const int tn = N / 32, tk = K / 64, ntile = tn * tk, nwaves = gridDim.x * 8;
    for (int tile = obid() * 8 + (tid >> 6); tile < ntile; tile += 2 * nwaves) {
        const int tile2 = tile + nwaves; const bool has2 = tile2 < ntile;
        const int tkk = tile / tn, tnn = tile - tkk * tn, k0 = tkk * 64 + 8 * kq, n0 = tnn * 32 + 4 * ng;
        const int tkk2 = has2 ? tile2 / tn : tkk, tnn2 = has2 ? tile2 - tkk2 * tn : tnn, k02 = tkk2 * 64 + 8 * kq, n02 = tnn2 * 32 + 4 * ng;
        f32x4 v[8], v2[8];
#pragma unroll
        for (int i = 0; i < 8; ++i) v[i] = *(const f32x4*)(src + (size_t)(k0 + i) * N + n0);
#pragma unroll
        for (int i = 0; i < 8; ++i) v2[i] = *(const f32x4*)(src + (size_t)(k02 + i) * N + n02);
#pragma unroll
        for (int j = 0; j < 4; ++j) {
            int nd = n0 + j; if (gate_shift == 1 && nd >= NGATE0) nd += 192; if (gate_shift == 2) { const int hd = nd >> 8, wi = nd & 255; nd = (wi < 128) ? hd * 128 + wi : 1024 + hd * 128 + (wi - 128); }
            u32x4 w; w.x = cvt_pk_bf16(v[0][j], v[1][j]); w.y = cvt_pk_bf16(v[2][j], v[3][j]); w.z = cvt_pk_bf16(v[4][j], v[5][j]); w.w = cvt_pk_bf16(v[6][j], v[7][j]);
            *(u32x4*)(dst + (size_t)nd * K + k0) = w;
        }
        if (has2) {
#pragma unroll
            for (int j = 0; j < 4; ++j) {
                int nd = n02 + j; if (gate_shift == 1 && nd >= NGATE0) nd += 192; if (gate_shift == 2) { const int hd = nd >> 8, wi = nd & 255; nd = (wi < 128) ? hd * 128 + wi : 1024 + hd * 128 + (wi - 128); }
                u32x4 w; w.x = cvt_pk_bf16(v2[0][j], v2[1][j]); w.y = cvt_pk_bf16(v2[2][j], v2[3][j]); w.z = cvt_pk_bf16(v2[4][j], v2[5][j]); w.w = cvt_pk_bf16(v2[6][j], v2[7][j]);
                *(u32x4*)(dst + (size_t)nd * K + k02) = w;
            }
        }
    }
}

__device__ __forceinline__ void ada_phase(int wv, const Params& p, LAS unsigned char* lds) {
    LAS float* sl = (LAS float*)lds;
    float* mod = (float*)(p.ws + S_MOD);
    const int tid = otid(wv);
    for (int u = obid(); u < NLAYER * 8 * 16; u += gridDim.x) {
        const int l = u / 128, r = u % 128, cb = r % 8, kc = r / 8, k0 = kc * 128;
        for (int i = tid; i < 9 * 128; i += NTHREADS) { const int v = i >> 7, k = i & 127; const float x = (v == 0) ? p.in[I_CCTX][k0 + k] : p.in[I_C][(v - 1) * DM + k0 + k]; sl[i] = siluf_(x); }
        __syncthreads();
        const bool act = tid < 384; const int col = cb * 1536 + (act ? tid : 0) * 4;
        f32x4 acc[9];
#pragma unroll
        for (int i = 0; i < 9; ++i) acc[i] = (f32x4){0.f, 0.f, 0.f, 0.f};
        const float* wp = p.in[I_ADAW] + ((size_t)l * DM + k0) * 12288 + col;
#pragma unroll 8
        for (int k = 0; k < 128; ++k) {
            const f32x4 w = *(const f32x4*)(wp + (size_t)k * 12288);
#pragma unroll
            for (int i = 0; i < 9; ++i) acc[i] += sl[i * 128 + k] * w;
        }
#pragma unroll
        for (int i = 0; i < 9; ++i) if (act) *(f32x4*)(mod + ((size_t)(l * 16 + kc) * 9 + i) * 12288 + col) = acc[i];
        __syncthreads();
    }
}

__device__ __forceinline__ void filter_phase(int wv, const Params& p, int l, LAS unsigned char* lds) {
    LAS float* z = (LAS float*)lds;
    LAS float* H1 = z + 32 * 33;
    LAS float* H2 = H1 + 32 * 64;
    LAS float* W1 = H2 + 32 * 64;
    LAS float* W2 = W1 + 33 * 64;
    LAS float* BF = W2 + 64 * 64;
    const int tid = otid(wv);
    const float* w3 = p.in[I_FW3] + (size_t)l * 64 * 2048; const float* b3 = p.in[I_FB3] + l * 2048;
    for (int u = obid(); u < 72; u += gridDim.x) {
        const int g = (u < 64) ? 1 : 0; const int tc = g ? u : u - 64; const int L = g ? LS : LP; const int t0 = tc * 32;
        float* kT = (float*)(p.ws + (g ? S_KTS : S_KTP)); float* part = (float*)(p.ws + (g ? S_PARTS : S_PARTP));
        for (int i = tid; i < 33 * 64; i += NTHREADS) W1[i] = p.in[I_FW1][(size_t)l * 33 * 64 + i];
        for (int i = tid; i < 64 * 64; i += NTHREADS) W2[i] = p.in[I_FW2][(size_t)l * 64 * 64 + i];
        if (tid < 64) BF[tid] = p.in[I_FB1][l * 64 + tid]; else if (tid < 128) BF[tid] = p.in[I_FB2][l * 64 + tid - 64]; else if (tid < 256) BF[tid] = p.in[I_FFREQ][l * 128 + tid - 128];
        for (int i = tid; i < 32 * 33; i += NTHREADS) {
            const int t = i / 33, e = i - t * 33; const float tf = (float)(t0 + t);
            float v;
            if (e == 0) v = tf / (float)(L - 1);
            else { const int k = (e - 1) & 15; const float band = 1e-4f + (float)k * ((15.0f - 1e-4f) / 15.0f); const float w = (6.283185307179586f * tf) / (float)L; const float ang = w * band;
                   v = (e <= 16) ? cosf(ang) : -sinf(ang); }
            z[i] = v;
        }
        __syncthreads();
#pragma unroll
        for (int q = 0; q < 4; ++q) { const int i = tid + q * NTHREADS; const int t = i >> 6, j = i & 63; float s = BF[j];
#pragma unroll
            for (int e = 0; e < 33; ++e) s += z[t * 33 + e] * W1[e * 64 + j];
            H1[i] = sinf(BF[128 + j] * s); }
        __syncthreads();
#pragma unroll
        for (int q = 0; q < 4; ++q) { const int i = tid + q * NTHREADS; const int t = i >> 6, j = i & 63; float s = BF[64 + j];
#pragma unroll 16
            for (int e = 0; e < 64; ++e) s += H1[t * 64 + e] * W2[e * 64 + j];
            H2[i] = sinf(BF[192 + j] * s); }
        __syncthreads();
        const int c = tid * 4;
        const f32x4 bias = *(const f32x4*)(b3 + c);
        f32x4 delta;
#pragma unroll
        for (int j = 0; j < 4; ++j) { const int d = (c + j) & 1023; const float mn = -3.0701134573253945f, mx = -15.350567286626973f; delta[j] = fabsf(mn + (float)d * ((mx - mn) / 1023.0f)); }
        f32x4 psum = (f32x4){0.f, 0.f, 0.f, 0.f};
        for (int tb = 0; tb < 2; ++tb) {
            f32x4 acc[16];
#pragma unroll
            for (int i = 0; i < 16; ++i) acc[i] = bias;
#pragma unroll 8
            for (int k = 0; k < 64; ++k) {
                const f32x4 w = *(const f32x4*)(w3 + (size_t)k * 2048 + c);
#pragma unroll
                for (int i = 0; i < 16; ++i) acc[i] += H2[(tb * 16 + i) * 64 + k] * w;
            }
#pragma unroll
            for (int i = 0; i < 16; ++i) {
                const int t = t0 + tb * 16 + i; const float tn = (float)t / (float)(L - 1);
#pragma unroll
                for (int j = 0; j < 4; ++j) {
                    const float v = acc[i][j] * __expf(-tn * delta[j]);
                    const int cc = c + j;
                    if (cc < 1024) { kT[(size_t)cc * (2 * L) + t] = v; psum[j] += fabsf(v); }
                    else { const int d = cc - 1024; if (t == 0) kT[(size_t)d * (2 * L) + L] = 0.f; else { kT[(size_t)d * (2 * L) + 2 * L - t] = v; psum[j] += fabsf(v); } }
                }
            }
        }
        *(f32x4*)(part + (size_t)tc * 2048 + c) = psum;
        __syncthreads();
    }
}

__device__ __forceinline__ void row_sel(const Params& p, int l, int mode, int& l2, int& shi, int& sci, const float*& prew, bool& wh, int& gi, const float*& pw) {
    wh = true;
    if (mode == 0) { l2 = l; shi = 0; sci = 1; prew = p.in[I_NMPRE] + l * DM; }
    else if (mode == 1) { l2 = l; shi = 3; sci = 4; prew = p.in[I_NFPRE] + l * DM; }
    else { l2 = l + 1; shi = 0; sci = 1; wh = (l + 1 < NLAYER); if (!wh) l2 = l; prew = p.in[I_NMPRE] + l2 * DM; }
    gi = (mode == 1) ? 2 : 5;
    pw = p.in[mode == 1 ? I_NMPOST : I_NFPOST] + l * DM;
}
__device__ __forceinline__ void comb_phase(int wv, const Params& p) {
    const int tid = otid(wv);
    const float* mod = (const float*)(p.ws + S_MOD); float* comb = (float*)(p.ws + S_COMB);
    for (int idx = obid() * NTHREADS + tid; idx < NLAYER * 3 * 9 * 2048; idx += gridDim.x * NTHREADS) {
        const int c = idx & 2047, q = idx >> 11, mi = q % 9, q2 = q / 9, mode = q2 % 3, l = q2 / 3;
        int l2, shi, sci, gi; const float* prew; const float* pw; bool wh;
        row_sel(p, l, mode, l2, shi, sci, prew, wh, gi, pw);
        float g = 0.f, sc = 0.f, sh = 0.f;
        for (int kc = 0; kc < 16; ++kc) {
            g += mod[((size_t)(l * 16 + kc) * 9 + mi) * 12288 + gi * 2048 + c];
            sc += mod[((size_t)(l2 * 16 + kc) * 9 + mi) * 12288 + sci * 2048 + c];
            sh += mod[((size_t)(l2 * 16 + kc) * 9 + mi) * 12288 + shi * 2048 + c];
        }
        g += p.in[I_ADAB][(size_t)l * 12288 + gi * 2048 + c];
        sc += p.in[I_ADAB][(size_t)l2 * 12288 + sci * 2048 + c];
        sh += p.in[I_ADAB][(size_t)l2 * 12288 + shi * 2048 + c];
        float* o = comb + (size_t)q * 3 * 2048 + c;
        o[0] = g * pw[c]; o[2048] = prew[c] * (1.0f + sc); o[4096] = sh;
    }
}
__device__ __forceinline__ void row_phase(int wv, const Params& p, int l, int mode) {
    const int tid = otid(wv); const int wave = obid() * 8 + (tid >> 6), nw = gridDim.x * 8, lane = tid & 63;
    float* X = p.out;
    bf16_t* H = (bf16_t*)(p.ws + A_H);
    const bool wh = !(mode == 2 && l + 1 >= NLAYER);
    const int rows_per = (MT + nw - 1) / nw;
    int cur_mi = -1; f32x4 cpre[8], csh[8], cgv[8];
    for (int rr = 0; rr < rows_per; ++rr) {
        const int row = wave * rows_per + rr;
        if (row >= MT) break;
        const int mi = row < MP ? 0 : 1 + ((row - MP) >> 11);
        const float* cb = (const float*)(p.ws + S_COMB) + (size_t)((l * 3 + mode) * 9 + mi) * 3 * 2048 + lane * 4;
        if (mi != cur_mi) { cur_mi = mi;
#pragma unroll
            for (int i = 0; i < 8; ++i) { cpre[i] = *(const f32x4*)(cb + 2048 + i * 256); csh[i] = *(const f32x4*)(cb + 4096 + i * 256); if (mode != 0) cgv[i] = *(const f32x4*)(cb + i * 256); } }
        f32x4 x[8];
        const float* xs = (mode == 0) ? (row < MP ? p.in[I_XP] + (size_t)row * DM : p.in[I_XS] + (size_t)(row - MP) * DM) : X + (size_t)row * DM;
#pragma unroll
        for (int i = 0; i < 8; ++i) x[i] = *(const f32x4*)(xs + i * 256 + lane * 4);
        if (mode != 0) {
            const bf16_t* o = (const bf16_t*)(p.ws + (mode == 1 ? A_M32 : A_F32)) + (size_t)row * DM;
            const unsigned tm = ((const unsigned*)(p.ws + S_TAIL))[row >> 8];
            f32x4 ovv[8]; float ss = 0.f;
#pragma unroll
            for (int i = 0; i < 8; ++i) { const u32x2 w = *(const u32x2*)(o + i * 256 + lane * 4); ovv[i] = (f32x4){bf_lo(w.x), bf_hi(w.x), bf_lo(w.y), bf_hi(w.y)};
                if ((tm >> i) & 1u) { const u32x2 w2 = *(const u32x2*)(o + (size_t)MT * DM + i * 256 + lane * 4); ovv[i] += (f32x4){bf_lo(w2.x), bf_hi(w2.x), bf_lo(w2.y), bf_hi(w2.y)}; }
                ss += ovv[i][0] * ovv[i][0] + ovv[i][1] * ovv[i][1] + ovv[i][2] * ovv[i][2] + ovv[i][3] * ovv[i][3]; }
            ss = wave_sum(ss, lane);
            const float rstd = rsqrtf(ss * (1.0f / DM) + 1e-6f);
#pragma unroll
            for (int i = 0; i < 8; ++i) x[i] += cgv[i] * (ovv[i] * rstd);
        }
#pragma unroll
        for (int i = 0; i < 8; ++i) *(f32x4*)(X + (size_t)row * DM + i * 256 + lane * 4) = x[i];
        if (wh) {
            float ss = 0.f;
#pragma unroll
            for (int i = 0; i < 8; ++i) ss += x[i][0] * x[i][0] + x[i][1] * x[i][1] + x[i][2] * x[i][2] + x[i][3] * x[i][3];
            ss = wave_sum(ss, lane);
            const float rstd = rsqrtf(ss * (1.0f / DM) + 1e-6f);
#pragma unroll
            for (int i = 0; i < 8; ++i) {
                const f32x4 hv = (x[i] * rstd) * cpre[i] + csh[i];
                u32x2 o; o.x = cvt_pk_bf16(hv[0], hv[1]); o.y = cvt_pk_bf16(hv[2], hv[3]);
                *(u32x2*)(H + (size_t)row * DM + i * 256 + lane * 4) = o;
            }
        }
    }
}

__device__ __forceinline__ void rope_table_phase(int wv, const Params& p) {
    float* C = (float*)(p.ws + S_ROPE); float* Sn = C + 2048 * 32;
    const int tid = otid(wv);
    for (int idx = obid() * NTHREADS + tid; idx < 2048 * 32; idx += gridDim.x * NTHREADS) {
        const int t = idx >> 5, i = idx & 31, k = i & 15;
        const float inv = exp2f(-(float)k * 0.8304820237218406f);
        const float pos = (i < 16) ? (float)(t >> 6) : (float)(t & 63);
        const float ang = pos * inv; C[idx] = cosf(ang); Sn[idx] = sinf(ang);
    }
}
__device__ __forceinline__ void e2_phase(int wv, const Params& p, int l, LAS unsigned char* lds) {
    const bf16_t* PA = (const bf16_t*)(p.ws + A_PROJA);
    const int tid = otid(wv), lane = tid & 63;
    {
        for (int gw = obid() * 8 + (tid >> 6); gw < 2048; gw += gridDim.x * 8) {
            const int g = gw >> 10, d = gw & 1023; const int NU = g ? 64 : 8;
            const float* part = (const float*)(p.ws + (g ? S_PARTS : S_PARTP));
            float v = 0.f;
            if (lane < NU) v = part[lane * 2048 + d] + part[lane * 2048 + 1024 + d];
            v = wave_sum(v, lane);
            if (lane == 0) ((float*)(p.ws + S_SCALE))[gw] = 1.0f / v;
        }
    }
    {
        bf16_t* CQN = (bf16_t*)(p.ws + A_CQN); bf16_t* KC = (bf16_t*)(p.ws + A_KEYSC); bf16_t* KP = (bf16_t*)(p.ws + A_KPER);
        float* out_ckv = p.out + (size_t)MT * DM; float* out_kpe = out_ckv + (size_t)BP * NLAYER * LP * 256;
        const int wave = obid() * 8 + (tid >> 6), nw = gridDim.x * 8;
        for (int row = wave; row < MT + BS * PAST; row += nw) {
            if (row < MT) {
                const bf16_t* pr = PA + (size_t)row * PA_LD;
                { const u32x4 v = *(const u32x4*)(pr + 3072 + lane * 8); float f[8]; unpack8(v, f); float ss = 0.f;
#pragma unroll
                  for (int j = 0; j < 8; ++j) ss += f[j] * f[j];
                  ss = wave_sum(ss, lane); const float rstd = rsqrtf(ss * (1.0f / 512.0f) + 1e-6f);
                  const float* qn = p.in[I_QN] + l * 512 + lane * 8;
#pragma unroll
                  for (int j = 0; j < 8; ++j) f[j] = f[j] * rstd * qn[j];
                  *(u32x4*)(CQN + (size_t)row * 512 + lane * 8) = pack8(f); }
                int KR, t; const bool isp = row < MP; int b;
                if (isp) { b = row >> 8; t = row & 255; KR = BS * LKS + row; } else { const int r2 = row - MP; b = r2 >> 11; t = r2 & 2047; KR = b * LKS + t; }
                { const u32x2 v = *(const u32x2*)(pr + 3584 + lane * 4); float f[4] = {bf_lo(v.x), bf_hi(v.x), bf_lo(v.y), bf_hi(v.y)};
                  float ss = f[0] * f[0] + f[1] * f[1] + f[2] * f[2] + f[3] * f[3]; ss = wave_sum(ss, lane); const float rstd = rsqrtf(ss * (1.0f / 256.0f) + 1e-6f);
                  const float* kn = p.in[I_KVN] + l * 256 + lane * 4;
#pragma unroll
                  for (int j = 0; j < 4; ++j) f[j] = f[j] * rstd * kn[j];
                  if (isp) *(f32x4*)(out_ckv + ((size_t)(b * NLAYER + l) * LP + t) * 256 + lane * 4) = (f32x4){f[0], f[1], f[2], f[3]};
                  u32x2 w; w.x = cvt_pk_bf16(f[0], f[1]); w.y = cvt_pk_bf16(f[2], f[3]); *(u32x2*)(KC + (size_t)KR * 256 + lane * 4) = w; }
                { const float v = __uint_as_float(((unsigned)pr[3840 + lane]) << 16);
                  float o = v;
                  if (isp) out_kpe[((size_t)(b * NLAYER + l) * LP + t) * 64 + lane] = v;
                  else { const float pv = shx(v, 32, lane); const float* rc = (const float*)(p.ws + S_ROPE); const float cs = rc[t * 32 + (lane & 31)], sn = rc[2048 * 32 + t * 32 + (lane & 31)]; o = (lane < 32) ? (v * cs - pv * sn) : (pv * sn + v * cs); }
                  KP[(size_t)KR * 64 + lane] = f2bf(o); }
            } else {
                const int r2 = row - MT, b = r2 >> 9, j = r2 & 511; const int KR = b * LKS + LS + j;
                const float* cc = p.in[I_CCKV] + ((size_t)(b * NLAYER + l) * PAST + j) * 256 + lane * 4;
                const f32x4 v = *(const f32x4*)cc; u32x2 w; w.x = cvt_pk_bf16(v[0], v[1]); w.y = cvt_pk_bf16(v[2], v[3]); *(u32x2*)(KC + (size_t)KR * 256 + lane * 4) = w;
                KP[(size_t)KR * 64 + lane] = f2bf(p.in[I_CKPE][((size_t)(b * NLAYER + l) * PAST + j) * 64 + lane]);
            }
        }
    }
    {
        bf16_t* YC = (bf16_t*)(p.ws + A_YC); const float* scw = p.in[I_SCW] + (size_t)l * 3 * 1024;
        float w0[8], w1[8], w2[8]; int cur_d0 = -1;
        for (int it = obid() * NTHREADS + tid; it < (MT / 4) * 128; it += gridDim.x * NTHREADS) {
            const int ch = it >> 7, d0 = (it & 127) * 8, row0 = ch * 4;
            const int t0 = row0 < MP ? (row0 & 255) : ((row0 - MP) & 2047); const int L = row0 < MP ? LP : LS;
            if (d0 != cur_d0) { cur_d0 = d0; const f32x4 a = *(const f32x4*)(scw + d0), b = *(const f32x4*)(scw + d0 + 4), c = *(const f32x4*)(scw + 1024 + d0), d = *(const f32x4*)(scw + 1024 + d0 + 4),
                          e2 = *(const f32x4*)(scw + 2048 + d0), f = *(const f32x4*)(scw + 2048 + d0 + 4);
#pragma unroll
              for (int j = 0; j < 4; ++j) { w0[j] = a[j]; w0[4 + j] = b[j]; w1[j] = c[j]; w1[4 + j] = d[j]; w2[j] = e2[j]; w2[4 + j] = f[j]; } }
            const bf16_t* pr = PA + (size_t)row0 * PA_LD;
            float pp[8], pc[8], pn[8];
#pragma unroll
            for (int j = 0; j < 8; ++j) pp[j] = 0.f;
            if (t0 > 0) { float cg[8], uu[8]; unpack8(*(const u32x4*)(pr - PA_LD + 4928 + d0), cg); unpack8(*(const u32x4*)(pr - PA_LD + 5952 + d0), uu);
#pragma unroll
                for (int j = 0; j < 8; ++j) pp[j] = cg[j] * uu[j]; }
            { float cg[8], uu[8]; unpack8(*(const u32x4*)(pr + 4928 + d0), cg); unpack8(*(const u32x4*)(pr + 5952 + d0), uu);
#pragma unroll
              for (int j = 0; j < 8; ++j) pc[j] = cg[j] * uu[j]; }
#pragma unroll
            for (int i = 0; i < 4; ++i) {
#pragma unroll
                for (int j = 0; j < 8; ++j) pn[j] = 0.f;
                if (t0 + i + 1 < L) { float cg[8], uu[8]; unpack8(*(const u32x4*)(pr + (size_t)(i + 1) * PA_LD + 4928 + d0), cg); unpack8(*(const u32x4*)(pr + (size_t)(i + 1) * PA_LD + 5952 + d0), uu);
#pragma unroll
                    for (int j = 0; j < 8; ++j) pn[j] = cg[j] * uu[j]; }
                float bg[8], o[8]; unpack8(*(const u32x4*)(pr + (size_t)i * PA_LD + 3904 + d0), bg);
#pragma unroll
                for (int j = 0; j < 8; ++j) { o[j] = bg[j] * (w0[j] * pp[j] + w1[j] * pc[j] + w2[j] * pn[j]); pp[j] = pc[j]; pc[j] = pn[j]; }
                *(u32x4*)(YC + (size_t)(row0 + i) * 1024 + d0) = pack8(o);
            }
        }
    }
    {
        bf16_t* X0S = (bf16_t*)(p.ws + A_X0S); bf16_t* ZZT = (bf16_t*)(p.ws + A_ZZT);
        const float* hw = p.in[I_HCW] + (size_t)l * 3 * 3072; const float* hb = p.in[I_HCB] + (size_t)l * 3072;
        LAS bf16_t* zt = (LAS bf16_t*)lds;
        float wgt[3][3][8], bs[3][8]; int cur_dt = -1;
        for (int u = obid(); u < (MT / 256) * 16; u += gridDim.x) {
            const int rt = u >> 4, dt = u & 15; const int row0 = rt * 256;
            const int dg = tid & 7, rb = tid >> 3, d0 = dt * 64 + dg * 8; const int rowb = row0 + rb * 4;
            const int L = row0 < MP ? LP : LS; const int tb = (row0 < MP ? (row0 & 255) : ((row0 - MP) & 2047)) + rb * 4;
            const bool reload = (dt != cur_dt); cur_dt = dt;
            if (reload)
#pragma unroll
            for (int g = 0; g < 3; ++g) {
#pragma unroll
                for (int o = 0; o < 3; ++o) { const f32x4 a = *(const f32x4*)(hw + o * 3072 + g * 1024 + d0), b = *(const f32x4*)(hw + o * 3072 + g * 1024 + d0 + 4);
#pragma unroll
                    for (int j = 0; j < 4; ++j) { wgt[g][o][j] = a[j]; wgt[g][o][4 + j] = b[j]; } }
                const f32x4 a = *(const f32x4*)(hb + g * 1024 + d0), b = *(const f32x4*)(hb + g * 1024 + d0 + 4);
#pragma unroll
                for (int j = 0; j < 4; ++j) { bs[g][j] = a[j]; bs[g][4 + j] = b[j]; }
            }
            const bf16_t* pr = PA + (size_t)rowb * PA_LD + d0;
            u32x4 wp[3], wc[3], wn[3];
#pragma unroll
            for (int g = 0; g < 3; ++g) { wp[g] = (u32x4){0u, 0u, 0u, 0u}; if (tb > 0) wp[g] = *(const u32x4*)(pr - PA_LD + g * 1024); wc[g] = *(const u32x4*)(pr + g * 1024); }
#pragma unroll
            for (int i = 0; i < 4; ++i) {
#pragma unroll
                for (int g = 0; g < 3; ++g) { wn[g] = (u32x4){0u, 0u, 0u, 0u}; if (tb + i + 1 < L) wn[g] = *(const u32x4*)(pr + (size_t)(i + 1) * PA_LD + g * 1024); }
                float hv[3][8];
#pragma unroll
                for (int g = 0; g < 3; ++g) { float a[8], b[8], c[8]; unpack8(wp[g], a); unpack8(wc[g], b); unpack8(wn[g], c);
#pragma unroll
                    for (int j = 0; j < 8; ++j) hv[g][j] = bs[g][j] + wgt[g][0][j] * a[j] + wgt[g][1][j] * b[j] + wgt[g][2][j] * c[j];
                    wp[g] = wc[g]; wc[g] = wn[g]; }
                *(u32x4*)(X0S + (size_t)(rowb + i) * 1024 + d0) = pack8(hv[0]);
#pragma unroll
                for (int j = 0; j < 8; ++j) zt[(dg * 8 + j) * 264 + rb * 4 + i] = f2bf(hv[1][j] * hv[2][j]);
            }
            __syncthreads();
#pragma unroll
            for (int i = 0; i < 4; ++i) {
                const int chunk = tid + i * NTHREADS; const int dl = chunk >> 5, tch = chunk & 31; const int d = dt * 64 + dl;
                size_t base; int t0;
                if (row0 < MP) { const int b = row0 >> 8; t0 = 0; base = ((size_t)b * 1024 + d) * LP; }
                else { const int r2 = row0 - MP; const int b = r2 >> 11; t0 = r2 & 2047; base = (size_t)BP * 1024 * LP + ((size_t)b * 1024 + d) * LS; }
                *(u32x4*)(ZZT + base + t0 + tch * 8) = *(const LAS u32x4*)(zt + dl * 264 + tch * 8);
            }
            __syncthreads();
        }
    }
}

__device__ __forceinline__ void conv_phase(int wv, const Params& p, int l, LAS unsigned char* lds) {
    const int tid = otid(wv), wid = tid >> 6, lane = tid & 63, r = lane & 31, hh = lane >> 5;
    const bf16_t* ZZT = (const bf16_t*)(p.ws + A_ZZT); bf16_t* YCT = (bf16_t*)(p.ws + A_YCT);
    const float* hbias = p.in[I_HBIAS] + l * 1024;
    LAS bf16_t* cp = (LAS bf16_t*)lds;
    LAS bf16_t* zz = (LAS bf16_t*)(lds + 65536);
    LAS float* kf = (LAS float*)(lds + 98304);
    for (int u = obid(); u < 2048; u += gridDim.x) {
        const int g = (u < 1024) ? 1 : 0, d = u & 1023;
        const int L = g ? LS : LP, B = g ? BS : BP, L2 = 2 * L, NB = L / 32, NI = 32 / B, NT = NB / NI, lgB = g ? 3 : 4;
        const float* kT = (const float*)(p.ws + (g ? S_KTS : S_KTP)) + (size_t)d * L2;
        const float scale = ((const float*)(p.ws + S_SCALE))[g * 1024 + d]; const float bias = hbias[d];
        for (int i = tid; i < L2 / 4; i += NTHREADS) { f32x4 v = *(const f32x4*)(kT + i * 4); v *= scale; if (i == 0) v[0] += bias; *(LAS f32x4*)(kf + i * 4) = v; }
        const size_t zbase = g ? (size_t)BP * 1024 * LP : 0;
        for (int ch = tid; ch < B * L / 8; ch += NTHREADS) {
            const int b = ch / (L / 8), s8 = ch - b * (L / 8);
            *(LAS u32x4*)(zz + b * L + s8 * 8) = *(const u32x4*)(ZZT + zbase + ((size_t)b * 1024 + d) * L + s8 * 8);
        }
        __syncthreads();
        for (int ck = tid; ck < L2; ck += NTHREADS) {
            const int c = ck / (L2 / 8), m0 = (ck - c * (L2 / 8)) * 8;
            float f[8];
#pragma unroll
            for (int j = 0; j < 8; ++j) f[j] = kf[(L2 - (m0 + c + j)) & (L2 - 1)];
            *(LAS u32x4*)(cp + c * L2 + m0) = pack8(f);
        }
        __syncthreads();
        const int Iloc = r >> lgB, b = r & (B - 1);
        for (int nt = wid * 2; nt < NT; nt += 16) {
            const int I0 = nt * NI;
            f32x16 acc0, acc1;
#pragma unroll
            for (int i = 0; i < 16; ++i) { acc0[i] = 0.f; acc1[i] = 0.f; }
            const bf16x8 zero8 = (bf16x8){0, 0, 0, 0, 0, 0, 0, 0};
            bf16x8 prev[4][2];
#pragma unroll
            for (int i = 0; i < 4; ++i) { prev[i][0] = zero8; prev[i][1] = zero8; }
            const int dl0 = I0 - (NB - 1), nsteps = NB + 2 * NI - 1;
            if (NI == 4) {
                for (int c4 = 0; c4 < nsteps; c4 += 4) {
                    bf16x8 cur[4][2];
#pragma unroll
                    for (int i = 0; i < 4; ++i) {
                        const int dl = dl0 + c4 + i; const int J0 = I0 + Iloc - dl; const bool v0 = (J0 >= 0) && (J0 < NB);
#pragma unroll
                        for (int ks = 0; ks < 2; ++ks) {
                            const int i0 = (16 * ks + 8 * hh - 32 * dl - r) & (L2 - 1); const int c = i0 & 7, q = i0 >> 3;
                            const bf16x8 Af = *(const LAS bf16x8*)(cp + c * L2 + q * 8);
                            cur[i][ks] = zero8;
                            if (v0) cur[i][ks] = *(const LAS bf16x8*)(zz + b * L + 32 * J0 + 16 * ks + 8 * hh);
                            acc0 = __builtin_amdgcn_mfma_f32_32x32x16_bf16(Af, cur[i][ks], acc0, 0, 0, 0);
                            acc1 = __builtin_amdgcn_mfma_f32_32x32x16_bf16(Af, prev[i][ks], acc1, 0, 0, 0);
                        }
                    }
#pragma unroll
                    for (int i = 0; i < 4; ++i) { prev[i][0] = cur[i][0]; prev[i][1] = cur[i][1]; }
                }
            } else {
                for (int c2 = 0; c2 < nsteps + 1; c2 += 2) {
                    bf16x8 cur[2][2];
#pragma unroll
                    for (int i = 0; i < 2; ++i) {
                        const int dl = dl0 + c2 + i; const int J0 = I0 + Iloc - dl; const bool v0 = (J0 >= 0) && (J0 < NB);
#pragma unroll
                        for (int ks = 0; ks < 2; ++ks) {
                            const int i0 = (16 * ks + 8 * hh - 32 * dl - r) & (L2 - 1); const int c = i0 & 7, q = i0 >> 3;
                            const bf16x8 Af = *(const LAS bf16x8*)(cp + c * L2 + q * 8);
                            cur[i][ks] = zero8;
                            if (v0) cur[i][ks] = *(const LAS bf16x8*)(zz + b * L + 32 * J0 + 16 * ks + 8 * hh);
                            acc0 = __builtin_amdgcn_mfma_f32_32x32x16_bf16(Af, cur[i][ks], acc0, 0, 0, 0);
                            acc1 = __builtin_amdgcn_mfma_f32_32x32x16_bf16(Af, prev[i][ks], acc1, 0, 0, 0);
                        }
                    }
#pragma unroll
                    for (int i = 0; i < 2; ++i) { prev[i][0] = cur[i][0]; prev[i][1] = cur[i][1]; }
                }
            }
            bf16_t* op = YCT + zbase + ((size_t)b * 1024 + d) * L + 32 * (I0 + Iloc) + 4 * hh;
#pragma unroll
            for (int g4 = 0; g4 < 4; ++g4) {
                u32x2 w; w.x = cvt_pk_bf16(acc0[4 * g4], acc0[4 * g4 + 1]); w.y = cvt_pk_bf16(acc0[4 * g4 + 2], acc0[4 * g4 + 3]); *(u32x2*)(op + 8 * g4) = w;
                u32x2 w1; w1.x = cvt_pk_bf16(acc1[4 * g4], acc1[4 * g4 + 1]); w1.y = cvt_pk_bf16(acc1[4 * g4 + 2], acc1[4 * g4 + 3]); *(u32x2*)(op + 32 * NI + 8 * g4) = w1;
            }
        }
        __syncthreads();
    }
}

__device__ __forceinline__ void e3b_phase(int wv, const Params& p, LAS unsigned char* lds) {
    const int tid = otid(wv);
    const bf16_t* X0S = (const bf16_t*)(p.ws + A_X0S); const bf16_t* YCT = (const bf16_t*)(p.ws + A_YCT); bf16_t* YA = (bf16_t*)(p.ws + A_YA);
    LAS bf16_t* yt = (LAS bf16_t*)lds;
    for (int u = obid(); u < (MT / 64) * 16; u += gridDim.x) {
        const int rt = u >> 4, dt = u & 15; const int row0 = rt * 64;
        {
            const int dl = tid >> 3, tch = tid & 7; const int d = dt * 64 + dl;
            size_t base; int t0;
            if (row0 < MP) { const int b = row0 >> 8; t0 = row0 & 255; base = ((size_t)b * 1024 + d) * LP; }
            else { const int r2 = row0 - MP; const int b = r2 >> 11; t0 = r2 & 2047; base = (size_t)BP * 1024 * LP + ((size_t)b * 1024 + d) * LS; }
            const u32x4 v = *(const u32x4*)(YCT + base + t0 + tch * 8);
            const unsigned w[4] = {v.x, v.y, v.z, v.w};
#pragma unroll
            for (int j = 0; j < 4; ++j) { yt[(tch * 8 + 2 * j) * 72 + dl] = (bf16_t)(w[j] & 0xffffu); yt[(tch * 8 + 2 * j + 1) * 72 + dl] = (bf16_t)(w[j] >> 16); }
        }
        __syncthreads();
        {
            const int tl = tid >> 3, dg = tid & 7; const int row = row0 + tl, d0 = dt * 64 + dg * 8;
            float a[8], b[8]; unpack8(*(const LAS u32x4*)(yt + tl * 72 + dg * 8), a); unpack8(*(const u32x4*)(X0S + (size_t)row * 1024 + d0), b);
#pragma unroll
            for (int j = 0; j < 8; ++j) a[j] *= b[j];
            *(u32x4*)(YA + (size_t)row * 1024 + d0) = pack8(a);
        }
        __syncthreads();
    }
}

__device__ __forceinline__ void attn_phase(int wv, const Params& p, LAS unsigned char* lds) {
    const bf16_t* Q = (const bf16_t*)(p.ws + A_Q); const bf16_t* KN = (const bf16_t*)(p.ws + A_KN); const bf16_t* KP = (const bf16_t*)(p.ws + A_KPER);
    const bf16_t* VT = (const bf16_t*)(p.ws + A_VT); bf16_t* O = (bf16_t*)(p.ws + A_OATT);
    LAS unsigned char* Ks = lds;
    LAS unsigned char* Vs = lds + 64 * 400;
    const float sc2 = 0.07216878364870322f * 1.4426950408889634f;
    for (int u0 = obid(); u0 < 512 + 128; u0 += gridDim.x) {
        const int tid = otid(wv), wid = tid >> 6, lane = tid & 63, r = lane & 31, hh = lane >> 5;
        int u = u0;
        if (u0 < 512 && gridDim.x == 256) {
            const int c = u0 & 255, xcd = c & 7, j = c >> 3; u = (u0 & ~255) + ((xcd * 4 + (j >> 3)) * 8 + (j & 7));
        }
        int b, h, row0, Lk, KR0; size_t vtb; bool samp;
        if (u < 512) { samp = true; b = u >> 6; h = (u >> 3) & 7; const int qb = u & 7; row0 = MP + b * LS + qb * 256; Lk = LKS; KR0 = b * LKS; vtb = (size_t)(b * 8 + h) * 128 * LKS; }
        else { samp = false; const int u2 = u - 512; b = u2 >> 3; h = u2 & 7; row0 = b * LP; Lk = LP; KR0 = BS * LKS + b * LP; vtb = (size_t)BS * 8 * 128 * LKS + (size_t)(b * 8 + h) * 128 * LP; }
        const int qrow = row0 + wid * 32 + r;
        bf16x8 qf[12];
        {
            const bf16_t* qp = Q + (size_t)qrow * 1536 + h * 192 + 8 * hh;
            u32x4 qv[12];
#pragma unroll
            for (int s = 0; s < 12; ++s) qv[s] = *(const u32x4*)(qp + 16 * s);
            if (samp) {
                const int t = (qrow - MP) & 2047;
#pragma unroll
                for (int s2 = 0; s2 < 2; ++s2) {
                    float x1[8], x2[8]; unpack8(qv[8 + s2], x1); unpack8(qv[10 + s2], x2);
                    const float* rc = (const float*)(p.ws + S_ROPE) + t * 32 + 16 * s2 + 8 * hh;
                    const f32x4 c0 = *(const f32x4*)rc, c1 = *(const f32x4*)(rc + 4), s0 = *(const f32x4*)(rc + 2048 * 32), s1 = *(const f32x4*)(rc + 2048 * 32 + 4);
#pragma unroll
                    for (int j = 0; j < 8; ++j) { const float cs = (j < 4) ? c0[j & 3] : c1[j & 3], sn = (j < 4) ? s0[j & 3] : s1[j & 3]; const float a = x1[j], c = x2[j]; x1[j] = a * cs - c * sn; x2[j] = a * sn + c * cs; }
                    qv[8 + s2] = pack8(x1); qv[10 + s2] = pack8(x2);
                }
            }
#pragma unroll
            for (int s = 0; s < 12; ++s) qf[s] = __builtin_bit_cast(bf16x8, qv[s]);
        }
        f32x16 oacc[4];
#pragma unroll
        for (int ct = 0; ct < 4; ++ct)
#pragma unroll
            for (int i = 0; i < 16; ++i) oacc[ct][i] = 0.f;
        float mrun = -1e30f, lrun = 0.f;
        const int nkt = Lk / 64;
        u32x4 kst[3], vst[2];
#pragma unroll
        for (int i = 0; i < 3; ++i) { const int ck = tid + i * NTHREADS; const int key = ck / 24, part = ck - key * 24;
            kst[i] = (part < 16) ? *(const u32x4*)(KN + (size_t)(KR0 + key) * 1024 + h * 128 + part * 8) : *(const u32x4*)(KP + (size_t)(KR0 + key) * 64 + (part - 16) * 8); }
#pragma unroll
        for (int i = 0; i < 2; ++i) { const int cv = tid + i * NTHREADS; const int v = cv >> 3, kc = cv & 7; vst[i] = *(const u32x4*)(VT + vtb + (size_t)v * Lk + kc * 8); }
        for (int kt = 0; kt < nkt; ++kt) {
            __syncthreads();
#pragma unroll
            for (int i = 0; i < 3; ++i) { const int ck = tid + i * NTHREADS; const int key = ck / 24, part = ck - key * 24; *(LAS u32x4*)(Ks + key * 400 + part * 16) = kst[i]; }
#pragma unroll
            for (int i = 0; i < 2; ++i) { const int cv = tid + i * NTHREADS; const int v = cv >> 3, kc = cv & 7;
                LAS unsigned char* vp = Vs + v * 144 + (kc >> 1) * 32 + (kc & 1) * 8;
                *(LAS u32x2*)vp = (u32x2){vst[i].x, vst[i].y}; *(LAS u32x2*)(vp + 16) = (u32x2){vst[i].z, vst[i].w}; }
            __syncthreads();
            if (kt + 1 < nkt) {
                const int k0 = (kt + 1) * 64;
#pragma unroll
                for (int i = 0; i < 3; ++i) { const int ck = tid + i * NTHREADS; const int key = ck / 24, part = ck - key * 24;
                    kst[i] = (part < 16) ? *(const u32x4*)(KN + (size_t)(KR0 + k0 + key) * 1024 + h * 128 + part * 8) : *(const u32x4*)(KP + (size_t)(KR0 + k0 + key) * 64 + (part - 16) * 8); }
#pragma unroll
                for (int i = 0; i < 2; ++i) { const int cv = tid + i * NTHREADS; const int v = cv >> 3, kc = cv & 7; vst[i] = *(const u32x4*)(VT + vtb + (size_t)v * Lk + k0 + kc * 8); }
            }
            f32x16 sacc[2];
#pragma unroll
            for (int i = 0; i < 16; ++i) { sacc[0][i] = 0.f; sacc[1][i] = 0.f; }
#pragma unroll
            for (int s = 0; s < 12; ++s) {
                const bf16x8 kf0 = *(const LAS bf16x8*)(Ks + r * 400 + (16 * s + 8 * hh) * 2);
                const bf16x8 kf1 = *(const LAS bf16x8*)(Ks + (32 + r) * 400 + (16 * s + 8 * hh) * 2);
                sacc[0] = __builtin_amdgcn_mfma_f32_32x32x16_bf16(kf0, qf[s], sacc[0], 0, 0, 0);
                sacc[1] = __builtin_amdgcn_mfma_f32_32x32x16_bf16(kf1, qf[s], sacc[1], 0, 0, 0);
            }
            float mx0 = fmaxf(sacc[0][0], sacc[1][0]), mx1 = fmaxf(sacc[0][1], sacc[1][1]);
#pragma unroll
            for (int i = 2; i < 16; i += 2) { mx0 = __builtin_fmaxf(__builtin_fmaxf(mx0, sacc[0][i]), sacc[1][i]); mx1 = __builtin_fmaxf(__builtin_fmaxf(mx1, sacc[0][i + 1]), sacc[1][i + 1]); }
            float mx = fmaxf(mx0, mx1);
            mx = fmaxf(mx, shx(mx, 32, lane));
            const float mnew = fmaxf(mrun, mx);
            const bool resc = __builtin_amdgcn_ballot_w64(mnew != mrun) != 0ull;
            const float alpha = __builtin_amdgcn_exp2f((mrun - mnew) * sc2);
            mrun = mnew;
            const float nm = -mnew * sc2;
            f32x2 ps2 = (f32x2){0.f, 0.f};
#pragma unroll
            for (int kk = 0; kk < 2; ++kk)
#pragma unroll
                for (int i = 0; i < 16; i += 2) {
                    f32x2 a = (f32x2){sacc[kk][i], sacc[kk][i + 1]}; a = a * sc2 + nm;
                    a.x = __builtin_amdgcn_exp2f(a.x); a.y = __builtin_amdgcn_exp2f(a.y);
                    sacc[kk][i] = a.x; sacc[kk][i + 1] = a.y; ps2 += a;
                }
            lrun = lrun * alpha + (ps2.x + ps2.y);
            if (resc) {
#pragma unroll
                for (int ct = 0; ct < 4; ++ct)
#pragma unroll
                    for (int i = 0; i < 16; ++i) oacc[ct][i] *= alpha;
            }
#pragma unroll
            for (int ks = 0; ks < 4; ++ks) {
                const int kk = ks >> 1, s2 = ks & 1;
                u32x4 pw;
                pw.x = cvt_pk_bf16(sacc[kk][8 * s2 + 0], sacc[kk][8 * s2 + 1]); pw.y = cvt_pk_bf16(sacc[kk][8 * s2 + 2], sacc[kk][8 * s2 + 3]);
                pw.z = cvt_pk_bf16(sacc[kk][8 * s2 + 4], sacc[kk][8 * s2 + 5]); pw.w = cvt_pk_bf16(sacc[kk][8 * s2 + 6], sacc[kk][8 * s2 + 7]);
                const bf16x8 pf = __builtin_bit_cast(bf16x8, pw);
#pragma unroll
                for (int ct = 0; ct < 4; ++ct) {
                    const bf16x8 vf = *(const LAS bf16x8*)(Vs + (32 * ct + r) * 144 + (32 * kk + 16 * s2) * 2 + 16 * hh);
                    oacc[ct] = __builtin_amdgcn_mfma_f32_32x32x16_bf16(vf, pf, oacc[ct], 0, 0, 0);
                }
            }
        }
        lrun += shx(lrun, 32, lane);
        const float invl = 1.0f / lrun;
        const int tid2 = otid(wv); const int qrow2 = row0 + (tid2 >> 6) * 32 + (tid2 & 31);
        bf16_t* op = O + (size_t)qrow2 * 1024 + h * 128 + 4 * ((tid2 >> 5) & 1);
#pragma unroll
        for (int ct = 0; ct < 4; ++ct)
#pragma unroll
            for (int g4 = 0; g4 < 4; ++g4) {
                u32x2 w; w.x = cvt_pk_bf16(oacc[ct][4 * g4] * invl, oacc[ct][4 * g4 + 1] * invl); w.y = cvt_pk_bf16(oacc[ct][4 * g4 + 2] * invl, oacc[ct][4 * g4 + 3] * invl);
                *(u32x2*)(op + 32 * ct + 8 * g4) = w;
            }
        __syncthreads();
    }
}

__device__ __forceinline__ void e9_phase(int wv, const Params& p, int l) {
    const bf16_t* UU = (const bf16_t*)(p.ws + A_UU); bf16_t* ACT = (bf16_t*)(p.ws + A_ACT);
    const float* cw = p.in[I_FCW] + (size_t)l * 3 * UU_LD; const float* cb = p.in[I_FCB] + (size_t)l * UU_LD;
    const int tid9 = otid(wv);
    constexpr int RC = 16, NCG = DFF / 8;
    const int gt = obid() * NTHREADS + tid9, nlr = (int)(gridDim.x * NTHREADS) / NCG;
    const int c0 = (gt % NCG) * 8, lr = gt / NCG;
    float wg[3][8], wx[3][8], bg[8], bx[8];
    if (lr < nlr) {
#pragma unroll
        for (int o = 0; o < 3; ++o) { const f32x4 a = *(const f32x4*)(cw + o * UU_LD + c0), b = *(const f32x4*)(cw + o * UU_LD + c0 + 4), c = *(const f32x4*)(cw + o * UU_LD + DFF + c0), d = *(const f32x4*)(cw + o * UU_LD + DFF + c0 + 4);
#pragma unroll
            for (int j = 0; j < 4; ++j) { wg[o][j] = a[j]; wg[o][4 + j] = b[j]; wx[o][j] = c[j]; wx[o][4 + j] = d[j]; } }
        { const f32x4 a = *(const f32x4*)(cb + c0), b = *(const f32x4*)(cb + c0 + 4), c = *(const f32x4*)(cb + DFF + c0), d = *(const f32x4*)(cb + DFF + c0 + 4);
#pragma unroll
          for (int j = 0; j < 4; ++j) { bg[j] = a[j]; bg[4 + j] = b[j]; bx[j] = c[j]; bx[4 + j] = d[j]; } }
    }
    for (int ch = lr; lr < nlr && ch < MT / RC; ch += nlr) {
        const int row0 = ch * RC;
        const int t0 = row0 < MP ? (row0 & 255) : ((row0 - MP) & 2047); const int L = row0 < MP ? LP : LS;
        const bf16_t* pr = UU + (size_t)row0 * UU_LD + c0;
        u32x4 gp = (u32x4){0u, 0u, 0u, 0u}, xp = gp, gc, xc, gn, xn;
        if (t0 > 0) { gp = *(const u32x4*)(pr - UU_LD); xp = *(const u32x4*)(pr - UU_LD + DFF); }
        gc = *(const u32x4*)pr; xc = *(const u32x4*)(pr + DFF);
#pragma unroll 4
        for (int i = 0; i < RC; ++i) {
            gn = (u32x4){0u, 0u, 0u, 0u}; xn = gn;
            if (t0 + i + 1 < L) { gn = *(const u32x4*)(pr + (size_t)(i + 1) * UU_LD); xn = *(const u32x4*)(pr + (size_t)(i + 1) * UU_LD + DFF); }
            float a[8], b[8], c[8], ga[8], va[8];
            unpack8(gp, a); unpack8(gc, b); unpack8(gn, c);
#pragma unroll
            for (int j = 0; j < 8; ++j) ga[j] = bg[j] + wg[0][j] * a[j] + wg[1][j] * b[j] + wg[2][j] * c[j];
            unpack8(xp, a); unpack8(xc, b); unpack8(xn, c);
#pragma unroll
            for (int j = 0; j < 8; ++j) va[j] = bx[j] + wx[0][j] * a[j] + wx[1][j] * b[j] + wx[2][j] * c[j];
#pragma unroll
            for (int j = 0; j < 8; ++j) ga[j] = siluf_(ga[j]) * va[j];
            *(u32x4*)(ACT + (size_t)(row0 + i) * DFF + c0) = pack8(ga);
            gp = gc; gc = gn; xp = xc; xc = xn;
        }
    }
}

__device__ __forceinline__ void merge_phase(int wv, const Params& p) {
    const bf16_t* RAW = (const bf16_t*)(p.ws + A_RAW); const bf16_t* G = (const bf16_t*)(p.ws + A_GATES); bf16_t* MB = (bf16_t*)(p.ws + A_MBF);
    const int tid = otid(wv);
    for (int it = obid() * NTHREADS + tid; it < MT * 256; it += gridDim.x * NTHREADS) {
        const int row = it >> 8, c0 = (it & 255) * 8;
        float acc[8];
#pragma unroll
        for (int j = 0; j < 8; ++j) acc[j] = 0.f;
#pragma unroll
        for (int P = 0; P < 3; ++P) {
            float r[8], g[8];
            unpack8(*(const u32x4*)(RAW + ((size_t)P * MT + row) * DM + c0), r); unpack8(*(const u32x4*)(G + (size_t)row * GATE_LD + P * 2048 + c0), g);
#pragma unroll
            for (int j = 0; j < 8; ++j) acc[j] += sigmoidf_(g[j]) * r[j];
        }
        *(u32x4*)(MB + (size_t)row * DM + c0) = pack8(acc);
    }
}

__device__ __forceinline__ void convert_layer(int wv, const Params& p, int l, LAS unsigned char* lds, int part = 0) {
    unsigned char* ws = p.ws;
    if (part != 2) {
    convT(wv, p.in[I_WIN] + (size_t)l * DM * NIN, DM, NIN, (bf16_t*)(ws + W_IN), 1, lds);
    convT(wv, p.in[I_WUQ] + (size_t)l * 512 * 1536, 512, 1536, (bf16_t*)(ws + W_UQ), 0, lds);
    convT(wv, p.in[I_WUKV] + (size_t)l * 256 * 2048, 256, 2048, (bf16_t*)(ws + W_UKV), 2, lds);
    convT(wv, p.in[I_WBRA] + (size_t)l * 1024 * 2048, 1024, 2048, (bf16_t*)(ws + W_BRA), 0, lds);
    convT(wv, p.in[I_WBRB] + (size_t)l * 1024 * 2048, 1024, 2048, (bf16_t*)(ws + W_BRB), 0, lds);
    convT(wv, p.in[I_WBRC] + (size_t)l * 1024 * 2048, 1024, 2048, (bf16_t*)(ws + W_BRC), 0, lds);
    convT(wv, p.in[I_WO] + (size_t)l * 2048 * 2048, 2048, 2048, (bf16_t*)(ws + W_O), 0, lds);
    convT(wv, p.in[I_FUP] + (size_t)l * 2048 * UU_LD, 2048, UU_LD, (bf16_t*)(ws + W_UP), 0, lds);
    }
    if (part != 1) convT(wv, p.in[I_FDN] + (size_t)l * DFF * 2048, DFF, 2048, (bf16_t*)(ws + W_DN), 0, lds);
}

namespace pg8 {
struct EpiGateRT {
    const bf16_t* gates; float* m32; bf16_t* mbf; int P;
    __device__ __forceinline__ void operator()(const f32x4 (&acc)[2][2][4][2], const Unit& u, int wr, int wc, int fr, int fq) const {
        const int row0 = u.pm * BM + wr * 64 + fr, col0 = u.pn * BM + wc * 32 + 4 * fq;
#pragma unroll
        for (int ai = 0; ai < 2; ++ai)
#pragma unroll
            for (int m = 0; m < 4; ++m) {
                const size_t row = (size_t)(row0 + ai * HALF + m * 16);
#pragma unroll
                for (int bj = 0; bj < 2; ++bj)
#pragma unroll
                    for (int n = 0; n < 2; ++n) {
                        const int col = col0 + bj * HALF + n * 16;
                        const u32x2 gw = *(const u32x2*)(gates + row * GATE_LD + P * 2048 + col);
                        f32x4 v = acc[ai][bj][m][n];
                        v[0] *= sigmoidf_(bf_lo(gw.x)); v[1] *= sigmoidf_(bf_hi(gw.x)); v[2] *= sigmoidf_(bf_lo(gw.y)); v[3] *= sigmoidf_(bf_hi(gw.y));
                        float* mp = m32 + row * 2048 + col;
                        if (P != 0) { const f32x4 o = *(const f32x4*)mp; v = v + o; }
                        if (P != 2) { *(f32x4*)mp = v; }
                        else { u32x2 w; w.x = cvt_pk_bf16(v[0], v[1]); w.y = cvt_pk_bf16(v[2], v[3]); *(u32x2*)(mbf + row * 2048 + col) = w; }
                    }
            }
    }
};
}


#define XB_TMO      128
#define XB_XCNT(j)  (256  + 64 * (j))
#define XB_XSUB(j)  (1280 + 64 * (j))
#define XB_XGEN(j)  (2304 + 64 * (j))
#define XB_TOP      3328
#define XB_TOPGEN   3392
#define XCD_BAR_WORDS 3456
#define XB_SPIN_CAP (1u << 20)
__device__ __forceinline__ unsigned xb_ld(unsigned* p)              { return __hip_atomic_load(p, __ATOMIC_RELAXED, __HIP_MEMORY_SCOPE_AGENT); }
__device__ __forceinline__ unsigned xb_add(unsigned* p, unsigned v) { return __hip_atomic_fetch_add(p, v, __ATOMIC_RELAXED, __HIP_MEMORY_SCOPE_AGENT); }
__device__ __forceinline__ unsigned xb_xcc_id() { return (unsigned)__builtin_amdgcn_s_getreg((3 << 11) | 20) & 0xFu; }
#define XB_SPIN(cond, bar) do { unsigned _sp = 0; while (cond) { __builtin_amdgcn_s_sleep(1); \
    if ((++_sp & 255u) == 0u) { if (xb_ld(&(bar)[XB_TMO])) break; if (_sp > XB_SPIN_CAP) { atomicAdd(&(bar)[XB_TMO], 1u); break; } } } } while (0)
__device__ __forceinline__ void xcd_barrier_complete(unsigned* bar, unsigned x, unsigned& nloc, unsigned& nx) {
    const unsigned G = gridDim.x;
    unsigned sum, cnt, mine, sp = 0u;
    for (;;) {
        sum = 0u; cnt = 0u; mine = 0u;
#pragma unroll
        for (unsigned j = 0; j < 16; ++j) { const unsigned c = xb_ld(&bar[XB_XCNT(j)]); sum += c; cnt += (c > 0u) ? 1u : 0u; mine = (j == x) ? c : mine; }
        if (sum == G) break;
        __builtin_amdgcn_s_sleep(1);
        if ((++sp & 255u) == 0u) { if (xb_ld(&bar[XB_TMO])) break; if (sp > XB_SPIN_CAP) { atomicAdd(&bar[XB_TMO], 1u); break; } }
    }
    nloc = mine > 0u ? mine : 1u; nx = cnt > 0u ? cnt : 1u;
}
__device__ __forceinline__ void xcd_barrier(int wv, unsigned* bar, volatile LAS unsigned* st) {
    asm volatile("s_waitcnt vmcnt(0)" ::: "memory");
    __syncthreads();
    if (otid(wv) == 0) {
        __builtin_amdgcn_s_waitcnt(0);
        const unsigned x = xb_xcc_id();
        unsigned nloc = st[0], nx = st[1];
        if (nloc == 0u) { xcd_barrier_complete(bar, x, nloc, nx); st[0] = nloc; st[1] = nx; }
        const unsigned old = xb_add(&bar[XB_XSUB(x)], 1u);
        const unsigned gen = old / nloc;
        if (old + 1u == (gen + 1u) * nloc) {
            __builtin_amdgcn_fence(__ATOMIC_RELEASE, "agent");
            asm volatile("s_waitcnt vmcnt(0)" ::: "memory");
            const unsigned og = xb_add(&bar[XB_TOP], 1u);
            const unsigned tg = og / nx;
            if (og + 1u == (tg + 1u) * nx) xb_add(&bar[XB_TOPGEN], 1u);
            else XB_SPIN(xb_ld(&bar[XB_TOPGEN]) == tg, bar);
            __builtin_amdgcn_fence(__ATOMIC_ACQUIRE, "agent");
            xb_add(&bar[XB_XGEN(x)], 1u);
            asm volatile("s_waitcnt vmcnt(0)" ::: "memory");
        } else {
            XB_SPIN(xb_ld(&bar[XB_XGEN(x)]) == gen, bar);
            __builtin_amdgcn_fence(__ATOMIC_ACQUIRE, "agent");
            asm volatile("s_waitcnt vmcnt(0)" ::: "memory");
        }
    }
    __syncthreads();
}

#ifndef REP_GEMM
#define REP_GEMM 1
#endif
#ifndef REP_ATTN
#define REP_ATTN 1
#endif
#ifndef REP_CONV
#define REP_CONV 1
#endif
#ifndef REP_ELT
#define REP_ELT 1
#endif
#ifndef REP_CVT
#define REP_CVT 1
#endif
enum { K_G1A = 0, K_E2, K_I3, K_I4, K_G1B, K_G5, K_G6, K_ROW1, K_G8, K_E9, K_G10, K_ROW2, K_PRO, K_ROW0, K_COMB };

__global__ void __launch_bounds__(NTHREADS) fwd_megakernel(Params p) {
    extern __shared__ __attribute__((aligned(16))) unsigned char shm[];
    LAS unsigned char* lds = (LAS unsigned char*)shm;
    cg::grid_group grid = cg::this_grid();
    const int wv = __builtin_amdgcn_readfirstlane((int)(threadIdx.x >> 6));
    volatile LAS unsigned* bst = (volatile LAS unsigned*)(lds + 131072);
    unsigned* bar = (unsigned*)(p.ws + S_BAR);
    if (threadIdx.x == 0) { bst[0] = 0u; bst[1] = 0u; bst[2] = 0u; bst[3] = 0u; (void)xb_add(&bar[XB_XCNT(xb_xcc_id())], 1u); }
    __syncthreads();
#pragma unroll 1
    for (int ph = 0; ph < 3 + 12 * NLAYER; ++ph) {
        int kind, l;
        if (ph == 0) { kind = K_PRO; l = 0; } else if (ph == 1) { kind = K_COMB; l = 0; } else if (ph == 2) { kind = K_ROW0; l = 0; } else { l = (ph - 3) / 12; kind = (ph - 3) - l * 12; }
        unsigned char* ws = p.ws;
        asm volatile("" : "+s"(ws));
        if (kind == K_G1A || kind == K_I3 || kind == K_G1B || kind == K_G8) {
            const bf16_t* A; const bf16_t* Bt; bf16_t* O; int N, K;
            if (kind == K_G1A) { A = (const bf16_t*)(ws + A_H); Bt = (const bf16_t*)(ws + W_IN); O = (bf16_t*)(ws + A_PROJA); N = PA_LD; K = DM; }
            else if (kind == K_I3) { A = (const bf16_t*)(ws + A_CQN); Bt = (const bf16_t*)(ws + W_UQ); O = (bf16_t*)(ws + A_Q); N = 1536; K = 512; }
            else if (kind == K_G1B) { A = (const bf16_t*)(ws + A_H); Bt = (const bf16_t*)(ws + W_IN) + (size_t)PA_LD * DM; O = (bf16_t*)(ws + A_GATES); N = GATE_LD; K = DM; }
            else { A = (const bf16_t*)(ws + A_H); Bt = (const bf16_t*)(ws + W_UP); O = (bf16_t*)(ws + A_UU); N = UU_LD; K = DM; }
            int Mr = MT;
            const int nrep = ((kind == K_I3) ? 2 : 1) * REP_GEMM;
#pragma unroll 1
            for (int rp = 0; rp < nrep; ++rp) {
                if (kind == K_I3 && rp >= REP_GEMM) { A = (const bf16_t*)(ws + A_KEYSC); Bt = (const bf16_t*)(ws + W_UKV); O = (bf16_t*)(ws + A_KN); N = 1024; K = 256; Mr = KROWS; }
                run_gemm(wv, lds, A, Bt, Mr, N, K, pg8::EpiBf16{O, N, O});
            }
        }
        if (kind == K_I3) {
#pragma unroll 1
            for (int rp = 0; rp < REP_GEMM; ++rp)
            run_gemm(wv, lds, (const bf16_t*)(ws + W_UKV) + (size_t)1024 * 256, (const bf16_t*)(ws + A_KEYSC), 1024, KROWS, 256,
                     pg8::EpiVT{(bf16_t*)(ws + A_VT), (bf16_t*)(ws + A_VT) + (size_t)BS * 8 * 128 * LKS});
#pragma unroll 1
            for (int rp = 0; rp < REP_CONV; ++rp) conv_phase(wv, p, l, lds);
        }
        if (kind == K_I4) {
#pragma unroll 1
            for (int rp = 0; rp < REP_ATTN; ++rp) attn_phase(wv, p, lds);
#pragma unroll 1
            for (int rp = 0; rp < REP_ELT; ++rp) e3b_phase(wv, p, lds); }
        if (kind == K_G1B) {
#pragma unroll 1
            for (int rp = 0; rp < REP_GEMM; ++rp)
            run_gemm(wv, lds, (const bf16_t*)(ws + A_YA), (const bf16_t*)(ws + W_BRA), 3 * MT, DM, 1024, pg8::EpiBf16{(bf16_t*)(ws + A_RAW), DM, (bf16_t*)(ws + A_RAW)}, false, MT / 256, E_WBR * 2, true);
        }
        if (kind == K_G5) merge_phase(wv, p);
        if (kind == K_G6 || kind == K_G10) {
            const bool g6 = (kind == K_G6);
            const bool cvt = (kind == K_G10) && (l + 1 < NLAYER);
            const int cfirst = (cvt && (obid() & 1)) ? 1 : 0;
#pragma unroll 1
            for (int step = 0; step < 2; ++step) {
            const bool do_cvt = (step == 0) ? (cfirst == 1) : (cfirst == 0);
            if (do_cvt) { if (cvt) convert_layer(wv, p, l + 1, lds, 1); }
            else
            run_gemm(wv, lds, (const bf16_t*)(ws + (g6 ? A_MBF : A_ACT)), (const bf16_t*)(ws + (g6 ? W_O : W_DN)), MT, DM, g6 ? DM : DFF, pg8::EpiBf16{(bf16_t*)(ws + (g6 ? A_M32 : A_F32)), DM, (bf16_t*)(ws + (g6 ? A_M32 : A_F32)) + (size_t)MT * DM}, true);
            }
        }
        if (kind == K_E2) {
#pragma unroll 1
            for (int rp = 0; rp < REP_ELT; ++rp) e2_phase(wv, p, l, lds); }
        if (kind == K_E9) {
#pragma unroll 1
            for (int rp = 0; rp < REP_ELT; ++rp) e9_phase(wv, p, l); }
        if (kind == K_ROW0 || kind == K_ROW1 || kind == K_ROW2) row_phase(wv, p, l, kind == K_ROW0 ? 0 : (kind == K_ROW1 ? 1 : 2));
        if (kind == K_COMB) comb_phase(wv, p);
        if (kind == K_PRO) {
            if (obid() == 0) {
                pg8::StaticOrder S; S.init(MT, DM, (int)gridDim.x, 0, true);
                const int t0 = otid(wv);
                if (t0 < S.nwg - S.nfull) { pg8::Unit uu; S.tile_of(S.nfull + t0, uu); atomicOr((unsigned*)(p.ws + S_TAIL) + uu.pm, 1u << uu.pn); }
            }
            ada_phase(wv, p, lds); rope_table_phase(wv, p); }
        if (kind == K_PRO || (kind == K_ROW2 && l + 1 < NLAYER)) { const int ln = (kind == K_PRO) ? 0 : l + 1;
#pragma unroll 1
            for (int rp = 0; rp < REP_CVT; ++rp) { filter_phase(wv, p, ln, lds); convert_layer(wv, p, ln, lds, kind == K_PRO ? 0 : 2); } }
        if (p.ws == nullptr) grid.sync();
        xcd_barrier(wv, bar, bst);
    }
}

extern "C" void kernel_launch(void* const* d_in, const int* in_sizes, int n_in, void* d_out, int out_size, void* d_ws, size_t ws_size, hipStream_t stream) {
    static int grid_blocks = 0;
    if (grid_blocks == 0) {
        if (n_in != N_INPUTS || ws_size < WS_NEED) { fprintf(stderr, "kernel_launch: need %d inputs and %zu bytes of workspace; got %d, %zu\n", N_INPUTS, (size_t)WS_NEED, n_in, ws_size); grid_blocks = -1; return; }
        int dev = 0, cus = 0, per_cu = 0;
        hipGetDevice(&dev);
        hipDeviceGetAttribute(&cus, hipDeviceAttributeMultiprocessorCount, dev);
        if (hipFuncSetAttribute((const void*)fwd_megakernel, hipFuncAttributeMaxDynamicSharedMemorySize, LDS_BYTES) != hipSuccess) { fprintf(stderr, "kernel_launch: hipFuncSetAttribute failed\n"); grid_blocks = -1; return; }
        if (hipOccupancyMaxActiveBlocksPerMultiprocessor(&per_cu, (const void*)fwd_megakernel, NTHREADS, LDS_BYTES) != hipSuccess || per_cu < 1) { fprintf(stderr, "kernel_launch: occupancy query gave %d\n", per_cu); per_cu = 1; }
        (void)hipGetLastError();
        grid_blocks = cus * 1;
    }
    if (grid_blocks < 0) return;
        (void)hipMemsetAsync((unsigned char*)d_ws + S_BAR, 0, 16384, stream);
    Params p{};
    for (int i = 0; i < N_INPUTS; ++i) p.in[i] = (const float*)d_in[i];
    p.out = (float*)d_out; p.ws = (unsigned char*)d_ws;
    void* args[] = {&p};
    hipError_t e = hipLaunchCooperativeKernel((const void*)fwd_megakernel, dim3(grid_blocks), dim3(NTHREADS), args, LDS_BYTES, stream);
    if (e != hipSuccess) fprintf(stderr, "cooperative launch failed: %s (grid %d)\n", hipGetErrorString(e), grid_blocks);
}
```

```cpp
#include <hip/hip_runtime.h>
#include <hip/hip_cooperative_groups.h>
#include <cstdio>
namespace cg = cooperative_groups;

#define LAS __attribute__((address_space(3)))
typedef unsigned short bf16_t;
typedef short bf16x8 __attribute__((ext_vector_type(8)));
typedef float f32x4 __attribute__((ext_vector_type(4)));
typedef float f32x16 __attribute__((ext_vector_type(16)));
typedef unsigned u32x4 __attribute__((ext_vector_type(4)));
typedef unsigned u32x2 __attribute__((ext_vector_type(2)));
typedef float f32x2 __attribute__((ext_vector_type(2)));

constexpr int DM = 2048, MP = 4096, MS = 16384, MT = 20480, NLAYER = 2;
constexpr int LP = 256, LS = 2048, BP = 16, BS = 8, PAST = 512, LKS = 2560;
constexpr int NIN = 13120, NGATE0 = 6976, PA_LD = 7168, GATE_LD = 6144;
constexpr int DFF = 5632, UU_LD = 11264;
constexpr int KROWS = 24576;
constexpr int NTHREADS = 512;
constexpr int LDS_BYTES = 131072 + 16;

enum { I_XP = 0, I_XS, I_C, I_CCKV, I_CKPE, I_CCTX, I_ADAW, I_ADAB, I_NMPRE, I_NMPOST, I_NFPRE, I_NFPOST, I_WIN, I_HCW, I_HCB,
       I_FW1, I_FB1, I_FW2, I_FB2, I_FW3, I_FB3, I_FFREQ, I_HBIAS, I_QN, I_KVN, I_WUQ, I_WUKV, I_SCW, I_WBRA, I_WBRB, I_WBRC,
       I_WO, I_FUP, I_FCW, I_FCB, I_FDN, N_INPUTS };

constexpr size_t E_WIN = (size_t)13312 * 2048, E_WUQ = (size_t)1536 * 512, E_WUKV = (size_t)2048 * 256, E_WBR = (size_t)2048 * 1024,
                 E_WO = (size_t)2048 * 2048, E_WUP = (size_t)11264 * 2048, E_WDN = (size_t)2048 * 5632;
constexpr size_t W_IN = 0, W_UQ = W_IN + E_WIN * 2, W_UKV = W_UQ + E_WUQ * 2, W_BRA = W_UKV + E_WUKV * 2, W_BRB = W_BRA + E_WBR * 2,
                 W_BRC = W_BRB + E_WBR * 2, W_O = W_BRC + E_WBR * 2, W_UP = W_O + E_WO * 2, W_DN = W_UP + E_WUP * 2, W_END = W_DN + E_WDN * 2;
constexpr size_t S_MOD = W_END, SZ_MOD = (size_t)NLAYER * 16 * 9 * 12288 * 4;
constexpr size_t S_KTS = S_MOD + SZ_MOD, S_KTP = S_KTS + (size_t)1024 * 4096 * 4, S_PARTS = S_KTP + (size_t)1024 * 512 * 4,
                 S_PARTP = S_PARTS + (size_t)64 * 2048 * 4, S_ROPE = S_PARTP + (size_t)8 * 2048 * 4, S_BAR = S_ROPE + (size_t)2 * 2048 * 32 * 4, S_COMB = S_BAR + 16384, S_SCALE = S_COMB + (size_t)NLAYER * 3 * 9 * 3 * 2048 * 4, S_TAIL = S_BAR + 14336, S_END = S_SCALE + 8192;
constexpr size_t AR = S_END;
constexpr size_t SZ_H = (size_t)MT * 2048 * 2;
constexpr size_t A_H = AR, A_UU = AR + SZ_H, A_ACT = A_UU + (size_t)MT * UU_LD * 2, AR_END = A_ACT + (size_t)MT * DFF * 2;
constexpr size_t A_PROJA = A_UU;
constexpr size_t A_Q = A_UU, A_KN = A_Q + (size_t)MT * 1536 * 2, A_VT = A_KN + (size_t)KROWS * 1024 * 2, A_YCT = A_VT + (size_t)KROWS * 1024 * 2;
constexpr size_t A_GATES = A_UU, A_M32 = A_GATES + (size_t)MT * GATE_LD * 2, A_MBF = A_H, A_F32 = A_UU;
constexpr size_t A_S = A_M32 + (size_t)MT * 2048 * 4;
constexpr size_t A_ZZT = A_S, A_X0S = A_ZZT + (size_t)MT * 1024 * 2, A_CQN = A_X0S + (size_t)MT * 1024 * 2, A_KEYSC = A_CQN + (size_t)MT * 512 * 2,
                 A_KPER = A_KEYSC + (size_t)KROWS * 256 * 2, A_YA = A_KPER + (size_t)KROWS * 64 * 2, A_OATT = A_YA + (size_t)MT * 1024 * 2,
                 A_YC = A_OATT + (size_t)MT * 1024 * 2, A_SEND = A_YC + (size_t)MT * 1024 * 2;
constexpr size_t A_RAW = A_M32;
static_assert(A_RAW + (size_t)3 * MT * 2048 * 2 <= A_CQN, "raw branch buffer overlaps live data");
static_assert(A_SEND <= AR_END, "arena overflow");
static_assert(A_YCT + (size_t)MT * 1024 * 2 <= A_M32, "arena overlap");
constexpr size_t WS_NEED = AR_END;
static_assert(WS_NEED <= 967590400ull, "workspace too large");

struct Params {
    const float* in[N_INPUTS];
    float* out;
    unsigned char* ws;
};

__device__ __forceinline__ unsigned cvt_pk_bf16(float lo, float hi) { unsigned r; asm volatile("v_cvt_pk_bf16_f32 %0, %1, %2" : "=v"(r) : "v"(lo), "v"(hi)); return r; }
__device__ __forceinline__ bf16_t f2bf(float f) { return (bf16_t)(cvt_pk_bf16(f, 0.f) & 0xffffu); }
__device__ __forceinline__ float bf_lo(unsigned w) { return __uint_as_float(w << 16); }
__device__ __forceinline__ float bf_hi(unsigned w) { return __uint_as_float(w & 0xffff0000u); }
__device__ __forceinline__ void unpack8(const u32x4 v, float* f) { f[0] = bf_lo(v.x); f[1] = bf_hi(v.x); f[2] = bf_lo(v.y); f[3] = bf_hi(v.y); f[4] = bf_lo(v.z); f[5] = bf_hi(v.z); f[6] = bf_lo(v.w); f[7] = bf_hi(v.w); }
__device__ __forceinline__ u32x4 pack8(const float* f) { u32x4 r; r.x = cvt_pk_bf16(f[0], f[1]); r.y = cvt_pk_bf16(f[2], f[3]); r.z = cvt_pk_bf16(f[4], f[5]); r.w = cvt_pk_bf16(f[6], f[7]); return r; }
__device__ __forceinline__ float shx(float v, int mask, int lane) { return __int_as_float(__builtin_amdgcn_ds_bpermute((lane ^ mask) << 2, __float_as_int(v))); }
__device__ __forceinline__ float wave_sum(float v, int lane) {
#pragma unroll
    for (int o = 32; o >= 1; o >>= 1) v += shx(v, o, lane);
    return v;
}
__device__ __forceinline__ int otid(int wv) { int t; asm volatile("v_mbcnt_lo_u32_b32 %0, -1, 0\n\tv_mbcnt_hi_u32_b32 %0, -1, %0" : "=v"(t)); return wv * 64 + t; }
__device__ __forceinline__ int obid() { int t = blockIdx.x; asm volatile("" : "+s"(t)); return t; }
__device__ __forceinline__ float sigmoidf_(float x) { return __builtin_amdgcn_rcpf(1.0f + __builtin_amdgcn_exp2f(-1.4426950408889634f * x)); }
__device__ __forceinline__ float siluf_(float x) { return x * sigmoidf_(x); }

namespace pg8 {
constexpr int BM = 256, BK = 64, HALF = 128, HTB = HALF * BK * 2, STAGE_BYTES = 8 * HTB, NXCD = 8, WGM = 8;
__host__ __device__ __forceinline__ int lds_byte(int r, int c) { const int st = (r >> 4) * 2 + (c >> 5), rr = r & 15, cc = c & 31, ob = rr * 64 + cc * 2; return st * 1024 + (ob ^ (((ob >> 9) & 1) << 5)); }
__host__ __device__ __forceinline__ void stage_rc(int b, int& R, int& C) { const int st = b / 1024, sb = b % 1024, swz = sb ^ (((sb >> 9) & 1) << 5); R = (st >> 1) * 16 + swz / 64; C = (st & 1) * 32 + (swz % 64) / 2; }
__host__ __device__ __forceinline__ int perm32(int rho) { const int n = rho >> 4, i = rho & 15; return 8 * (i >> 2) + 4 * n + (i & 3); }
struct Unit { int pm, pn, kh; };
struct Gemm { const bf16_t* A; const bf16_t* Bt; int M, N, K; int nMper; size_t bstride; };
struct StaticOrder {
    int nM, nN, nwg, G, c, nfull;
    __device__ void init(int M, int N, int G_, int c_, bool split = false) { nM = M / BM; nN = N / BM; nwg = nM * nN; G = G_; c = c_;
        nfull = nwg; if (split) { const int rem = nwg % G; if (rem > 0 && 2 * rem <= G) nfull = nwg - rem; } }
    __device__ void tile_of(int wgid, Unit& u) const {
        { const int q = nwg / NXCD, r = nwg % NXCD, xcd = wgid % NXCD, off = wgid / NXCD; wgid = (xcd < r ? xcd * (q + 1) : r * (q + 1) + (xcd - r) * q) + off; }
        const int nig = WGM * nN, gid = wgid / nig, fm = gid * WGM, gsz = (nM - fm) < WGM ? (nM - fm) : WGM;
        u.pm = fm + ((wgid % nig) % gsz); u.pn = (wgid % nig) / gsz;
    }
    __device__ bool next(int i, Unit& u) const {
        const long L = (long)i * G + c;
        int tile = (int)L, kh = -1; bool ok = L < nwg;
        if (L >= nfull) { const long h = L - nfull; ok = h < 2 * (long)(nwg - nfull); tile = nfull + (int)(h >> 1); kh = (int)(h & 1); }
        if (!ok) return false;
        int pm, pn;
        { int wgid = tile; const int q = nwg / NXCD, r = nwg % NXCD, xcd = wgid % NXCD, off = wgid / NXCD; wgid = (xcd < r ? xcd * (q + 1) : r * (q + 1) + (xcd - r) * q) + off;
          const int nig = WGM * nN, gid = wgid / nig, fm = gid * WGM, gsz = (nM - fm) < WGM ? (nM - fm) : WGM;
          pm = fm + ((wgid % nig) % gsz); pn = (wgid % nig) / gsz; }
        u.pm = pm; u.pn = pn; u.kh = kh; return true;
    }
};
template <class Epi>
__device__ __forceinline__ void gemm_phase(int wv, LAS unsigned char* lds, const Gemm g, const StaticOrder& S, const Epi& E) {
    const int tid = otid(wv), wid = __builtin_amdgcn_readfirstlane(tid >> 6), lane = tid & 63, wr = wid >> 2, wc = wid & 3, fr = lane & 15, fq = lane >> 4;
    const int K = g.K, nt = K / BK;
    unsigned voffA[2], voffB[2];
#pragma unroll
    for (int i = 0; i < 2; ++i) { int R, C; stage_rc(tid * 16 + i * 8192, R, C); const int Rb = (R & ~31) + perm32(R & 31); voffA[i] = (unsigned)(R * K + C) * 2u; voffB[i] = (unsigned)(Rb * K + C) * 2u; }
    const size_t kstep = (size_t)(BK * 2);
    const size_t hstep = (size_t)HALF * K * 2;
    const size_t tstep = 2 * hstep;
    const unsigned ldsw = (unsigned)wid * 1024u;
    const int aoff = lds_byte(wr * 64 + fr, fq * 8), boff = lds_byte(wc * 32 + fr, fq * 8);
#define PG8_SA(b, h) (((b) * 2 + (h)) * HTB)
#define PG8_SB(b, h) ((4 + (b) * 2 + (h)) * HTB)
#define PG8_STAGE(bufoff, gbase, voff) do { _Pragma("unroll") for (int _i = 0; _i < 2; ++_i) \
        __builtin_amdgcn_global_load_lds((const unsigned*)((const char*)(gbase) + (voff)[_i]), (LAS unsigned*)(lds + (bufoff) + ldsw + _i * 8192), 16, 0, 0); } while (0)
#define PG8_LDA(dst, b, h) do { _Pragma("unroll") for (int m = 0; m < 4; ++m) _Pragma("unroll") for (int k = 0; k < 2; ++k) dst[m][k] = *(const LAS bf16x8*)(lds + PG8_SA(b, h) + aoff + m * 2048 + k * 1024); } while (0)
#define PG8_LDB(dst, b, h) do { _Pragma("unroll") for (int n = 0; n < 2; ++n) _Pragma("unroll") for (int k = 0; k < 2; ++k) dst[n][k] = *(const LAS bf16x8*)(lds + PG8_SB(b, h) + boff + n * 2048 + k * 1024); } while (0)
#define PG8_MMA(ai, bj, At, Bt) do { __builtin_amdgcn_s_setprio(1); _Pragma("unroll") for (int m = 0; m < 4; ++m) _Pragma("unroll") for (int n = 0; n < 2; ++n) _Pragma("unroll") for (int k = 0; k < 2; ++k) \
        acc[ai][bj][m][n] = __builtin_amdgcn_mfma_f32_16x16x32_bf16(Bt[n][k], At[m][k], acc[ai][bj][m][n], 0, 0, 0); __builtin_amdgcn_s_setprio(0); } while (0)
#define PG8_WAIT_V(n) asm volatile("s_waitcnt vmcnt(" #n ")" ::: "memory")
#define PG8_WAIT_L(n) asm volatile("s_waitcnt lgkmcnt(" #n ")" ::: "memory")
#define PG8_BAR __builtin_amdgcn_s_barrier()
#define PG8_SCHED __builtin_amdgcn_sched_barrier(0)
    Unit cur, nxt; int ui = 0;
    if (!S.next(0, cur)) return;
    f32x4 acc[2][2][4][2];
#pragma unroll
    for (int a = 0; a < 2; ++a)
#pragma unroll
        for (int b = 0; b < 2; ++b)
#pragma unroll
            for (int m = 0; m < 4; ++m)
#pragma unroll
                for (int n = 0; n < 2; ++n) acc[a][b][m][n] = (f32x4){0.f, 0.f, 0.f, 0.f};
    bf16x8 At[4][2], B0[2][2], B1[2][2];
    const size_t khoff = (size_t)(nt / 2) * kstep;
    const char* cA = (const char*)g.A + (size_t)cur.pm * tstep + (cur.kh == 1 ? khoff : 0); const char* cB = (const char*)g.Bt + (size_t)(cur.pm / g.nMper) * g.bstride + (size_t)cur.pn * tstep + (cur.kh == 1 ? khoff : 0);
    PG8_STAGE(PG8_SB(0, 0), cB, voffB); PG8_STAGE(PG8_SA(0, 0), cA, voffA); PG8_STAGE(PG8_SB(0, 1), cB + hstep, voffB); PG8_STAGE(PG8_SA(0, 1), cA + hstep, voffA);
    if (wr == 1) PG8_BAR;
    PG8_WAIT_V(4); PG8_BAR;
    PG8_STAGE(PG8_SB(1, 0), cB + kstep, voffB); PG8_STAGE(PG8_SA(1, 0), cA + kstep, voffA); PG8_STAGE(PG8_SB(1, 1), cB + hstep + kstep, voffB);
    PG8_WAIT_V(6); PG8_BAR;
    for (;;) {
        const bool has_next = S.next(ui + 1, nxt);
        const char* nA = has_next ? (const char*)g.A + (size_t)nxt.pm * tstep + (nxt.kh == 1 ? khoff : 0) : cA; const char* nB = has_next ? (const char*)g.Bt + (size_t)(nxt.pm / g.nMper) * g.bstride + (size_t)nxt.pn * tstep + (nxt.kh == 1 ? khoff : 0) : cB;
        const int ntu = (cur.kh < 0) ? nt : (nt >> 1);
        for (int t = 0; t < ntu; t += 2) {
            const bool last = (t == ntu - 2);
            const char* a1 = cA + (size_t)(t + 1) * kstep;
            const char* a2 = last ? nA : cA + (size_t)(t + 2) * kstep; const char* b2 = last ? nB : cB + (size_t)(t + 2) * kstep;
            const char* a3 = a2 + kstep; const char* b3 = b2 + kstep;
            PG8_LDB(B0, 0, 0); PG8_SCHED; PG8_LDA(At, 0, 0); PG8_STAGE(PG8_SA(1, 1), a1 + hstep, voffA);
            PG8_WAIT_L(8); PG8_BAR; PG8_WAIT_L(0); PG8_MMA(0, 0, At, B0); PG8_BAR; PG8_SCHED;
            PG8_LDB(B1, 0, 1); PG8_STAGE(PG8_SB(0, 0), b2, voffB);
            PG8_BAR; PG8_WAIT_L(0); PG8_MMA(0, 1, At, B1); PG8_BAR;
            PG8_LDA(At, 0, 1); PG8_STAGE(PG8_SA(0, 0), a2, voffA);
            PG8_BAR; PG8_WAIT_L(0); PG8_MMA(1, 0, At, B0); PG8_BAR; PG8_SCHED;
            PG8_STAGE(PG8_SB(0, 1), b2 + hstep, voffB);
            PG8_WAIT_V(6); PG8_BAR; PG8_MMA(1, 1, At, B1); PG8_BAR;
            PG8_LDB(B0, 1, 0); PG8_SCHED; PG8_LDA(At, 1, 0); PG8_STAGE(PG8_SA(0, 1), a2 + hstep, voffA);
            PG8_WAIT_L(8); PG8_BAR; PG8_WAIT_L(0); PG8_MMA(0, 0, At, B0); PG8_BAR; PG8_SCHED;
            PG8_LDB(B1, 1, 1); PG8_STAGE(PG8_SB(1, 0), b3, voffB);
            PG8_BAR; PG8_WAIT_L(0); PG8_MMA(0, 1, At, B1); PG8_BAR;
            PG8_LDA(At, 1, 1); PG8_STAGE(PG8_SA(1, 0), a3, voffA);
            PG8_BAR; PG8_WAIT_L(0); PG8_MMA(1, 0, At, B0); PG8_BAR; PG8_SCHED;
            PG8_STAGE(PG8_SB(1, 1), b3 + hstep, voffB);
            PG8_WAIT_V(6); PG8_BAR; PG8_MMA(1, 1, At, B1); PG8_BAR;
        }
        { const int t2 = otid(wv); const int l2 = t2 & 63, w2 = __builtin_amdgcn_readfirstlane(t2 >> 6); E(acc, cur, w2 >> 2, w2 & 3, l2 & 15, l2 >> 4); }
        if (!has_next) break;
#pragma unroll
        for (int a = 0; a < 2; ++a)
#pragma unroll
            for (int b = 0; b < 2; ++b)
#pragma unroll
                for (int m = 0; m < 4; ++m)
#pragma unroll
                    for (int n = 0; n < 2; ++n) acc[a][b][m][n] = (f32x4){0.f, 0.f, 0.f, 0.f};
        cur = nxt; cA = nA; cB = nB; ++ui;
    }
    PG8_WAIT_V(0);
    if (wr == 0) PG8_BAR;
    PG8_BAR;
#undef PG8_SA
#undef PG8_SB
#undef PG8_STAGE
#undef PG8_LDA
#undef PG8_LDB
#undef PG8_MMA
#undef PG8_WAIT_V
#undef PG8_WAIT_L
#undef PG8_BAR
#undef PG8_SCHED
}

struct EpiBf16 {
    bf16_t* O; int ldc; bf16_t* O2;
    __device__ __forceinline__ void operator()(const f32x4 (&acc)[2][2][4][2], const Unit& u, int wr, int wc, int fr, int fq) const {
        const int row0 = u.pm * BM + wr * 64 + fr, col0 = u.pn * BM + wc * 32 + 8 * fq;
        bf16_t* Ob = (u.kh == 1) ? O2 : O;
#pragma unroll
        for (int ai = 0; ai < 2; ++ai)
#pragma unroll
            for (int m = 0; m < 4; ++m) { bf16_t* rowp = Ob + (size_t)(row0 + ai * HALF + m * 16) * ldc + col0;
#pragma unroll
                for (int bj = 0; bj < 2; ++bj) { const f32x4 v0 = acc[ai][bj][m][0], v1 = acc[ai][bj][m][1];
                    u32x4 w; w.x = cvt_pk_bf16(v0[0], v0[1]); w.y = cvt_pk_bf16(v0[2], v0[3]); w.z = cvt_pk_bf16(v1[0], v1[1]); w.w = cvt_pk_bf16(v1[2], v1[3]);
                    *(u32x4*)(rowp + bj * HALF) = w; } }
    }
};
struct EpiF32 {
    float* C; int ldc;
    __device__ __forceinline__ void operator()(const f32x4 (&acc)[2][2][4][2], const Unit& u, int wr, int wc, int fr, int fq) const {
        const int row0 = u.pm * BM + wr * 64 + fr, col0 = u.pn * BM + wc * 32 + 4 * fq;
#pragma unroll
        for (int ai = 0; ai < 2; ++ai)
#pragma unroll
            for (int m = 0; m < 4; ++m) { float* rowp = C + (size_t)(row0 + ai * HALF + m * 16) * ldc + col0;
#pragma unroll
                for (int bj = 0; bj < 2; ++bj)
#pragma unroll
                    for (int n = 0; n < 2; ++n) *(f32x4*)(rowp + bj * HALF + n * 16) = acc[ai][bj][m][n]; }
    }
};
struct EpiVT {
    bf16_t* VTs; bf16_t* VTp;
    __device__ __forceinline__ void operator()(const f32x4 (&acc)[2][2][4][2], const Unit& u, int wr, int wc, int fr, int fq) const {
        const int KR0 = u.pn * BM;
        bf16_t* vt; int Lk;
        if (KR0 < BS * LKS) { const int b = KR0 / LKS; Lk = LKS; vt = VTs + (size_t)b * 1024 * LKS + (KR0 - b * LKS); }
        else { const int b = (KR0 - BS * LKS) >> 8; Lk = LP; vt = VTp + (size_t)b * 1024 * LP; }
        const int row0 = u.pm * BM + wr * 64 + fr, col0 = wc * 32 + 8 * fq;
#pragma unroll
        for (int ai = 0; ai < 2; ++ai)
#pragma unroll
            for (int m = 0; m < 4; ++m) { bf16_t* rowp = vt + (size_t)(row0 + ai * HALF + m * 16) * Lk + col0;
#pragma unroll
                for (int bj = 0; bj < 2; ++bj) { const f32x4 v0 = acc[ai][bj][m][0], v1 = acc[ai][bj][m][1];
                    u32x4 w; w.x = cvt_pk_bf16(v0[0], v0[1]); w.y = cvt_pk_bf16(v0[2], v0[3]); w.z = cvt_pk_bf16(v1[0], v1[1]); w.w = cvt_pk_bf16(v1[2], v1[3]);
                    *(u32x4*)(rowp + bj * HALF) = w; } }
    }
};
template <int P> struct EpiGate {
    const bf16_t* gates; float* m32; bf16_t* mbf;
    __device__ __forceinline__ void operator()(const f32x4 (&acc)[2][2][4][2], const Unit& u, int wr, int wc, int fr, int fq) const {
        const int row0 = u.pm * BM + wr * 64 + fr, col0 = u.pn * BM + wc * 32 + 4 * fq;
#pragma unroll
        for (int ai = 0; ai < 2; ++ai)
#pragma unroll
            for (int m = 0; m < 4; ++m) {
                const size_t row = (size_t)(row0 + ai * HALF + m * 16);
#pragma unroll
                for (int bj = 0; bj < 2; ++bj)
#pragma unroll
                    for (int n = 0; n < 2; ++n) {
                        const int col = col0 + bj * HALF + n * 16;
                        const u32x2 gw = *(const u32x2*)(gates + row * GATE_LD + P * 2048 + col);
                        f32x4 v = acc[ai][bj][m][n];
                        v[0] *= sigmoidf_(bf_lo(gw.x)); v[1] *= sigmoidf_(bf_hi(gw.x)); v[2] *= sigmoidf_(bf_lo(gw.y)); v[3] *= sigmoidf_(bf_hi(gw.y));
                        float* mp = m32 + row * 2048 + col;
                        if (P == 0) { *(f32x4*)mp = v; }
                        else if (P == 1) { const f32x4 o = *(const f32x4*)mp; *(f32x4*)mp = o + v; }
                        else { const f32x4 o = *(const f32x4*)mp; v = v + o; u32x2 w; w.x = cvt_pk_bf16(v[0], v[1]); w.y = cvt_pk_bf16(v[2], v[3]); *(u32x2*)(mbf + row * 2048 + col) = w; }
                    }
            }
    }
};
}

template <class Epi>
__device__ __forceinline__ void run_gemm(int wv, LAS unsigned char* lds, const bf16_t* A, const bf16_t* Bt, int M, int N, int K, const Epi& E, bool split = false, int nMper = 1 << 28, size_t bstride = 0, bool rev = false) {
    pg8::Gemm g; g.A = A; g.Bt = Bt; g.M = M; g.N = N; g.K = K; g.nMper = nMper; g.bstride = bstride;
    pg8::StaticOrder S; S.init(M, N, (int)gridDim.x, rev ? (int)gridDim.x - 1 - obid() : obid(), split);
    pg8::gemm_phase<Epi>(wv, lds, g, S, E);
    __syncthreads();
}

__device__ __forceinline__ void convT(int wv, const float* __restrict__ src, int K, int N, bf16_t* __restrict__ dst, int gate_shift, LAS unsigned char* lds) {
    const int tid = otid(wv), lane = tid & 63, kq = lane & 7, ng = lane >> 3;
    const int tn = N / 32, tk = K / 64, ntile = tn * tk, nwaves = gridDim.x * 8;
    for (int tile = obid() * 8 + (tid >> 6); tile < ntile; tile += 2 * nwaves) {
        const int tile2 = tile + nwaves; const bool has2 = tile2 < ntile;
        const int tkk = tile / tn, tnn = tile - tkk * tn, k0 = tkk * 64 + 8 * kq, n0 = tnn * 32 + 4 * ng;
        const int tkk2 = has2 ? tile2 / tn : tkk, tnn2 = has2 ? tile2 - tkk2 * tn : tnn, k02 = tkk2 * 64 + 8 * kq, n02 = tnn2 * 32 + 4 * ng;
        f32x4 v[8], v2[8];
#pragma unroll
        for (int i = 0; i < 8; ++i) v[i] = *(const f32x4*)(src + (size_t)(k0 + i) * N + n0);
#pragma unroll
        for (int i = 0; i < 8; ++i) v2[i] = *(const f32x4*)(src + (size_t)(k02 + i) * N + n02);
#pragma unroll
        for (int j = 0; j < 4; ++j) {
            int nd = n0 + j; if (gate_shift == 1 && nd >= NGATE0) nd += 192; if (gate_shift == 2) { const int hd = nd >> 8, wi = nd & 255; nd = (wi < 128) ? hd * 128 + wi : 1024 + hd * 128 + (wi - 128); }
            u32x4 w; w.x = cvt_pk_bf16(v[0][j], v[1][j]); w.y = cvt_pk_bf16(v[2][j], v[3][j]); w.z = cvt_pk_bf16(v[4][j], v[5][j]); w.w = cvt_pk_bf16(v[6][j], v[7][j]);
            *(u32x4*)(dst + (size_t)nd * K + k0) = w;
        }
        if (has2) {
#pragma unroll
            for (int j = 0; j < 4; ++j) {
                int nd = n02 + j; if (gate_shift == 1 && nd >= NGATE0) nd += 192; if (gate_shift == 2) { const int hd = nd >> 8, wi = nd & 255; nd = (wi < 128) ? hd * 128 + wi : 1024 + hd * 128 + (wi - 128); }
                u32x4 w; w.x = cvt_pk_bf16(v2[0][j], v2[1][j]); w.y = cvt_pk_bf16(v2[2][j], v2[3][j]); w.z = cvt_pk_bf16(v2[4][j], v2[5][j]); w.w = cvt_pk_bf16(v2[6][j], v2[7][j]);
                *(u32x4*)(dst + (size_t)nd * K + k02) = w;
            }
        }
    }
}

__device__ __forceinline__ void ada_phase(int wv, const Params& p, LAS unsigned char* lds) {
    LAS float* sl = (LAS float*)lds;
    float* mod = (float*)(p.ws + S_MOD);
    const int tid = otid(wv);
    for (int u = obid(); u < NLAYER * 8 * 16; u += gridDim.x) {
        const int l = u / 128, r = u % 128, cb = r % 8, kc = r / 8, k0 = kc * 128;
        for (int i = tid; i < 9 * 128; i += NTHREADS) { const int v = i >> 7, k = i & 127; const float x = (v == 0) ? p.in[I_CCTX][k0 + k] : p.in[I_C][(v - 1) * DM + k0 + k]; sl[i] = siluf_(x); }
        __syncthreads();
        const bool act = tid < 384; const int col = cb * 1536 + (act ? tid : 0) * 4;
        f32x4 acc[9];
#pragma unroll
        for (int i = 0; i < 9; ++i) acc[i] = (f32x4){0.f, 0.f, 0.f, 0.f};
        const float* wp = p.in[I_ADAW] + ((size_t)l * DM + k0) * 12288 + col;
#pragma unroll 8
        for (int k = 0; k < 128; ++k) {
            const f32x4 w = *(const f32x4*)(wp + (size_t)k * 12288);
#pragma unroll
            for (int i = 0; i < 9; ++i) acc[i] += sl[i * 128 + k] * w;
        }
#pragma unroll
        for (int i = 0; i < 9; ++i) if (act) *(f32x4*)(mod + ((size_t)(l * 16 + kc) * 9 + i) * 12288 + col) = acc[i];
        __syncthreads();
    }
}

__device__ __forceinline__ void filter_phase(int wv, const Params& p, int l, LAS unsigned char* lds) {
    LAS float* z = (LAS float*)lds;
    LAS float* H1 = z + 32 * 33;
    LAS float* H2 = H1 + 32 * 64;
    LAS float* W1 = H2 + 32 * 64;
    LAS float* W2 = W1 + 33 * 64;
    LAS float* BF = W2 + 64 * 64;
    const int tid = otid(wv);
    const float* w3 = p.in[I_FW3] + (size_t)l * 64 * 2048; const float* b3 = p.in[I_FB3] + l * 2048;
    for (int u = obid(); u < 72; u += gridDim.x) {
        const int g = (u < 64) ? 1 : 0; const int tc = g ? u : u - 64; const int L = g ? LS : LP; const int t0 = tc * 32;
        float* kT = (float*)(p.ws + (g ? S_KTS : S_KTP)); float* part = (float*)(p.ws + (g ? S_PARTS : S_PARTP));
        for (int i = tid; i < 33 * 64; i += NTHREADS) W1[i] = p.in[I_FW1][(size_t)l * 33 * 64 + i];
        for (int i = tid; i < 64 * 64; i += NTHREADS) W2[i] = p.in[I_FW2][(size_t)l * 64 * 64 + i];
        if (tid < 64) BF[tid] = p.in[I_FB1][l * 64 + tid]; else if (tid < 128) BF[tid] = p.in[I_FB2][l * 64 + tid - 64]; else if (tid < 256) BF[tid] = p.in[I_FFREQ][l * 128 + tid - 128];
        for (int i = tid; i < 32 * 33; i += NTHREADS) {
            const int t = i / 33, e = i - t * 33; const float tf = (float)(t0 + t);
            float v;
            if (e == 0) v = tf / (float)(L - 1);
            else { const int k = (e - 1) & 15; const float band = 1e-4f + (float)k * ((15.0f - 1e-4f) / 15.0f); const float w = (6.283185307179586f * tf) / (float)L; const float ang = w * band;
                   v = (e <= 16) ? cosf(ang) : -sinf(ang); }
            z[i] = v;
        }
        __syncthreads();
#pragma unroll
        for (int q = 0; q < 4; ++q) { const int i = tid + q * NTHREADS; const int t = i >> 6, j = i & 63; float s = BF[j];
#pragma unroll
            for (int e = 0; e < 33; ++e) s += z[t * 33 + e] * W1[e * 64 + j];
            H1[i] = sinf(BF[128 + j] * s); }
        __syncthreads();
#pragma unroll
        for (int q = 0; q < 4; ++q) { const int i = tid + q * NTHREADS; const int t = i >> 6, j = i & 63; float s = BF[64 + j];
#pragma unroll 16
            for (int e = 0; e < 64; ++e) s += H1[t * 64 + e] * W2[e * 64 + j];
            H2[i] = sinf(BF[192 + j] * s); }
        __syncthreads();
        const int c = tid * 4;
        const f32x4 bias = *(const f32x4*)(b3 + c);
        f32x4 delta;
#pragma unroll
        for (int j = 0; j < 4; ++j) { const int d = (c + j) & 1023; const float mn = -3.0701134573253945f, mx = -15.350567286626973f; delta[j] = fabsf(mn + (float)d * ((mx - mn) / 1023.0f)); }
        f32x4 psum = (f32x4){0.f, 0.f, 0.f, 0.f};
        for (int tb = 0; tb < 2; ++tb) {
            f32x4 acc[16];
#pragma unroll
            for (int i = 0; i < 16; ++i) acc[i] = bias;
#pragma unroll 8
            for (int k = 0; k < 64; ++k) {
                const f32x4 w = *(const f32x4*)(w3 + (size_t)k * 2048 + c);
#pragma unroll
                for (int i = 0; i < 16; ++i) acc[i] += H2[(tb * 16 + i) * 64 + k] * w;
            }
#pragma unroll
            for (int i = 0; i < 16; ++i) {
                const int t = t0 + tb * 16 + i; const float tn = (float)t / (float)(L - 1);
#pragma unroll
                for (int j = 0; j < 4; ++j) {
                    const float v = acc[i][j] * __expf(-tn * delta[j]);
                    const int cc = c + j;
                    if (cc < 1024) { kT[(size_t)cc * (2 * L) + t] = v; psum[j] += fabsf(v); }
                    else { const int d = cc - 1024; if (t == 0) kT[(size_t)d * (2 * L) + L] = 0.f; else { kT[(size_t)d * (2 * L) + 2 * L - t] = v; psum[j] += fabsf(v); } }
                }
            }
        }
        *(f32x4*)(part + (size_t)tc * 2048 + c) = psum;
        __syncthreads();
    }
}

__device__ __forceinline__ void row_sel(const Params& p, int l, int mode, int& l2, int& shi, int& sci, const float*& prew, bool& wh, int& gi, const float*& pw) {
    wh = true;
    if (mode == 0) { l2 = l; shi = 0; sci = 1; prew = p.in[I_NMPRE] + l * DM; }
    else if (mode == 1) { l2 = l; shi = 3; sci = 4; prew = p.in[I_NFPRE] + l * DM; }
    else { l2 = l + 1; shi = 0; sci = 1; wh = (l + 1 < NLAYER); if (!wh) l2 = l; prew = p.in[I_NMPRE] + l2 * DM; }
    gi = (mode == 1) ? 2 : 5;
    pw = p.in[mode == 1 ? I_NMPOST : I_NFPOST] + l * DM;
}
__device__ __forceinline__ void comb_phase(int wv, const Params& p) {
    const int tid = otid(wv);
    const float* mod = (const float*)(p.ws + S_MOD); float* comb = (float*)(p.ws + S_COMB);
    for (int idx = obid() * NTHREADS + tid; idx < NLAYER * 3 * 9 * 2048; idx += gridDim.x * NTHREADS) {
        const int c = idx & 2047, q = idx >> 11, mi = q % 9, q2 = q / 9, mode = q2 % 3, l = q2 / 3;
        int l2, shi, sci, gi; const float* prew; const float* pw; bool wh;
        row_sel(p, l, mode, l2, shi, sci, prew, wh, gi, pw);
        float g = 0.f, sc = 0.f, sh = 0.f;
        for (int kc = 0; kc < 16; ++kc) {
            g += mod[((size_t)(l * 16 + kc) * 9 + mi) * 12288 + gi * 2048 + c];
            sc += mod[((size_t)(l2 * 16 + kc) * 9 + mi) * 12288 + sci * 2048 + c];
            sh += mod[((size_t)(l2 * 16 + kc) * 9 + mi) * 12288 + shi * 2048 + c];
        }
        g += p.in[I_ADAB][(size_t)l * 12288 + gi * 2048 + c];
        sc += p.in[I_ADAB][(size_t)l2 * 12288 + sci * 2048 + c];
        sh += p.in[I_ADAB][(size_t)l2 * 12288 + shi * 2048 + c];
        float* o = comb + (size_t)q * 3 * 2048 + c;
        o[0] = g * pw[c]; o[2048] = prew[c] * (1.0f + sc); o[4096] = sh;
    }
}
__device__ __forceinline__ void row_phase(int wv, const Params& p, int l, int mode) {
    const int tid = otid(wv); const int wave = obid() * 8 + (tid >> 6), nw = gridDim.x * 8, lane = tid & 63;
    float* X = p.out;
    bf16_t* H = (bf16_t*)(p.ws + A_H);
    const bool wh = !(mode == 2 && l + 1 >= NLAYER);
    const int rows_per = (MT + nw - 1) / nw;
    int cur_mi = -1; f32x4 cpre[8], csh[8], cgv[8];
    for (int rr = 0; rr < rows_per; ++rr) {
        const int row = wave * rows_per + rr;
        if (row >= MT) break;
        const int mi = row < MP ? 0 : 1 + ((row - MP) >> 11);
        const float* cb = (const float*)(p.ws + S_COMB) + (size_t)((l * 3 + mode) * 9 + mi) * 3 * 2048 + lane * 4;
        if (mi != cur_mi) { cur_mi = mi;
#pragma unroll
            for (int i = 0; i < 8; ++i) { cpre[i] = *(const f32x4*)(cb + 2048 + i * 256); csh[i] = *(const f32x4*)(cb + 4096 + i * 256); if (mode != 0) cgv[i] = *(const f32x4*)(cb + i * 256); } }
        f32x4 x[8];
        const float* xs = (mode == 0) ? (row < MP ? p.in[I_XP] + (size_t)row * DM : p.in[I_XS] + (size_t)(row - MP) * DM) : X + (size_t)row * DM;
#pragma unroll
        for (int i = 0; i < 8; ++i) x[i] = *(const f32x4*)(xs + i * 256 + lane * 4);
        if (mode != 0) {
            const bf16_t* o = (const bf16_t*)(p.ws + (mode == 1 ? A_M32 : A_F32)) + (size_t)row * DM;
            const unsigned tm = ((const unsigned*)(p.ws + S_TAIL))[row >> 8];
            f32x4 ovv[8]; float ss = 0.f;
#pragma unroll
            for (int i = 0; i < 8; ++i) { const u32x2 w = *(const u32x2*)(o + i * 256 + lane * 4); ovv[i] = (f32x4){bf_lo(w.x), bf_hi(w.x), bf_lo(w.y), bf_hi(w.y)};
                if ((tm >> i) & 1u) { const u32x2 w2 = *(const u32x2*)(o + (size_t)MT * DM + i * 256 + lane * 4); ovv[i] += (f32x4){bf_lo(w2.x), bf_hi(w2.x), bf_lo(w2.y), bf_hi(w2.y)}; }
                ss += ovv[i][0] * ovv[i][0] + ovv[i][1] * ovv[i][1] + ovv[i][2] * ovv[i][2] + ovv[i][3] * ovv[i][3]; }
            ss = wave_sum(ss, lane);
            const float rstd = rsqrtf(ss * (1.0f / DM) + 1e-6f);
#pragma unroll
            for (int i = 0; i < 8; ++i) x[i] += cgv[i] * (ovv[i] * rstd);
        }
#pragma unroll
        for (int i = 0; i < 8; ++i) *(f32x4*)(X + (size_t)row * DM + i * 256 + lane * 4) = x[i];
        if (wh) {
            float ss = 0.f;
#pragma unroll
            for (int i = 0; i < 8; ++i) ss += x[i][0] * x[i][0] + x[i][1] * x[i][1] + x[i][2] * x[i][2] + x[i][3] * x[i][3];
            ss = wave_sum(ss, lane);
            const float rstd = rsqrtf(ss * (1.0f / DM) + 1e-6f);
#pragma unroll
            for (int i = 0; i < 8; ++i) {
                const f32x4 hv = (x[i] * rstd) * cpre[i] + csh[i];
                u32x2 o; o.x = cvt_pk_bf16(hv[0], hv[1]); o.y = cvt_pk_bf16(hv[2], hv[3]);
                *(u32x2*)(H + (size_t)row * DM + i * 256 + lane * 4) = o;
            }
        }
    }
}

__device__ __forceinline__ void rope_table_phase(int wv, const Params& p) {
    float* C = (float*)(p.ws + S_ROPE); float* Sn = C + 2048 * 32;
    const int tid = otid(wv);
    for (int idx = obid() * NTHREADS + tid; idx < 2048 * 32; idx += gridDim.x * NTHREADS) {
        const int t = idx >> 5, i = idx & 31, k = i & 15;
        const float inv = exp2f(-(float)k * 0.8304820237218406f);
        const float pos = (i < 16) ? (float)(t >> 6) : (float)(t & 63);
        const float ang = pos * inv; C[idx] = cosf(ang); Sn[idx] = sinf(ang);
    }
}
__device__ __forceinline__ void e2_phase(int wv, const Params& p, int l, LAS unsigned char* lds) {
    const bf16_t* PA = (const bf16_t*)(p.ws + A_PROJA);
    const int tid = otid(wv), lane = tid & 63;
    {
        for (int gw = obid() * 8 + (tid >> 6); gw < 2048; gw += gridDim.x * 8) {
            const int g = gw >> 10, d = gw & 1023; const int NU = g ? 64 : 8;
            const float* part = (const float*)(p.ws + (g ? S_PARTS : S_PARTP));
            float v = 0.f;
            if (lane < NU) v = part[lane * 2048 + d] + part[lane * 2048 + 1024 + d];
            v = wave_sum(v, lane);
            if (lane == 0) ((float*)(p.ws + S_SCALE))[gw] = 1.0f / v;
        }
    }
    {
        bf16_t* CQN = (bf16_t*)(p.ws + A_CQN); bf16_t* KC = (bf16_t*)(p.ws + A_KEYSC); bf16_t* KP = (bf16_t*)(p.ws + A_KPER);
        float* out_ckv = p.out + (size_t)MT * DM; float* out_kpe = out_ckv + (size_t)BP * NLAYER * LP * 256;
        const int wave = obid() * 8 + (tid >> 6), nw = gridDim.x * 8;
        for (int row = wave; row < MT + BS * PAST; row += nw) {
            if (row < MT) {
                const bf16_t* pr = PA + (size_t)row * PA_LD;
                { const u32x4 v = *(const u32x4*)(pr + 3072 + lane * 8); float f[8]; unpack8(v, f); float ss = 0.f;
#pragma unroll
                  for (int j = 0; j < 8; ++j) ss += f[j] * f[j];
                  ss = wave_sum(ss, lane); const float rstd = rsqrtf(ss * (1.0f / 512.0f) + 1e-6f);
                  const float* qn = p.in[I_QN] + l * 512 + lane * 8;
#pragma unroll
                  for (int j = 0; j < 8; ++j) f[j] = f[j] * rstd * qn[j];
                  *(u32x4*)(CQN + (size_t)row * 512 + lane * 8) = pack8(f); }
                int KR, t; const bool isp = row < MP; int b;
                if (isp) { b = row >> 8; t = row & 255; KR = BS * LKS + row; } else { const int r2 = row - MP; b = r2 >> 11; t = r2 & 2047; KR = b * LKS + t; }
                { const u32x2 v = *(const u32x2*)(pr + 3584 + lane * 4); float f[4] = {bf_lo(v.x), bf_hi(v.x), bf_lo(v.y), bf_hi(v.y)};
                  float ss = f[0] * f[0] + f[1] * f[1] + f[2] * f[2] + f[3] * f[3]; ss = wave_sum(ss, lane); const float rstd = rsqrtf(ss * (1.0f / 256.0f) + 1e-6f);
                  const float* kn = p.in[I_KVN] + l * 256 + lane * 4;
#pragma unroll
                  for (int j = 0; j < 4; ++j) f[j] = f[j] * rstd * kn[j];
                  if (isp) *(f32x4*)(out_ckv + ((size_t)(b * NLAYER + l) * LP + t) * 256 + lane * 4) = (f32x4){f[0], f[1], f[2], f[3]};
                  u32x2 w; w.x = cvt_pk_bf16(f[0], f[1]); w.y = cvt_pk_bf16(f[2], f[3]); *(u32x2*)(KC + (size_t)KR * 256 + lane * 4) = w; }
                { const float v = __uint_as_float(((unsigned)pr[3840 + lane]) << 16);
                  float o = v;
                  if (isp) out_kpe[((size_t)(b * NLAYER + l) * LP + t) * 64 + lane] = v;
                  else { const float pv = shx(v, 32, lane); const float* rc = (const float*)(p.ws + S_ROPE); const float cs = rc[t * 32 + (lane & 31)], sn = rc[2048 * 32 + t * 32 + (lane & 31)]; o = (lane < 32) ? (v * cs - pv * sn) : (pv * sn + v * cs); }
                  KP[(size_t)KR * 64 + lane] = f2bf(o); }
            } else {
                const int r2 = row - MT, b = r2 >> 9, j = r2 & 511; const int KR = b * LKS + LS + j;
                const float* cc = p.in[I_CCKV] + ((size_t)(b * NLAYER + l) * PAST + j) * 256 + lane * 4;
                const f32x4 v = *(const f32x4*)cc; u32x2 w; w.x = cvt_pk_bf16(v[0], v[1]); w.y = cvt_pk_bf16(v[2], v[3]); *(u32x2*)(KC + (size_t)KR * 256 + lane * 4) = w;
                KP[(size_t)KR * 64 + lane] = f2bf(p.in[I_CKPE][((size_t)(b * NLAYER + l) * PAST + j) * 64 + lane]);
            }
        }
    }
    {
        bf16_t* YC = (bf16_t*)(p.ws + A_YC); const float* scw = p.in[I_SCW] + (size_t)l * 3 * 1024;
        float w0[8], w1[8], w2[8]; int cur_d0 = -1;
        for (int it = obid() * NTHREADS + tid; it < (MT / 4) * 128; it += gridDim.x * NTHREADS) {
            const int ch = it >> 7, d0 = (it & 127) * 8, row0 = ch * 4;
            const int t0 = row0 < MP ? (row0 & 255) : ((row0 - MP) & 2047); const int L = row0 < MP ? LP : LS;
            if (d0 != cur_d0) { cur_d0 = d0; const f32x4 a = *(const f32x4*)(scw + d0), b = *(const f32x4*)(scw + d0 + 4), c = *(const f32x4*)(scw + 1024 + d0), d = *(const f32x4*)(scw + 1024 + d0 + 4),
                          e2 = *(const f32x4*)(scw + 2048 + d0), f = *(const f32x4*)(scw + 2048 + d0 + 4);
#pragma unroll
              for (int j = 0; j < 4; ++j) { w0[j] = a[j]; w0[4 + j] = b[j]; w1[j] = c[j]; w1[4 + j] = d[j]; w2[j] = e2[j]; w2[4 + j] = f[j]; } }
            const bf16_t* pr = PA + (size_t)row0 * PA_LD;
            float pp[8], pc[8], pn[8];
#pragma unroll
            for (int j = 0; j < 8; ++j) pp[j] = 0.f;
            if (t0 > 0) { float cg[8], uu[8]; unpack8(*(const u32x4*)(pr - PA_LD + 4928 + d0), cg); unpack8(*(const u32x4*)(pr - PA_LD + 5952 + d0), uu);
#pragma unroll
                for (int j = 0; j < 8; ++j) pp[j] = cg[j] * uu[j]; }
            { float cg[8], uu[8]; unpack8(*(const u32x4*)(pr + 4928 + d0), cg); unpack8(*(const u32x4*)(pr + 5952 + d0), uu);
#pragma unroll
              for (int j = 0; j < 8; ++j) pc[j] = cg[j] * uu[j]; }
#pragma unroll
            for (int i = 0; i < 4; ++i) {
#pragma unroll
                for (int j = 0; j < 8; ++j) pn[j] = 0.f;
                if (t0 + i + 1 < L) { float cg[8], uu[8]; unpack8(*(const u32x4*)(pr + (size_t)(i + 1) * PA_LD + 4928 + d0), cg); unpack8(*(const u32x4*)(pr + (size_t)(i + 1) * PA_LD + 5952 + d0), uu);
#pragma unroll
                    for (int j = 0; j < 8; ++j) pn[j] = cg[j] * uu[j]; }
                float bg[8], o[8]; unpack8(*(const u32x4*)(pr + (size_t)i * PA_LD + 3904 + d0), bg);
#pragma unroll
                for (int j = 0; j < 8; ++j) { o[j] = bg[j] * (w0[j] * pp[j] + w1[j] * pc[j] + w2[j] * pn[j]); pp[j] = pc[j]; pc[j] = pn[j]; }
                *(u32x4*)(YC + (size_t)(row0 + i) * 1024 + d0) = pack8(o);
            }
        }
    }
    {
        bf16_t* X0S = (bf16_t*)(p.ws + A_X0S); bf16_t* ZZT = (bf16_t*)(p.ws + A_ZZT);
        const float* hw = p.in[I_HCW] + (size_t)l * 3 * 3072; const float* hb = p.in[I_HCB] + (size_t)l * 3072;
        LAS bf16_t* zt = (LAS bf16_t*)lds;
        float wgt[3][3][8], bs[3][8]; int cur_dt = -1;
        for (int u = obid(); u < (MT / 256) * 16; u += gridDim.x) {
            const int rt = u >> 4, dt = u & 15; const int row0 = rt * 256;
            const int dg = tid & 7, rb = tid >> 3, d0 = dt * 64 + dg * 8; const int rowb = row0 + rb * 4;
            const int L = row0 < MP ? LP : LS; const int tb = (row0 < MP ? (row0 & 255) : ((row0 - MP) & 2047)) + rb * 4;
            const bool reload = (dt != cur_dt); cur_dt = dt;
            if (reload)
#pragma unroll
            for (int g = 0; g < 3; ++g) {
#pragma unroll
                for (int o = 0; o < 3; ++o) { const f32x4 a = *(const f32x4*)(hw + o * 3072 + g * 1024 + d0), b = *(const f32x4*)(hw + o * 3072 + g * 1024 + d0 + 4);
#pragma unroll
                    for (int j = 0; j < 4; ++j) { wgt[g][o][j] = a[j]; wgt[g][o][4 + j] = b[j]; } }
                const f32x4 a = *(const f32x4*)(hb + g * 1024 + d0), b = *(const f32x4*)(hb + g * 1024 + d0 + 4);
#pragma unroll
                for (int j = 0; j < 4; ++j) { bs[g][j] = a[j]; bs[g][4 + j] = b[j]; }
            }
            const bf16_t* pr = PA + (size_t)rowb * PA_LD + d0;
            u32x4 wp[3], wc[3], wn[3];
#pragma unroll
            for (int g = 0; g < 3; ++g) { wp[g] = (u32x4){0u, 0u, 0u, 0u}; if (tb > 0) wp[g] = *(const u32x4*)(pr - PA_LD + g * 1024); wc[g] = *(const u32x4*)(pr + g * 1024); }
#pragma unroll
            for (int i = 0; i < 4; ++i) {
#pragma unroll
                for (int g = 0; g < 3; ++g) { wn[g] = (u32x4){0u, 0u, 0u, 0u}; if (tb + i + 1 < L) wn[g] = *(const u32x4*)(pr + (size_t)(i + 1) * PA_LD + g * 1024); }
                float hv[3][8];
#pragma unroll
                for (int g = 0; g < 3; ++g) { float a[8], b[8], c[8]; unpack8(wp[g], a); unpack8(wc[g], b); unpack8(wn[g], c);
#pragma unroll
                    for (int j = 0; j < 8; ++j) hv[g][j] = bs[g][j] + wgt[g][0][j] * a[j] + wgt[g][1][j] * b[j] + wgt[g][2][j] * c[j];
                    wp[g] = wc[g]; wc[g] = wn[g]; }
                *(u32x4*)(X0S + (size_t)(rowb + i) * 1024 + d0) = pack8(hv[0]);
#pragma unroll
                for (int j = 0; j < 8; ++j) zt[(dg * 8 + j) * 264 + rb * 4 + i] = f2bf(hv[1][j] * hv[2][j]);
            }
            __syncthreads();
#pragma unroll
            for (int i = 0; i < 4; ++i) {
                const int chunk = tid + i * NTHREADS; const int dl = chunk >> 5, tch = chunk & 31; const int d = dt * 64 + dl;
                size_t base; int t0;
                if (row0 < MP) { const int b = row0 >> 8; t0 = 0; base = ((size_t)b * 1024 + d) * LP; }
                else { const int r2 = row0 - MP; const int b = r2 >> 11; t0 = r2 & 2047; base = (size_t)BP * 1024 * LP + ((size_t)b * 1024 + d) * LS; }
                *(u32x4*)(ZZT + base + t0 + tch * 8) = *(const LAS u32x4*)(zt + dl * 264 + tch * 8);
            }
            __syncthreads();
        }
    }
}

__device__ __forceinline__ void conv_phase(int wv, const Params& p, int l, LAS unsigned char* lds) {
    const int tid = otid(wv), wid = tid >> 6, lane = tid & 63, r = lane & 31, hh = lane >> 5;
    const bf16_t* ZZT = (const bf16_t*)(p.ws + A_ZZT); bf16_t* YCT = (bf16_t*)(p.ws + A_YCT);
    const float* hbias = p.in[I_HBIAS] + l * 1024;
    LAS bf16_t* cp = (LAS bf16_t*)lds;
    LAS bf16_t* zz = (LAS bf16_t*)(lds + 65536);
    LAS float* kf = (LAS float*)(lds + 98304);
    for (int u = obid(); u < 2048; u += gridDim.x) {
        const int g = (u < 1024) ? 1 : 0, d = u & 1023;
        const int L = g ? LS : LP, B = g ? BS : BP, L2 = 2 * L, NB = L / 32, NI = 32 / B, NT = NB / NI, lgB = g ? 3 : 4;
        const float* kT = (const float*)(p.ws + (g ? S_KTS : S_KTP)) + (size_t)d * L2;
        const float scale = ((const float*)(p.ws + S_SCALE))[g * 1024 + d]; const float bias = hbias[d];
        for (int i = tid; i < L2 / 4; i += NTHREADS) { f32x4 v = *(const f32x4*)(kT + i * 4); v *= scale; if (i == 0) v[0] += bias; *(LAS f32x4*)(kf + i * 4) = v; }
        const size_t zbase = g ? (size_t)BP * 1024 * LP : 0;
        for (int ch = tid; ch < B * L / 8; ch += NTHREADS) {
            const int b = ch / (L / 8), s8 = ch - b * (L / 8);
            *(LAS u32x4*)(zz + b * L + s8 * 8) = *(const u32x4*)(ZZT + zbase + ((size_t)b * 1024 + d) * L + s8 * 8);
        }
        __syncthreads();
        for (int ck = tid; ck < L2; ck += NTHREADS) {
            const int c = ck / (L2 / 8), m0 = (ck - c * (L2 / 8)) * 8;
            float f[8];
#pragma unroll
            for (int j = 0; j < 8; ++j) f[j] = kf[(L2 - (m0 + c + j)) & (L2 - 1)];
            *(LAS u32x4*)(cp + c * L2 + m0) = pack8(f);
        }
        __syncthreads();
        const int Iloc = r >> lgB, b = r & (B - 1);
        for (int nt = wid * 2; nt < NT; nt += 16) {
            const int I0 = nt * NI;
            f32x16 acc0, acc1;
#pragma unroll
            for (int i = 0; i < 16; ++i) { acc0[i] = 0.f; acc1[i] = 0.f; }
            const bf16x8 zero8 = (bf16x8){0, 0, 0, 0, 0, 0, 0, 0};
            bf16x8 prev[4][2];
#pragma unroll
            for (int i = 0; i < 4; ++i) { prev[i][0] = zero8; prev[i][1] = zero8; }
            const int dl0 = I0 - (NB - 1), nsteps = NB + 2 * NI - 1;
            if (NI == 4) {
                for (int c4 = 0; c4 < nsteps; c4 += 4) {
                    bf16x8 cur[4][2];
#pragma unroll
                    for (int i = 0; i < 4; ++i) {
                        const int dl = dl0 + c4 + i; const int J0 = I0 + Iloc - dl; const bool v0 = (J0 >= 0) && (J0 < NB);
#pragma unroll
                        for (int ks = 0; ks < 2; ++ks) {
                            const int i0 = (16 * ks + 8 * hh - 32 * dl - r) & (L2 - 1); const int c = i0 & 7, q = i0 >> 3;
                            const bf16x8 Af = *(const LAS bf16x8*)(cp + c * L2 + q * 8);
                            cur[i][ks] = zero8;
                            if (v0) cur[i][ks] = *(const LAS bf16x8*)(zz + b * L + 32 * J0 + 16 * ks + 8 * hh);
                            acc0 = __builtin_amdgcn_mfma_f32_32x32x16_bf16(Af, cur[i][ks], acc0, 0, 0, 0);
                            acc1 = __builtin_amdgcn_mfma_f32_32x32x16_bf16(Af, prev[i][ks], acc1, 0, 0, 0);
                        }
                    }
#pragma unroll
                    for (int i = 0; i < 4; ++i) { prev[i][0] = cur[i][0]; prev[i][1] = cur[i][1]; }
                }
            } else {
                for (int c2 = 0; c2 < nsteps + 1; c2 += 2) {
                    bf16x8 cur[2][2];
#pragma unroll
                    for (int i = 0; i < 2; ++i) {
                        const int dl = dl0 + c2 + i; const int J0 = I0 + Iloc - dl; const bool v0 = (J0 >= 0) && (J0 < NB);
#pragma unroll
                        for (int ks = 0; ks < 2; ++ks) {
                            const int i0 = (16 * ks + 8 * hh - 32 * dl - r) & (L2 - 1); const int c = i0 & 7, q = i0 >> 3;
                            const bf16x8 Af = *(const LAS bf16x8*)(cp + c * L2 + q * 8);
                            cur[i][ks] = zero8;
                            if (v0) cur[i][ks] = *(const LAS bf16x8*)(zz + b * L + 32 * J0 + 16 * ks + 8 * hh);
                            acc0 = __builtin_amdgcn_mfma_f32_32x32x16_bf16(Af, cur[i][ks], acc0, 0, 0, 0);
                            acc1 = __builtin_amdgcn_mfma_f32_32x32x16_bf16(Af, prev[i][ks], acc1, 0, 0, 0);
                        }
                    }
#pragma unroll
                    for (int i = 0; i < 2; ++i) { prev[i][0] = cur[i][0]; prev[i][1] = cur[i][1]; }
                }
            }
            bf16_t* op = YCT + zbase + ((size_t)b * 1024 + d) * L + 32 * (I0 + Iloc) + 4 * hh;
#pragma unroll
            for (int g4 = 0; g4 < 4; ++g4) {
                u32x2 w; w.x = cvt_pk_bf16(acc0[4 * g4], acc0[4 * g4 + 1]); w.y = cvt_pk_bf16(acc0[4 * g4 + 2], acc0[4 * g4 + 3]); *(u32x2*)(op + 8 * g4) = w;
                u32x2 w1; w1.x = cvt_pk_bf16(acc1[4 * g4], acc1[4 * g4 + 1]); w1.y = cvt_pk_bf16(acc1[4 * g4 + 2], acc1[4 * g4 + 3]); *(u32x2*)(op + 32 * NI + 8 * g4) = w1;
            }
        }
        __syncthreads();
    }
}

__device__ __forceinline__ void e3b_phase(int wv, const Params& p, LAS unsigned char* lds) {
    const int tid = otid(wv);
    const bf16_t* X0S = (const bf16_t*)(p.ws + A_X0S); const bf16_t* YCT = (const bf16_t*)(p.ws + A_YCT); bf16_t* YA = (bf16_t*)(p.ws + A_YA);
    LAS bf16_t* yt = (LAS bf16_t*)lds;
    for (int u = obid(); u < (MT / 64) * 16; u += gridDim.x) {
        const int rt = u >> 4, dt = u & 15; const int row0 = rt * 64;
        {
            const int dl = tid >> 3, tch = tid & 7; const int d = dt * 64 + dl;
            size_t base; int t0;
            if (row0 < MP) { const int b = row0 >> 8; t0 = row0 & 255; base = ((size_t)b * 1024 + d) * LP; }
            else { const int r2 = row0 - MP; const int b = r2 >> 11; t0 = r2 & 2047; base = (size_t)BP * 1024 * LP + ((size_t)b * 1024 + d) * LS; }
            const u32x4 v = *(const u32x4*)(YCT + base + t0 + tch * 8);
            const unsigned w[4] = {v.x, v.y, v.z, v.w};
#pragma unroll
            for (int j = 0; j < 4; ++j) { yt[(tch * 8 + 2 * j) * 72 + dl] = (bf16_t)(w[j] & 0xffffu); yt[(tch * 8 + 2 * j + 1) * 72 + dl] = (bf16_t)(w[j] >> 16); }
        }
        __syncthreads();
        {
            const int tl = tid >> 3, dg = tid & 7; const int row = row0 + tl, d0 = dt * 64 + dg * 8;
            float a[8], b[8]; unpack8(*(const LAS u32x4*)(yt + tl * 72 + dg * 8), a); unpack8(*(const u32x4*)(X0S + (size_t)row * 1024 + d0), b);
#pragma unroll
            for (int j = 0; j < 8; ++j) a[j] *= b[j];
            *(u32x4*)(YA + (size_t)row * 1024 + d0) = pack8(a);
        }
        __syncthreads();
    }
}

__device__ __forceinline__ void attn_phase(int wv, const Params& p, LAS unsigned char* lds) {
    const bf16_t* Q = (const bf16_t*)(p.ws + A_Q); const bf16_t* KN = (const bf16_t*)(p.ws + A_KN); const bf16_t* KP = (const bf16_t*)(p.ws + A_KPER);
    const bf16_t* VT = (const bf16_t*)(p.ws + A_VT); bf16_t* O = (bf16_t*)(p.ws + A_OATT);
    LAS unsigned char* Ks = lds;
    LAS unsigned char* Vs = lds + 64 * 400;
    const float sc2 = 0.07216878364870322f * 1.4426950408889634f;
    for (int u0 = obid(); u0 < 512 + 128; u0 += gridDim.x) {
        const int tid = otid(wv), wid = tid >> 6, lane = tid & 63, r = lane & 31, hh = lane >> 5;
        int u = u0;
        if (u0 < 512 && gridDim.x == 256) {
            const int c = u0 & 255, xcd = c & 7, j = c >> 3; u = (u0 & ~255) + ((xcd * 4 + (j >> 3)) * 8 + (j & 7));
        }
        int b, h, row0, Lk, KR0; size_t vtb; bool samp;
        if (u < 512) { samp = true; b = u >> 6; h = (u >> 3) & 7; const int qb = u & 7; row0 = MP + b * LS + qb * 256; Lk = LKS; KR0 = b * LKS; vtb = (size_t)(b * 8 + h) * 128 * LKS; }
        else { samp = false; const int u2 = u - 512; b = u2 >> 3; h = u2 & 7; row0 = b * LP; Lk = LP; KR0 = BS * LKS + b * LP; vtb = (size_t)BS * 8 * 128 * LKS + (size_t)(b * 8 + h) * 128 * LP; }
        const int qrow = row0 + wid * 32 + r;
        bf16x8 qf[12];
        {
            const bf16_t* qp = Q + (size_t)qrow * 1536 + h * 192 + 8 * hh;
            u32x4 qv[12];
#pragma unroll
            for (int s = 0; s < 12; ++s) qv[s] = *(const u32x4*)(qp + 16 * s);
            if (samp) {
                const int t = (qrow - MP) & 2047;
#pragma unroll
                for (int s2 = 0; s2 < 2; ++s2) {
                    float x1[8], x2[8]; unpack8(qv[8 + s2], x1); unpack8(qv[10 + s2], x2);
                    const float* rc = (const float*)(p.ws + S_ROPE) + t * 32 + 16 * s2 + 8 * hh;
                    const f32x4 c0 = *(const f32x4*)rc, c1 = *(const f32x4*)(rc + 4), s0 = *(const f32x4*)(rc + 2048 * 32), s1 = *(const f32x4*)(rc + 2048 * 32 + 4);
#pragma unroll
                    for (int j = 0; j < 8; ++j) { const float cs = (j < 4) ? c0[j & 3] : c1[j & 3], sn = (j < 4) ? s0[j & 3] : s1[j & 3]; const float a = x1[j], c = x2[j]; x1[j] = a * cs - c * sn; x2[j] = a * sn + c * cs; }
                    qv[8 + s2] = pack8(x1); qv[10 + s2] = pack8(x2);
                }
            }
#pragma unroll
            for (int s = 0; s < 12; ++s) qf[s] = __builtin_bit_cast(bf16x8, qv[s]);
        }
        f32x16 oacc[4];
#pragma unroll
        for (int ct = 0; ct < 4; ++ct)
#pragma unroll
            for (int i = 0; i < 16; ++i) oacc[ct][i] = 0.f;
        float mrun = -1e30f, lrun = 0.f;
        const int nkt = Lk / 64;
        u32x4 kst[3], vst[2];
#pragma unroll
        for (int i = 0; i < 3; ++i) { const int ck = tid + i * NTHREADS; const int key = ck / 24, part = ck - key * 24;
            kst[i] = (part < 16) ? *(const u32x4*)(KN + (size_t)(KR0 + key) * 1024 + h * 128 + part * 8) : *(const u32x4*)(KP + (size_t)(KR0 + key) * 64 + (part - 16) * 8); }
#pragma unroll
        for (int i = 0; i < 2; ++i) { const int cv = tid + i * NTHREADS; const int v = cv >> 3, kc = cv & 7; vst[i] = *(const u32x4*)(VT + vtb + (size_t)v * Lk + kc * 8); }
        for (int kt = 0; kt < nkt; ++kt) {
            __syncthreads();
#pragma unroll
            for (int i = 0; i < 3; ++i) { const int ck = tid + i * NTHREADS; const int key = ck / 24, part = ck - key * 24; *(LAS u32x4*)(Ks + key * 400 + part * 16) = kst[i]; }
#pragma unroll
            for (int i = 0; i < 2; ++i) { const int cv = tid + i * NTHREADS; const int v = cv >> 3, kc = cv & 7;
                LAS unsigned char* vp = Vs + v * 144 + (kc >> 1) * 32 + (kc & 1) * 8;
                *(LAS u32x2*)vp = (u32x2){vst[i].x, vst[i].y}; *(LAS u32x2*)(vp + 16) = (u32x2){vst[i].z, vst[i].w}; }
            __syncthreads();
            if (kt + 1 < nkt) {
                const int k0 = (kt + 1) * 64;
#pragma unroll
                for (int i = 0; i < 3; ++i) { const int ck = tid + i * NTHREADS; const int key = ck / 24, part = ck - key * 24;
                    kst[i] = (part < 16) ? *(const u32x4*)(KN + (size_t)(KR0 + k0 + key) * 1024 + h * 128 + part * 8) : *(const u32x4*)(KP + (size_t)(KR0 + k0 + key) * 64 + (part - 16) * 8); }
#pragma unroll
                for (int i = 0; i < 2; ++i) { const int cv = tid + i * NTHREADS; const int v = cv >> 3, kc = cv & 7; vst[i] = *(const u32x4*)(VT + vtb + (size_t)v * Lk + k0 + kc * 8); }
            }
            f32x16 sacc[2];
#pragma unroll
            for (int i = 0; i < 16; ++i) { sacc[0][i] = 0.f; sacc[1][i] = 0.f; }
#pragma unroll
            for (int s = 0; s < 12; ++s) {
                const bf16x8 kf0 = *(const LAS bf16x8*)(Ks + r * 400 + (16 * s + 8 * hh) * 2);
                const bf16x8 kf1 = *(const LAS bf16x8*)(Ks + (32 + r) * 400 + (16 * s + 8 * hh) * 2);
                sacc[0] = __builtin_amdgcn_mfma_f32_32x32x16_bf16(kf0, qf[s], sacc[0], 0, 0, 0);
                sacc[1] = __builtin_amdgcn_mfma_f32_32x32x16_bf16(kf1, qf[s], sacc[1], 0, 0, 0);
            }
            float mx0 = fmaxf(sacc[0][0], sacc[1][0]), mx1 = fmaxf(sacc[0][1], sacc[1][1]);
#pragma unroll
            for (int i = 2; i < 16; i += 2) { mx0 = __builtin_fmaxf(__builtin_fmaxf(mx0, sacc[0][i]), sacc[1][i]); mx1 = __builtin_fmaxf(__builtin_fmaxf(mx1, sacc[0][i + 1]), sacc[1][i + 1]); }
            float mx = fmaxf(mx0, mx1);
            mx = fmaxf(mx, shx(mx, 32, lane));
            const float mnew = fmaxf(mrun, mx);
            const bool resc = __builtin_amdgcn_ballot_w64(mnew != mrun) != 0ull;
            const float alpha = __builtin_amdgcn_exp2f((mrun - mnew) * sc2);
            mrun = mnew;
            const float nm = -mnew * sc2;
            f32x2 ps2 = (f32x2){0.f, 0.f};
#pragma unroll
            for (int kk = 0; kk < 2; ++kk)
#pragma unroll
                for (int i = 0; i < 16; i += 2) {
                    f32x2 a = (f32x2){sacc[kk][i], sacc[kk][i + 1]}; a = a * sc2 + nm;
                    a.x = __builtin_amdgcn_exp2f(a.x); a.y = __builtin_amdgcn_exp2f(a.y);
                    sacc[kk][i] = a.x; sacc[kk][i + 1] = a.y; ps2 += a;
                }
            lrun = lrun * alpha + (ps2.x + ps2.y);
            if (resc) {
#pragma unroll
                for (int ct = 0; ct < 4; ++ct)
#pragma unroll
                    for (int i = 0; i < 16; ++i) oacc[ct][i] *= alpha;
            }
#pragma unroll
            for (int ks = 0; ks < 4; ++ks) {
                const int kk = ks >> 1, s2 = ks & 1;
                u32x4 pw;
                pw.x = cvt_pk_bf16(sacc[kk][8 * s2 + 0], sacc[kk][8 * s2 + 1]); pw.y = cvt_pk_bf16(sacc[kk][8 * s2 + 2], sacc[kk][8 * s2 + 3]);
                pw.z = cvt_pk_bf16(sacc[kk][8 * s2 + 4], sacc[kk][8 * s2 + 5]); pw.w = cvt_pk_bf16(sacc[kk][8 * s2 + 6], sacc[kk][8 * s2 + 7]);
                const bf16x8 pf = __builtin_bit_cast(bf16x8, pw);
#pragma unroll
                for (int ct = 0; ct < 4; ++ct) {
                    const bf16x8 vf = *(const LAS bf16x8*)(Vs + (32 * ct + r) * 144 + (32 * kk + 16 * s2) * 2 + 16 * hh);
                    oacc[ct] = __builtin_amdgcn_mfma_f32_32x32x16_bf16(vf, pf, oacc[ct], 0, 0, 0);
                }
            }
        }
        lrun += shx(lrun, 32, lane);
        const float invl = 1.0f / lrun;
        const int tid2 = otid(wv); const int qrow2 = row0 + (tid2 >> 6) * 32 + (tid2 & 31);
        bf16_t* op = O + (size_t)qrow2 * 1024 + h * 128 + 4 * ((tid2 >> 5) & 1);
#pragma unroll
        for (int ct = 0; ct < 4; ++ct)
#pragma unroll
            for (int g4 = 0; g4 < 4; ++g4) {
                u32x2 w; w.x = cvt_pk_bf16(oacc[ct][4 * g4] * invl, oacc[ct][4 * g4 + 1] * invl); w.y = cvt_pk_bf16(oacc[ct][4 * g4 + 2] * invl, oacc[ct][4 * g4 + 3] * invl);
                *(u32x2*)(op + 32 * ct + 8 * g4) = w;
            }
        __syncthreads();
    }
}

__device__ __forceinline__ void e9_phase(int wv, const Params& p, int l) {
    const bf16_t* UU = (const bf16_t*)(p.ws + A_UU); bf16_t* ACT = (bf16_t*)(p.ws + A_ACT);
    const float* cw = p.in[I_FCW] + (size_t)l * 3 * UU_LD; const float* cb = p.in[I_FCB] + (size_t)l * UU_LD;
    const int tid9 = otid(wv);
    constexpr int RC = 16, NCG = DFF / 8;
    const int gt = obid() * NTHREADS + tid9, nlr = (int)(gridDim.x * NTHREADS) / NCG;
    const int c0 = (gt % NCG) * 8, lr = gt / NCG;
    float wg[3][8], wx[3][8], bg[8], bx[8];
    if (lr < nlr) {
#pragma unroll
        for (int o = 0; o < 3; ++o) { const f32x4 a = *(const f32x4*)(cw + o * UU_LD + c0), b = *(const f32x4*)(cw + o * UU_LD + c0 + 4), c = *(const f32x4*)(cw + o * UU_LD + DFF + c0), d = *(const f32x4*)(cw + o * UU_LD + DFF + c0 + 4);
#pragma unroll
            for (int j = 0; j < 4; ++j) { wg[o][j] = a[j]; wg[o][4 + j] = b[j]; wx[o][j] = c[j]; wx[o][4 + j] = d[j]; } }
        { const f32x4 a = *(const f32x4*)(cb + c0), b = *(const f32x4*)(cb + c0 + 4), c = *(const f32x4*)(cb + DFF + c0), d = *(const f32x4*)(cb + DFF + c0 + 4);
#pragma unroll
          for (int j = 0; j < 4; ++j) { bg[j] = a[j]; bg[4 + j] = b[j]; bx[j] = c[j]; bx[4 + j] = d[j]; } }
    }
    for (int ch = lr; lr < nlr && ch < MT / RC; ch += nlr) {
        const int row0 = ch * RC;
        const int t0 = row0 < MP ? (row0 & 255) : ((row0 - MP) & 2047); const int L = row0 < MP ? LP : LS;
        const bf16_t* pr = UU + (size_t)row0 * UU_LD + c0;
        u32x4 gp = (u32x4){0u, 0u, 0u, 0u}, xp = gp, gc, xc, gn, xn;
        if (t0 > 0) { gp = *(const u32x4*)(pr - UU_LD); xp = *(const u32x4*)(pr - UU_LD + DFF); }
        gc = *(const u32x4*)pr; xc = *(const u32x4*)(pr + DFF);
#pragma unroll 4
        for (int i = 0; i < RC; ++i) {
            gn = (u32x4){0u, 0u, 0u, 0u}; xn = gn;
            if (t0 + i + 1 < L) { gn = *(const u32x4*)(pr + (size_t)(i + 1) * UU_LD); xn = *(const u32x4*)(pr + (size_t)(i + 1) * UU_LD + DFF); }
            float a[8], b[8], c[8], ga[8], va[8];
            unpack8(gp, a); unpack8(gc, b); unpack8(gn, c);
#pragma unroll
            for (int j = 0; j < 8; ++j) ga[j] = bg[j] + wg[0][j] * a[j] + wg[1][j] * b[j] + wg[2][j] * c[j];
            unpack8(xp, a); unpack8(xc, b); unpack8(xn, c);
#pragma unroll
            for (int j = 0; j < 8; ++j) va[j] = bx[j] + wx[0][j] * a[j] + wx[1][j] * b[j] + wx[2][j] * c[j];
#pragma unroll
            for (int j = 0; j < 8; ++j) ga[j] = siluf_(ga[j]) * va[j];
            *(u32x4*)(ACT + (size_t)(row0 + i) * DFF + c0) = pack8(ga);
            gp = gc; gc = gn; xp = xc; xc = xn;
        }
    }
}

__device__ __forceinline__ void merge_phase(int wv, const Params& p) {
    const bf16_t* RAW = (const bf16_t*)(p.ws + A_RAW); const bf16_t* G = (const bf16_t*)(p.ws + A_GATES); bf16_t* MB = (bf16_t*)(p.ws + A_MBF);
    const int tid = otid(wv);
    for (int it = obid() * NTHREADS + tid; it < MT * 256; it += gridDim.x * NTHREADS) {
        const int row = it >> 8, c0 = (it & 255) * 8;
        float acc[8];
#pragma unroll
        for (int j = 0; j < 8; ++j) acc[j] = 0.f;
#pragma unroll
        for (int P = 0; P < 3; ++P) {
            float r[8], g[8];
            unpack8(*(const u32x4*)(RAW + ((size_t)P * MT + row) * DM + c0), r); unpack8(*(const u32x4*)(G + (size_t)row * GATE_LD + P * 2048 + c0), g);
#pragma unroll
            for (int j = 0; j < 8; ++j) acc[j] += sigmoidf_(g[j]) * r[j];
        }
        *(u32x4*)(MB + (size_t)row * DM + c0) = pack8(acc);
    }
}

__device__ __forceinline__ void convert_layer(int wv, const Params& p, int l, LAS unsigned char* lds, int part = 0) {
    unsigned char* ws = p.ws;
    const bool early = (part == 0 || part == 1 || part == 3), late = (part == 0 || part == 1 || part == 4), dn = (part == 0 || part == 2 || part == 4);
    if (early) {
        convT(wv, p.in[I_WIN] + (size_t)l * DM * NIN, DM, NIN, (bf16_t*)(ws + W_IN), 1, lds);
        convT(wv, p.in[I_WUQ] + (size_t)l * 512 * 1536, 512, 1536, (bf16_t*)(ws + W_UQ), 0, lds);
        convT(wv, p.in[I_WUKV] + (size_t)l * 256 * 2048, 256, 2048, (bf16_t*)(ws + W_UKV), 2, lds);
    }
    if (late) {
        convT(wv, p.in[I_WBRA] + (size_t)l * 1024 * 2048, 1024, 2048, (bf16_t*)(ws + W_BRA), 0, lds);
        convT(wv, p.in[I_WBRB] + (size_t)l * 1024 * 2048, 1024, 2048, (bf16_t*)(ws + W_BRB), 0, lds);
        convT(wv, p.in[I_WBRC] + (size_t)l * 1024 * 2048, 1024, 2048, (bf16_t*)(ws + W_BRC), 0, lds);
        convT(wv, p.in[I_WO] + (size_t)l * 2048 * 2048, 2048, 2048, (bf16_t*)(ws + W_O), 0, lds);
        convT(wv, p.in[I_FUP] + (size_t)l * 2048 * UU_LD, 2048, UU_LD, (bf16_t*)(ws + W_UP), 0, lds);
    }
    if (dn) convT(wv, p.in[I_FDN] + (size_t)l * DFF * 2048, DFF, 2048, (bf16_t*)(ws + W_DN), 0, lds);
}

namespace pg8 {
struct EpiGateRT {
    const bf16_t* gates; float* m32; bf16_t* mbf; int P;
    __device__ __forceinline__ void operator()(const f32x4 (&acc)[2][2][4][2], const Unit& u, int wr, int wc, int fr, int fq) const {
        const int row0 = u.pm * BM + wr * 64 + fr, col0 = u.pn * BM + wc * 32 + 4 * fq;
#pragma unroll
        for (int ai = 0; ai < 2; ++ai)
#pragma unroll
            for (int m = 0; m < 4; ++m) {
                const size_t row = (size_t)(row0 + ai * HALF + m * 16);
#pragma unroll
                for (int bj = 0; bj < 2; ++bj)
#pragma unroll
                    for (int n = 0; n < 2; ++n) {
                        const int col = col0 + bj * HALF + n * 16;
                        const u32x2 gw = *(const u32x2*)(gates + row * GATE_LD + P * 2048 + col);
                        f32x4 v = acc[ai][bj][m][n];
                        v[0] *= sigmoidf_(bf_lo(gw.x)); v[1] *= sigmoidf_(bf_hi(gw.x)); v[2] *= sigmoidf_(bf_lo(gw.y)); v[3] *= sigmoidf_(bf_hi(gw.y));
                        float* mp = m32 + row * 2048 + col;
                        if (P != 0) { const f32x4 o = *(const f32x4*)mp; v = v + o; }
                        if (P != 2) { *(f32x4*)mp = v; }
                        else { u32x2 w; w.x = cvt_pk_bf16(v[0], v[1]); w.y = cvt_pk_bf16(v[2], v[3]); *(u32x2*)(mbf + row * 2048 + col) = w; }
                    }
            }
    }
};
}


#define XB_TMO      128
#define XB_XCNT(j)  (256  + 64 * (j))
#define XB_XSUB(j)  (1280 + 64 * (j))
#define XB_XGEN(j)  (2304 + 64 * (j))
#define XB_TOP      3328
#define XB_TOPGEN   3392
#define XCD_BAR_WORDS 3456
#define XB_SPIN_CAP (1u << 20)
__device__ __forceinline__ unsigned xb_ld(unsigned* p)              { return __hip_atomic_load(p, __ATOMIC_RELAXED, __HIP_MEMORY_SCOPE_AGENT); }
__device__ __forceinline__ unsigned xb_add(unsigned* p, unsigned v) { return __hip_atomic_fetch_add(p, v, __ATOMIC_RELAXED, __HIP_MEMORY_SCOPE_AGENT); }
__device__ __forceinline__ unsigned xb_xcc_id() { return (unsigned)__builtin_amdgcn_s_getreg((3 << 11) | 20) & 0xFu; }
#define XB_SPIN(cond, bar) do { unsigned _sp = 0; while (cond) { __builtin_amdgcn_s_sleep(1); \
    if ((++_sp & 255u) == 0u) { if (xb_ld(&(bar)[XB_TMO])) break; if (_sp > XB_SPIN_CAP) { atomicAdd(&(bar)[XB_TMO], 1u); break; } } } } while (0)
__device__ __forceinline__ void xcd_barrier_complete(unsigned* bar, unsigned x, unsigned& nloc, unsigned& nx) {
    const unsigned G = gridDim.x;
    unsigned sum, cnt, mine, sp = 0u;
    for (;;) {
        sum = 0u; cnt = 0u; mine = 0u;
#pragma unroll
        for (unsigned j = 0; j < 16; ++j) { const unsigned c = xb_ld(&bar[XB_XCNT(j)]); sum += c; cnt += (c > 0u) ? 1u : 0u; mine = (j == x) ? c : mine; }
        if (sum == G) break;
        __builtin_amdgcn_s_sleep(1);
        if ((++sp & 255u) == 0u) { if (xb_ld(&bar[XB_TMO])) break; if (sp > XB_SPIN_CAP) { atomicAdd(&bar[XB_TMO], 1u); break; } }
    }
    nloc = mine > 0u ? mine : 1u; nx = cnt > 0u ? cnt : 1u;
}
__device__ __forceinline__ void xcd_barrier(int wv, unsigned* bar, volatile LAS unsigned* st) {
    asm volatile("s_waitcnt vmcnt(0)" ::: "memory");
    __syncthreads();
    if (otid(wv) == 0) {
        __builtin_amdgcn_s_waitcnt(0);
        const unsigned x = xb_xcc_id();
        unsigned nloc = st[0], nx = st[1];
        if (nloc == 0u) { xcd_barrier_complete(bar, x, nloc, nx); st[0] = nloc; st[1] = nx; }
        const unsigned old = xb_add(&bar[XB_XSUB(x)], 1u);
        const unsigned gen = old / nloc;
        if (old + 1u == (gen + 1u) * nloc) {
            __builtin_amdgcn_fence(__ATOMIC_RELEASE, "agent");
            asm volatile("s_waitcnt vmcnt(0)" ::: "memory");
            const unsigned og = xb_add(&bar[XB_TOP], 1u);
            const unsigned tg = og / nx;
            if (og + 1u == (tg + 1u) * nx) xb_add(&bar[XB_TOPGEN], 1u);
            else XB_SPIN(xb_ld(&bar[XB_TOPGEN]) == tg, bar);
            __builtin_amdgcn_fence(__ATOMIC_ACQUIRE, "agent");
            xb_add(&bar[XB_XGEN(x)], 1u);
            asm volatile("s_waitcnt vmcnt(0)" ::: "memory");
        } else {
            XB_SPIN(xb_ld(&bar[XB_XGEN(x)]) == gen, bar);
            __builtin_amdgcn_fence(__ATOMIC_ACQUIRE, "agent");
            asm volatile("s_waitcnt vmcnt(0)" ::: "memory");
        }
    }
    __syncthreads();
}

#ifndef REP_GEMM
#define REP_GEMM 1
#endif
#ifndef REP_ATTN
#define REP_ATTN 1
#endif
#ifndef REP_CONV
#define REP_CONV 1
#endif
#ifndef REP_ELT
#define REP_ELT 1
#endif
#ifndef REP_CVT
#define REP_CVT 1
#endif
enum { K_G1A = 0, K_E2, K_I3, K_I4, K_G1B, K_G5, K_G6, K_ROW1, K_G8, K_E9, K_G10, K_ROW2, K_PRO, K_ROW0, K_COMB };

__global__ void __launch_bounds__(NTHREADS) fwd_megakernel(Params p) {
    extern __shared__ __attribute__((aligned(16))) unsigned char shm[];
    LAS unsigned char* lds = (LAS unsigned char*)shm;
    cg::grid_group grid = cg::this_grid();
    const int wv = __builtin_amdgcn_readfirstlane((int)(threadIdx.x >> 6));
    volatile LAS unsigned* bst = (volatile LAS unsigned*)(lds + 131072);
    unsigned* bar = (unsigned*)(p.ws + S_BAR);
    if (threadIdx.x == 0) { bst[0] = 0u; bst[1] = 0u; bst[2] = 0u; bst[3] = 0u; (void)xb_add(&bar[XB_XCNT(xb_xcc_id())], 1u); }
    __syncthreads();
#pragma unroll 1
    for (int ph = 0; ph < 3 + 12 * NLAYER; ++ph) {
        int kind, l;
        if (ph == 0) { kind = K_PRO; l = 0; } else if (ph == 1) { kind = K_COMB; l = 0; } else if (ph == 2) { kind = K_ROW0; l = 0; } else { l = (ph - 3) / 12; kind = (ph - 3) - l * 12; }
        unsigned char* ws = p.ws;
        asm volatile("" : "+s"(ws));
        if (kind == K_G1A || kind == K_I3 || kind == K_G1B || kind == K_G8) {
            const bf16_t* A; const bf16_t* Bt; bf16_t* O; int N, K;
            if (kind == K_G1A) { A = (const bf16_t*)(ws + A_H); Bt = (const bf16_t*)(ws + W_IN); O = (bf16_t*)(ws + A_PROJA); N = PA_LD; K = DM; }
            else if (kind == K_I3) { A = (const bf16_t*)(ws + A_CQN); Bt = (const bf16_t*)(ws + W_UQ); O = (bf16_t*)(ws + A_Q); N = 1536; K = 512; }
            else if (kind == K_G1B) { A = (const bf16_t*)(ws + A_H); Bt = (const bf16_t*)(ws + W_IN) + (size_t)PA_LD * DM; O = (bf16_t*)(ws + A_GATES); N = GATE_LD; K = DM; }
            else { A = (const bf16_t*)(ws + A_H); Bt = (const bf16_t*)(ws + W_UP); O = (bf16_t*)(ws + A_UU); N = UU_LD; K = DM; }
            int Mr = MT;
            const int nrep = ((kind == K_I3) ? 2 : 1) * REP_GEMM;
            const bool cv0 = (kind == K_G1A) && (l == 0);
            const int c0first = (cv0 && (obid() & 1)) ? 1 : 0;
#pragma unroll 1
            for (int step = 0; step < 2; ++step) {
            const bool do_cvt = (step == 0) ? (c0first == 1) : (c0first == 0);
            if (do_cvt) { if (cv0) convert_layer(wv, p, 0, lds, 4); }
            else
#pragma unroll 1
            for (int rp = 0; rp < nrep; ++rp) {
                if (kind == K_I3 && rp >= REP_GEMM) { A = (const bf16_t*)(ws + A_KEYSC); Bt = (const bf16_t*)(ws + W_UKV); O = (bf16_t*)(ws + A_KN); N = 1024; K = 256; Mr = KROWS; }
                run_gemm(wv, lds, A, Bt, Mr, N, K, pg8::EpiBf16{O, N, O});
            }
            }
        }
        if (kind == K_I3) {
#pragma unroll 1
            for (int rp = 0; rp < REP_GEMM; ++rp)
            run_gemm(wv, lds, (const bf16_t*)(ws + W_UKV) + (size_t)1024 * 256, (const bf16_t*)(ws + A_KEYSC), 1024, KROWS, 256,
                     pg8::EpiVT{(bf16_t*)(ws + A_VT), (bf16_t*)(ws + A_VT) + (size_t)BS * 8 * 128 * LKS});
#pragma unroll 1
            for (int rp = 0; rp < REP_CONV; ++rp) conv_phase(wv, p, l, lds);
        }
        if (kind == K_I4) {
            const int efirst = obid() & 1;
#pragma unroll 1
            for (int step = 0; step < 2; ++step) {
                if ((step == 0) == (efirst == 1)) e3b_phase(wv, p, lds);
                else attn_phase(wv, p, lds);
            } }
        if (kind == K_G1B) {
#pragma unroll 1
            for (int rp = 0; rp < REP_GEMM; ++rp)
            run_gemm(wv, lds, (const bf16_t*)(ws + A_YA), (const bf16_t*)(ws + W_BRA), 3 * MT, DM, 1024, pg8::EpiBf16{(bf16_t*)(ws + A_RAW), DM, (bf16_t*)(ws + A_RAW)}, false, MT / 256, E_WBR * 2, true);
        }
        if (kind == K_G5) merge_phase(wv, p);
        if (kind == K_G6 || kind == K_G10) {
            const bool g6 = (kind == K_G6);
            const bool cvt = (kind == K_G10) && (l + 1 < NLAYER);
            const int cfirst = (cvt && (obid() & 1)) ? 1 : 0;
#pragma unroll 1
            for (int step = 0; step < 2; ++step) {
            const bool do_cvt = (step == 0) ? (cfirst == 1) : (cfirst == 0);
            if (do_cvt) { if (cvt) convert_layer(wv, p, l + 1, lds, 1); }
            else
            run_gemm(wv, lds, (const bf16_t*)(ws + (g6 ? A_MBF : A_ACT)), (const bf16_t*)(ws + (g6 ? W_O : W_DN)), MT, DM, g6 ? DM : DFF, pg8::EpiBf16{(bf16_t*)(ws + (g6 ? A_M32 : A_F32)), DM, (bf16_t*)(ws + (g6 ? A_M32 : A_F32)) + (size_t)MT * DM}, true);
            }
        }
        if (kind == K_E2) {
#pragma unroll 1
            for (int rp = 0; rp < REP_ELT; ++rp) e2_phase(wv, p, l, lds); }
        if (kind == K_E9) {
#pragma unroll 1
            for (int rp = 0; rp < REP_ELT; ++rp) e9_phase(wv, p, l); }
        if (kind == K_ROW0 || kind == K_ROW1 || kind == K_ROW2) row_phase(wv, p, l, kind == K_ROW0 ? 0 : (kind == K_ROW1 ? 1 : 2));
        if (kind == K_COMB) comb_phase(wv, p);
        if (kind == K_PRO) {
            if (obid() == 0) {
                pg8::StaticOrder S; S.init(MT, DM, (int)gridDim.x, 0, true);
                const int t0 = otid(wv);
                if (t0 < S.nwg - S.nfull) { pg8::Unit uu; S.tile_of(S.nfull + t0, uu); atomicOr((unsigned*)(p.ws + S_TAIL) + uu.pm, 1u << uu.pn); }
            }
            ada_phase(wv, p, lds); rope_table_phase(wv, p); }
        if (kind == K_PRO || (kind == K_ROW2 && l + 1 < NLAYER)) { const int ln = (kind == K_PRO) ? 0 : l + 1;
#pragma unroll 1
            for (int rp = 0; rp < REP_CVT; ++rp) { filter_phase(wv, p, ln, lds); convert_layer(wv, p, ln, lds, kind == K_PRO ? 3 : 2); } }
        if (p.ws == nullptr) grid.sync();
        xcd_barrier(wv, bar, bst);
    }
}

extern "C" void kernel_launch(void* const* d_in, const int* in_sizes, int n_in, void* d_out, int out_size, void* d_ws, size_t ws_size, hipStream_t stream) {
    static int grid_blocks = 0;
    if (grid_blocks == 0) {
        if (n_in != N_INPUTS || ws_size < WS_NEED) { fprintf(stderr, "kernel_launch: need %d inputs and %zu bytes of workspace; got %d, %zu\n", N_INPUTS, (size_t)WS_NEED, n_in, ws_size); grid_blocks = -1; return; }
        int dev = 0, cus = 0, per_cu = 0;
        hipGetDevice(&dev);
        hipDeviceGetAttribute(&cus, hipDeviceAttributeMultiprocessorCount, dev);
        if (hipFuncSetAttribute((const void*)fwd_megakernel, hipFuncAttributeMaxDynamicSharedMemorySize, LDS_BYTES) != hipSuccess) { fprintf(stderr, "kernel_launch: hipFuncSetAttribute failed\n"); grid_blocks = -1; return; }
        if (hipOccupancyMaxActiveBlocksPerMultiprocessor(&per_cu, (const void*)fwd_megakernel, NTHREADS, LDS_BYTES) != hipSuccess || per_cu < 1) { fprintf(stderr, "kernel_launch: occupancy query gave %d\n", per_cu); per_cu = 1; }
        (void)hipGetLastError();
        grid_blocks = cus * 1;
    }
    if (grid_blocks < 0) return;
        (void)hipMemsetAsync((unsigned char*)d_ws + S_BAR, 0, 16384, stream);
    Params p{};
    for (int i = 0; i < N_INPUTS; ++i) p.in[i] = (const float*)d_in[i];
    p.out = (float*)d_out; p.ws = (unsigned char*)d_ws;
    void* args[] = {&p};
    hipError_t e = hipLaunchCooperativeKernel((const void*)fwd_megakernel, dim3(grid_blocks), dim3(NTHREADS), args, LDS_BYTES, stream);
    if (e != hipSuccess) fprintf(stderr, "cooperative launch failed: %s (grid %d)\n", hipGetErrorString(e), grid_blocks);
}
```
